# Optimizing an MI355X kernel written in HIP

```python
import jax, jax.numpy as jnp
from jax import lax
import numpy as np

D_MODEL = 1024
BATCH = 2
SEQ = 8192
DEPTH = 4
DEC_BATCH = 32
DEC_SEQ = 4
PAST_LEN = 8192
PAGE_SIZE = 128

N_REC = (DEPTH + 1) // 2
N_ATT = DEPTH // 2
CONV_W = 4
D_RNN = D_MODEL // 2
RG_HEADS = 8
RG_BW = D_RNN // RG_HEADS
RG_C = 8.0
DN_HEADS = 4
DN_DK = 128
DN_DV = 128
DN_QK = DN_HEADS * DN_DK
DN_VD = DN_HEADS * DN_DV
DN_CHUNK = 64
CONV_CH = D_RNN + 2 * DN_QK + DN_VD
REC_IN = CONV_CH + D_RNN + DN_VD + 2 * DN_HEADS
ATT_HEADS = D_MODEL // 128
KV_HEADS = 2
HEAD_DIM = 128
GROUP = ATT_HEADS // KV_HEADS
IDX_HEADS = 8
IDX_DIM = 64
TOPK_MAX = 256
Q_BLOCK = 128
ATT_IN = ATT_HEADS * HEAD_DIM + 2 * KV_HEADS * HEAD_DIM + IDX_HEADS * IDX_DIM + IDX_DIM + IDX_HEADS
D_FF = 4 * D_MODEL
EPS = 1e-6

kernel_name = 'hybrid_rglru_gdn_dsa_step'


def rmsnorm(x, g):
    x32 = x.astype(jnp.float32)
    y = x32 * lax.rsqrt(jnp.mean(x32 * x32, axis=-1, keepdims=True) + EPS)
    return (y * g.astype(jnp.float32)).astype(x.dtype)


def l2norm(x):
    return x * lax.rsqrt(jnp.sum(x * x, axis=-1, keepdims=True) + EPS)


def mlp(x, w_up, w_down):
    h = jax.nn.relu(x @ w_up)
    return (h * h) @ w_down


def causal_dwconv(u, buf, w):
    T = u.shape[1]
    xp = jnp.concatenate([buf.astype(u.dtype), u], axis=1)
    out = xp[:, 0:T] * w[0]
    for i in range(1, CONV_W):
        out = out + xp[:, i:i + T] * w[i]
    return out, xp[:, T:]


def rglru(xr, is_first, h0, wa, ba, wx, bx, lam):
    B, T, _ = xr.shape
    f32 = jnp.float32
    x32 = xr.astype(f32)
    xb = x32.reshape(B, T, RG_HEADS, RG_BW)
    r = jax.nn.sigmoid(jnp.einsum('bthi,hij->bthj', xb, wa.astype(f32)).reshape(B, T, D_RNN) + ba.astype(f32))
    ig = jax.nn.sigmoid(jnp.einsum('bthi,hij->bthj', xb, wx.astype(f32)).reshape(B, T, D_RNN) + bx.astype(f32))
    log_a = -RG_C * r * jax.nn.softplus(-lam.astype(f32))
    a = jnp.exp(log_a)
    mult = jnp.where(is_first[None, :, None], 1.0, jnp.sqrt(jnp.maximum(1.0 - jnp.exp(2.0 * log_a), 0.0)))
    b = x32 * ig * mult
    b = b.at[:, 0].add(a[:, 0] * h0.astype(f32))

    def comb(lhs, rhs):
        return (lhs[0] * rhs[0], rhs[0] * lhs[1] + rhs[1])

    _, h = lax.associative_scan(comb, (a, b), axis=1)
    return h, h[:, -1]


def gated_delta(q, k, v, g, beta, S0):
    B, T, H, DK = q.shape
    DV = v.shape[-1]
    C = DN_CHUNK if T % DN_CHUNK == 0 else T
    n = T // C
    f32 = jnp.float32

    def chunks(x):
        return jnp.moveaxis(x.reshape((B, n, C, H) + x.shape[3:]), 3, 1)

    q = chunks(l2norm(q.astype(f32)) * DK ** -0.5)
    k = chunks(l2norm(k.astype(f32)))
    v = chunks(v.astype(f32))
    g = chunks(g.astype(f32))
    beta = chunks(beta.astype(f32))
    gc = jnp.cumsum(g, axis=-1)
    tri = jnp.tril(jnp.ones((C, C), bool))
    strict = jnp.tril(jnp.ones((C, C), bool), -1)
    decay = jnp.exp(jnp.where(tri, gc[..., :, None] - gc[..., None, :], -jnp.inf))
    kb = k * beta[..., None]
    lmat = jnp.where(strict, jnp.einsum('bhnid,bhnjd->bhnij', kb, k) * decay, 0.0)
    amat = lmat + jnp.eye(C, dtype=f32)
    rhs = jnp.concatenate([v * beta[..., None], kb * jnp.exp(gc)[..., None]], axis=-1)
    sol = lax.linalg.triangular_solve(amat, rhs, left_side=True, lower=True, unit_diagonal=True)
    u, w = sol[..., :DV], sol[..., DV:]
    attn = jnp.einsum('bhnid,bhnjd->bhnij', q, k) * decay
    qg = q * jnp.exp(gc)[..., None]
    kd = k * jnp.exp(gc[..., -1:] - gc)[..., None]
    glast = jnp.exp(gc[..., -1])

    def step(S, inp):
        u_i, w_i, a_i, qg_i, kd_i, gl_i = inp
        vnew = u_i - jnp.einsum('bhcd,bhdv->bhcv', w_i, S)
        o = jnp.einsum('bhcd,bhdv->bhcv', qg_i, S) + jnp.einsum('bhij,bhjv->bhiv', a_i, vnew)
        S = S * gl_i[..., None, None] + jnp.einsum('bhcd,bhcv->bhdv', kd_i, vnew)
        return S, o

    xs = tuple(jnp.moveaxis(t, 2, 0) for t in (u, w, attn, qg, kd, glast))
    S_T, o = lax.scan(step, S0.astype(f32), xs)
    o = jnp.moveaxis(jnp.moveaxis(o, 0, 2), 1, 3).reshape(B, T, H, DV)
    return o, S_T


def rec_mixer(xn, conv_buf, h0, S0, is_first, w_in, w_conv, b_conv, wa, ba, wx, bx, lam,
              a_log, dt_bias, dn_w, w_out):
    B, T, _ = xn.shape
    p = xn @ w_in
    u = p[..., :CONV_CH]
    gate = p[..., CONV_CH:CONV_CH + D_RNN]
    z = p[..., CONV_CH + D_RNN:CONV_CH + D_RNN + DN_VD]
    off = CONV_CH + D_RNN + DN_VD
    b_raw = p[..., off:off + DN_HEADS]
    a_raw = p[..., off + DN_HEADS:off + 2 * DN_HEADS]
    uc, new_buf = causal_dwconv(u, conv_buf, w_conv)
    xr = uc[..., :D_RNN] + b_conv
    h, hT = rglru(xr, is_first, h0, wa, ba, wx, bx, lam)
    rg_y = (h * jax.nn.gelu(gate.astype(jnp.float32))).astype(xn.dtype)
    qkv = jax.nn.silu(uc[..., D_RNN:])
    q = qkv[..., :DN_QK].reshape(B, T, DN_HEADS, DN_DK)
    k = qkv[..., DN_QK:2 * DN_QK].reshape(B, T, DN_HEADS, DN_DK)
    v = qkv[..., 2 * DN_QK:].reshape(B, T, DN_HEADS, DN_DV)
    beta = jax.nn.sigmoid(b_raw.astype(jnp.float32))
    g = -jnp.exp(a_log.astype(jnp.float32)) * jax.nn.softplus(a_raw.astype(jnp.float32) + dt_bias.astype(jnp.float32))
    o, S_T = gated_delta(q, k, v, g, beta, S0)
    o = rmsnorm(o, dn_w) * jax.nn.silu(z.astype(jnp.float32).reshape(B, T, DN_HEADS, DN_DV))
    dn_y = o.reshape(B, T, DN_VD).astype(xn.dtype)
    y = jnp.concatenate([rg_y, dn_y], axis=-1) @ w_out
    return y, new_buf, hT.astype(xn.dtype), S_T.astype(xn.dtype)


def att_project(xn, w_in):
    B, T, _ = xn.shape
    p = xn @ w_in
    o1 = ATT_HEADS * HEAD_DIM
    o2 = o1 + KV_HEADS * HEAD_DIM
    o3 = o2 + KV_HEADS * HEAD_DIM
    o4 = o3 + IDX_HEADS * IDX_DIM
    o5 = o4 + IDX_DIM
    q = p[..., :o1].reshape(B, T, ATT_HEADS, HEAD_DIM)
    k = p[..., o1:o2].reshape(B, T, KV_HEADS, HEAD_DIM)
    v = p[..., o2:o3].reshape(B, T, KV_HEADS, HEAD_DIM)
    qi = p[..., o3:o4].reshape(B, T, IDX_HEADS, IDX_DIM)
    ki = p[..., o4:o5]
    wi = p[..., o5:]
    return q, k, v, qi, ki, wi


def index_scores(qi, wi, ki):
    s = jax.nn.relu(jnp.einsum('bthd,bsd->bths', qi, ki).astype(jnp.float32))
    return jnp.einsum('bth,bths->bts', wi.astype(jnp.float32), s)


def sparse_attend(q, kg, vg, valid):
    B, T = q.shape[:2]
    qg = q.reshape(B, T, KV_HEADS, GROUP, HEAD_DIM)
    s = jnp.einsum('btkgd,btjkd->btkgj', qg, kg).astype(jnp.float32) * HEAD_DIM ** -0.5
    s = jnp.where(valid[:, :, None, None, :], s, -1e30)
    pr = jax.nn.softmax(s, axis=-1)
    o = jnp.einsum('btkgj,btjkd->btkgd', pr.astype(vg.dtype), vg)
    return o.reshape(B, T, ATT_HEADS * HEAD_DIM)


def dsa_prompt(xn, w_in, w_out):
    B, S, _ = xn.shape
    q, k, v, qi, ki, wi = att_project(xn, w_in)
    topk = min(TOPK_MAX, S // 4)
    qb = min(Q_BLOCK, S)
    nb = S // qb
    bidx = jnp.arange(B)[:, None, None]
    kpos = jnp.arange(S)

    def blocks(x):
        return jnp.moveaxis(x.reshape((B, nb, qb) + x.shape[2:]), 1, 0)

    def blk(args):
        q_b, qi_b, wi_b, bi = args
        tpos = bi * qb + jnp.arange(qb)
        sc = index_scores(qi_b, wi_b, ki)
        sc = jnp.where(kpos[None, None, :] <= tpos[None, :, None], sc, -jnp.inf)
        _, idx = lax.top_k(sc, topk)
        valid = idx <= tpos[None, :, None]
        return sparse_attend(q_b, k[bidx, idx], v[bidx, idx], valid)

    o = lax.map(blk, (blocks(q), blocks(qi), blocks(wi), jnp.arange(nb)))
    o = jnp.moveaxis(o, 0, 1).reshape(B, S, ATT_HEADS * HEAD_DIM)
    return o @ w_out, k, v, ki


def dsa_sample(xn, ck, cv, cki, page_table, w_in, w_out):
    DB, T, _ = xn.shape
    page = ck.shape[1]
    past = page_table.shape[1] * page
    L = past + T
    q, k, v, qi, ki, wi = att_project(xn, w_in)
    ki_past = cki[page_table].reshape(DB, past, IDX_DIM)
    ki_all = jnp.concatenate([ki_past, ki.astype(ki_past.dtype)], axis=1)
    tpos = past + jnp.arange(T)
    sc = index_scores(qi, wi, ki_all)
    sc = jnp.where(jnp.arange(L)[None, None, :] <= tpos[None, :, None], sc, -jnp.inf)
    _, idx = lax.top_k(sc, min(TOPK_MAX, L // 4))
    bidx = jnp.arange(DB)[:, None, None]
    pidx = jnp.minimum(idx, past - 1)
    phys = page_table[bidx, pidx // page] * page + pidx % page
    nidx = jnp.clip(idx - past, 0, T - 1)
    is_new = (idx >= past)[..., None, None]
    ck_rows = ck.reshape((-1,) + ck.shape[2:])
    cv_rows = cv.reshape((-1,) + cv.shape[2:])
    kg = jnp.where(is_new, k[bidx, nidx].astype(ck.dtype), ck_rows[phys])
    vg = jnp.where(is_new, v[bidx, nidx].astype(cv.dtype), cv_rows[phys])
    valid = idx <= tpos[None, :, None]
    o = sparse_attend(q, kg, vg, valid)
    return o @ w_out, k, v, ki


def setup_inputs(seed: int = 0) -> dict:
    key = jax.random.key(seed)
    ks = jax.random.split(key, 32)
    f32 = jnp.float32
    n_pages = PAST_LEN // PAGE_SIZE
    n_used = DEC_BATCH * n_pages
    n_pool = n_used + (n_used + 3) // 4

    def nrm(k, shape, s):
        return jax.random.normal(k, shape, f32) * s

    a0 = jax.random.uniform(ks[15], (N_REC, D_RNN), f32, 0.9, 0.999) ** (1.0 / RG_C)
    return {
        'x_prompt': nrm(ks[0], (BATCH, SEQ, D_MODEL), 1.0),
        'x_sample': nrm(ks[1], (DEC_BATCH, DEC_SEQ, D_MODEL), 1.0),
        'state_conv': nrm(ks[2], (N_REC, DEC_BATCH, CONV_W - 1, CONV_CH), 1.0),
        'state_h': nrm(ks[3], (N_REC, DEC_BATCH, D_RNN), 0.5),
        'state_S': nrm(ks[4], (N_REC, DEC_BATCH, DN_HEADS, DN_DK, DN_DV), DN_DK ** -0.5),
        'cache_k': nrm(ks[5], (N_ATT, n_pool, PAGE_SIZE, KV_HEADS, HEAD_DIM), 1.0),
        'cache_v': nrm(ks[6], (N_ATT, n_pool, PAGE_SIZE, KV_HEADS, HEAD_DIM), 1.0),
        'cache_kidx': nrm(ks[7], (N_ATT, n_pool, PAGE_SIZE, IDX_DIM), 1.0),
        'page_table': jax.random.permutation(ks[8], n_pool)[:n_used].reshape(DEC_BATCH, n_pages).astype(jnp.int32),
        'norm_mix': 1.0 + nrm(ks[9], (DEPTH, D_MODEL), 0.01),
        'norm_mlp': 1.0 + nrm(ks[10], (DEPTH, D_MODEL), 0.01),
        'norm_final': 1.0 + nrm(ks[11], (D_MODEL,), 0.01),
        'w_in_rec': nrm(ks[12], (N_REC, D_MODEL, REC_IN), D_MODEL ** -0.5),
        'w_conv': nrm(ks[13], (N_REC, CONV_W, CONV_CH), CONV_W ** -0.5),
        'b_conv': nrm(ks[14], (N_REC, D_RNN), 0.01),
        'rg_wa': nrm(ks[16], (N_REC, RG_HEADS, RG_BW, RG_BW), RG_BW ** -0.5),
        'rg_ba': nrm(ks[17], (N_REC, D_RNN), 0.01),
        'rg_wx': nrm(ks[18], (N_REC, RG_HEADS, RG_BW, RG_BW), RG_BW ** -0.5),
        'rg_bx': nrm(ks[19], (N_REC, D_RNN), 0.01),
        'rg_lambda': jnp.log(a0) - jnp.log1p(-a0),
        'dn_a_log': jnp.log(jax.random.uniform(ks[20], (N_REC, DN_HEADS), f32, 1.0, 16.0)),
        'dn_dt_bias': nrm(ks[21], (N_REC, DN_HEADS), 0.1),
        'dn_norm': 1.0 + nrm(ks[22], (N_REC, DN_DV), 0.01),
        'w_out_rec': nrm(ks[23], (N_REC, D_RNN + DN_VD, D_MODEL), (D_RNN + DN_VD) ** -0.5),
        'w_in_att': nrm(ks[24], (N_ATT, D_MODEL, ATT_IN), D_MODEL ** -0.5),
        'w_out_att': nrm(ks[25], (N_ATT, ATT_HEADS * HEAD_DIM, D_MODEL), (ATT_HEADS * HEAD_DIM) ** -0.5),
        'w_up': nrm(ks[26], (DEPTH, D_MODEL, D_FF), D_MODEL ** -0.5),
        'w_down': nrm(ks[27], (DEPTH, D_FF, D_MODEL), D_FF ** -0.5),
    }


def reference(x_prompt, x_sample, state_conv, state_h, state_S, cache_k, cache_v, cache_kidx, page_table,
              norm_mix, norm_mlp, norm_final, w_in_rec, w_conv, b_conv, rg_wa, rg_ba, rg_wx, rg_bx,
              rg_lambda, dn_a_log, dn_dt_bias, dn_norm, w_out_rec, w_in_att, w_out_att, w_up, w_down):
    B, S, _ = x_prompt.shape
    DB, T, _ = x_sample.shape
    past = page_table.shape[1] * cache_k.shape[2]
    first_p = jnp.arange(S) == 0
    first_s = (past + jnp.arange(T)) == 0
    dt = x_prompt.dtype
    xp, xs = x_prompt, x_sample
    conv_p, h_p, S_p, conv_s, h_s, S_s = [], [], [], [], [], []
    k_p, v_p, ki_p, k_s, v_s, ki_s = [], [], [], [], [], []
    for layer in range(DEPTH):
        hp = rmsnorm(xp, norm_mix[layer])
        hs = rmsnorm(xs, norm_mix[layer])
        if layer % 2 == 0:
            r = layer // 2
            prm = (w_in_rec[r], w_conv[r], b_conv[r], rg_wa[r], rg_ba[r], rg_wx[r], rg_bx[r], rg_lambda[r],
                   dn_a_log[r], dn_dt_bias[r], dn_norm[r], w_out_rec[r])
            yp, cb, hT, ST = rec_mixer(hp, jnp.zeros((B, CONV_W - 1, CONV_CH), dt), jnp.zeros((B, D_RNN), dt),
                                       jnp.zeros((B, DN_HEADS, DN_DK, DN_DV), dt), first_p, *prm)
            conv_p.append(cb); h_p.append(hT); S_p.append(ST)
            ys, cb, hT, ST = rec_mixer(hs, state_conv[r], state_h[r], state_S[r], first_s, *prm)
            conv_s.append(cb); h_s.append(hT); S_s.append(ST)
        else:
            a = layer // 2
            yp, kk, vv, kii = dsa_prompt(hp, w_in_att[a], w_out_att[a])
            k_p.append(kk); v_p.append(vv); ki_p.append(kii)
            ys, kk, vv, kii = dsa_sample(hs, cache_k[a], cache_v[a], cache_kidx[a], page_table, w_in_att[a], w_out_att[a])
            k_s.append(kk); v_s.append(vv); ki_s.append(kii)
        xp = xp + yp
        xs = xs + ys
        xp = xp + mlp(rmsnorm(xp, norm_mlp[layer]), w_up[layer], w_down[layer])
        xs = xs + mlp(rmsnorm(xs, norm_mlp[layer]), w_up[layer], w_down[layer])
    y_prompt = rmsnorm(xp, norm_final)
    y_sample = rmsnorm(xs, norm_final)
    return (y_prompt, y_sample,
            jnp.stack(conv_p), jnp.stack(h_p), jnp.stack(S_p),
            jnp.stack(k_p), jnp.stack(v_p), jnp.stack(ki_p),
            jnp.stack(conv_s), jnp.stack(h_s), jnp.stack(S_s),
            jnp.stack(k_s), jnp.stack(v_s), jnp.stack(ki_s))
```

```cpp
#ifndef HOST_TEST
#include <hip/hip_runtime.h>
#define HD __device__ __forceinline__
#define UNI(x) __builtin_amdgcn_readfirstlane(x)
#else
#include <cmath>
#include <cstddef>
#include <cstring>
#define HD static inline
#define UNI(x) (x)
#endif

#ifndef CFG_D_MODEL
#define CFG_D_MODEL 1024
#define CFG_BATCH 2
#define CFG_SEQ 8192
#define CFG_DEC_BATCH 32
#define CFG_PAST 8192
#endif
constexpr int D = CFG_D_MODEL, NB = CFG_BATCH, SEQ = CFG_SEQ, DEPTH = 4, DB = CFG_DEC_BATCH, DT = 4, PAST = CFG_PAST, PAGE = 128;
constexpr int N_REC = 2, N_ATT = 2, NPAGES = PAST / PAGE, NUSED = DB * NPAGES, NPOOL = NUSED + (NUSED + 3) / 4;
constexpr int D_RNN = D / 2, RG_HEADS = 8, RG_BW = D_RNN / RG_HEADS;
constexpr int DNH = 4, DNK = 128, DN_QK = 512, DN_VD = 512;
constexpr int CONV_CH = D_RNN + 2 * DN_QK + DN_VD, REC_IN = CONV_CH + D_RNN + DN_VD + 2 * DNH;
constexpr int OFF_GATE = CONV_CH, OFF_Z = CONV_CH + D_RNN, OFF_B = OFF_Z + DN_VD, OFF_A = OFF_B + DNH;
constexpr int AH = D / 128, KVH = 2, HDIM = 128, GROUP = AH / KVH, IH = 8, IDIM = 64;
constexpr int AO_K = AH * HDIM, AO_V = AO_K + KVH * HDIM, AO_QI = AO_V + KVH * HDIM, AO_KI = AO_QI + IH * IDIM, AO_WI = AO_KI + IDIM, ATT_IN = AO_WI + IH;
constexpr int D_FF = 4 * D;
constexpr int TOPK_P = (SEQ / 4 < 256) ? SEQ / 4 : 256, TOPK_S = ((PAST + DT) / 4 < 256) ? (PAST + DT) / 4 : 256, KMAX = 256;
constexpr int MP = NB * SEQ, MS = DB * DT, MT = MP + MS, MPAD = (MT + 255) / 256 * 256;
constexpr int REC_PAD = (REC_IN + 255) / 256 * 256, ATT_PAD = (ATT_IN + 255) / 256 * 256, LDP = REC_PAD > ATT_PAD ? REC_PAD : ATT_PAD;
constexpr int Y2W = D_RNN + DN_VD;
constexpr int SMAX = (PAST + DT > SEQ) ? PAST + DT : SEQ, MTP = (MT + 7) / 8 * 8;
constexpr float EPS = 1e-6f;
typedef unsigned short bf16;

constexpr size_t O_YP = 0, O_YS = O_YP + (size_t)MP * D, O_CONVP = O_YS + (size_t)MS * D, O_HP = O_CONVP + (size_t)N_REC * NB * 3 * CONV_CH,
    O_SP = O_HP + (size_t)N_REC * NB * D_RNN, O_KP = O_SP + (size_t)N_REC * NB * DNH * 128 * 128, O_VP = O_KP + (size_t)N_ATT * MP * KVH * HDIM,
    O_KIP = O_VP + (size_t)N_ATT * MP * KVH * HDIM, O_CONVS = O_KIP + (size_t)N_ATT * MP * IDIM, O_HS = O_CONVS + (size_t)N_REC * DB * 3 * CONV_CH,
    O_SS = O_HS + (size_t)N_REC * DB * D_RNN, O_KS = O_SS + (size_t)N_REC * DB * DNH * 128 * 128, O_VS = O_KS + (size_t)N_ATT * MS * KVH * HDIM,
    O_KIS = O_VS + (size_t)N_ATT * MS * KVH * HDIM, O_END = O_KIS + (size_t)N_ATT * MS * IDIM;

constexpr size_t al256(size_t x) { return (x + 255) / 256 * 256; }
constexpr size_t WS_CTL = 0, CTL_BYTES = 1u << 20;
constexpr size_t WS_WINR = CTL_BYTES, WS_WOUTR = WS_WINR + al256((size_t)N_REC * REC_PAD * D * 2), WS_WINA = WS_WOUTR + al256((size_t)N_REC * D * Y2W * 2),
    WS_WOUTA = WS_WINA + al256((size_t)N_ATT * ATT_PAD * D * 2), WS_WUP = WS_WOUTA + al256((size_t)N_ATT * D * D * 2), WS_WDN = WS_WUP + al256((size_t)DEPTH * D_FF * D * 2),
    WS_X = WS_WDN + al256((size_t)DEPTH * D * D_FF * 2), WS_XN = WS_X + al256((size_t)MPAD * D * 4), WS_P = WS_XN + al256((size_t)MPAD * D * 2),
    WS_H = WS_P + al256((size_t)MPAD * LDP * 4), WS_Y2 = WS_H + al256((size_t)MPAD * D_FF * 2), WS_XR = WS_Y2 + al256((size_t)MPAD * D * 2),
    WS_QKV = WS_XR + al256((size_t)MT * D_RNN * 4), WS_RA = WS_QKV + al256((size_t)MT * 1536 * 4), WS_RB = WS_RA + al256((size_t)MT * D_RNN * 4),
    WS_HH = WS_RB + al256((size_t)MT * D_RNN * 4), WS_QN = WS_HH + al256((size_t)MT * D_RNN * 4), WS_KN = WS_QN + al256((size_t)MT * 512 * 4),
    WS_GB = WS_KN + al256((size_t)MT * 512 * 4), WS_ODN = WS_GB + al256((size_t)MT * 8 * 4), WS_SCT = WS_ODN + al256((size_t)MT * 512 * 4),
    WS_IDX = WS_SCT + al256((size_t)SMAX * MTP * 4), WS_NSEL = WS_IDX + al256((size_t)MT * KMAX * 4), WS_SCR = WS_NSEL + al256((size_t)MT * 4),
    WS_END = WS_SCR + al256((size_t)MT * AH * KMAX * 4);

struct Args { const float* in[28]; float* out; unsigned char* ws; int ph_lo, ph_hi; };
enum { I_XP = 0, I_XS, I_SCONV, I_SH, I_SS, I_CK, I_CV, I_CKI, I_PT, I_NMIX, I_NMLP, I_NFIN, I_WINR, I_WCONV, I_BCONV, I_WA, I_BA, I_WX, I_BX, I_LAM, I_ALOG, I_DTB, I_DNW,
       I_WOUTR, I_WINA, I_WOUTA, I_WUP, I_WDN };

HD bf16 f2bf(float f) { unsigned u; memcpy(&u, &f, 4); u += 0x7FFFu + ((u >> 16) & 1u); return (bf16)(u >> 16); }
HD float bf2f(bf16 b) { unsigned u = ((unsigned)b) << 16; float f; memcpy(&f, &u, 4); return f; }
HD float sigmoidf_(float x) { return 1.0f / (1.0f + expf(-x)); }
HD float softplusf_(float x) { return x > 20.f ? x : (x < -20.f ? expf(x) : log1pf(expf(x))); }
HD float siluf_(float x) { return x * sigmoidf_(x); }
HD float gelu_tanhf_(float x) { return 0.5f * x * (1.0f + tanhf(0.7978845608028654f * (x + 0.044715f * x * x * x))); }
HD unsigned fkey(float f) { f = f + 0.0f; unsigned u; memcpy(&u, &f, 4); return (u & 0x80000000u) ? ~u : (u | 0x80000000u); }
struct RowInfo { int seq, t, T, row0; bool sample; };
HD RowInfo row_info(int m) { RowInfo r; if (m < MP) { r.seq = m / SEQ; r.t = m % SEQ; r.T = SEQ; r.row0 = r.seq * SEQ; r.sample = false; }
    else { const int q = m - MP; r.seq = NB + q / DT; r.t = q % DT; r.T = DT; r.row0 = MP + (q / DT) * DT; r.sample = true; } return r; }

HD void ph_copy_x(const Args& a, size_t gtid, size_t gsz) {
    float* X = (float*)(a.ws + WS_X);
    for (size_t i = gtid; i < (size_t)MPAD * D; i += gsz) { const size_t m = i / D; X[i] = m < (size_t)MP ? a.in[I_XP][i] : (m < (size_t)MT ? a.in[I_XS][i - (size_t)MP * D] : 0.f); }
}
HD void wprep_one(const float* w, bf16* wt, int K, int N, int NP, size_t gtid, size_t gsz) {
    const size_t k8n = (size_t)K / 8;
    for (size_t i = gtid; i < (size_t)NP * k8n; i += gsz) { const int n = (int)(i % NP); const size_t k0 = (i / NP) * 8;
        for (int j = 0; j < 8; ++j) wt[(size_t)n * K + k0 + j] = n < N ? f2bf(w[(k0 + j) * (size_t)N + n]) : (bf16)0; }
}
HD void ph_wprep(const Args& a, size_t gtid, size_t gsz) {
    for (int r = 0; r < N_REC; ++r) { wprep_one(a.in[I_WINR] + (size_t)r * D * REC_IN, (bf16*)(a.ws + WS_WINR) + (size_t)r * REC_PAD * D, D, REC_IN, REC_PAD, gtid, gsz);
        wprep_one(a.in[I_WOUTR] + (size_t)r * Y2W * D, (bf16*)(a.ws + WS_WOUTR) + (size_t)r * D * Y2W, Y2W, D, D, gtid, gsz); }
    for (int r = 0; r < N_ATT; ++r) { wprep_one(a.in[I_WINA] + (size_t)r * D * ATT_IN, (bf16*)(a.ws + WS_WINA) + (size_t)r * ATT_PAD * D, D, ATT_IN, ATT_PAD, gtid, gsz);
        wprep_one(a.in[I_WOUTA] + (size_t)r * D * D, (bf16*)(a.ws + WS_WOUTA) + (size_t)r * D * D, D, D, D, gtid, gsz); }
    for (int l = 0; l < DEPTH; ++l) { wprep_one(a.in[I_WUP] + (size_t)l * D * D_FF, (bf16*)(a.ws + WS_WUP) + (size_t)l * D_FF * D, D, D_FF, D_FF, gtid, gsz);
        wprep_one(a.in[I_WDN] + (size_t)l * D_FF * D, (bf16*)(a.ws + WS_WDN) + (size_t)l * D * D_FF, D_FF, D, D, gtid, gsz); }
}
HD void ph_conv(const Args& a, int r, size_t gtid, size_t gsz) {
    const float* P = (const float*)(a.ws + WS_P); float* XR = (float*)(a.ws + WS_XR); float* QKV = (float*)(a.ws + WS_QKV);
    const float* wc = a.in[I_WCONV] + (size_t)r * 4 * CONV_CH; const float* bc = a.in[I_BCONV] + (size_t)r * D_RNN;
    for (size_t i = gtid; i < (size_t)MT * CONV_CH; i += gsz) { const int m = (int)(i / CONV_CH), c = (int)(i % CONV_CH); const RowInfo ri = row_info(m);
        float acc = 0.f;
        for (int k = 0; k < 4; ++k) { const int tau = ri.t - 3 + k; float xv;
            if (tau >= 0) xv = P[(size_t)(ri.row0 + tau) * LDP + c];
            else xv = ri.sample ? a.in[I_SCONV][(((size_t)r * DB + (ri.seq - NB)) * 3 + (3 + tau)) * CONV_CH + c] : 0.f;
            acc += xv * wc[(size_t)k * CONV_CH + c]; }
        if (c < D_RNN) XR[(size_t)m * D_RNN + c] = acc + bc[c]; else QKV[(size_t)m * 1536 + (c - D_RNN)] = siluf_(acc);
        const float uraw = P[(size_t)m * LDP + c];
        if (!ri.sample) { if (ri.t >= SEQ - 3) a.out[O_CONVP + (((size_t)r * NB + ri.seq) * 3 + (ri.t - (SEQ - 3))) * CONV_CH + c] = uraw; }
        else { if (ri.t >= DT - 3) a.out[O_CONVS + (((size_t)r * DB + (ri.seq - NB)) * 3 + (ri.t - (DT - 3))) * CONV_CH + c] = uraw; }
    }
}
HD void ph_rg_gates(const Args& a, int r, size_t gtid, size_t gsz) {
    const float* XR = (const float*)(a.ws + WS_XR); float* RA = (float*)(a.ws + WS_RA); float* RB = (float*)(a.ws + WS_RB);
    const float* wa = a.in[I_WA] + (size_t)r * RG_HEADS * RG_BW * RG_BW; const float* wx = a.in[I_WX] + (size_t)r * RG_HEADS * RG_BW * RG_BW;
    for (size_t i = gtid; i < (size_t)MT * D_RNN; i += gsz) { const int m = (int)(i / D_RNN), j = (int)(i % D_RNN), hd = j / RG_BW, jj = j % RG_BW; const RowInfo ri = row_info(m);
        float pr = 0.f, pi = 0.f; const float* xrow = XR + (size_t)m * D_RNN + hd * RG_BW;
        for (int k = 0; k < RG_BW; ++k) { const float xv = xrow[k]; pr += xv * wa[((size_t)hd * RG_BW + k) * RG_BW + jj]; pi += xv * wx[((size_t)hd * RG_BW + k) * RG_BW + jj]; }
        const float rg = sigmoidf_(pr + a.in[I_BA][(size_t)r * D_RNN + j]), ig = sigmoidf_(pi + a.in[I_BX][(size_t)r * D_RNN + j]);
        const float log_a = -8.0f * rg * softplusf_(-a.in[I_LAM][(size_t)r * D_RNN + j]); const float av = expf(log_a);
        const bool first = (!ri.sample) && ri.t == 0;
        const float mult = first ? 1.0f : sqrtf(fmaxf(1.0f - expf(2.0f * log_a), 0.0f));
        float bv = XR[(size_t)m * D_RNN + j] * ig * mult;
        if (ri.t == 0 && ri.sample) bv += av * a.in[I_SH][((size_t)r * DB + (ri.seq - NB)) * D_RNN + j];
        RA[i] = av; RB[i] = bv; }
}
HD void ph_rg_scan(const Args& a, int r, size_t gtid, size_t gsz) {
    const float* RA = (const float*)(a.ws + WS_RA); const float* RB = (const float*)(a.ws + WS_RB); float* HH = (float*)(a.ws + WS_HH);
    for (size_t i = gtid; i < (size_t)(NB + DB) * D_RNN; i += gsz) { const int seq = (int)(i / D_RNN), j = (int)(i % D_RNN);
        const int row0 = seq < NB ? seq * SEQ : MP + (seq - NB) * DT, T = seq < NB ? SEQ : DT; float h = 0.f;
        for (int t = 0; t < T; ++t) { const size_t o = (size_t)(row0 + t) * D_RNN + j; h = RA[o] * h + RB[o]; HH[o] = h; }
        if (seq < NB) a.out[O_HP + ((size_t)r * NB + seq) * D_RNN + j] = h; else a.out[O_HS + ((size_t)r * DB + (seq - NB)) * D_RNN + j] = h; }
}
HD void ph_dn_prep(const Args& a, int r, size_t gtid, size_t gsz) {
    const float* P = (const float*)(a.ws + WS_P); const float* QKV = (const float*)(a.ws + WS_QKV); float* QN = (float*)(a.ws + WS_QN); float* KN = (float*)(a.ws + WS_KN); float* GB = (float*)(a.ws + WS_GB);
    for (size_t i = gtid; i < (size_t)MT * DNH; i += gsz) { const int m = (int)(i / DNH), hd = (int)(i % DNH);
        const float* q = QKV + (size_t)m * 1536 + hd * 128; const float* k = q + 512; float sq = 0.f, sk = 0.f;
        for (int d = 0; d < 128; ++d) { sq += q[d] * q[d]; sk += k[d] * k[d]; }
        const float rq = 1.0f / sqrtf(sq + EPS) * 0.08838834764831845f, rk = 1.0f / sqrtf(sk + EPS);
        for (int d = 0; d < 128; ++d) { QN[(size_t)m * 512 + hd * 128 + d] = q[d] * rq; KN[(size_t)m * 512 + hd * 128 + d] = k[d] * rk; }
        const float beta = sigmoidf_(P[(size_t)m * LDP + OFF_B + hd]);
        const float g = -expf(a.in[I_ALOG][r * DNH + hd]) * softplusf_(P[(size_t)m * LDP + OFF_A + hd] + a.in[I_DTB][r * DNH + hd]);
        GB[(size_t)m * 8 + hd * 2] = expf(g); GB[(size_t)m * 8 + hd * 2 + 1] = beta; }
}
#ifndef HOST_TEST
#define DN_FENCE() asm volatile("" ::: "memory")
#else
#define DN_FENCE() do { } while (0)
#endif
HD void ph_dn_seq(const Args& a, int r, size_t gtid, size_t gsz) {
    const float* QKV = (const float*)(a.ws + WS_QKV); const float* QN = (const float*)(a.ws + WS_QN); const float* KN = (const float*)(a.ws + WS_KN); const float* GB = (const float*)(a.ws + WS_GB);
    float* ODN = (float*)(a.ws + WS_ODN);
    for (size_t i = gtid; i < (size_t)(NB + DB) * DNH * 128; i += gsz) { const int v = (int)(i % 128), sh = UNI((int)(i / 128)), hd = sh % DNH, seq = sh / DNH;
        const int row0 = seq < NB ? seq * SEQ : MP + (seq - NB) * DT, T = seq < NB ? SEQ : DT;
        float S[128];
        if (seq < NB) {
#pragma unroll
            for (int d = 0; d < 128; ++d) S[d] = 0.f; }
        else { const float* s0 = a.in[I_SS] + ((((size_t)r * DB + (seq - NB)) * DNH + hd) * 128) * 128 + v;
#pragma unroll
            for (int d = 0; d < 128; ++d) S[d] = s0[(size_t)d * 128]; }
        for (int t = 0; t < T; ++t) { const size_t m = (size_t)(row0 + t);
            const float* kk = KN + m * 512 + hd * 128; const float* qq = QN + m * 512 + hd * 128;
            const float eg = GB[m * 8 + hd * 2], beta = GB[m * 8 + hd * 2 + 1], vv = QKV[m * 1536 + 1024 + hd * 128 + v];
            float ks = 0.f;
#pragma unroll
            for (int c = 0; c < 8; ++c) {
#pragma unroll
                for (int d = c * 16; d < c * 16 + 16; ++d) ks += kk[d] * S[d];
                DN_FENCE(); }
            const float cc = beta * (vv - eg * ks); float o = 0.f;
#pragma unroll
            for (int c = 0; c < 8; ++c) {
#pragma unroll
                for (int d = c * 16; d < c * 16 + 16; ++d) { S[d] = eg * S[d] + kk[d] * cc; o += qq[d] * S[d]; }
                DN_FENCE(); }
            ODN[m * 512 + hd * 128 + v] = o; }
        float* so = seq < NB ? a.out + O_SP + ((((size_t)r * NB + seq) * DNH + hd) * 128) * 128 + v : a.out + O_SS + ((((size_t)r * DB + (seq - NB)) * DNH + hd) * 128) * 128 + v;
#pragma unroll
        for (int d = 0; d < 128; ++d) so[(size_t)d * 128] = S[d]; }
}
HD void ph_rec_out(const Args& a, int r, size_t gtid, size_t gsz) {
    const float* P = (const float*)(a.ws + WS_P); const float* HH = (const float*)(a.ws + WS_HH); const float* ODN = (const float*)(a.ws + WS_ODN); bf16* Y2 = (bf16*)(a.ws + WS_Y2);
    for (size_t i = gtid; i < (size_t)MT * Y2W; i += gsz) { const int m = (int)(i / Y2W), c = (int)(i % Y2W); float y;
        if (c < D_RNN) y = HH[(size_t)m * D_RNN + c] * gelu_tanhf_(P[(size_t)m * LDP + OFF_GATE + c]);
        else { const int cc = c - D_RNN, hd = cc / 128, vv = cc % 128; const float* o = ODN + (size_t)m * 512 + hd * 128; float ss = 0.f;
            for (int d = 0; d < 128; ++d) ss += o[d] * o[d];
            y = o[vv] / sqrtf(ss * (1.0f / 128.0f) + EPS) * a.in[I_DNW][r * 128 + vv] * siluf_(P[(size_t)m * LDP + OFF_Z + cc]); }
        Y2[i] = f2bf(y); }
}
HD void ph_att_split(const Args& a, int ai, size_t gtid, size_t gsz) {
    const float* P = (const float*)(a.ws + WS_P); constexpr int W = 2 * KVH * HDIM + IDIM;
    for (size_t i = gtid; i < (size_t)MT * W; i += gsz) { const int m = (int)(i / W), c = (int)(i % W);
        if (m < MP) { if (c < 256) a.out[O_KP + ((size_t)ai * MP + m) * 256 + c] = P[(size_t)m * LDP + AO_K + c];
            else if (c < 512) a.out[O_VP + ((size_t)ai * MP + m) * 256 + (c - 256)] = P[(size_t)m * LDP + AO_V + (c - 256)];
            else a.out[O_KIP + ((size_t)ai * MP + m) * 64 + (c - 512)] = P[(size_t)m * LDP + AO_KI + (c - 512)]; }
        else { const int ms = m - MP; if (c < 256) a.out[O_KS + ((size_t)ai * MS + ms) * 256 + c] = P[(size_t)m * LDP + AO_K + c];
            else if (c < 512) a.out[O_VS + ((size_t)ai * MS + ms) * 256 + (c - 256)] = P[(size_t)m * LDP + AO_V + (c - 256)];
            else a.out[O_KIS + ((size_t)ai * MS + ms) * 64 + (c - 512)] = P[(size_t)m * LDP + AO_KI + (c - 512)]; } }
}
HD const float* ki_row_sample(const Args& a, int ai, int db, int s) {
    if (s < PAST) { const int pg = ((const int*)a.in[I_PT])[db * NPAGES + s / PAGE]; return a.in[I_CKI] + (((size_t)ai * NPOOL + pg) * PAGE + s % PAGE) * IDIM; }
    return (const float*)(a.ws + WS_P) + (size_t)(MP + db * DT + (s - PAST)) * LDP + AO_KI;
}
HD void ph_idx_scores(const Args& a, int ai, size_t gtid, size_t gsz) {
    const float* P = (const float*)(a.ws + WS_P); float* SCT = (float*)(a.ws + WS_SCT);
    const int lane = (int)(gtid & 63); const size_t w = gtid >> 6, nw = gsz >> 6;
    constexpr int TM = 8, NKB = (SEQ + 63) / 64, NMT = SEQ / TM, NKBS = (PAST + DT + 63) / 64;
    const size_t n_p = (size_t)NB * NMT * NKB, n_s = (size_t)DB * NKBS;
    for (size_t it0 = w; it0 < n_p + n_s; it0 += nw) { const size_t it = (size_t)UNI((int)it0);
        int mrow0, nrows, s, smax_valid; const float* kr;
        if (it < n_p) { const int b = (int)(it / ((size_t)NMT * NKB)), rr = (int)(it % ((size_t)NMT * NKB)), mt = rr / NKB, kb = rr % NKB;
            if (kb * 64 > mt * TM + TM - 1) continue;
            mrow0 = b * SEQ + mt * TM; nrows = TM; s = kb * 64 + lane; smax_valid = SEQ; kr = P + (size_t)(b * SEQ + (s < SEQ ? s : 0)) * LDP + AO_KI; }
        else { const int q = (int)(it - n_p), db = q / NKBS, kb = q % NKBS; mrow0 = MP + db * DT; nrows = DT; s = kb * 64 + lane; smax_valid = PAST + DT; kr = ki_row_sample(a, ai, db, s < PAST + DT ? s : 0); }
        float kv[IDIM];
#pragma unroll
        for (int d = 0; d < IDIM; ++d) kv[d] = kr[d];
        for (int i = 0; i < nrows; ++i) { const int m = mrow0 + i; const float* qi = P + (size_t)m * LDP + AO_QI; const float* wi = P + (size_t)m * LDP + AO_WI; float sc = 0.f;
            for (int h = 0; h < IH; ++h) { float dot = 0.f;
#pragma unroll
                for (int d = 0; d < IDIM; ++d) dot += qi[h * IDIM + d] * kv[d];
                sc += wi[h] * fmaxf(dot, 0.f); }
            if (s < smax_valid) SCT[(size_t)s * MTP + m] = sc; } }
}
HD void ph_select(const Args& a, size_t gtid, size_t gsz) {
    const float* SCT = (const float*)(a.ws + WS_SCT); int* IDX = (int*)(a.ws + WS_IDX); int* NSEL = (int*)(a.ws + WS_NSEL);
    for (size_t m = gtid; m < (size_t)MT; m += gsz) { const RowInfo ri = row_info((int)m);
        const int n = ri.sample ? PAST + ri.t + 1 : ri.t + 1, K = ri.sample ? TOPK_S : TOPK_P; const float* col = SCT + m; int* out = IDX + m * KMAX;
        if (n <= K) { for (int j = 0; j < n; ++j) out[j] = j; NSEL[m] = n; continue; }
        unsigned lo = 0u;
        for (int bit = 31; bit >= 0; --bit) { const unsigned cand = lo | (1u << bit); int c = 0;
            for (int s = 0; s < n; ++s) c += (fkey(col[(size_t)s * MTP]) >= cand) ? 1 : 0;
            if (c >= K) lo = cand; }
        int cnt = 0;
        for (int s = 0; s < n; ++s) if (fkey(col[(size_t)s * MTP]) > lo) out[cnt++] = s;
        for (int s = 0; s < n && cnt < K; ++s) if (fkey(col[(size_t)s * MTP]) == lo) out[cnt++] = s;
        NSEL[m] = K; }
}
HD const float* kv_row(const Args& a, int ai, const RowInfo& ri, int idx, int kvh, bool isv) {
    const float* P = (const float*)(a.ws + WS_P); const int off = (isv ? AO_V : AO_K) + kvh * HDIM;
    if (!ri.sample) return P + (size_t)(ri.row0 + idx) * LDP + off;
    const int db = ri.seq - NB;
    if (idx >= PAST) return P + (size_t)(MP + db * DT + (idx - PAST)) * LDP + off;
    const int pg = ((const int*)a.in[I_PT])[db * NPAGES + idx / PAGE];
    return a.in[isv ? I_CV : I_CK] + ((((size_t)ai * NPOOL + pg) * PAGE + idx % PAGE) * KVH + kvh) * HDIM;
}
HD void ph_sp_scores(const Args& a, int ai, size_t gtid, size_t gsz) {
    const float* P = (const float*)(a.ws + WS_P); const int* IDX = (const int*)(a.ws + WS_IDX); const int* NSEL = (const int*)(a.ws + WS_NSEL); float* SCR = (float*)(a.ws + WS_SCR);
    for (size_t i = gtid; i < (size_t)MT * AH * KMAX; i += gsz) { const int j = (int)(i % KMAX), h = (int)((i / KMAX) % AH), m = (int)(i / ((size_t)KMAX * AH));
        if (j >= NSEL[m]) { SCR[i] = -1e30f; continue; }
        const RowInfo ri = row_info(m); const float* kr = kv_row(a, ai, ri, IDX[(size_t)m * KMAX + j], h / GROUP, false); const float* q = P + (size_t)m * LDP + h * HDIM; float dot = 0.f;
        for (int d = 0; d < HDIM; ++d) dot += q[d] * kr[d];
        SCR[i] = dot * 0.08838834764831845f; }
}
HD void ph_sp_out(const Args& a, int ai, size_t gtid, size_t gsz) {
    const int* IDX = (const int*)(a.ws + WS_IDX); const int* NSEL = (const int*)(a.ws + WS_NSEL); const float* SCR = (const float*)(a.ws + WS_SCR); bf16* O = (bf16*)(a.ws + WS_Y2);
    for (size_t i = gtid; i < (size_t)MT * AH * HDIM; i += gsz) { const int d = (int)(i % HDIM), h = (int)((i / HDIM) % AH), m = (int)(i / ((size_t)HDIM * AH));
        const int ns = NSEL[m]; const float* sc = SCR + ((size_t)m * AH + h) * KMAX; const RowInfo ri = row_info(m);
        float mx = -3e38f; for (int j = 0; j < ns; ++j) mx = fmaxf(mx, sc[j]);
        float sum = 0.f, acc = 0.f;
        for (int j = 0; j < ns; ++j) { const float p = expf(sc[j] - mx); sum += p; acc += p * kv_row(a, ai, ri, IDX[(size_t)m * KMAX + j], h / GROUP, true)[d]; }
        O[(size_t)m * D + h * HDIM + d] = f2bf(acc / sum); }
}
#ifndef HOST_TEST
#define LAS __attribute__((address_space(3)))
#define XB_TMO      128
#define XB_XCNT(j)  (256  + 64 * (j))
#define XB_XSUB(j)  (1280 + 64 * (j))
#define XB_XGEN(j)  (2304 + 64 * (j))
#define XB_TOP      3328
#define XB_TOPGEN   3392
#define XCD_BAR_WORDS 3456
#define XB_SPIN_CAP (1u << 18)

__device__ __forceinline__ unsigned xb_ld(unsigned* p)              { return __hip_atomic_load(p, __ATOMIC_RELAXED, __HIP_MEMORY_SCOPE_AGENT); }
__device__ __forceinline__ unsigned xb_add(unsigned* p, unsigned v) { return __hip_atomic_fetch_add(p, v, __ATOMIC_RELAXED, __HIP_MEMORY_SCOPE_AGENT); }
__device__ __forceinline__ unsigned xb_xcc_id() { return (unsigned)__builtin_amdgcn_s_getreg((3 << 11) | 20) & 0xFu; }
#define XB_SPIN(cond, bar) do { unsigned _sp = 0; while (cond) { __builtin_amdgcn_s_sleep(1); \
    if ((++_sp & 255u) == 0u) { if (xb_ld(&(bar)[XB_TMO])) break; if (_sp > XB_SPIN_CAP) { atomicAdd(&(bar)[XB_TMO], 1u); break; } } } } while (0)

struct XcdBarrier {
    unsigned* bar; unsigned x;
    volatile LAS unsigned* st;
};

__device__ __forceinline__ XcdBarrier xcd_barrier_post(unsigned* bar, volatile LAS unsigned* st) {
    XcdBarrier b; b.bar = bar; b.x = xb_xcc_id(); b.st = st;
    if (threadIdx.x == 0) (void)xb_add(&bar[XB_XCNT(b.x)], 1u);
    return b;
}
__device__ __forceinline__ void xcd_barrier_complete(unsigned* bar, unsigned x, unsigned& nloc, unsigned& nx) {
    const unsigned G = gridDim.x * gridDim.y * gridDim.z;
    unsigned sum, cnt, mine, sp = 0u;
    for (;;) {
        sum = 0u; cnt = 0u; mine = 0u;
#pragma unroll
        for (unsigned j = 0; j < 16; ++j) { const unsigned c = xb_ld(&bar[XB_XCNT(j)]); sum += c; cnt += (c > 0u) ? 1u : 0u; mine = (j == x) ? c : mine; }
        if (sum == G) break;
        __builtin_amdgcn_s_sleep(1);
        if ((++sp & 255u) == 0u) { if (xb_ld(&bar[XB_TMO])) break; if (sp > XB_SPIN_CAP) { atomicAdd(&bar[XB_TMO], 1u); break; } }
    }
    nloc = mine > 0u ? mine : 1u; nx = cnt > 0u ? cnt : 1u;
}

__device__ __forceinline__ void xcd_barrier(const XcdBarrier& b) {
    asm volatile("s_waitcnt vmcnt(0)" ::: "memory");
    __syncthreads();
    if (threadIdx.x == 0) {
        unsigned* bar = b.bar;
        __builtin_amdgcn_s_waitcnt(0);
        unsigned nloc = b.st[0], nx = b.st[1];
        if (nloc == 0u) { xcd_barrier_complete(bar, b.x, nloc, nx); b.st[0] = nloc; b.st[1] = nx; }
        const unsigned old = xb_add(&bar[XB_XSUB(b.x)], 1u);
        const unsigned gen = old / nloc;
        if (old + 1u == (gen + 1u) * nloc) {
            __builtin_amdgcn_fence(__ATOMIC_RELEASE, "agent");
            asm volatile("s_waitcnt vmcnt(0)" ::: "memory");
            const unsigned og = xb_add(&bar[XB_TOP], 1u);
            const unsigned tg = og / nx;
            if (og + 1u == (tg + 1u) * nx) xb_add(&bar[XB_TOPGEN], 1u);
            else XB_SPIN(xb_ld(&bar[XB_TOPGEN]) == tg, bar);
            __builtin_amdgcn_fence(__ATOMIC_ACQUIRE, "agent");
            xb_add(&bar[XB_XGEN(b.x)], 1u);
            asm volatile("s_waitcnt vmcnt(0)" ::: "memory");
        } else {
            XB_SPIN(xb_ld(&bar[XB_XGEN(b.x)]) == gen, bar);
            __builtin_amdgcn_fence(__ATOMIC_ACQUIRE, "agent");
            asm volatile("s_waitcnt vmcnt(0)" ::: "memory");
        }
    }
    __syncthreads();
}

namespace pg8 {
#define PG8_LAS __attribute__((address_space(3)))
typedef unsigned short bf16_t;
typedef short bf16x8 __attribute__((ext_vector_type(8)));
typedef float f32x4 __attribute__((ext_vector_type(4)));
typedef unsigned u32x4 __attribute__((ext_vector_type(4)));
constexpr int BM = 256, BK = 64, HALF = 128, HTB = HALF * BK * 2  , STAGE_BYTES = 8 * HTB, NXCD = 8, WGM = 8;

__host__ __device__ __forceinline__ int lds_byte(int r, int c) { const int st = (r >> 4) * 2 + (c >> 5), rr = r & 15, cc = c & 31, ob = rr * 64 + cc * 2; return st * 1024 + (ob ^ (((ob >> 9) & 1) << 5)); }
__host__ __device__ __forceinline__ void stage_rc(int b, int& R, int& C) { const int st = b / 1024, sb = b % 1024, swz = sb ^ (((sb >> 9) & 1) << 5); R = (st >> 1) * 16 + swz / 64; C = (st & 1) * 32 + (swz % 64) / 2; }
__host__ __device__ __forceinline__ int perm32(int rho) { const int n = rho >> 4, i = rho & 15; return 8 * (i >> 2) + 4 * n + (i & 3); }

struct Unit { int pm, pn; };
struct Gemm { const bf16_t* A; const bf16_t* Bt; int M, N, K; };

struct StaticOrder {
    int nM, nN, nwg, G, c;
    __host__ __device__ void init(int M, int N, int G_, int c_) { nM = M / BM; nN = N / BM; nwg = nM * nN; G = G_; c = c_; }
    __host__ __device__ bool next(int i, Unit& u) const {
        const long L = (long)i * G + c; if (L >= nwg) return false;
        int wgid = (int)L; { const int q = nwg / NXCD, r = nwg % NXCD, xcd = wgid % NXCD, off = wgid / NXCD; wgid = (xcd < r ? xcd * (q + 1) : r * (q + 1) + (xcd - r) * q) + off; }
        const int nig = WGM * nN, gid = wgid / nig, fm = gid * WGM, gsz = (nM - fm) < WGM ? (nM - fm) : WGM;
        u.pm = fm + ((wgid % nig) % gsz); u.pn = (wgid % nig) / gsz; return true;
    }
    __device__ __forceinline__ void a_ready(const Unit&) const {}
    __device__ __forceinline__ void done(const Unit&) const {}
};

__device__ __forceinline__ unsigned cvt_pk_bf16(float lo, float hi) { unsigned r; asm volatile("v_cvt_pk_bf16_f32 %0, %1, %2" : "=v"(r) : "v"(lo), "v"(hi)); return r; }
struct EpiF32 {
    static constexpr bool PERM = false, AFTER_DRAIN = false;
    float* C; int ldc; const float* bias;
    __device__ __forceinline__ void operator()(const f32x4 (&acc)[2][2][4][2], const Unit& u, int wr, int wc, int fr, int fq) const {
        const int row0 = u.pm * BM + wr * 64 + fr, col0 = u.pn * BM + wc * 32 + 4 * fq;
        f32x4 bv[2][2];
#pragma unroll
        for (int bj = 0; bj < 2; ++bj)
#pragma unroll
            for (int n = 0; n < 2; ++n) bv[bj][n] = bias ? *(const f32x4*)(bias + col0 + bj * HALF + n * 16) : (f32x4){0.f, 0.f, 0.f, 0.f};
#pragma unroll
        for (int ai = 0; ai < 2; ++ai)
#pragma unroll
            for (int m = 0; m < 4; ++m) { float* rowp = C + (size_t)(row0 + ai * HALF + m * 16) * ldc + col0;
#pragma unroll
                for (int bj = 0; bj < 2; ++bj)
#pragma unroll
                    for (int n = 0; n < 2; ++n) *(f32x4*)(rowp + bj * HALF + n * 16) = acc[ai][bj][m][n] + bv[bj][n]; }
    }
};
template <class Epi, class Sched, bool STAMP = false>
__device__ __forceinline__ void gemm_phase(PG8_LAS unsigned char* lds, const Gemm g, const Sched& S, const Epi& E, unsigned long long* stamps) {
    int tid_ = threadIdx.x; asm volatile("" : "+v"(tid_));
    const int tid = tid_, wid = __builtin_amdgcn_readfirstlane(tid >> 6), lane = tid & 63, wr = wid >> 2, wc = wid & 3, fr = lane & 15, fq = lane >> 4;
    const int K = g.K, nt = K / BK;
    int ts_lo = 0, ts_hi = 0, nts = 0; const unsigned long long rt_entry = STAMP ? (unsigned long long)wall_clock64() : 0ull;
#define PG8_STAMP() do { if (STAMP && wid == 0 && nts < 64) { const unsigned long long _c = (unsigned long long)clock64(); \
        ts_lo = (lane == nts) ? (int)(unsigned)_c : ts_lo; ts_hi = (lane == nts) ? (int)(unsigned)(_c >> 32) : ts_hi; ++nts; } } while (0)
    PG8_STAMP();
    unsigned voffA[2], voffB[2];
#pragma unroll
    for (int i = 0; i < 2; ++i) { int R, C; stage_rc(tid * 16 + i * 8192, R, C); const int Rb = Epi::PERM ? ((R & ~31) + perm32(R & 31)) : R;
        voffA[i] = (unsigned)(R * K + C) * 2u; voffB[i] = (unsigned)(Rb * K + C) * 2u; }
    const size_t kstep = (size_t)(BK * 2);
    const size_t hstep = (size_t)HALF * K * 2;
    const size_t tstep = 2 * hstep;
    const unsigned ldsw = (unsigned)wid * 1024u;
    const int aoff = lds_byte(wr * 64 + fr, fq * 8), boff = lds_byte(wc * 32 + fr, fq * 8);
#define PG8_SA(b, h) (((b) * 2 + (h)) * HTB)
#define PG8_SB(b, h) ((4 + (b) * 2 + (h)) * HTB)
#define PG8_STAGE(bufoff, gbase, voff) do { _Pragma("unroll") for (int _i = 0; _i < 2; ++_i) \
        __builtin_amdgcn_global_load_lds((const unsigned*)((const char*)(gbase) + (voff)[_i]), (PG8_LAS unsigned*)(lds + (bufoff) + ldsw + _i * 8192), 16, 0, 0); } while (0)
#define PG8_LDA(dst, b, h) do { _Pragma("unroll") for (int m = 0; m < 4; ++m) _Pragma("unroll") for (int k = 0; k < 2; ++k) dst[m][k] = *(const PG8_LAS bf16x8*)(lds + PG8_SA(b, h) + aoff + m * 2048 + k * 1024); } while (0)
#define PG8_LDB(dst, b, h) do { _Pragma("unroll") for (int n = 0; n < 2; ++n) _Pragma("unroll") for (int k = 0; k < 2; ++k) dst[n][k] = *(const PG8_LAS bf16x8*)(lds + PG8_SB(b, h) + boff + n * 2048 + k * 1024); } while (0)
#define PG8_MMA(ai, bj, At, Bt) do { __builtin_amdgcn_s_setprio(1); _Pragma("unroll") for (int m = 0; m < 4; ++m) _Pragma("unroll") for (int n = 0; n < 2; ++n) _Pragma("unroll") for (int k = 0; k < 2; ++k) \
        acc[ai][bj][m][n] = __builtin_amdgcn_mfma_f32_16x16x32_bf16(Bt[n][k], At[m][k], acc[ai][bj][m][n], 0, 0, 0); __builtin_amdgcn_s_setprio(0); } while (0)
#define PG8_WAIT_V(n) asm volatile("s_waitcnt vmcnt(" #n ")" ::: "memory")
#define PG8_WAIT_L(n) asm volatile("s_waitcnt lgkmcnt(" #n ")" ::: "memory")
#define PG8_BAR __builtin_amdgcn_s_barrier()
#define PG8_SCHED __builtin_amdgcn_sched_barrier(0)
    Unit cur, nxt; int ui = 0;
    if (!S.next(0, cur)) return;
    f32x4 acc[2][2][4][2];
#pragma unroll
    for (int a = 0; a < 2; ++a)
#pragma unroll
        for (int b = 0; b < 2; ++b)
#pragma unroll
            for (int m = 0; m < 4; ++m)
#pragma unroll
                for (int n = 0; n < 2; ++n) acc[a][b][m][n] = (f32x4){0.f, 0.f, 0.f, 0.f};
    bf16x8 At[4][2], B0[2][2], B1[2][2];
    const char* cA = (const char*)g.A + (size_t)cur.pm * tstep; const char* cB = (const char*)g.Bt + (size_t)cur.pn * tstep;
    S.a_ready(cur);
    PG8_STAGE(PG8_SB(0, 0), cB, voffB); PG8_STAGE(PG8_SA(0, 0), cA, voffA); PG8_STAGE(PG8_SB(0, 1), cB + hstep, voffB); PG8_STAGE(PG8_SA(0, 1), cA + hstep, voffA);
    if (wr == 1) PG8_BAR;
    PG8_WAIT_V(4); PG8_BAR;
    PG8_STAGE(PG8_SB(1, 0), cB + kstep, voffB); PG8_STAGE(PG8_SA(1, 0), cA + kstep, voffA); PG8_STAGE(PG8_SB(1, 1), cB + hstep + kstep, voffB);
    PG8_WAIT_V(6); PG8_BAR;
    PG8_STAMP();
    for (;;) {
        const bool has_next = S.next(ui + 1, nxt);
        const char* nA = has_next ? (const char*)g.A + (size_t)nxt.pm * tstep : cA; const char* nB = has_next ? (const char*)g.Bt + (size_t)nxt.pn * tstep : cB;
        for (int t = 0; t < nt; t += 2) {
            const bool last = (t == nt - 2);
            const char* a1 = cA + (size_t)(t + 1) * kstep;
            const char* a2 = last ? nA : cA + (size_t)(t + 2) * kstep; const char* b2 = last ? nB : cB + (size_t)(t + 2) * kstep;
            const char* a3 = a2 + kstep; const char* b3 = b2 + kstep;
            if (last && has_next) S.a_ready(nxt);
            PG8_LDB(B0, 0, 0); PG8_SCHED; PG8_LDA(At, 0, 0); PG8_STAGE(PG8_SA(1, 1), a1 + hstep, voffA);
            PG8_WAIT_L(8); PG8_BAR; PG8_WAIT_L(0); PG8_MMA(0, 0, At, B0); PG8_BAR; PG8_SCHED;
            PG8_LDB(B1, 0, 1); PG8_STAGE(PG8_SB(0, 0), b2, voffB);
            PG8_BAR; PG8_WAIT_L(0); PG8_MMA(0, 1, At, B1); PG8_BAR;
            PG8_LDA(At, 0, 1); PG8_STAGE(PG8_SA(0, 0), a2, voffA);
            PG8_BAR; PG8_WAIT_L(0); PG8_MMA(1, 0, At, B0); PG8_BAR; PG8_SCHED;
            PG8_STAGE(PG8_SB(0, 1), b2 + hstep, voffB);
            PG8_WAIT_V(6); PG8_BAR; PG8_MMA(1, 1, At, B1); PG8_BAR;
            PG8_LDB(B0, 1, 0); PG8_SCHED; PG8_LDA(At, 1, 0); PG8_STAGE(PG8_SA(0, 1), a2 + hstep, voffA);
            PG8_WAIT_L(8); PG8_BAR; PG8_WAIT_L(0); PG8_MMA(0, 0, At, B0); PG8_BAR; PG8_SCHED;
            PG8_LDB(B1, 1, 1); PG8_STAGE(PG8_SB(1, 0), b3, voffB);
            PG8_BAR; PG8_WAIT_L(0); PG8_MMA(0, 1, At, B1); PG8_BAR;
            PG8_LDA(At, 1, 1); PG8_STAGE(PG8_SA(1, 0), a3, voffA);
            PG8_BAR; PG8_WAIT_L(0); PG8_MMA(1, 0, At, B0); PG8_BAR; PG8_SCHED;
            PG8_STAGE(PG8_SB(1, 1), b3 + hstep, voffB);
            PG8_WAIT_V(6); PG8_BAR; PG8_MMA(1, 1, At, B1); PG8_BAR;
        }
        PG8_STAMP();
        if constexpr (!Epi::AFTER_DRAIN) { E(acc, cur, wr, wc, fr, fq); S.done(cur); }
        PG8_STAMP();
        if (!has_next) break;
#pragma unroll
        for (int a = 0; a < 2; ++a)
#pragma unroll
            for (int b = 0; b < 2; ++b)
#pragma unroll
                for (int m = 0; m < 4; ++m)
#pragma unroll
                    for (int n = 0; n < 2; ++n) acc[a][b][m][n] = (f32x4){0.f, 0.f, 0.f, 0.f};
        cur = nxt; cA = nA; cB = nB; ++ui;
    }
    PG8_WAIT_V(0);
    if (wr == 0) PG8_BAR;
    PG8_BAR;
    if constexpr (Epi::AFTER_DRAIN) { E.fused(acc, cur, wr, wc, fr, fq, lds, wid, lane); S.done(cur); }
    PG8_STAMP();
    if (STAMP && wid == 0) { stamps[lane] = lane < nts ? (((unsigned long long)(unsigned)ts_hi << 32) | (unsigned)ts_lo) : 0ull;
        if (lane == 62) stamps[62] = rt_entry; if (lane == 63) stamps[63] = (unsigned long long)wall_clock64(); }
#undef PG8_STAMP
#undef PG8_SA
#undef PG8_SB
#undef PG8_STAGE
#undef PG8_LDA
#undef PG8_LDB
#undef PG8_MMA
#undef PG8_WAIT_V
#undef PG8_WAIT_L
#undef PG8_BAR
#undef PG8_SCHED
}
}
#endif

#ifndef HOST_TEST
#include <cstdio>
namespace pg8 {
struct EpiAddF32 {
    static constexpr bool PERM = false, AFTER_DRAIN = false;
    float* C; int ldc;
    __device__ __forceinline__ void operator()(const f32x4 (&acc)[2][2][4][2], const Unit& u, int wr, int wc, int fr, int fq) const {
        const int row0 = u.pm * BM + wr * 64 + fr, col0 = u.pn * BM + wc * 32 + 4 * fq;
#pragma unroll
        for (int ai = 0; ai < 2; ++ai)
#pragma unroll
            for (int m = 0; m < 4; ++m) { float* rowp = C + (size_t)(row0 + ai * HALF + m * 16) * ldc + col0;
#pragma unroll
                for (int bj = 0; bj < 2; ++bj)
#pragma unroll
                    for (int n = 0; n < 2; ++n) { f32x4* p = (f32x4*)(rowp + bj * HALF + n * 16); *p = *p + acc[ai][bj][m][n]; } }
    }
};
struct EpiRelu2Bf16 {
    static constexpr bool PERM = true, AFTER_DRAIN = false;
    bf16_t* O; int ldc;
    __device__ __forceinline__ void operator()(const f32x4 (&acc)[2][2][4][2], const Unit& u, int wr, int wc, int fr, int fq) const {
        const int row0 = u.pm * BM + wr * 64 + fr, col0 = u.pn * BM + wc * 32 + 8 * fq;
#pragma unroll
        for (int ai = 0; ai < 2; ++ai)
#pragma unroll
            for (int m = 0; m < 4; ++m) { bf16_t* rowp = O + (size_t)(row0 + ai * HALF + m * 16) * ldc + col0;
#pragma unroll
                for (int bj = 0; bj < 2; ++bj) { f32x4 v0 = acc[ai][bj][m][0], v1 = acc[ai][bj][m][1];
#pragma unroll
                    for (int j = 0; j < 4; ++j) { const float r0 = fmaxf(v0[j], 0.f), r1 = fmaxf(v1[j], 0.f); v0[j] = r0 * r0; v1[j] = r1 * r1; }
                    u32x4 w; w.x = cvt_pk_bf16(v0[0], v0[1]); w.y = cvt_pk_bf16(v0[2], v0[3]); w.z = cvt_pk_bf16(v1[0], v1[1]); w.w = cvt_pk_bf16(v1[2], v1[3]);
                    *(u32x4*)(rowp + bj * HALF) = w; } }
    }
};
}

typedef float f32x4_t __attribute__((ext_vector_type(4)));
__device__ __forceinline__ void ph_rmsnorm(const Args& a, const float* g) {
    static_assert(D == 1024, "device rmsnorm is written for D = 1024");
    const float* X = (const float*)(a.ws + WS_X); bf16* XN = (bf16*)(a.ws + WS_XN);
    const int lane = threadIdx.x & 63, wv = blockIdx.x * (blockDim.x >> 6) + (threadIdx.x >> 6), nwv = gridDim.x * (blockDim.x >> 6);
    f32x4_t gv[4];
#pragma unroll
    for (int i = 0; i < 4; ++i) gv[i] = *(const f32x4_t*)(g + (i * 64 + lane) * 4);
    for (int m = wv; m < MPAD; m += nwv) { f32x4_t xv[4]; float ss = 0.f;
#pragma unroll
        for (int i = 0; i < 4; ++i) { xv[i] = *(const f32x4_t*)(X + (size_t)m * D + (i * 64 + lane) * 4); ss += xv[i][0] * xv[i][0] + xv[i][1] * xv[i][1] + xv[i][2] * xv[i][2] + xv[i][3] * xv[i][3]; }
#pragma unroll
        for (int o = 32; o >= 1; o >>= 1) ss += __shfl_xor(ss, o);
        const float r = 1.0f / sqrtf(ss * (1.0f / D) + EPS);
#pragma unroll
        for (int i = 0; i < 4; ++i) { const f32x4_t y = xv[i] * r * gv[i]; uint2 w; w.x = pg8::cvt_pk_bf16(y[0], y[1]); w.y = pg8::cvt_pk_bf16(y[2], y[3]); *(uint2*)(XN + (size_t)m * D + (i * 64 + lane) * 4) = w; } }
}
__device__ __forceinline__ void ph_final(const Args& a) {
    const float* X = (const float*)(a.ws + WS_X); const float* g = a.in[I_NFIN];
    const int lane = threadIdx.x & 63, wv = blockIdx.x * (blockDim.x >> 6) + (threadIdx.x >> 6), nwv = gridDim.x * (blockDim.x >> 6);
    f32x4_t gv[4];
#pragma unroll
    for (int i = 0; i < 4; ++i) gv[i] = *(const f32x4_t*)(g + (i * 64 + lane) * 4);
    for (int m = wv; m < MT; m += nwv) { f32x4_t xv[4]; float ss = 0.f;
#pragma unroll
        for (int i = 0; i < 4; ++i) { xv[i] = *(const f32x4_t*)(X + (size_t)m * D + (i * 64 + lane) * 4); ss += xv[i][0] * xv[i][0] + xv[i][1] * xv[i][1] + xv[i][2] * xv[i][2] + xv[i][3] * xv[i][3]; }
#pragma unroll
        for (int o = 32; o >= 1; o >>= 1) ss += __shfl_xor(ss, o);
        const float r = 1.0f / sqrtf(ss * (1.0f / D) + EPS);
        float* orow = a.out + (m < MP ? O_YP + (size_t)m * D : O_YS + (size_t)(m - MP) * D);
#pragma unroll
        for (int i = 0; i < 4; ++i) *(f32x4_t*)(orow + (i * 64 + lane) * 4) = xv[i] * r * gv[i]; }
}

constexpr int NTHREADS = 512, LDS_BYTES = 147456, LDS_MISC = 131072;
constexpr int PH_PER_LAYER = 12, PH_LAYER0 = 2, PH_FINAL = PH_LAYER0 + DEPTH * PH_PER_LAYER, N_PHASES = PH_FINAL + 1;
#ifndef MK_SINGLE
#define MK_SINGLE 0
#endif
__global__ void __launch_bounds__(NTHREADS, 2) mega(Args a) {
    extern __shared__ __attribute__((aligned(16))) unsigned char lds[];
    LAS unsigned char* L = (LAS unsigned char*)lds;
    const size_t gsz = (size_t)gridDim.x * NTHREADS;
#define GT() ([&]() -> size_t { unsigned tx_ = threadIdx.x; asm volatile("" : "+v"(tx_)); return (size_t)blockIdx.x * NTHREADS + tx_; }())
    const int lo = a.ph_lo, hi = a.ph_hi;
#if MK_SINGLE
    if (threadIdx.x < 4) ((LAS unsigned*)(L + LDS_MISC))[threadIdx.x] = 0u;
    __syncthreads();
    XcdBarrier bar = xcd_barrier_post((unsigned*)(a.ws + WS_CTL) + 4096, (volatile LAS unsigned*)(L + LDS_MISC));
#define SEAM(k) do { if ((k) + 1 < hi) xcd_barrier(bar); } while (0)
#else
#define SEAM(k) do { } while (0)
#endif
#define IN(k) (lo <= (k) && (k) < hi)
    bf16* XN = (bf16*)(a.ws + WS_XN); float* X = (float*)(a.ws + WS_X); float* P = (float*)(a.ws + WS_P); bf16* H = (bf16*)(a.ws + WS_H); bf16* Y2 = (bf16*)(a.ws + WS_Y2);
    if (IN(0)) { ph_copy_x(a, GT(), gsz); SEAM(0); }
    if (IN(1)) { ph_wprep(a, GT(), gsz); SEAM(1); }
    for (int l = 0; l < DEPTH; ++l) {
        const int pb = PH_LAYER0 + l * PH_PER_LAYER, r = l >> 1;
        if (IN(pb + 0)) { ph_rmsnorm(a, a.in[I_NMIX] + (size_t)l * D); SEAM(pb + 0); }
        if ((l & 1) == 0) {
            if (IN(pb + 1)) { pg8::Gemm g{XN, (const bf16*)(a.ws + WS_WINR) + (size_t)r * REC_PAD * D, MPAD, REC_PAD, D}; pg8::StaticOrder S; S.init(MPAD, REC_PAD, gridDim.x, blockIdx.x);
                pg8::EpiF32 E{P, LDP, nullptr}; pg8::gemm_phase<pg8::EpiF32, pg8::StaticOrder, false>(L, g, S, E, nullptr); SEAM(pb + 1); }
            if (IN(pb + 2)) { ph_conv(a, r, GT(), gsz); SEAM(pb + 2); }
            if (IN(pb + 3)) { ph_rg_gates(a, r, GT(), gsz); SEAM(pb + 3); }
            if (IN(pb + 4)) { ph_rg_scan(a, r, GT(), gsz); SEAM(pb + 4); }
            if (IN(pb + 5)) { ph_dn_prep(a, r, GT(), gsz); SEAM(pb + 5); }
            if (IN(pb + 6)) { ph_dn_seq(a, r, GT(), gsz); SEAM(pb + 6); }
            if (IN(pb + 7)) { ph_rec_out(a, r, GT(), gsz); SEAM(pb + 7); }
            if (IN(pb + 8)) { pg8::Gemm g{Y2, (const bf16*)(a.ws + WS_WOUTR) + (size_t)r * D * Y2W, MPAD, D, Y2W}; pg8::StaticOrder S; S.init(MPAD, D, gridDim.x, blockIdx.x);
                pg8::EpiAddF32 E{X, D}; pg8::gemm_phase<pg8::EpiAddF32, pg8::StaticOrder, false>(L, g, S, E, nullptr); SEAM(pb + 8); }
        } else {
            if (IN(pb + 1)) { pg8::Gemm g{XN, (const bf16*)(a.ws + WS_WINA) + (size_t)r * ATT_PAD * D, MPAD, ATT_PAD, D}; pg8::StaticOrder S; S.init(MPAD, ATT_PAD, gridDim.x, blockIdx.x);
                pg8::EpiF32 E{P, LDP, nullptr}; pg8::gemm_phase<pg8::EpiF32, pg8::StaticOrder, false>(L, g, S, E, nullptr); SEAM(pb + 1); }
            if (IN(pb + 2)) { ph_att_split(a, r, GT(), gsz); SEAM(pb + 2); }
            if (IN(pb + 3)) { ph_idx_scores(a, r, GT(), gsz); SEAM(pb + 3); }
            if (IN(pb + 4)) { ph_select(a, GT(), gsz); SEAM(pb + 4); }
            if (IN(pb + 5)) { ph_sp_scores(a, r, GT(), gsz); SEAM(pb + 5); }
            if (IN(pb + 6)) { ph_sp_out(a, r, GT(), gsz); SEAM(pb + 6); }
            if (IN(pb + 8)) { pg8::Gemm g{Y2, (const bf16*)(a.ws + WS_WOUTA) + (size_t)r * D * D, MPAD, D, D}; pg8::StaticOrder S; S.init(MPAD, D, gridDim.x, blockIdx.x);
                pg8::EpiAddF32 E{X, D}; pg8::gemm_phase<pg8::EpiAddF32, pg8::StaticOrder, false>(L, g, S, E, nullptr); SEAM(pb + 8); }
        }
        if (IN(pb + 9)) { ph_rmsnorm(a, a.in[I_NMLP] + (size_t)l * D); SEAM(pb + 9); }
        if (IN(pb + 10)) { pg8::Gemm g{XN, (const bf16*)(a.ws + WS_WUP) + (size_t)l * D_FF * D, MPAD, D_FF, D}; pg8::StaticOrder S; S.init(MPAD, D_FF, gridDim.x, blockIdx.x);
            pg8::EpiRelu2Bf16 E{H, D_FF}; pg8::gemm_phase<pg8::EpiRelu2Bf16, pg8::StaticOrder, false>(L, g, S, E, nullptr); SEAM(pb + 10); }
        if (IN(pb + 11)) { pg8::Gemm g{H, (const bf16*)(a.ws + WS_WDN) + (size_t)l * D * D_FF, MPAD, D, D_FF}; pg8::StaticOrder S; S.init(MPAD, D, gridDim.x, blockIdx.x);
            pg8::EpiAddF32 E{X, D}; pg8::gemm_phase<pg8::EpiAddF32, pg8::StaticOrder, false>(L, g, S, E, nullptr); SEAM(pb + 11); }
    }
    if (IN(PH_FINAL)) ph_final(a);
}

extern "C" void kernel_launch(void* const* d_in, const int* in_sizes, int n_in, void* d_out, int out_size, void* d_ws, size_t ws_size, hipStream_t stream) {
    static int grid = 0;
    if (grid == 0) {
        if (n_in != 28 || (size_t)out_size != (size_t)O_END || ws_size < WS_END) { fprintf(stderr, "kernel_launch: unexpected shapes n_in %d out %d (want %zu) ws %zu (want %zu)\n", n_in, out_size, (size_t)O_END, ws_size, (size_t)WS_END); grid = -1; return; }
        int dev = 0, cus = 0;
        if (hipGetDevice(&dev) != hipSuccess || hipDeviceGetAttribute(&cus, hipDeviceAttributeMultiprocessorCount, dev) != hipSuccess) { grid = -1; return; }
        if (hipFuncSetAttribute((const void*)mega, hipFuncAttributeMaxDynamicSharedMemorySize, LDS_BYTES) != hipSuccess) { fprintf(stderr, "kernel_launch: hipFuncSetAttribute failed\n"); grid = -1; return; }
        int per_cu = 0; (void)hipOccupancyMaxActiveBlocksPerMultiprocessor(&per_cu, (const void*)mega, NTHREADS, LDS_BYTES); (void)hipGetLastError();
        if (per_cu < 1) fprintf(stderr, "kernel_launch: occupancy query says %d blocks per CU\n", per_cu);
        grid = cus;
    }
    if (grid < 0) return;
    (void)hipMemsetAsync((char*)d_ws + WS_CTL, 0, CTL_BYTES, stream);
    Args a{};
    for (int i = 0; i < 28; ++i) a.in[i] = (const float*)d_in[i];
    a.out = (float*)d_out; a.ws = (unsigned char*)d_ws;
#if MK_SINGLE
    a.ph_lo = 0; a.ph_hi = N_PHASES;
    hipLaunchKernelGGL(mega, dim3(grid), dim3(NTHREADS), LDS_BYTES, stream, a);
#else
    for (int ph = 0; ph < N_PHASES; ++ph) { const int k = ph - PH_LAYER0; if (k >= 0 && ph < PH_FINAL && ((k / PH_PER_LAYER) & 1) == 1 && (k % PH_PER_LAYER) == 7) continue;
        a.ph_lo = ph; a.ph_hi = ph + 1; hipLaunchKernelGGL(mega, dim3(grid), dim3(NTHREADS), LDS_BYTES, stream, a); }
#endif
}
#endif
```

```cpp
#ifndef HOST_TEST
#include <hip/hip_runtime.h>
#define HD __device__ __forceinline__
#define UNI(x) __builtin_amdgcn_readfirstlane(x)
#else
#include <cmath>
#include <cstddef>
#include <cstring>
#define HD static inline
#define UNI(x) (x)
#endif

#ifndef CFG_D_MODEL
#define CFG_D_MODEL 1024
#define CFG_BATCH 2
#define CFG_SEQ 8192
#define CFG_DEC_BATCH 32
#define CFG_PAST 8192
#endif
constexpr int D = CFG_D_MODEL, NB = CFG_BATCH, SEQ = CFG_SEQ, DEPTH = 4, DB = CFG_DEC_BATCH, DT = 4, PAST = CFG_PAST, PAGE = 128;
constexpr int N_REC = 2, N_ATT = 2, NPAGES = PAST / PAGE, NUSED = DB * NPAGES, NPOOL = NUSED + (NUSED + 3) / 4;
constexpr int D_RNN = D / 2, RG_HEADS = 8, RG_BW = D_RNN / RG_HEADS;
constexpr int DNH = 4, DNK = 128, DN_QK = 512, DN_VD = 512;
constexpr int CONV_CH = D_RNN + 2 * DN_QK + DN_VD, REC_IN = CONV_CH + D_RNN + DN_VD + 2 * DNH;
constexpr int OFF_GATE = CONV_CH, OFF_Z = CONV_CH + D_RNN, OFF_B = OFF_Z + DN_VD, OFF_A = OFF_B + DNH;
constexpr int AH = D / 128, KVH = 2, HDIM = 128, GROUP = AH / KVH, IH = 8, IDIM = 64;
constexpr int AO_K = AH * HDIM, AO_V = AO_K + KVH * HDIM, AO_QI = AO_V + KVH * HDIM, AO_KI = AO_QI + IH * IDIM, AO_WI = AO_KI + IDIM, ATT_IN = AO_WI + IH;
constexpr int D_FF = 4 * D;
constexpr int TOPK_P = (SEQ / 4 < 256) ? SEQ / 4 : 256, TOPK_S = ((PAST + DT) / 4 < 256) ? (PAST + DT) / 4 : 256, KMAX = 256, KROW = 320;
constexpr int MP = NB * SEQ, MS = DB * DT, MT = MP + MS, MPAD = (MT + 255) / 256 * 256;
constexpr int REC_PAD = (REC_IN + 255) / 256 * 256, ATT_PAD = (ATT_IN + 255) / 256 * 256, LDP = REC_PAD > ATT_PAD ? REC_PAD : ATT_PAD;
constexpr int Y2W = D_RNN + DN_VD;
constexpr int SMAX = (PAST + DT > SEQ) ? PAST + DT : SEQ, SLD = (SMAX + 63) / 64 * 64;
constexpr int NC = SEQ / 64, NCU = NB * DNH * NC;
constexpr float EPS = 1e-6f;
typedef unsigned short bf16;

constexpr size_t O_YP = 0, O_YS = O_YP + (size_t)MP * D, O_CONVP = O_YS + (size_t)MS * D, O_HP = O_CONVP + (size_t)N_REC * NB * 3 * CONV_CH,
    O_SP = O_HP + (size_t)N_REC * NB * D_RNN, O_KP = O_SP + (size_t)N_REC * NB * DNH * 128 * 128, O_VP = O_KP + (size_t)N_ATT * MP * KVH * HDIM,
    O_KIP = O_VP + (size_t)N_ATT * MP * KVH * HDIM, O_CONVS = O_KIP + (size_t)N_ATT * MP * IDIM, O_HS = O_CONVS + (size_t)N_REC * DB * 3 * CONV_CH,
    O_SS = O_HS + (size_t)N_REC * DB * D_RNN, O_KS = O_SS + (size_t)N_REC * DB * DNH * 128 * 128, O_VS = O_KS + (size_t)N_ATT * MS * KVH * HDIM,
    O_KIS = O_VS + (size_t)N_ATT * MS * KVH * HDIM, O_END = O_KIS + (size_t)N_ATT * MS * IDIM;

constexpr size_t al256(size_t x) { return (x + 255) / 256 * 256; }
constexpr size_t WS_CTL = 0, CTL_BYTES = 4u << 20;
constexpr size_t WS_WINR = CTL_BYTES, WS_WOUTR = WS_WINR + al256((size_t)N_REC * REC_PAD * D * 2), WS_WINA = WS_WOUTR + al256((size_t)N_REC * D * Y2W * 2),
    WS_WOUTA = WS_WINA + al256((size_t)N_ATT * ATT_PAD * D * 2), WS_WUP = WS_WOUTA + al256((size_t)N_ATT * D * D * 2), WS_WDN = WS_WUP + al256((size_t)DEPTH * D_FF * D * 2),
    WS_X = WS_WDN + al256((size_t)DEPTH * D * D_FF * 2), WS_XN = WS_X + al256((size_t)MPAD * D * 4), WS_P = WS_XN + al256((size_t)MPAD * D * 2),
    WS_H = WS_P + al256((size_t)MPAD * LDP * 4), WS_Y2 = WS_H + al256((size_t)MPAD * D_FF * 2), WS_XR = WS_Y2 + al256((size_t)MPAD * D * 2),
    WS_QKV = WS_XR + al256((size_t)MT * D_RNN * 4), WS_RA = WS_QKV + al256((size_t)MT * 1536 * 4), WS_RB = WS_RA + al256((size_t)MT * D_RNN * 4),
    WS_HH = WS_RB + al256((size_t)MT * D_RNN * 4), WS_QN = WS_HH + al256((size_t)MT * D_RNN * 4), WS_KN = WS_QN + al256((size_t)MT * 512 * 4),
    WS_GB = WS_KN + al256((size_t)MT * 512 * 4), WS_ODN = WS_GB + al256((size_t)MT * 16 * 4), WS_SCT = WS_ODN + al256((size_t)MT * 512 * 4),
    WS_IDX = WS_SCT + al256((size_t)MT * SLD * 4), WS_NSEL = WS_IDX + al256((size_t)MT * KROW * 4), WS_SCR = WS_NSEL + al256((size_t)MT * 4),
    WS_CARRY = WS_SCR + al256((size_t)MT * AH * KMAX * 4), WS_L = WS_CARRY + al256((size_t)NB * NC * D_RNN * 4), WS_AT = WS_L + al256((size_t)NCU * 4096 * 4),
    WS_UT = WS_AT + al256((size_t)NCU * 4096 * 2), WS_WN = WS_UT + al256((size_t)NCU * 8192 * 4), WS_QG = WS_WN + al256((size_t)NCU * 8192 * 2),
    WS_KDT = WS_QG + al256((size_t)NCU * 8192 * 2), WS_GL = WS_KDT + al256((size_t)NCU * 8192 * 2), WS_KNT = WS_GL + al256((size_t)NCU * 4), WS_END = WS_KNT + al256((size_t)NCU * 8192 * 4);

constexpr size_t WS_KB = WS_H, WS_VB = WS_KB + al256((size_t)MT * 256 * 2), WS_QIB = WS_VB + al256((size_t)MT * 256 * 2), WS_KIB = WS_QIB + al256((size_t)MT * 512 * 2);
constexpr size_t WS_QB = WS_KIB + al256((size_t)MT * 64 * 2);
static_assert(WS_QB + (size_t)MT * D * 2 <= WS_Y2, "bf16 attention copies must fit inside the H buffer");
#ifdef HOST_TEST
struct Args { const float* in[28]; float* out; unsigned char* ws; int ph_lo, ph_hi; };
#else
struct KArgs { const float* in[28]; float* out; unsigned char* ws; int ph_lo, ph_hi; };
struct Args { const float* const* in; float* out; unsigned char* ws; };
constexpr size_t WS_TAB = 65536;
constexpr size_t WS_SS = 1u << 20;
static_assert(WS_SS + (size_t)9 * MPAD * 8 <= CTL_BYTES, "norm statistics inside the memset region");
constexpr size_t WS_END2 = WS_END;
#endif
enum { I_XP = 0, I_XS, I_SCONV, I_SH, I_SS, I_CK, I_CV, I_CKI, I_PT, I_NMIX, I_NMLP, I_NFIN, I_WINR, I_WCONV, I_BCONV, I_WA, I_BA, I_WX, I_BX, I_LAM, I_ALOG, I_DTB, I_DNW,
       I_WOUTR, I_WINA, I_WOUTA, I_WUP, I_WDN };

HD bf16 f2bf(float f) { unsigned u; memcpy(&u, &f, 4); u += 0x7FFFu + ((u >> 16) & 1u); return (bf16)(u >> 16); }
HD float bf2f(bf16 b) { unsigned u = ((unsigned)b) << 16; float f; memcpy(&f, &u, 4); return f; }
#ifndef HOST_TEST
#define FEXP(x) __expf(x)
#define FLOG(x) __logf(x)
#define FRCP(x) __builtin_amdgcn_rcpf(x)
#define FSQRT(x) __builtin_amdgcn_sqrtf(x)
#define FRSQ(x) __builtin_amdgcn_rsqf(x)
#else
#define FEXP(x) expf(x)
#define FLOG(x) logf(x)
#define FRCP(x) (1.0f / (x))
#define FSQRT(x) sqrtf(x)
#define FRSQ(x) (1.0f / sqrtf(x))
#endif
HD float sigmoidf_(float x) { return FRCP(1.0f + FEXP(-x)); }
HD float softplusf_(float x) { return x > 20.f ? x : FLOG(1.0f + FEXP(x)); }
HD float siluf_(float x) { return x * sigmoidf_(x); }
HD float gelu_tanhf_(float x) { const float u = 0.7978845608028654f * (x + 0.044715f * x * x * x); const float th = 1.0f - 2.0f * FRCP(1.0f + FEXP(2.0f * u)); return 0.5f * x * (1.0f + th); }
HD unsigned fkey(float f) { f = f + 0.0f; unsigned u; memcpy(&u, &f, 4); return (u & 0x80000000u) ? ~u : (u | 0x80000000u); }
struct RowInfo { int seq, t, T, row0; bool sample; };
HD RowInfo row_info(int m) { RowInfo r; if (m < MP) { r.seq = m / SEQ; r.t = m % SEQ; r.T = SEQ; r.row0 = r.seq * SEQ; r.sample = false; }
    else { const int q = m - MP; r.seq = NB + q / DT; r.t = q % DT; r.T = DT; r.row0 = MP + (q / DT) * DT; r.sample = true; } return r; }

HD void ph_copy_x(const Args& a, size_t gtid, size_t gsz) {
    float* X = (float*)(a.ws + WS_X);
    for (size_t i = gtid; i < (size_t)MPAD * D; i += gsz) { const size_t m = i / D; X[i] = m < (size_t)MP ? a.in[I_XP][i] : (m < (size_t)MT ? a.in[I_XS][i - (size_t)MP * D] : 0.f); }
}
HD void wprep_one(const float* w, bf16* wt, int K, int N, int NP, const float* gamma, size_t gtid, size_t gsz) {
    const size_t k32n = (size_t)K / 32;
    for (size_t i = gtid; i < (size_t)NP * k32n; i += gsz) { const int n = (int)(i % NP); const size_t k0 = (i / NP) * 32; bf16 tmp[32];
#ifndef HOST_TEST
#pragma unroll
#endif
        for (int j = 0; j < 32; ++j) tmp[j] = n < N ? f2bf(w[(k0 + j) * (size_t)N + n] * (gamma ? gamma[k0 + j] : 1.0f)) : (bf16)0;
#ifndef HOST_TEST
#pragma unroll
#endif
        for (int j = 0; j < 32; ++j) wt[(size_t)n * K + k0 + j] = tmp[j]; }
}
HD void ph_wprep(const Args& a, bool fold, int part, size_t gtid, size_t gsz) {
    for (int r = 0; r < N_REC; ++r) { if (part == 2 || (part == 0) == (r == 0)) wprep_one(a.in[I_WINR] + (size_t)r * D * REC_IN, (bf16*)(a.ws + WS_WINR) + (size_t)r * REC_PAD * D, D, REC_IN, REC_PAD, fold ? a.in[I_NMIX] + (size_t)(2 * r) * D : nullptr, gtid, gsz);
        if (part != 0) wprep_one(a.in[I_WOUTR] + (size_t)r * Y2W * D, (bf16*)(a.ws + WS_WOUTR) + (size_t)r * D * Y2W, Y2W, D, D, nullptr, gtid, gsz); }
    if (part == 0) return;
    for (int r = 0; r < N_ATT; ++r) { wprep_one(a.in[I_WINA] + (size_t)r * D * ATT_IN, (bf16*)(a.ws + WS_WINA) + (size_t)r * ATT_PAD * D, D, ATT_IN, ATT_PAD, fold ? a.in[I_NMIX] + (size_t)(2 * r + 1) * D : nullptr, gtid, gsz);
        wprep_one(a.in[I_WOUTA] + (size_t)r * D * D, (bf16*)(a.ws + WS_WOUTA) + (size_t)r * D * D, D, D, D, nullptr, gtid, gsz); }
    for (int l = 0; l < DEPTH; ++l) { wprep_one(a.in[I_WUP] + (size_t)l * D * D_FF, (bf16*)(a.ws + WS_WUP) + (size_t)l * D_FF * D, D, D_FF, D_FF, fold ? a.in[I_NMLP] + (size_t)l * D : nullptr, gtid, gsz);
        wprep_one(a.in[I_WDN] + (size_t)l * D_FF * D, (bf16*)(a.ws + WS_WDN) + (size_t)l * D * D_FF, D_FF, D, D, nullptr, gtid, gsz); }
}
HD void ph_conv(const Args& a, int r, size_t gtid, size_t gsz) {
    const float* P = (const float*)(a.ws + WS_P); float* XR = (float*)(a.ws + WS_XR); float* QKV = (float*)(a.ws + WS_QKV);
    const float* wc = a.in[I_WCONV] + (size_t)r * 4 * CONV_CH; const float* bc = a.in[I_BCONV] + (size_t)r * D_RNN;
    for (size_t i = gtid; i < (size_t)MT * CONV_CH; i += gsz) { const int m = (int)(i / CONV_CH), c = (int)(i % CONV_CH); const RowInfo ri = row_info(m);
        float acc = 0.f;
        for (int k = 0; k < 4; ++k) { const int tau = ri.t - 3 + k; float xv;
            if (tau >= 0) xv = P[(size_t)(ri.row0 + tau) * LDP + c];
            else xv = ri.sample ? a.in[I_SCONV][(((size_t)r * DB + (ri.seq - NB)) * 3 + (3 + tau)) * CONV_CH + c] : 0.f;
            acc += xv * wc[(size_t)k * CONV_CH + c]; }
        if (c < D_RNN) XR[(size_t)m * D_RNN + c] = acc + bc[c]; else QKV[(size_t)m * 1536 + (c - D_RNN)] = siluf_(acc);
        const float uraw = P[(size_t)m * LDP + c];
        if (!ri.sample) { if (ri.t >= SEQ - 3) a.out[O_CONVP + (((size_t)r * NB + ri.seq) * 3 + (ri.t - (SEQ - 3))) * CONV_CH + c] = uraw; }
        else { if (ri.t >= DT - 3) a.out[O_CONVS + (((size_t)r * DB + (ri.seq - NB)) * 3 + (ri.t - (DT - 3))) * CONV_CH + c] = uraw; }
    }
}
HD void ph_rg_gates(const Args& a, int r, size_t gtid, size_t gsz) {
    const float* XR = (const float*)(a.ws + WS_XR); float* RA = (float*)(a.ws + WS_RA); float* RB = (float*)(a.ws + WS_RB);
    const float* wa = a.in[I_WA] + (size_t)r * RG_HEADS * RG_BW * RG_BW; const float* wx = a.in[I_WX] + (size_t)r * RG_HEADS * RG_BW * RG_BW;
    for (size_t i = gtid; i < (size_t)MT * D_RNN; i += gsz) { const int m = (int)(i / D_RNN), j = (int)(i % D_RNN), hd = j / RG_BW, jj = j % RG_BW; const RowInfo ri = row_info(m);
        float pr = 0.f, pi = 0.f; const float* xrow = XR + (size_t)m * D_RNN + hd * RG_BW;
        for (int k = 0; k < RG_BW; ++k) { const float xv = xrow[k]; pr += xv * wa[((size_t)hd * RG_BW + k) * RG_BW + jj]; pi += xv * wx[((size_t)hd * RG_BW + k) * RG_BW + jj]; }
        const float rg = sigmoidf_(pr + a.in[I_BA][(size_t)r * D_RNN + j]), ig = sigmoidf_(pi + a.in[I_BX][(size_t)r * D_RNN + j]);
        const float log_a = -8.0f * rg * softplusf_(-a.in[I_LAM][(size_t)r * D_RNN + j]); const float av = FEXP(log_a);
        const bool first = (!ri.sample) && ri.t == 0;
        const float mult = first ? 1.0f : sqrtf(fmaxf(1.0f - FEXP(2.0f * log_a), 0.0f));
        float bv = XR[(size_t)m * D_RNN + j] * ig * mult;
        if (ri.t == 0 && ri.sample) bv += av * a.in[I_SH][((size_t)r * DB + (ri.seq - NB)) * D_RNN + j];
        RA[i] = av; RB[i] = bv; }
}
HD void ph_rg_scan1(const Args& a, int r, size_t gtid, size_t gsz) {
    const float* RA = (const float*)(a.ws + WS_RA); float* AP = (float*)(a.ws + WS_XR); const float* RB = (const float*)(a.ws + WS_RB); float* HH = (float*)(a.ws + WS_HH);
    const size_t n_p = (size_t)NB * NC * D_RNN, n_s = (size_t)DB * D_RNN;
    for (size_t i = gtid; i < n_p + n_s; i += gsz) {
        if (i < n_p) { const int j = (int)(i % D_RNN); const size_t row0 = (i / D_RNN) * 64; float h = 0.f, ap = 1.f;
            for (int t = 0; t < 64; ++t) { const size_t o = (row0 + t) * D_RNN + j; const float av = RA[o]; h = av * h + RB[o]; ap *= av; HH[o] = h; AP[o] = ap; } }
        else { const size_t q = i - n_p; const int db = (int)(q / D_RNN), j = (int)(q % D_RNN); float h = 0.f;
            for (int t = 0; t < DT; ++t) { const size_t o = (size_t)(MP + db * DT + t) * D_RNN + j; h = RA[o] * h + RB[o]; HH[o] = h; }
            a.out[O_HS + ((size_t)r * DB + db) * D_RNN + j] = h; } }
}
HD void ph_rg_scan2(const Args& a, int r, size_t gtid, size_t gsz) {
    const float* RA = (const float*)(a.ws + WS_XR); const float* HH = (const float*)(a.ws + WS_HH); float* CARRY = (float*)(a.ws + WS_CARRY);
    for (size_t i = gtid; i < (size_t)NB * D_RNN; i += gsz) { const int b = (int)(i / D_RNN), j = (int)(i % D_RNN); float carry = 0.f;
        for (int n0 = 0; n0 < NC; n0 += 16) { float av[16], hv[16];
#pragma unroll
            for (int q = 0; q < 16; ++q) { const int n = n0 + q < NC ? n0 + q : NC - 1; const size_t last = ((size_t)b * SEQ + n * 64 + 63) * D_RNN + j; av[q] = RA[last]; hv[q] = HH[last]; }
#pragma unroll
            for (int q = 0; q < 16; ++q) if (n0 + q < NC) { CARRY[((size_t)b * NC + n0 + q) * D_RNN + j] = carry; carry = av[q] * carry + hv[q]; } }
        a.out[O_HP + ((size_t)r * NB + b) * D_RNN + j] = carry; }
}
HD float dn_g(const Args& a, int r, size_t m, int hd) { const float* P = (const float*)(a.ws + WS_P);
    return -FEXP(a.in[I_ALOG][r * DNH + hd]) * softplusf_(P[m * LDP + OFF_A + hd] + a.in[I_DTB][r * DNH + hd]); }
HD void ph_dn_prep(const Args& a, int r, size_t gtid, size_t gsz) {
    const float* P = (const float*)(a.ws + WS_P); const float* QKV = (const float*)(a.ws + WS_QKV); float* QN = (float*)(a.ws + WS_QN); float* KN = (float*)(a.ws + WS_KN); float* GB = (float*)(a.ws + WS_GB);
    for (size_t i = gtid; i < (size_t)MT * DNH; i += gsz) { const int m = (int)(i / DNH), hd = (int)(i % DNH);
        const float* q = QKV + (size_t)m * 1536 + hd * 128; const float* k = q + 512; float sq = 0.f, sk = 0.f;
        for (int d = 0; d < 128; ++d) { sq += q[d] * q[d]; sk += k[d] * k[d]; }
        const float rq = FRSQ(sq + EPS) * 0.08838834764831845f, rk = 1.0f / sqrtf(sk + EPS);
        for (int d = 0; d < 128; ++d) { QN[(size_t)m * 512 + hd * 128 + d] = q[d] * rq; KN[(size_t)m * 512 + hd * 128 + d] = k[d] * rk; }
        if (m < MP) { float* KNT = (float*)(a.ws + WS_KNT) + (((size_t)(m / SEQ) * DNH + hd) * NC + (m % SEQ) / 64) * 8192 + (m % 64); for (int d = 0; d < 128; ++d) KNT[(size_t)d * 64] = k[d] * rk; }
        const float beta = sigmoidf_(P[(size_t)m * LDP + OFF_B + hd]);
        const float g = dn_g(a, r, (size_t)m, hd); float gc = g;
        if (m < MP) { const int t = m % SEQ; for (int tau = (t / 64) * 64; tau < t; ++tau) gc += dn_g(a, r, (size_t)(m - t + tau), hd); }
        GB[(size_t)m * 16 + hd * 4] = g; GB[(size_t)m * 16 + hd * 4 + 1] = beta; GB[(size_t)m * 16 + hd * 4 + 2] = gc; }
}
#ifndef HOST_TEST
#define DN_FENCE() asm volatile("" ::: "memory")
#else
#define DN_FENCE() do { } while (0)
#endif
HD void ph_dn_seq(const Args& a, int r, int seq_lo, size_t gtid, size_t gsz) {
    const float* QKV = (const float*)(a.ws + WS_QKV); const float* QN = (const float*)(a.ws + WS_QN); const float* KN = (const float*)(a.ws + WS_KN); const float* GB = (const float*)(a.ws + WS_GB);
    float* ODN = (float*)(a.ws + WS_ODN);
    for (size_t i = gtid; i < (size_t)(NB + DB - seq_lo) * DNH * 128; i += gsz) { const int v = (int)(i % 128), sh = UNI((int)(i / 128)), hd = sh % DNH, seq = seq_lo + sh / DNH;
        const int row0 = seq < NB ? seq * SEQ : MP + (seq - NB) * DT, T = seq < NB ? SEQ : DT;
        float S[128];
        if (seq < NB) {
#pragma unroll
            for (int d = 0; d < 128; ++d) S[d] = 0.f; }
        else { const float* s0 = a.in[I_SS] + ((((size_t)r * DB + (seq - NB)) * DNH + hd) * 128) * 128 + v;
#pragma unroll
            for (int d = 0; d < 128; ++d) S[d] = s0[(size_t)d * 128]; }
        for (int t = 0; t < T; ++t) { const size_t m = (size_t)(row0 + t);
            const float* kk = KN + m * 512 + hd * 128; const float* qq = QN + m * 512 + hd * 128;
            const float eg = FEXP(GB[m * 16 + hd * 4]), beta = GB[m * 16 + hd * 4 + 1], vv = QKV[m * 1536 + 1024 + hd * 128 + v];
            float ks = 0.f;
#pragma unroll
            for (int c = 0; c < 4; ++c) {
#pragma unroll
                for (int d = c * 32; d < c * 32 + 32; ++d) ks += kk[d] * S[d];
                DN_FENCE(); }
            const float cc = beta * (vv - eg * ks); float o = 0.f;
#pragma unroll
            for (int c = 0; c < 4; ++c) {
#pragma unroll
                for (int d = c * 32; d < c * 32 + 32; ++d) { S[d] = eg * S[d] + kk[d] * cc; o += qq[d] * S[d]; }
                DN_FENCE(); }
            ODN[m * 512 + hd * 128 + v] = o; }
        float* so = seq < NB ? a.out + O_SP + ((((size_t)r * NB + seq) * DNH + hd) * 128) * 128 + v : a.out + O_SS + ((((size_t)r * DB + (seq - NB)) * DNH + hd) * 128) * 128 + v;
#pragma unroll
        for (int d = 0; d < 128; ++d) so[(size_t)d * 128] = S[d]; }
}
HD void ph_dn_lat(const Args& a, size_t gtid, size_t gsz) {
    const float* QN = (const float*)(a.ws + WS_QN); const float* KN = (const float*)(a.ws + WS_KN); const float* GB = (const float*)(a.ws + WS_GB); const float* KNT = (const float*)(a.ws + WS_KNT);
    float* Lm = (float*)(a.ws + WS_L); bf16* AT = (bf16*)(a.ws + WS_AT); bf16* QG = (bf16*)(a.ws + WS_QG); bf16* KDT = (bf16*)(a.ws + WS_KDT); float* GL = (float*)(a.ws + WS_GL);
    for (size_t it = gtid; it < (size_t)NCU * 4096; it += gsz) { const int j = (int)(it % 64), ci = UNI((int)(it / 64)), i = ci % 64, cu = ci / 64;
        const int n = cu % NC, hd = (cu / NC) % DNH, b = cu / (NC * DNH); const size_t mi = (size_t)b * SEQ + n * 64 + i, mj = (size_t)b * SEQ + n * 64 + j;
        const float* ki = KN + mi * 512 + hd * 128; const float* qi = QN + mi * 512 + hd * 128; const float* kt = KNT + (size_t)cu * 8192 + j; float kk = 0.f, qk = 0.f;
        for (int d = 0; d < 128; ++d) { const float kj = kt[(size_t)d * 64]; kk += ki[d] * kj; qk += qi[d] * kj; }
        float lv = 0.f, av = 0.f;
        if (i >= j) { const float dec = FEXP(GB[mi * 16 + hd * 4 + 2] - GB[mj * 16 + hd * 4 + 2]); av = qk * dec; if (i > j) lv = GB[mi * 16 + hd * 4 + 1] * kk * dec; }
        Lm[it] = lv; AT[it] = f2bf(av); }
    for (size_t it = gtid; it < (size_t)NCU * 8192; it += gsz) { const int d = (int)(it % 128), i = (int)((it / 128) % 64), cu = (int)(it / 8192);
        const int n = cu % NC, hd = (cu / NC) % DNH, b = cu / (NC * DNH); const size_t mi = (size_t)b * SEQ + n * 64 + i;
        QG[it] = f2bf(QN[mi * 512 + hd * 128 + d] * FEXP(GB[mi * 16 + hd * 4 + 2])); }
    for (size_t it = gtid; it < (size_t)NCU * 8192; it += gsz) { const int i = (int)(it % 64), cu = (int)(it / 8192);
        const int n = cu % NC, hd = (cu / NC) % DNH, b = cu / (NC * DNH); const size_t mi = (size_t)b * SEQ + n * 64 + i, ml = (size_t)b * SEQ + n * 64 + 63;
        const float gci = GB[mi * 16 + hd * 4 + 2], gcl = GB[ml * 16 + hd * 4 + 2];
        KDT[it] = f2bf(KNT[it] * FEXP(gcl - gci)); if ((it % 8192) == 0) GL[cu] = FEXP(gcl); }
}
HD void ph_dn_solve(const Args& a, size_t gtid, size_t gsz) {
    const float* QKV = (const float*)(a.ws + WS_QKV); const float* KN = (const float*)(a.ws + WS_KN); const float* GB = (const float*)(a.ws + WS_GB); const float* Lm = (const float*)(a.ws + WS_L);
    float* UT = (float*)(a.ws + WS_UT); bf16* WN = (bf16*)(a.ws + WS_WN);
    for (size_t it = gtid; it < (size_t)NCU * 256; it += gsz) { const int col = (int)(it % 256), cu = UNI((int)(it / 256));
        const int n = cu % NC, hd = (cu / NC) % DNH, b = cu / (NC * DNH); const size_t m0 = (size_t)b * SEQ + n * 64; const float* Lc = Lm + (size_t)cu * 4096;
        float X[64];
#pragma unroll
        for (int j = 0; j < 64; ++j) { const float beta = GB[(m0 + j) * 16 + hd * 4 + 1];
            X[j] = col < 128 ? QKV[(m0 + j) * 1536 + 1024 + hd * 128 + col] * beta : KN[(m0 + j) * 512 + hd * 128 + (col - 128)] * beta * FEXP(GB[(m0 + j) * 16 + hd * 4 + 2]); }
#pragma unroll
        for (int i = 1; i < 64; ++i) { float acc = X[i];
#pragma unroll
            for (int j = 0; j < i; ++j) acc -= Lc[i * 64 + j] * X[j];
            X[i] = acc; DN_FENCE(); }
        if (col < 128) {
#pragma unroll
            for (int j = 0; j < 64; ++j) UT[(size_t)cu * 8192 + (size_t)col * 64 + j] = X[j]; }
        else {
#pragma unroll
            for (int j = 0; j < 64; ++j) WN[(size_t)cu * 8192 + (size_t)j * 128 + (col - 128)] = f2bf(-X[j]); } }
}
HD float bfr(float x) { return bf2f(f2bf(x)); }
HD void ph_dn_b_naive(const Args& a, int r, size_t gtid, size_t gsz) {
    const float* UT = (const float*)(a.ws + WS_UT); const bf16* WN = (const bf16*)(a.ws + WS_WN); const bf16* QG = (const bf16*)(a.ws + WS_QG); const bf16* AT = (const bf16*)(a.ws + WS_AT);
    const bf16* KDT = (const bf16*)(a.ws + WS_KDT); const float* GL = (const float*)(a.ws + WS_GL); float* ODN = (float*)(a.ws + WS_ODN); float* VN = (float*)(a.ws + WS_SCR);
    for (size_t it = gtid; it < (size_t)NB * DNH * 128; it += gsz) { const int v = (int)(it % 128), bh = UNI((int)(it / 128)), b = bh / DNH, hd = bh % DNH;
        float S[128];
#pragma unroll
        for (int d = 0; d < 128; ++d) S[d] = 0.f;
        for (int n = 0; n < NC; ++n) { const size_t cu = (size_t)bh * NC + n;
            for (int i = 0; i < 64; ++i) { float acc = UT[cu * 8192 + (size_t)v * 64 + i]; const bf16* wr = WN + cu * 8192 + i * 128;
#pragma unroll
                for (int d = 0; d < 128; ++d) acc += bf2f(wr[d]) * S[d];
                VN[((size_t)bh * 64 + i) * 128 + v] = acc; DN_FENCE(); }
            for (int i = 0; i < 64; ++i) { float acc = 0.f; const bf16* qr = QG + cu * 8192 + i * 128;
#pragma unroll
                for (int d = 0; d < 128; ++d) acc += bf2f(qr[d]) * S[d];
                for (int j = 0; j < 64; ++j) acc += bf2f(AT[cu * 4096 + i * 64 + j]) * bfr(VN[((size_t)bh * 64 + j) * 128 + v]);
                ODN[((size_t)b * SEQ + n * 64 + i) * 512 + hd * 128 + v] = acc; DN_FENCE(); }
            const float gl = GL[cu];
#pragma unroll
            for (int d = 0; d < 128; ++d) S[d] *= gl;
            for (int j = 0; j < 64; ++j) { const float vj = bfr(VN[((size_t)bh * 64 + j) * 128 + v]); const bf16* kr = KDT + cu * 8192 + j;
#pragma unroll
                for (int d = 0; d < 128; ++d) S[d] += bf2f(kr[d * 64]) * vj;
                DN_FENCE(); }
            DN_FENCE(); }
        float* so = a.out + O_SP + ((((size_t)r * NB + b) * DNH + hd) * 128) * 128 + v;
#pragma unroll
        for (int d = 0; d < 128; ++d) so[(size_t)d * 128] = S[d]; }
}
HD void ph_rec_out(const Args& a, int r, size_t gtid, size_t gsz) {
    const float* P = (const float*)(a.ws + WS_P); const float* HH = (const float*)(a.ws + WS_HH); const float* ODN = (const float*)(a.ws + WS_ODN); bf16* Y2 = (bf16*)(a.ws + WS_Y2);
    for (size_t i = gtid; i < (size_t)MT * Y2W; i += gsz) { const int m = (int)(i / Y2W), c = (int)(i % Y2W); float y;
        if (c < D_RNN) { float h = HH[(size_t)m * D_RNN + c]; if (m < MP) h += ((const float*)(a.ws + WS_XR))[(size_t)m * D_RNN + c] * ((const float*)(a.ws + WS_CARRY))[(size_t)(m / 64) * D_RNN + c];
            y = h * gelu_tanhf_(P[(size_t)m * LDP + OFF_GATE + c]); }
        else { const int cc = c - D_RNN, hd = cc / 128, vv = cc % 128; const float* o = ODN + (size_t)m * 512 + hd * 128; float ss = 0.f;
            for (int d = 0; d < 128; ++d) ss += o[d] * o[d];
            y = o[vv] / sqrtf(ss * (1.0f / 128.0f) + EPS) * a.in[I_DNW][r * 128 + vv] * siluf_(P[(size_t)m * LDP + OFF_Z + cc]); }
        Y2[i] = f2bf(y); }
}
HD void ph_att_split(const Args& a, int ai, size_t gtid, size_t gsz) {
    const float* P = (const float*)(a.ws + WS_P); constexpr int W = 2 * KVH * HDIM + IDIM;
    for (size_t i = gtid; i < (size_t)MT * W; i += gsz) { const int m = (int)(i / W), c = (int)(i % W);
        if (m < MP) { if (c < 256) a.out[O_KP + ((size_t)ai * MP + m) * 256 + c] = P[(size_t)m * LDP + AO_K + c];
            else if (c < 512) a.out[O_VP + ((size_t)ai * MP + m) * 256 + (c - 256)] = P[(size_t)m * LDP + AO_V + (c - 256)];
            else a.out[O_KIP + ((size_t)ai * MP + m) * 64 + (c - 512)] = P[(size_t)m * LDP + AO_KI + (c - 512)]; }
        else { const int ms = m - MP; if (c < 256) a.out[O_KS + ((size_t)ai * MS + ms) * 256 + c] = P[(size_t)m * LDP + AO_K + c];
            else if (c < 512) a.out[O_VS + ((size_t)ai * MS + ms) * 256 + (c - 256)] = P[(size_t)m * LDP + AO_V + (c - 256)];
            else a.out[O_KIS + ((size_t)ai * MS + ms) * 64 + (c - 512)] = P[(size_t)m * LDP + AO_KI + (c - 512)]; } }
}
HD const float* ki_row_sample(const Args& a, int ai, int db, int s) {
    if (s < PAST) { const int pg = ((const int*)a.in[I_PT])[db * NPAGES + s / PAGE]; return a.in[I_CKI] + (((size_t)ai * NPOOL + pg) * PAGE + s % PAGE) * IDIM; }
    return (const float*)(a.ws + WS_P) + (size_t)(MP + db * DT + (s - PAST)) * LDP + AO_KI;
}
HD void ph_idx_scores(const Args& a, int ai, bool prompt_too, size_t gtid, size_t gsz) {
    const float* P = (const float*)(a.ws + WS_P); float* SCT = (float*)(a.ws + WS_SCT);
    const int lane = (int)(gtid & 63); const size_t w = gtid >> 6, nw = gsz >> 6;
    constexpr int TM = 8, NKB = (SEQ + 63) / 64, NMT = SEQ / TM, NKBS = (PAST + DT + 63) / 64;
    const size_t n_p = (size_t)NB * NMT * NKB, n_s = (size_t)DB * NKBS;
    for (size_t it0 = w + (prompt_too ? 0 : n_p); it0 < n_p + n_s; it0 += nw) { const size_t it = (size_t)UNI((int)it0);
        int mrow0, nrows, s, smax_valid; const float* kr;
        if (it < n_p) { const int b = (int)(it / ((size_t)NMT * NKB)), rr = (int)(it % ((size_t)NMT * NKB)), mt = rr / NKB, kb = rr % NKB;
            if (kb * 64 > mt * TM + TM - 1) continue;
            mrow0 = b * SEQ + mt * TM; nrows = TM; s = kb * 64 + lane; smax_valid = SEQ; kr = P + (size_t)(b * SEQ + (s < SEQ ? s : 0)) * LDP + AO_KI; }
        else { const int q = (int)(it - n_p), db = q / NKBS, kb = q % NKBS; mrow0 = MP + db * DT; nrows = DT; s = kb * 64 + lane; smax_valid = PAST + DT; kr = ki_row_sample(a, ai, db, s < PAST + DT ? s : 0); }
        float kv[IDIM];
#pragma unroll
        for (int d = 0; d < IDIM; ++d) kv[d] = kr[d];
        for (int i = 0; i < nrows; ++i) { const int m = mrow0 + i; const float* qi = P + (size_t)m * LDP + AO_QI; const float* wi = P + (size_t)m * LDP + AO_WI; float sc = 0.f;
            for (int h = 0; h < IH; ++h) { float dot = 0.f;
#pragma unroll
                for (int d = 0; d < IDIM; ++d) dot += qi[h * IDIM + d] * kv[d];
                sc += wi[h] * fmaxf(dot, 0.f); }
            if (s < smax_valid) SCT[(size_t)m * SLD + s] = sc; } }
}
HD void ph_select(const Args& a, size_t gtid, size_t gsz) {
    const float* SCT = (const float*)(a.ws + WS_SCT); int* IDX = (int*)(a.ws + WS_IDX); int* NSEL = (int*)(a.ws + WS_NSEL);
    for (size_t m = gtid; m < (size_t)MT; m += gsz) { const RowInfo ri = row_info((int)m);
        const int n = ri.sample ? PAST + ri.t + 1 : ri.t + 1, K = ri.sample ? TOPK_S : TOPK_P; const float* col = SCT + m * SLD; int* out = IDX + m * KROW;
        if (n <= K) { for (int j = 0; j < n; ++j) out[j] = j; NSEL[m] = n; continue; }
        unsigned lo = 0u;
        for (int bit = 31; bit >= 0; --bit) { const unsigned cand = lo | (1u << bit); int c = 0;
            for (int s = 0; s < n; ++s) c += (fkey(col[s]) >= cand) ? 1 : 0;
            if (c >= K) lo = cand; }
        int cnt = 0;
        for (int s = 0; s < n; ++s) if (fkey(col[s]) > lo) out[cnt++] = s;
        for (int s = 0; s < n && cnt < K; ++s) if (fkey(col[s]) == lo) out[cnt++] = s;
        NSEL[m] = K; }
}
HD const float* kv_row(const Args& a, int ai, const RowInfo& ri, int idx, int kvh, bool isv) {
    const float* P = (const float*)(a.ws + WS_P); const int off = (isv ? AO_V : AO_K) + kvh * HDIM;
    if (!ri.sample) return P + (size_t)(ri.row0 + idx) * LDP + off;
    const int db = ri.seq - NB;
    if (idx >= PAST) return P + (size_t)(MP + db * DT + (idx - PAST)) * LDP + off;
    const int pg = ((const int*)a.in[I_PT])[db * NPAGES + idx / PAGE];
    return a.in[isv ? I_CV : I_CK] + ((((size_t)ai * NPOOL + pg) * PAGE + idx % PAGE) * KVH + kvh) * HDIM;
}
HD void ph_sp_scores(const Args& a, int ai, int m_lo, int m_hi, size_t gtid, size_t gsz) {
    const float* P = (const float*)(a.ws + WS_P); const int* IDX = (const int*)(a.ws + WS_IDX); const int* NSEL = (const int*)(a.ws + WS_NSEL); float* SCR = (float*)(a.ws + WS_SCR);
    for (size_t i = gtid + (size_t)m_lo * AH * KMAX; i < (size_t)m_hi * AH * KMAX; i += gsz) { const int j = (int)(i % KMAX), h = (int)((i / KMAX) % AH), m = (int)(i / ((size_t)KMAX * AH));
        if (j >= NSEL[m]) { SCR[i] = -1e30f; continue; }
        const RowInfo ri = row_info(m); const float* kr = kv_row(a, ai, ri, IDX[(size_t)m * KROW + j], h / GROUP, false); const float* q = P + (size_t)m * LDP + h * HDIM; float dot = 0.f;
        for (int d = 0; d < HDIM; ++d) dot += q[d] * kr[d];
        SCR[i] = dot * 0.08838834764831845f; }
}
HD void ph_sp_out(const Args& a, int ai, int m_lo, int m_hi, size_t gtid, size_t gsz) {
    const int* IDX = (const int*)(a.ws + WS_IDX); const int* NSEL = (const int*)(a.ws + WS_NSEL); const float* SCR = (const float*)(a.ws + WS_SCR); bf16* O = (bf16*)(a.ws + WS_Y2);
    for (size_t i = gtid + (size_t)m_lo * AH * HDIM; i < (size_t)m_hi * AH * HDIM; i += gsz) { const int d = (int)(i % HDIM), h = (int)((i / HDIM) % AH), m = (int)(i / ((size_t)HDIM * AH));
        const int ns = NSEL[m]; const float* sc = SCR + ((size_t)m * AH + h) * KMAX; const RowInfo ri = row_info(m);
        float mx = -3e38f; for (int j = 0; j < ns; ++j) mx = fmaxf(mx, sc[j]);
        float sum = 0.f, acc = 0.f;
        for (int j = 0; j < ns; ++j) { const float p = FEXP(sc[j] - mx); sum += p; acc += p * kv_row(a, ai, ri, IDX[(size_t)m * KROW + j], h / GROUP, true)[d]; }
        O[(size_t)m * D + h * HDIM + d] = f2bf(acc / sum); }
}
#ifndef HOST_TEST
#define LAS __attribute__((address_space(3)))

constexpr int LDS_WTAB = 131072 + 64;
__device__ __forceinline__ int TID() { extern __shared__ __attribute__((aligned(16))) unsigned char lds_dyn_[]; const unsigned hw = (unsigned)__builtin_amdgcn_s_getreg((5 << 11) | 4) & 63u;
    const int wvi = ((const LAS int*)((LAS unsigned char*)lds_dyn_ + LDS_WTAB))[hw]; int ln_; asm volatile("v_mbcnt_lo_u32_b32 %0, -1, 0\n\tv_mbcnt_hi_u32_b32 %0, -1, %0" : "=v"(ln_));
    return (wvi << 6) | ln_; }
#define XB_TMO      128
#define XB_XCNT(j)  (256  + 64 * (j))
#define XB_XSUB(j)  (1280 + 64 * (j))
#define XB_XGEN(j)  (2304 + 64 * (j))
#define XB_TOP      3328
#define XB_TOPGEN   3392
#define XCD_BAR_WORDS 3456
#define XB_SPIN_CAP (1u << 22)

__device__ __forceinline__ unsigned xb_ld(unsigned* p)              { return __hip_atomic_load(p, __ATOMIC_RELAXED, __HIP_MEMORY_SCOPE_AGENT); }
__device__ __forceinline__ unsigned xb_add(unsigned* p, unsigned v) { return __hip_atomic_fetch_add(p, v, __ATOMIC_RELAXED, __HIP_MEMORY_SCOPE_AGENT); }
__device__ __forceinline__ unsigned xb_xcc_id() { return (unsigned)__builtin_amdgcn_s_getreg((3 << 11) | 20) & 0xFu; }
#define XB_SPIN(cond, bar) do { unsigned _sp = 0; while (cond) { __builtin_amdgcn_s_sleep(1); \
    if ((++_sp & 255u) == 0u) { if (xb_ld(&(bar)[XB_TMO])) break; if (_sp > XB_SPIN_CAP) { atomicAdd(&(bar)[XB_TMO], 1u); break; } } } } while (0)

struct XcdBarrier {
    unsigned* bar; unsigned x;
    volatile LAS unsigned* st;
};

__device__ __forceinline__ XcdBarrier xcd_barrier_post(unsigned* bar, volatile LAS unsigned* st) {
    XcdBarrier b; b.bar = bar; b.x = xb_xcc_id(); b.st = st;
    if (TID() == 0) (void)xb_add(&bar[XB_XCNT(b.x)], 1u);
    return b;
}
__device__ __forceinline__ void xcd_barrier_complete(unsigned* bar, unsigned x, unsigned& nloc, unsigned& nx) {
    const unsigned G = gridDim.x * gridDim.y * gridDim.z;
    unsigned sum, cnt, mine, sp = 0u;
    for (;;) {
        sum = 0u; cnt = 0u; mine = 0u;
#pragma unroll
        for (unsigned j = 0; j < 16; ++j) { const unsigned c = xb_ld(&bar[XB_XCNT(j)]); sum += c; cnt += (c > 0u) ? 1u : 0u; mine = (j == x) ? c : mine; }
        if (sum == G) break;
        __builtin_amdgcn_s_sleep(1);
        if ((++sp & 255u) == 0u) { if (xb_ld(&bar[XB_TMO])) break; if (sp > XB_SPIN_CAP) { atomicAdd(&bar[XB_TMO], 1u); break; } }
    }
    nloc = mine > 0u ? mine : 1u; nx = cnt > 0u ? cnt : 1u;
}

__device__ __forceinline__ void xcd_barrier(const XcdBarrier& b) {
    asm volatile("s_waitcnt vmcnt(0)" ::: "memory");
    __syncthreads();
    if (TID() == 0) {
        unsigned* bar = b.bar;
        __builtin_amdgcn_s_waitcnt(0);
        unsigned nloc = b.st[0], nx = b.st[1];
        if (nloc == 0u) { xcd_barrier_complete(bar, b.x, nloc, nx); b.st[0] = nloc; b.st[1] = nx; }
        const unsigned old = xb_add(&bar[XB_XSUB(b.x)], 1u);
        const unsigned gen = old / nloc;
        if (old + 1u == (gen + 1u) * nloc) {
            __builtin_amdgcn_fence(__ATOMIC_RELEASE, "agent");
            asm volatile("s_waitcnt vmcnt(0)" ::: "memory");
            const unsigned og = xb_add(&bar[XB_TOP], 1u);
            const unsigned tg = og / nx;
            if (og + 1u == (tg + 1u) * nx) xb_add(&bar[XB_TOPGEN], 1u);
            else XB_SPIN(xb_ld(&bar[XB_TOPGEN]) == tg, bar);
            __builtin_amdgcn_fence(__ATOMIC_ACQUIRE, "agent");
            xb_add(&bar[XB_XGEN(b.x)], 1u);
            asm volatile("s_waitcnt vmcnt(0)" ::: "memory");
        } else {
            XB_SPIN(xb_ld(&bar[XB_XGEN(b.x)]) == gen, bar);
            __builtin_amdgcn_fence(__ATOMIC_ACQUIRE, "agent");
            asm volatile("s_waitcnt vmcnt(0)" ::: "memory");
        }
    }
    __syncthreads();
}

namespace pg8 {
#define PG8_LAS __attribute__((address_space(3)))
typedef unsigned short bf16_t;
typedef short bf16x8 __attribute__((ext_vector_type(8)));
typedef float f32x4 __attribute__((ext_vector_type(4)));
typedef unsigned u32x4 __attribute__((ext_vector_type(4)));
constexpr int BM = 256, BK = 64, HALF = 128, HTB = HALF * BK * 2  , STAGE_BYTES = 8 * HTB, NXCD = 8, WGM = 8;

__host__ __device__ __forceinline__ int lds_byte(int r, int c) { const int st = (r >> 4) * 2 + (c >> 5), rr = r & 15, cc = c & 31, ob = rr * 64 + cc * 2; return st * 1024 + (ob ^ (((ob >> 9) & 1) << 5)); }
__host__ __device__ __forceinline__ void stage_rc(int b, int& R, int& C) { const int st = b / 1024, sb = b % 1024, swz = sb ^ (((sb >> 9) & 1) << 5); R = (st >> 1) * 16 + swz / 64; C = (st & 1) * 32 + (swz % 64) / 2; }
__host__ __device__ __forceinline__ int perm32(int rho) { const int n = rho >> 4, i = rho & 15; return 8 * (i >> 2) + 4 * n + (i & 3); }

struct Unit { int pm, pn; };
struct Gemm { const bf16_t* A; const bf16_t* Bt; int M, N, K; };

struct StaticOrder {
    int nM, nN, nwg, G, c;
    __host__ __device__ void init(int M, int N, int G_, int c_) { nM = M / BM; nN = N / BM; nwg = nM * nN; G = G_; c = c_; }
    __host__ __device__ bool next(int i, Unit& u) const {
        const long L = (long)i * G + c; if (L >= nwg) return false;
        int wgid = (int)L; { const int q = nwg / NXCD, r = nwg % NXCD, xcd = wgid % NXCD, off = wgid / NXCD; wgid = (xcd < r ? xcd * (q + 1) : r * (q + 1) + (xcd - r) * q) + off; }
        const int nig = WGM * nN, gid = wgid / nig, fm = gid * WGM, gsz = (nM - fm) < WGM ? (nM - fm) : WGM;
        u.pm = fm + ((wgid % nig) % gsz); u.pn = (wgid % nig) / gsz; return true;
    }
    __device__ __forceinline__ void a_ready(const Unit&) const {}
    __device__ __forceinline__ void done(const Unit&) const {}
};

__device__ __forceinline__ unsigned cvt_pk_bf16(float lo, float hi) { unsigned r; asm volatile("v_cvt_pk_bf16_f32 %0, %1, %2" : "=v"(r) : "v"(lo), "v"(hi)); return r; }
struct EpiF32 {
    static constexpr bool PERM = false, AFTER_DRAIN = false;
    float* C; int ldc; const float* bias;
    __device__ __forceinline__ void operator()(const f32x4 (&acc)[2][2][4][2], const Unit& u, int wr, int wc, int fr, int fq) const {
        const int row0 = u.pm * BM + wr * 64 + fr, col0 = u.pn * BM + wc * 32 + 4 * fq;
        f32x4 bv[2][2];
#pragma unroll
        for (int bj = 0; bj < 2; ++bj)
#pragma unroll
            for (int n = 0; n < 2; ++n) bv[bj][n] = bias ? *(const f32x4*)(bias + col0 + bj * HALF + n * 16) : (f32x4){0.f, 0.f, 0.f, 0.f};
#pragma unroll
        for (int ai = 0; ai < 2; ++ai)
#pragma unroll
            for (int m = 0; m < 4; ++m) { float* rowp = C + (size_t)(row0 + ai * HALF + m * 16) * ldc + col0;
#pragma unroll
                for (int bj = 0; bj < 2; ++bj)
#pragma unroll
                    for (int n = 0; n < 2; ++n) *(f32x4*)(rowp + bj * HALF + n * 16) = acc[ai][bj][m][n] + bv[bj][n]; }
    }
};
template <class Epi, class Sched, bool STAMP = false>
__device__ __forceinline__ void gemm_phase(PG8_LAS unsigned char* lds, const Gemm g, const Sched& S, const Epi& E, unsigned long long* stamps) {
    int tid_ = TID(); asm volatile("" : "+v"(tid_));
    const int tid = tid_, wid = __builtin_amdgcn_readfirstlane(tid >> 6), lane = tid & 63, wr = wid >> 2, wc = wid & 3, fr = lane & 15, fq = lane >> 4;
    const int K = g.K, nt = K / BK;
    int ts_lo = 0, ts_hi = 0, nts = 0; const unsigned long long rt_entry = STAMP ? (unsigned long long)wall_clock64() : 0ull;
#define PG8_STAMP() do { if (STAMP && wid == 0 && nts < 64) { const unsigned long long _c = (unsigned long long)clock64(); \
        ts_lo = (lane == nts) ? (int)(unsigned)_c : ts_lo; ts_hi = (lane == nts) ? (int)(unsigned)(_c >> 32) : ts_hi; ++nts; } } while (0)
    PG8_STAMP();
    unsigned voffA[2], voffB[2];
#pragma unroll
    for (int i = 0; i < 2; ++i) { int R, C; stage_rc(tid * 16 + i * 8192, R, C); const int Rb = Epi::PERM ? ((R & ~31) + perm32(R & 31)) : R;
        voffA[i] = (unsigned)(R * K + C) * 2u; voffB[i] = (unsigned)(Rb * K + C) * 2u; }
    const size_t kstep = (size_t)(BK * 2);
    const size_t hstep = (size_t)HALF * K * 2;
    const size_t tstep = 2 * hstep;
    const unsigned ldsw = (unsigned)wid * 1024u;
    const int aoff = lds_byte(wr * 64 + fr, fq * 8), boff = lds_byte(wc * 32 + fr, fq * 8);
#define PG8_SA(b, h) (((b) * 2 + (h)) * HTB)
#define PG8_SB(b, h) ((4 + (b) * 2 + (h)) * HTB)
#define PG8_STAGE(bufoff, gbase, voff) do { _Pragma("unroll") for (int _i = 0; _i < 2; ++_i) \
        __builtin_amdgcn_global_load_lds((const unsigned*)((const char*)(gbase) + (voff)[_i]), (PG8_LAS unsigned*)(lds + (bufoff) + ldsw + _i * 8192), 16, 0, 0); } while (0)
#define PG8_LDA(dst, b, h) do { _Pragma("unroll") for (int m = 0; m < 4; ++m) _Pragma("unroll") for (int k = 0; k < 2; ++k) dst[m][k] = *(const PG8_LAS bf16x8*)(lds + PG8_SA(b, h) + aoff + m * 2048 + k * 1024); } while (0)
#define PG8_LDB(dst, b, h) do { _Pragma("unroll") for (int n = 0; n < 2; ++n) _Pragma("unroll") for (int k = 0; k < 2; ++k) dst[n][k] = *(const PG8_LAS bf16x8*)(lds + PG8_SB(b, h) + boff + n * 2048 + k * 1024); } while (0)
#define PG8_MMA(ai, bj, At, Bt) do { __builtin_amdgcn_s_setprio(1); _Pragma("unroll") for (int m = 0; m < 4; ++m) _Pragma("unroll") for (int n = 0; n < 2; ++n) _Pragma("unroll") for (int k = 0; k < 2; ++k) \
        acc[ai][bj][m][n] = __builtin_amdgcn_mfma_f32_16x16x32_bf16(Bt[n][k], At[m][k], acc[ai][bj][m][n], 0, 0, 0); __builtin_amdgcn_s_setprio(0); } while (0)
#define PG8_WAIT_V(n) asm volatile("s_waitcnt vmcnt(" #n ")" ::: "memory")
#define PG8_WAIT_L(n) asm volatile("s_waitcnt lgkmcnt(" #n ")" ::: "memory")
#define PG8_BAR __builtin_amdgcn_s_barrier()
#define PG8_SCHED __builtin_amdgcn_sched_barrier(0)
    Unit cur, nxt; int ui = 0;
    if (!S.next(0, cur)) return;
    f32x4 acc[2][2][4][2];
#pragma unroll
    for (int a = 0; a < 2; ++a)
#pragma unroll
        for (int b = 0; b < 2; ++b)
#pragma unroll
            for (int m = 0; m < 4; ++m)
#pragma unroll
                for (int n = 0; n < 2; ++n) acc[a][b][m][n] = (f32x4){0.f, 0.f, 0.f, 0.f};
    bf16x8 At[4][2], B0[2][2], B1[2][2];
    const char* cA = (const char*)g.A + (size_t)cur.pm * tstep; const char* cB = (const char*)g.Bt + (size_t)cur.pn * tstep;
    S.a_ready(cur);
    PG8_STAGE(PG8_SB(0, 0), cB, voffB); PG8_STAGE(PG8_SA(0, 0), cA, voffA); PG8_STAGE(PG8_SB(0, 1), cB + hstep, voffB); PG8_STAGE(PG8_SA(0, 1), cA + hstep, voffA);
    if (wr == 1) PG8_BAR;
    PG8_WAIT_V(4); PG8_BAR;
    PG8_STAGE(PG8_SB(1, 0), cB + kstep, voffB); PG8_STAGE(PG8_SA(1, 0), cA + kstep, voffA); PG8_STAGE(PG8_SB(1, 1), cB + hstep + kstep, voffB);
    PG8_WAIT_V(6); PG8_BAR;
    PG8_STAMP();
    for (;;) {
        const bool has_next = S.next(ui + 1, nxt);
        const char* nA = has_next ? (const char*)g.A + (size_t)nxt.pm * tstep : cA; const char* nB = has_next ? (const char*)g.Bt + (size_t)nxt.pn * tstep : cB;
        for (int t = 0; t < nt; t += 2) {
            const bool last = (t == nt - 2);
            const char* a1 = cA + (size_t)(t + 1) * kstep;
            const char* a2 = last ? nA : cA + (size_t)(t + 2) * kstep; const char* b2 = last ? nB : cB + (size_t)(t + 2) * kstep;
            const char* a3 = a2 + kstep; const char* b3 = b2 + kstep;
            if (last && has_next) S.a_ready(nxt);
            PG8_LDB(B0, 0, 0); PG8_SCHED; PG8_LDA(At, 0, 0); PG8_STAGE(PG8_SA(1, 1), a1 + hstep, voffA);
            PG8_WAIT_L(8); PG8_BAR; PG8_WAIT_L(0); PG8_MMA(0, 0, At, B0); PG8_BAR; PG8_SCHED;
            PG8_LDB(B1, 0, 1); PG8_STAGE(PG8_SB(0, 0), b2, voffB);
            PG8_BAR; PG8_WAIT_L(0); PG8_MMA(0, 1, At, B1); PG8_BAR;
            PG8_LDA(At, 0, 1); PG8_STAGE(PG8_SA(0, 0), a2, voffA);
            PG8_BAR; PG8_WAIT_L(0); PG8_MMA(1, 0, At, B0); PG8_BAR; PG8_SCHED;
            PG8_STAGE(PG8_SB(0, 1), b2 + hstep, voffB);
            PG8_WAIT_V(6); PG8_BAR; PG8_MMA(1, 1, At, B1); PG8_BAR;
            PG8_LDB(B0, 1, 0); PG8_SCHED; PG8_LDA(At, 1, 0); PG8_STAGE(PG8_SA(0, 1), a2 + hstep, voffA);
            PG8_WAIT_L(8); PG8_BAR; PG8_WAIT_L(0); PG8_MMA(0, 0, At, B0); PG8_BAR; PG8_SCHED;
            PG8_LDB(B1, 1, 1); PG8_STAGE(PG8_SB(1, 0), b3, voffB);
            PG8_BAR; PG8_WAIT_L(0); PG8_MMA(0, 1, At, B1); PG8_BAR;
            PG8_LDA(At, 1, 1); PG8_STAGE(PG8_SA(1, 0), a3, voffA);
            PG8_BAR; PG8_WAIT_L(0); PG8_MMA(1, 0, At, B0); PG8_BAR; PG8_SCHED;
            PG8_STAGE(PG8_SB(1, 1), b3 + hstep, voffB);
            PG8_WAIT_V(6); PG8_BAR; PG8_MMA(1, 1, At, B1); PG8_BAR;
        }
        PG8_STAMP();
        if constexpr (!Epi::AFTER_DRAIN) { E(acc, cur, wr, wc, fr, fq); S.done(cur); }
        PG8_STAMP();
        if (!has_next) break;
#pragma unroll
        for (int a = 0; a < 2; ++a)
#pragma unroll
            for (int b = 0; b < 2; ++b)
#pragma unroll
                for (int m = 0; m < 4; ++m)
#pragma unroll
                    for (int n = 0; n < 2; ++n) acc[a][b][m][n] = (f32x4){0.f, 0.f, 0.f, 0.f};
        cur = nxt; cA = nA; cB = nB; ++ui;
    }
    PG8_WAIT_V(0);
    if (wr == 0) PG8_BAR;
    PG8_BAR;
    if constexpr (Epi::AFTER_DRAIN) { E.fused(acc, cur, wr, wc, fr, fq, lds, wid, lane); S.done(cur); }
    PG8_STAMP();
    if (STAMP && wid == 0) { stamps[lane] = lane < nts ? (((unsigned long long)(unsigned)ts_hi << 32) | (unsigned)ts_lo) : 0ull;
        if (lane == 62) stamps[62] = rt_entry; if (lane == 63) stamps[63] = (unsigned long long)wall_clock64(); }
#undef PG8_STAMP
#undef PG8_SA
#undef PG8_SB
#undef PG8_STAGE
#undef PG8_LDA
#undef PG8_LDB
#undef PG8_MMA
#undef PG8_WAIT_V
#undef PG8_WAIT_L
#undef PG8_BAR
#undef PG8_SCHED
}
}
#endif

#ifndef HOST_TEST
#include <cstdio>
#define FRAG_OFF(row_, k_, KS_) ((((((row_) >> 4) * (KS_) + ((k_) >> 5)) * 64 + (((k_) >> 3) & 3) * 16 + ((row_) & 15)) * 8) + ((k_) & 7))
namespace pg8 {
struct EpiAddF32 {
    static constexpr bool PERM = false, AFTER_DRAIN = false;
    float* C; int ldc;
    __device__ __forceinline__ void operator()(const f32x4 (&acc)[2][2][4][2], const Unit& u, int wr, int wc, int fr, int fq) const {
        const int row0 = u.pm * BM + wr * 64 + fr, col0 = u.pn * BM + wc * 32 + 4 * fq;
#pragma unroll
        for (int ai = 0; ai < 2; ++ai)
#pragma unroll
            for (int m = 0; m < 4; ++m) { float* rowp = C + (size_t)(row0 + ai * HALF + m * 16) * ldc + col0;
#pragma unroll
                for (int bj = 0; bj < 2; ++bj)
#pragma unroll
                    for (int n = 0; n < 2; ++n) { f32x4* p = (f32x4*)(rowp + bj * HALF + n * 16); *p = *p + acc[ai][bj][m][n]; } }
    }
};
struct EpiRelu2Bf16 {
    static constexpr bool PERM = true, AFTER_DRAIN = false;
    bf16_t* O; int ldc;
    __device__ __forceinline__ void operator()(const f32x4 (&acc)[2][2][4][2], const Unit& u, int wr, int wc, int fr, int fq) const {
        const int row0 = u.pm * BM + wr * 64 + fr, col0 = u.pn * BM + wc * 32 + 8 * fq;
#pragma unroll
        for (int ai = 0; ai < 2; ++ai)
#pragma unroll
            for (int m = 0; m < 4; ++m) { bf16_t* rowp = O + (size_t)(row0 + ai * HALF + m * 16) * ldc + col0;
#pragma unroll
                for (int bj = 0; bj < 2; ++bj) { f32x4 v0 = acc[ai][bj][m][0], v1 = acc[ai][bj][m][1];
#pragma unroll
                    for (int j = 0; j < 4; ++j) { const float r0 = fmaxf(v0[j], 0.f), r1 = fmaxf(v1[j], 0.f); v0[j] = r0 * r0; v1[j] = r1 * r1; }
                    u32x4 w; w.x = cvt_pk_bf16(v0[0], v0[1]); w.y = cvt_pk_bf16(v0[2], v0[3]); w.z = cvt_pk_bf16(v1[0], v1[1]); w.w = cvt_pk_bf16(v1[2], v1[3]);
                    *(u32x4*)(rowp + bj * HALF) = w; } }
    }
};

__device__ __forceinline__ float epi_shfl_xor(float v, int o, int lane) { return __builtin_bit_cast(float, __builtin_amdgcn_ds_bpermute((lane ^ o) << 2, __builtin_bit_cast(int, v))); }
__device__ __forceinline__ float row_rs(const unsigned long long* ss, int row) { return FRSQ((float)ss[row] * (5.9604644775390625e-08f / D) + EPS); }
struct EpiF32S {
    static constexpr bool PERM = false, AFTER_DRAIN = false;
    float* C; int ldc; const unsigned long long* ss;
    __device__ __forceinline__ void operator()(const f32x4 (&acc)[2][2][4][2], const Unit& u, int wr, int wc, int fr_in, int fq_in) const {
        int fr = fr_in, fq = fq_in; asm volatile("" : "+v"(fr), "+v"(fq));
        const int row0 = u.pm * BM + wr * 64 + fr, col0 = u.pn * BM + wc * 32 + 4 * fq;
#pragma unroll
        for (int ai = 0; ai < 2; ++ai)
#pragma unroll
            for (int m = 0; m < 4; ++m) { const int row = row0 + ai * HALF + m * 16; const float rs = row_rs(ss, row); float* rowp = C + (size_t)row * ldc + col0;
#pragma unroll
                for (int bj = 0; bj < 2; ++bj)
#pragma unroll
                    for (int n = 0; n < 2; ++n) *(f32x4*)(rowp + bj * HALF + n * 16) = acc[ai][bj][m][n] * rs; }
    }
};
struct EpiRelu2S {
    static constexpr bool PERM = true, AFTER_DRAIN = false;
    bf16_t* O; int ldc; const unsigned long long* ss;
    __device__ __forceinline__ void operator()(const f32x4 (&acc)[2][2][4][2], const Unit& u, int wr, int wc, int fr_in, int fq_in) const {
        int fr = fr_in, fq = fq_in; asm volatile("" : "+v"(fr), "+v"(fq));
        const int row0 = u.pm * BM + wr * 64 + fr, col0 = u.pn * BM + wc * 32 + 8 * fq;
#pragma unroll
        for (int ai = 0; ai < 2; ++ai)
#pragma unroll
            for (int m = 0; m < 4; ++m) { const int row = row0 + ai * HALF + m * 16; const float rs = row_rs(ss, row); bf16_t* rowp = O + (size_t)row * ldc + col0;
#pragma unroll
                for (int bj = 0; bj < 2; ++bj) { f32x4 v0 = acc[ai][bj][m][0] * rs, v1 = acc[ai][bj][m][1] * rs;
#pragma unroll
                    for (int j = 0; j < 4; ++j) { const float r0 = fmaxf(v0[j], 0.f), r1 = fmaxf(v1[j], 0.f); v0[j] = r0 * r0; v1[j] = r1 * r1; }
                    u32x4 w; w.x = cvt_pk_bf16(v0[0], v0[1]); w.y = cvt_pk_bf16(v0[2], v0[3]); w.z = cvt_pk_bf16(v1[0], v1[1]); w.w = cvt_pk_bf16(v1[2], v1[3]);
                    *(u32x4*)(rowp + bj * HALF) = w; } }
    }
};
struct EpiAddN {
    static constexpr bool PERM = false, AFTER_DRAIN = false;
    float* C; int ldc; bf16_t* XB; unsigned long long* ss;
    __device__ __forceinline__ void operator()(const f32x4 (&acc)[2][2][4][2], const Unit& u, int wr, int wc, int fr_in, int fq_in) const {
        int fr = fr_in, fq = fq_in; asm volatile("" : "+v"(fr), "+v"(fq));
        const int row0 = u.pm * BM + wr * 64 + fr, col0 = u.pn * BM + wc * 32 + 4 * fq, lane = fq * 16 + fr;
#pragma unroll
        for (int ai = 0; ai < 2; ++ai)
#pragma unroll
            for (int m = 0; m < 4; ++m) { const int row = row0 + ai * HALF + m * 16; float* rowp = C + (size_t)row * ldc + col0; bf16_t* xbp = XB + (size_t)row * ldc + col0; float q = 0.f;
#pragma unroll
                for (int bj = 0; bj < 2; ++bj)
#pragma unroll
                    for (int n = 0; n < 2; ++n) { f32x4* p = (f32x4*)(rowp + bj * HALF + n * 16); const f32x4 v = *p + acc[ai][bj][m][n]; *p = v; q += (v[0] * v[0] + v[1] * v[1]) + (v[2] * v[2] + v[3] * v[3]);
                        unsigned w0 = cvt_pk_bf16(v[0], v[1]), w1 = cvt_pk_bf16(v[2], v[3]); *(uint2*)(xbp + bj * HALF + n * 16) = make_uint2(w0, w1); }
                q += epi_shfl_xor(q, 16, lane); q += epi_shfl_xor(q, 32, lane);
                if (fq == 0) __hip_atomic_fetch_add(ss + row, (unsigned long long)(q * 16777216.0f), __ATOMIC_RELAXED, __HIP_MEMORY_SCOPE_AGENT); }
    }
};
struct EpiAttS {
    static constexpr bool PERM = false, AFTER_DRAIN = false;
    unsigned char* ws; float* out; const unsigned long long* ss; int ai_;
    __device__ __forceinline__ void operator()(const f32x4 (&acc)[2][2][4][2], const Unit& u, int wr, int wc, int fr_in, int fq_in) const {
        int fr = fr_in, fq = fq_in; asm volatile("" : "+v"(fr), "+v"(fq));
        float* P = (float*)(ws + WS_P); constexpr int ldc = LDP; bf16_t* QB = (bf16_t*)(ws + WS_QB); bf16_t* KB = (bf16_t*)(ws + WS_KB); bf16_t* VB = (bf16_t*)(ws + WS_VB); bf16_t* QIB = (bf16_t*)(ws + WS_QIB); bf16_t* KIB = (bf16_t*)(ws + WS_KIB);
        const int row0 = u.pm * BM + wr * 64 + fr; float rsv[2][4];
#pragma unroll
        for (int ai = 0; ai < 2; ++ai)
#pragma unroll
            for (int m = 0; m < 4; ++m) rsv[ai][m] = row_rs(ss, row0 + ai * HALF + m * 16);
#pragma unroll
        for (int bj = 0; bj < 2; ++bj)
#pragma unroll
            for (int n = 0; n < 2; ++n) { const int cb = u.pn * BM + bj * HALF + wc * 32 + n * 16;
                bf16_t* bdst; int bld, bc; float* odst0 = nullptr; float* odst1 = nullptr; int old_ = 0;
                if (cb < AO_K) { bdst = QB; bld = D; bc = cb; }
                else if (cb < AO_V) { bdst = KB; bld = 256; bc = cb - AO_K; odst0 = out + O_KP + (size_t)ai_ * MP * 256 + bc; odst1 = out + O_KS + (size_t)ai_ * MS * 256 + bc; old_ = 256; }
                else if (cb < AO_QI) { bdst = VB; bld = 256; bc = cb - AO_V; odst0 = out + O_VP + (size_t)ai_ * MP * 256 + bc; odst1 = out + O_VS + (size_t)ai_ * MS * 256 + bc; old_ = 256; }
                else if (cb < AO_KI) { bdst = QIB; bld = 512; bc = cb - AO_QI; }
                else if (cb < AO_WI) { bdst = KIB; bld = -1; bc = cb - AO_KI;     odst0 = out + O_KIP + (size_t)ai_ * MP * 64 + bc; odst1 = out + O_KIS + (size_t)ai_ * MS * 64 + bc; old_ = 64; }
                else { bdst = nullptr; bld = 0; bc = 0; }
#pragma unroll
                for (int ai = 0; ai < 2; ++ai)
#pragma unroll
                    for (int m = 0; m < 4; ++m) { const int row = row0 + ai * HALF + m * 16; const f32x4 v = acc[ai][bj][m][n] * rsv[ai][m]; *(f32x4*)(P + (size_t)row * ldc + cb + 4 * fq) = v;
                        if (bdst != nullptr && row < MT) { bf16_t* bp_ = bld >= 0 ? bdst + (size_t)row * bld + bc + 4 * fq : bdst + (size_t)(row >> 4) * 1024 + FRAG_OFF(row & 15, bc + 4 * fq, 2); *(uint2*)bp_ = make_uint2(cvt_pk_bf16(v[0], v[1]), cvt_pk_bf16(v[2], v[3]));
                            if (odst0 != nullptr) { float* op = row < MP ? odst0 + (size_t)row * old_ : odst1 + (size_t)(row - MP) * old_; *(f32x4*)(op + 4 * fq) = v; } } } }
    }
};
}

constexpr int NTHREADS = 512, LDS_BYTES = 147456, LDS_MISC = 131072;
typedef float f32x4_t __attribute__((ext_vector_type(4)));
__device__ __forceinline__ float shfl_xor_l(float v, int o, int lane) { return __builtin_bit_cast(float, __builtin_amdgcn_ds_bpermute((lane ^ o) << 2, __builtin_bit_cast(int, v))); }
__device__ __forceinline__ void ph_rmsnorm(const Args& a, const float* g) {
    static_assert(D == 1024, "device rmsnorm is written for D = 1024");
    const float* X = (const float*)(a.ws + WS_X); bf16* XN = (bf16*)(a.ws + WS_XN);
    int tx_ = TID(); asm volatile("" : "+v"(tx_));
    const int lane = tx_ & 63, wv = blockIdx.x * (NTHREADS >> 6) + (tx_ >> 6), nwv = gridDim.x * (NTHREADS >> 6);
    f32x4_t gv[4];
#pragma unroll
    for (int i = 0; i < 4; ++i) gv[i] = *(const f32x4_t*)(g + (i * 64 + lane) * 4);
    for (int m = wv; m < MPAD; m += nwv) { f32x4_t xv[4]; float ss = 0.f;
#pragma unroll
        for (int i = 0; i < 4; ++i) { xv[i] = *(const f32x4_t*)(X + (size_t)m * D + (i * 64 + lane) * 4); ss += xv[i][0] * xv[i][0] + xv[i][1] * xv[i][1] + xv[i][2] * xv[i][2] + xv[i][3] * xv[i][3]; }
#pragma unroll
        for (int o = 32; o >= 1; o >>= 1) ss += shfl_xor_l(ss, o, lane);
        const float r = FRSQ(ss * (1.0f / D) + EPS);
#pragma unroll
        for (int i = 0; i < 4; ++i) { const f32x4_t y = xv[i] * r * gv[i]; uint2 w; w.x = pg8::cvt_pk_bf16(y[0], y[1]); w.y = pg8::cvt_pk_bf16(y[2], y[3]); *(uint2*)(XN + (size_t)m * D + (i * 64 + lane) * 4) = w; } }
}

__device__ __forceinline__ void ph_prep_x(const Args& a) {
    float* X = (float*)(a.ws + WS_X); bf16* XB = (bf16*)(a.ws + WS_XN); unsigned long long* SS = (unsigned long long*)(a.ws + WS_SS);
    int tx_ = TID(); asm volatile("" : "+v"(tx_));
    const int lane = tx_ & 63, wv = blockIdx.x * (NTHREADS >> 6) + (tx_ >> 6), nwv = gridDim.x * (NTHREADS >> 6);
    for (int m = wv; m < MPAD; m += nwv) { const float* src = m < MP ? a.in[I_XP] + (size_t)m * D : a.in[I_XS] + (size_t)(m - MP) * D; float ss = 0.f;
#pragma unroll
        for (int i = 0; i < 4; ++i) { f32x4_t v = {0.f, 0.f, 0.f, 0.f}; if (m < MT) v = *(const f32x4_t*)(src + (i * 64 + lane) * 4);
            *(f32x4_t*)(X + (size_t)m * D + (i * 64 + lane) * 4) = v; ss += v[0] * v[0] + v[1] * v[1] + v[2] * v[2] + v[3] * v[3];
            uint2 w; w.x = pg8::cvt_pk_bf16(v[0], v[1]); w.y = pg8::cvt_pk_bf16(v[2], v[3]); *(uint2*)(XB + (size_t)m * D + (i * 64 + lane) * 4) = w; }
#pragma unroll
        for (int o = 32; o >= 1; o >>= 1) ss += shfl_xor_l(ss, o, lane);
        if (lane == 0) SS[m] = (unsigned long long)(ss * 16777216.0f); }
}
__device__ __forceinline__ void ph_final(const Args& a) {
    const float* X = (const float*)(a.ws + WS_X); const float* g = a.in[I_NFIN];
    int tx_ = TID(); asm volatile("" : "+v"(tx_));
    const int lane = tx_ & 63, wv = blockIdx.x * (NTHREADS >> 6) + (tx_ >> 6), nwv = gridDim.x * (NTHREADS >> 6);
    f32x4_t gv[4];
#pragma unroll
    for (int i = 0; i < 4; ++i) gv[i] = *(const f32x4_t*)(g + (i * 64 + lane) * 4);
    for (int m = wv; m < MT; m += nwv) { f32x4_t xv[4]; float ss = 0.f;
#pragma unroll
        for (int i = 0; i < 4; ++i) { xv[i] = *(const f32x4_t*)(X + (size_t)m * D + (i * 64 + lane) * 4); ss += xv[i][0] * xv[i][0] + xv[i][1] * xv[i][1] + xv[i][2] * xv[i][2] + xv[i][3] * xv[i][3]; }
#pragma unroll
        for (int o = 32; o >= 1; o >>= 1) ss += shfl_xor_l(ss, o, lane);
        const float r = FRSQ(ss * (1.0f / D) + EPS);
        float* orow = a.out + (m < MP ? O_YP + (size_t)m * D : O_YS + (size_t)(m - MP) * D);
#pragma unroll
        for (int i = 0; i < 4; ++i) *(f32x4_t*)(orow + (i * 64 + lane) * 4) = xv[i] * r * gv[i]; }
}


#ifndef DIAG_WRITE_O
#define DIAG_WRITE_O 1
#define DIAG_WRITE_S 1
#endif
typedef short bf16x8_t __attribute__((ext_vector_type(8)));
typedef unsigned u32x2_t __attribute__((ext_vector_type(2)));
typedef unsigned u32x4_t __attribute__((ext_vector_type(4)));
typedef float f32x2_t __attribute__((ext_vector_type(2)));
typedef __bf16 bf16x2n_t __attribute__((ext_vector_type(2)));
__device__ __forceinline__ unsigned pk_bf16(float lo, float hi) { const f32x2_t v = {lo, hi}; const bf16x2n_t r = __builtin_convertvector(v, bf16x2n_t); return __builtin_bit_cast(unsigned, r); }
__device__ __forceinline__ void ph_dn_b(const Args& a, int r, LAS unsigned char* lds) {
    const float* UT = (const float*)(a.ws + WS_UT); const bf16* WN = (const bf16*)(a.ws + WS_WN); const bf16* QG = (const bf16*)(a.ws + WS_QG); const bf16* AT = (const bf16*)(a.ws + WS_AT);
    const bf16* KDT = (const bf16*)(a.ws + WS_KDT); const float* GL = (const float*)(a.ws + WS_GL); float* ODN = (float*)(a.ws + WS_ODN); float* DUMP = (float*)(a.ws + WS_SCR);
    int tid_ = TID(); asm volatile("" : "+v"(tid_));
    const int tid = tid_, wid = __builtin_amdgcn_readfirstlane(tid >> 6), lane = tid & 63, fr = lane & 15, fq = lane >> 4;
    constexpr int STS = 136, VTS = 72;
    LAS bf16* ST = (LAS bf16*)lds; LAS bf16* VT = (LAS bf16*)(lds + 16 * STS * 2);
    const bool vw = wid < 4; const float uf = vw ? 1.0f : 0.0f;
    for (int unit = blockIdx.x; unit < NB * DNH * 8; unit += gridDim.x) {
        const int slice = unit & 7, bh = unit >> 3, b = bh / DNH, hd = bh % DNH, c0 = slice * 16;
        f32x4_t accS = {0.f, 0.f, 0.f, 0.f};
        for (int i = tid; i < 16 * STS; i += NTHREADS) ST[i] = (bf16)0;
        __syncthreads();
        const int i0 = (wid & 3) * 16;
        const bf16* p1 = (vw ? WN : QG) + (size_t)bh * NC * 8192 + (size_t)((wid & 3) * 4) * 512 + lane * 8;
        const bf16* p2 = AT + (size_t)bh * NC * 4096 + (size_t)((wid & 3) * 2) * 512 + lane * 8;
        const bf16* p3 = KDT + (size_t)bh * NC * 8192 + (size_t)(wid * 2) * 512 + lane * 8;
        const float* pu = UT + (size_t)bh * NC * 8192 + (size_t)(slice * 4 + (wid & 3)) * 256 + lane * 4; const float* pg = GL + (size_t)bh * NC;
        LAS bf16* vtw = VT + (vw ? 0 : 16 * VTS) + fr * VTS + i0 + 4 * fq;
        float* op = (vw ? DUMP + ((size_t)blockIdx.x * NTHREADS + tid) * 4 - (size_t)0 : ODN + ((size_t)b * SEQ + i0 + 4 * fq) * 512 + hd * 128 + c0 + fr);
        const size_t ostep = vw ? 0 : (size_t)64 * 512, oq = vw ? 1 : 512;
        bf16x8_t s0a1[4], s0a2[2], s0a3[2], s1a1[4], s1a2[2], s1a3[2], s2a1[4], s2a2[2], s2a3[2]; f32x4_t s0u, s1u, s2u; float s0g, s1g, s2g;
#define DNB_LOAD(P_, n_) do { const size_t c_ = (size_t)((n_) < NC ? (n_) : NC - 1); \
            _Pragma("unroll") for (int ks = 0; ks < 4; ++ks) P_##a1[ks] = *(const bf16x8_t*)(p1 + c_ * 8192 + ks * 512); \
            _Pragma("unroll") for (int ks = 0; ks < 2; ++ks) { P_##a2[ks] = *(const bf16x8_t*)(p2 + c_ * 4096 + ks * 512); P_##a3[ks] = *(const bf16x8_t*)(p3 + c_ * 8192 + ks * 512); } \
            P_##u = *(const f32x4_t*)(pu + c_ * 8192); P_##g = pg[c_]; } while (0)
#define DNB_BAR() do { asm volatile("s_waitcnt lgkmcnt(0)" ::: "memory"); __builtin_amdgcn_s_barrier(); asm volatile("" ::: "memory"); } while (0)
#define DNB_STEP(C_, L_, n_) do { f32x4_t acc = C_##u * uf; const float gl = C_##g; bf16x8_t x1[4], x2[2], x3[2]; \
            _Pragma("unroll") for (int ks = 0; ks < 4; ++ks) x1[ks] = C_##a1[ks]; \
            _Pragma("unroll") for (int ks = 0; ks < 2; ++ks) { x2[ks] = C_##a2[ks]; x3[ks] = C_##a3[ks]; } \
            DNB_LOAD(L_, (n_) + 2); \
            bf16x8_t bS[4]; \
            _Pragma("unroll") for (int ks = 0; ks < 4; ++ks) bS[ks] = *(const LAS bf16x8_t*)(ST + fr * STS + ks * 32 + fq * 8); \
            _Pragma("unroll") for (int ks = 0; ks < 4; ++ks) acc = __builtin_amdgcn_mfma_f32_16x16x32_bf16(x1[ks], bS[ks], acc, 0, 0, 0); \
            { u32x2_t w; w.x = pk_bf16(acc[0], acc[1]); w.y = pk_bf16(acc[2], acc[3]); *(LAS u32x2_t*)vtw = w; } \
            DNB_BAR(); \
            bf16x8_t bV[2]; \
            _Pragma("unroll") for (int ks = 0; ks < 2; ++ks) bV[ks] = *(const LAS bf16x8_t*)(VT + fr * VTS + ks * 32 + fq * 8); \
            _Pragma("unroll") for (int ks = 0; ks < 2; ++ks) acc = __builtin_amdgcn_mfma_f32_16x16x32_bf16(x2[ks], bV[ks], acc, 0, 0, 0); \
            { float* o_ = op + (size_t)(n_) * ostep; _Pragma("unroll") for (int q = 0; q < 4; ++q) o_[(size_t)q * oq] = acc[q]; } \
            accS = accS * gl; \
            _Pragma("unroll") for (int ks = 0; ks < 2; ++ks) accS = __builtin_amdgcn_mfma_f32_16x16x32_bf16(x3[ks], bV[ks], accS, 0, 0, 0); \
            { u32x2_t w; w.x = pk_bf16(accS[0], accS[1]); w.y = pk_bf16(accS[2], accS[3]); *(LAS u32x2_t*)(ST + fr * STS + wid * 16 + 4 * fq) = w; } \
            DNB_BAR(); } while (0)
        static_assert(NC % 3 == 2, "the chunk loop is peeled for NC = 3 k + 2");
        DNB_LOAD(s0, 0); DNB_LOAD(s1, 1);
        int n = 0;
        for (; n + 2 < NC; n += 3) { DNB_STEP(s0, s2, n); DNB_STEP(s1, s0, n + 1); DNB_STEP(s2, s1, n + 2); }
        DNB_STEP(s0, s2, n); DNB_STEP(s1, s0, n + 1);
#undef DNB_STEP
#undef DNB_LOAD
        float* sp = a.out + O_SP + ((((size_t)r * NB + b) * DNH + hd) * 128 + wid * 16 + 4 * fq) * 128 + c0 + fr;
#pragma unroll
        for (int q = 0; q < 4; ++q) sp[(size_t)q * 128] = accS[q];
        __syncthreads();
    }
}


template <int NREG> __device__ __forceinline__ void select_row(const float* __restrict__ row, int n, int K, int* __restrict__ out, unsigned lane, LAS unsigned* cand_lds) {
    static_assert(NREG * 64 <= SLD, "row buffer too short");
    lane &= 63u;
    unsigned key[NREG];
#pragma unroll
    for (int i = 0; i < NREG; ++i) { const float f = __builtin_nontemporal_load(row + i * 64u + lane); key[i] = fkey(f) & (0u - ((unsigned)((int)(i * 64u + lane) - n) >> 31)); }
    if (NREG >= 32 && NREG <= 128 && n >= 1024) { unsigned ls = 0u;
        for (int bit = 31; bit >= 0; --bit) { const unsigned cand = ls | (1u << bit); int c = 0;
#pragma unroll
            for (int i = 0; i < NREG; i += 8) c += __builtin_popcountll(__ballot(key[i] >= cand));
            if (c >= 48) ls = cand;
            if (c == 48) break; }
        int c0 = 0;
#pragma unroll
        for (int i = 0; i < NREG; ++i) c0 += __builtin_popcountll(__ballot(key[i] >= ls));
        if (c0 >= K && c0 <= 512) {
            asm volatile("" : "+v"(lane)); lane &= 63u; const unsigned long long bl = (1ull << lane) - 1ull; int base = 0;
            unsigned ls2 = ls; asm volatile("" : "+v"(ls2));
#pragma unroll
            for (int i = 0; i < NREG; ++i) { const bool g = key[i] >= ls2; const unsigned long long mg = __ballot(g);
                const int p = base + __builtin_popcountll(mg & bl); cand_lds[g ? (unsigned)p : 1024u + lane] = key[i]; cand_lds[g ? 512u + p : 1088u + lane] = i * 64u + lane;
                base += __builtin_popcountll(mg); }
            asm volatile("s_waitcnt lgkmcnt(0)" ::: "memory");
            unsigned ck[8], ci[8];
#pragma unroll
            for (int q = 0; q < 8; ++q) { const int p = q * 64 + (int)lane; const bool v = p < c0; ck[q] = v ? cand_lds[p] : 0u; ci[q] = v ? cand_lds[512 + p] : 0u; }
            unsigned lo2 = 0u;
            for (int bit = 31; bit >= 0; --bit) { const unsigned cand = lo2 | (1u << bit); int c = 0;
#pragma unroll
                for (int q = 0; q < 8; ++q) c += __builtin_popcountll(__ballot(ck[q] >= cand));
                if (c >= K) lo2 = cand;
                if (c == K) break; }
            int bg2 = 0;
#pragma unroll
            for (int q = 0; q < 8; ++q) { const bool g = ck[q] > lo2; const unsigned long long mg = __ballot(g);
                out[g ? (unsigned)(bg2 + __builtin_popcountll(mg & bl)) : KMAX + lane] = (int)ci[q]; bg2 += __builtin_popcountll(mg); }
            int be2 = 0;
#pragma unroll
            for (int q = 0; q < 8; ++q) { const bool e = ck[q] == lo2; const unsigned long long me = __ballot(e); const int slot = bg2 + be2 + __builtin_popcountll(me & bl);
                out[(e && slot < K) ? (unsigned)slot : KMAX + lane] = (int)ci[q]; be2 += __builtin_popcountll(me); }
            asm volatile("s_waitcnt lgkmcnt(0)" ::: "memory");
            return; } }
    unsigned lo = 0u;
    for (int bit = 31; bit >= 0; --bit) { const unsigned cand = lo | (1u << bit); int c = 0;
#pragma unroll
        for (int i = 0; i < NREG; ++i) c += __builtin_popcountll(__ballot(key[i] >= cand));
        if (c >= K) lo = cand;
        if (c == K) break; }
    asm volatile("" : "+v"(lane)); lane &= 63u;
    const unsigned long long below = (1ull << lane) - 1ull; int bg = 0;
#pragma unroll
    for (int i = 0; i < NREG; ++i) { const bool g = key[i] > lo; const unsigned long long mg = __ballot(g);
        out[g ? (unsigned)(bg + __builtin_popcountll(mg & below)) : KMAX + lane] = (int)(i * 64u + lane); bg += __builtin_popcountll(mg); }
    const int cg = bg; int be = 0; asm volatile("" : "+v"(lane)); lane &= 63u; const unsigned long long below2 = (1ull << lane) - 1ull;
#pragma unroll
    for (int i = 0; i < NREG; ++i) { const bool e = key[i] == lo; const unsigned long long me = __ballot(e); const int slot = cg + be + __builtin_popcountll(me & below2);
        out[(e && slot < K) ? (unsigned)slot : KMAX + lane] = (int)(i * 64u + lane); be += __builtin_popcountll(me); }
}
__device__ __forceinline__ void ph_select_w(const Args& a, LAS unsigned char* lds) {
    const float* SC = (const float*)(a.ws + WS_SCT); int* IDX = (int*)(a.ws + WS_IDX); int* NSEL = (int*)(a.ws + WS_NSEL);
    int tx_ = TID(); asm volatile("" : "+v"(tx_));
    const int lane0 = tx_ & 63, wv = __builtin_amdgcn_readfirstlane(blockIdx.x * (NTHREADS >> 6) + (tx_ >> 6)), nwv = gridDim.x * (NTHREADS >> 6);
    LAS unsigned* cand = (LAS unsigned*)(lds + (tx_ >> 6) * 4608);
    for (int m = MP + wv; m < MT; m += nwv) { const RowInfo ri = row_info(m); int lane = lane0; asm volatile("" : "+v"(lane));
        const int n = PAST + ri.t + 1, K = TOPK_S; const float* row = SC + (size_t)m * SLD; int* out = IDX + (size_t)m * KROW;
        if (n <= K) { for (int j = lane; j < n; j += 64) out[j] = j; if (lane == 0) NSEL[m] = n; continue; }
        select_row<(SLD / 64)>(row, n, K, out, lane, cand);
        if (lane == 0) NSEL[m] = K; }
}


__device__ __forceinline__ void ph_att_split_dev(const Args& a, int ai, size_t gtid, size_t gsz) {
    const float* P = (const float*)(a.ws + WS_P); bf16* QB = (bf16*)(a.ws + WS_XN); bf16* KB = (bf16*)(a.ws + WS_KB); bf16* VB = (bf16*)(a.ws + WS_VB); bf16* QIB = (bf16*)(a.ws + WS_QIB); bf16* KIB = (bf16*)(a.ws + WS_KIB);
    constexpr int W = AO_WI;
    for (size_t i = gtid; i < (size_t)MT * W; i += gsz) { const int m = (int)(i / W), c = (int)(i % W); const float v = P[(size_t)m * LDP + c];
        if (c < AO_K) QB[(size_t)m * D + c] = f2bf(v);
        else if (c < AO_V) { const int cc = c - AO_K; KB[(size_t)m * 256 + cc] = f2bf(v); if (m < MP) a.out[O_KP + ((size_t)ai * MP + m) * 256 + cc] = v; else a.out[O_KS + ((size_t)ai * MS + (m - MP)) * 256 + cc] = v; }
        else if (c < AO_QI) { const int cc = c - AO_V; VB[(size_t)m * 256 + cc] = f2bf(v); if (m < MP) a.out[O_VP + ((size_t)ai * MP + m) * 256 + cc] = v; else a.out[O_VS + ((size_t)ai * MS + (m - MP)) * 256 + cc] = v; }
        else if (c < AO_KI) QIB[(size_t)m * 512 + (c - AO_QI)] = f2bf(v);
        else { const int cc = c - AO_KI; KIB[(size_t)m * 64 + cc] = f2bf(v); if (m < MP) a.out[O_KIP + ((size_t)ai * MP + m) * 64 + cc] = v; else a.out[O_KIS + ((size_t)ai * MS + (m - MP)) * 64 + cc] = v; } }
}
__device__ __forceinline__ void ph_idx_mfma(const Args& a, LAS unsigned char* lds) {
    const float* P = (const float*)(a.ws + WS_P); const bf16* QIB = (const bf16*)(a.ws + WS_QIB); const bf16* KIB = (const bf16*)(a.ws + WS_KIB); float* SC = (float*)(a.ws + WS_SCT); int* IDX = (int*)(a.ws + WS_IDX); int* NSEL = (int*)(a.ws + WS_NSEL);
    int tx_ = TID(); asm volatile("" : "+v"(tx_));
    const int lane = tx_ & 63, fr = lane & 15, fq = lane >> 4, wv = __builtin_amdgcn_readfirstlane(blockIdx.x * (NTHREADS >> 6) + (tx_ >> 6)), nwv = gridDim.x * (NTHREADS >> 6);
    constexpr int NU = MP / 4;
    for (int pr2 = wv * 2; pr2 < NU; pr2 += nwv * 2) for (int u0 = pr2; u0 < pr2 + 2; ++u0) { const int hh = u0 >> 1, u = (u0 & 1) ? (NU - 1 - hh) : hh;
        const int m0 = u * 4, b = m0 / SEQ, t0 = m0 % SEQ;
        int lnu = lane; asm volatile("" : "+v"(lnu)); const int fr = lnu & 15, fq = (lnu >> 4) & 3;
        bf16x8_t aQ[2][2];
#pragma unroll
        for (int p = 0; p < 2; ++p)
#pragma unroll
            for (int ks = 0; ks < 2; ++ks) aQ[p][ks] = *(const bf16x8_t*)(QIB + (size_t)(m0 + (fr >> 2)) * 512 + (4 * p + (fr & 3)) * 64 + ks * 32 + fq * 8);
        const f32x4_t w0 = *(const f32x4_t*)(P + (size_t)(m0 + fq) * LDP + AO_WI), w1 = *(const f32x4_t*)(P + (size_t)(m0 + fq) * LDP + AO_WI + 4);
        float* scrow = SC + (size_t)(m0 + fq) * SLD + fr;
        const int nkt = (t0 + 3) / 16 + 1;
        bf16x8_t bKa[4][2], bKb[4][2];
#define IDX_LOAD(B_, kt0_) do { _Pragma("unroll") for (int q = 0; q < 4; ++q) { const int kt = (kt0_) + q < nkt ? (kt0_) + q : nkt - 1; const bf16* kr = KIB + ((size_t)b * (SEQ / 16) + kt) * 1024 + lnu * 8; \
            B_[q][0] = *(const bf16x8_t*)kr; B_[q][1] = *(const bf16x8_t*)(kr + 512); } } while (0)
#define IDX_COMP(B_, kt0_) do { _Pragma("unroll") for (int q = 0; q < 4; ++q) { if ((kt0_) + q < nkt) { f32x4_t c0 = {0.f, 0.f, 0.f, 0.f}, c1 = {0.f, 0.f, 0.f, 0.f}; \
                    c0 = __builtin_amdgcn_mfma_f32_16x16x32_bf16(aQ[0][0], B_[q][0], c0, 0, 0, 0); c0 = __builtin_amdgcn_mfma_f32_16x16x32_bf16(aQ[0][1], B_[q][1], c0, 0, 0, 0); \
                    c1 = __builtin_amdgcn_mfma_f32_16x16x32_bf16(aQ[1][0], B_[q][0], c1, 0, 0, 0); c1 = __builtin_amdgcn_mfma_f32_16x16x32_bf16(aQ[1][1], B_[q][1], c1, 0, 0, 0); \
                    __builtin_nontemporal_store((w0[0] * fmaxf(c0[0], 0.f) + w0[1] * fmaxf(c0[1], 0.f)) + (w0[2] * fmaxf(c0[2], 0.f) + w0[3] * fmaxf(c0[3], 0.f)) \
                                             + (w1[0] * fmaxf(c1[0], 0.f) + w1[1] * fmaxf(c1[1], 0.f)) + (w1[2] * fmaxf(c1[2], 0.f) + w1[3] * fmaxf(c1[3], 0.f)), scrow + ((kt0_) + q) * 16); } } } while (0)
        IDX_LOAD(bKa, 0);
        for (int kt0 = 0; kt0 < nkt; kt0 += 8) { IDX_LOAD(bKb, kt0 + 4); IDX_COMP(bKa, kt0); IDX_LOAD(bKa, kt0 + 8); IDX_COMP(bKb, kt0 + 4); }
#undef IDX_LOAD
#undef IDX_COMP
        LAS unsigned* cand = (LAS unsigned*)(lds + (tx_ >> 6) * 4608);
        for (int q = 0; q < 4; ++q) { const int m = m0 + q, n = t0 + q + 1, K = TOPK_P; int ln = lane; asm volatile("" : "+v"(ln));
            const float* row = SC + (size_t)m * SLD; int* out = IDX + (size_t)m * KROW;
            if (n <= K) { for (int j = ln; j < n; j += 64) out[j] = j; if (ln == 0) NSEL[m] = n; continue; }
            if (n <= 2048) select_row<32>(row, n, K, out, ln, cand);
            else if (n <= 4096) select_row<64>(row, n, K, out, ln, cand);
            else if (n <= 6144) select_row<96>(row, n, K, out, ln, cand);
            else select_row<128>(row, n, K, out, ln, cand);
            if (ln == 0) NSEL[m] = K; }
    }
}
__device__ __forceinline__ void ph_idx_sample_mfma(const Args& a, int ai) {
    const float* P = (const float*)(a.ws + WS_P); const bf16* QIB = (const bf16*)(a.ws + WS_QIB); float* SC = (float*)(a.ws + WS_SCT); const int* PT = (const int*)a.in[I_PT]; const float* CKI = a.in[I_CKI];
    int tx_ = TID(); asm volatile("" : "+v"(tx_));
    const int lane = tx_ & 63, fr = lane & 15, fq = lane >> 4, wv = __builtin_amdgcn_readfirstlane(blockIdx.x * (NTHREADS >> 6) + (tx_ >> 6)), nwv = gridDim.x * (NTHREADS >> 6);
    constexpr int NKT = (PAST + DT + 15) / 16, SPL = 64, TPU = (NKT + SPL - 1) / SPL;
    static_assert(PAGE % 16 == 0 && PAST % 16 == 0 && DT <= 16, "sample index tiles");
    for (int u = wv; u < DB * SPL; u += nwv) { const int db = u / SPL, k0 = (u % SPL) * TPU, k1 = (k0 + TPU < NKT) ? k0 + TPU : NKT; const int m0 = MP + db * DT;
        if (k0 >= k1) continue;
        bf16x8_t aQ[2][2];
#pragma unroll
        for (int p = 0; p < 2; ++p)
#pragma unroll
            for (int ks = 0; ks < 2; ++ks) aQ[p][ks] = *(const bf16x8_t*)(QIB + (size_t)(m0 + (fr >> 2)) * 512 + (4 * p + (fr & 3)) * 64 + ks * 32 + fq * 8);
        const f32x4_t w0 = *(const f32x4_t*)(P + (size_t)(m0 + fq) * LDP + AO_WI), w1 = *(const f32x4_t*)(P + (size_t)(m0 + fq) * LDP + AO_WI + 4);
        float* scrow = SC + (size_t)(m0 + fq) * SLD + fr;
        for (int kb = k0; kb < k1; kb += 3) { f32x4_t kf[3][4];
#pragma unroll
            for (int q = 0; q < 3; ++q) { const int kt = kb + q < k1 ? kb + q : k1 - 1, s0 = kt * 16; const float* kr;
                if (s0 < PAST) { const int pg = PT[db * NPAGES + s0 / PAGE]; kr = CKI + (((size_t)ai * NPOOL + pg) * PAGE + (s0 % PAGE) + fr) * IDIM + fq * 8; }
                else kr = P + (size_t)(m0 + (fr < DT ? fr : DT - 1)) * LDP + AO_KI + fq * 8;
                kf[q][0] = *(const f32x4_t*)kr; kf[q][1] = *(const f32x4_t*)(kr + 4); kf[q][2] = *(const f32x4_t*)(kr + 32); kf[q][3] = *(const f32x4_t*)(kr + 36); }
#pragma unroll
            for (int q = 0; q < 3; ++q) { if (kb + q < k1) { const int s0 = (kb + q) * 16; u32x4_t b0, b1;
                b0[0] = pk_bf16(kf[q][0][0], kf[q][0][1]); b0[1] = pk_bf16(kf[q][0][2], kf[q][0][3]); b0[2] = pk_bf16(kf[q][1][0], kf[q][1][1]); b0[3] = pk_bf16(kf[q][1][2], kf[q][1][3]);
                b1[0] = pk_bf16(kf[q][2][0], kf[q][2][1]); b1[1] = pk_bf16(kf[q][2][2], kf[q][2][3]); b1[2] = pk_bf16(kf[q][3][0], kf[q][3][1]); b1[3] = pk_bf16(kf[q][3][2], kf[q][3][3]);
                const bf16x8_t bK0 = __builtin_bit_cast(bf16x8_t, b0), bK1 = __builtin_bit_cast(bf16x8_t, b1);
                f32x4_t c0 = {0.f, 0.f, 0.f, 0.f}, c1 = {0.f, 0.f, 0.f, 0.f};
                c0 = __builtin_amdgcn_mfma_f32_16x16x32_bf16(aQ[0][0], bK0, c0, 0, 0, 0); c0 = __builtin_amdgcn_mfma_f32_16x16x32_bf16(aQ[0][1], bK1, c0, 0, 0, 0);
                c1 = __builtin_amdgcn_mfma_f32_16x16x32_bf16(aQ[1][0], bK0, c1, 0, 0, 0); c1 = __builtin_amdgcn_mfma_f32_16x16x32_bf16(aQ[1][1], bK1, c1, 0, 0, 0);
                scrow[s0] = (w0[0] * fmaxf(c0[0], 0.f) + w0[1] * fmaxf(c0[1], 0.f)) + (w0[2] * fmaxf(c0[2], 0.f) + w0[3] * fmaxf(c0[3], 0.f))
                          + (w1[0] * fmaxf(c1[0], 0.f) + w1[1] * fmaxf(c1[1], 0.f)) + (w1[2] * fmaxf(c1[2], 0.f) + w1[3] * fmaxf(c1[3], 0.f)); } } } }
}

__device__ __forceinline__ void ph_sparse_attn(const Args& a, LAS unsigned char* lds) {
    const bf16* QB = (const bf16*)(a.ws + WS_QB); const bf16* KB = (const bf16*)(a.ws + WS_KB); const bf16* VB = (const bf16*)(a.ws + WS_VB); const int* IDX = (const int*)(a.ws + WS_IDX); const int* NSEL = (const int*)(a.ws + WS_NSEL);
    bf16* O = (bf16*)(a.ws + WS_Y2);
    int tx_ = TID(); asm volatile("" : "+v"(tx_));
    const int lane = tx_ & 63, fr = lane & 15, fq = lane >> 4, wid = __builtin_amdgcn_readfirstlane(tx_ >> 6), wv = blockIdx.x * (NTHREADS >> 6) + wid, nwv = gridDim.x * (NTHREADS >> 6);
    LAS int* IDXS = (LAS int*)(lds + wid * 9216); LAS float* PS = (LAS float*)(lds + wid * 9216 + 1024);
    for (int m = wv; m < MP; m += nwv) { const int b = m / SEQ; const int ns = __builtin_amdgcn_readfirstlane(NSEL[m]);
#pragma unroll
        for (int c = 0; c < 4; ++c) { const int j = lane + 64 * c; IDXS[j] = j < ns ? IDX[(size_t)m * KROW + j] : 0; }
        bf16x8_t bQ[2][4];
#pragma unroll
        for (int kv = 0; kv < 2; ++kv)
#pragma unroll
            for (int ks = 0; ks < 4; ++ks) { bQ[kv][ks] = (bf16x8_t){0, 0, 0, 0, 0, 0, 0, 0}; if (fr < 4) bQ[kv][ks] = *(const bf16x8_t*)(QB + (size_t)m * D + (kv * 4 + fr) * 128 + ks * 32 + fq * 8); }
        asm volatile("s_waitcnt lgkmcnt(0)" ::: "memory");
#pragma unroll
        for (int tb = 0; tb < 16; tb += 2) { bf16x8_t ak[2][2][4];
#pragma unroll
            for (int t = 0; t < 2; ++t) { const int ri = IDXS[(tb + t) * 16 + fr]; const bf16* kb = KB + (size_t)(b * SEQ + ri) * 256 + fq * 8;
#pragma unroll
                for (int kv = 0; kv < 2; ++kv)
#pragma unroll
                    for (int ks = 0; ks < 4; ++ks) ak[t][kv][ks] = *(const bf16x8_t*)(kb + kv * 128 + ks * 32); }
#pragma unroll
            for (int t = 0; t < 2; ++t)
#pragma unroll
                for (int kv = 0; kv < 2; ++kv) { f32x4_t acc = {0.f, 0.f, 0.f, 0.f};
#pragma unroll
                    for (int ks = 0; ks < 4; ++ks) acc = __builtin_amdgcn_mfma_f32_16x16x32_bf16(ak[t][kv][ks], bQ[kv][ks], acc, 0, 0, 0);
                    if (fr < 4) {
#pragma unroll
                        for (int q = 0; q < 4; ++q) { const int j = (tb + t) * 16 + 4 * fq + q; PS[j * 8 + kv * 4 + fr] = j < ns ? acc[q] * 0.08838834764831845f : -1e30f; } } } }
        asm volatile("s_waitcnt lgkmcnt(0)" ::: "memory");
        { f32x4_t sv[4][2]; float mx[8];
#pragma unroll
            for (int h = 0; h < 8; ++h) mx[h] = -3e38f;
#pragma unroll
            for (int c = 0; c < 4; ++c) { sv[c][0] = *(const LAS f32x4_t*)(PS + (lane + 64 * c) * 8); sv[c][1] = *(const LAS f32x4_t*)(PS + (lane + 64 * c) * 8 + 4);
#pragma unroll
                for (int h = 0; h < 8; ++h) mx[h] = fmaxf(mx[h], sv[c][h >> 2][h & 3]); }
#pragma unroll
            for (int o = 32; o >= 1; o >>= 1)
#pragma unroll
                for (int h = 0; h < 8; ++h) mx[h] = fmaxf(mx[h], shfl_xor_l(mx[h], o, lane));
            float sum[8];
#pragma unroll
            for (int h = 0; h < 8; ++h) sum[h] = 0.f;
#pragma unroll
            for (int c = 0; c < 4; ++c)
#pragma unroll
                for (int h = 0; h < 8; ++h) { const float e = FEXP(sv[c][h >> 2][h & 3] - mx[h]); sv[c][h >> 2][h & 3] = e; sum[h] += e; }
#pragma unroll
            for (int o = 32; o >= 1; o >>= 1)
#pragma unroll
                for (int h = 0; h < 8; ++h) sum[h] += shfl_xor_l(sum[h], o, lane);
#pragma unroll
            for (int h = 0; h < 8; ++h) sum[h] = FRCP(sum[h]);
#pragma unroll
            for (int c = 0; c < 4; ++c) { f32x4_t p0, p1;
#pragma unroll
                for (int h = 0; h < 4; ++h) { p0[h] = sv[c][0][h] * sum[h]; p1[h] = sv[c][1][h] * sum[4 + h]; }
                *(LAS f32x4_t*)(PS + (lane + 64 * c) * 8) = p0; *(LAS f32x4_t*)(PS + (lane + 64 * c) * 8 + 4) = p1; } }
        asm volatile("s_waitcnt lgkmcnt(0)" ::: "memory");
        f32x4_t o4[4] = {{0.f, 0.f, 0.f, 0.f}, {0.f, 0.f, 0.f, 0.f}, {0.f, 0.f, 0.f, 0.f}, {0.f, 0.f, 0.f, 0.f}};
        const int kvl = lane >> 5; const char* vb8 = (const char*)(VB + (size_t)b * SEQ * 256);
        const unsigned loff = (unsigned)(kvl * 128 + (lane & 31) * 4) * 2u;
        for (int j0 = 0; j0 < ns; j0 += 64) { u32x2_t vv[64];
#pragma unroll
            for (int jj = 0; jj < 64; ++jj) { const unsigned off = (unsigned)IDXS[j0 + jj] * 512u + loff; vv[jj] = *(const u32x2_t*)(vb8 + off); }
#pragma unroll
            for (int jj = 0; jj < 64; ++jj) { const f32x4_t p4 = *(const LAS f32x4_t*)(PS + (j0 + jj) * 8 + kvl * 4);
                const f32x4_t vf = {__builtin_bit_cast(float, vv[jj][0] << 16), __builtin_bit_cast(float, vv[jj][0] & 0xffff0000u), __builtin_bit_cast(float, vv[jj][1] << 16), __builtin_bit_cast(float, vv[jj][1] & 0xffff0000u)};
#pragma unroll
                for (int h = 0; h < 4; ++h) o4[h] += vf * p4[h]; } }
#pragma unroll
        for (int h = 0; h < 4; ++h) { u32x2_t w; w[0] = pk_bf16(o4[h][0], o4[h][1]); w[1] = pk_bf16(o4[h][2], o4[h][3]); *(u32x2_t*)(O + (size_t)m * D + (kvl * 4 + h) * 128 + (lane & 31) * 4) = w; }
        asm volatile("s_waitcnt lgkmcnt(0)" ::: "memory");
    }
}

__device__ __forceinline__ void ph_sparse_sample(const Args& a, int ai, LAS unsigned char* lds) {
    const float* P = (const float*)(a.ws + WS_P); const int* IDX = (const int*)(a.ws + WS_IDX); const int* NSEL = (const int*)(a.ws + WS_NSEL); bf16* O = (bf16*)(a.ws + WS_Y2);
    int tx_ = TID(); asm volatile("" : "+v"(tx_));
    const int lane = tx_ & 63, wid = __builtin_amdgcn_readfirstlane(tx_ >> 6), wv = blockIdx.x * (NTHREADS >> 6) + wid, nwv = gridDim.x * (NTHREADS >> 6);
    LAS float* QS = (LAS float*)(lds + wid * 9216); LAS float* PSs = (LAS float*)(lds + wid * 9216 + 512); LAS unsigned long long* VP = (LAS unsigned long long*)(lds + wid * 9216 + 1536);
    for (int u = wv; u < MS * AH; u += nwv) { const int m = MP + u / AH, h = u % AH, kvh = h / GROUP; const RowInfo ri = row_info(m); const int ns = __builtin_amdgcn_readfirstlane(NSEL[m]);
        { const f32x2_t q2 = *(const f32x2_t*)(P + (size_t)m * LDP + h * HDIM + 2 * lane); QS[2 * lane] = q2[0]; QS[2 * lane + 1] = q2[1]; }
        const float* kp[4];
#pragma unroll
        for (int c = 0; c < 4; ++c) { const int j = lane + 64 * c; const int idx = j < ns ? IDX[(size_t)m * KROW + j] : 0; kp[c] = kv_row(a, ai, ri, idx, kvh, false); VP[j] = (unsigned long long)(size_t)kv_row(a, ai, ri, idx, kvh, true); }
        asm volatile("s_waitcnt lgkmcnt(0)" ::: "memory");
        float sc[4] = {0.f, 0.f, 0.f, 0.f};
        for (int d0 = 0; d0 < HDIM; d0 += 16) { f32x4_t kq[4][4];
#pragma unroll
            for (int e = 0; e < 4; ++e)
#pragma unroll
                for (int c = 0; c < 4; ++c) kq[e][c] = *(const f32x4_t*)(kp[c] + d0 + 4 * e);
#pragma unroll
            for (int e = 0; e < 4; ++e) { const f32x4_t q4 = *(const LAS f32x4_t*)(QS + d0 + 4 * e);
#pragma unroll
                for (int c = 0; c < 4; ++c) sc[c] += (kq[e][c][0] * q4[0] + kq[e][c][1] * q4[1]) + (kq[e][c][2] * q4[2] + kq[e][c][3] * q4[3]); } }
        float mx = -3e38f;
#pragma unroll
        for (int c = 0; c < 4; ++c) { sc[c] = (lane + 64 * c) < ns ? sc[c] * 0.08838834764831845f : -1e30f; mx = fmaxf(mx, sc[c]); }
#pragma unroll
        for (int o = 32; o >= 1; o >>= 1) mx = fmaxf(mx, shfl_xor_l(mx, o, lane));
        float sum = 0.f;
#pragma unroll
        for (int c = 0; c < 4; ++c) { sc[c] = FEXP(sc[c] - mx); sum += sc[c]; }
#pragma unroll
        for (int o = 32; o >= 1; o >>= 1) sum += shfl_xor_l(sum, o, lane);
        const float inv = FRCP(sum);
#pragma unroll
        for (int c = 0; c < 4; ++c) PSs[lane + 64 * c] = sc[c] * inv;
        asm volatile("s_waitcnt lgkmcnt(0)" ::: "memory");
        f32x2_t o2 = {0.f, 0.f};
        for (int j0 = 0; j0 < ns; j0 += 16) { f32x2_t vv[16];
#pragma unroll
            for (int jj = 0; jj < 16; ++jj) { const float* vp = (const float*)(size_t)VP[j0 + jj]; vv[jj] = *(const f32x2_t*)(vp + 2 * lane); }
#pragma unroll
            for (int jj = 0; jj < 16; ++jj) o2 += vv[jj] * PSs[j0 + jj]; }
        *(unsigned*)(O + (size_t)m * D + h * HDIM + 2 * lane) = pk_bf16(o2[0], o2[1]);
        asm volatile("s_waitcnt lgkmcnt(0)" ::: "memory");
    }
}

__device__ __forceinline__ void ph_rg_chunk(const Args& a, int r, LAS unsigned char* lds) {
    const float* P = (const float*)(a.ws + WS_P); float* HH = (float*)(a.ws + WS_HH); float* AP = (float*)(a.ws + WS_XR);
    const float* wc = a.in[I_WCONV] + (size_t)r * 4 * CONV_CH; const float* wa = a.in[I_WA] + (size_t)r * RG_HEADS * RG_BW * RG_BW; const float* wx = a.in[I_WX] + (size_t)r * RG_HEADS * RG_BW * RG_BW;
    static_assert(RG_BW == 64 && RG_HEADS == 8, "ph_rg_chunk is written for 8 gate heads of 64 channels");
    int tx_ = TID(); asm volatile("" : "+v"(tx_));
    const int lane = tx_ & 63, wid = __builtin_amdgcn_readfirstlane(tx_ >> 6), wv = blockIdx.x * (NTHREADS >> 6) + wid, nwv = gridDim.x * (NTHREADS >> 6);
    LAS float* XS = (LAS float*)(lds + wid * 16384);
    constexpr int NUP = NB * NC * 8, NU = NUP + DB * 8;
    for (int u = wv; u < NU; u += nwv) { const bool prompt = u < NUP; int hd, row0, T, n = 0, b = 0, db = 0;
        if (prompt) { const int c = u >> 3; hd = u & 7; row0 = c * 64; T = 64; n = c % NC; b = c / NC; } else { const int q = u - NUP; db = q >> 3; hd = q & 7; row0 = MP + db * DT; T = DT; }
        const int ch = hd * 64 + lane;
        const float w0 = wc[ch], w1 = wc[CONV_CH + ch], w2 = wc[2 * CONV_CH + ch], w3 = wc[3 * CONV_CH + ch], bcv = a.in[I_BCONV][(size_t)r * D_RNN + ch];
        float x3 = 0.f, x2 = 0.f, x1 = 0.f;
        if (prompt) { if (n != 0) { x3 = P[(size_t)(row0 - 3) * LDP + ch]; x2 = P[(size_t)(row0 - 2) * LDP + ch]; x1 = P[(size_t)(row0 - 1) * LDP + ch]; } }
        else { const float* sc = a.in[I_SCONV] + ((size_t)r * DB + db) * 3 * CONV_CH + ch; x3 = sc[0]; x2 = sc[CONV_CH]; x1 = sc[2 * CONV_CH]; }
        for (int tb = 0; tb < T; tb += 16) { float ub[16];
#pragma unroll
            for (int q = 0; q < 16; ++q) ub[q] = P[(size_t)(row0 + (tb + q < T ? tb + q : T - 1)) * LDP + ch];
#pragma unroll
            for (int q = 0; q < 16; ++q) { const int t = tb + q; if (t < T) { const float ut = ub[q]; XS[t * 64 + lane] = w3 * ut + w2 * x1 + w1 * x2 + w0 * x3 + bcv; x3 = x2; x2 = x1; x1 = ut;
                if (prompt) { if (n == NC - 1 && t >= 61) a.out[O_CONVP + (((size_t)r * NB + b) * 3 + (t - 61)) * CONV_CH + ch] = ut; }
                else if (t >= DT - 3) a.out[O_CONVS + (((size_t)r * DB + db) * 3 + (t - (DT - 3))) * CONV_CH + ch] = ut; } } }
        asm volatile("s_waitcnt lgkmcnt(0)" ::: "memory");
        float war[64], wxr[64];
        unsigned ln = (unsigned)lane; asm volatile("" : "+v"(ln)); ln &= 63u;
        const float* wah = wa + (size_t)hd * 4096; const float* wxh = wx + (size_t)hd * 4096;
#pragma unroll
        for (int k = 0; k < 64; ++k) { war[k] = wah[k * 64u + ln]; wxr[k] = wxh[k * 64u + ln]; }
        const float ba = a.in[I_BA][(size_t)r * D_RNN + ch], bx = a.in[I_BX][(size_t)r * D_RNN + ch], sp = softplusf_(-a.in[I_LAM][(size_t)r * D_RNN + ch]);
        float h = 0.f, ap = 1.f;
        for (int t = 0; t < T; ++t) { float pr = 0.f, pi = 0.f;
#pragma unroll
            for (int k = 0; k < 64; k += 4) { const f32x4_t x4 = *(const LAS f32x4_t*)(XS + t * 64 + k);
#pragma unroll
                for (int e = 0; e < 4; ++e) { pr += x4[e] * war[k + e]; pi += x4[e] * wxr[k + e]; } }
            const float rg = sigmoidf_(pr + ba), ig = sigmoidf_(pi + bx), log_a = -8.0f * rg * sp, av = __expf(log_a);
            const bool first = prompt && n == 0 && t == 0; const float mult = first ? 1.0f : FSQRT(fmaxf(1.0f - __expf(2.0f * log_a), 0.0f));
            float bv = XS[t * 64 + lane] * ig * mult; if (!prompt && t == 0) bv += av * a.in[I_SH][((size_t)r * DB + db) * D_RNN + ch];
            h = av * h + bv; ap *= av; const size_t o = (size_t)(row0 + t) * D_RNN + ch; HH[o] = h; AP[o] = ap; }
        if (!prompt) a.out[O_HS + ((size_t)r * DB + db) * D_RNN + ch] = h;
        asm volatile("s_waitcnt lgkmcnt(0)" ::: "memory");
    }
}
__device__ __forceinline__ void ph_dn_tok(const Args& a, int r) {
    const float* P = (const float*)(a.ws + WS_P); float* QKV = (float*)(a.ws + WS_QKV); float* QN = (float*)(a.ws + WS_QN); float* KN = (float*)(a.ws + WS_KN); float* GB = (float*)(a.ws + WS_GB); float* KNT = (float*)(a.ws + WS_KNT);
    const float* wc = a.in[I_WCONV] + (size_t)r * 4 * CONV_CH;
    int tx_ = TID(); asm volatile("" : "+v"(tx_));
    const int lane = tx_ & 63, wv = __builtin_amdgcn_readfirstlane(blockIdx.x * (NTHREADS >> 6) + (tx_ >> 6)), nwv = gridDim.x * (NTHREADS >> 6);
    constexpr int NUP = (MP / 16) * DNH, NU = NUP + DB * DNH;
    static_assert(DT == 4 && SEQ % 64 == 0, "ph_dn_tok run lengths");
    for (int u = wv; u < NU; u += nwv) { const bool prompt = u < NUP; const int hd = prompt ? (u & 3) : ((u - NUP) & 3), m0 = prompt ? (u >> 2) * 16 : MP + ((u - NUP) >> 2) * DT, T = prompt ? 16 : DT;
        const int seq = prompt ? m0 / SEQ : 0, t0 = prompt ? m0 % SEQ : 0, db = prompt ? 0 : (m0 - MP) / DT;
        f32x2_t wk[3][4], h3[3], h2[3], h1[3];
#pragma unroll
        for (int p = 0; p < 3; ++p) { const int c = D_RNN + p * 512 + hd * 128 + 2 * lane;
#pragma unroll
            for (int k = 0; k < 4; ++k) wk[p][k] = *(const f32x2_t*)(wc + (size_t)k * CONV_CH + c);
            h3[p] = h2[p] = h1[p] = (f32x2_t){0.f, 0.f};
            if (prompt) { if (t0 != 0) { h3[p] = *(const f32x2_t*)(P + (size_t)(m0 - 3) * LDP + c); h2[p] = *(const f32x2_t*)(P + (size_t)(m0 - 2) * LDP + c); h1[p] = *(const f32x2_t*)(P + (size_t)(m0 - 1) * LDP + c); } }
            else { const float* sc = a.in[I_SCONV] + ((size_t)r * DB + db) * 3 * CONV_CH + c; h3[p] = *(const f32x2_t*)sc; h2[p] = *(const f32x2_t*)(sc + CONV_CH); h1[p] = *(const f32x2_t*)(sc + 2 * CONV_CH); } }
        float gcum = 0.f;
        if (prompt) { const int tl0 = t0 & 63; float gt = lane < tl0 ? dn_g(a, r, (size_t)(m0 - tl0 + lane), hd) : 0.f;
#pragma unroll
            for (int o2 = 32; o2 >= 1; o2 >>= 1) gt += shfl_xor_l(gt, o2, lane);
            gcum = gt; }
        for (int tb = 0; tb < T; tb += 8) { f32x2_t xin[8][3];
#pragma unroll
            for (int q = 0; q < 8; ++q)
#pragma unroll
                for (int p = 0; p < 3; ++p) xin[q][p] = *(const f32x2_t*)(P + (size_t)(m0 + (tb + q < T ? tb + q : T - 1)) * LDP + D_RNN + p * 512 + hd * 128 + 2 * lane);
#pragma unroll
            for (int q = 0; q < 8; ++q) { const int t = tb + q; if (t < T) { const int m = m0 + t; f32x2_t x[3];
#pragma unroll
                for (int p = 0; p < 3; ++p) { const int c = D_RNN + p * 512 + hd * 128 + 2 * lane; const f32x2_t xv = xin[q][p];
                    const f32x2_t acc = wk[p][0] * h3[p] + wk[p][1] * h2[p] + wk[p][2] * h1[p] + wk[p][3] * xv; h3[p] = h2[p]; h2[p] = h1[p]; h1[p] = xv;
                    x[p][0] = siluf_(acc[0]); x[p][1] = siluf_(acc[1]);
                    if (prompt) { if (t0 + t >= SEQ - 3) *(f32x2_t*)(a.out + O_CONVP + (((size_t)r * NB + seq) * 3 + (t0 + t - (SEQ - 3))) * CONV_CH + c) = xv; }
                    else if (t >= DT - 3) *(f32x2_t*)(a.out + O_CONVS + (((size_t)r * DB + db) * 3 + (t - (DT - 3))) * CONV_CH + c) = xv; }
                float sq = x[0][0] * x[0][0] + x[0][1] * x[0][1], sk = x[1][0] * x[1][0] + x[1][1] * x[1][1];
#pragma unroll
                for (int o = 32; o >= 1; o >>= 1) { sq += shfl_xor_l(sq, o, lane); sk += shfl_xor_l(sk, o, lane); }
                const float rq = FRSQ(sq + EPS) * 0.08838834764831845f, rk = FRSQ(sk + EPS);
                const f32x2_t qn = x[0] * rq, kn = x[1] * rk; const size_t o = (size_t)m * 512 + hd * 128 + 2 * lane;
                *(f32x2_t*)(QN + o) = qn; *(f32x2_t*)(KN + o) = kn; *(f32x2_t*)(QKV + (size_t)m * 1536 + 1024 + hd * 128 + 2 * lane) = x[2];
                const float g = dn_g(a, r, (size_t)m, hd); float gc = g;
                if (prompt) { const int tt = t0 + t, tl = tt & 63; if (tl == 0) gcum = 0.f; gcum += g; gc = gcum;
                    float* kt = KNT + (((size_t)seq * DNH + hd) * NC + tt / 64) * 8192 + (size_t)(2 * lane) * 64 + tl; kt[0] = kn[0]; kt[64] = kn[1]; }
                if (lane == 0) { GB[(size_t)m * 16 + hd * 4] = g; GB[(size_t)m * 16 + hd * 4 + 1] = sigmoidf_(P[(size_t)m * LDP + OFF_B + hd]); GB[(size_t)m * 16 + hd * 4 + 2] = gc; } } } } }
}
__device__ __forceinline__ void ph_rec_out_w(const Args& a, int r) {
    static_assert(D_RNN == 512 && Y2W == 1024, "ph_rec_out_w is written for D_RNN 512");
    const float* P = (const float*)(a.ws + WS_P); const float* HH = (const float*)(a.ws + WS_HH); const float* AP = (const float*)(a.ws + WS_XR); const float* CARRY = (const float*)(a.ws + WS_CARRY);
    const float* ODN = (const float*)(a.ws + WS_ODN); bf16* Y2 = (bf16*)(a.ws + WS_Y2); const float* dnw = a.in[I_DNW] + r * 128;
    int tx_ = TID(); asm volatile("" : "+v"(tx_));
    const int lane = tx_ & 63, wv = __builtin_amdgcn_readfirstlane(blockIdx.x * (NTHREADS >> 6) + (tx_ >> 6)), nwv = gridDim.x * (NTHREADS >> 6);
    const f32x2_t dw = *(const f32x2_t*)(dnw + 2 * lane);
    for (int m = wv; m < MT; m += nwv) {
        { const size_t o = (size_t)m * D_RNN + 8 * lane; f32x4_t h0 = *(const f32x4_t*)(HH + o), h1 = *(const f32x4_t*)(HH + o + 4);
            if (m < MP) { const float* cr = CARRY + (size_t)(m / 64) * D_RNN + 8 * lane; h0 += *(const f32x4_t*)(AP + o) * *(const f32x4_t*)cr; h1 += *(const f32x4_t*)(AP + o + 4) * *(const f32x4_t*)(cr + 4); }
            const float* gp = P + (size_t)m * LDP + OFF_GATE + 8 * lane; const f32x4_t g0 = *(const f32x4_t*)gp, g1 = *(const f32x4_t*)(gp + 4);
            u32x4_t w; w[0] = pk_bf16(h0[0] * gelu_tanhf_(g0[0]), h0[1] * gelu_tanhf_(g0[1])); w[1] = pk_bf16(h0[2] * gelu_tanhf_(g0[2]), h0[3] * gelu_tanhf_(g0[3]));
            w[2] = pk_bf16(h1[0] * gelu_tanhf_(g1[0]), h1[1] * gelu_tanhf_(g1[1])); w[3] = pk_bf16(h1[2] * gelu_tanhf_(g1[2]), h1[3] * gelu_tanhf_(g1[3]));
            *(u32x4_t*)(Y2 + (size_t)m * Y2W + 8 * lane) = w; }
        f32x2_t ov[4]; float ss[4];
#pragma unroll
        for (int hd = 0; hd < 4; ++hd) { ov[hd] = *(const f32x2_t*)(ODN + (size_t)m * 512 + hd * 128 + 2 * lane); ss[hd] = ov[hd][0] * ov[hd][0] + ov[hd][1] * ov[hd][1]; }
#pragma unroll
        for (int o = 32; o >= 1; o >>= 1)
#pragma unroll
            for (int hd = 0; hd < 4; ++hd) ss[hd] += shfl_xor_l(ss[hd], o, lane);
#pragma unroll
        for (int hd = 0; hd < 4; ++hd) { const float rs = FRSQ(ss[hd] * (1.0f / 128.0f) + EPS); const f32x2_t z = *(const f32x2_t*)(P + (size_t)m * LDP + OFF_Z + hd * 128 + 2 * lane);
            *(unsigned*)(Y2 + (size_t)m * Y2W + D_RNN + hd * 128 + 2 * lane) = pk_bf16(ov[hd][0] * rs * dw[0] * siluf_(z[0]), ov[hd][1] * rs * dw[1] * siluf_(z[1])); } }
}


__device__ __forceinline__ void ph_dn_chunk(const Args& a, LAS unsigned char* lds) {
    const float* QKV = (const float*)(a.ws + WS_QKV); const float* QN = (const float*)(a.ws + WS_QN); const float* KN = (const float*)(a.ws + WS_KN); const float* GB = (const float*)(a.ws + WS_GB); const float* KNT = (const float*)(a.ws + WS_KNT);
    bf16* AT = (bf16*)(a.ws + WS_AT); float* UT = (float*)(a.ws + WS_UT); bf16* WN = (bf16*)(a.ws + WS_WN); bf16* QG = (bf16*)(a.ws + WS_QG); bf16* KDT = (bf16*)(a.ws + WS_KDT); float* GL = (float*)(a.ws + WS_GL);
    int tx_ = TID(); asm volatile("" : "+v"(tx_));
    const int tid = tx_, lane = tid & 63, fr = lane & 15, fq = lane >> 4, wid = __builtin_amdgcn_readfirstlane(tid >> 6);
    constexpr int RS = 136;
    LAS bf16* Kb = (LAS bf16*)lds; LAS bf16* Qb = (LAS bf16*)(lds + 17408); LAS float* Lf = (LAS float*)(lds + 34816); LAS float* gcs = (LAS float*)(lds + 51200); LAS float* bts = (LAS float*)(lds + 51456);
    for (int cu = blockIdx.x; cu < NCU; cu += gridDim.x) { const int n = cu % NC, hd = (cu / NC) % DNH, b = cu / (NC * DNH); const size_t m0 = (size_t)b * SEQ + n * 64;
        { const int i = tid >> 3, sg = tid & 7; const float* qp = QN + (m0 + i) * 512 + hd * 128 + sg * 16; const float* kp = KN + (m0 + i) * 512 + hd * 128 + sg * 16;
            f32x4_t qv[4], kv[4];
#pragma unroll
            for (int e = 0; e < 4; ++e) { qv[e] = *(const f32x4_t*)(qp + 4 * e); kv[e] = *(const f32x4_t*)(kp + 4 * e); }
            u32x4_t w0, w1;
#pragma unroll
            for (int e = 0; e < 2; ++e) { w0[2 * e] = pk_bf16(qv[e][0], qv[e][1]); w0[2 * e + 1] = pk_bf16(qv[e][2], qv[e][3]); w1[2 * e] = pk_bf16(qv[e + 2][0], qv[e + 2][1]); w1[2 * e + 1] = pk_bf16(qv[e + 2][2], qv[e + 2][3]); }
            *(LAS u32x4_t*)(Qb + i * RS + sg * 16) = w0; *(LAS u32x4_t*)(Qb + i * RS + sg * 16 + 8) = w1;
#pragma unroll
            for (int e = 0; e < 2; ++e) { w0[2 * e] = pk_bf16(kv[e][0], kv[e][1]); w0[2 * e + 1] = pk_bf16(kv[e][2], kv[e][3]); w1[2 * e] = pk_bf16(kv[e + 2][0], kv[e + 2][1]); w1[2 * e + 1] = pk_bf16(kv[e + 2][2], kv[e + 2][3]); }
            *(LAS u32x4_t*)(Kb + i * RS + sg * 16) = w0; *(LAS u32x4_t*)(Kb + i * RS + sg * 16 + 8) = w1;
            if (tid < 64) { gcs[tid] = GB[(m0 + tid) * 16 + hd * 4 + 2]; bts[tid] = GB[(m0 + tid) * 16 + hd * 4 + 1]; } }
        __syncthreads();
        { const int ti = wid >> 1;
#pragma unroll
            for (int tq = 0; tq < 2; ++tq) { const int tj = 2 * (wid & 1) + tq; f32x4_t ck = {0.f, 0.f, 0.f, 0.f}, cq = {0.f, 0.f, 0.f, 0.f};
                if (tj <= ti) {
#pragma unroll
                    for (int ks = 0; ks < 4; ++ks) { const bf16x8_t bK = *(const LAS bf16x8_t*)(Kb + (tj * 16 + fr) * RS + ks * 32 + fq * 8);
                        ck = __builtin_amdgcn_mfma_f32_16x16x32_bf16(*(const LAS bf16x8_t*)(Kb + (ti * 16 + fr) * RS + ks * 32 + fq * 8), bK, ck, 0, 0, 0);
                        cq = __builtin_amdgcn_mfma_f32_16x16x32_bf16(*(const LAS bf16x8_t*)(Qb + (ti * 16 + fr) * RS + ks * 32 + fq * 8), bK, cq, 0, 0, 0); } }
                const int j = tj * 16 + fr; const float gj = gcs[j];
#pragma unroll
                for (int q = 0; q < 4; ++q) { const int i = ti * 16 + 4 * fq + q; float lv = 0.f, av = 0.f;
                    if (i >= j) { const float dec = __expf(gcs[i] - gj); av = cq[q] * dec; if (i > j) lv = bts[i] * ck[q] * dec; }
                    Lf[i * 64 + j] = lv; AT[(size_t)cu * 4096 + FRAG_OFF(i, j, 2)] = f2bf(av); } } }
        __syncthreads();
        if (wid < 4) { const int col = tid; float X[64];
            if (col < 128) {
#pragma unroll
                for (int j = 0; j < 64; ++j) X[j] = QKV[(m0 + j) * 1536 + 1024 + hd * 128 + col] * bts[j]; }
            else {
#pragma unroll
                for (int j = 0; j < 64; ++j) X[j] = KN[(m0 + j) * 512 + hd * 128 + (col - 128)] * bts[j] * __expf(gcs[j]); }
#pragma unroll
            for (int i = 1; i < 64; ++i) { float acc = X[i];
#pragma unroll
                for (int jb = 0; jb < i; jb += 4) { const f32x4_t l4 = *(const LAS f32x4_t*)(Lf + i * 64 + jb);
                    acc -= l4[0] * X[jb]; acc -= l4[1] * X[jb + 1]; acc -= l4[2] * X[jb + 2]; acc -= l4[3] * X[jb + 3]; }
                X[i] = acc; }
            if (col < 128) { float* up = UT + (size_t)cu * 8192 + (size_t)((col >> 4) * 4) * 256 + (col & 15) * 4;
#pragma unroll
                for (int j = 0; j < 64; j += 4) *(f32x4_t*)(up + (j >> 4) * 256 + ((j >> 2) & 3) * 64) = (f32x4_t){X[j], X[j + 1], X[j + 2], X[j + 3]}; }
            else { bf16* wp = WN + (size_t)cu * 8192;
#pragma unroll
                for (int j = 0; j < 64; ++j) wp[FRAG_OFF(j, col - 128, 4)] = f2bf(-X[j]); } }
        else { const int t2 = tid - 256; const float gl63 = gcs[63];
            { const int i = t2 >> 2, sg = t2 & 3; const float eg = __expf(gcs[i]); const float* qp = QN + (m0 + i) * 512 + hd * 128 + sg * 32; bf16* op = QG + (size_t)cu * 8192;
#pragma unroll
                for (int e = 0; e < 8; ++e) { const f32x4_t v = *(const f32x4_t*)(qp + 4 * e); u32x2_t w; w[0] = pk_bf16(v[0] * eg, v[1] * eg); w[1] = pk_bf16(v[2] * eg, v[3] * eg); *(u32x2_t*)(op + FRAG_OFF(i, sg * 32 + 4 * e, 4)) = w; } }
            { const int dd = t2 >> 1, hf = t2 & 1; const float* kp = KNT + (size_t)cu * 8192 + dd * 64 + hf * 32; bf16* op = KDT + (size_t)cu * 8192;
#pragma unroll
                for (int e = 0; e < 8; ++e) { const f32x4_t v = *(const f32x4_t*)(kp + 4 * e); const int i0 = hf * 32 + 4 * e; u32x2_t w;
                    w[0] = pk_bf16(v[0] * __expf(gl63 - gcs[i0]), v[1] * __expf(gl63 - gcs[i0 + 1])); w[1] = pk_bf16(v[2] * __expf(gl63 - gcs[i0 + 2]), v[3] * __expf(gl63 - gcs[i0 + 3])); *(u32x2_t*)(op + FRAG_OFF(dd, i0, 2)) = w; } }
            if (t2 == 0) GL[cu] = __expf(gl63); }
        __syncthreads();
    }
}


template <int MODE, int UNR> __device__ __forceinline__ void small_gemm(const bf16* __restrict__ A, const bf16* __restrict__ Bt, int N, int K, void* C, int ldc) {
    static_assert(MS == 128, "small_gemm covers 128 sample rows");
    int tx_ = TID(); asm volatile("" : "+v"(tx_));
    const int lane = tx_ & 63, fr = lane & 15, fq = lane >> 4, wv = __builtin_amdgcn_readfirstlane(blockIdx.x * (NTHREADS >> 6) + (tx_ >> 6)), nwv = gridDim.x * (NTHREADS >> 6);
    const int ntile = (N / 16) * 4;
    for (int tile = wv; tile < ntile; tile += nwv) { const int n0 = (tile >> 2) * 16, tg = tile & 3;
        f32x4_t acc0 = {0.f, 0.f, 0.f, 0.f}, acc1 = {0.f, 0.f, 0.f, 0.f};
        const bf16* bp = Bt + (size_t)(n0 + fr) * K + fq * 8; const bf16* ap0 = A + (size_t)(MP + tg * 32 + fr) * K + fq * 8; const bf16* ap1 = ap0 + (size_t)16 * K;
        for (int k = 0; k < K; k += 32 * UNR) { bf16x8_t bb[UNR], a0[UNR], a1[UNR];
#pragma unroll
            for (int u = 0; u < UNR; ++u) { bb[u] = *(const bf16x8_t*)(bp + k + 32 * u); a0[u] = *(const bf16x8_t*)(ap0 + k + 32 * u); a1[u] = *(const bf16x8_t*)(ap1 + k + 32 * u); }
#pragma unroll
            for (int u = 0; u < UNR; ++u) { acc0 = __builtin_amdgcn_mfma_f32_16x16x32_bf16(bb[u], a0[u], acc0, 0, 0, 0); acc1 = __builtin_amdgcn_mfma_f32_16x16x32_bf16(bb[u], a1[u], acc1, 0, 0, 0); } }
#pragma unroll
        for (int tt = 0; tt < 2; ++tt) { const f32x4_t v = tt ? acc1 : acc0; const size_t o = (size_t)(MP + tg * 32 + tt * 16 + fr) * ldc + n0 + 4 * fq;
            if (MODE == 0) *(f32x4_t*)((float*)C + o) = v;
            else if (MODE == 1) { const float r0 = fmaxf(v[0], 0.f), r1 = fmaxf(v[1], 0.f), r2 = fmaxf(v[2], 0.f), r3 = fmaxf(v[3], 0.f); u32x2_t w; w[0] = pk_bf16(r0 * r0, r1 * r1); w[1] = pk_bf16(r2 * r2, r3 * r3); *(u32x2_t*)((bf16*)C + o) = w; }
            else { f32x4_t* p = (f32x4_t*)((float*)C + o); *p = *p + v; } } }
}


template <int MODE> __device__ __forceinline__ void small_gemm2(const bf16* __restrict__ A, const bf16* __restrict__ Bt, int N, int K, void* C, int ldc, bf16* XB, unsigned long long* ss, LAS unsigned char* lds) {
    static_assert(MS == 128, "small_gemm2 covers 128 sample rows");
    int tx_ = TID(); asm volatile("" : "+v"(tx_));
    const int tid = tx_, lane = tid & 63, fr = lane & 15, fq = lane >> 4, wid = __builtin_amdgcn_readfirstlane(tid >> 6);
    LAS float* RED = (LAS float*)lds;
    const int kw = K / 8;
    for (int tile = blockIdx.x; tile < N / 16; tile += gridDim.x) { const int n0 = tile * 16;
        f32x4_t acc[8];
#pragma unroll
        for (int tt = 0; tt < 8; ++tt) acc[tt] = (f32x4_t){0.f, 0.f, 0.f, 0.f};
        const bf16* bp = Bt + (size_t)(n0 + fr) * K + wid * kw + fq * 8; const bf16* ap = A + (size_t)(MP + fr) * K + wid * kw + fq * 8;
        for (int k = 0; k < kw; k += 64) { bf16x8_t bb[2], aa[2][8];
#pragma unroll
            for (int u = 0; u < 2; ++u) { bb[u] = *(const bf16x8_t*)(bp + k + 32 * u);
#pragma unroll
                for (int tt = 0; tt < 8; ++tt) aa[u][tt] = *(const bf16x8_t*)(ap + (size_t)(tt * 16) * K + k + 32 * u); }
#pragma unroll
            for (int u = 0; u < 2; ++u)
#pragma unroll
                for (int tt = 0; tt < 8; ++tt) acc[tt] = __builtin_amdgcn_mfma_f32_16x16x32_bf16(bb[u], aa[u][tt], acc[tt], 0, 0, 0); }
#pragma unroll
        for (int tt = 0; tt < 8; ++tt) *(LAS f32x4_t*)(RED + ((size_t)(wid * 128 + tt * 16 + fr)) * 16 + 4 * fq) = acc[tt];
        __syncthreads();
        { const int tok = tid >> 2, c4 = (tid & 3) * 4; f32x4_t v = *(const LAS f32x4_t*)(RED + (size_t)tok * 16 + c4);
#pragma unroll
            for (int w = 1; w < 8; ++w) v += *(const LAS f32x4_t*)(RED + (size_t)(w * 128 + tok) * 16 + c4);
            const int m = MP + tok; const size_t o = (size_t)m * ldc + n0 + c4;
            if (MODE == 1) { const float rs = FRSQ((float)ss[m] * (5.9604644775390625e-08f / D) + EPS);
                const float r0 = fmaxf(v[0] * rs, 0.f), r1 = fmaxf(v[1] * rs, 0.f), r2 = fmaxf(v[2] * rs, 0.f), r3 = fmaxf(v[3] * rs, 0.f); u32x2_t w; w[0] = pk_bf16(r0 * r0, r1 * r1); w[1] = pk_bf16(r2 * r2, r3 * r3); *(u32x2_t*)((bf16*)C + o) = w; }
            else { f32x4_t* p = (f32x4_t*)((float*)C + o); const f32x4_t x = *p + v; *p = x; u32x2_t w; w[0] = pk_bf16(x[0], x[1]); w[1] = pk_bf16(x[2], x[3]); *(u32x2_t*)(XB + o) = w;
                float q = (x[0] * x[0] + x[1] * x[1]) + (x[2] * x[2] + x[3] * x[3]); q += shfl_xor_l(q, 1, lane); q += shfl_xor_l(q, 2, lane);
                if ((tid & 3) == 0) __hip_atomic_fetch_add(ss + m, (unsigned long long)(q * 16777216.0f), __ATOMIC_RELAXED, __HIP_MEMORY_SCOPE_AGENT); } }
        __syncthreads();
    }
}

constexpr int PH_PER_LAYER = 12, PH_LAYER0 = 2, PH_FINAL = PH_LAYER0 + DEPTH * PH_PER_LAYER, N_PHASES = PH_FINAL + 1;
#ifndef DIAG_SEQ_LO
#define DIAG_SEQ_LO NB
#endif
#ifndef PROBE_N
#define PROBE_N 1
#define PROBE_KIND -1
#define PROBE_LO 0
#define PROBE_HI 0
#endif
#define NREP(kind, k) ((PROBE_KIND == (kind) && (k) >= PROBE_LO && (k) <= PROBE_HI) ? PROBE_N : 1)
#define REP(kind, k) for (int rep_ = 0; rep_ < NREP(kind, k); ++rep_)
#ifndef MK_SINGLE
#define MK_SINGLE 1
#endif
__global__ void __launch_bounds__(NTHREADS, 2) mega(KArgs ka) {
    extern __shared__ __attribute__((aligned(16))) unsigned char lds[];
    LAS unsigned char* L = (LAS unsigned char*)lds;
    const size_t gsz = (size_t)gridDim.x * NTHREADS;
#define GT() ([&]() -> size_t { unsigned tx_ = TID(); asm volatile("" : "+v"(tx_)); return (size_t)blockIdx.x * NTHREADS + tx_; }())
    const int lo = ka.ph_lo, hi = ka.ph_hi; (void)lo; (void)hi;
    { const unsigned hw_ = (unsigned)__builtin_amdgcn_s_getreg((5 << 11) | 4) & 63u; if ((threadIdx.x & 63) == 0) ((LAS int*)(L + LDS_WTAB))[hw_] = (int)(threadIdx.x >> 6); __syncthreads(); }
    { const float** tab = (const float**)(ka.ws + WS_TAB); if (threadIdx.x < 28) tab[threadIdx.x] = ka.in[threadIdx.x]; asm volatile("s_waitcnt vmcnt(0)" ::: "memory"); __syncthreads(); }
    Args a; a.in = (const float* const*)(ka.ws + WS_TAB); a.out = ka.out; a.ws = ka.ws;
#define OPQ() do { size_t z_ = 0; asm volatile("" : "+s"(z_)); a.ws = ka.ws + z_; a.out = ka.out + z_; a.in = (const float* const*)(ka.ws + WS_TAB + z_); } while (0)
#if MK_SINGLE
    if (TID() < 4) ((LAS unsigned*)(L + LDS_MISC))[TID()] = 0u;
    __syncthreads();
    XcdBarrier bar = xcd_barrier_post((unsigned*)(a.ws + WS_CTL) + 4096, (volatile LAS unsigned*)(L + LDS_MISC));
#define SEAM(k) do { XcdBarrier bb_ = bar; asm volatile("" : "+s"(bb_.x)); xcd_barrier(bb_); } while (0)
#else
#define SEAM(k) do { } while (0)
#endif
#if MK_SINGLE
#define IN(k) (true)
#else
#define IN(k) (lo <= (k) && (k) < hi)
#endif
#define XN ((bf16*)(a.ws + WS_XN))
#define X ((float*)(a.ws + WS_X))
#define P ((float*)(a.ws + WS_P))
#define H ((bf16*)(a.ws + WS_H))
#define Y2 ((bf16*)(a.ws + WS_Y2))
    if (IN(0)) { OPQ(); REP(2, 0) { ph_prep_x(a); ph_wprep(a, true, 0, GT(), gsz); } SEAM(0); }
    for (int l = 0; l < DEPTH; ++l) {
        const int pb = PH_LAYER0 + l * PH_PER_LAYER, r = l >> 1; unsigned long long* SSb = (unsigned long long*)(a.ws + WS_SS);
        if ((l & 1) == 0) {
            if (IN(pb + 1)) { OPQ(); REP(3, 1) { pg8::Gemm g{XN, (const bf16*)(a.ws + WS_WINR) + (size_t)r * REC_PAD * D, MPAD, REC_PAD, D}; pg8::StaticOrder S; S.init(MPAD, REC_PAD, gridDim.x, blockIdx.x);
                pg8::EpiF32S E{P, LDP, SSb + (size_t)(2 * l) * MPAD}; pg8::gemm_phase<pg8::EpiF32S, pg8::StaticOrder, false>(L, g, S, E, nullptr); } SEAM(pb + 1); }
            if (IN(pb + 2)) { OPQ(); REP(0, 2) { ph_rg_chunk(a, r, L); ph_dn_tok(a, r); } SEAM(pb + 2); }
            if (IN(pb + 3)) { OPQ(); REP(0, 3) ph_dn_chunk(a, L); SEAM(pb + 3); }
            if (IN(pb + 6)) { OPQ();
                constexpr int NDNB = NB * DNH * 8;
                REP(0, 6) {
                if ((int)gridDim.x > NDNB) { if ((int)blockIdx.x < NDNB) {
#ifdef DIAG_NAIVE_B
                    ph_dn_b_naive(a, r, GT(), (size_t)NDNB * NTHREADS);
#else
                    ph_dn_b(a, r, L);
#endif
                } else { const size_t g2 = GT() - (size_t)NDNB * NTHREADS, s2 = gsz - (size_t)NDNB * NTHREADS; ph_rg_scan2(a, r, g2, s2); if (DIAG_SEQ_LO != 0) ph_dn_seq(a, r, DIAG_SEQ_LO, g2, s2);
                    if (l == 0) ph_wprep(a, true, 1, g2, s2); } }
                else { ph_dn_b(a, r, L); ph_rg_scan2(a, r, GT(), gsz); ph_dn_seq(a, r, DIAG_SEQ_LO, GT(), gsz); if (l == 0) ph_wprep(a, true, 1, GT(), gsz); }
                }
                SEAM(pb + 6); }
            if (IN(pb + 7)) { OPQ(); REP(0, 7) ph_rec_out_w(a, r); SEAM(pb + 7); }
            if (IN(pb + 8)) { OPQ(); REP(3, 8) { pg8::Gemm g{Y2, (const bf16*)(a.ws + WS_WOUTR) + (size_t)r * D * Y2W, MP, D, Y2W}; pg8::StaticOrder S; S.init(MP, D, gridDim.x, blockIdx.x);
                pg8::EpiAddN E{X, D, XN, SSb + (size_t)(2 * l + 1) * MPAD}; pg8::gemm_phase<pg8::EpiAddN, pg8::StaticOrder, false>(L, g, S, E, nullptr); small_gemm2<2>(Y2, (const bf16*)(a.ws + WS_WOUTR) + (size_t)r * D * Y2W, D, Y2W, X, D, XN, SSb + (size_t)(2 * l + 1) * MPAD, L); } SEAM(pb + 8); }
        } else {
            if (IN(pb + 1)) { OPQ(); REP(3, 1) { pg8::Gemm g{XN, (const bf16*)(a.ws + WS_WINA) + (size_t)r * ATT_PAD * D, MPAD, ATT_PAD, D}; pg8::StaticOrder S; S.init(MPAD, ATT_PAD, gridDim.x, blockIdx.x);
                pg8::EpiAttS E{a.ws, a.out, SSb + (size_t)(2 * l) * MPAD, r}; pg8::gemm_phase<pg8::EpiAttS, pg8::StaticOrder, false>(L, g, S, E, nullptr); } SEAM(pb + 1); }
            if (IN(pb + 3)) { OPQ(); REP(1, 3) { ph_idx_sample_mfma(a, r); ph_idx_mfma(a, L); } SEAM(pb + 3); }
            if (IN(pb + 4)) { OPQ(); REP(1, 4) ph_select_w(a, L); SEAM(pb + 4); }
            if (IN(pb + 5)) { OPQ(); REP(1, 5) { ph_sparse_sample(a, r, L); ph_sparse_attn(a, L); } SEAM(pb + 5); }
            if (IN(pb + 8)) { OPQ(); REP(3, 8) { pg8::Gemm g{Y2, (const bf16*)(a.ws + WS_WOUTA) + (size_t)r * D * D, MP, D, D}; pg8::StaticOrder S; S.init(MP, D, gridDim.x, blockIdx.x);
                pg8::EpiAddN E{X, D, XN, SSb + (size_t)(2 * l + 1) * MPAD}; pg8::gemm_phase<pg8::EpiAddN, pg8::StaticOrder, false>(L, g, S, E, nullptr); small_gemm2<2>(Y2, (const bf16*)(a.ws + WS_WOUTA) + (size_t)r * D * D, D, D, X, D, XN, SSb + (size_t)(2 * l + 1) * MPAD, L); } SEAM(pb + 8); }
        }
        if (IN(pb + 10)) { OPQ(); REP(3, 10) { pg8::Gemm g{XN, (const bf16*)(a.ws + WS_WUP) + (size_t)l * D_FF * D, MP, D_FF, D}; pg8::StaticOrder S; S.init(MP, D_FF, gridDim.x, blockIdx.x);
            pg8::EpiRelu2S E{H, D_FF, SSb + (size_t)(2 * l + 1) * MPAD}; pg8::gemm_phase<pg8::EpiRelu2S, pg8::StaticOrder, false>(L, g, S, E, nullptr); small_gemm2<1>(XN, (const bf16*)(a.ws + WS_WUP) + (size_t)l * D_FF * D, D_FF, D, H, D_FF, nullptr, SSb + (size_t)(2 * l + 1) * MPAD, L); } SEAM(pb + 10); }
        if (IN(pb + 11)) { OPQ(); REP(3, 11) { pg8::Gemm g{H, (const bf16*)(a.ws + WS_WDN) + (size_t)l * D * D_FF, MP, D, D_FF}; pg8::StaticOrder S; S.init(MP, D, gridDim.x, blockIdx.x);
            pg8::EpiAddN E{X, D, XN, SSb + (size_t)(2 * l + 2) * MPAD}; pg8::gemm_phase<pg8::EpiAddN, pg8::StaticOrder, false>(L, g, S, E, nullptr); small_gemm2<2>(H, (const bf16*)(a.ws + WS_WDN) + (size_t)l * D * D_FF, D, D_FF, X, D, XN, SSb + (size_t)(2 * l + 2) * MPAD, L); } SEAM(pb + 11); }
    }
    if (IN(PH_FINAL)) { OPQ(); ph_final(a); }
}
#undef XN
#undef X
#undef P
#undef H
#undef Y2

extern "C" void kernel_launch(void* const* d_in, const int* in_sizes, int n_in, void* d_out, int out_size, void* d_ws, size_t ws_size, hipStream_t stream) {
    static int grid = 0;
    if (grid == 0) {
        if (n_in != 28 || (size_t)out_size != (size_t)O_END || ws_size < WS_END2) { fprintf(stderr, "kernel_launch: unexpected shapes n_in %d out %d (want %zu) ws %zu (want %zu)\n", n_in, out_size, (size_t)O_END, ws_size, (size_t)WS_END2); grid = -1; return; }
        int dev = 0, cus = 0;
        if (hipGetDevice(&dev) != hipSuccess || hipDeviceGetAttribute(&cus, hipDeviceAttributeMultiprocessorCount, dev) != hipSuccess) { grid = -1; return; }
        if (hipFuncSetAttribute((const void*)mega, hipFuncAttributeMaxDynamicSharedMemorySize, LDS_BYTES) != hipSuccess) { fprintf(stderr, "kernel_launch: hipFuncSetAttribute failed\n"); grid = -1; return; }
        int per_cu = 0; (void)hipOccupancyMaxActiveBlocksPerMultiprocessor(&per_cu, (const void*)mega, NTHREADS, LDS_BYTES); (void)hipGetLastError();
        if (per_cu < 1) fprintf(stderr, "kernel_launch: occupancy query says %d blocks per CU\n", per_cu);
        grid = cus;
    }
    if (grid < 0) return;
    (void)hipMemsetAsync((char*)d_ws + WS_CTL, 0, CTL_BYTES, stream);
    KArgs a{};
    for (int i = 0; i < 28; ++i) a.in[i] = (const float*)d_in[i];
    a.out = (float*)d_out; a.ws = (unsigned char*)d_ws;
#if MK_SINGLE
    a.ph_lo = 0; a.ph_hi = N_PHASES;
    hipLaunchKernelGGL(mega, dim3(grid), dim3(NTHREADS), LDS_BYTES, stream, a);
#else
    for (int ph = 0; ph < N_PHASES; ++ph) { const int k = ph - PH_LAYER0; if (k >= 0 && ph < PH_FINAL && ((k / PH_PER_LAYER) & 1) == 1 && (k % PH_PER_LAYER) == 7) continue;
        a.ph_lo = ph; a.ph_hi = ph + 1; hipLaunchKernelGGL(mega, dim3(grid), dim3(NTHREADS), LDS_BYTES, stream, a); }
#endif
}
#endif
```

```cpp
#ifndef HOST_TEST
#include <hip/hip_runtime.h>
#define HD __device__ __forceinline__
#define UNI(x) __builtin_amdgcn_readfirstlane(x)
#else
#include <cmath>
#include <cstddef>
#include <cstring>
#define HD static inline
#define UNI(x) (x)
#endif

#ifndef CFG_D_MODEL
#define CFG_D_MODEL 1024
#define CFG_BATCH 2
#define CFG_SEQ 8192
#define CFG_DEC_BATCH 32
#define CFG_PAST 8192
#endif
constexpr int D = CFG_D_MODEL, NB = CFG_BATCH, SEQ = CFG_SEQ, DEPTH = 4, DB = CFG_DEC_BATCH, DT = 4, PAST = CFG_PAST, PAGE = 128;
constexpr int N_REC = 2, N_ATT = 2, NPAGES = PAST / PAGE, NUSED = DB * NPAGES, NPOOL = NUSED + (NUSED + 3) / 4;
constexpr int D_RNN = D / 2, RG_HEADS = 8, RG_BW = D_RNN / RG_HEADS;
constexpr int DNH = 4, DNK = 128, DN_QK = 512, DN_VD = 512;
constexpr int CONV_CH = D_RNN + 2 * DN_QK + DN_VD, REC_IN = CONV_CH + D_RNN + DN_VD + 2 * DNH;
constexpr int OFF_GATE = CONV_CH, OFF_Z = CONV_CH + D_RNN, OFF_B = OFF_Z + DN_VD, OFF_A = OFF_B + DNH;
constexpr int AH = D / 128, KVH = 2, HDIM = 128, GROUP = AH / KVH, IH = 8, IDIM = 64;
constexpr int AO_K = AH * HDIM, AO_V = AO_K + KVH * HDIM, AO_QI = AO_V + KVH * HDIM, AO_KI = AO_QI + IH * IDIM, AO_WI = AO_KI + IDIM, ATT_IN = AO_WI + IH;
constexpr int D_FF = 4 * D;
constexpr int TOPK_P = (SEQ / 4 < 256) ? SEQ / 4 : 256, TOPK_S = ((PAST + DT) / 4 < 256) ? (PAST + DT) / 4 : 256, KMAX = 256, KROW = 320;
constexpr int MP = NB * SEQ, MS = DB * DT, MT = MP + MS, MPAD = (MT + 255) / 256 * 256;
constexpr int REC_PAD = (REC_IN + 255) / 256 * 256, ATT_PAD = (ATT_IN + 255) / 256 * 256, LDP = REC_PAD > ATT_PAD ? REC_PAD : ATT_PAD;
constexpr int Y2W = D_RNN + DN_VD;
constexpr int SMAX = (PAST + DT > SEQ) ? PAST + DT : SEQ, SLD = (SMAX + 63) / 64 * 64;
constexpr int NC = SEQ / 64, NCU = NB * DNH * NC;
constexpr float EPS = 1e-6f;
typedef unsigned short bf16;

constexpr size_t O_YP = 0, O_YS = O_YP + (size_t)MP * D, O_CONVP = O_YS + (size_t)MS * D, O_HP = O_CONVP + (size_t)N_REC * NB * 3 * CONV_CH,
    O_SP = O_HP + (size_t)N_REC * NB * D_RNN, O_KP = O_SP + (size_t)N_REC * NB * DNH * 128 * 128, O_VP = O_KP + (size_t)N_ATT * MP * KVH * HDIM,
    O_KIP = O_VP + (size_t)N_ATT * MP * KVH * HDIM, O_CONVS = O_KIP + (size_t)N_ATT * MP * IDIM, O_HS = O_CONVS + (size_t)N_REC * DB * 3 * CONV_CH,
    O_SS = O_HS + (size_t)N_REC * DB * D_RNN, O_KS = O_SS + (size_t)N_REC * DB * DNH * 128 * 128, O_VS = O_KS + (size_t)N_ATT * MS * KVH * HDIM,
    O_KIS = O_VS + (size_t)N_ATT * MS * KVH * HDIM, O_END = O_KIS + (size_t)N_ATT * MS * IDIM;

constexpr size_t al256(size_t x) { return (x + 255) / 256 * 256; }
constexpr size_t WS_CTL = 0, CTL_BYTES = 4u << 20;
constexpr size_t WS_WINR = CTL_BYTES, WS_WOUTR = WS_WINR + al256((size_t)N_REC * REC_PAD * D * 2), WS_WINA = WS_WOUTR + al256((size_t)N_REC * D * Y2W * 2),
    WS_WOUTA = WS_WINA + al256((size_t)N_ATT * ATT_PAD * D * 2), WS_WUP = WS_WOUTA + al256((size_t)N_ATT * D * D * 2), WS_WDN = WS_WUP + al256((size_t)DEPTH * D_FF * D * 2),
    WS_X = WS_WDN + al256((size_t)DEPTH * D * D_FF * 2), WS_XN = WS_X + al256((size_t)MPAD * D * 4), WS_P = WS_XN + al256((size_t)MPAD * D * 2),
    WS_H = WS_P + al256((size_t)MPAD * LDP * 4), WS_Y2 = WS_H + al256((size_t)MPAD * D_FF * 2), WS_XR = WS_Y2 + al256((size_t)MPAD * D * 2),
    WS_QKV = WS_XR + al256((size_t)MT * D_RNN * 4), WS_RA = WS_QKV + al256((size_t)MT * 1536 * 4), WS_RB = WS_RA + al256((size_t)MT * D_RNN * 4),
    WS_HH = WS_RB + al256((size_t)MT * D_RNN * 4), WS_QN = WS_HH + al256((size_t)MT * D_RNN * 4), WS_KN = WS_QN + al256((size_t)MT * 512 * 4),
    WS_GB = WS_KN + al256((size_t)MT * 512 * 4), WS_ODN = WS_GB + al256((size_t)MT * 16 * 4), WS_SCT = WS_ODN + al256((size_t)MT * 512 * 4),
    WS_IDX = WS_SCT + al256((size_t)MT * SLD * 4), WS_NSEL = WS_IDX + al256((size_t)MT * KROW * 4), WS_SCR = WS_NSEL + al256((size_t)MT * 4),
    WS_CARRY = WS_SCR + al256((size_t)MT * AH * KMAX * 4), WS_L = WS_CARRY + al256((size_t)NB * NC * D_RNN * 4), WS_AT = WS_L + al256((size_t)NCU * 4096 * 4),
    WS_UT = WS_AT + al256((size_t)NCU * 4096 * 2), WS_WN = WS_UT + al256((size_t)NCU * 8192 * 4), WS_QG = WS_WN + al256((size_t)NCU * 8192 * 2),
    WS_KDT = WS_QG + al256((size_t)NCU * 8192 * 2), WS_GL = WS_KDT + al256((size_t)NCU * 8192 * 2), WS_KNT = WS_GL + al256((size_t)NCU * 4), WS_END = WS_KNT + al256((size_t)NCU * 8192 * 4);

constexpr size_t WS_KB = WS_H, WS_VB = WS_KB + al256((size_t)MT * 256 * 2), WS_QIB = WS_VB + al256((size_t)MT * 256 * 2), WS_KIB = WS_QIB + al256((size_t)MT * 512 * 2);
constexpr size_t WS_QB = WS_KIB + al256((size_t)MT * 64 * 2);
static_assert(WS_QB + (size_t)MT * D * 2 <= WS_Y2, "bf16 attention copies must fit inside the H buffer");
#ifdef HOST_TEST
struct Args { const float* in[28]; float* out; unsigned char* ws; int ph_lo, ph_hi; };
#else
struct KArgs { const float* in[28]; float* out; unsigned char* ws; int ph_lo, ph_hi; };
struct Args { const float* const* in; float* out; unsigned char* ws; };
constexpr size_t WS_TAB = 65536;
constexpr size_t WS_SS = 1u << 20;
static_assert(WS_SS + (size_t)9 * MPAD * 8 <= CTL_BYTES, "norm statistics inside the memset region");
constexpr size_t WS_END2 = WS_END;
#endif
enum { I_XP = 0, I_XS, I_SCONV, I_SH, I_SS, I_CK, I_CV, I_CKI, I_PT, I_NMIX, I_NMLP, I_NFIN, I_WINR, I_WCONV, I_BCONV, I_WA, I_BA, I_WX, I_BX, I_LAM, I_ALOG, I_DTB, I_DNW,
       I_WOUTR, I_WINA, I_WOUTA, I_WUP, I_WDN };

HD bf16 f2bf(float f) { unsigned u; memcpy(&u, &f, 4); u += 0x7FFFu + ((u >> 16) & 1u); return (bf16)(u >> 16); }
HD float bf2f(bf16 b) { unsigned u = ((unsigned)b) << 16; float f; memcpy(&f, &u, 4); return f; }
#ifndef HOST_TEST
#define FEXP(x) __expf(x)
#define FLOG(x) __logf(x)
#define FRCP(x) __builtin_amdgcn_rcpf(x)
#define FSQRT(x) __builtin_amdgcn_sqrtf(x)
#define FRSQ(x) __builtin_amdgcn_rsqf(x)
#else
#define FEXP(x) expf(x)
#define FLOG(x) logf(x)
#define FRCP(x) (1.0f / (x))
#define FSQRT(x) sqrtf(x)
#define FRSQ(x) (1.0f / sqrtf(x))
#endif
HD float sigmoidf_(float x) { return FRCP(1.0f + FEXP(-x)); }
HD float softplusf_(float x) { return x > 20.f ? x : FLOG(1.0f + FEXP(x)); }
HD float siluf_(float x) { return x * sigmoidf_(x); }
HD float gelu_tanhf_(float x) { const float u = 0.7978845608028654f * (x + 0.044715f * x * x * x); const float th = 1.0f - 2.0f * FRCP(1.0f + FEXP(2.0f * u)); return 0.5f * x * (1.0f + th); }
HD unsigned fkey(float f) { f = f + 0.0f; unsigned u; memcpy(&u, &f, 4); return (u & 0x80000000u) ? ~u : (u | 0x80000000u); }
struct RowInfo { int seq, t, T, row0; bool sample; };
HD RowInfo row_info(int m) { RowInfo r; if (m < MP) { r.seq = m / SEQ; r.t = m % SEQ; r.T = SEQ; r.row0 = r.seq * SEQ; r.sample = false; }
    else { const int q = m - MP; r.seq = NB + q / DT; r.t = q % DT; r.T = DT; r.row0 = MP + (q / DT) * DT; r.sample = true; } return r; }

HD void ph_copy_x(const Args& a, size_t gtid, size_t gsz) {
    float* X = (float*)(a.ws + WS_X);
    for (size_t i = gtid; i < (size_t)MPAD * D; i += gsz) { const size_t m = i / D; X[i] = m < (size_t)MP ? a.in[I_XP][i] : (m < (size_t)MT ? a.in[I_XS][i - (size_t)MP * D] : 0.f); }
}
HD void wprep_one(const float* w, bf16* wt, int K, int N, int NP, const float* gamma, size_t gtid, size_t gsz) {
    const size_t k32n = (size_t)K / 32;
    for (size_t i = gtid; i < (size_t)NP * k32n; i += gsz) { const int n = (int)(i % NP); const size_t k0 = (i / NP) * 32; bf16 tmp[32];
#ifndef HOST_TEST
#pragma unroll
#endif
        for (int j = 0; j < 32; ++j) tmp[j] = n < N ? f2bf(w[(k0 + j) * (size_t)N + n] * (gamma ? gamma[k0 + j] : 1.0f)) : (bf16)0;
#ifndef HOST_TEST
#pragma unroll
#endif
        for (int j = 0; j < 32; ++j) wt[(size_t)n * K + k0 + j] = tmp[j]; }
}
HD void ph_wprep(const Args& a, bool fold, int part, size_t gtid, size_t gsz) {
    for (int r = 0; r < N_REC; ++r) { if (part == 2 || (part == 0) == (r == 0)) wprep_one(a.in[I_WINR] + (size_t)r * D * REC_IN, (bf16*)(a.ws + WS_WINR) + (size_t)r * REC_PAD * D, D, REC_IN, REC_PAD, fold ? a.in[I_NMIX] + (size_t)(2 * r) * D : nullptr, gtid, gsz);
        if (part != 0) wprep_one(a.in[I_WOUTR] + (size_t)r * Y2W * D, (bf16*)(a.ws + WS_WOUTR) + (size_t)r * D * Y2W, Y2W, D, D, nullptr, gtid, gsz); }
    if (part == 0) return;
    for (int r = 0; r < N_ATT; ++r) { wprep_one(a.in[I_WINA] + (size_t)r * D * ATT_IN, (bf16*)(a.ws + WS_WINA) + (size_t)r * ATT_PAD * D, D, ATT_IN, ATT_PAD, fold ? a.in[I_NMIX] + (size_t)(2 * r + 1) * D : nullptr, gtid, gsz);
        wprep_one(a.in[I_WOUTA] + (size_t)r * D * D, (bf16*)(a.ws + WS_WOUTA) + (size_t)r * D * D, D, D, D, nullptr, gtid, gsz); }
    for (int l = 0; l < DEPTH; ++l) { wprep_one(a.in[I_WUP] + (size_t)l * D * D_FF, (bf16*)(a.ws + WS_WUP) + (size_t)l * D_FF * D, D, D_FF, D_FF, fold ? a.in[I_NMLP] + (size_t)l * D : nullptr, gtid, gsz);
        wprep_one(a.in[I_WDN] + (size_t)l * D_FF * D, (bf16*)(a.ws + WS_WDN) + (size_t)l * D * D_FF, D_FF, D, D, nullptr, gtid, gsz); }
}
HD void ph_conv(const Args& a, int r, size_t gtid, size_t gsz) {
    const float* P = (const float*)(a.ws + WS_P); float* XR = (float*)(a.ws + WS_XR); float* QKV = (float*)(a.ws + WS_QKV);
    const float* wc = a.in[I_WCONV] + (size_t)r * 4 * CONV_CH; const float* bc = a.in[I_BCONV] + (size_t)r * D_RNN;
    for (size_t i = gtid; i < (size_t)MT * CONV_CH; i += gsz) { const int m = (int)(i / CONV_CH), c = (int)(i % CONV_CH); const RowInfo ri = row_info(m);
        float acc = 0.f;
        for (int k = 0; k < 4; ++k) { const int tau = ri.t - 3 + k; float xv;
            if (tau >= 0) xv = P[(size_t)(ri.row0 + tau) * LDP + c];
            else xv = ri.sample ? a.in[I_SCONV][(((size_t)r * DB + (ri.seq - NB)) * 3 + (3 + tau)) * CONV_CH + c] : 0.f;
            acc += xv * wc[(size_t)k * CONV_CH + c]; }
        if (c < D_RNN) XR[(size_t)m * D_RNN + c] = acc + bc[c]; else QKV[(size_t)m * 1536 + (c - D_RNN)] = siluf_(acc);
        const float uraw = P[(size_t)m * LDP + c];
        if (!ri.sample) { if (ri.t >= SEQ - 3) a.out[O_CONVP + (((size_t)r * NB + ri.seq) * 3 + (ri.t - (SEQ - 3))) * CONV_CH + c] = uraw; }
        else { if (ri.t >= DT - 3) a.out[O_CONVS + (((size_t)r * DB + (ri.seq - NB)) * 3 + (ri.t - (DT - 3))) * CONV_CH + c] = uraw; }
    }
}
HD void ph_rg_gates(const Args& a, int r, size_t gtid, size_t gsz) {
    const float* XR = (const float*)(a.ws + WS_XR); float* RA = (float*)(a.ws + WS_RA); float* RB = (float*)(a.ws + WS_RB);
    const float* wa = a.in[I_WA] + (size_t)r * RG_HEADS * RG_BW * RG_BW; const float* wx = a.in[I_WX] + (size_t)r * RG_HEADS * RG_BW * RG_BW;
    for (size_t i = gtid; i < (size_t)MT * D_RNN; i += gsz) { const int m = (int)(i / D_RNN), j = (int)(i % D_RNN), hd = j / RG_BW, jj = j % RG_BW; const RowInfo ri = row_info(m);
        float pr = 0.f, pi = 0.f; const float* xrow = XR + (size_t)m * D_RNN + hd * RG_BW;
        for (int k = 0; k < RG_BW; ++k) { const float xv = xrow[k]; pr += xv * wa[((size_t)hd * RG_BW + k) * RG_BW + jj]; pi += xv * wx[((size_t)hd * RG_BW + k) * RG_BW + jj]; }
        const float rg = sigmoidf_(pr + a.in[I_BA][(size_t)r * D_RNN + j]), ig = sigmoidf_(pi + a.in[I_BX][(size_t)r * D_RNN + j]);
        const float log_a = -8.0f * rg * softplusf_(-a.in[I_LAM][(size_t)r * D_RNN + j]); const float av = FEXP(log_a);
        const bool first = (!ri.sample) && ri.t == 0;
        const float mult = first ? 1.0f : sqrtf(fmaxf(1.0f - FEXP(2.0f * log_a), 0.0f));
        float bv = XR[(size_t)m * D_RNN + j] * ig * mult;
        if (ri.t == 0 && ri.sample) bv += av * a.in[I_SH][((size_t)r * DB + (ri.seq - NB)) * D_RNN + j];
        RA[i] = av; RB[i] = bv; }
}
HD void ph_rg_scan1(const Args& a, int r, size_t gtid, size_t gsz) {
    const float* RA = (const float*)(a.ws + WS_RA); float* AP = (float*)(a.ws + WS_XR); const float* RB = (const float*)(a.ws + WS_RB); float* HH = (float*)(a.ws + WS_HH);
    const size_t n_p = (size_t)NB * NC * D_RNN, n_s = (size_t)DB * D_RNN;
    for (size_t i = gtid; i < n_p + n_s; i += gsz) {
        if (i < n_p) { const int j = (int)(i % D_RNN); const size_t row0 = (i / D_RNN) * 64; float h = 0.f, ap = 1.f;
            for (int t = 0; t < 64; ++t) { const size_t o = (row0 + t) * D_RNN + j; const float av = RA[o]; h = av * h + RB[o]; ap *= av; HH[o] = h; AP[o] = ap; } }
        else { const size_t q = i - n_p; const int db = (int)(q / D_RNN), j = (int)(q % D_RNN); float h = 0.f;
            for (int t = 0; t < DT; ++t) { const size_t o = (size_t)(MP + db * DT + t) * D_RNN + j; h = RA[o] * h + RB[o]; HH[o] = h; }
            a.out[O_HS + ((size_t)r * DB + db) * D_RNN + j] = h; } }
}
HD void ph_rg_scan2(const Args& a, int r, size_t gtid, size_t gsz) {
    const float* RA = (const float*)(a.ws + WS_XR); const float* HH = (const float*)(a.ws + WS_HH); float* CARRY = (float*)(a.ws + WS_CARRY);
    for (size_t i = gtid; i < (size_t)NB * D_RNN; i += gsz) { const int b = (int)(i / D_RNN), j = (int)(i % D_RNN); float carry = 0.f;
        for (int n0 = 0; n0 < NC; n0 += 16) { float av[16], hv[16];
#pragma unroll
            for (int q = 0; q < 16; ++q) { const int n = n0 + q < NC ? n0 + q : NC - 1; const size_t last = ((size_t)b * SEQ + n * 64 + 63) * D_RNN + j; av[q] = RA[last]; hv[q] = HH[last]; }
#pragma unroll
            for (int q = 0; q < 16; ++q) if (n0 + q < NC) { CARRY[((size_t)b * NC + n0 + q) * D_RNN + j] = carry; carry = av[q] * carry + hv[q]; } }
        a.out[O_HP + ((size_t)r * NB + b) * D_RNN + j] = carry; }
}
HD float dn_g(const Args& a, int r, size_t m, int hd) { const float* P = (const float*)(a.ws + WS_P);
    return -FEXP(a.in[I_ALOG][r * DNH + hd]) * softplusf_(P[m * LDP + OFF_A + hd] + a.in[I_DTB][r * DNH + hd]); }
HD void ph_dn_prep(const Args& a, int r, size_t gtid, size_t gsz) {
    const float* P = (const float*)(a.ws + WS_P); const float* QKV = (const float*)(a.ws + WS_QKV); float* QN = (float*)(a.ws + WS_QN); float* KN = (float*)(a.ws + WS_KN); float* GB = (float*)(a.ws + WS_GB);
    for (size_t i = gtid; i < (size_t)MT * DNH; i += gsz) { const int m = (int)(i / DNH), hd = (int)(i % DNH);
        const float* q = QKV + (size_t)m * 1536 + hd * 128; const float* k = q + 512; float sq = 0.f, sk = 0.f;
        for (int d = 0; d < 128; ++d) { sq += q[d] * q[d]; sk += k[d] * k[d]; }
        const float rq = FRSQ(sq + EPS) * 0.08838834764831845f, rk = 1.0f / sqrtf(sk + EPS);
        for (int d = 0; d < 128; ++d) { QN[(size_t)m * 512 + hd * 128 + d] = q[d] * rq; KN[(size_t)m * 512 + hd * 128 + d] = k[d] * rk; }
        if (m < MP) { float* KNT = (float*)(a.ws + WS_KNT) + (((size_t)(m / SEQ) * DNH + hd) * NC + (m % SEQ) / 64) * 8192 + (m % 64); for (int d = 0; d < 128; ++d) KNT[(size_t)d * 64] = k[d] * rk; }
        const float beta = sigmoidf_(P[(size_t)m * LDP + OFF_B + hd]);
        const float g = dn_g(a, r, (size_t)m, hd); float gc = g;
        if (m < MP) { const int t = m % SEQ; for (int tau = (t / 64) * 64; tau < t; ++tau) gc += dn_g(a, r, (size_t)(m - t + tau), hd); }
        GB[(size_t)m * 16 + hd * 4] = g; GB[(size_t)m * 16 + hd * 4 + 1] = beta; GB[(size_t)m * 16 + hd * 4 + 2] = gc; }
}
#ifndef HOST_TEST
#define DN_FENCE() asm volatile("" ::: "memory")
#else
#define DN_FENCE() do { } while (0)
#endif
HD void ph_dn_seq(const Args& a, int r, int seq_lo, size_t gtid, size_t gsz) {
    const float* QKV = (const float*)(a.ws + WS_QKV); const float* QN = (const float*)(a.ws + WS_QN); const float* KN = (const float*)(a.ws + WS_KN); const float* GB = (const float*)(a.ws + WS_GB);
    float* ODN = (float*)(a.ws + WS_ODN);
    for (size_t i = gtid; i < (size_t)(NB + DB - seq_lo) * DNH * 128; i += gsz) { const int v = (int)(i % 128), sh = UNI((int)(i / 128)), hd = sh % DNH, seq = seq_lo + sh / DNH;
        const int row0 = seq < NB ? seq * SEQ : MP + (seq - NB) * DT, T = seq < NB ? SEQ : DT;
        float S[128];
        if (seq < NB) {
#pragma unroll
            for (int d = 0; d < 128; ++d) S[d] = 0.f; }
        else { const float* s0 = a.in[I_SS] + ((((size_t)r * DB + (seq - NB)) * DNH + hd) * 128) * 128 + v;
#pragma unroll
            for (int d = 0; d < 128; ++d) S[d] = s0[(size_t)d * 128]; }
        for (int t = 0; t < T; ++t) { const size_t m = (size_t)(row0 + t);
            const float* kk = KN + m * 512 + hd * 128; const float* qq = QN + m * 512 + hd * 128;
            const float eg = FEXP(GB[m * 16 + hd * 4]), beta = GB[m * 16 + hd * 4 + 1], vv = QKV[m * 1536 + 1024 + hd * 128 + v];
            float ks = 0.f;
#pragma unroll
            for (int c = 0; c < 4; ++c) {
#pragma unroll
                for (int d = c * 32; d < c * 32 + 32; ++d) ks += kk[d] * S[d];
                DN_FENCE(); }
            const float cc = beta * (vv - eg * ks); float o = 0.f;
#pragma unroll
            for (int c = 0; c < 4; ++c) {
#pragma unroll
                for (int d = c * 32; d < c * 32 + 32; ++d) { S[d] = eg * S[d] + kk[d] * cc; o += qq[d] * S[d]; }
                DN_FENCE(); }
            ODN[m * 512 + hd * 128 + v] = o; }
        float* so = seq < NB ? a.out + O_SP + ((((size_t)r * NB + seq) * DNH + hd) * 128) * 128 + v : a.out + O_SS + ((((size_t)r * DB + (seq - NB)) * DNH + hd) * 128) * 128 + v;
#pragma unroll
        for (int d = 0; d < 128; ++d) so[(size_t)d * 128] = S[d]; }
}
HD void ph_dn_lat(const Args& a, size_t gtid, size_t gsz) {
    const float* QN = (const float*)(a.ws + WS_QN); const float* KN = (const float*)(a.ws + WS_KN); const float* GB = (const float*)(a.ws + WS_GB); const float* KNT = (const float*)(a.ws + WS_KNT);
    float* Lm = (float*)(a.ws + WS_L); bf16* AT = (bf16*)(a.ws + WS_AT); bf16* QG = (bf16*)(a.ws + WS_QG); bf16* KDT = (bf16*)(a.ws + WS_KDT); float* GL = (float*)(a.ws + WS_GL);
    for (size_t it = gtid; it < (size_t)NCU * 4096; it += gsz) { const int j = (int)(it % 64), ci = UNI((int)(it / 64)), i = ci % 64, cu = ci / 64;
        const int n = cu % NC, hd = (cu / NC) % DNH, b = cu / (NC * DNH); const size_t mi = (size_t)b * SEQ + n * 64 + i, mj = (size_t)b * SEQ + n * 64 + j;
        const float* ki = KN + mi * 512 + hd * 128; const float* qi = QN + mi * 512 + hd * 128; const float* kt = KNT + (size_t)cu * 8192 + j; float kk = 0.f, qk = 0.f;
        for (int d = 0; d < 128; ++d) { const float kj = kt[(size_t)d * 64]; kk += ki[d] * kj; qk += qi[d] * kj; }
        float lv = 0.f, av = 0.f;
        if (i >= j) { const float dec = FEXP(GB[mi * 16 + hd * 4 + 2] - GB[mj * 16 + hd * 4 + 2]); av = qk * dec; if (i > j) lv = GB[mi * 16 + hd * 4 + 1] * kk * dec; }
        Lm[it] = lv; AT[it] = f2bf(av); }
    for (size_t it = gtid; it < (size_t)NCU * 8192; it += gsz) { const int d = (int)(it % 128), i = (int)((it / 128) % 64), cu = (int)(it / 8192);
        const int n = cu % NC, hd = (cu / NC) % DNH, b = cu / (NC * DNH); const size_t mi = (size_t)b * SEQ + n * 64 + i;
        QG[it] = f2bf(QN[mi * 512 + hd * 128 + d] * FEXP(GB[mi * 16 + hd * 4 + 2])); }
    for (size_t it = gtid; it < (size_t)NCU * 8192; it += gsz) { const int i = (int)(it % 64), cu = (int)(it / 8192);
        const int n = cu % NC, hd = (cu / NC) % DNH, b = cu / (NC * DNH); const size_t mi = (size_t)b * SEQ + n * 64 + i, ml = (size_t)b * SEQ + n * 64 + 63;
        const float gci = GB[mi * 16 + hd * 4 + 2], gcl = GB[ml * 16 + hd * 4 + 2];
        KDT[it] = f2bf(KNT[it] * FEXP(gcl - gci)); if ((it % 8192) == 0) GL[cu] = FEXP(gcl); }
}
HD void ph_dn_solve(const Args& a, size_t gtid, size_t gsz) {
    const float* QKV = (const float*)(a.ws + WS_QKV); const float* KN = (const float*)(a.ws + WS_KN); const float* GB = (const float*)(a.ws + WS_GB); const float* Lm = (const float*)(a.ws + WS_L);
    float* UT = (float*)(a.ws + WS_UT); bf16* WN = (bf16*)(a.ws + WS_WN);
    for (size_t it = gtid; it < (size_t)NCU * 256; it += gsz) { const int col = (int)(it % 256), cu = UNI((int)(it / 256));
        const int n = cu % NC, hd = (cu / NC) % DNH, b = cu / (NC * DNH); const size_t m0 = (size_t)b * SEQ + n * 64; const float* Lc = Lm + (size_t)cu * 4096;
        float X[64];
#pragma unroll
        for (int j = 0; j < 64; ++j) { const float beta = GB[(m0 + j) * 16 + hd * 4 + 1];
            X[j] = col < 128 ? QKV[(m0 + j) * 1536 + 1024 + hd * 128 + col] * beta : KN[(m0 + j) * 512 + hd * 128 + (col - 128)] * beta * FEXP(GB[(m0 + j) * 16 + hd * 4 + 2]); }
#pragma unroll
        for (int i = 1; i < 64; ++i) { float acc = X[i];
#pragma unroll
            for (int j = 0; j < i; ++j) acc -= Lc[i * 64 + j] * X[j];
            X[i] = acc; DN_FENCE(); }
        if (col < 128) {
#pragma unroll
            for (int j = 0; j < 64; ++j) UT[(size_t)cu * 8192 + (size_t)col * 64 + j] = X[j]; }
        else {
#pragma unroll
            for (int j = 0; j < 64; ++j) WN[(size_t)cu * 8192 + (size_t)j * 128 + (col - 128)] = f2bf(-X[j]); } }
}
HD float bfr(float x) { return bf2f(f2bf(x)); }
HD void ph_dn_b_naive(const Args& a, int r, size_t gtid, size_t gsz) {
    const float* UT = (const float*)(a.ws + WS_UT); const bf16* WN = (const bf16*)(a.ws + WS_WN); const bf16* QG = (const bf16*)(a.ws + WS_QG); const bf16* AT = (const bf16*)(a.ws + WS_AT);
    const bf16* KDT = (const bf16*)(a.ws + WS_KDT); const float* GL = (const float*)(a.ws + WS_GL); float* ODN = (float*)(a.ws + WS_ODN); float* VN = (float*)(a.ws + WS_SCR);
    for (size_t it = gtid; it < (size_t)NB * DNH * 128; it += gsz) { const int v = (int)(it % 128), bh = UNI((int)(it / 128)), b = bh / DNH, hd = bh % DNH;
        float S[128];
#pragma unroll
        for (int d = 0; d < 128; ++d) S[d] = 0.f;
        for (int n = 0; n < NC; ++n) { const size_t cu = (size_t)bh * NC + n;
            for (int i = 0; i < 64; ++i) { float acc = UT[cu * 8192 + (size_t)v * 64 + i]; const bf16* wr = WN + cu * 8192 + i * 128;
#pragma unroll
                for (int d = 0; d < 128; ++d) acc += bf2f(wr[d]) * S[d];
                VN[((size_t)bh * 64 + i) * 128 + v] = acc; DN_FENCE(); }
            for (int i = 0; i < 64; ++i) { float acc = 0.f; const bf16* qr = QG + cu * 8192 + i * 128;
#pragma unroll
                for (int d = 0; d < 128; ++d) acc += bf2f(qr[d]) * S[d];
                for (int j = 0; j < 64; ++j) acc += bf2f(AT[cu * 4096 + i * 64 + j]) * bfr(VN[((size_t)bh * 64 + j) * 128 + v]);
                ODN[((size_t)b * SEQ + n * 64 + i) * 512 + hd * 128 + v] = acc; DN_FENCE(); }
            const float gl = GL[cu];
#pragma unroll
            for (int d = 0; d < 128; ++d) S[d] *= gl;
            for (int j = 0; j < 64; ++j) { const float vj = bfr(VN[((size_t)bh * 64 + j) * 128 + v]); const bf16* kr = KDT + cu * 8192 + j;
#pragma unroll
                for (int d = 0; d < 128; ++d) S[d] += bf2f(kr[d * 64]) * vj;
                DN_FENCE(); }
            DN_FENCE(); }
        float* so = a.out + O_SP + ((((size_t)r * NB + b) * DNH + hd) * 128) * 128 + v;
#pragma unroll
        for (int d = 0; d < 128; ++d) so[(size_t)d * 128] = S[d]; }
}
HD void ph_rec_out(const Args& a, int r, size_t gtid, size_t gsz) {
    const float* P = (const float*)(a.ws + WS_P); const float* HH = (const float*)(a.ws + WS_HH); const float* ODN = (const float*)(a.ws + WS_ODN); bf16* Y2 = (bf16*)(a.ws + WS_Y2);
    for (size_t i = gtid; i < (size_t)MT * Y2W; i += gsz) { const int m = (int)(i / Y2W), c = (int)(i % Y2W); float y;
        if (c < D_RNN) { float h = HH[(size_t)m * D_RNN + c]; if (m < MP) h += ((const float*)(a.ws + WS_XR))[(size_t)m * D_RNN + c] * ((const float*)(a.ws + WS_CARRY))[(size_t)(m / 64) * D_RNN + c];
            y = h * gelu_tanhf_(P[(size_t)m * LDP + OFF_GATE + c]); }
        else { const int cc = c - D_RNN, hd = cc / 128, vv = cc % 128; const float* o = ODN + (size_t)m * 512 + hd * 128; float ss = 0.f;
            for (int d = 0; d < 128; ++d) ss += o[d] * o[d];
            y = o[vv] / sqrtf(ss * (1.0f / 128.0f) + EPS) * a.in[I_DNW][r * 128 + vv] * siluf_(P[(size_t)m * LDP + OFF_Z + cc]); }
        Y2[i] = f2bf(y); }
}
HD void ph_att_split(const Args& a, int ai, size_t gtid, size_t gsz) {
    const float* P = (const float*)(a.ws + WS_P); constexpr int W = 2 * KVH * HDIM + IDIM;
    for (size_t i = gtid; i < (size_t)MT * W; i += gsz) { const int m = (int)(i / W), c = (int)(i % W);
        if (m < MP) { if (c < 256) a.out[O_KP + ((size_t)ai * MP + m) * 256 + c] = P[(size_t)m * LDP + AO_K + c];
            else if (c < 512) a.out[O_VP + ((size_t)ai * MP + m) * 256 + (c - 256)] = P[(size_t)m * LDP + AO_V + (c - 256)];
            else a.out[O_KIP + ((size_t)ai * MP + m) * 64 + (c - 512)] = P[(size_t)m * LDP + AO_KI + (c - 512)]; }
        else { const int ms = m - MP; if (c < 256) a.out[O_KS + ((size_t)ai * MS + ms) * 256 + c] = P[(size_t)m * LDP + AO_K + c];
            else if (c < 512) a.out[O_VS + ((size_t)ai * MS + ms) * 256 + (c - 256)] = P[(size_t)m * LDP + AO_V + (c - 256)];
            else a.out[O_KIS + ((size_t)ai * MS + ms) * 64 + (c - 512)] = P[(size_t)m * LDP + AO_KI + (c - 512)]; } }
}
HD const float* ki_row_sample(const Args& a, int ai, int db, int s) {
    if (s < PAST) { const int pg = ((const int*)a.in[I_PT])[db * NPAGES + s / PAGE]; return a.in[I_CKI] + (((size_t)ai * NPOOL + pg) * PAGE + s % PAGE) * IDIM; }
    return (const float*)(a.ws + WS_P) + (size_t)(MP + db * DT + (s - PAST)) * LDP + AO_KI;
}
HD void ph_idx_scores(const Args& a, int ai, bool prompt_too, size_t gtid, size_t gsz) {
    const float* P = (const float*)(a.ws + WS_P); float* SCT = (float*)(a.ws + WS_SCT);
    const int lane = (int)(gtid & 63); const size_t w = gtid >> 6, nw = gsz >> 6;
    constexpr int TM = 8, NKB = (SEQ + 63) / 64, NMT = SEQ / TM, NKBS = (PAST + DT + 63) / 64;
    const size_t n_p = (size_t)NB * NMT * NKB, n_s = (size_t)DB * NKBS;
    for (size_t it0 = w + (prompt_too ? 0 : n_p); it0 < n_p + n_s; it0 += nw) { const size_t it = (size_t)UNI((int)it0);
        int mrow0, nrows, s, smax_valid; const float* kr;
        if (it < n_p) { const int b = (int)(it / ((size_t)NMT * NKB)), rr = (int)(it % ((size_t)NMT * NKB)), mt = rr / NKB, kb = rr % NKB;
            if (kb * 64 > mt * TM + TM - 1) continue;
            mrow0 = b * SEQ + mt * TM; nrows = TM; s = kb * 64 + lane; smax_valid = SEQ; kr = P + (size_t)(b * SEQ + (s < SEQ ? s : 0)) * LDP + AO_KI; }
        else { const int q = (int)(it - n_p), db = q / NKBS, kb = q % NKBS; mrow0 = MP + db * DT; nrows = DT; s = kb * 64 + lane; smax_valid = PAST + DT; kr = ki_row_sample(a, ai, db, s < PAST + DT ? s : 0); }
        float kv[IDIM];
#pragma unroll
        for (int d = 0; d < IDIM; ++d) kv[d] = kr[d];
        for (int i = 0; i < nrows; ++i) { const int m = mrow0 + i; const float* qi = P + (size_t)m * LDP + AO_QI; const float* wi = P + (size_t)m * LDP + AO_WI; float sc = 0.f;
            for (int h = 0; h < IH; ++h) { float dot = 0.f;
#pragma unroll
                for (int d = 0; d < IDIM; ++d) dot += qi[h * IDIM + d] * kv[d];
                sc += wi[h] * fmaxf(dot, 0.f); }
            if (s < smax_valid) SCT[(size_t)m * SLD + s] = sc; } }
}
HD void ph_select(const Args& a, size_t gtid, size_t gsz) {
    const float* SCT = (const float*)(a.ws + WS_SCT); int* IDX = (int*)(a.ws + WS_IDX); int* NSEL = (int*)(a.ws + WS_NSEL);
    for (size_t m = gtid; m < (size_t)MT; m += gsz) { const RowInfo ri = row_info((int)m);
        const int n = ri.sample ? PAST + ri.t + 1 : ri.t + 1, K = ri.sample ? TOPK_S : TOPK_P; const float* col = SCT + m * SLD; int* out = IDX + m * KROW;
        if (n <= K) { for (int j = 0; j < n; ++j) out[j] = j; NSEL[m] = n; continue; }
        unsigned lo = 0u;
        for (int bit = 31; bit >= 0; --bit) { const unsigned cand = lo | (1u << bit); int c = 0;
            for (int s = 0; s < n; ++s) c += (fkey(col[s]) >= cand) ? 1 : 0;
            if (c >= K) lo = cand; }
        int cnt = 0;
        for (int s = 0; s < n; ++s) if (fkey(col[s]) > lo) out[cnt++] = s;
        for (int s = 0; s < n && cnt < K; ++s) if (fkey(col[s]) == lo) out[cnt++] = s;
        NSEL[m] = K; }
}
HD const float* kv_row(const Args& a, int ai, const RowInfo& ri, int idx, int kvh, bool isv) {
    const float* P = (const float*)(a.ws + WS_P); const int off = (isv ? AO_V : AO_K) + kvh * HDIM;
    if (!ri.sample) return P + (size_t)(ri.row0 + idx) * LDP + off;
    const int db = ri.seq - NB;
    if (idx >= PAST) return P + (size_t)(MP + db * DT + (idx - PAST)) * LDP + off;
    const int pg = ((const int*)a.in[I_PT])[db * NPAGES + idx / PAGE];
    return a.in[isv ? I_CV : I_CK] + ((((size_t)ai * NPOOL + pg) * PAGE + idx % PAGE) * KVH + kvh) * HDIM;
}
HD void ph_sp_scores(const Args& a, int ai, int m_lo, int m_hi, size_t gtid, size_t gsz) {
    const float* P = (const float*)(a.ws + WS_P); const int* IDX = (const int*)(a.ws + WS_IDX); const int* NSEL = (const int*)(a.ws + WS_NSEL); float* SCR = (float*)(a.ws + WS_SCR);
    for (size_t i = gtid + (size_t)m_lo * AH * KMAX; i < (size_t)m_hi * AH * KMAX; i += gsz) { const int j = (int)(i % KMAX), h = (int)((i / KMAX) % AH), m = (int)(i / ((size_t)KMAX * AH));
        if (j >= NSEL[m]) { SCR[i] = -1e30f; continue; }
        const RowInfo ri = row_info(m); const float* kr = kv_row(a, ai, ri, IDX[(size_t)m * KROW + j], h / GROUP, false); const float* q = P + (size_t)m * LDP + h * HDIM; float dot = 0.f;
        for (int d = 0; d < HDIM; ++d) dot += q[d] * kr[d];
        SCR[i] = dot * 0.08838834764831845f; }
}
HD void ph_sp_out(const Args& a, int ai, int m_lo, int m_hi, size_t gtid, size_t gsz) {
    const int* IDX = (const int*)(a.ws + WS_IDX); const int* NSEL = (const int*)(a.ws + WS_NSEL); const float* SCR = (const float*)(a.ws + WS_SCR); bf16* O = (bf16*)(a.ws + WS_Y2);
    for (size_t i = gtid + (size_t)m_lo * AH * HDIM; i < (size_t)m_hi * AH * HDIM; i += gsz) { const int d = (int)(i % HDIM), h = (int)((i / HDIM) % AH), m = (int)(i / ((size_t)HDIM * AH));
        const int ns = NSEL[m]; const float* sc = SCR + ((size_t)m * AH + h) * KMAX; const RowInfo ri = row_info(m);
        float mx = -3e38f; for (int j = 0; j < ns; ++j) mx = fmaxf(mx, sc[j]);
        float sum = 0.f, acc = 0.f;
        for (int j = 0; j < ns; ++j) { const float p = FEXP(sc[j] - mx); sum += p; acc += p * kv_row(a, ai, ri, IDX[(size_t)m * KROW + j], h / GROUP, true)[d]; }
        O[(size_t)m * D + h * HDIM + d] = f2bf(acc / sum); }
}
#ifndef HOST_TEST
#define LAS __attribute__((address_space(3)))

constexpr int LDS_WTAB = 131072 + 64;
__device__ __forceinline__ int TID() { extern __shared__ __attribute__((aligned(16))) unsigned char lds_dyn_[]; const unsigned hw = (unsigned)__builtin_amdgcn_s_getreg((5 << 11) | 4) & 63u;
    const int wvi = ((const LAS int*)((LAS unsigned char*)lds_dyn_ + LDS_WTAB))[hw]; int ln_; asm volatile("v_mbcnt_lo_u32_b32 %0, -1, 0\n\tv_mbcnt_hi_u32_b32 %0, -1, %0" : "=v"(ln_));
    return (wvi << 6) | ln_; }
#define XB_TMO      128
#define XB_XCNT(j)  (256  + 64 * (j))
#define XB_XSUB(j)  (1280 + 64 * (j))
#define XB_XGEN(j)  (2304 + 64 * (j))
#define XB_TOP      3328
#define XB_TOPGEN   3392
#define XCD_BAR_WORDS 3456
#define XB_SPIN_CAP (1u << 22)

__device__ __forceinline__ unsigned xb_ld(unsigned* p)              { return __hip_atomic_load(p, __ATOMIC_RELAXED, __HIP_MEMORY_SCOPE_AGENT); }
__device__ __forceinline__ unsigned xb_add(unsigned* p, unsigned v) { return __hip_atomic_fetch_add(p, v, __ATOMIC_RELAXED, __HIP_MEMORY_SCOPE_AGENT); }
__device__ __forceinline__ unsigned xb_xcc_id() { return (unsigned)__builtin_amdgcn_s_getreg((3 << 11) | 20) & 0xFu; }
#define XB_SPIN(cond, bar) do { unsigned _sp = 0; while (cond) { __builtin_amdgcn_s_sleep(1); \
    if ((++_sp & 255u) == 0u) { if (xb_ld(&(bar)[XB_TMO])) break; if (_sp > XB_SPIN_CAP) { atomicAdd(&(bar)[XB_TMO], 1u); break; } } } } while (0)

struct XcdBarrier {
    unsigned* bar; unsigned x;
    volatile LAS unsigned* st;
};

__device__ __forceinline__ XcdBarrier xcd_barrier_post(unsigned* bar, volatile LAS unsigned* st) {
    XcdBarrier b; b.bar = bar; b.x = xb_xcc_id(); b.st = st;
    if (TID() == 0) (void)xb_add(&bar[XB_XCNT(b.x)], 1u);
    return b;
}
__device__ __forceinline__ void xcd_barrier_complete(unsigned* bar, unsigned x, unsigned& nloc, unsigned& nx) {
    const unsigned G = gridDim.x * gridDim.y * gridDim.z;
    unsigned sum, cnt, mine, sp = 0u;
    for (;;) {
        sum = 0u; cnt = 0u; mine = 0u;
#pragma unroll
        for (unsigned j = 0; j < 16; ++j) { const unsigned c = xb_ld(&bar[XB_XCNT(j)]); sum += c; cnt += (c > 0u) ? 1u : 0u; mine = (j == x) ? c : mine; }
        if (sum == G) break;
        __builtin_amdgcn_s_sleep(1);
        if ((++sp & 255u) == 0u) { if (xb_ld(&bar[XB_TMO])) break; if (sp > XB_SPIN_CAP) { atomicAdd(&bar[XB_TMO], 1u); break; } }
    }
    nloc = mine > 0u ? mine : 1u; nx = cnt > 0u ? cnt : 1u;
}

__device__ __forceinline__ void xcd_barrier(const XcdBarrier& b) {
    asm volatile("s_waitcnt vmcnt(0)" ::: "memory");
    __syncthreads();
    if (TID() == 0) {
        unsigned* bar = b.bar;
        __builtin_amdgcn_s_waitcnt(0);
        unsigned nloc = b.st[0], nx = b.st[1];
        if (nloc == 0u) { xcd_barrier_complete(bar, b.x, nloc, nx); b.st[0] = nloc; b.st[1] = nx; }
        const unsigned old = xb_add(&bar[XB_XSUB(b.x)], 1u);
        const unsigned gen = old / nloc;
        if (old + 1u == (gen + 1u) * nloc) {
            __builtin_amdgcn_fence(__ATOMIC_RELEASE, "agent");
            asm volatile("s_waitcnt vmcnt(0)" ::: "memory");
            const unsigned og = xb_add(&bar[XB_TOP], 1u);
            const unsigned tg = og / nx;
            if (og + 1u == (tg + 1u) * nx) xb_add(&bar[XB_TOPGEN], 1u);
            else XB_SPIN(xb_ld(&bar[XB_TOPGEN]) == tg, bar);
            __builtin_amdgcn_fence(__ATOMIC_ACQUIRE, "agent");
            xb_add(&bar[XB_XGEN(b.x)], 1u);
            asm volatile("s_waitcnt vmcnt(0)" ::: "memory");
        } else {
            XB_SPIN(xb_ld(&bar[XB_XGEN(b.x)]) == gen, bar);
            __builtin_amdgcn_fence(__ATOMIC_ACQUIRE, "agent");
            asm volatile("s_waitcnt vmcnt(0)" ::: "memory");
        }
    }
    __syncthreads();
}

namespace pg8 {
#define PG8_LAS __attribute__((address_space(3)))
typedef unsigned short bf16_t;
typedef short bf16x8 __attribute__((ext_vector_type(8)));
typedef float f32x4 __attribute__((ext_vector_type(4)));
typedef unsigned u32x4 __attribute__((ext_vector_type(4)));
constexpr int BM = 256, BK = 64, HALF = 128, HTB = HALF * BK * 2  , STAGE_BYTES = 8 * HTB, NXCD = 8, WGM = 8;

__host__ __device__ __forceinline__ int lds_byte(int r, int c) { const int st = (r >> 4) * 2 + (c >> 5), rr = r & 15, cc = c & 31, ob = rr * 64 + cc * 2; return st * 1024 + (ob ^ (((ob >> 9) & 1) << 5)); }
__host__ __device__ __forceinline__ void stage_rc(int b, int& R, int& C) { const int st = b / 1024, sb = b % 1024, swz = sb ^ (((sb >> 9) & 1) << 5); R = (st >> 1) * 16 + swz / 64; C = (st & 1) * 32 + (swz % 64) / 2; }
__host__ __device__ __forceinline__ int perm32(int rho) { const int n = rho >> 4, i = rho & 15; return 8 * (i >> 2) + 4 * n + (i & 3); }

struct Unit { int pm, pn; };
struct Gemm { const bf16_t* A; const bf16_t* Bt; int M, N, K; };

struct StaticOrder {
    int nM, nN, nwg, G, c;
    __host__ __device__ void init(int M, int N, int G_, int c_) { nM = M / BM; nN = N / BM; nwg = nM * nN; G = G_; c = c_; }
    __host__ __device__ bool next(int i, Unit& u) const {
        const long L = (long)i * G + c; if (L >= nwg) return false;
        int wgid = (int)L; { const int q = nwg / NXCD, r = nwg % NXCD, xcd = wgid % NXCD, off = wgid / NXCD; wgid = (xcd < r ? xcd * (q + 1) : r * (q + 1) + (xcd - r) * q) + off; }
        const int nig = WGM * nN, gid = wgid / nig, fm = gid * WGM, gsz = (nM - fm) < WGM ? (nM - fm) : WGM;
        u.pm = fm + ((wgid % nig) % gsz); u.pn = (wgid % nig) / gsz; return true;
    }
    __device__ __forceinline__ void a_ready(const Unit&) const {}
    __device__ __forceinline__ void done(const Unit&) const {}
};

__device__ __forceinline__ unsigned cvt_pk_bf16(float lo, float hi) { unsigned r; asm volatile("v_cvt_pk_bf16_f32 %0, %1, %2" : "=v"(r) : "v"(lo), "v"(hi)); return r; }
struct EpiF32 {
    static constexpr bool PERM = false, AFTER_DRAIN = false;
    float* C; int ldc; const float* bias;
    __device__ __forceinline__ void operator()(const f32x4 (&acc)[2][2][4][2], const Unit& u, int wr, int wc, int fr, int fq) const {
        const int row0 = u.pm * BM + wr * 64 + fr, col0 = u.pn * BM + wc * 32 + 4 * fq;
        f32x4 bv[2][2];
#pragma unroll
        for (int bj = 0; bj < 2; ++bj)
#pragma unroll
            for (int n = 0; n < 2; ++n) bv[bj][n] = bias ? *(const f32x4*)(bias + col0 + bj * HALF + n * 16) : (f32x4){0.f, 0.f, 0.f, 0.f};
#pragma unroll
        for (int ai = 0; ai < 2; ++ai)
#pragma unroll
            for (int m = 0; m < 4; ++m) { float* rowp = C + (size_t)(row0 + ai * HALF + m * 16) * ldc + col0;
#pragma unroll
                for (int bj = 0; bj < 2; ++bj)
#pragma unroll
                    for (int n = 0; n < 2; ++n) *(f32x4*)(rowp + bj * HALF + n * 16) = acc[ai][bj][m][n] + bv[bj][n]; }
    }
};
template <class Epi, class Sched, bool STAMP = false>
__device__ __forceinline__ void gemm_phase(PG8_LAS unsigned char* lds, const Gemm g, const Sched& S, const Epi& E, unsigned long long* stamps) {
    int tid_ = TID(); asm volatile("" : "+v"(tid_));
    const int tid = tid_, wid = __builtin_amdgcn_readfirstlane(tid >> 6), lane = tid & 63, wr = wid >> 2, wc = wid & 3, fr = lane & 15, fq = lane >> 4;
    const int K = g.K, nt = K / BK;
    int ts_lo = 0, ts_hi = 0, nts = 0; const unsigned long long rt_entry = STAMP ? (unsigned long long)wall_clock64() : 0ull;
#define PG8_STAMP() do { if (STAMP && wid == 0 && nts < 64) { const unsigned long long _c = (unsigned long long)clock64(); \
        ts_lo = (lane == nts) ? (int)(unsigned)_c : ts_lo; ts_hi = (lane == nts) ? (int)(unsigned)(_c >> 32) : ts_hi; ++nts; } } while (0)
    PG8_STAMP();
    unsigned voffA[2], voffB[2];
#pragma unroll
    for (int i = 0; i < 2; ++i) { int R, C; stage_rc(tid * 16 + i * 8192, R, C); const int Rb = Epi::PERM ? ((R & ~31) + perm32(R & 31)) : R;
        voffA[i] = (unsigned)(R * K + C) * 2u; voffB[i] = (unsigned)(Rb * K + C) * 2u; }
    const size_t kstep = (size_t)(BK * 2);
    const size_t hstep = (size_t)HALF * K * 2;
    const size_t tstep = 2 * hstep;
    const unsigned ldsw = (unsigned)wid * 1024u;
    const int aoff = lds_byte(wr * 64 + fr, fq * 8), boff = lds_byte(wc * 32 + fr, fq * 8);
#define PG8_SA(b, h) (((b) * 2 + (h)) * HTB)
#define PG8_SB(b, h) ((4 + (b) * 2 + (h)) * HTB)
#define PG8_STAGE(bufoff, gbase, voff) do { _Pragma("unroll") for (int _i = 0; _i < 2; ++_i) \
        __builtin_amdgcn_global_load_lds((const unsigned*)((const char*)(gbase) + (voff)[_i]), (PG8_LAS unsigned*)(lds + (bufoff) + ldsw + _i * 8192), 16, 0, 0); } while (0)
#define PG8_LDA(dst, b, h) do { _Pragma("unroll") for (int m = 0; m < 4; ++m) _Pragma("unroll") for (int k = 0; k < 2; ++k) dst[m][k] = *(const PG8_LAS bf16x8*)(lds + PG8_SA(b, h) + aoff + m * 2048 + k * 1024); } while (0)
#define PG8_LDB(dst, b, h) do { _Pragma("unroll") for (int n = 0; n < 2; ++n) _Pragma("unroll") for (int k = 0; k < 2; ++k) dst[n][k] = *(const PG8_LAS bf16x8*)(lds + PG8_SB(b, h) + boff + n * 2048 + k * 1024); } while (0)
#define PG8_MMA(ai, bj, At, Bt) do { __builtin_amdgcn_s_setprio(1); _Pragma("unroll") for (int m = 0; m < 4; ++m) _Pragma("unroll") for (int n = 0; n < 2; ++n) _Pragma("unroll") for (int k = 0; k < 2; ++k) \
        acc[ai][bj][m][n] = __builtin_amdgcn_mfma_f32_16x16x32_bf16(Bt[n][k], At[m][k], acc[ai][bj][m][n], 0, 0, 0); __builtin_amdgcn_s_setprio(0); } while (0)
#define PG8_WAIT_V(n) asm volatile("s_waitcnt vmcnt(" #n ")" ::: "memory")
#define PG8_WAIT_L(n) asm volatile("s_waitcnt lgkmcnt(" #n ")" ::: "memory")
#define PG8_BAR __builtin_amdgcn_s_barrier()
#define PG8_SCHED __builtin_amdgcn_sched_barrier(0)
    Unit cur, nxt; int ui = 0;
    if (!S.next(0, cur)) return;
    f32x4 acc[2][2][4][2];
#pragma unroll
    for (int a = 0; a < 2; ++a)
#pragma unroll
        for (int b = 0; b < 2; ++b)
#pragma unroll
            for (int m = 0; m < 4; ++m)
#pragma unroll
                for (int n = 0; n < 2; ++n) acc[a][b][m][n] = (f32x4){0.f, 0.f, 0.f, 0.f};
    bf16x8 At[4][2], B0[2][2], B1[2][2];
    const char* cA = (const char*)g.A + (size_t)cur.pm * tstep; const char* cB = (const char*)g.Bt + (size_t)cur.pn * tstep;
    S.a_ready(cur);
    PG8_STAGE(PG8_SB(0, 0), cB, voffB); PG8_STAGE(PG8_SA(0, 0), cA, voffA); PG8_STAGE(PG8_SB(0, 1), cB + hstep, voffB); PG8_STAGE(PG8_SA(0, 1), cA + hstep, voffA);
    if (wr == 1) PG8_BAR;
    PG8_WAIT_V(4); PG8_BAR;
    PG8_STAGE(PG8_SB(1, 0), cB + kstep, voffB); PG8_STAGE(PG8_SA(1, 0), cA + kstep, voffA); PG8_STAGE(PG8_SB(1, 1), cB + hstep + kstep, voffB);
    PG8_WAIT_V(6); PG8_BAR;
    PG8_STAMP();
    for (;;) {
        const bool has_next = S.next(ui + 1, nxt);
        const char* nA = has_next ? (const char*)g.A + (size_t)nxt.pm * tstep : cA; const char* nB = has_next ? (const char*)g.Bt + (size_t)nxt.pn * tstep : cB;
        for (int t = 0; t < nt; t += 2) {
            const bool last = (t == nt - 2);
            const char* a1 = cA + (size_t)(t + 1) * kstep;
            const char* a2 = last ? nA : cA + (size_t)(t + 2) * kstep; const char* b2 = last ? nB : cB + (size_t)(t + 2) * kstep;
            const char* a3 = a2 + kstep; const char* b3 = b2 + kstep;
            if (last && has_next) S.a_ready(nxt);
            PG8_LDB(B0, 0, 0); PG8_SCHED; PG8_LDA(At, 0, 0); PG8_STAGE(PG8_SA(1, 1), a1 + hstep, voffA);
            PG8_WAIT_L(8); PG8_BAR; PG8_WAIT_L(0); PG8_MMA(0, 0, At, B0); PG8_BAR; PG8_SCHED;
            PG8_LDB(B1, 0, 1); PG8_STAGE(PG8_SB(0, 0), b2, voffB);
            PG8_BAR; PG8_WAIT_L(0); PG8_MMA(0, 1, At, B1); PG8_BAR;
            PG8_LDA(At, 0, 1); PG8_STAGE(PG8_SA(0, 0), a2, voffA);
            PG8_BAR; PG8_WAIT_L(0); PG8_MMA(1, 0, At, B0); PG8_BAR; PG8_SCHED;
            PG8_STAGE(PG8_SB(0, 1), b2 + hstep, voffB);
            PG8_WAIT_V(6); PG8_BAR; PG8_MMA(1, 1, At, B1); PG8_BAR;
            PG8_LDB(B0, 1, 0); PG8_SCHED; PG8_LDA(At, 1, 0); PG8_STAGE(PG8_SA(0, 1), a2 + hstep, voffA);
            PG8_WAIT_L(8); PG8_BAR; PG8_WAIT_L(0); PG8_MMA(0, 0, At, B0); PG8_BAR; PG8_SCHED;
            PG8_LDB(B1, 1, 1); PG8_STAGE(PG8_SB(1, 0), b3, voffB);
            PG8_BAR; PG8_WAIT_L(0); PG8_MMA(0, 1, At, B1); PG8_BAR;
            PG8_LDA(At, 1, 1); PG8_STAGE(PG8_SA(1, 0), a3, voffA);
            PG8_BAR; PG8_WAIT_L(0); PG8_MMA(1, 0, At, B0); PG8_BAR; PG8_SCHED;
            PG8_STAGE(PG8_SB(1, 1), b3 + hstep, voffB);
            PG8_WAIT_V(6); PG8_BAR; PG8_MMA(1, 1, At, B1); PG8_BAR;
        }
        PG8_STAMP();
        if constexpr (!Epi::AFTER_DRAIN) { E(acc, cur, wr, wc, fr, fq); S.done(cur); }
        PG8_STAMP();
        if (!has_next) break;
#pragma unroll
        for (int a = 0; a < 2; ++a)
#pragma unroll
            for (int b = 0; b < 2; ++b)
#pragma unroll
                for (int m = 0; m < 4; ++m)
#pragma unroll
                    for (int n = 0; n < 2; ++n) acc[a][b][m][n] = (f32x4){0.f, 0.f, 0.f, 0.f};
        cur = nxt; cA = nA; cB = nB; ++ui;
    }
    PG8_WAIT_V(0);
    if (wr == 0) PG8_BAR;
    PG8_BAR;
    if constexpr (Epi::AFTER_DRAIN) { E.fused(acc, cur, wr, wc, fr, fq, lds, wid, lane); S.done(cur); }
    PG8_STAMP();
    if (STAMP && wid == 0) { stamps[lane] = lane < nts ? (((unsigned long long)(unsigned)ts_hi << 32) | (unsigned)ts_lo) : 0ull;
        if (lane == 62) stamps[62] = rt_entry; if (lane == 63) stamps[63] = (unsigned long long)wall_clock64(); }
#undef PG8_STAMP
#undef PG8_SA
#undef PG8_SB
#undef PG8_STAGE
#undef PG8_LDA
#undef PG8_LDB
#undef PG8_MMA
#undef PG8_WAIT_V
#undef PG8_WAIT_L
#undef PG8_BAR
#undef PG8_SCHED
}
}
#endif

#ifndef HOST_TEST
#include <cstdio>
#define FRAG_OFF(row_, k_, KS_) ((((((row_) >> 4) * (KS_) + ((k_) >> 5)) * 64 + (((k_) >> 3) & 3) * 16 + ((row_) & 15)) * 8) + ((k_) & 7))
namespace pg8 {
struct EpiAddF32 {
    static constexpr bool PERM = false, AFTER_DRAIN = false;
    float* C; int ldc;
    __device__ __forceinline__ void operator()(const f32x4 (&acc)[2][2][4][2], const Unit& u, int wr, int wc, int fr, int fq) const {
        const int row0 = u.pm * BM + wr * 64 + fr, col0 = u.pn * BM + wc * 32 + 4 * fq;
#pragma unroll
        for (int ai = 0; ai < 2; ++ai)
#pragma unroll
            for (int m = 0; m < 4; ++m) { float* rowp = C + (size_t)(row0 + ai * HALF + m * 16) * ldc + col0;
#pragma unroll
                for (int bj = 0; bj < 2; ++bj)
#pragma unroll
                    for (int n = 0; n < 2; ++n) { f32x4* p = (f32x4*)(rowp + bj * HALF + n * 16); *p = *p + acc[ai][bj][m][n]; } }
    }
};
struct EpiRelu2Bf16 {
    static constexpr bool PERM = true, AFTER_DRAIN = false;
    bf16_t* O; int ldc;
    __device__ __forceinline__ void operator()(const f32x4 (&acc)[2][2][4][2], const Unit& u, int wr, int wc, int fr, int fq) const {
        const int row0 = u.pm * BM + wr * 64 + fr, col0 = u.pn * BM + wc * 32 + 8 * fq;
#pragma unroll
        for (int ai = 0; ai < 2; ++ai)
#pragma unroll
            for (int m = 0; m < 4; ++m) { bf16_t* rowp = O + (size_t)(row0 + ai * HALF + m * 16) * ldc + col0;
#pragma unroll
                for (int bj = 0; bj < 2; ++bj) { f32x4 v0 = acc[ai][bj][m][0], v1 = acc[ai][bj][m][1];
#pragma unroll
                    for (int j = 0; j < 4; ++j) { const float r0 = fmaxf(v0[j], 0.f), r1 = fmaxf(v1[j], 0.f); v0[j] = r0 * r0; v1[j] = r1 * r1; }
                    u32x4 w; w.x = cvt_pk_bf16(v0[0], v0[1]); w.y = cvt_pk_bf16(v0[2], v0[3]); w.z = cvt_pk_bf16(v1[0], v1[1]); w.w = cvt_pk_bf16(v1[2], v1[3]);
                    *(u32x4*)(rowp + bj * HALF) = w; } }
    }
};

__device__ __forceinline__ float epi_shfl_xor(float v, int o, int lane) { return __builtin_bit_cast(float, __builtin_amdgcn_ds_bpermute((lane ^ o) << 2, __builtin_bit_cast(int, v))); }
__device__ __forceinline__ float row_rs(const unsigned long long* ss, int row) { return FRSQ((float)ss[row] * (5.9604644775390625e-08f / D) + EPS); }
struct EpiF32S {
    static constexpr bool PERM = false, AFTER_DRAIN = false;
    float* C; int ldc; const unsigned long long* ss;
    __device__ __forceinline__ void operator()(const f32x4 (&acc)[2][2][4][2], const Unit& u, int wr, int wc, int fr_in, int fq_in) const {
        int fr = fr_in, fq = fq_in; asm volatile("" : "+v"(fr), "+v"(fq));
        const int row0 = u.pm * BM + wr * 64 + fr, col0 = u.pn * BM + wc * 32 + 4 * fq;
#pragma unroll
        for (int ai = 0; ai < 2; ++ai)
#pragma unroll
            for (int m = 0; m < 4; ++m) { const int row = row0 + ai * HALF + m * 16; const float rs = row_rs(ss, row); float* rowp = C + (size_t)row * ldc + col0;
#pragma unroll
                for (int bj = 0; bj < 2; ++bj)
#pragma unroll
                    for (int n = 0; n < 2; ++n) *(f32x4*)(rowp + bj * HALF + n * 16) = acc[ai][bj][m][n] * rs; }
    }
};
struct EpiRelu2S {
    static constexpr bool PERM = true, AFTER_DRAIN = false;
    bf16_t* O; int ldc; const unsigned long long* ss;
    __device__ __forceinline__ void operator()(const f32x4 (&acc)[2][2][4][2], const Unit& u, int wr, int wc, int fr_in, int fq_in) const {
        int fr = fr_in, fq = fq_in; asm volatile("" : "+v"(fr), "+v"(fq));
        const int row0 = u.pm * BM + wr * 64 + fr, col0 = u.pn * BM + wc * 32 + 8 * fq;
#pragma unroll
        for (int ai = 0; ai < 2; ++ai)
#pragma unroll
            for (int m = 0; m < 4; ++m) { const int row = row0 + ai * HALF + m * 16; const float rs = row_rs(ss, row); bf16_t* rowp = O + (size_t)row * ldc + col0;
#pragma unroll
                for (int bj = 0; bj < 2; ++bj) { f32x4 v0 = acc[ai][bj][m][0] * rs, v1 = acc[ai][bj][m][1] * rs;
#pragma unroll
                    for (int j = 0; j < 4; ++j) { const float r0 = fmaxf(v0[j], 0.f), r1 = fmaxf(v1[j], 0.f); v0[j] = r0 * r0; v1[j] = r1 * r1; }
                    u32x4 w; w.x = cvt_pk_bf16(v0[0], v0[1]); w.y = cvt_pk_bf16(v0[2], v0[3]); w.z = cvt_pk_bf16(v1[0], v1[1]); w.w = cvt_pk_bf16(v1[2], v1[3]);
                    *(u32x4*)(rowp + bj * HALF) = w; } }
    }
};
struct EpiAddN {
    static constexpr bool PERM = false, AFTER_DRAIN = false;
    float* C; int ldc; bf16_t* XB; unsigned long long* ss;
    __device__ __forceinline__ void operator()(const f32x4 (&acc)[2][2][4][2], const Unit& u, int wr, int wc, int fr_in, int fq_in) const {
        int fr = fr_in, fq = fq_in; asm volatile("" : "+v"(fr), "+v"(fq));
        const int row0 = u.pm * BM + wr * 64 + fr, col0 = u.pn * BM + wc * 32 + 4 * fq, lane = fq * 16 + fr;
#pragma unroll
        for (int ai = 0; ai < 2; ++ai)
#pragma unroll
            for (int m = 0; m < 4; ++m) { const int row = row0 + ai * HALF + m * 16; float* rowp = C + (size_t)row * ldc + col0; bf16_t* xbp = XB + (size_t)row * ldc + col0; float q = 0.f;
#pragma unroll
                for (int bj = 0; bj < 2; ++bj)
#pragma unroll
                    for (int n = 0; n < 2; ++n) { f32x4* p = (f32x4*)(rowp + bj * HALF + n * 16); const f32x4 v = *p + acc[ai][bj][m][n]; *p = v; q += (v[0] * v[0] + v[1] * v[1]) + (v[2] * v[2] + v[3] * v[3]);
                        unsigned w0 = cvt_pk_bf16(v[0], v[1]), w1 = cvt_pk_bf16(v[2], v[3]); *(uint2*)(xbp + bj * HALF + n * 16) = make_uint2(w0, w1); }
                q += epi_shfl_xor(q, 16, lane); q += epi_shfl_xor(q, 32, lane);
                if (fq == 0) __hip_atomic_fetch_add(ss + row, (unsigned long long)(q * 16777216.0f), __ATOMIC_RELAXED, __HIP_MEMORY_SCOPE_AGENT); }
    }
};
struct EpiAttS {
    static constexpr bool PERM = false, AFTER_DRAIN = false;
    unsigned char* ws; float* out; const unsigned long long* ss; int ai_;
    __device__ __forceinline__ void operator()(const f32x4 (&acc)[2][2][4][2], const Unit& u, int wr, int wc, int fr_in, int fq_in) const {
        int fr = fr_in, fq = fq_in; asm volatile("" : "+v"(fr), "+v"(fq));
        float* P = (float*)(ws + WS_P); constexpr int ldc = LDP; bf16_t* QB = (bf16_t*)(ws + WS_QB); bf16_t* KB = (bf16_t*)(ws + WS_KB); bf16_t* VB = (bf16_t*)(ws + WS_VB); bf16_t* QIB = (bf16_t*)(ws + WS_QIB); bf16_t* KIB = (bf16_t*)(ws + WS_KIB);
        const int row0 = u.pm * BM + wr * 64 + fr; float rsv[2][4];
#pragma unroll
        for (int ai = 0; ai < 2; ++ai)
#pragma unroll
            for (int m = 0; m < 4; ++m) rsv[ai][m] = row_rs(ss, row0 + ai * HALF + m * 16);
#pragma unroll
        for (int bj = 0; bj < 2; ++bj)
#pragma unroll
            for (int n = 0; n < 2; ++n) { const int cb = u.pn * BM + bj * HALF + wc * 32 + n * 16;
                bf16_t* bdst; int bld, bc; float* odst0 = nullptr; float* odst1 = nullptr; int old_ = 0;
                if (cb < AO_K) { bdst = QB; bld = D; bc = cb; }
                else if (cb < AO_V) { bdst = KB; bld = 256; bc = cb - AO_K; odst0 = out + O_KP + (size_t)ai_ * MP * 256 + bc; odst1 = out + O_KS + (size_t)ai_ * MS * 256 + bc; old_ = 256; }
                else if (cb < AO_QI) { bdst = VB; bld = 256; bc = cb - AO_V; odst0 = out + O_VP + (size_t)ai_ * MP * 256 + bc; odst1 = out + O_VS + (size_t)ai_ * MS * 256 + bc; old_ = 256; }
                else if (cb < AO_KI) { bdst = QIB; bld = 512; bc = cb - AO_QI; }
                else if (cb < AO_WI) { bdst = KIB; bld = -1; bc = cb - AO_KI;     odst0 = out + O_KIP + (size_t)ai_ * MP * 64 + bc; odst1 = out + O_KIS + (size_t)ai_ * MS * 64 + bc; old_ = 64; }
                else { bdst = nullptr; bld = 0; bc = 0; }
#pragma unroll
                for (int ai = 0; ai < 2; ++ai)
#pragma unroll
                    for (int m = 0; m < 4; ++m) { const int row = row0 + ai * HALF + m * 16; const f32x4 v = acc[ai][bj][m][n] * rsv[ai][m]; *(f32x4*)(P + (size_t)row * ldc + cb + 4 * fq) = v;
                        if (bdst != nullptr && row < MT) { bf16_t* bp_ = bld >= 0 ? bdst + (size_t)row * bld + bc + 4 * fq : bdst + (size_t)(row >> 4) * 1024 + FRAG_OFF(row & 15, bc + 4 * fq, 2); *(uint2*)bp_ = make_uint2(cvt_pk_bf16(v[0], v[1]), cvt_pk_bf16(v[2], v[3]));
                            if (odst0 != nullptr) { float* op = row < MP ? odst0 + (size_t)row * old_ : odst1 + (size_t)(row - MP) * old_; *(f32x4*)(op + 4 * fq) = v; } } } }
    }
};
}

constexpr int NTHREADS = 512, LDS_BYTES = 147456, LDS_MISC = 131072;
typedef float f32x4_t __attribute__((ext_vector_type(4)));
__device__ __forceinline__ float shfl_xor_l(float v, int o, int lane) { return __builtin_bit_cast(float, __builtin_amdgcn_ds_bpermute((lane ^ o) << 2, __builtin_bit_cast(int, v))); }
__device__ __forceinline__ void ph_rmsnorm(const Args& a, const float* g) {
    static_assert(D == 1024, "device rmsnorm is written for D = 1024");
    const float* X = (const float*)(a.ws + WS_X); bf16* XN = (bf16*)(a.ws + WS_XN);
    int tx_ = TID(); asm volatile("" : "+v"(tx_));
    const int lane = tx_ & 63, wv = blockIdx.x * (NTHREADS >> 6) + (tx_ >> 6), nwv = gridDim.x * (NTHREADS >> 6);
    f32x4_t gv[4];
#pragma unroll
    for (int i = 0; i < 4; ++i) gv[i] = *(const f32x4_t*)(g + (i * 64 + lane) * 4);
    for (int m = wv; m < MPAD; m += nwv) { f32x4_t xv[4]; float ss = 0.f;
#pragma unroll
        for (int i = 0; i < 4; ++i) { xv[i] = *(const f32x4_t*)(X + (size_t)m * D + (i * 64 + lane) * 4); ss += xv[i][0] * xv[i][0] + xv[i][1] * xv[i][1] + xv[i][2] * xv[i][2] + xv[i][3] * xv[i][3]; }
#pragma unroll
        for (int o = 32; o >= 1; o >>= 1) ss += shfl_xor_l(ss, o, lane);
        const float r = FRSQ(ss * (1.0f / D) + EPS);
#pragma unroll
        for (int i = 0; i < 4; ++i) { const f32x4_t y = xv[i] * r * gv[i]; uint2 w; w.x = pg8::cvt_pk_bf16(y[0], y[1]); w.y = pg8::cvt_pk_bf16(y[2], y[3]); *(uint2*)(XN + (size_t)m * D + (i * 64 + lane) * 4) = w; } }
}

__device__ __forceinline__ void ph_prep_x(const Args& a) {
    float* X = (float*)(a.ws + WS_X); bf16* XB = (bf16*)(a.ws + WS_XN); unsigned long long* SS = (unsigned long long*)(a.ws + WS_SS);
    int tx_ = TID(); asm volatile("" : "+v"(tx_));
    const int lane = tx_ & 63, wv = blockIdx.x * (NTHREADS >> 6) + (tx_ >> 6), nwv = gridDim.x * (NTHREADS >> 6);
    for (int m = wv; m < MPAD; m += nwv) { const float* src = m < MP ? a.in[I_XP] + (size_t)m * D : a.in[I_XS] + (size_t)(m - MP) * D; float ss = 0.f;
#pragma unroll
        for (int i = 0; i < 4; ++i) { f32x4_t v = {0.f, 0.f, 0.f, 0.f}; if (m < MT) v = *(const f32x4_t*)(src + (i * 64 + lane) * 4);
            *(f32x4_t*)(X + (size_t)m * D + (i * 64 + lane) * 4) = v; ss += v[0] * v[0] + v[1] * v[1] + v[2] * v[2] + v[3] * v[3];
            uint2 w; w.x = pg8::cvt_pk_bf16(v[0], v[1]); w.y = pg8::cvt_pk_bf16(v[2], v[3]); *(uint2*)(XB + (size_t)m * D + (i * 64 + lane) * 4) = w; }
#pragma unroll
        for (int o = 32; o >= 1; o >>= 1) ss += shfl_xor_l(ss, o, lane);
        if (lane == 0) SS[m] = (unsigned long long)(ss * 16777216.0f); }
}
__device__ __forceinline__ void ph_final(const Args& a) {
    const float* X = (const float*)(a.ws + WS_X); const float* g = a.in[I_NFIN];
    int tx_ = TID(); asm volatile("" : "+v"(tx_));
    const int lane = tx_ & 63, wv = blockIdx.x * (NTHREADS >> 6) + (tx_ >> 6), nwv = gridDim.x * (NTHREADS >> 6);
    f32x4_t gv[4];
#pragma unroll
    for (int i = 0; i < 4; ++i) gv[i] = *(const f32x4_t*)(g + (i * 64 + lane) * 4);
    for (int m = wv; m < MT; m += nwv) { f32x4_t xv[4]; float ss = 0.f;
#pragma unroll
        for (int i = 0; i < 4; ++i) { xv[i] = *(const f32x4_t*)(X + (size_t)m * D + (i * 64 + lane) * 4); ss += xv[i][0] * xv[i][0] + xv[i][1] * xv[i][1] + xv[i][2] * xv[i][2] + xv[i][3] * xv[i][3]; }
#pragma unroll
        for (int o = 32; o >= 1; o >>= 1) ss += shfl_xor_l(ss, o, lane);
        const float r = FRSQ(ss * (1.0f / D) + EPS);
        float* orow = a.out + (m < MP ? O_YP + (size_t)m * D : O_YS + (size_t)(m - MP) * D);
#pragma unroll
        for (int i = 0; i < 4; ++i) *(f32x4_t*)(orow + (i * 64 + lane) * 4) = xv[i] * r * gv[i]; }
}


#ifndef DIAG_WRITE_O
#define DIAG_WRITE_O 1
#define DIAG_WRITE_S 1
#endif
typedef short bf16x8_t __attribute__((ext_vector_type(8)));
typedef unsigned u32x2_t __attribute__((ext_vector_type(2)));
typedef unsigned u32x4_t __attribute__((ext_vector_type(4)));
typedef float f32x2_t __attribute__((ext_vector_type(2)));
typedef __bf16 bf16x2n_t __attribute__((ext_vector_type(2)));
__device__ __forceinline__ unsigned pk_bf16(float lo, float hi) { const f32x2_t v = {lo, hi}; const bf16x2n_t r = __builtin_convertvector(v, bf16x2n_t); return __builtin_bit_cast(unsigned, r); }
__device__ __forceinline__ void ph_dn_b(const Args& a, int r, LAS unsigned char* lds) {
    const float* UT = (const float*)(a.ws + WS_UT); const bf16* WN = (const bf16*)(a.ws + WS_WN); const bf16* QG = (const bf16*)(a.ws + WS_QG); const bf16* AT = (const bf16*)(a.ws + WS_AT);
    const bf16* KDT = (const bf16*)(a.ws + WS_KDT); const float* GL = (const float*)(a.ws + WS_GL); float* ODN = (float*)(a.ws + WS_ODN); float* DUMP = (float*)(a.ws + WS_SCR);
    int tid_ = TID(); asm volatile("" : "+v"(tid_));
    const int tid = tid_, wid = __builtin_amdgcn_readfirstlane(tid >> 6), lane = tid & 63, fr = lane & 15, fq = lane >> 4;
    constexpr int STS = 136, VTS = 72;
    LAS bf16* ST = (LAS bf16*)lds; LAS bf16* VT = (LAS bf16*)(lds + 16 * STS * 2);
    const bool vw = wid < 4; const float uf = vw ? 1.0f : 0.0f;
    for (int unit = blockIdx.x; unit < NB * DNH * 8; unit += gridDim.x) {
        const int slice = unit & 7, bh = unit >> 3, b = bh / DNH, hd = bh % DNH, c0 = slice * 16;
        f32x4_t accS = {0.f, 0.f, 0.f, 0.f};
        for (int i = tid; i < 16 * STS; i += NTHREADS) ST[i] = (bf16)0;
        __syncthreads();
        const int i0 = (wid & 3) * 16;
        const bf16* p1 = (vw ? WN : QG) + (size_t)bh * NC * 8192 + (size_t)((wid & 3) * 4) * 512 + lane * 8;
        const bf16* p2 = AT + (size_t)bh * NC * 4096 + (size_t)((wid & 3) * 2) * 512 + lane * 8;
        const bf16* p3 = KDT + (size_t)bh * NC * 8192 + (size_t)(wid * 2) * 512 + lane * 8;
        const float* pu = UT + (size_t)bh * NC * 8192 + (size_t)(slice * 4 + (wid & 3)) * 256 + lane * 4; const float* pg = GL + (size_t)bh * NC;
        LAS bf16* vtw = VT + (vw ? 0 : 16 * VTS) + fr * VTS + i0 + 4 * fq;
        float* op = (vw ? DUMP + ((size_t)blockIdx.x * NTHREADS + tid) * 4 - (size_t)0 : ODN + ((size_t)b * SEQ + i0 + 4 * fq) * 512 + hd * 128 + c0 + fr);
        const size_t ostep = vw ? 0 : (size_t)64 * 512, oq = vw ? 1 : 512;
        bf16x8_t s0a1[4], s0a2[2], s0a3[2], s1a1[4], s1a2[2], s1a3[2], s2a1[4], s2a2[2], s2a3[2]; f32x4_t s0u, s1u, s2u; float s0g, s1g, s2g;
#define DNB_LOAD(P_, n_) do { const size_t c_ = (size_t)((n_) < NC ? (n_) : NC - 1); \
            _Pragma("unroll") for (int ks = 0; ks < 4; ++ks) P_##a1[ks] = *(const bf16x8_t*)(p1 + c_ * 8192 + ks * 512); \
            _Pragma("unroll") for (int ks = 0; ks < 2; ++ks) { P_##a2[ks] = *(const bf16x8_t*)(p2 + c_ * 4096 + ks * 512); P_##a3[ks] = *(const bf16x8_t*)(p3 + c_ * 8192 + ks * 512); } \
            P_##u = *(const f32x4_t*)(pu + c_ * 8192); P_##g = pg[c_]; } while (0)
#define DNB_BAR() do { asm volatile("s_waitcnt lgkmcnt(0)" ::: "memory"); __builtin_amdgcn_s_barrier(); asm volatile("" ::: "memory"); } while (0)
#define DNB_STEP(C_, L_, n_) do { f32x4_t acc = C_##u * uf; const float gl = C_##g; bf16x8_t x1[4], x2[2], x3[2]; \
            _Pragma("unroll") for (int ks = 0; ks < 4; ++ks) x1[ks] = C_##a1[ks]; \
            _Pragma("unroll") for (int ks = 0; ks < 2; ++ks) { x2[ks] = C_##a2[ks]; x3[ks] = C_##a3[ks]; } \
            DNB_LOAD(L_, (n_) + 2); \
            bf16x8_t bS[4]; \
            _Pragma("unroll") for (int ks = 0; ks < 4; ++ks) bS[ks] = *(const LAS bf16x8_t*)(ST + fr * STS + ks * 32 + fq * 8); \
            _Pragma("unroll") for (int ks = 0; ks < 4; ++ks) acc = __builtin_amdgcn_mfma_f32_16x16x32_bf16(x1[ks], bS[ks], acc, 0, 0, 0); \
            { u32x2_t w; w.x = pk_bf16(acc[0], acc[1]); w.y = pk_bf16(acc[2], acc[3]); *(LAS u32x2_t*)vtw = w; } \
            DNB_BAR(); \
            bf16x8_t bV[2]; \
            _Pragma("unroll") for (int ks = 0; ks < 2; ++ks) bV[ks] = *(const LAS bf16x8_t*)(VT + fr * VTS + ks * 32 + fq * 8); \
            _Pragma("unroll") for (int ks = 0; ks < 2; ++ks) acc = __builtin_amdgcn_mfma_f32_16x16x32_bf16(x2[ks], bV[ks], acc, 0, 0, 0); \
            { float* o_ = op + (size_t)(n_) * ostep; _Pragma("unroll") for (int q = 0; q < 4; ++q) o_[(size_t)q * oq] = acc[q]; } \
            accS = accS * gl; \
            _Pragma("unroll") for (int ks = 0; ks < 2; ++ks) accS = __builtin_amdgcn_mfma_f32_16x16x32_bf16(x3[ks], bV[ks], accS, 0, 0, 0); \
            { u32x2_t w; w.x = pk_bf16(accS[0], accS[1]); w.y = pk_bf16(accS[2], accS[3]); *(LAS u32x2_t*)(ST + fr * STS + wid * 16 + 4 * fq) = w; } \
            DNB_BAR(); } while (0)
        static_assert(NC % 3 == 2, "the chunk loop is peeled for NC = 3 k + 2");
        DNB_LOAD(s0, 0); DNB_LOAD(s1, 1);
        int n = 0;
        for (; n + 2 < NC; n += 3) { DNB_STEP(s0, s2, n); DNB_STEP(s1, s0, n + 1); DNB_STEP(s2, s1, n + 2); }
        DNB_STEP(s0, s2, n); DNB_STEP(s1, s0, n + 1);
#undef DNB_STEP
#undef DNB_LOAD
        float* sp = a.out + O_SP + ((((size_t)r * NB + b) * DNH + hd) * 128 + wid * 16 + 4 * fq) * 128 + c0 + fr;
#pragma unroll
        for (int q = 0; q < 4; ++q) sp[(size_t)q * 128] = accS[q];
        __syncthreads();
    }
}


template <int NREG> __device__ __forceinline__ void select_row(const float* __restrict__ row, int n, int K, int* __restrict__ out, unsigned lane, LAS unsigned* cand_lds) {
    static_assert(NREG * 64 <= SLD, "row buffer too short");
    lane &= 63u;
    unsigned key[NREG];
#pragma unroll
    for (int i = 0; i < NREG; ++i) { const float f = __builtin_nontemporal_load(row + i * 64u + lane); key[i] = fkey(f) & (0u - ((unsigned)((int)(i * 64u + lane) - n) >> 31)); }
    if (NREG >= 32 && NREG <= 128 && n >= 1024) { unsigned ls = 0u;
        for (int bit = 31; bit >= 0; --bit) { const unsigned cand = ls | (1u << bit); int c = 0;
#pragma unroll
            for (int i = 0; i < NREG; i += 8) c += __builtin_popcountll(__ballot(key[i] >= cand));
            if (c >= 48) ls = cand;
            if (c == 48) break; }
        int c0 = 0;
#pragma unroll
        for (int i = 0; i < NREG; ++i) c0 += __builtin_popcountll(__ballot(key[i] >= ls));
        if (c0 >= K && c0 <= 512) {
            asm volatile("" : "+v"(lane)); lane &= 63u; const unsigned long long bl = (1ull << lane) - 1ull; int base = 0;
            unsigned ls2 = ls; asm volatile("" : "+v"(ls2));
#pragma unroll
            for (int i = 0; i < NREG; ++i) { const bool g = key[i] >= ls2; const unsigned long long mg = __ballot(g);
                const int p = base + __builtin_popcountll(mg & bl); cand_lds[g ? (unsigned)p : 1024u + lane] = key[i]; cand_lds[g ? 512u + p : 1088u + lane] = i * 64u + lane;
                base += __builtin_popcountll(mg); }
            asm volatile("s_waitcnt lgkmcnt(0)" ::: "memory");
            unsigned ck[8], ci[8];
#pragma unroll
            for (int q = 0; q < 8; ++q) { const int p = q * 64 + (int)lane; const bool v = p < c0; ck[q] = v ? cand_lds[p] : 0u; ci[q] = v ? cand_lds[512 + p] : 0u; }
            unsigned lo2 = 0u;
            for (int bit = 31; bit >= 0; --bit) { const unsigned cand = lo2 | (1u << bit); int c = 0;
#pragma unroll
                for (int q = 0; q < 8; ++q) c += __builtin_popcountll(__ballot(ck[q] >= cand));
                if (c >= K) lo2 = cand;
                if (c == K) break; }
            int bg2 = 0;
#pragma unroll
            for (int q = 0; q < 8; ++q) { const bool g = ck[q] > lo2; const unsigned long long mg = __ballot(g);
                out[g ? (unsigned)(bg2 + __builtin_popcountll(mg & bl)) : KMAX + lane] = (int)ci[q]; bg2 += __builtin_popcountll(mg); }
            int be2 = 0;
#pragma unroll
            for (int q = 0; q < 8; ++q) { const bool e = ck[q] == lo2; const unsigned long long me = __ballot(e); const int slot = bg2 + be2 + __builtin_popcountll(me & bl);
                out[(e && slot < K) ? (unsigned)slot : KMAX + lane] = (int)ci[q]; be2 += __builtin_popcountll(me); }
            asm volatile("s_waitcnt lgkmcnt(0)" ::: "memory");
            return; } }
    unsigned lo = 0u;
    for (int bit = 31; bit >= 0; --bit) { const unsigned cand = lo | (1u << bit); int c = 0;
#pragma unroll
        for (int i = 0; i < NREG; ++i) c += __builtin_popcountll(__ballot(key[i] >= cand));
        if (c >= K) lo = cand;
        if (c == K) break; }
    asm volatile("" : "+v"(lane)); lane &= 63u;
    const unsigned long long below = (1ull << lane) - 1ull; int bg = 0;
#pragma unroll
    for (int i = 0; i < NREG; ++i) { const bool g = key[i] > lo; const unsigned long long mg = __ballot(g);
        out[g ? (unsigned)(bg + __builtin_popcountll(mg & below)) : KMAX + lane] = (int)(i * 64u + lane); bg += __builtin_popcountll(mg); }
    const int cg = bg; int be = 0; asm volatile("" : "+v"(lane)); lane &= 63u; const unsigned long long below2 = (1ull << lane) - 1ull;
#pragma unroll
    for (int i = 0; i < NREG; ++i) { const bool e = key[i] == lo; const unsigned long long me = __ballot(e); const int slot = cg + be + __builtin_popcountll(me & below2);
        out[(e && slot < K) ? (unsigned)slot : KMAX + lane] = (int)(i * 64u + lane); be += __builtin_popcountll(me); }
}
__device__ __forceinline__ void ph_select_w(const Args& a, LAS unsigned char* lds) {
    const float* SC = (const float*)(a.ws + WS_SCT); int* IDX = (int*)(a.ws + WS_IDX); int* NSEL = (int*)(a.ws + WS_NSEL);
    int tx_ = TID(); asm volatile("" : "+v"(tx_));
    const int lane0 = tx_ & 63, wv = __builtin_amdgcn_readfirstlane(blockIdx.x * (NTHREADS >> 6) + (tx_ >> 6)), nwv = gridDim.x * (NTHREADS >> 6);
    LAS unsigned* cand = (LAS unsigned*)(lds + (tx_ >> 6) * 4608);
    for (int m = MP + wv; m < MT; m += nwv) { const RowInfo ri = row_info(m); int lane = lane0; asm volatile("" : "+v"(lane));
        const int n = PAST + ri.t + 1, K = TOPK_S; const float* row = SC + (size_t)m * SLD; int* out = IDX + (size_t)m * KROW;
        if (n <= K) { for (int j = lane; j < n; j += 64) out[j] = j; if (lane == 0) NSEL[m] = n; continue; }
        select_row<(SLD / 64)>(row, n, K, out, lane, cand);
        if (lane == 0) NSEL[m] = K; }
}


__device__ __forceinline__ void ph_att_split_dev(const Args& a, int ai, size_t gtid, size_t gsz) {
    const float* P = (const float*)(a.ws + WS_P); bf16* QB = (bf16*)(a.ws + WS_XN); bf16* KB = (bf16*)(a.ws + WS_KB); bf16* VB = (bf16*)(a.ws + WS_VB); bf16* QIB = (bf16*)(a.ws + WS_QIB); bf16* KIB = (bf16*)(a.ws + WS_KIB);
    constexpr int W = AO_WI;
    for (size_t i = gtid; i < (size_t)MT * W; i += gsz) { const int m = (int)(i / W), c = (int)(i % W); const float v = P[(size_t)m * LDP + c];
        if (c < AO_K) QB[(size_t)m * D + c] = f2bf(v);
        else if (c < AO_V) { const int cc = c - AO_K; KB[(size_t)m * 256 + cc] = f2bf(v); if (m < MP) a.out[O_KP + ((size_t)ai * MP + m) * 256 + cc] = v; else a.out[O_KS + ((size_t)ai * MS + (m - MP)) * 256 + cc] = v; }
        else if (c < AO_QI) { const int cc = c - AO_V; VB[(size_t)m * 256 + cc] = f2bf(v); if (m < MP) a.out[O_VP + ((size_t)ai * MP + m) * 256 + cc] = v; else a.out[O_VS + ((size_t)ai * MS + (m - MP)) * 256 + cc] = v; }
        else if (c < AO_KI) QIB[(size_t)m * 512 + (c - AO_QI)] = f2bf(v);
        else { const int cc = c - AO_KI; KIB[(size_t)m * 64 + cc] = f2bf(v); if (m < MP) a.out[O_KIP + ((size_t)ai * MP + m) * 64 + cc] = v; else a.out[O_KIS + ((size_t)ai * MS + (m - MP)) * 64 + cc] = v; } }
}
__device__ __forceinline__ void ph_idx_mfma(const Args& a, LAS unsigned char* lds) {
    const float* P = (const float*)(a.ws + WS_P); const bf16* QIB = (const bf16*)(a.ws + WS_QIB); const bf16* KIB = (const bf16*)(a.ws + WS_KIB); float* SC = (float*)(a.ws + WS_SCT); int* IDX = (int*)(a.ws + WS_IDX); int* NSEL = (int*)(a.ws + WS_NSEL);
    int tx_ = TID(); asm volatile("" : "+v"(tx_));
    const int lane = tx_ & 63, fr = lane & 15, fq = lane >> 4, wv = __builtin_amdgcn_readfirstlane(blockIdx.x * (NTHREADS >> 6) + (tx_ >> 6)), nwv = gridDim.x * (NTHREADS >> 6);
    constexpr int NU = MP / 4;
    for (int pr2 = wv * 2; pr2 < NU; pr2 += nwv * 2) for (int u0 = pr2; u0 < pr2 + 2; ++u0) { const int hh = u0 >> 1, u = (u0 & 1) ? (NU - 1 - hh) : hh;
        const int m0 = u * 4, b = m0 / SEQ, t0 = m0 % SEQ;
        int lnu = lane; asm volatile("" : "+v"(lnu)); const int fr = lnu & 15, fq = (lnu >> 4) & 3;
        bf16x8_t aQ[2][2];
#pragma unroll
        for (int p = 0; p < 2; ++p)
#pragma unroll
            for (int ks = 0; ks < 2; ++ks) aQ[p][ks] = *(const bf16x8_t*)(QIB + (size_t)(m0 + (fr >> 2)) * 512 + (4 * p + (fr & 3)) * 64 + ks * 32 + fq * 8);
        const f32x4_t w0 = *(const f32x4_t*)(P + (size_t)(m0 + fq) * LDP + AO_WI), w1 = *(const f32x4_t*)(P + (size_t)(m0 + fq) * LDP + AO_WI + 4);
        float* scrow = SC + (size_t)(m0 + fq) * SLD + fr;
        const int nkt = (t0 + 3) / 16 + 1;
        bf16x8_t bKa[4][2], bKb[4][2];
#define IDX_LOAD(B_, kt0_) do { _Pragma("unroll") for (int q = 0; q < 4; ++q) { const int kt = (kt0_) + q < nkt ? (kt0_) + q : nkt - 1; const bf16* kr = KIB + ((size_t)b * (SEQ / 16) + kt) * 1024 + lnu * 8; \
            B_[q][0] = *(const bf16x8_t*)kr; B_[q][1] = *(const bf16x8_t*)(kr + 512); } } while (0)
#define IDX_COMP(B_, kt0_) do { _Pragma("unroll") for (int q = 0; q < 4; ++q) { if ((kt0_) + q < nkt) { f32x4_t c0 = {0.f, 0.f, 0.f, 0.f}, c1 = {0.f, 0.f, 0.f, 0.f}; \
                    c0 = __builtin_amdgcn_mfma_f32_16x16x32_bf16(aQ[0][0], B_[q][0], c0, 0, 0, 0); c0 = __builtin_amdgcn_mfma_f32_16x16x32_bf16(aQ[0][1], B_[q][1], c0, 0, 0, 0); \
                    c1 = __builtin_amdgcn_mfma_f32_16x16x32_bf16(aQ[1][0], B_[q][0], c1, 0, 0, 0); c1 = __builtin_amdgcn_mfma_f32_16x16x32_bf16(aQ[1][1], B_[q][1], c1, 0, 0, 0); \
                    __builtin_nontemporal_store((w0[0] * fmaxf(c0[0], 0.f) + w0[1] * fmaxf(c0[1], 0.f)) + (w0[2] * fmaxf(c0[2], 0.f) + w0[3] * fmaxf(c0[3], 0.f)) \
                                             + (w1[0] * fmaxf(c1[0], 0.f) + w1[1] * fmaxf(c1[1], 0.f)) + (w1[2] * fmaxf(c1[2], 0.f) + w1[3] * fmaxf(c1[3], 0.f)), scrow + ((kt0_) + q) * 16); } } } while (0)
        IDX_LOAD(bKa, 0);
        for (int kt0 = 0; kt0 < nkt; kt0 += 8) { IDX_LOAD(bKb, kt0 + 4); IDX_COMP(bKa, kt0); IDX_LOAD(bKa, kt0 + 8); IDX_COMP(bKb, kt0 + 4); }
#undef IDX_LOAD
#undef IDX_COMP
        LAS unsigned* cand = (LAS unsigned*)(lds + (tx_ >> 6) * 4608);
        for (int q = 0; q < 4; ++q) { const int m = m0 + q, n = t0 + q + 1, K = TOPK_P; int ln = lane; asm volatile("" : "+v"(ln));
            const float* row = SC + (size_t)m * SLD; int* out = IDX + (size_t)m * KROW;
            if (n <= K) { for (int j = ln; j < n; j += 64) out[j] = j; if (ln == 0) NSEL[m] = n; continue; }
            if (n <= 2048) select_row<32>(row, n, K, out, ln, cand);
            else if (n <= 4096) select_row<64>(row, n, K, out, ln, cand);
            else if (n <= 6144) select_row<96>(row, n, K, out, ln, cand);
            else select_row<128>(row, n, K, out, ln, cand);
            if (ln == 0) NSEL[m] = K; }
    }
}
__device__ __forceinline__ void ph_idx_sample_mfma(const Args& a, int ai) {
    const float* P = (const float*)(a.ws + WS_P); const bf16* QIB = (const bf16*)(a.ws + WS_QIB); float* SC = (float*)(a.ws + WS_SCT); const int* PT = (const int*)a.in[I_PT]; const float* CKI = a.in[I_CKI];
    int tx_ = TID(); asm volatile("" : "+v"(tx_));
    const int lane = tx_ & 63, fr = lane & 15, fq = lane >> 4, wv = __builtin_amdgcn_readfirstlane(blockIdx.x * (NTHREADS >> 6) + (tx_ >> 6)), nwv = gridDim.x * (NTHREADS >> 6);
    constexpr int NKT = (PAST + DT + 15) / 16, SPL = 64, TPU = (NKT + SPL - 1) / SPL;
    static_assert(PAGE % 16 == 0 && PAST % 16 == 0 && DT <= 16, "sample index tiles");
    for (int u = wv; u < DB * SPL; u += nwv) { const int db = u / SPL, k0 = (u % SPL) * TPU, k1 = (k0 + TPU < NKT) ? k0 + TPU : NKT; const int m0 = MP + db * DT;
        if (k0 >= k1) continue;
        bf16x8_t aQ[2][2];
#pragma unroll
        for (int p = 0; p < 2; ++p)
#pragma unroll
            for (int ks = 0; ks < 2; ++ks) aQ[p][ks] = *(const bf16x8_t*)(QIB + (size_t)(m0 + (fr >> 2)) * 512 + (4 * p + (fr & 3)) * 64 + ks * 32 + fq * 8);
        const f32x4_t w0 = *(const f32x4_t*)(P + (size_t)(m0 + fq) * LDP + AO_WI), w1 = *(const f32x4_t*)(P + (size_t)(m0 + fq) * LDP + AO_WI + 4);
        float* scrow = SC + (size_t)(m0 + fq) * SLD + fr;
        for (int kb = k0; kb < k1; kb += 3) { f32x4_t kf[3][4];
#pragma unroll
            for (int q = 0; q < 3; ++q) { const int kt = kb + q < k1 ? kb + q : k1 - 1, s0 = kt * 16; const float* kr;
                if (s0 < PAST) { const int pg = PT[db * NPAGES + s0 / PAGE]; kr = CKI + (((size_t)ai * NPOOL + pg) * PAGE + (s0 % PAGE) + fr) * IDIM + fq * 8; }
                else kr = P + (size_t)(m0 + (fr < DT ? fr : DT - 1)) * LDP + AO_KI + fq * 8;
                kf[q][0] = *(const f32x4_t*)kr; kf[q][1] = *(const f32x4_t*)(kr + 4); kf[q][2] = *(const f32x4_t*)(kr + 32); kf[q][3] = *(const f32x4_t*)(kr + 36); }
#pragma unroll
            for (int q = 0; q < 3; ++q) { if (kb + q < k1) { const int s0 = (kb + q) * 16; u32x4_t b0, b1;
                b0[0] = pk_bf16(kf[q][0][0], kf[q][0][1]); b0[1] = pk_bf16(kf[q][0][2], kf[q][0][3]); b0[2] = pk_bf16(kf[q][1][0], kf[q][1][1]); b0[3] = pk_bf16(kf[q][1][2], kf[q][1][3]);
                b1[0] = pk_bf16(kf[q][2][0], kf[q][2][1]); b1[1] = pk_bf16(kf[q][2][2], kf[q][2][3]); b1[2] = pk_bf16(kf[q][3][0], kf[q][3][1]); b1[3] = pk_bf16(kf[q][3][2], kf[q][3][3]);
                const bf16x8_t bK0 = __builtin_bit_cast(bf16x8_t, b0), bK1 = __builtin_bit_cast(bf16x8_t, b1);
                f32x4_t c0 = {0.f, 0.f, 0.f, 0.f}, c1 = {0.f, 0.f, 0.f, 0.f};
                c0 = __builtin_amdgcn_mfma_f32_16x16x32_bf16(aQ[0][0], bK0, c0, 0, 0, 0); c0 = __builtin_amdgcn_mfma_f32_16x16x32_bf16(aQ[0][1], bK1, c0, 0, 0, 0);
                c1 = __builtin_amdgcn_mfma_f32_16x16x32_bf16(aQ[1][0], bK0, c1, 0, 0, 0); c1 = __builtin_amdgcn_mfma_f32_16x16x32_bf16(aQ[1][1], bK1, c1, 0, 0, 0);
                scrow[s0] = (w0[0] * fmaxf(c0[0], 0.f) + w0[1] * fmaxf(c0[1], 0.f)) + (w0[2] * fmaxf(c0[2], 0.f) + w0[3] * fmaxf(c0[3], 0.f))
                          + (w1[0] * fmaxf(c1[0], 0.f) + w1[1] * fmaxf(c1[1], 0.f)) + (w1[2] * fmaxf(c1[2], 0.f) + w1[3] * fmaxf(c1[3], 0.f)); } } } }
}

__device__ __forceinline__ void ph_sparse_attn(const Args& a, LAS unsigned char* lds) {
    const bf16* QB = (const bf16*)(a.ws + WS_QB); const bf16* KB = (const bf16*)(a.ws + WS_KB); const bf16* VB = (const bf16*)(a.ws + WS_VB); const int* IDX = (const int*)(a.ws + WS_IDX); const int* NSEL = (const int*)(a.ws + WS_NSEL);
    bf16* O = (bf16*)(a.ws + WS_Y2);
    int tx_ = TID(); asm volatile("" : "+v"(tx_));
    const int lane = tx_ & 63, fr = lane & 15, fq = lane >> 4, wid = __builtin_amdgcn_readfirstlane(tx_ >> 6), wv = blockIdx.x * (NTHREADS >> 6) + wid, nwv = gridDim.x * (NTHREADS >> 6);
    LAS int* IDXS = (LAS int*)(lds + wid * 9216); LAS float* PS = (LAS float*)(lds + wid * 9216 + 1024);
    for (int m = wv; m < MP; m += nwv) { const int b = m / SEQ; const int ns = __builtin_amdgcn_readfirstlane(NSEL[m]);
#pragma unroll
        for (int c = 0; c < 4; ++c) { const int j = lane + 64 * c; IDXS[j] = j < ns ? IDX[(size_t)m * KROW + j] : 0; }
        bf16x8_t bQ[2][4];
#pragma unroll
        for (int kv = 0; kv < 2; ++kv)
#pragma unroll
            for (int ks = 0; ks < 4; ++ks) { bQ[kv][ks] = (bf16x8_t){0, 0, 0, 0, 0, 0, 0, 0}; if (fr < 4) bQ[kv][ks] = *(const bf16x8_t*)(QB + (size_t)m * D + (kv * 4 + fr) * 128 + ks * 32 + fq * 8); }
        asm volatile("s_waitcnt lgkmcnt(0)" ::: "memory");
#pragma unroll
        for (int tb = 0; tb < 16; tb += 2) { bf16x8_t ak[2][2][4];
#pragma unroll
            for (int t = 0; t < 2; ++t) { const int ri = IDXS[(tb + t) * 16 + fr]; const bf16* kb = KB + (size_t)(b * SEQ + ri) * 256 + fq * 8;
#pragma unroll
                for (int kv = 0; kv < 2; ++kv)
#pragma unroll
                    for (int ks = 0; ks < 4; ++ks) ak[t][kv][ks] = *(const bf16x8_t*)(kb + kv * 128 + ks * 32); }
#pragma unroll
            for (int t = 0; t < 2; ++t)
#pragma unroll
                for (int kv = 0; kv < 2; ++kv) { f32x4_t acc = {0.f, 0.f, 0.f, 0.f};
#pragma unroll
                    for (int ks = 0; ks < 4; ++ks) acc = __builtin_amdgcn_mfma_f32_16x16x32_bf16(ak[t][kv][ks], bQ[kv][ks], acc, 0, 0, 0);
                    if (fr < 4) {
#pragma unroll
                        for (int q = 0; q < 4; ++q) { const int j = (tb + t) * 16 + 4 * fq + q; PS[j * 8 + kv * 4 + fr] = j < ns ? acc[q] * 0.08838834764831845f : -1e30f; } } } }
        asm volatile("s_waitcnt lgkmcnt(0)" ::: "memory");
        { f32x4_t sv[4][2]; float mx[8];
#pragma unroll
            for (int h = 0; h < 8; ++h) mx[h] = -3e38f;
#pragma unroll
            for (int c = 0; c < 4; ++c) { sv[c][0] = *(const LAS f32x4_t*)(PS + (lane + 64 * c) * 8); sv[c][1] = *(const LAS f32x4_t*)(PS + (lane + 64 * c) * 8 + 4);
#pragma unroll
                for (int h = 0; h < 8; ++h) mx[h] = fmaxf(mx[h], sv[c][h >> 2][h & 3]); }
#pragma unroll
            for (int o = 32; o >= 1; o >>= 1)
#pragma unroll
                for (int h = 0; h < 8; ++h) mx[h] = fmaxf(mx[h], shfl_xor_l(mx[h], o, lane));
            float sum[8];
#pragma unroll
            for (int h = 0; h < 8; ++h) sum[h] = 0.f;
#pragma unroll
            for (int c = 0; c < 4; ++c)
#pragma unroll
                for (int h = 0; h < 8; ++h) { const float e = FEXP(sv[c][h >> 2][h & 3] - mx[h]); sv[c][h >> 2][h & 3] = e; sum[h] += e; }
#pragma unroll
            for (int o = 32; o >= 1; o >>= 1)
#pragma unroll
                for (int h = 0; h < 8; ++h) sum[h] += shfl_xor_l(sum[h], o, lane);
#pragma unroll
            for (int h = 0; h < 8; ++h) sum[h] = FRCP(sum[h]);
#pragma unroll
            for (int c = 0; c < 4; ++c) { f32x4_t p0, p1;
#pragma unroll
                for (int h = 0; h < 4; ++h) { p0[h] = sv[c][0][h] * sum[h]; p1[h] = sv[c][1][h] * sum[4 + h]; }
                *(LAS f32x4_t*)(PS + (lane + 64 * c) * 8) = p0; *(LAS f32x4_t*)(PS + (lane + 64 * c) * 8 + 4) = p1; } }
        asm volatile("s_waitcnt lgkmcnt(0)" ::: "memory");
        f32x4_t o4[4] = {{0.f, 0.f, 0.f, 0.f}, {0.f, 0.f, 0.f, 0.f}, {0.f, 0.f, 0.f, 0.f}, {0.f, 0.f, 0.f, 0.f}};
        const int kvl = lane >> 5; const char* vb8 = (const char*)(VB + (size_t)b * SEQ * 256);
        const unsigned loff = (unsigned)(kvl * 128 + (lane & 31) * 4) * 2u;
        for (int j0 = 0; j0 < ns; j0 += 32) { u32x2_t vv[32];
#pragma unroll
            for (int jj = 0; jj < 32; ++jj) { const unsigned off = (unsigned)IDXS[j0 + jj] * 512u + loff; vv[jj] = *(const u32x2_t*)(vb8 + off); }
#pragma unroll
            for (int jj = 0; jj < 32; ++jj) { const f32x4_t p4 = *(const LAS f32x4_t*)(PS + (j0 + jj) * 8 + kvl * 4);
                const f32x4_t vf = {__builtin_bit_cast(float, vv[jj][0] << 16), __builtin_bit_cast(float, vv[jj][0] & 0xffff0000u), __builtin_bit_cast(float, vv[jj][1] << 16), __builtin_bit_cast(float, vv[jj][1] & 0xffff0000u)};
#pragma unroll
                for (int h = 0; h < 4; ++h) o4[h] += vf * p4[h]; } }
#pragma unroll
        for (int h = 0; h < 4; ++h) { u32x2_t w; w[0] = pk_bf16(o4[h][0], o4[h][1]); w[1] = pk_bf16(o4[h][2], o4[h][3]); *(u32x2_t*)(O + (size_t)m * D + (kvl * 4 + h) * 128 + (lane & 31) * 4) = w; }
        asm volatile("s_waitcnt lgkmcnt(0)" ::: "memory");
    }
}

__device__ __forceinline__ void ph_sparse_sample(const Args& a, int ai, LAS unsigned char* lds) {
    const float* P = (const float*)(a.ws + WS_P); const int* IDX = (const int*)(a.ws + WS_IDX); const int* NSEL = (const int*)(a.ws + WS_NSEL); bf16* O = (bf16*)(a.ws + WS_Y2);
    int tx_ = TID(); asm volatile("" : "+v"(tx_));
    const int lane = tx_ & 63, wid = __builtin_amdgcn_readfirstlane(tx_ >> 6), wv = blockIdx.x * (NTHREADS >> 6) + wid, nwv = gridDim.x * (NTHREADS >> 6);
    LAS float* QS = (LAS float*)(lds + wid * 9216); LAS float* PSs = (LAS float*)(lds + wid * 9216 + 512); LAS unsigned long long* VP = (LAS unsigned long long*)(lds + wid * 9216 + 1536);
    for (int u = wv; u < MS * AH; u += nwv) { const int m = MP + u / AH, h = u % AH, kvh = h / GROUP; const RowInfo ri = row_info(m); const int ns = __builtin_amdgcn_readfirstlane(NSEL[m]);
        { const f32x2_t q2 = *(const f32x2_t*)(P + (size_t)m * LDP + h * HDIM + 2 * lane); QS[2 * lane] = q2[0]; QS[2 * lane + 1] = q2[1]; }
        const float* kp[4];
#pragma unroll
        for (int c = 0; c < 4; ++c) { const int j = lane + 64 * c; const int idx = j < ns ? IDX[(size_t)m * KROW + j] : 0; kp[c] = kv_row(a, ai, ri, idx, kvh, false); VP[j] = (unsigned long long)(size_t)kv_row(a, ai, ri, idx, kvh, true); }
        asm volatile("s_waitcnt lgkmcnt(0)" ::: "memory");
        float sc[4] = {0.f, 0.f, 0.f, 0.f};
        for (int d0 = 0; d0 < HDIM; d0 += 16) { f32x4_t kq[4][4];
#pragma unroll
            for (int e = 0; e < 4; ++e)
#pragma unroll
                for (int c = 0; c < 4; ++c) kq[e][c] = *(const f32x4_t*)(kp[c] + d0 + 4 * e);
#pragma unroll
            for (int e = 0; e < 4; ++e) { const f32x4_t q4 = *(const LAS f32x4_t*)(QS + d0 + 4 * e);
#pragma unroll
                for (int c = 0; c < 4; ++c) sc[c] += (kq[e][c][0] * q4[0] + kq[e][c][1] * q4[1]) + (kq[e][c][2] * q4[2] + kq[e][c][3] * q4[3]); } }
        float mx = -3e38f;
#pragma unroll
        for (int c = 0; c < 4; ++c) { sc[c] = (lane + 64 * c) < ns ? sc[c] * 0.08838834764831845f : -1e30f; mx = fmaxf(mx, sc[c]); }
#pragma unroll
        for (int o = 32; o >= 1; o >>= 1) mx = fmaxf(mx, shfl_xor_l(mx, o, lane));
        float sum = 0.f;
#pragma unroll
        for (int c = 0; c < 4; ++c) { sc[c] = FEXP(sc[c] - mx); sum += sc[c]; }
#pragma unroll
        for (int o = 32; o >= 1; o >>= 1) sum += shfl_xor_l(sum, o, lane);
        const float inv = FRCP(sum);
#pragma unroll
        for (int c = 0; c < 4; ++c) PSs[lane + 64 * c] = sc[c] * inv;
        asm volatile("s_waitcnt lgkmcnt(0)" ::: "memory");
        f32x2_t o2 = {0.f, 0.f};
        for (int j0 = 0; j0 < ns; j0 += 16) { f32x2_t vv[16];
#pragma unroll
            for (int jj = 0; jj < 16; ++jj) { const float* vp = (const float*)(size_t)VP[j0 + jj]; vv[jj] = *(const f32x2_t*)(vp + 2 * lane); }
#pragma unroll
            for (int jj = 0; jj < 16; ++jj) o2 += vv[jj] * PSs[j0 + jj]; }
        *(unsigned*)(O + (size_t)m * D + h * HDIM + 2 * lane) = pk_bf16(o2[0], o2[1]);
        asm volatile("s_waitcnt lgkmcnt(0)" ::: "memory");
    }
}

__device__ __forceinline__ void ph_rg_chunk(const Args& a, int r, LAS unsigned char* lds) {
    const float* P = (const float*)(a.ws + WS_P); float* HH = (float*)(a.ws + WS_HH); float* AP = (float*)(a.ws + WS_XR);
    const float* wc = a.in[I_WCONV] + (size_t)r * 4 * CONV_CH; const float* wa = a.in[I_WA] + (size_t)r * RG_HEADS * RG_BW * RG_BW; const float* wx = a.in[I_WX] + (size_t)r * RG_HEADS * RG_BW * RG_BW;
    static_assert(RG_BW == 64 && RG_HEADS == 8, "ph_rg_chunk is written for 8 gate heads of 64 channels");
    int tx_ = TID(); asm volatile("" : "+v"(tx_));
    const int lane = tx_ & 63, wid = __builtin_amdgcn_readfirstlane(tx_ >> 6), wv = blockIdx.x * (NTHREADS >> 6) + wid, nwv = gridDim.x * (NTHREADS >> 6);
    LAS float* XS = (LAS float*)(lds + wid * 16384);
    constexpr int NUP = NB * NC * 8, NU = NUP + DB * 8;
    for (int u = wv; u < NU; u += nwv) { const bool prompt = u < NUP; int hd, row0, T, n = 0, b = 0, db = 0;
        if (prompt) { const int c = u >> 3; hd = u & 7; row0 = c * 64; T = 64; n = c % NC; b = c / NC; } else { const int q = u - NUP; db = q >> 3; hd = q & 7; row0 = MP + db * DT; T = DT; }
        const int ch = hd * 64 + lane;
        const float w0 = wc[ch], w1 = wc[CONV_CH + ch], w2 = wc[2 * CONV_CH + ch], w3 = wc[3 * CONV_CH + ch], bcv = a.in[I_BCONV][(size_t)r * D_RNN + ch];
        float x3 = 0.f, x2 = 0.f, x1 = 0.f;
        if (prompt) { if (n != 0) { x3 = P[(size_t)(row0 - 3) * LDP + ch]; x2 = P[(size_t)(row0 - 2) * LDP + ch]; x1 = P[(size_t)(row0 - 1) * LDP + ch]; } }
        else { const float* sc = a.in[I_SCONV] + ((size_t)r * DB + db) * 3 * CONV_CH + ch; x3 = sc[0]; x2 = sc[CONV_CH]; x1 = sc[2 * CONV_CH]; }
        for (int tb = 0; tb < T; tb += 16) { float ub[16];
#pragma unroll
            for (int q = 0; q < 16; ++q) ub[q] = P[(size_t)(row0 + (tb + q < T ? tb + q : T - 1)) * LDP + ch];
#pragma unroll
            for (int q = 0; q < 16; ++q) { const int t = tb + q; if (t < T) { const float ut = ub[q]; XS[t * 64 + lane] = w3 * ut + w2 * x1 + w1 * x2 + w0 * x3 + bcv; x3 = x2; x2 = x1; x1 = ut;
                if (prompt) { if (n == NC - 1 && t >= 61) a.out[O_CONVP + (((size_t)r * NB + b) * 3 + (t - 61)) * CONV_CH + ch] = ut; }
                else if (t >= DT - 3) a.out[O_CONVS + (((size_t)r * DB + db) * 3 + (t - (DT - 3))) * CONV_CH + ch] = ut; } } }
        asm volatile("s_waitcnt lgkmcnt(0)" ::: "memory");
        float war[64], wxr[64];
        unsigned ln = (unsigned)lane; asm volatile("" : "+v"(ln)); ln &= 63u;
        const float* wah = wa + (size_t)hd * 4096; const float* wxh = wx + (size_t)hd * 4096;
#pragma unroll
        for (int k = 0; k < 64; ++k) { war[k] = wah[k * 64u + ln]; wxr[k] = wxh[k * 64u + ln]; }
        const float ba = a.in[I_BA][(size_t)r * D_RNN + ch], bx = a.in[I_BX][(size_t)r * D_RNN + ch], sp = softplusf_(-a.in[I_LAM][(size_t)r * D_RNN + ch]);
        float h = 0.f, ap = 1.f;
        for (int t = 0; t < T; ++t) { float pr = 0.f, pi = 0.f;
#pragma unroll
            for (int k = 0; k < 64; k += 4) { const f32x4_t x4 = *(const LAS f32x4_t*)(XS + t * 64 + k);
#pragma unroll
                for (int e = 0; e < 4; ++e) { pr += x4[e] * war[k + e]; pi += x4[e] * wxr[k + e]; } }
            const float rg = sigmoidf_(pr + ba), ig = sigmoidf_(pi + bx), log_a = -8.0f * rg * sp, av = __expf(log_a);
            const bool first = prompt && n == 0 && t == 0; const float mult = first ? 1.0f : FSQRT(fmaxf(1.0f - __expf(2.0f * log_a), 0.0f));
            float bv = XS[t * 64 + lane] * ig * mult; if (!prompt && t == 0) bv += av * a.in[I_SH][((size_t)r * DB + db) * D_RNN + ch];
            h = av * h + bv; ap *= av; const size_t o = (size_t)(row0 + t) * D_RNN + ch; HH[o] = h; AP[o] = ap; }
        if (!prompt) a.out[O_HS + ((size_t)r * DB + db) * D_RNN + ch] = h;
        asm volatile("s_waitcnt lgkmcnt(0)" ::: "memory");
    }
}
__device__ __forceinline__ void ph_dn_tok(const Args& a, int r) {
    const float* P = (const float*)(a.ws + WS_P); float* QKV = (float*)(a.ws + WS_QKV); float* QN = (float*)(a.ws + WS_QN); float* KN = (float*)(a.ws + WS_KN); float* GB = (float*)(a.ws + WS_GB); float* KNT = (float*)(a.ws + WS_KNT);
    const float* wc = a.in[I_WCONV] + (size_t)r * 4 * CONV_CH;
    int tx_ = TID(); asm volatile("" : "+v"(tx_));
    const int lane = tx_ & 63, wv = __builtin_amdgcn_readfirstlane(blockIdx.x * (NTHREADS >> 6) + (tx_ >> 6)), nwv = gridDim.x * (NTHREADS >> 6);
    constexpr int NUP = (MP / 16) * DNH, NU = NUP + DB * DNH;
    static_assert(DT == 4 && SEQ % 64 == 0, "ph_dn_tok run lengths");
    for (int u = wv; u < NU; u += nwv) { const bool prompt = u < NUP; const int hd = prompt ? (u & 3) : ((u - NUP) & 3), m0 = prompt ? (u >> 2) * 16 : MP + ((u - NUP) >> 2) * DT, T = prompt ? 16 : DT;
        const int seq = prompt ? m0 / SEQ : 0, t0 = prompt ? m0 % SEQ : 0, db = prompt ? 0 : (m0 - MP) / DT;
        f32x2_t wk[3][4], h3[3], h2[3], h1[3];
#pragma unroll
        for (int p = 0; p < 3; ++p) { const int c = D_RNN + p * 512 + hd * 128 + 2 * lane;
#pragma unroll
            for (int k = 0; k < 4; ++k) wk[p][k] = *(const f32x2_t*)(wc + (size_t)k * CONV_CH + c);
            h3[p] = h2[p] = h1[p] = (f32x2_t){0.f, 0.f};
            if (prompt) { if (t0 != 0) { h3[p] = *(const f32x2_t*)(P + (size_t)(m0 - 3) * LDP + c); h2[p] = *(const f32x2_t*)(P + (size_t)(m0 - 2) * LDP + c); h1[p] = *(const f32x2_t*)(P + (size_t)(m0 - 1) * LDP + c); } }
            else { const float* sc = a.in[I_SCONV] + ((size_t)r * DB + db) * 3 * CONV_CH + c; h3[p] = *(const f32x2_t*)sc; h2[p] = *(const f32x2_t*)(sc + CONV_CH); h1[p] = *(const f32x2_t*)(sc + 2 * CONV_CH); } }
        float gcum = 0.f;
        if (prompt) { const int tl0 = t0 & 63; float gt = lane < tl0 ? dn_g(a, r, (size_t)(m0 - tl0 + lane), hd) : 0.f;
#pragma unroll
            for (int o2 = 32; o2 >= 1; o2 >>= 1) gt += shfl_xor_l(gt, o2, lane);
            gcum = gt; }
        for (int tb = 0; tb < T; tb += 8) { f32x2_t xin[8][3];
#pragma unroll
            for (int q = 0; q < 8; ++q)
#pragma unroll
                for (int p = 0; p < 3; ++p) xin[q][p] = *(const f32x2_t*)(P + (size_t)(m0 + (tb + q < T ? tb + q : T - 1)) * LDP + D_RNN + p * 512 + hd * 128 + 2 * lane);
#pragma unroll
            for (int q = 0; q < 8; ++q) { const int t = tb + q; if (t < T) { const int m = m0 + t; f32x2_t x[3];
#pragma unroll
                for (int p = 0; p < 3; ++p) { const int c = D_RNN + p * 512 + hd * 128 + 2 * lane; const f32x2_t xv = xin[q][p];
                    const f32x2_t acc = wk[p][0] * h3[p] + wk[p][1] * h2[p] + wk[p][2] * h1[p] + wk[p][3] * xv; h3[p] = h2[p]; h2[p] = h1[p]; h1[p] = xv;
                    x[p][0] = siluf_(acc[0]); x[p][1] = siluf_(acc[1]);
                    if (prompt) { if (t0 + t >= SEQ - 3) *(f32x2_t*)(a.out + O_CONVP + (((size_t)r * NB + seq) * 3 + (t0 + t - (SEQ - 3))) * CONV_CH + c) = xv; }
                    else if (t >= DT - 3) *(f32x2_t*)(a.out + O_CONVS + (((size_t)r * DB + db) * 3 + (t - (DT - 3))) * CONV_CH + c) = xv; }
                float sq = x[0][0] * x[0][0] + x[0][1] * x[0][1], sk = x[1][0] * x[1][0] + x[1][1] * x[1][1];
#pragma unroll
                for (int o = 32; o >= 1; o >>= 1) { sq += shfl_xor_l(sq, o, lane); sk += shfl_xor_l(sk, o, lane); }
                const float rq = FRSQ(sq + EPS) * 0.08838834764831845f, rk = FRSQ(sk + EPS);
                const f32x2_t qn = x[0] * rq, kn = x[1] * rk; const size_t o = (size_t)m * 512 + hd * 128 + 2 * lane;
                *(f32x2_t*)(QN + o) = qn; *(f32x2_t*)(KN + o) = kn; *(f32x2_t*)(QKV + (size_t)m * 1536 + 1024 + hd * 128 + 2 * lane) = x[2];
                const float g = dn_g(a, r, (size_t)m, hd); float gc = g;
                if (prompt) { const int tt = t0 + t, tl = tt & 63; if (tl == 0) gcum = 0.f; gcum += g; gc = gcum;
                    float* kt = KNT + (((size_t)seq * DNH + hd) * NC + tt / 64) * 8192 + (size_t)(2 * lane) * 64 + tl; kt[0] = kn[0]; kt[64] = kn[1]; }
                if (lane == 0) { GB[(size_t)m * 16 + hd * 4] = g; GB[(size_t)m * 16 + hd * 4 + 1] = sigmoidf_(P[(size_t)m * LDP + OFF_B + hd]); GB[(size_t)m * 16 + hd * 4 + 2] = gc; } } } } }
}
__device__ __forceinline__ void ph_rec_out_w(const Args& a, int r) {
    static_assert(D_RNN == 512 && Y2W == 1024, "ph_rec_out_w is written for D_RNN 512");
    const float* P = (const float*)(a.ws + WS_P); const float* HH = (const float*)(a.ws + WS_HH); const float* AP = (const float*)(a.ws + WS_XR); const float* CARRY = (const float*)(a.ws + WS_CARRY);
    const float* ODN = (const float*)(a.ws + WS_ODN); bf16* Y2 = (bf16*)(a.ws + WS_Y2); const float* dnw = a.in[I_DNW] + r * 128;
    int tx_ = TID(); asm volatile("" : "+v"(tx_));
    const int lane = tx_ & 63, wv = __builtin_amdgcn_readfirstlane(blockIdx.x * (NTHREADS >> 6) + (tx_ >> 6)), nwv = gridDim.x * (NTHREADS >> 6);
    const f32x2_t dw = *(const f32x2_t*)(dnw + 2 * lane);
    for (int m = wv; m < MT; m += nwv) {
        { const size_t o = (size_t)m * D_RNN + 8 * lane; f32x4_t h0 = *(const f32x4_t*)(HH + o), h1 = *(const f32x4_t*)(HH + o + 4);
            if (m < MP) { const float* cr = CARRY + (size_t)(m / 64) * D_RNN + 8 * lane; h0 += *(const f32x4_t*)(AP + o) * *(const f32x4_t*)cr; h1 += *(const f32x4_t*)(AP + o + 4) * *(const f32x4_t*)(cr + 4); }
            const float* gp = P + (size_t)m * LDP + OFF_GATE + 8 * lane; const f32x4_t g0 = *(const f32x4_t*)gp, g1 = *(const f32x4_t*)(gp + 4);
            u32x4_t w; w[0] = pk_bf16(h0[0] * gelu_tanhf_(g0[0]), h0[1] * gelu_tanhf_(g0[1])); w[1] = pk_bf16(h0[2] * gelu_tanhf_(g0[2]), h0[3] * gelu_tanhf_(g0[3]));
            w[2] = pk_bf16(h1[0] * gelu_tanhf_(g1[0]), h1[1] * gelu_tanhf_(g1[1])); w[3] = pk_bf16(h1[2] * gelu_tanhf_(g1[2]), h1[3] * gelu_tanhf_(g1[3]));
            *(u32x4_t*)(Y2 + (size_t)m * Y2W + 8 * lane) = w; }
        f32x2_t ov[4]; float ss[4];
#pragma unroll
        for (int hd = 0; hd < 4; ++hd) { ov[hd] = *(const f32x2_t*)(ODN + (size_t)m * 512 + hd * 128 + 2 * lane); ss[hd] = ov[hd][0] * ov[hd][0] + ov[hd][1] * ov[hd][1]; }
#pragma unroll
        for (int o = 32; o >= 1; o >>= 1)
#pragma unroll
            for (int hd = 0; hd < 4; ++hd) ss[hd] += shfl_xor_l(ss[hd], o, lane);
#pragma unroll
        for (int hd = 0; hd < 4; ++hd) { const float rs = FRSQ(ss[hd] * (1.0f / 128.0f) + EPS); const f32x2_t z = *(const f32x2_t*)(P + (size_t)m * LDP + OFF_Z + hd * 128 + 2 * lane);
            *(unsigned*)(Y2 + (size_t)m * Y2W + D_RNN + hd * 128 + 2 * lane) = pk_bf16(ov[hd][0] * rs * dw[0] * siluf_(z[0]), ov[hd][1] * rs * dw[1] * siluf_(z[1])); } }
}


__device__ __forceinline__ void ph_dn_chunk(const Args& a, LAS unsigned char* lds) {
    const float* QKV = (const float*)(a.ws + WS_QKV); const float* QN = (const float*)(a.ws + WS_QN); const float* KN = (const float*)(a.ws + WS_KN); const float* GB = (const float*)(a.ws + WS_GB); const float* KNT = (const float*)(a.ws + WS_KNT);
    bf16* AT = (bf16*)(a.ws + WS_AT); float* UT = (float*)(a.ws + WS_UT); bf16* WN = (bf16*)(a.ws + WS_WN); bf16* QG = (bf16*)(a.ws + WS_QG); bf16* KDT = (bf16*)(a.ws + WS_KDT); float* GL = (float*)(a.ws + WS_GL);
    int tx_ = TID(); asm volatile("" : "+v"(tx_));
    const int tid = tx_, lane = tid & 63, fr = lane & 15, fq = lane >> 4, wid = __builtin_amdgcn_readfirstlane(tid >> 6);
    constexpr int RS = 136;
    LAS bf16* Kb = (LAS bf16*)lds; LAS bf16* Qb = (LAS bf16*)(lds + 17408); LAS float* Lf = (LAS float*)(lds + 34816); LAS float* gcs = (LAS float*)(lds + 51200); LAS float* bts = (LAS float*)(lds + 51456);
    for (int cu = blockIdx.x; cu < NCU; cu += gridDim.x) { const int n = cu % NC, hd = (cu / NC) % DNH, b = cu / (NC * DNH); const size_t m0 = (size_t)b * SEQ + n * 64;
        { const int i = tid >> 3, sg = tid & 7; const float* qp = QN + (m0 + i) * 512 + hd * 128 + sg * 16; const float* kp = KN + (m0 + i) * 512 + hd * 128 + sg * 16;
            f32x4_t qv[4], kv[4];
#pragma unroll
            for (int e = 0; e < 4; ++e) { qv[e] = *(const f32x4_t*)(qp + 4 * e); kv[e] = *(const f32x4_t*)(kp + 4 * e); }
            u32x4_t w0, w1;
#pragma unroll
            for (int e = 0; e < 2; ++e) { w0[2 * e] = pk_bf16(qv[e][0], qv[e][1]); w0[2 * e + 1] = pk_bf16(qv[e][2], qv[e][3]); w1[2 * e] = pk_bf16(qv[e + 2][0], qv[e + 2][1]); w1[2 * e + 1] = pk_bf16(qv[e + 2][2], qv[e + 2][3]); }
            *(LAS u32x4_t*)(Qb + i * RS + sg * 16) = w0; *(LAS u32x4_t*)(Qb + i * RS + sg * 16 + 8) = w1;
#pragma unroll
            for (int e = 0; e < 2; ++e) { w0[2 * e] = pk_bf16(kv[e][0], kv[e][1]); w0[2 * e + 1] = pk_bf16(kv[e][2], kv[e][3]); w1[2 * e] = pk_bf16(kv[e + 2][0], kv[e + 2][1]); w1[2 * e + 1] = pk_bf16(kv[e + 2][2], kv[e + 2][3]); }
            *(LAS u32x4_t*)(Kb + i * RS + sg * 16) = w0; *(LAS u32x4_t*)(Kb + i * RS + sg * 16 + 8) = w1;
            if (tid < 64) { gcs[tid] = GB[(m0 + tid) * 16 + hd * 4 + 2]; bts[tid] = GB[(m0 + tid) * 16 + hd * 4 + 1]; } }
        __syncthreads();
        { const int ti = wid >> 1;
#pragma unroll
            for (int tq = 0; tq < 2; ++tq) { const int tj = 2 * (wid & 1) + tq; f32x4_t ck = {0.f, 0.f, 0.f, 0.f}, cq = {0.f, 0.f, 0.f, 0.f};
                if (tj <= ti) {
#pragma unroll
                    for (int ks = 0; ks < 4; ++ks) { const bf16x8_t bK = *(const LAS bf16x8_t*)(Kb + (tj * 16 + fr) * RS + ks * 32 + fq * 8);
                        ck = __builtin_amdgcn_mfma_f32_16x16x32_bf16(*(const LAS bf16x8_t*)(Kb + (ti * 16 + fr) * RS + ks * 32 + fq * 8), bK, ck, 0, 0, 0);
                        cq = __builtin_amdgcn_mfma_f32_16x16x32_bf16(*(const LAS bf16x8_t*)(Qb + (ti * 16 + fr) * RS + ks * 32 + fq * 8), bK, cq, 0, 0, 0); } }
                const int j = tj * 16 + fr; const float gj = gcs[j];
#pragma unroll
                for (int q = 0; q < 4; ++q) { const int i = ti * 16 + 4 * fq + q; float lv = 0.f, av = 0.f;
                    if (i >= j) { const float dec = __expf(gcs[i] - gj); av = cq[q] * dec; if (i > j) lv = bts[i] * ck[q] * dec; }
                    Lf[i * 64 + j] = lv; AT[(size_t)cu * 4096 + FRAG_OFF(i, j, 2)] = f2bf(av); } } }
        __syncthreads();
        if (wid < 4) { const int col = tid; float X[64];
            if (col < 128) {
#pragma unroll
                for (int j = 0; j < 64; ++j) X[j] = QKV[(m0 + j) * 1536 + 1024 + hd * 128 + col] * bts[j]; }
            else {
#pragma unroll
                for (int j = 0; j < 64; ++j) X[j] = KN[(m0 + j) * 512 + hd * 128 + (col - 128)] * bts[j] * __expf(gcs[j]); }
#pragma unroll
            for (int i = 1; i < 64; ++i) { float acc = X[i];
#pragma unroll
                for (int jb = 0; jb < i; jb += 4) { const f32x4_t l4 = *(const LAS f32x4_t*)(Lf + i * 64 + jb);
                    acc -= l4[0] * X[jb]; acc -= l4[1] * X[jb + 1]; acc -= l4[2] * X[jb + 2]; acc -= l4[3] * X[jb + 3]; }
                X[i] = acc; }
            if (col < 128) { float* up = UT + (size_t)cu * 8192 + (size_t)((col >> 4) * 4) * 256 + (col & 15) * 4;
#pragma unroll
                for (int j = 0; j < 64; j += 4) *(f32x4_t*)(up + (j >> 4) * 256 + ((j >> 2) & 3) * 64) = (f32x4_t){X[j], X[j + 1], X[j + 2], X[j + 3]}; }
            else { bf16* wp = WN + (size_t)cu * 8192;
#pragma unroll
                for (int j = 0; j < 64; ++j) wp[FRAG_OFF(j, col - 128, 4)] = f2bf(-X[j]); } }
        else { const int t2 = tid - 256; const float gl63 = gcs[63];
            { const int i = t2 >> 2, sg = t2 & 3; const float eg = __expf(gcs[i]); const float* qp = QN + (m0 + i) * 512 + hd * 128 + sg * 32; bf16* op = QG + (size_t)cu * 8192;
#pragma unroll
                for (int e = 0; e < 8; ++e) { const f32x4_t v = *(const f32x4_t*)(qp + 4 * e); u32x2_t w; w[0] = pk_bf16(v[0] * eg, v[1] * eg); w[1] = pk_bf16(v[2] * eg, v[3] * eg); *(u32x2_t*)(op + FRAG_OFF(i, sg * 32 + 4 * e, 4)) = w; } }
            { const int dd = t2 >> 1, hf = t2 & 1; const float* kp = KNT + (size_t)cu * 8192 + dd * 64 + hf * 32; bf16* op = KDT + (size_t)cu * 8192;
#pragma unroll
                for (int e = 0; e < 8; ++e) { const f32x4_t v = *(const f32x4_t*)(kp + 4 * e); const int i0 = hf * 32 + 4 * e; u32x2_t w;
                    w[0] = pk_bf16(v[0] * __expf(gl63 - gcs[i0]), v[1] * __expf(gl63 - gcs[i0 + 1])); w[1] = pk_bf16(v[2] * __expf(gl63 - gcs[i0 + 2]), v[3] * __expf(gl63 - gcs[i0 + 3])); *(u32x2_t*)(op + FRAG_OFF(dd, i0, 2)) = w; } }
            if (t2 == 0) GL[cu] = __expf(gl63); }
        __syncthreads();
    }
}


template <int MODE, int UNR> __device__ __forceinline__ void small_gemm(const bf16* __restrict__ A, const bf16* __restrict__ Bt, int N, int K, void* C, int ldc) {
    static_assert(MS == 128, "small_gemm covers 128 sample rows");
    int tx_ = TID(); asm volatile("" : "+v"(tx_));
    const int lane = tx_ & 63, fr = lane & 15, fq = lane >> 4, wv = __builtin_amdgcn_readfirstlane(blockIdx.x * (NTHREADS >> 6) + (tx_ >> 6)), nwv = gridDim.x * (NTHREADS >> 6);
    const int ntile = (N / 16) * 4;
    for (int tile = wv; tile < ntile; tile += nwv) { const int n0 = (tile >> 2) * 16, tg = tile & 3;
        f32x4_t acc0 = {0.f, 0.f, 0.f, 0.f}, acc1 = {0.f, 0.f, 0.f, 0.f};
        const bf16* bp = Bt + (size_t)(n0 + fr) * K + fq * 8; const bf16* ap0 = A + (size_t)(MP + tg * 32 + fr) * K + fq * 8; const bf16* ap1 = ap0 + (size_t)16 * K;
        for (int k = 0; k < K; k += 32 * UNR) { bf16x8_t bb[UNR], a0[UNR], a1[UNR];
#pragma unroll
            for (int u = 0; u < UNR; ++u) { bb[u] = *(const bf16x8_t*)(bp + k + 32 * u); a0[u] = *(const bf16x8_t*)(ap0 + k + 32 * u); a1[u] = *(const bf16x8_t*)(ap1 + k + 32 * u); }
#pragma unroll
            for (int u = 0; u < UNR; ++u) { acc0 = __builtin_amdgcn_mfma_f32_16x16x32_bf16(bb[u], a0[u], acc0, 0, 0, 0); acc1 = __builtin_amdgcn_mfma_f32_16x16x32_bf16(bb[u], a1[u], acc1, 0, 0, 0); } }
#pragma unroll
        for (int tt = 0; tt < 2; ++tt) { const f32x4_t v = tt ? acc1 : acc0; const size_t o = (size_t)(MP + tg * 32 + tt * 16 + fr) * ldc + n0 + 4 * fq;
            if (MODE == 0) *(f32x4_t*)((float*)C + o) = v;
            else if (MODE == 1) { const float r0 = fmaxf(v[0], 0.f), r1 = fmaxf(v[1], 0.f), r2 = fmaxf(v[2], 0.f), r3 = fmaxf(v[3], 0.f); u32x2_t w; w[0] = pk_bf16(r0 * r0, r1 * r1); w[1] = pk_bf16(r2 * r2, r3 * r3); *(u32x2_t*)((bf16*)C + o) = w; }
            else { f32x4_t* p = (f32x4_t*)((float*)C + o); *p = *p + v; } } }
}


template <int MODE> __device__ __forceinline__ void small_gemm2(const bf16* __restrict__ A, const bf16* __restrict__ Bt, int N, int K, void* C, int ldc, bf16* XB, unsigned long long* ss, LAS unsigned char* lds) {
    static_assert(MS == 128, "small_gemm2 covers 128 sample rows");
    int tx_ = TID(); asm volatile("" : "+v"(tx_));
    const int tid = tx_, lane = tid & 63, fr = lane & 15, fq = lane >> 4, wid = __builtin_amdgcn_readfirstlane(tid >> 6);
    LAS float* RED = (LAS float*)lds;
    const int kw = K / 8;
    for (int tile = blockIdx.x; tile < (N / 16) * 4; tile += gridDim.x) { const int n0 = (tile >> 2) * 16, tg = tile & 3;
        f32x4_t acc0 = {0.f, 0.f, 0.f, 0.f}, acc1 = {0.f, 0.f, 0.f, 0.f};
        const bf16* bp = Bt + (size_t)(n0 + fr) * K + wid * kw + fq * 8; const bf16* ap0 = A + (size_t)(MP + tg * 32 + fr) * K + wid * kw + fq * 8; const bf16* ap1 = ap0 + (size_t)16 * K;
        for (int k = 0; k < kw; k += 128) { bf16x8_t bb[4], a0[4], a1[4];
#pragma unroll
            for (int u = 0; u < 4; ++u) { bb[u] = *(const bf16x8_t*)(bp + k + 32 * u); a0[u] = *(const bf16x8_t*)(ap0 + k + 32 * u); a1[u] = *(const bf16x8_t*)(ap1 + k + 32 * u); }
#pragma unroll
            for (int u = 0; u < 4; ++u) { acc0 = __builtin_amdgcn_mfma_f32_16x16x32_bf16(bb[u], a0[u], acc0, 0, 0, 0); acc1 = __builtin_amdgcn_mfma_f32_16x16x32_bf16(bb[u], a1[u], acc1, 0, 0, 0); } }
        *(LAS f32x4_t*)(RED + ((size_t)(wid * 32 + fr)) * 16 + 4 * fq) = acc0; *(LAS f32x4_t*)(RED + ((size_t)(wid * 32 + 16 + fr)) * 16 + 4 * fq) = acc1;
        __syncthreads();
        { const int tok = tid >> 4, c = tid & 15; float v = RED[(size_t)tok * 16 + c];
#pragma unroll
            for (int w = 1; w < 8; ++w) v += RED[(size_t)(w * 32 + tok) * 16 + c];
            const int m = MP + tg * 32 + tok; const size_t o = (size_t)m * ldc + n0 + c;
            if (MODE == 1) { const float rs = FRSQ((float)ss[m] * (5.9604644775390625e-08f / D) + EPS); const float r0 = fmaxf(v * rs, 0.f); ((bf16*)C)[o] = f2bf(r0 * r0); }
            else { const float x = ((float*)C)[o] + v; ((float*)C)[o] = x; XB[o] = f2bf(x);
                float q = x * x; q += shfl_xor_l(q, 1, lane); q += shfl_xor_l(q, 2, lane); q += shfl_xor_l(q, 4, lane); q += shfl_xor_l(q, 8, lane);
                if (c == 0) __hip_atomic_fetch_add(ss + m, (unsigned long long)(q * 16777216.0f), __ATOMIC_RELAXED, __HIP_MEMORY_SCOPE_AGENT); } }
        __syncthreads();
    }
}

constexpr int PH_PER_LAYER = 12, PH_LAYER0 = 2, PH_FINAL = PH_LAYER0 + DEPTH * PH_PER_LAYER, N_PHASES = PH_FINAL + 1;
#ifndef DIAG_SEQ_LO
#define DIAG_SEQ_LO NB
#endif
#ifndef PROBE_N
#define PROBE_N 1
#define PROBE_KIND -1
#define PROBE_LO 0
#define PROBE_HI 0
#endif
#define NREP(kind, k) ((PROBE_KIND == (kind) && (k) >= PROBE_LO && (k) <= PROBE_HI) ? PROBE_N : 1)
#define REP(kind, k) for (int rep_ = 0; rep_ < NREP(kind, k); ++rep_)
#ifndef MK_SINGLE
#define MK_SINGLE 1
#endif
__global__ void __launch_bounds__(NTHREADS, 2) mega(KArgs ka) {
    extern __shared__ __attribute__((aligned(16))) unsigned char lds[];
    LAS unsigned char* L = (LAS unsigned char*)lds;
    const size_t gsz = (size_t)gridDim.x * NTHREADS;
#define GT() ([&]() -> size_t { unsigned tx_ = TID(); asm volatile("" : "+v"(tx_)); return (size_t)blockIdx.x * NTHREADS + tx_; }())
    const int lo = ka.ph_lo, hi = ka.ph_hi; (void)lo; (void)hi;
    { const unsigned hw_ = (unsigned)__builtin_amdgcn_s_getreg((5 << 11) | 4) & 63u; if ((threadIdx.x & 63) == 0) ((LAS int*)(L + LDS_WTAB))[hw_] = (int)(threadIdx.x >> 6); __syncthreads(); }
    { const float** tab = (const float**)(ka.ws + WS_TAB); if (threadIdx.x < 28) tab[threadIdx.x] = ka.in[threadIdx.x]; asm volatile("s_waitcnt vmcnt(0)" ::: "memory"); __syncthreads(); }
    Args a; a.in = (const float* const*)(ka.ws + WS_TAB); a.out = ka.out; a.ws = ka.ws;
#define OPQ() do { size_t z_ = 0; asm volatile("" : "+s"(z_)); a.ws = ka.ws + z_; a.out = ka.out + z_; a.in = (const float* const*)(ka.ws + WS_TAB + z_); } while (0)
#if MK_SINGLE
    if (TID() < 4) ((LAS unsigned*)(L + LDS_MISC))[TID()] = 0u;
    __syncthreads();
    XcdBarrier bar = xcd_barrier_post((unsigned*)(a.ws + WS_CTL) + 4096, (volatile LAS unsigned*)(L + LDS_MISC));
#define SEAM(k) do { XcdBarrier bb_ = bar; asm volatile("" : "+s"(bb_.x)); xcd_barrier(bb_); } while (0)
#else
#define SEAM(k) do { } while (0)
#endif
#if MK_SINGLE
#define IN(k) (true)
#else
#define IN(k) (lo <= (k) && (k) < hi)
#endif
#define XN ((bf16*)(a.ws + WS_XN))
#define X ((float*)(a.ws + WS_X))
#define P ((float*)(a.ws + WS_P))
#define H ((bf16*)(a.ws + WS_H))
#define Y2 ((bf16*)(a.ws + WS_Y2))
    if (IN(0)) { OPQ(); REP(2, 0) { ph_prep_x(a); ph_wprep(a, true, 0, GT(), gsz); } SEAM(0); }
    for (int l = 0; l < DEPTH; ++l) {
        const int pb = PH_LAYER0 + l * PH_PER_LAYER, r = l >> 1; unsigned long long* SSb = (unsigned long long*)(a.ws + WS_SS);
        if ((l & 1) == 0) {
            if (IN(pb + 1)) { OPQ(); REP(3, 1) { pg8::Gemm g{XN, (const bf16*)(a.ws + WS_WINR) + (size_t)r * REC_PAD * D, MPAD, REC_PAD, D}; pg8::StaticOrder S; S.init(MPAD, REC_PAD, gridDim.x, blockIdx.x);
                pg8::EpiF32S E{P, LDP, SSb + (size_t)(2 * l) * MPAD}; pg8::gemm_phase<pg8::EpiF32S, pg8::StaticOrder, false>(L, g, S, E, nullptr); } SEAM(pb + 1); }
            if (IN(pb + 2)) { OPQ(); REP(0, 2) { ph_rg_chunk(a, r, L); ph_dn_tok(a, r); } SEAM(pb + 2); }
            if (IN(pb + 3)) { OPQ(); REP(0, 3) ph_dn_chunk(a, L); SEAM(pb + 3); }
            if (IN(pb + 6)) { OPQ();
                constexpr int NDNB = NB * DNH * 8;
                REP(0, 6) {
                if ((int)gridDim.x > NDNB) { if ((int)blockIdx.x < NDNB) {
#ifdef DIAG_NAIVE_B
                    ph_dn_b_naive(a, r, GT(), (size_t)NDNB * NTHREADS);
#else
                    ph_dn_b(a, r, L);
#endif
                } else { const size_t g2 = GT() - (size_t)NDNB * NTHREADS, s2 = gsz - (size_t)NDNB * NTHREADS; ph_rg_scan2(a, r, g2, s2); if (DIAG_SEQ_LO != 0) ph_dn_seq(a, r, DIAG_SEQ_LO, g2, s2);
                    if (l == 0) ph_wprep(a, true, 1, g2, s2); } }
                else { ph_dn_b(a, r, L); ph_rg_scan2(a, r, GT(), gsz); ph_dn_seq(a, r, DIAG_SEQ_LO, GT(), gsz); if (l == 0) ph_wprep(a, true, 1, GT(), gsz); }
                }
                SEAM(pb + 6); }
            if (IN(pb + 7)) { OPQ(); REP(0, 7) ph_rec_out_w(a, r); SEAM(pb + 7); }
            if (IN(pb + 8)) { OPQ(); REP(3, 8) { pg8::Gemm g{Y2, (const bf16*)(a.ws + WS_WOUTR) + (size_t)r * D * Y2W, MP, D, Y2W}; pg8::StaticOrder S; S.init(MP, D, gridDim.x, blockIdx.x);
                pg8::EpiAddN E{X, D, XN, SSb + (size_t)(2 * l + 1) * MPAD}; pg8::gemm_phase<pg8::EpiAddN, pg8::StaticOrder, false>(L, g, S, E, nullptr); small_gemm2<2>(Y2, (const bf16*)(a.ws + WS_WOUTR) + (size_t)r * D * Y2W, D, Y2W, X, D, XN, SSb + (size_t)(2 * l + 1) * MPAD, L); } SEAM(pb + 8); }
        } else {
            if (IN(pb + 1)) { OPQ(); REP(3, 1) { pg8::Gemm g{XN, (const bf16*)(a.ws + WS_WINA) + (size_t)r * ATT_PAD * D, MPAD, ATT_PAD, D}; pg8::StaticOrder S; S.init(MPAD, ATT_PAD, gridDim.x, blockIdx.x);
                pg8::EpiAttS E{a.ws, a.out, SSb + (size_t)(2 * l) * MPAD, r}; pg8::gemm_phase<pg8::EpiAttS, pg8::StaticOrder, false>(L, g, S, E, nullptr); } SEAM(pb + 1); }
            if (IN(pb + 3)) { OPQ(); REP(1, 3) { ph_idx_sample_mfma(a, r); ph_idx_mfma(a, L); } SEAM(pb + 3); }
            if (IN(pb + 4)) { OPQ(); REP(1, 4) ph_select_w(a, L); SEAM(pb + 4); }
            if (IN(pb + 5)) { OPQ(); REP(1, 5) { ph_sparse_sample(a, r, L); ph_sparse_attn(a, L); } SEAM(pb + 5); }
            if (IN(pb + 8)) { OPQ(); REP(3, 8) { pg8::Gemm g{Y2, (const bf16*)(a.ws + WS_WOUTA) + (size_t)r * D * D, MP, D, D}; pg8::StaticOrder S; S.init(MP, D, gridDim.x, blockIdx.x);
                pg8::EpiAddN E{X, D, XN, SSb + (size_t)(2 * l + 1) * MPAD}; pg8::gemm_phase<pg8::EpiAddN, pg8::StaticOrder, false>(L, g, S, E, nullptr); small_gemm2<2>(Y2, (const bf16*)(a.ws + WS_WOUTA) + (size_t)r * D * D, D, D, X, D, XN, SSb + (size_t)(2 * l + 1) * MPAD, L); } SEAM(pb + 8); }
        }
        if (IN(pb + 10)) { OPQ(); REP(3, 10) { pg8::Gemm g{XN, (const bf16*)(a.ws + WS_WUP) + (size_t)l * D_FF * D, MP, D_FF, D}; pg8::StaticOrder S; S.init(MP, D_FF, gridDim.x, blockIdx.x);
            pg8::EpiRelu2S E{H, D_FF, SSb + (size_t)(2 * l + 1) * MPAD}; pg8::gemm_phase<pg8::EpiRelu2S, pg8::StaticOrder, false>(L, g, S, E, nullptr); small_gemm2<1>(XN, (const bf16*)(a.ws + WS_WUP) + (size_t)l * D_FF * D, D_FF, D, H, D_FF, nullptr, SSb + (size_t)(2 * l + 1) * MPAD, L); } SEAM(pb + 10); }
        if (IN(pb + 11)) { OPQ(); REP(3, 11) { pg8::Gemm g{H, (const bf16*)(a.ws + WS_WDN) + (size_t)l * D * D_FF, MP, D, D_FF}; pg8::StaticOrder S; S.init(MP, D, gridDim.x, blockIdx.x);
            pg8::EpiAddN E{X, D, XN, SSb + (size_t)(2 * l + 2) * MPAD}; pg8::gemm_phase<pg8::EpiAddN, pg8::StaticOrder, false>(L, g, S, E, nullptr); small_gemm2<2>(H, (const bf16*)(a.ws + WS_WDN) + (size_t)l * D * D_FF, D, D_FF, X, D, XN, SSb + (size_t)(2 * l + 2) * MPAD, L); } SEAM(pb + 11); }
    }
    if (IN(PH_FINAL)) { OPQ(); ph_final(a); }
}
#undef XN
#undef X
#undef P
#undef H
#undef Y2

extern "C" void kernel_launch(void* const* d_in, const int* in_sizes, int n_in, void* d_out, int out_size, void* d_ws, size_t ws_size, hipStream_t stream) {
    static int grid = 0;
    if (grid == 0) {
        if (n_in != 28 || (size_t)out_size != (size_t)O_END || ws_size < WS_END2) { fprintf(stderr, "kernel_launch: unexpected shapes n_in %d out %d (want %zu) ws %zu (want %zu)\n", n_in, out_size, (size_t)O_END, ws_size, (size_t)WS_END2); grid = -1; return; }
        int dev = 0, cus = 0;
        if (hipGetDevice(&dev) != hipSuccess || hipDeviceGetAttribute(&cus, hipDeviceAttributeMultiprocessorCount, dev) != hipSuccess) { grid = -1; return; }
        if (hipFuncSetAttribute((const void*)mega, hipFuncAttributeMaxDynamicSharedMemorySize, LDS_BYTES) != hipSuccess) { fprintf(stderr, "kernel_launch: hipFuncSetAttribute failed\n"); grid = -1; return; }
        int per_cu = 0; (void)hipOccupancyMaxActiveBlocksPerMultiprocessor(&per_cu, (const void*)mega, NTHREADS, LDS_BYTES); (void)hipGetLastError();
        if (per_cu < 1) fprintf(stderr, "kernel_launch: occupancy query says %d blocks per CU\n", per_cu);
        grid = cus;
    }
    if (grid < 0) return;
    (void)hipMemsetAsync((char*)d_ws + WS_CTL, 0, CTL_BYTES, stream);
    KArgs a{};
    for (int i = 0; i < 28; ++i) a.in[i] = (const float*)d_in[i];
    a.out = (float*)d_out; a.ws = (unsigned char*)d_ws;
#if MK_SINGLE
    a.ph_lo = 0; a.ph_hi = N_PHASES;
    hipLaunchKernelGGL(mega, dim3(grid), dim3(NTHREADS), LDS_BYTES, stream, a);
#else
    for (int ph = 0; ph < N_PHASES; ++ph) { const int k = ph - PH_LAYER0; if (k >= 0 && ph < PH_FINAL && ((k / PH_PER_LAYER) & 1) == 1 && (k % PH_PER_LAYER) == 7) continue;
        a.ph_lo = ph; a.ph_hi = ph + 1; hipLaunchKernelGGL(mega, dim3(grid), dim3(NTHREADS), LDS_BYTES, stream, a); }
#endif
}
#endif
```

```cpp
#ifndef HOST_TEST
#include <hip/hip_runtime.h>
#define HD __device__ __forceinline__
#define UNI(x) __builtin_amdgcn_readfirstlane(x)
#else
#include <cmath>
#include <cstddef>
#include <cstring>
#define HD static inline
#define UNI(x) (x)
#endif

#ifndef CFG_D_MODEL
#define CFG_D_MODEL 1024
#define CFG_BATCH 2
#define CFG_SEQ 8192
#define CFG_DEC_BATCH 32
#define CFG_PAST 8192
#endif
constexpr int D = CFG_D_MODEL, NB = CFG_BATCH, SEQ = CFG_SEQ, DEPTH = 4, DB = CFG_DEC_BATCH, DT = 4, PAST = CFG_PAST, PAGE = 128;
constexpr int N_REC = 2, N_ATT = 2, NPAGES = PAST / PAGE, NUSED = DB * NPAGES, NPOOL = NUSED + (NUSED + 3) / 4;
constexpr int D_RNN = D / 2, RG_HEADS = 8, RG_BW = D_RNN / RG_HEADS;
constexpr int DNH = 4, DNK = 128, DN_QK = 512, DN_VD = 512;
constexpr int CONV_CH = D_RNN + 2 * DN_QK + DN_VD, REC_IN = CONV_CH + D_RNN + DN_VD + 2 * DNH;
constexpr int OFF_GATE = CONV_CH, OFF_Z = CONV_CH + D_RNN, OFF_B = OFF_Z + DN_VD, OFF_A = OFF_B + DNH;
constexpr int AH = D / 128, KVH = 2, HDIM = 128, GROUP = AH / KVH, IH = 8, IDIM = 64;
constexpr int AO_K = AH * HDIM, AO_V = AO_K + KVH * HDIM, AO_QI = AO_V + KVH * HDIM, AO_KI = AO_QI + IH * IDIM, AO_WI = AO_KI + IDIM, ATT_IN = AO_WI + IH;
constexpr int D_FF = 4 * D;
constexpr int TOPK_P = (SEQ / 4 < 256) ? SEQ / 4 : 256, TOPK_S = ((PAST + DT) / 4 < 256) ? (PAST + DT) / 4 : 256, KMAX = 256, KROW = 320;
constexpr int MP = NB * SEQ, MS = DB * DT, MT = MP + MS, MPAD = (MT + 255) / 256 * 256;
constexpr int REC_PAD = (REC_IN + 255) / 256 * 256, ATT_PAD = (ATT_IN + 255) / 256 * 256, LDP = REC_PAD > ATT_PAD ? REC_PAD : ATT_PAD;
constexpr int Y2W = D_RNN + DN_VD;
constexpr int SMAX = (PAST + DT > SEQ) ? PAST + DT : SEQ, SLD = (SMAX + 63) / 64 * 64;
constexpr int NC = SEQ / 64, NCU = NB * DNH * NC;
constexpr float EPS = 1e-6f;
typedef unsigned short bf16;

constexpr size_t O_YP = 0, O_YS = O_YP + (size_t)MP * D, O_CONVP = O_YS + (size_t)MS * D, O_HP = O_CONVP + (size_t)N_REC * NB * 3 * CONV_CH,
    O_SP = O_HP + (size_t)N_REC * NB * D_RNN, O_KP = O_SP + (size_t)N_REC * NB * DNH * 128 * 128, O_VP = O_KP + (size_t)N_ATT * MP * KVH * HDIM,
    O_KIP = O_VP + (size_t)N_ATT * MP * KVH * HDIM, O_CONVS = O_KIP + (size_t)N_ATT * MP * IDIM, O_HS = O_CONVS + (size_t)N_REC * DB * 3 * CONV_CH,
    O_SS = O_HS + (size_t)N_REC * DB * D_RNN, O_KS = O_SS + (size_t)N_REC * DB * DNH * 128 * 128, O_VS = O_KS + (size_t)N_ATT * MS * KVH * HDIM,
    O_KIS = O_VS + (size_t)N_ATT * MS * KVH * HDIM, O_END = O_KIS + (size_t)N_ATT * MS * IDIM;

constexpr size_t al256(size_t x) { return (x + 255) / 256 * 256; }
constexpr size_t WS_CTL = 0, CTL_BYTES = 4u << 20;
constexpr size_t WS_WINR = CTL_BYTES, WS_WOUTR = WS_WINR + al256((size_t)N_REC * REC_PAD * D * 2), WS_WINA = WS_WOUTR + al256((size_t)N_REC * D * Y2W * 2),
    WS_WOUTA = WS_WINA + al256((size_t)N_ATT * ATT_PAD * D * 2), WS_WUP = WS_WOUTA + al256((size_t)N_ATT * D * D * 2), WS_WDN = WS_WUP + al256((size_t)DEPTH * D_FF * D * 2),
    WS_X = WS_WDN + al256((size_t)DEPTH * D * D_FF * 2), WS_XN = WS_X + al256((size_t)MPAD * D * 4), WS_P = WS_XN + al256((size_t)MPAD * D * 2),
    WS_H = WS_P + al256((size_t)MPAD * LDP * 4), WS_Y2 = WS_H + al256((size_t)MPAD * D_FF * 2), WS_XR = WS_Y2 + al256((size_t)MPAD * D * 2),
    WS_QKV = WS_XR + al256((size_t)MT * D_RNN * 4), WS_RA = WS_QKV + al256((size_t)MT * 1536 * 4), WS_RB = WS_RA + al256((size_t)MT * D_RNN * 4),
    WS_HH = WS_RB + al256((size_t)MT * D_RNN * 4), WS_QN = WS_HH + al256((size_t)MT * D_RNN * 4), WS_KN = WS_QN + al256((size_t)MT * 512 * 4),
    WS_GB = WS_KN + al256((size_t)MT * 512 * 4), WS_ODN = WS_GB + al256((size_t)MT * 16 * 4), WS_SCT = WS_ODN + al256((size_t)MT * 512 * 4),
    WS_IDX = WS_SCT + al256((size_t)MT * SLD * 4), WS_NSEL = WS_IDX + al256((size_t)MT * KROW * 4), WS_SCR = WS_NSEL + al256((size_t)MT * 4),
    WS_CARRY = WS_SCR + al256((size_t)MT * AH * KMAX * 4), WS_L = WS_CARRY + al256((size_t)NB * NC * D_RNN * 4), WS_AT = WS_L + al256((size_t)NCU * 4096 * 4),
    WS_UT = WS_AT + al256((size_t)NCU * 4096 * 2), WS_WN = WS_UT + al256((size_t)NCU * 8192 * 4), WS_QG = WS_WN + al256((size_t)NCU * 8192 * 2),
    WS_KDT = WS_QG + al256((size_t)NCU * 8192 * 2), WS_GL = WS_KDT + al256((size_t)NCU * 8192 * 2), WS_KNT = WS_GL + al256((size_t)NCU * 4), WS_END = WS_KNT + al256((size_t)NCU * 8192 * 4);

constexpr size_t WS_KB = WS_H, WS_VB = WS_KB + al256((size_t)MT * 256 * 2), WS_QIB = WS_VB + al256((size_t)MT * 256 * 2), WS_KIB = WS_QIB + al256((size_t)MT * 512 * 2);
constexpr size_t WS_QB = WS_KIB + al256((size_t)MT * 64 * 2);
static_assert(WS_QB + (size_t)MT * D * 2 <= WS_Y2, "bf16 attention copies must fit inside the H buffer");
#ifdef HOST_TEST
struct Args { const float* in[28]; float* out; unsigned char* ws; int ph_lo, ph_hi; };
#else
struct KArgs { const float* in[28]; float* out; unsigned char* ws; int ph_lo, ph_hi; };
struct Args { const float* const* in; float* out; unsigned char* ws; };
constexpr size_t WS_TAB = 65536;
constexpr size_t WS_SS = 1u << 20;
static_assert(WS_SS + (size_t)9 * MPAD * 8 <= CTL_BYTES, "norm statistics inside the memset region");
constexpr size_t WS_END2 = WS_END;
#endif
enum { I_XP = 0, I_XS, I_SCONV, I_SH, I_SS, I_CK, I_CV, I_CKI, I_PT, I_NMIX, I_NMLP, I_NFIN, I_WINR, I_WCONV, I_BCONV, I_WA, I_BA, I_WX, I_BX, I_LAM, I_ALOG, I_DTB, I_DNW,
       I_WOUTR, I_WINA, I_WOUTA, I_WUP, I_WDN };

HD bf16 f2bf(float f) { unsigned u; memcpy(&u, &f, 4); u += 0x7FFFu + ((u >> 16) & 1u); return (bf16)(u >> 16); }
HD float bf2f(bf16 b) { unsigned u = ((unsigned)b) << 16; float f; memcpy(&f, &u, 4); return f; }
#ifndef HOST_TEST
#define FEXP(x) __expf(x)
#define FLOG(x) __logf(x)
#define FRCP(x) __builtin_amdgcn_rcpf(x)
#define FSQRT(x) __builtin_amdgcn_sqrtf(x)
#define FRSQ(x) __builtin_amdgcn_rsqf(x)
#else
#define FEXP(x) expf(x)
#define FLOG(x) logf(x)
#define FRCP(x) (1.0f / (x))
#define FSQRT(x) sqrtf(x)
#define FRSQ(x) (1.0f / sqrtf(x))
#endif
HD float sigmoidf_(float x) { return FRCP(1.0f + FEXP(-x)); }
HD float softplusf_(float x) { return x > 20.f ? x : FLOG(1.0f + FEXP(x)); }
HD float siluf_(float x) { return x * sigmoidf_(x); }
HD float gelu_tanhf_(float x) { const float u = 0.7978845608028654f * (x + 0.044715f * x * x * x); const float th = 1.0f - 2.0f * FRCP(1.0f + FEXP(2.0f * u)); return 0.5f * x * (1.0f + th); }
HD unsigned fkey(float f) { f = f + 0.0f; unsigned u; memcpy(&u, &f, 4); return (u & 0x80000000u) ? ~u : (u | 0x80000000u); }
struct RowInfo { int seq, t, T, row0; bool sample; };
HD RowInfo row_info(int m) { RowInfo r; if (m < MP) { r.seq = m / SEQ; r.t = m % SEQ; r.T = SEQ; r.row0 = r.seq * SEQ; r.sample = false; }
    else { const int q = m - MP; r.seq = NB + q / DT; r.t = q % DT; r.T = DT; r.row0 = MP + (q / DT) * DT; r.sample = true; } return r; }

HD void ph_copy_x(const Args& a, size_t gtid, size_t gsz) {
    float* X = (float*)(a.ws + WS_X);
    for (size_t i = gtid; i < (size_t)MPAD * D; i += gsz) { const size_t m = i / D; X[i] = m < (size_t)MP ? a.in[I_XP][i] : (m < (size_t)MT ? a.in[I_XS][i - (size_t)MP * D] : 0.f); }
}
HD void wprep_one(const float* w, bf16* wt, int K, int N, int NP, const float* gamma, size_t gtid, size_t gsz) {
    const size_t k32n = (size_t)K / 32;
    for (size_t i = gtid; i < (size_t)NP * k32n; i += gsz) { const int n = (int)(i % NP); const size_t k0 = (i / NP) * 32; bf16 tmp[32];
#ifndef HOST_TEST
#pragma unroll
#endif
        for (int j = 0; j < 32; ++j) tmp[j] = n < N ? f2bf(w[(k0 + j) * (size_t)N + n] * (gamma ? gamma[k0 + j] : 1.0f)) : (bf16)0;
#ifndef HOST_TEST
#pragma unroll
#endif
        for (int j = 0; j < 32; ++j) wt[(size_t)n * K + k0 + j] = tmp[j]; }
}
HD void ph_wprep(const Args& a, bool fold, int part, size_t gtid, size_t gsz) {
    for (int r = 0; r < N_REC; ++r) { if (part == 2 || (part == 0) == (r == 0)) wprep_one(a.in[I_WINR] + (size_t)r * D * REC_IN, (bf16*)(a.ws + WS_WINR) + (size_t)r * REC_PAD * D, D, REC_IN, REC_PAD, fold ? a.in[I_NMIX] + (size_t)(2 * r) * D : nullptr, gtid, gsz);
        if (part != 0) wprep_one(a.in[I_WOUTR] + (size_t)r * Y2W * D, (bf16*)(a.ws + WS_WOUTR) + (size_t)r * D * Y2W, Y2W, D, D, nullptr, gtid, gsz); }
    if (part == 0) return;
    for (int r = 0; r < N_ATT; ++r) { wprep_one(a.in[I_WINA] + (size_t)r * D * ATT_IN, (bf16*)(a.ws + WS_WINA) + (size_t)r * ATT_PAD * D, D, ATT_IN, ATT_PAD, fold ? a.in[I_NMIX] + (size_t)(2 * r + 1) * D : nullptr, gtid, gsz);
        wprep_one(a.in[I_WOUTA] + (size_t)r * D * D, (bf16*)(a.ws + WS_WOUTA) + (size_t)r * D * D, D, D, D, nullptr, gtid, gsz); }
    for (int l = 0; l < DEPTH; ++l) { wprep_one(a.in[I_WUP] + (size_t)l * D * D_FF, (bf16*)(a.ws + WS_WUP) + (size_t)l * D_FF * D, D, D_FF, D_FF, fold ? a.in[I_NMLP] + (size_t)l * D : nullptr, gtid, gsz);
        wprep_one(a.in[I_WDN] + (size_t)l * D_FF * D, (bf16*)(a.ws + WS_WDN) + (size_t)l * D * D_FF, D_FF, D, D, nullptr, gtid, gsz); }
}
HD void ph_conv(const Args& a, int r, size_t gtid, size_t gsz) {
    const float* P = (const float*)(a.ws + WS_P); float* XR = (float*)(a.ws + WS_XR); float* QKV = (float*)(a.ws + WS_QKV);
    const float* wc = a.in[I_WCONV] + (size_t)r * 4 * CONV_CH; const float* bc = a.in[I_BCONV] + (size_t)r * D_RNN;
    for (size_t i = gtid; i < (size_t)MT * CONV_CH; i += gsz) { const int m = (int)(i / CONV_CH), c = (int)(i % CONV_CH); const RowInfo ri = row_info(m);
        float acc = 0.f;
        for (int k = 0; k < 4; ++k) { const int tau = ri.t - 3 + k; float xv;
            if (tau >= 0) xv = P[(size_t)(ri.row0 + tau) * LDP + c];
            else xv = ri.sample ? a.in[I_SCONV][(((size_t)r * DB + (ri.seq - NB)) * 3 + (3 + tau)) * CONV_CH + c] : 0.f;
            acc += xv * wc[(size_t)k * CONV_CH + c]; }
        if (c < D_RNN) XR[(size_t)m * D_RNN + c] = acc + bc[c]; else QKV[(size_t)m * 1536 + (c - D_RNN)] = siluf_(acc);
        const float uraw = P[(size_t)m * LDP + c];
        if (!ri.sample) { if (ri.t >= SEQ - 3) a.out[O_CONVP + (((size_t)r * NB + ri.seq) * 3 + (ri.t - (SEQ - 3))) * CONV_CH + c] = uraw; }
        else { if (ri.t >= DT - 3) a.out[O_CONVS + (((size_t)r * DB + (ri.seq - NB)) * 3 + (ri.t - (DT - 3))) * CONV_CH + c] = uraw; }
    }
}
HD void ph_rg_gates(const Args& a, int r, size_t gtid, size_t gsz) {
    const float* XR = (const float*)(a.ws + WS_XR); float* RA = (float*)(a.ws + WS_RA); float* RB = (float*)(a.ws + WS_RB);
    const float* wa = a.in[I_WA] + (size_t)r * RG_HEADS * RG_BW * RG_BW; const float* wx = a.in[I_WX] + (size_t)r * RG_HEADS * RG_BW * RG_BW;
    for (size_t i = gtid; i < (size_t)MT * D_RNN; i += gsz) { const int m = (int)(i / D_RNN), j = (int)(i % D_RNN), hd = j / RG_BW, jj = j % RG_BW; const RowInfo ri = row_info(m);
        float pr = 0.f, pi = 0.f; const float* xrow = XR + (size_t)m * D_RNN + hd * RG_BW;
        for (int k = 0; k < RG_BW; ++k) { const float xv = xrow[k]; pr += xv * wa[((size_t)hd * RG_BW + k) * RG_BW + jj]; pi += xv * wx[((size_t)hd * RG_BW + k) * RG_BW + jj]; }
        const float rg = sigmoidf_(pr + a.in[I_BA][(size_t)r * D_RNN + j]), ig = sigmoidf_(pi + a.in[I_BX][(size_t)r * D_RNN + j]);
        const float log_a = -8.0f * rg * softplusf_(-a.in[I_LAM][(size_t)r * D_RNN + j]); const float av = FEXP(log_a);
        const bool first = (!ri.sample) && ri.t == 0;
        const float mult = first ? 1.0f : sqrtf(fmaxf(1.0f - FEXP(2.0f * log_a), 0.0f));
        float bv = XR[(size_t)m * D_RNN + j] * ig * mult;
        if (ri.t == 0 && ri.sample) bv += av * a.in[I_SH][((size_t)r * DB + (ri.seq - NB)) * D_RNN + j];
        RA[i] = av; RB[i] = bv; }
}
HD void ph_rg_scan1(const Args& a, int r, size_t gtid, size_t gsz) {
    const float* RA = (const float*)(a.ws + WS_RA); float* AP = (float*)(a.ws + WS_XR); const float* RB = (const float*)(a.ws + WS_RB); float* HH = (float*)(a.ws + WS_HH);
    const size_t n_p = (size_t)NB * NC * D_RNN, n_s = (size_t)DB * D_RNN;
    for (size_t i = gtid; i < n_p + n_s; i += gsz) {
        if (i < n_p) { const int j = (int)(i % D_RNN); const size_t row0 = (i / D_RNN) * 64; float h = 0.f, ap = 1.f;
            for (int t = 0; t < 64; ++t) { const size_t o = (row0 + t) * D_RNN + j; const float av = RA[o]; h = av * h + RB[o]; ap *= av; HH[o] = h; AP[o] = ap; } }
        else { const size_t q = i - n_p; const int db = (int)(q / D_RNN), j = (int)(q % D_RNN); float h = 0.f;
            for (int t = 0; t < DT; ++t) { const size_t o = (size_t)(MP + db * DT + t) * D_RNN + j; h = RA[o] * h + RB[o]; HH[o] = h; }
            a.out[O_HS + ((size_t)r * DB + db) * D_RNN + j] = h; } }
}
HD void ph_rg_scan2(const Args& a, int r, size_t gtid, size_t gsz) {
    const float* RA = (const float*)(a.ws + WS_XR); const float* HH = (const float*)(a.ws + WS_HH); float* CARRY = (float*)(a.ws + WS_CARRY);
    for (size_t i = gtid; i < (size_t)NB * D_RNN; i += gsz) { const int b = (int)(i / D_RNN), j = (int)(i % D_RNN); float carry = 0.f;
        for (int n0 = 0; n0 < NC; n0 += 16) { float av[16], hv[16];
#pragma unroll
            for (int q = 0; q < 16; ++q) { const int n = n0 + q < NC ? n0 + q : NC - 1; const size_t last = ((size_t)b * SEQ + n * 64 + 63) * D_RNN + j; av[q] = RA[last]; hv[q] = HH[last]; }
#pragma unroll
            for (int q = 0; q < 16; ++q) if (n0 + q < NC) { CARRY[((size_t)b * NC + n0 + q) * D_RNN + j] = carry; carry = av[q] * carry + hv[q]; } }
        a.out[O_HP + ((size_t)r * NB + b) * D_RNN + j] = carry; }
}
HD float dn_g(const Args& a, int r, size_t m, int hd) { const float* P = (const float*)(a.ws + WS_P);
    return -FEXP(a.in[I_ALOG][r * DNH + hd]) * softplusf_(P[m * LDP + OFF_A + hd] + a.in[I_DTB][r * DNH + hd]); }
HD void ph_dn_prep(const Args& a, int r, size_t gtid, size_t gsz) {
    const float* P = (const float*)(a.ws + WS_P); const float* QKV = (const float*)(a.ws + WS_QKV); float* QN = (float*)(a.ws + WS_QN); float* KN = (float*)(a.ws + WS_KN); float* GB = (float*)(a.ws + WS_GB);
    for (size_t i = gtid; i < (size_t)MT * DNH; i += gsz) { const int m = (int)(i / DNH), hd = (int)(i % DNH);
        const float* q = QKV + (size_t)m * 1536 + hd * 128; const float* k = q + 512; float sq = 0.f, sk = 0.f;
        for (int d = 0; d < 128; ++d) { sq += q[d] * q[d]; sk += k[d] * k[d]; }
        const float rq = FRSQ(sq + EPS) * 0.08838834764831845f, rk = 1.0f / sqrtf(sk + EPS);
        for (int d = 0; d < 128; ++d) { QN[(size_t)m * 512 + hd * 128 + d] = q[d] * rq; KN[(size_t)m * 512 + hd * 128 + d] = k[d] * rk; }
        if (m < MP) { float* KNT = (float*)(a.ws + WS_KNT) + (((size_t)(m / SEQ) * DNH + hd) * NC + (m % SEQ) / 64) * 8192 + (m % 64); for (int d = 0; d < 128; ++d) KNT[(size_t)d * 64] = k[d] * rk; }
        const float beta = sigmoidf_(P[(size_t)m * LDP + OFF_B + hd]);
        const float g = dn_g(a, r, (size_t)m, hd); float gc = g;
        if (m < MP) { const int t = m % SEQ; for (int tau = (t / 64) * 64; tau < t; ++tau) gc += dn_g(a, r, (size_t)(m - t + tau), hd); }
        GB[(size_t)m * 16 + hd * 4] = g; GB[(size_t)m * 16 + hd * 4 + 1] = beta; GB[(size_t)m * 16 + hd * 4 + 2] = gc; }
}
#ifndef HOST_TEST
#define DN_FENCE() asm volatile("" ::: "memory")
#else
#define DN_FENCE() do { } while (0)
#endif
HD void ph_dn_seq(const Args& a, int r, int seq_lo, size_t gtid, size_t gsz) {
    const float* QKV = (const float*)(a.ws + WS_QKV); const float* QN = (const float*)(a.ws + WS_QN); const float* KN = (const float*)(a.ws + WS_KN); const float* GB = (const float*)(a.ws + WS_GB);
    float* ODN = (float*)(a.ws + WS_ODN);
    for (size_t i = gtid; i < (size_t)(NB + DB - seq_lo) * DNH * 128; i += gsz) { const int v = (int)(i % 128), sh = UNI((int)(i / 128)), hd = sh % DNH, seq = seq_lo + sh / DNH;
        const int row0 = seq < NB ? seq * SEQ : MP + (seq - NB) * DT, T = seq < NB ? SEQ : DT;
        float S[128];
        if (seq < NB) {
#pragma unroll
            for (int d = 0; d < 128; ++d) S[d] = 0.f; }
        else { const float* s0 = a.in[I_SS] + ((((size_t)r * DB + (seq - NB)) * DNH + hd) * 128) * 128 + v;
#pragma unroll
            for (int d = 0; d < 128; ++d) S[d] = s0[(size_t)d * 128]; }
        for (int t = 0; t < T; ++t) { const size_t m = (size_t)(row0 + t);
            const float* kk = KN + m * 512 + hd * 128; const float* qq = QN + m * 512 + hd * 128;
            const float eg = FEXP(GB[m * 16 + hd * 4]), beta = GB[m * 16 + hd * 4 + 1], vv = QKV[m * 1536 + 1024 + hd * 128 + v];
            float ks = 0.f;
#pragma unroll
            for (int c = 0; c < 4; ++c) {
#pragma unroll
                for (int d = c * 32; d < c * 32 + 32; ++d) ks += kk[d] * S[d];
                DN_FENCE(); }
            const float cc = beta * (vv - eg * ks); float o = 0.f;
#pragma unroll
            for (int c = 0; c < 4; ++c) {
#pragma unroll
                for (int d = c * 32; d < c * 32 + 32; ++d) { S[d] = eg * S[d] + kk[d] * cc; o += qq[d] * S[d]; }
                DN_FENCE(); }
            ODN[m * 512 + hd * 128 + v] = o; }
        float* so = seq < NB ? a.out + O_SP + ((((size_t)r * NB + seq) * DNH + hd) * 128) * 128 + v : a.out + O_SS + ((((size_t)r * DB + (seq - NB)) * DNH + hd) * 128) * 128 + v;
#pragma unroll
        for (int d = 0; d < 128; ++d) so[(size_t)d * 128] = S[d]; }
}
HD void ph_dn_lat(const Args& a, size_t gtid, size_t gsz) {
    const float* QN = (const float*)(a.ws + WS_QN); const float* KN = (const float*)(a.ws + WS_KN); const float* GB = (const float*)(a.ws + WS_GB); const float* KNT = (const float*)(a.ws + WS_KNT);
    float* Lm = (float*)(a.ws + WS_L); bf16* AT = (bf16*)(a.ws + WS_AT); bf16* QG = (bf16*)(a.ws + WS_QG); bf16* KDT = (bf16*)(a.ws + WS_KDT); float* GL = (float*)(a.ws + WS_GL);
    for (size_t it = gtid; it < (size_t)NCU * 4096; it += gsz) { const int j = (int)(it % 64), ci = UNI((int)(it / 64)), i = ci % 64, cu = ci / 64;
        const int n = cu % NC, hd = (cu / NC) % DNH, b = cu / (NC * DNH); const size_t mi = (size_t)b * SEQ + n * 64 + i, mj = (size_t)b * SEQ + n * 64 + j;
        const float* ki = KN + mi * 512 + hd * 128; const float* qi = QN + mi * 512 + hd * 128; const float* kt = KNT + (size_t)cu * 8192 + j; float kk = 0.f, qk = 0.f;
        for (int d = 0; d < 128; ++d) { const float kj = kt[(size_t)d * 64]; kk += ki[d] * kj; qk += qi[d] * kj; }
        float lv = 0.f, av = 0.f;
        if (i >= j) { const float dec = FEXP(GB[mi * 16 + hd * 4 + 2] - GB[mj * 16 + hd * 4 + 2]); av = qk * dec; if (i > j) lv = GB[mi * 16 + hd * 4 + 1] * kk * dec; }
        Lm[it] = lv; AT[it] = f2bf(av); }
    for (size_t it = gtid; it < (size_t)NCU * 8192; it += gsz) { const int d = (int)(it % 128), i = (int)((it / 128) % 64), cu = (int)(it / 8192);
        const int n = cu % NC, hd = (cu / NC) % DNH, b = cu / (NC * DNH); const size_t mi = (size_t)b * SEQ + n * 64 + i;
        QG[it] = f2bf(QN[mi * 512 + hd * 128 + d] * FEXP(GB[mi * 16 + hd * 4 + 2])); }
    for (size_t it = gtid; it < (size_t)NCU * 8192; it += gsz) { const int i = (int)(it % 64), cu = (int)(it / 8192);
        const int n = cu % NC, hd = (cu / NC) % DNH, b = cu / (NC * DNH); const size_t mi = (size_t)b * SEQ + n * 64 + i, ml = (size_t)b * SEQ + n * 64 + 63;
        const float gci = GB[mi * 16 + hd * 4 + 2], gcl = GB[ml * 16 + hd * 4 + 2];
        KDT[it] = f2bf(KNT[it] * FEXP(gcl - gci)); if ((it % 8192) == 0) GL[cu] = FEXP(gcl); }
}
HD void ph_dn_solve(const Args& a, size_t gtid, size_t gsz) {
    const float* QKV = (const float*)(a.ws + WS_QKV); const float* KN = (const float*)(a.ws + WS_KN); const float* GB = (const float*)(a.ws + WS_GB); const float* Lm = (const float*)(a.ws + WS_L);
    float* UT = (float*)(a.ws + WS_UT); bf16* WN = (bf16*)(a.ws + WS_WN);
    for (size_t it = gtid; it < (size_t)NCU * 256; it += gsz) { const int col = (int)(it % 256), cu = UNI((int)(it / 256));
        const int n = cu % NC, hd = (cu / NC) % DNH, b = cu / (NC * DNH); const size_t m0 = (size_t)b * SEQ + n * 64; const float* Lc = Lm + (size_t)cu * 4096;
        float X[64];
#pragma unroll
        for (int j = 0; j < 64; ++j) { const float beta = GB[(m0 + j) * 16 + hd * 4 + 1];
            X[j] = col < 128 ? QKV[(m0 + j) * 1536 + 1024 + hd * 128 + col] * beta : KN[(m0 + j) * 512 + hd * 128 + (col - 128)] * beta * FEXP(GB[(m0 + j) * 16 + hd * 4 + 2]); }
#pragma unroll
        for (int i = 1; i < 64; ++i) { float acc = X[i];
#pragma unroll
            for (int j = 0; j < i; ++j) acc -= Lc[i * 64 + j] * X[j];
            X[i] = acc; DN_FENCE(); }
        if (col < 128) {
#pragma unroll
            for (int j = 0; j < 64; ++j) UT[(size_t)cu * 8192 + (size_t)col * 64 + j] = X[j]; }
        else {
#pragma unroll
            for (int j = 0; j < 64; ++j) WN[(size_t)cu * 8192 + (size_t)j * 128 + (col - 128)] = f2bf(-X[j]); } }
}
HD float bfr(float x) { return bf2f(f2bf(x)); }
HD void ph_dn_b_naive(const Args& a, int r, size_t gtid, size_t gsz) {
    const float* UT = (const float*)(a.ws + WS_UT); const bf16* WN = (const bf16*)(a.ws + WS_WN); const bf16* QG = (const bf16*)(a.ws + WS_QG); const bf16* AT = (const bf16*)(a.ws + WS_AT);
    const bf16* KDT = (const bf16*)(a.ws + WS_KDT); const float* GL = (const float*)(a.ws + WS_GL); float* ODN = (float*)(a.ws + WS_ODN); float* VN = (float*)(a.ws + WS_SCR);
    for (size_t it = gtid; it < (size_t)NB * DNH * 128; it += gsz) { const int v = (int)(it % 128), bh = UNI((int)(it / 128)), b = bh / DNH, hd = bh % DNH;
        float S[128];
#pragma unroll
        for (int d = 0; d < 128; ++d) S[d] = 0.f;
        for (int n = 0; n < NC; ++n) { const size_t cu = (size_t)bh * NC + n;
            for (int i = 0; i < 64; ++i) { float acc = UT[cu * 8192 + (size_t)v * 64 + i]; const bf16* wr = WN + cu * 8192 + i * 128;
#pragma unroll
                for (int d = 0; d < 128; ++d) acc += bf2f(wr[d]) * S[d];
                VN[((size_t)bh * 64 + i) * 128 + v] = acc; DN_FENCE(); }
            for (int i = 0; i < 64; ++i) { float acc = 0.f; const bf16* qr = QG + cu * 8192 + i * 128;
#pragma unroll
                for (int d = 0; d < 128; ++d) acc += bf2f(qr[d]) * S[d];
                for (int j = 0; j < 64; ++j) acc += bf2f(AT[cu * 4096 + i * 64 + j]) * bfr(VN[((size_t)bh * 64 + j) * 128 + v]);
                ODN[((size_t)b * SEQ + n * 64 + i) * 512 + hd * 128 + v] = acc; DN_FENCE(); }
            const float gl = GL[cu];
#pragma unroll
            for (int d = 0; d < 128; ++d) S[d] *= gl;
            for (int j = 0; j < 64; ++j) { const float vj = bfr(VN[((size_t)bh * 64 + j) * 128 + v]); const bf16* kr = KDT + cu * 8192 + j;
#pragma unroll
                for (int d = 0; d < 128; ++d) S[d] += bf2f(kr[d * 64]) * vj;
                DN_FENCE(); }
            DN_FENCE(); }
        float* so = a.out + O_SP + ((((size_t)r * NB + b) * DNH + hd) * 128) * 128 + v;
#pragma unroll
        for (int d = 0; d < 128; ++d) so[(size_t)d * 128] = S[d]; }
}
HD void ph_rec_out(const Args& a, int r, size_t gtid, size_t gsz) {
    const float* P = (const float*)(a.ws + WS_P); const float* HH = (const float*)(a.ws + WS_HH); const float* ODN = (const float*)(a.ws + WS_ODN); bf16* Y2 = (bf16*)(a.ws + WS_Y2);
    for (size_t i = gtid; i < (size_t)MT * Y2W; i += gsz) { const int m = (int)(i / Y2W), c = (int)(i % Y2W); float y;
        if (c < D_RNN) { float h = HH[(size_t)m * D_RNN + c]; if (m < MP) h += ((const float*)(a.ws + WS_XR))[(size_t)m * D_RNN + c] * ((const float*)(a.ws + WS_CARRY))[(size_t)(m / 64) * D_RNN + c];
            y = h * gelu_tanhf_(P[(size_t)m * LDP + OFF_GATE + c]); }
        else { const int cc = c - D_RNN, hd = cc / 128, vv = cc % 128; const float* o = ODN + (size_t)m * 512 + hd * 128; float ss = 0.f;
            for (int d = 0; d < 128; ++d) ss += o[d] * o[d];
            y = o[vv] / sqrtf(ss * (1.0f / 128.0f) + EPS) * a.in[I_DNW][r * 128 + vv] * siluf_(P[(size_t)m * LDP + OFF_Z + cc]); }
        Y2[i] = f2bf(y); }
}
HD void ph_att_split(const Args& a, int ai, size_t gtid, size_t gsz) {
    const float* P = (const float*)(a.ws + WS_P); constexpr int W = 2 * KVH * HDIM + IDIM;
    for (size_t i = gtid; i < (size_t)MT * W; i += gsz) { const int m = (int)(i / W), c = (int)(i % W);
        if (m < MP) { if (c < 256) a.out[O_KP + ((size_t)ai * MP + m) * 256 + c] = P[(size_t)m * LDP + AO_K + c];
            else if (c < 512) a.out[O_VP + ((size_t)ai * MP + m) * 256 + (c - 256)] = P[(size_t)m * LDP + AO_V + (c - 256)];
            else a.out[O_KIP + ((size_t)ai * MP + m) * 64 + (c - 512)] = P[(size_t)m * LDP + AO_KI + (c - 512)]; }
        else { const int ms = m - MP; if (c < 256) a.out[O_KS + ((size_t)ai * MS + ms) * 256 + c] = P[(size_t)m * LDP + AO_K + c];
            else if (c < 512) a.out[O_VS + ((size_t)ai * MS + ms) * 256 + (c - 256)] = P[(size_t)m * LDP + AO_V + (c - 256)];
            else a.out[O_KIS + ((size_t)ai * MS + ms) * 64 + (c - 512)] = P[(size_t)m * LDP + AO_KI + (c - 512)]; } }
}
HD const float* ki_row_sample(const Args& a, int ai, int db, int s) {
    if (s < PAST) { const int pg = ((const int*)a.in[I_PT])[db * NPAGES + s / PAGE]; return a.in[I_CKI] + (((size_t)ai * NPOOL + pg) * PAGE + s % PAGE) * IDIM; }
    return (const float*)(a.ws + WS_P) + (size_t)(MP + db * DT + (s - PAST)) * LDP + AO_KI;
}
HD void ph_idx_scores(const Args& a, int ai, bool prompt_too, size_t gtid, size_t gsz) {
    const float* P = (const float*)(a.ws + WS_P); float* SCT = (float*)(a.ws + WS_SCT);
    const int lane = (int)(gtid & 63); const size_t w = gtid >> 6, nw = gsz >> 6;
    constexpr int TM = 8, NKB = (SEQ + 63) / 64, NMT = SEQ / TM, NKBS = (PAST + DT + 63) / 64;
    const size_t n_p = (size_t)NB * NMT * NKB, n_s = (size_t)DB * NKBS;
    for (size_t it0 = w + (prompt_too ? 0 : n_p); it0 < n_p + n_s; it0 += nw) { const size_t it = (size_t)UNI((int)it0);
        int mrow0, nrows, s, smax_valid; const float* kr;
        if (it < n_p) { const int b = (int)(it / ((size_t)NMT * NKB)), rr = (int)(it % ((size_t)NMT * NKB)), mt = rr / NKB, kb = rr % NKB;
            if (kb * 64 > mt * TM + TM - 1) continue;
            mrow0 = b * SEQ + mt * TM; nrows = TM; s = kb * 64 + lane; smax_valid = SEQ; kr = P + (size_t)(b * SEQ + (s < SEQ ? s : 0)) * LDP + AO_KI; }
        else { const int q = (int)(it - n_p), db = q / NKBS, kb = q % NKBS; mrow0 = MP + db * DT; nrows = DT; s = kb * 64 + lane; smax_valid = PAST + DT; kr = ki_row_sample(a, ai, db, s < PAST + DT ? s : 0); }
        float kv[IDIM];
#pragma unroll
        for (int d = 0; d < IDIM; ++d) kv[d] = kr[d];
        for (int i = 0; i < nrows; ++i) { const int m = mrow0 + i; const float* qi = P + (size_t)m * LDP + AO_QI; const float* wi = P + (size_t)m * LDP + AO_WI; float sc = 0.f;
            for (int h = 0; h < IH; ++h) { float dot = 0.f;
#pragma unroll
                for (int d = 0; d < IDIM; ++d) dot += qi[h * IDIM + d] * kv[d];
                sc += wi[h] * fmaxf(dot, 0.f); }
            if (s < smax_valid) SCT[(size_t)m * SLD + s] = sc; } }
}
HD void ph_select(const Args& a, size_t gtid, size_t gsz) {
    const float* SCT = (const float*)(a.ws + WS_SCT); int* IDX = (int*)(a.ws + WS_IDX); int* NSEL = (int*)(a.ws + WS_NSEL);
    for (size_t m = gtid; m < (size_t)MT; m += gsz) { const RowInfo ri = row_info((int)m);
        const int n = ri.sample ? PAST + ri.t + 1 : ri.t + 1, K = ri.sample ? TOPK_S : TOPK_P; const float* col = SCT + m * SLD; int* out = IDX + m * KROW;
        if (n <= K) { for (int j = 0; j < n; ++j) out[j] = j; NSEL[m] = n; continue; }
        unsigned lo = 0u;
        for (int bit = 31; bit >= 0; --bit) { const unsigned cand = lo | (1u << bit); int c = 0;
            for (int s = 0; s < n; ++s) c += (fkey(col[s]) >= cand) ? 1 : 0;
            if (c >= K) lo = cand; }
        int cnt = 0;
        for (int s = 0; s < n; ++s) if (fkey(col[s]) > lo) out[cnt++] = s;
        for (int s = 0; s < n && cnt < K; ++s) if (fkey(col[s]) == lo) out[cnt++] = s;
        NSEL[m] = K; }
}
HD const float* kv_row(const Args& a, int ai, const RowInfo& ri, int idx, int kvh, bool isv) {
    const float* P = (const float*)(a.ws + WS_P); const int off = (isv ? AO_V : AO_K) + kvh * HDIM;
    if (!ri.sample) return P + (size_t)(ri.row0 + idx) * LDP + off;
    const int db = ri.seq - NB;
    if (idx >= PAST) return P + (size_t)(MP + db * DT + (idx - PAST)) * LDP + off;
    const int pg = ((const int*)a.in[I_PT])[db * NPAGES + idx / PAGE];
    return a.in[isv ? I_CV : I_CK] + ((((size_t)ai * NPOOL + pg) * PAGE + idx % PAGE) * KVH + kvh) * HDIM;
}
HD void ph_sp_scores(const Args& a, int ai, int m_lo, int m_hi, size_t gtid, size_t gsz) {
    const float* P = (const float*)(a.ws + WS_P); const int* IDX = (const int*)(a.ws + WS_IDX); const int* NSEL = (const int*)(a.ws + WS_NSEL); float* SCR = (float*)(a.ws + WS_SCR);
    for (size_t i = gtid + (size_t)m_lo * AH * KMAX; i < (size_t)m_hi * AH * KMAX; i += gsz) { const int j = (int)(i % KMAX), h = (int)((i / KMAX) % AH), m = (int)(i / ((size_t)KMAX * AH));
        if (j >= NSEL[m]) { SCR[i] = -1e30f; continue; }
        const RowInfo ri = row_info(m); const float* kr = kv_row(a, ai, ri, IDX[(size_t)m * KROW + j], h / GROUP, false); const float* q = P + (size_t)m * LDP + h * HDIM; float dot = 0.f;
        for (int d = 0; d < HDIM; ++d) dot += q[d] * kr[d];
        SCR[i] = dot * 0.08838834764831845f; }
}
HD void ph_sp_out(const Args& a, int ai, int m_lo, int m_hi, size_t gtid, size_t gsz) {
    const int* IDX = (const int*)(a.ws + WS_IDX); const int* NSEL = (const int*)(a.ws + WS_NSEL); const float* SCR = (const float*)(a.ws + WS_SCR); bf16* O = (bf16*)(a.ws + WS_Y2);
    for (size_t i = gtid + (size_t)m_lo * AH * HDIM; i < (size_t)m_hi * AH * HDIM; i += gsz) { const int d = (int)(i % HDIM), h = (int)((i / HDIM) % AH), m = (int)(i / ((size_t)HDIM * AH));
        const int ns = NSEL[m]; const float* sc = SCR + ((size_t)m * AH + h) * KMAX; const RowInfo ri = row_info(m);
        float mx = -3e38f; for (int j = 0; j < ns; ++j) mx = fmaxf(mx, sc[j]);
        float sum = 0.f, acc = 0.f;
        for (int j = 0; j < ns; ++j) { const float p = FEXP(sc[j] - mx); sum += p; acc += p * kv_row(a, ai, ri, IDX[(size_t)m * KROW + j], h / GROUP, true)[d]; }
        O[(size_t)m * D + h * HDIM + d] = f2bf(acc / sum); }
}
#ifndef HOST_TEST
#define LAS __attribute__((address_space(3)))

constexpr int LDS_WTAB = 131072 + 64;
__device__ __forceinline__ int TID() { extern __shared__ __attribute__((aligned(16))) unsigned char lds_dyn_[]; const unsigned hw = (unsigned)__builtin_amdgcn_s_getreg((5 << 11) | 4) & 63u;
    const int wvi = ((const LAS int*)((LAS unsigned char*)lds_dyn_ + LDS_WTAB))[hw]; int ln_; asm volatile("v_mbcnt_lo_u32_b32 %0, -1, 0\n\tv_mbcnt_hi_u32_b32 %0, -1, %0" : "=v"(ln_));
    return (wvi << 6) | ln_; }
#define XB_TMO      128
#define XB_XCNT(j)  (256  + 64 * (j))
#define XB_XSUB(j)  (1280 + 64 * (j))
#define XB_XGEN(j)  (2304 + 64 * (j))
#define XB_TOP      3328
#define XB_TOPGEN   3392
#define XCD_BAR_WORDS 3456
#define XB_SPIN_CAP (1u << 22)

__device__ __forceinline__ unsigned xb_ld(unsigned* p)              { return __hip_atomic_load(p, __ATOMIC_RELAXED, __HIP_MEMORY_SCOPE_AGENT); }
__device__ __forceinline__ unsigned xb_add(unsigned* p, unsigned v) { return __hip_atomic_fetch_add(p, v, __ATOMIC_RELAXED, __HIP_MEMORY_SCOPE_AGENT); }
__device__ __forceinline__ unsigned xb_xcc_id() { return (unsigned)__builtin_amdgcn_s_getreg((3 << 11) | 20) & 0xFu; }
#define XB_SPIN(cond, bar) do { unsigned _sp = 0; while (cond) { __builtin_amdgcn_s_sleep(1); \
    if ((++_sp & 255u) == 0u) { if (xb_ld(&(bar)[XB_TMO])) break; if (_sp > XB_SPIN_CAP) { atomicAdd(&(bar)[XB_TMO], 1u); break; } } } } while (0)

struct XcdBarrier {
    unsigned* bar; unsigned x;
    volatile LAS unsigned* st;
};

__device__ __forceinline__ XcdBarrier xcd_barrier_post(unsigned* bar, volatile LAS unsigned* st) {
    XcdBarrier b; b.bar = bar; b.x = xb_xcc_id(); b.st = st;
    if (TID() == 0) (void)xb_add(&bar[XB_XCNT(b.x)], 1u);
    return b;
}
__device__ __forceinline__ void xcd_barrier_complete(unsigned* bar, unsigned x, unsigned& nloc, unsigned& nx) {
    const unsigned G = gridDim.x * gridDim.y * gridDim.z;
    unsigned sum, cnt, mine, sp = 0u;
    for (;;) {
        sum = 0u; cnt = 0u; mine = 0u;
#pragma unroll
        for (unsigned j = 0; j < 16; ++j) { const unsigned c = xb_ld(&bar[XB_XCNT(j)]); sum += c; cnt += (c > 0u) ? 1u : 0u; mine = (j == x) ? c : mine; }
        if (sum == G) break;
        __builtin_amdgcn_s_sleep(1);
        if ((++sp & 255u) == 0u) { if (xb_ld(&bar[XB_TMO])) break; if (sp > XB_SPIN_CAP) { atomicAdd(&bar[XB_TMO], 1u); break; } }
    }
    nloc = mine > 0u ? mine : 1u; nx = cnt > 0u ? cnt : 1u;
}

__device__ __forceinline__ void xcd_barrier(const XcdBarrier& b) {
    asm volatile("s_waitcnt vmcnt(0)" ::: "memory");
    __syncthreads();
    if (TID() == 0) {
        unsigned* bar = b.bar;
        __builtin_amdgcn_s_waitcnt(0);
        unsigned nloc = b.st[0], nx = b.st[1];
        if (nloc == 0u) { xcd_barrier_complete(bar, b.x, nloc, nx); b.st[0] = nloc; b.st[1] = nx; }
        const unsigned old = xb_add(&bar[XB_XSUB(b.x)], 1u);
        const unsigned gen = old / nloc;
        if (old + 1u == (gen + 1u) * nloc) {
            __builtin_amdgcn_fence(__ATOMIC_RELEASE, "agent");
            asm volatile("s_waitcnt vmcnt(0)" ::: "memory");
            const unsigned og = xb_add(&bar[XB_TOP], 1u);
            const unsigned tg = og / nx;
            if (og + 1u == (tg + 1u) * nx) xb_add(&bar[XB_TOPGEN], 1u);
            else XB_SPIN(xb_ld(&bar[XB_TOPGEN]) == tg, bar);
            __builtin_amdgcn_fence(__ATOMIC_ACQUIRE, "agent");
            xb_add(&bar[XB_XGEN(b.x)], 1u);
            asm volatile("s_waitcnt vmcnt(0)" ::: "memory");
        } else {
            XB_SPIN(xb_ld(&bar[XB_XGEN(b.x)]) == gen, bar);
            __builtin_amdgcn_fence(__ATOMIC_ACQUIRE, "agent");
            asm volatile("s_waitcnt vmcnt(0)" ::: "memory");
        }
    }
    __syncthreads();
}

namespace pg8 {
#define PG8_LAS __attribute__((address_space(3)))
typedef unsigned short bf16_t;
typedef short bf16x8 __attribute__((ext_vector_type(8)));
typedef float f32x4 __attribute__((ext_vector_type(4)));
typedef unsigned u32x4 __attribute__((ext_vector_type(4)));
constexpr int BM = 256, BK = 64, HALF = 128, HTB = HALF * BK * 2  , STAGE_BYTES = 8 * HTB, NXCD = 8, WGM = 8;

__host__ __device__ __forceinline__ int lds_byte(int r, int c) { const int st = (r >> 4) * 2 + (c >> 5), rr = r & 15, cc = c & 31, ob = rr * 64 + cc * 2; return st * 1024 + (ob ^ (((ob >> 9) & 1) << 5)); }
__host__ __device__ __forceinline__ void stage_rc(int b, int& R, int& C) { const int st = b / 1024, sb = b % 1024, swz = sb ^ (((sb >> 9) & 1) << 5); R = (st >> 1) * 16 + swz / 64; C = (st & 1) * 32 + (swz % 64) / 2; }
__host__ __device__ __forceinline__ int perm32(int rho) { const int n = rho >> 4, i = rho & 15; return 8 * (i >> 2) + 4 * n + (i & 3); }

struct Unit { int pm, pn; };
struct Gemm { const bf16_t* A; const bf16_t* Bt; int M, N, K; };

struct StaticOrder {
    int nM, nN, nwg, G, c;
    __host__ __device__ void init(int M, int N, int G_, int c_) { nM = M / BM; nN = N / BM; nwg = nM * nN; G = G_; c = c_; }
    __host__ __device__ bool next(int i, Unit& u) const {
        const long L = (long)i * G + c; if (L >= nwg) return false;
        int wgid = (int)L; { const int q = nwg / NXCD, r = nwg % NXCD, xcd = wgid % NXCD, off = wgid / NXCD; wgid = (xcd < r ? xcd * (q + 1) : r * (q + 1) + (xcd - r) * q) + off; }
        const int nig = WGM * nN, gid = wgid / nig, fm = gid * WGM, gsz = (nM - fm) < WGM ? (nM - fm) : WGM;
        u.pm = fm + ((wgid % nig) % gsz); u.pn = (wgid % nig) / gsz; return true;
    }
    __device__ __forceinline__ void a_ready(const Unit&) const {}
    __device__ __forceinline__ void done(const Unit&) const {}
};

__device__ __forceinline__ unsigned cvt_pk_bf16(float lo, float hi) { unsigned r; asm volatile("v_cvt_pk_bf16_f32 %0, %1, %2" : "=v"(r) : "v"(lo), "v"(hi)); return r; }
struct EpiF32 {
    static constexpr bool PERM = false, AFTER_DRAIN = false;
    float* C; int ldc; const float* bias;
    __device__ __forceinline__ void operator()(const f32x4 (&acc)[2][2][4][2], const Unit& u, int wr, int wc, int fr, int fq) const {
        const int row0 = u.pm * BM + wr * 64 + fr, col0 = u.pn * BM + wc * 32 + 4 * fq;
        f32x4 bv[2][2];
#pragma unroll
        for (int bj = 0; bj < 2; ++bj)
#pragma unroll
            for (int n = 0; n < 2; ++n) bv[bj][n] = bias ? *(const f32x4*)(bias + col0 + bj * HALF + n * 16) : (f32x4){0.f, 0.f, 0.f, 0.f};
#pragma unroll
        for (int ai = 0; ai < 2; ++ai)
#pragma unroll
            for (int m = 0; m < 4; ++m) { float* rowp = C + (size_t)(row0 + ai * HALF + m * 16) * ldc + col0;
#pragma unroll
                for (int bj = 0; bj < 2; ++bj)
#pragma unroll
                    for (int n = 0; n < 2; ++n) *(f32x4*)(rowp + bj * HALF + n * 16) = acc[ai][bj][m][n] + bv[bj][n]; }
    }
};
template <class Epi, class Sched, bool STAMP = false>
__device__ __forceinline__ void gemm_phase(PG8_LAS unsigned char* lds, const Gemm g, const Sched& S, const Epi& E, unsigned long long* stamps) {
    int tid_ = TID(); asm volatile("" : "+v"(tid_));
    const int tid = tid_, wid = __builtin_amdgcn_readfirstlane(tid >> 6), lane = tid & 63, wr = wid >> 2, wc = wid & 3, fr = lane & 15, fq = lane >> 4;
    const int K = g.K, nt = K / BK;
    int ts_lo = 0, ts_hi = 0, nts = 0; const unsigned long long rt_entry = STAMP ? (unsigned long long)wall_clock64() : 0ull;
#define PG8_STAMP() do { if (STAMP && wid == 0 && nts < 64) { const unsigned long long _c = (unsigned long long)clock64(); \
        ts_lo = (lane == nts) ? (int)(unsigned)_c : ts_lo; ts_hi = (lane == nts) ? (int)(unsigned)(_c >> 32) : ts_hi; ++nts; } } while (0)
    PG8_STAMP();
    unsigned voffA[2], voffB[2];
#pragma unroll
    for (int i = 0; i < 2; ++i) { int R, C; stage_rc(tid * 16 + i * 8192, R, C); const int Rb = Epi::PERM ? ((R & ~31) + perm32(R & 31)) : R;
        voffA[i] = (unsigned)(R * K + C) * 2u; voffB[i] = (unsigned)(Rb * K + C) * 2u; }
    const size_t kstep = (size_t)(BK * 2);
    const size_t hstep = (size_t)HALF * K * 2;
    const size_t tstep = 2 * hstep;
    const unsigned ldsw = (unsigned)wid * 1024u;
    const int aoff = lds_byte(wr * 64 + fr, fq * 8), boff = lds_byte(wc * 32 + fr, fq * 8);
#define PG8_SA(b, h) (((b) * 2 + (h)) * HTB)
#define PG8_SB(b, h) ((4 + (b) * 2 + (h)) * HTB)
#define PG8_STAGE(bufoff, gbase, voff) do { _Pragma("unroll") for (int _i = 0; _i < 2; ++_i) \
        __builtin_amdgcn_global_load_lds((const unsigned*)((const char*)(gbase) + (voff)[_i]), (PG8_LAS unsigned*)(lds + (bufoff) + ldsw + _i * 8192), 16, 0, 0); } while (0)
#define PG8_LDA(dst, b, h) do { _Pragma("unroll") for (int m = 0; m < 4; ++m) _Pragma("unroll") for (int k = 0; k < 2; ++k) dst[m][k] = *(const PG8_LAS bf16x8*)(lds + PG8_SA(b, h) + aoff + m * 2048 + k * 1024); } while (0)
#define PG8_LDB(dst, b, h) do { _Pragma("unroll") for (int n = 0; n < 2; ++n) _Pragma("unroll") for (int k = 0; k < 2; ++k) dst[n][k] = *(const PG8_LAS bf16x8*)(lds + PG8_SB(b, h) + boff + n * 2048 + k * 1024); } while (0)
#define PG8_MMA(ai, bj, At, Bt) do { __builtin_amdgcn_s_setprio(1); _Pragma("unroll") for (int m = 0; m < 4; ++m) _Pragma("unroll") for (int n = 0; n < 2; ++n) _Pragma("unroll") for (int k = 0; k < 2; ++k) \
        acc[ai][bj][m][n] = __builtin_amdgcn_mfma_f32_16x16x32_bf16(Bt[n][k], At[m][k], acc[ai][bj][m][n], 0, 0, 0); __builtin_amdgcn_s_setprio(0); } while (0)
#define PG8_WAIT_V(n) asm volatile("s_waitcnt vmcnt(" #n ")" ::: "memory")
#define PG8_WAIT_L(n) asm volatile("s_waitcnt lgkmcnt(" #n ")" ::: "memory")
#define PG8_BAR __builtin_amdgcn_s_barrier()
#define PG8_SCHED __builtin_amdgcn_sched_barrier(0)
    Unit cur, nxt; int ui = 0;
    if (!S.next(0, cur)) return;
    f32x4 acc[2][2][4][2];
#pragma unroll
    for (int a = 0; a < 2; ++a)
#pragma unroll
        for (int b = 0; b < 2; ++b)
#pragma unroll
            for (int m = 0; m < 4; ++m)
#pragma unroll
                for (int n = 0; n < 2; ++n) acc[a][b][m][n] = (f32x4){0.f, 0.f, 0.f, 0.f};
    bf16x8 At[4][2], B0[2][2], B1[2][2];
    const char* cA = (const char*)g.A + (size_t)cur.pm * tstep; const char* cB = (const char*)g.Bt + (size_t)cur.pn * tstep;
    S.a_ready(cur);
    PG8_STAGE(PG8_SB(0, 0), cB, voffB); PG8_STAGE(PG8_SA(0, 0), cA, voffA); PG8_STAGE(PG8_SB(0, 1), cB + hstep, voffB); PG8_STAGE(PG8_SA(0, 1), cA + hstep, voffA);
    if (wr == 1) PG8_BAR;
    PG8_WAIT_V(4); PG8_BAR;
    PG8_STAGE(PG8_SB(1, 0), cB + kstep, voffB); PG8_STAGE(PG8_SA(1, 0), cA + kstep, voffA); PG8_STAGE(PG8_SB(1, 1), cB + hstep + kstep, voffB);
    PG8_WAIT_V(6); PG8_BAR;
    PG8_STAMP();
    for (;;) {
        const bool has_next = S.next(ui + 1, nxt);
        const char* nA = has_next ? (const char*)g.A + (size_t)nxt.pm * tstep : cA; const char* nB = has_next ? (const char*)g.Bt + (size_t)nxt.pn * tstep : cB;
        for (int t = 0; t < nt; t += 2) {
            const bool last = (t == nt - 2);
            const char* a1 = cA + (size_t)(t + 1) * kstep;
            const char* a2 = last ? nA : cA + (size_t)(t + 2) * kstep; const char* b2 = last ? nB : cB + (size_t)(t + 2) * kstep;
            const char* a3 = a2 + kstep; const char* b3 = b2 + kstep;
            if (last && has_next) S.a_ready(nxt);
            PG8_LDB(B0, 0, 0); PG8_SCHED; PG8_LDA(At, 0, 0); PG8_STAGE(PG8_SA(1, 1), a1 + hstep, voffA);
            PG8_WAIT_L(8); PG8_BAR; PG8_WAIT_L(0); PG8_MMA(0, 0, At, B0); PG8_BAR; PG8_SCHED;
            PG8_LDB(B1, 0, 1); PG8_STAGE(PG8_SB(0, 0), b2, voffB);
            PG8_BAR; PG8_WAIT_L(0); PG8_MMA(0, 1, At, B1); PG8_BAR;
            PG8_LDA(At, 0, 1); PG8_STAGE(PG8_SA(0, 0), a2, voffA);
            PG8_BAR; PG8_WAIT_L(0); PG8_MMA(1, 0, At, B0); PG8_BAR; PG8_SCHED;
            PG8_STAGE(PG8_SB(0, 1), b2 + hstep, voffB);
            PG8_WAIT_V(6); PG8_BAR; PG8_MMA(1, 1, At, B1); PG8_BAR;
            PG8_LDB(B0, 1, 0); PG8_SCHED; PG8_LDA(At, 1, 0); PG8_STAGE(PG8_SA(0, 1), a2 + hstep, voffA);
            PG8_WAIT_L(8); PG8_BAR; PG8_WAIT_L(0); PG8_MMA(0, 0, At, B0); PG8_BAR; PG8_SCHED;
            PG8_LDB(B1, 1, 1); PG8_STAGE(PG8_SB(1, 0), b3, voffB);
            PG8_BAR; PG8_WAIT_L(0); PG8_MMA(0, 1, At, B1); PG8_BAR;
            PG8_LDA(At, 1, 1); PG8_STAGE(PG8_SA(1, 0), a3, voffA);
            PG8_BAR; PG8_WAIT_L(0); PG8_MMA(1, 0, At, B0); PG8_BAR; PG8_SCHED;
            PG8_STAGE(PG8_SB(1, 1), b3 + hstep, voffB);
            PG8_WAIT_V(6); PG8_BAR; PG8_MMA(1, 1, At, B1); PG8_BAR;
        }
        PG8_STAMP();
        if constexpr (!Epi::AFTER_DRAIN) { E(acc, cur, wr, wc, fr, fq); S.done(cur); }
        PG8_STAMP();
        if (!has_next) break;
#pragma unroll
        for (int a = 0; a < 2; ++a)
#pragma unroll
            for (int b = 0; b < 2; ++b)
#pragma unroll
                for (int m = 0; m < 4; ++m)
#pragma unroll
                    for (int n = 0; n < 2; ++n) acc[a][b][m][n] = (f32x4){0.f, 0.f, 0.f, 0.f};
        cur = nxt; cA = nA; cB = nB; ++ui;
    }
    PG8_WAIT_V(0);
    if (wr == 0) PG8_BAR;
    PG8_BAR;
    if constexpr (Epi::AFTER_DRAIN) { E.fused(acc, cur, wr, wc, fr, fq, lds, wid, lane); S.done(cur); }
    PG8_STAMP();
    if (STAMP && wid == 0) { stamps[lane] = lane < nts ? (((unsigned long long)(unsigned)ts_hi << 32) | (unsigned)ts_lo) : 0ull;
        if (lane == 62) stamps[62] = rt_entry; if (lane == 63) stamps[63] = (unsigned long long)wall_clock64(); }
#undef PG8_STAMP
#undef PG8_SA
#undef PG8_SB
#undef PG8_STAGE
#undef PG8_LDA
#undef PG8_LDB
#undef PG8_MMA
#undef PG8_WAIT_V
#undef PG8_WAIT_L
#undef PG8_BAR
#undef PG8_SCHED
}
}
#endif

#ifndef HOST_TEST
#include <cstdio>
#define FRAG_OFF(row_, k_, KS_) ((((((row_) >> 4) * (KS_) + ((k_) >> 5)) * 64 + (((k_) >> 3) & 3) * 16 + ((row_) & 15)) * 8) + ((k_) & 7))
namespace pg8 {
struct EpiAddF32 {
    static constexpr bool PERM = false, AFTER_DRAIN = false;
    float* C; int ldc;
    __device__ __forceinline__ void operator()(const f32x4 (&acc)[2][2][4][2], const Unit& u, int wr, int wc, int fr, int fq) const {
        const int row0 = u.pm * BM + wr * 64 + fr, col0 = u.pn * BM + wc * 32 + 4 * fq;
#pragma unroll
        for (int ai = 0; ai < 2; ++ai)
#pragma unroll
            for (int m = 0; m < 4; ++m) { float* rowp = C + (size_t)(row0 + ai * HALF + m * 16) * ldc + col0;
#pragma unroll
                for (int bj = 0; bj < 2; ++bj)
#pragma unroll
                    for (int n = 0; n < 2; ++n) { f32x4* p = (f32x4*)(rowp + bj * HALF + n * 16); *p = *p + acc[ai][bj][m][n]; } }
    }
};
struct EpiRelu2Bf16 {
    static constexpr bool PERM = true, AFTER_DRAIN = false;
    bf16_t* O; int ldc;
    __device__ __forceinline__ void operator()(const f32x4 (&acc)[2][2][4][2], const Unit& u, int wr, int wc, int fr, int fq) const {
        const int row0 = u.pm * BM + wr * 64 + fr, col0 = u.pn * BM + wc * 32 + 8 * fq;
#pragma unroll
        for (int ai = 0; ai < 2; ++ai)
#pragma unroll
            for (int m = 0; m < 4; ++m) { bf16_t* rowp = O + (size_t)(row0 + ai * HALF + m * 16) * ldc + col0;
#pragma unroll
                for (int bj = 0; bj < 2; ++bj) { f32x4 v0 = acc[ai][bj][m][0], v1 = acc[ai][bj][m][1];
#pragma unroll
                    for (int j = 0; j < 4; ++j) { const float r0 = fmaxf(v0[j], 0.f), r1 = fmaxf(v1[j], 0.f); v0[j] = r0 * r0; v1[j] = r1 * r1; }
                    u32x4 w; w.x = cvt_pk_bf16(v0[0], v0[1]); w.y = cvt_pk_bf16(v0[2], v0[3]); w.z = cvt_pk_bf16(v1[0], v1[1]); w.w = cvt_pk_bf16(v1[2], v1[3]);
                    *(u32x4*)(rowp + bj * HALF) = w; } }
    }
};

__device__ __forceinline__ float epi_shfl_xor(float v, int o, int lane) { return __builtin_bit_cast(float, __builtin_amdgcn_ds_bpermute((lane ^ o) << 2, __builtin_bit_cast(int, v))); }
__device__ __forceinline__ float row_rs(const unsigned long long* ss, int row) { return FRSQ((float)ss[row] * (5.9604644775390625e-08f / D) + EPS); }
struct EpiF32S {
    static constexpr bool PERM = false, AFTER_DRAIN = false;
    float* C; int ldc; const unsigned long long* ss;
    __device__ __forceinline__ void operator()(const f32x4 (&acc)[2][2][4][2], const Unit& u, int wr, int wc, int fr_in, int fq_in) const {
        int fr = fr_in, fq = fq_in; asm volatile("" : "+v"(fr), "+v"(fq));
        const int row0 = u.pm * BM + wr * 64 + fr, col0 = u.pn * BM + wc * 32 + 4 * fq;
#pragma unroll
        for (int ai = 0; ai < 2; ++ai)
#pragma unroll
            for (int m = 0; m < 4; ++m) { const int row = row0 + ai * HALF + m * 16; const float rs = row_rs(ss, row); float* rowp = C + (size_t)row * ldc + col0;
#pragma unroll
                for (int bj = 0; bj < 2; ++bj)
#pragma unroll
                    for (int n = 0; n < 2; ++n) *(f32x4*)(rowp + bj * HALF + n * 16) = acc[ai][bj][m][n] * rs; }
    }
};
struct EpiRelu2S {
    static constexpr bool PERM = true, AFTER_DRAIN = false;
    bf16_t* O; int ldc; const unsigned long long* ss;
    __device__ __forceinline__ void operator()(const f32x4 (&acc)[2][2][4][2], const Unit& u, int wr, int wc, int fr_in, int fq_in) const {
        int fr = fr_in, fq = fq_in; asm volatile("" : "+v"(fr), "+v"(fq));
        const int row0 = u.pm * BM + wr * 64 + fr, col0 = u.pn * BM + wc * 32 + 8 * fq;
#pragma unroll
        for (int ai = 0; ai < 2; ++ai)
#pragma unroll
            for (int m = 0; m < 4; ++m) { const int row = row0 + ai * HALF + m * 16; const float rs = row_rs(ss, row); bf16_t* rowp = O + (size_t)row * ldc + col0;
#pragma unroll
                for (int bj = 0; bj < 2; ++bj) { f32x4 v0 = acc[ai][bj][m][0] * rs, v1 = acc[ai][bj][m][1] * rs;
#pragma unroll
                    for (int j = 0; j < 4; ++j) { const float r0 = fmaxf(v0[j], 0.f), r1 = fmaxf(v1[j], 0.f); v0[j] = r0 * r0; v1[j] = r1 * r1; }
                    u32x4 w; w.x = cvt_pk_bf16(v0[0], v0[1]); w.y = cvt_pk_bf16(v0[2], v0[3]); w.z = cvt_pk_bf16(v1[0], v1[1]); w.w = cvt_pk_bf16(v1[2], v1[3]);
                    *(u32x4*)(rowp + bj * HALF) = w; } }
    }
};
struct EpiAddN {
    static constexpr bool PERM = false, AFTER_DRAIN = false;
    float* C; int ldc; bf16_t* XB; unsigned long long* ss;
    __device__ __forceinline__ void operator()(const f32x4 (&acc)[2][2][4][2], const Unit& u, int wr, int wc, int fr_in, int fq_in) const {
        int fr = fr_in, fq = fq_in; asm volatile("" : "+v"(fr), "+v"(fq));
        const int row0 = u.pm * BM + wr * 64 + fr, col0 = u.pn * BM + wc * 32 + 4 * fq, lane = fq * 16 + fr;
#pragma unroll
        for (int ai = 0; ai < 2; ++ai)
#pragma unroll
            for (int m = 0; m < 4; ++m) { const int row = row0 + ai * HALF + m * 16; float* rowp = C + (size_t)row * ldc + col0; bf16_t* xbp = XB + (size_t)row * ldc + col0; float q = 0.f;
#pragma unroll
                for (int bj = 0; bj < 2; ++bj)
#pragma unroll
                    for (int n = 0; n < 2; ++n) { f32x4* p = (f32x4*)(rowp + bj * HALF + n * 16); const f32x4 v = *p + acc[ai][bj][m][n]; *p = v; q += (v[0] * v[0] + v[1] * v[1]) + (v[2] * v[2] + v[3] * v[3]);
                        unsigned w0 = cvt_pk_bf16(v[0], v[1]), w1 = cvt_pk_bf16(v[2], v[3]); *(uint2*)(xbp + bj * HALF + n * 16) = make_uint2(w0, w1); }
                q += epi_shfl_xor(q, 16, lane); q += epi_shfl_xor(q, 32, lane);
                if (fq == 0) __hip_atomic_fetch_add(ss + row, (unsigned long long)(q * 16777216.0f), __ATOMIC_RELAXED, __HIP_MEMORY_SCOPE_AGENT); }
    }
};
struct EpiAttS {
    static constexpr bool PERM = false, AFTER_DRAIN = false;
    unsigned char* ws; float* out; const unsigned long long* ss; int ai_;
    __device__ __forceinline__ void operator()(const f32x4 (&acc)[2][2][4][2], const Unit& u, int wr, int wc, int fr_in, int fq_in) const {
        int fr = fr_in, fq = fq_in; asm volatile("" : "+v"(fr), "+v"(fq));
        float* P = (float*)(ws + WS_P); constexpr int ldc = LDP; bf16_t* QB = (bf16_t*)(ws + WS_QB); bf16_t* KB = (bf16_t*)(ws + WS_KB); bf16_t* VB = (bf16_t*)(ws + WS_VB); bf16_t* QIB = (bf16_t*)(ws + WS_QIB); bf16_t* KIB = (bf16_t*)(ws + WS_KIB);
        const int row0 = u.pm * BM + wr * 64 + fr; float rsv[2][4];
#pragma unroll
        for (int ai = 0; ai < 2; ++ai)
#pragma unroll
            for (int m = 0; m < 4; ++m) rsv[ai][m] = row_rs(ss, row0 + ai * HALF + m * 16);
#pragma unroll
        for (int bj = 0; bj < 2; ++bj)
#pragma unroll
            for (int n = 0; n < 2; ++n) { const int cb = u.pn * BM + bj * HALF + wc * 32 + n * 16;
                bf16_t* bdst; int bld, bc; float* odst0 = nullptr; float* odst1 = nullptr; int old_ = 0;
                if (cb < AO_K) { bdst = QB; bld = D; bc = cb; }
                else if (cb < AO_V) { bdst = KB; bld = 256; bc = cb - AO_K; odst0 = out + O_KP + (size_t)ai_ * MP * 256 + bc; odst1 = out + O_KS + (size_t)ai_ * MS * 256 + bc; old_ = 256; }
                else if (cb < AO_QI) { bdst = VB; bld = 256; bc = cb - AO_V; odst0 = out + O_VP + (size_t)ai_ * MP * 256 + bc; odst1 = out + O_VS + (size_t)ai_ * MS * 256 + bc; old_ = 256; }
                else if (cb < AO_KI) { bdst = QIB; bld = 512; bc = cb - AO_QI; }
                else if (cb < AO_WI) { bdst = KIB; bld = -1; bc = cb - AO_KI;     odst0 = out + O_KIP + (size_t)ai_ * MP * 64 + bc; odst1 = out + O_KIS + (size_t)ai_ * MS * 64 + bc; old_ = 64; }
                else { bdst = nullptr; bld = 0; bc = 0; }
#pragma unroll
                for (int ai = 0; ai < 2; ++ai)
#pragma unroll
                    for (int m = 0; m < 4; ++m) { const int row = row0 + ai * HALF + m * 16; const f32x4 v = acc[ai][bj][m][n] * rsv[ai][m]; *(f32x4*)(P + (size_t)row * ldc + cb + 4 * fq) = v;
                        if (bdst != nullptr && row < MT) { bf16_t* bp_ = bld >= 0 ? bdst + (size_t)row * bld + bc + 4 * fq : bdst + (size_t)(row >> 4) * 1024 + FRAG_OFF(row & 15, bc + 4 * fq, 2); *(uint2*)bp_ = make_uint2(cvt_pk_bf16(v[0], v[1]), cvt_pk_bf16(v[2], v[3]));
                            if (odst0 != nullptr) { float* op = row < MP ? odst0 + (size_t)row * old_ : odst1 + (size_t)(row - MP) * old_; *(f32x4*)(op + 4 * fq) = v; } } } }
    }
};
}

constexpr int NTHREADS = 512, LDS_BYTES = 147456, LDS_MISC = 131072;
typedef float f32x4_t __attribute__((ext_vector_type(4)));
__device__ __forceinline__ float shfl_xor_l(float v, int o, int lane) { return __builtin_bit_cast(float, __builtin_amdgcn_ds_bpermute((lane ^ o) << 2, __builtin_bit_cast(int, v))); }
__device__ __forceinline__ void ph_rmsnorm(const Args& a, const float* g) {
    static_assert(D == 1024, "device rmsnorm is written for D = 1024");
    const float* X = (const float*)(a.ws + WS_X); bf16* XN = (bf16*)(a.ws + WS_XN);
    int tx_ = TID(); asm volatile("" : "+v"(tx_));
    const int lane = tx_ & 63, wv = blockIdx.x * (NTHREADS >> 6) + (tx_ >> 6), nwv = gridDim.x * (NTHREADS >> 6);
    f32x4_t gv[4];
#pragma unroll
    for (int i = 0; i < 4; ++i) gv[i] = *(const f32x4_t*)(g + (i * 64 + lane) * 4);
    for (int m = wv; m < MPAD; m += nwv) { f32x4_t xv[4]; float ss = 0.f;
#pragma unroll
        for (int i = 0; i < 4; ++i) { xv[i] = *(const f32x4_t*)(X + (size_t)m * D + (i * 64 + lane) * 4); ss += xv[i][0] * xv[i][0] + xv[i][1] * xv[i][1] + xv[i][2] * xv[i][2] + xv[i][3] * xv[i][3]; }
#pragma unroll
        for (int o = 32; o >= 1; o >>= 1) ss += shfl_xor_l(ss, o, lane);
        const float r = FRSQ(ss * (1.0f / D) + EPS);
#pragma unroll
        for (int i = 0; i < 4; ++i) { const f32x4_t y = xv[i] * r * gv[i]; uint2 w; w.x = pg8::cvt_pk_bf16(y[0], y[1]); w.y = pg8::cvt_pk_bf16(y[2], y[3]); *(uint2*)(XN + (size_t)m * D + (i * 64 + lane) * 4) = w; } }
}

__device__ __forceinline__ void ph_prep_x(const Args& a) {
    float* X = (float*)(a.ws + WS_X); bf16* XB = (bf16*)(a.ws + WS_XN); unsigned long long* SS = (unsigned long long*)(a.ws + WS_SS);
    int tx_ = TID(); asm volatile("" : "+v"(tx_));
    const int lane = tx_ & 63, wv = blockIdx.x * (NTHREADS >> 6) + (tx_ >> 6), nwv = gridDim.x * (NTHREADS >> 6);
    for (int m = wv; m < MPAD; m += nwv) { const float* src = m < MP ? a.in[I_XP] + (size_t)m * D : a.in[I_XS] + (size_t)(m - MP) * D; float ss = 0.f;
#pragma unroll
        for (int i = 0; i < 4; ++i) { f32x4_t v = {0.f, 0.f, 0.f, 0.f}; if (m < MT) v = *(const f32x4_t*)(src + (i * 64 + lane) * 4);
            *(f32x4_t*)(X + (size_t)m * D + (i * 64 + lane) * 4) = v; ss += v[0] * v[0] + v[1] * v[1] + v[2] * v[2] + v[3] * v[3];
            uint2 w; w.x = pg8::cvt_pk_bf16(v[0], v[1]); w.y = pg8::cvt_pk_bf16(v[2], v[3]); *(uint2*)(XB + (size_t)m * D + (i * 64 + lane) * 4) = w; }
#pragma unroll
        for (int o = 32; o >= 1; o >>= 1) ss += shfl_xor_l(ss, o, lane);
        if (lane == 0) SS[m] = (unsigned long long)(ss * 16777216.0f); }
}
__device__ __forceinline__ void ph_final(const Args& a) {
    const float* X = (const float*)(a.ws + WS_X); const float* g = a.in[I_NFIN];
    int tx_ = TID(); asm volatile("" : "+v"(tx_));
    const int lane = tx_ & 63, wv = blockIdx.x * (NTHREADS >> 6) + (tx_ >> 6), nwv = gridDim.x * (NTHREADS >> 6);
    f32x4_t gv[4];
#pragma unroll
    for (int i = 0; i < 4; ++i) gv[i] = *(const f32x4_t*)(g + (i * 64 + lane) * 4);
    for (int m = wv; m < MT; m += nwv) { f32x4_t xv[4]; float ss = 0.f;
#pragma unroll
        for (int i = 0; i < 4; ++i) { xv[i] = *(const f32x4_t*)(X + (size_t)m * D + (i * 64 + lane) * 4); ss += xv[i][0] * xv[i][0] + xv[i][1] * xv[i][1] + xv[i][2] * xv[i][2] + xv[i][3] * xv[i][3]; }
#pragma unroll
        for (int o = 32; o >= 1; o >>= 1) ss += shfl_xor_l(ss, o, lane);
        const float r = FRSQ(ss * (1.0f / D) + EPS);
        float* orow = a.out + (m < MP ? O_YP + (size_t)m * D : O_YS + (size_t)(m - MP) * D);
#pragma unroll
        for (int i = 0; i < 4; ++i) *(f32x4_t*)(orow + (i * 64 + lane) * 4) = xv[i] * r * gv[i]; }
}


#ifndef DIAG_WRITE_O
#define DIAG_WRITE_O 1
#define DIAG_WRITE_S 1
#endif
typedef short bf16x8_t __attribute__((ext_vector_type(8)));
typedef unsigned u32x2_t __attribute__((ext_vector_type(2)));
typedef unsigned u32x4_t __attribute__((ext_vector_type(4)));
typedef float f32x2_t __attribute__((ext_vector_type(2)));
typedef __bf16 bf16x2n_t __attribute__((ext_vector_type(2)));
__device__ __forceinline__ unsigned pk_bf16(float lo, float hi) { const f32x2_t v = {lo, hi}; const bf16x2n_t r = __builtin_convertvector(v, bf16x2n_t); return __builtin_bit_cast(unsigned, r); }
__device__ __forceinline__ void ph_dn_b(const Args& a, int r, LAS unsigned char* lds) {
    const float* UT = (const float*)(a.ws + WS_UT); const bf16* WN = (const bf16*)(a.ws + WS_WN); const bf16* QG = (const bf16*)(a.ws + WS_QG); const bf16* AT = (const bf16*)(a.ws + WS_AT);
    const bf16* KDT = (const bf16*)(a.ws + WS_KDT); const float* GL = (const float*)(a.ws + WS_GL); float* ODN = (float*)(a.ws + WS_ODN); float* DUMP = (float*)(a.ws + WS_SCR);
    int tid_ = TID(); asm volatile("" : "+v"(tid_));
    const int tid = tid_, wid = __builtin_amdgcn_readfirstlane(tid >> 6), lane = tid & 63, fr = lane & 15, fq = lane >> 4;
    constexpr int STS = 136, VTS = 72;
    LAS bf16* ST = (LAS bf16*)lds; LAS bf16* VT = (LAS bf16*)(lds + 16 * STS * 2);
    const bool vw = wid < 4; const float uf = vw ? 1.0f : 0.0f;
    for (int unit = blockIdx.x; unit < NB * DNH * 8; unit += gridDim.x) {
        const int slice = unit & 7, bh = unit >> 3, b = bh / DNH, hd = bh % DNH, c0 = slice * 16;
        f32x4_t accS = {0.f, 0.f, 0.f, 0.f};
        for (int i = tid; i < 16 * STS; i += NTHREADS) ST[i] = (bf16)0;
        __syncthreads();
        const int i0 = (wid & 3) * 16;
        const bf16* p1 = (vw ? WN : QG) + (size_t)bh * NC * 8192 + (size_t)((wid & 3) * 4) * 512 + lane * 8;
        const bf16* p2 = AT + (size_t)bh * NC * 4096 + (size_t)((wid & 3) * 2) * 512 + lane * 8;
        const bf16* p3 = KDT + (size_t)bh * NC * 8192 + (size_t)(wid * 2) * 512 + lane * 8;
        const float* pu = UT + (size_t)bh * NC * 8192 + (size_t)(slice * 4 + (wid & 3)) * 256 + lane * 4; const float* pg = GL + (size_t)bh * NC;
        LAS bf16* vtw = VT + (vw ? 0 : 16 * VTS) + fr * VTS + i0 + 4 * fq;
        float* op = (vw ? DUMP + ((size_t)blockIdx.x * NTHREADS + tid) * 4 - (size_t)0 : ODN + ((size_t)b * SEQ + i0 + 4 * fq) * 512 + hd * 128 + c0 + fr);
        const size_t ostep = vw ? 0 : (size_t)64 * 512, oq = vw ? 1 : 512;
        bf16x8_t s0a1[4], s0a2[2], s0a3[2], s1a1[4], s1a2[2], s1a3[2], s2a1[4], s2a2[2], s2a3[2]; f32x4_t s0u, s1u, s2u; float s0g, s1g, s2g;
#define DNB_LOAD(P_, n_) do { const size_t c_ = (size_t)((n_) < NC ? (n_) : NC - 1); \
            _Pragma("unroll") for (int ks = 0; ks < 4; ++ks) P_##a1[ks] = *(const bf16x8_t*)(p1 + c_ * 8192 + ks * 512); \
            _Pragma("unroll") for (int ks = 0; ks < 2; ++ks) { P_##a2[ks] = *(const bf16x8_t*)(p2 + c_ * 4096 + ks * 512); P_##a3[ks] = *(const bf16x8_t*)(p3 + c_ * 8192 + ks * 512); } \
            P_##u = *(const f32x4_t*)(pu + c_ * 8192); P_##g = pg[c_]; } while (0)
#define DNB_BAR() do { asm volatile("s_waitcnt lgkmcnt(0)" ::: "memory"); __builtin_amdgcn_s_barrier(); asm volatile("" ::: "memory"); } while (0)
#define DNB_STEP(C_, L_, n_) do { f32x4_t acc = C_##u * uf; const float gl = C_##g; bf16x8_t x1[4], x2[2], x3[2]; \
            _Pragma("unroll") for (int ks = 0; ks < 4; ++ks) x1[ks] = C_##a1[ks]; \
            _Pragma("unroll") for (int ks = 0; ks < 2; ++ks) { x2[ks] = C_##a2[ks]; x3[ks] = C_##a3[ks]; } \
            DNB_LOAD(L_, (n_) + 2); \
            bf16x8_t bS[4]; \
            _Pragma("unroll") for (int ks = 0; ks < 4; ++ks) bS[ks] = *(const LAS bf16x8_t*)(ST + fr * STS + ks * 32 + fq * 8); \
            _Pragma("unroll") for (int ks = 0; ks < 4; ++ks) acc = __builtin_amdgcn_mfma_f32_16x16x32_bf16(x1[ks], bS[ks], acc, 0, 0, 0); \
            { u32x2_t w; w.x = pk_bf16(acc[0], acc[1]); w.y = pk_bf16(acc[2], acc[3]); *(LAS u32x2_t*)vtw = w; } \
            DNB_BAR(); \
            bf16x8_t bV[2]; \
            _Pragma("unroll") for (int ks = 0; ks < 2; ++ks) bV[ks] = *(const LAS bf16x8_t*)(VT + fr * VTS + ks * 32 + fq * 8); \
            _Pragma("unroll") for (int ks = 0; ks < 2; ++ks) acc = __builtin_amdgcn_mfma_f32_16x16x32_bf16(x2[ks], bV[ks], acc, 0, 0, 0); \
            { float* o_ = op + (size_t)(n_) * ostep; _Pragma("unroll") for (int q = 0; q < 4; ++q) o_[(size_t)q * oq] = acc[q]; } \
            accS = accS * gl; \
            _Pragma("unroll") for (int ks = 0; ks < 2; ++ks) accS = __builtin_amdgcn_mfma_f32_16x16x32_bf16(x3[ks], bV[ks], accS, 0, 0, 0); \
            { u32x2_t w; w.x = pk_bf16(accS[0], accS[1]); w.y = pk_bf16(accS[2], accS[3]); *(LAS u32x2_t*)(ST + fr * STS + wid * 16 + 4 * fq) = w; } \
            DNB_BAR(); } while (0)
        static_assert(NC % 3 == 2, "the chunk loop is peeled for NC = 3 k + 2");
        DNB_LOAD(s0, 0); DNB_LOAD(s1, 1);
        int n = 0;
        for (; n + 2 < NC; n += 3) { DNB_STEP(s0, s2, n); DNB_STEP(s1, s0, n + 1); DNB_STEP(s2, s1, n + 2); }
        DNB_STEP(s0, s2, n); DNB_STEP(s1, s0, n + 1);
#undef DNB_STEP
#undef DNB_LOAD
        float* sp = a.out + O_SP + ((((size_t)r * NB + b) * DNH + hd) * 128 + wid * 16 + 4 * fq) * 128 + c0 + fr;
#pragma unroll
        for (int q = 0; q < 4; ++q) sp[(size_t)q * 128] = accS[q];
        __syncthreads();
    }
}


template <int NREG> __device__ __forceinline__ void select_row(const float* __restrict__ row, int n, int K, int* __restrict__ out, unsigned lane, LAS unsigned* cand_lds) {
    static_assert(NREG * 64 <= SLD, "row buffer too short");
    lane &= 63u;
    unsigned key[NREG];
#pragma unroll
    for (int i = 0; i < NREG; ++i) { const float f = __builtin_nontemporal_load(row + i * 64u + lane); key[i] = fkey(f) & (0u - ((unsigned)((int)(i * 64u + lane) - n) >> 31)); }
    if (NREG >= 32 && n >= 1024) { unsigned ls = 0u;
        for (int bit = 31; bit >= 0; --bit) { const unsigned cand = ls | (1u << bit); int c = 0;
#pragma unroll
            for (int i = 0; i < NREG; i += 8) c += __builtin_popcountll(__ballot(key[i] >= cand));
            if (c >= 48) ls = cand;
            if (c == 48) break; }
        int c0 = 0;
#pragma unroll
        for (int i = 0; i < NREG; ++i) c0 += __builtin_popcountll(__ballot(key[i] >= ls));
        if (c0 >= K && c0 <= 512) {
            asm volatile("" : "+v"(lane)); lane &= 63u; const unsigned long long bl = (1ull << lane) - 1ull; int base = 0;
            unsigned ls2 = ls; asm volatile("" : "+v"(ls2));
#pragma unroll
            for (int i = 0; i < NREG; ++i) { const bool g = key[i] >= ls2; const unsigned long long mg = __ballot(g);
                const int p = base + __builtin_popcountll(mg & bl); cand_lds[g ? (unsigned)p : 1024u + lane] = key[i]; cand_lds[g ? 512u + p : 1088u + lane] = i * 64u + lane;
                base += __builtin_popcountll(mg); }
            asm volatile("s_waitcnt lgkmcnt(0)" ::: "memory");
            unsigned ck[8], ci[8];
#pragma unroll
            for (int q = 0; q < 8; ++q) { const int p = q * 64 + (int)lane; const bool v = p < c0; ck[q] = v ? cand_lds[p] : 0u; ci[q] = v ? cand_lds[512 + p] : 0u; }
            unsigned lo2 = 0u;
            for (int bit = 31; bit >= 0; --bit) { const unsigned cand = lo2 | (1u << bit); int c = 0;
#pragma unroll
                for (int q = 0; q < 8; ++q) c += __builtin_popcountll(__ballot(ck[q] >= cand));
                if (c >= K) lo2 = cand;
                if (c == K) break; }
            int bg2 = 0;
#pragma unroll
            for (int q = 0; q < 8; ++q) { const bool g = ck[q] > lo2; const unsigned long long mg = __ballot(g);
                out[g ? (unsigned)(bg2 + __builtin_popcountll(mg & bl)) : KMAX + lane] = (int)ci[q]; bg2 += __builtin_popcountll(mg); }
            int be2 = 0;
#pragma unroll
            for (int q = 0; q < 8; ++q) { const bool e = ck[q] == lo2; const unsigned long long me = __ballot(e); const int slot = bg2 + be2 + __builtin_popcountll(me & bl);
                out[(e && slot < K) ? (unsigned)slot : KMAX + lane] = (int)ci[q]; be2 += __builtin_popcountll(me); }
            asm volatile("s_waitcnt lgkmcnt(0)" ::: "memory");
            return; } }
    unsigned lo = 0u;
    for (int bit = 31; bit >= 0; --bit) { const unsigned cand = lo | (1u << bit); int c = 0;
#pragma unroll
        for (int i = 0; i < NREG; ++i) c += __builtin_popcountll(__ballot(key[i] >= cand));
        if (c >= K) lo = cand;
        if (c == K) break; }
    asm volatile("" : "+v"(lane)); lane &= 63u;
    const unsigned long long below = (1ull << lane) - 1ull; int bg = 0;
#pragma unroll
    for (int i = 0; i < NREG; ++i) { const bool g = key[i] > lo; const unsigned long long mg = __ballot(g);
        out[g ? (unsigned)(bg + __builtin_popcountll(mg & below)) : KMAX + lane] = (int)(i * 64u + lane); bg += __builtin_popcountll(mg); }
    const int cg = bg; int be = 0; asm volatile("" : "+v"(lane)); lane &= 63u; const unsigned long long below2 = (1ull << lane) - 1ull;
#pragma unroll
    for (int i = 0; i < NREG; ++i) { const bool e = key[i] == lo; const unsigned long long me = __ballot(e); const int slot = cg + be + __builtin_popcountll(me & below2);
        out[(e && slot < K) ? (unsigned)slot : KMAX + lane] = (int)(i * 64u + lane); be += __builtin_popcountll(me); }
}
__device__ __forceinline__ void ph_select_w(const Args& a, LAS unsigned char* lds) {
    const float* SC = (const float*)(a.ws + WS_SCT); int* IDX = (int*)(a.ws + WS_IDX); int* NSEL = (int*)(a.ws + WS_NSEL);
    int tx_ = TID(); asm volatile("" : "+v"(tx_));
    const int lane0 = tx_ & 63, wv = __builtin_amdgcn_readfirstlane(blockIdx.x * (NTHREADS >> 6) + (tx_ >> 6)), nwv = gridDim.x * (NTHREADS >> 6);
    LAS unsigned* cand = (LAS unsigned*)(lds + (tx_ >> 6) * 4608);
    for (int m = MP + wv; m < MT; m += nwv) { const RowInfo ri = row_info(m); int lane = lane0; asm volatile("" : "+v"(lane));
        const int n = PAST + ri.t + 1, K = TOPK_S; const float* row = SC + (size_t)m * SLD; int* out = IDX + (size_t)m * KROW;
        if (n <= K) { for (int j = lane; j < n; j += 64) out[j] = j; if (lane == 0) NSEL[m] = n; continue; }
        select_row<(SLD / 64)>(row, n, K, out, lane, cand);
        if (lane == 0) NSEL[m] = K; }
}


__device__ __forceinline__ void ph_att_split_dev(const Args& a, int ai, size_t gtid, size_t gsz) {
    const float* P = (const float*)(a.ws + WS_P); bf16* QB = (bf16*)(a.ws + WS_XN); bf16* KB = (bf16*)(a.ws + WS_KB); bf16* VB = (bf16*)(a.ws + WS_VB); bf16* QIB = (bf16*)(a.ws + WS_QIB); bf16* KIB = (bf16*)(a.ws + WS_KIB);
    constexpr int W = AO_WI;
    for (size_t i = gtid; i < (size_t)MT * W; i += gsz) { const int m = (int)(i / W), c = (int)(i % W); const float v = P[(size_t)m * LDP + c];
        if (c < AO_K) QB[(size_t)m * D + c] = f2bf(v);
        else if (c < AO_V) { const int cc = c - AO_K; KB[(size_t)m * 256 + cc] = f2bf(v); if (m < MP) a.out[O_KP + ((size_t)ai * MP + m) * 256 + cc] = v; else a.out[O_KS + ((size_t)ai * MS + (m - MP)) * 256 + cc] = v; }
        else if (c < AO_QI) { const int cc = c - AO_V; VB[(size_t)m * 256 + cc] = f2bf(v); if (m < MP) a.out[O_VP + ((size_t)ai * MP + m) * 256 + cc] = v; else a.out[O_VS + ((size_t)ai * MS + (m - MP)) * 256 + cc] = v; }
        else if (c < AO_KI) QIB[(size_t)m * 512 + (c - AO_QI)] = f2bf(v);
        else { const int cc = c - AO_KI; KIB[(size_t)m * 64 + cc] = f2bf(v); if (m < MP) a.out[O_KIP + ((size_t)ai * MP + m) * 64 + cc] = v; else a.out[O_KIS + ((size_t)ai * MS + (m - MP)) * 64 + cc] = v; } }
}
__device__ __forceinline__ void ph_idx_mfma(const Args& a, LAS unsigned char* lds) {
    const float* P = (const float*)(a.ws + WS_P); const bf16* QIB = (const bf16*)(a.ws + WS_QIB); const bf16* KIB = (const bf16*)(a.ws + WS_KIB); float* SC = (float*)(a.ws + WS_SCT); int* IDX = (int*)(a.ws + WS_IDX); int* NSEL = (int*)(a.ws + WS_NSEL);
    int tx_ = TID(); asm volatile("" : "+v"(tx_));
    const int lane = tx_ & 63, fr = lane & 15, fq = lane >> 4, wv = __builtin_amdgcn_readfirstlane(blockIdx.x * (NTHREADS >> 6) + (tx_ >> 6)), nwv = gridDim.x * (NTHREADS >> 6);
    constexpr int NU = MP / 4;
    for (int pr2 = wv * 2; pr2 < NU; pr2 += nwv * 2) for (int u0 = pr2; u0 < pr2 + 2; ++u0) { const int hh = u0 >> 1, u = (u0 & 1) ? (NU - 1 - hh) : hh;
        const int m0 = u * 4, b = m0 / SEQ, t0 = m0 % SEQ;
        int lnu = lane; asm volatile("" : "+v"(lnu)); const int fr = lnu & 15, fq = (lnu >> 4) & 3;
        bf16x8_t aQ[2][2];
#pragma unroll
        for (int p = 0; p < 2; ++p)
#pragma unroll
            for (int ks = 0; ks < 2; ++ks) aQ[p][ks] = *(const bf16x8_t*)(QIB + (size_t)(m0 + (fr >> 2)) * 512 + (4 * p + (fr & 3)) * 64 + ks * 32 + fq * 8);
        const f32x4_t w0 = *(const f32x4_t*)(P + (size_t)(m0 + fq) * LDP + AO_WI), w1 = *(const f32x4_t*)(P + (size_t)(m0 + fq) * LDP + AO_WI + 4);
        float* scrow = SC + (size_t)(m0 + fq) * SLD + fr;
        const int nkt = (t0 + 3) / 16 + 1;
        bf16x8_t bKa[4][2], bKb[4][2];
#define IDX_LOAD(B_, kt0_) do { _Pragma("unroll") for (int q = 0; q < 4; ++q) { const int kt = (kt0_) + q < nkt ? (kt0_) + q : nkt - 1; const bf16* kr = KIB + ((size_t)b * (SEQ / 16) + kt) * 1024 + lnu * 8; \
            B_[q][0] = *(const bf16x8_t*)kr; B_[q][1] = *(const bf16x8_t*)(kr + 512); } } while (0)
#define IDX_COMP(B_, kt0_) do { _Pragma("unroll") for (int q = 0; q < 4; ++q) { if ((kt0_) + q < nkt) { f32x4_t c0 = {0.f, 0.f, 0.f, 0.f}, c1 = {0.f, 0.f, 0.f, 0.f}; \
                    c0 = __builtin_amdgcn_mfma_f32_16x16x32_bf16(aQ[0][0], B_[q][0], c0, 0, 0, 0); c0 = __builtin_amdgcn_mfma_f32_16x16x32_bf16(aQ[0][1], B_[q][1], c0, 0, 0, 0); \
                    c1 = __builtin_amdgcn_mfma_f32_16x16x32_bf16(aQ[1][0], B_[q][0], c1, 0, 0, 0); c1 = __builtin_amdgcn_mfma_f32_16x16x32_bf16(aQ[1][1], B_[q][1], c1, 0, 0, 0); \
                    __builtin_nontemporal_store((w0[0] * fmaxf(c0[0], 0.f) + w0[1] * fmaxf(c0[1], 0.f)) + (w0[2] * fmaxf(c0[2], 0.f) + w0[3] * fmaxf(c0[3], 0.f)) \
                                             + (w1[0] * fmaxf(c1[0], 0.f) + w1[1] * fmaxf(c1[1], 0.f)) + (w1[2] * fmaxf(c1[2], 0.f) + w1[3] * fmaxf(c1[3], 0.f)), scrow + ((kt0_) + q) * 16); } } } while (0)
        IDX_LOAD(bKa, 0);
        for (int kt0 = 0; kt0 < nkt; kt0 += 8) { IDX_LOAD(bKb, kt0 + 4); IDX_COMP(bKa, kt0); IDX_LOAD(bKa, kt0 + 8); IDX_COMP(bKb, kt0 + 4); }
#undef IDX_LOAD
#undef IDX_COMP
        LAS unsigned* cand = (LAS unsigned*)(lds + (tx_ >> 6) * 4608);
        for (int q = 0; q < 4; ++q) { const int m = m0 + q, n = t0 + q + 1, K = TOPK_P; int ln = lane; asm volatile("" : "+v"(ln));
            const float* row = SC + (size_t)m * SLD; int* out = IDX + (size_t)m * KROW;
            if (n <= K) { for (int j = ln; j < n; j += 64) out[j] = j; if (ln == 0) NSEL[m] = n; continue; }
            if (n <= 2048) select_row<32>(row, n, K, out, ln, cand);
            else if (n <= 4096) select_row<64>(row, n, K, out, ln, cand);
            else if (n <= 6144) select_row<96>(row, n, K, out, ln, cand);
            else select_row<128>(row, n, K, out, ln, cand);
            if (ln == 0) NSEL[m] = K; }
    }
}
__device__ __forceinline__ void ph_idx_sample_mfma(const Args& a, int ai) {
    const float* P = (const float*)(a.ws + WS_P); const bf16* QIB = (const bf16*)(a.ws + WS_QIB); float* SC = (float*)(a.ws + WS_SCT); const int* PT = (const int*)a.in[I_PT]; const float* CKI = a.in[I_CKI];
    int tx_ = TID(); asm volatile("" : "+v"(tx_));
    const int lane = tx_ & 63, fr = lane & 15, fq = lane >> 4, wv = __builtin_amdgcn_readfirstlane(blockIdx.x * (NTHREADS >> 6) + (tx_ >> 6)), nwv = gridDim.x * (NTHREADS >> 6);
    constexpr int NKT = (PAST + DT + 15) / 16, SPL = 64, TPU = (NKT + SPL - 1) / SPL;
    static_assert(PAGE % 16 == 0 && PAST % 16 == 0 && DT <= 16, "sample index tiles");
    for (int u = wv; u < DB * SPL; u += nwv) { const int db = u / SPL, k0 = (u % SPL) * TPU, k1 = (k0 + TPU < NKT) ? k0 + TPU : NKT; const int m0 = MP + db * DT;
        if (k0 >= k1) continue;
        bf16x8_t aQ[2][2];
#pragma unroll
        for (int p = 0; p < 2; ++p)
#pragma unroll
            for (int ks = 0; ks < 2; ++ks) aQ[p][ks] = *(const bf16x8_t*)(QIB + (size_t)(m0 + (fr >> 2)) * 512 + (4 * p + (fr & 3)) * 64 + ks * 32 + fq * 8);
        const f32x4_t w0 = *(const f32x4_t*)(P + (size_t)(m0 + fq) * LDP + AO_WI), w1 = *(const f32x4_t*)(P + (size_t)(m0 + fq) * LDP + AO_WI + 4);
        float* scrow = SC + (size_t)(m0 + fq) * SLD + fr;
        for (int kb = k0; kb < k1; kb += 3) { f32x4_t kf[3][4];
#pragma unroll
            for (int q = 0; q < 3; ++q) { const int kt = kb + q < k1 ? kb + q : k1 - 1, s0 = kt * 16; const float* kr;
                if (s0 < PAST) { const int pg = PT[db * NPAGES + s0 / PAGE]; kr = CKI + (((size_t)ai * NPOOL + pg) * PAGE + (s0 % PAGE) + fr) * IDIM + fq * 8; }
                else kr = P + (size_t)(m0 + (fr < DT ? fr : DT - 1)) * LDP + AO_KI + fq * 8;
                kf[q][0] = *(const f32x4_t*)kr; kf[q][1] = *(const f32x4_t*)(kr + 4); kf[q][2] = *(const f32x4_t*)(kr + 32); kf[q][3] = *(const f32x4_t*)(kr + 36); }
#pragma unroll
            for (int q = 0; q < 3; ++q) { if (kb + q < k1) { const int s0 = (kb + q) * 16; u32x4_t b0, b1;
                b0[0] = pk_bf16(kf[q][0][0], kf[q][0][1]); b0[1] = pk_bf16(kf[q][0][2], kf[q][0][3]); b0[2] = pk_bf16(kf[q][1][0], kf[q][1][1]); b0[3] = pk_bf16(kf[q][1][2], kf[q][1][3]);
                b1[0] = pk_bf16(kf[q][2][0], kf[q][2][1]); b1[1] = pk_bf16(kf[q][2][2], kf[q][2][3]); b1[2] = pk_bf16(kf[q][3][0], kf[q][3][1]); b1[3] = pk_bf16(kf[q][3][2], kf[q][3][3]);
                const bf16x8_t bK0 = __builtin_bit_cast(bf16x8_t, b0), bK1 = __builtin_bit_cast(bf16x8_t, b1);
                f32x4_t c0 = {0.f, 0.f, 0.f, 0.f}, c1 = {0.f, 0.f, 0.f, 0.f};
                c0 = __builtin_amdgcn_mfma_f32_16x16x32_bf16(aQ[0][0], bK0, c0, 0, 0, 0); c0 = __builtin_amdgcn_mfma_f32_16x16x32_bf16(aQ[0][1], bK1, c0, 0, 0, 0);
                c1 = __builtin_amdgcn_mfma_f32_16x16x32_bf16(aQ[1][0], bK0, c1, 0, 0, 0); c1 = __builtin_amdgcn_mfma_f32_16x16x32_bf16(aQ[1][1], bK1, c1, 0, 0, 0);
                scrow[s0] = (w0[0] * fmaxf(c0[0], 0.f) + w0[1] * fmaxf(c0[1], 0.f)) + (w0[2] * fmaxf(c0[2], 0.f) + w0[3] * fmaxf(c0[3], 0.f))
                          + (w1[0] * fmaxf(c1[0], 0.f) + w1[1] * fmaxf(c1[1], 0.f)) + (w1[2] * fmaxf(c1[2], 0.f) + w1[3] * fmaxf(c1[3], 0.f)); } } } }
}

__device__ __forceinline__ void ph_sparse_attn(const Args& a, LAS unsigned char* lds) {
    const bf16* QB = (const bf16*)(a.ws + WS_QB); const bf16* KB = (const bf16*)(a.ws + WS_KB); const bf16* VB = (const bf16*)(a.ws + WS_VB); const int* IDX = (const int*)(a.ws + WS_IDX); const int* NSEL = (const int*)(a.ws + WS_NSEL);
    bf16* O = (bf16*)(a.ws + WS_Y2);
    int tx_ = TID(); asm volatile("" : "+v"(tx_));
    const int lane = tx_ & 63, fr = lane & 15, fq = lane >> 4, wid = __builtin_amdgcn_readfirstlane(tx_ >> 6), wv = blockIdx.x * (NTHREADS >> 6) + wid, nwv = gridDim.x * (NTHREADS >> 6);
    LAS int* IDXS = (LAS int*)(lds + wid * 9216); LAS float* PS = (LAS float*)(lds + wid * 9216 + 1024);
    for (int m = wv; m < MP; m += nwv) { const int b = m / SEQ; const int ns = __builtin_amdgcn_readfirstlane(NSEL[m]);
#pragma unroll
        for (int c = 0; c < 4; ++c) { const int j = lane + 64 * c; IDXS[j] = j < ns ? IDX[(size_t)m * KROW + j] : 0; }
        bf16x8_t bQ[2][4];
#pragma unroll
        for (int kv = 0; kv < 2; ++kv)
#pragma unroll
            for (int ks = 0; ks < 4; ++ks) { bQ[kv][ks] = (bf16x8_t){0, 0, 0, 0, 0, 0, 0, 0}; if (fr < 4) bQ[kv][ks] = *(const bf16x8_t*)(QB + (size_t)m * D + (kv * 4 + fr) * 128 + ks * 32 + fq * 8); }
        asm volatile("s_waitcnt lgkmcnt(0)" ::: "memory");
#pragma unroll
        for (int tb = 0; tb < 16; tb += 2) { bf16x8_t ak[2][2][4];
#pragma unroll
            for (int t = 0; t < 2; ++t) { const int ri = IDXS[(tb + t) * 16 + fr]; const bf16* kb = KB + (size_t)(b * SEQ + ri) * 256 + fq * 8;
#pragma unroll
                for (int kv = 0; kv < 2; ++kv)
#pragma unroll
                    for (int ks = 0; ks < 4; ++ks) ak[t][kv][ks] = *(const bf16x8_t*)(kb + kv * 128 + ks * 32); }
#pragma unroll
            for (int t = 0; t < 2; ++t)
#pragma unroll
                for (int kv = 0; kv < 2; ++kv) { f32x4_t acc = {0.f, 0.f, 0.f, 0.f};
#pragma unroll
                    for (int ks = 0; ks < 4; ++ks) acc = __builtin_amdgcn_mfma_f32_16x16x32_bf16(ak[t][kv][ks], bQ[kv][ks], acc, 0, 0, 0);
                    if (fr < 4) {
#pragma unroll
                        for (int q = 0; q < 4; ++q) { const int j = (tb + t) * 16 + 4 * fq + q; PS[j * 8 + kv * 4 + fr] = j < ns ? acc[q] * 0.08838834764831845f : -1e30f; } } } }
        asm volatile("s_waitcnt lgkmcnt(0)" ::: "memory");
        { f32x4_t sv[4][2]; float mx[8];
#pragma unroll
            for (int h = 0; h < 8; ++h) mx[h] = -3e38f;
#pragma unroll
            for (int c = 0; c < 4; ++c) { sv[c][0] = *(const LAS f32x4_t*)(PS + (lane + 64 * c) * 8); sv[c][1] = *(const LAS f32x4_t*)(PS + (lane + 64 * c) * 8 + 4);
#pragma unroll
                for (int h = 0; h < 8; ++h) mx[h] = fmaxf(mx[h], sv[c][h >> 2][h & 3]); }
#pragma unroll
            for (int o = 32; o >= 1; o >>= 1)
#pragma unroll
                for (int h = 0; h < 8; ++h) mx[h] = fmaxf(mx[h], shfl_xor_l(mx[h], o, lane));
            float sum[8];
#pragma unroll
            for (int h = 0; h < 8; ++h) sum[h] = 0.f;
#pragma unroll
            for (int c = 0; c < 4; ++c)
#pragma unroll
                for (int h = 0; h < 8; ++h) { const float e = FEXP(sv[c][h >> 2][h & 3] - mx[h]); sv[c][h >> 2][h & 3] = e; sum[h] += e; }
#pragma unroll
            for (int o = 32; o >= 1; o >>= 1)
#pragma unroll
                for (int h = 0; h < 8; ++h) sum[h] += shfl_xor_l(sum[h], o, lane);
#pragma unroll
            for (int h = 0; h < 8; ++h) sum[h] = FRCP(sum[h]);
#pragma unroll
            for (int c = 0; c < 4; ++c) { f32x4_t p0, p1;
#pragma unroll
                for (int h = 0; h < 4; ++h) { p0[h] = sv[c][0][h] * sum[h]; p1[h] = sv[c][1][h] * sum[4 + h]; }
                *(LAS f32x4_t*)(PS + (lane + 64 * c) * 8) = p0; *(LAS f32x4_t*)(PS + (lane + 64 * c) * 8 + 4) = p1; } }
        asm volatile("s_waitcnt lgkmcnt(0)" ::: "memory");
        f32x4_t o4[4] = {{0.f, 0.f, 0.f, 0.f}, {0.f, 0.f, 0.f, 0.f}, {0.f, 0.f, 0.f, 0.f}, {0.f, 0.f, 0.f, 0.f}};
        const int kvl = lane >> 5; const char* vb8 = (const char*)(VB + (size_t)b * SEQ * 256);
        const unsigned loff = (unsigned)(kvl * 128 + (lane & 31) * 4) * 2u;
        for (int j0 = 0; j0 < ns; j0 += 32) { u32x2_t vv[32];
#pragma unroll
            for (int jj = 0; jj < 32; ++jj) { const unsigned off = (unsigned)IDXS[j0 + jj] * 512u + loff; vv[jj] = *(const u32x2_t*)(vb8 + off); }
#pragma unroll
            for (int jj = 0; jj < 32; ++jj) { const f32x4_t p4 = *(const LAS f32x4_t*)(PS + (j0 + jj) * 8 + kvl * 4);
                const f32x4_t vf = {__builtin_bit_cast(float, vv[jj][0] << 16), __builtin_bit_cast(float, vv[jj][0] & 0xffff0000u), __builtin_bit_cast(float, vv[jj][1] << 16), __builtin_bit_cast(float, vv[jj][1] & 0xffff0000u)};
#pragma unroll
                for (int h = 0; h < 4; ++h) o4[h] += vf * p4[h]; } }
#pragma unroll
        for (int h = 0; h < 4; ++h) { u32x2_t w; w[0] = pk_bf16(o4[h][0], o4[h][1]); w[1] = pk_bf16(o4[h][2], o4[h][3]); *(u32x2_t*)(O + (size_t)m * D + (kvl * 4 + h) * 128 + (lane & 31) * 4) = w; }
        asm volatile("s_waitcnt lgkmcnt(0)" ::: "memory");
    }
}

__device__ __forceinline__ void ph_sparse_sample(const Args& a, int ai, LAS unsigned char* lds) {
    const float* P = (const float*)(a.ws + WS_P); const int* IDX = (const int*)(a.ws + WS_IDX); const int* NSEL = (const int*)(a.ws + WS_NSEL); bf16* O = (bf16*)(a.ws + WS_Y2);
    int tx_ = TID(); asm volatile("" : "+v"(tx_));
    const int lane = tx_ & 63, wid = __builtin_amdgcn_readfirstlane(tx_ >> 6), wv = blockIdx.x * (NTHREADS >> 6) + wid, nwv = gridDim.x * (NTHREADS >> 6);
    LAS float* QS = (LAS float*)(lds + wid * 9216); LAS float* PSs = (LAS float*)(lds + wid * 9216 + 512); LAS unsigned long long* VP = (LAS unsigned long long*)(lds + wid * 9216 + 1536);
    for (int u = wv; u < MS * AH; u += nwv) { const int m = MP + u / AH, h = u % AH, kvh = h / GROUP; const RowInfo ri = row_info(m); const int ns = __builtin_amdgcn_readfirstlane(NSEL[m]);
        { const f32x2_t q2 = *(const f32x2_t*)(P + (size_t)m * LDP + h * HDIM + 2 * lane); QS[2 * lane] = q2[0]; QS[2 * lane + 1] = q2[1]; }
        const float* kp[4];
#pragma unroll
        for (int c = 0; c < 4; ++c) { const int j = lane + 64 * c; const int idx = j < ns ? IDX[(size_t)m * KROW + j] : 0; kp[c] = kv_row(a, ai, ri, idx, kvh, false); VP[j] = (unsigned long long)(size_t)kv_row(a, ai, ri, idx, kvh, true); }
        asm volatile("s_waitcnt lgkmcnt(0)" ::: "memory");
        float sc[4] = {0.f, 0.f, 0.f, 0.f};
        for (int d0 = 0; d0 < HDIM; d0 += 16) { f32x4_t kq[4][4];
#pragma unroll
            for (int e = 0; e < 4; ++e)
#pragma unroll
                for (int c = 0; c < 4; ++c) kq[e][c] = *(const f32x4_t*)(kp[c] + d0 + 4 * e);
#pragma unroll
            for (int e = 0; e < 4; ++e) { const f32x4_t q4 = *(const LAS f32x4_t*)(QS + d0 + 4 * e);
#pragma unroll
                for (int c = 0; c < 4; ++c) sc[c] += (kq[e][c][0] * q4[0] + kq[e][c][1] * q4[1]) + (kq[e][c][2] * q4[2] + kq[e][c][3] * q4[3]); } }
        float mx = -3e38f;
#pragma unroll
        for (int c = 0; c < 4; ++c) { sc[c] = (lane + 64 * c) < ns ? sc[c] * 0.08838834764831845f : -1e30f; mx = fmaxf(mx, sc[c]); }
#pragma unroll
        for (int o = 32; o >= 1; o >>= 1) mx = fmaxf(mx, shfl_xor_l(mx, o, lane));
        float sum = 0.f;
#pragma unroll
        for (int c = 0; c < 4; ++c) { sc[c] = FEXP(sc[c] - mx); sum += sc[c]; }
#pragma unroll
        for (int o = 32; o >= 1; o >>= 1) sum += shfl_xor_l(sum, o, lane);
        const float inv = FRCP(sum);
#pragma unroll
        for (int c = 0; c < 4; ++c) PSs[lane + 64 * c] = sc[c] * inv;
        asm volatile("s_waitcnt lgkmcnt(0)" ::: "memory");
        f32x2_t o2 = {0.f, 0.f};
        for (int j0 = 0; j0 < ns; j0 += 16) { f32x2_t vv[16];
#pragma unroll
            for (int jj = 0; jj < 16; ++jj) { const float* vp = (const float*)(size_t)VP[j0 + jj]; vv[jj] = *(const f32x2_t*)(vp + 2 * lane); }
#pragma unroll
            for (int jj = 0; jj < 16; ++jj) o2 += vv[jj] * PSs[j0 + jj]; }
        *(unsigned*)(O + (size_t)m * D + h * HDIM + 2 * lane) = pk_bf16(o2[0], o2[1]);
        asm volatile("s_waitcnt lgkmcnt(0)" ::: "memory");
    }
}

__device__ __forceinline__ void ph_rg_chunk(const Args& a, int r, LAS unsigned char* lds) {
    const float* P = (const float*)(a.ws + WS_P); float* HH = (float*)(a.ws + WS_HH); float* AP = (float*)(a.ws + WS_XR);
    const float* wc = a.in[I_WCONV] + (size_t)r * 4 * CONV_CH; const float* wa = a.in[I_WA] + (size_t)r * RG_HEADS * RG_BW * RG_BW; const float* wx = a.in[I_WX] + (size_t)r * RG_HEADS * RG_BW * RG_BW;
    static_assert(RG_BW == 64 && RG_HEADS == 8, "ph_rg_chunk is written for 8 gate heads of 64 channels");
    int tx_ = TID(); asm volatile("" : "+v"(tx_));
    const int lane = tx_ & 63, wid = __builtin_amdgcn_readfirstlane(tx_ >> 6), wv = blockIdx.x * (NTHREADS >> 6) + wid, nwv = gridDim.x * (NTHREADS >> 6);
    LAS float* XS = (LAS float*)(lds + wid * 16384);
    constexpr int NUP = NB * NC * 8, NU = NUP + DB * 8;
    for (int u = wv; u < NU; u += nwv) { const bool prompt = u < NUP; int hd, row0, T, n = 0, b = 0, db = 0;
        if (prompt) { const int c = u >> 3; hd = u & 7; row0 = c * 64; T = 64; n = c % NC; b = c / NC; } else { const int q = u - NUP; db = q >> 3; hd = q & 7; row0 = MP + db * DT; T = DT; }
        const int ch = hd * 64 + lane;
        const float w0 = wc[ch], w1 = wc[CONV_CH + ch], w2 = wc[2 * CONV_CH + ch], w3 = wc[3 * CONV_CH + ch], bcv = a.in[I_BCONV][(size_t)r * D_RNN + ch];
        float x3 = 0.f, x2 = 0.f, x1 = 0.f;
        if (prompt) { if (n != 0) { x3 = P[(size_t)(row0 - 3) * LDP + ch]; x2 = P[(size_t)(row0 - 2) * LDP + ch]; x1 = P[(size_t)(row0 - 1) * LDP + ch]; } }
        else { const float* sc = a.in[I_SCONV] + ((size_t)r * DB + db) * 3 * CONV_CH + ch; x3 = sc[0]; x2 = sc[CONV_CH]; x1 = sc[2 * CONV_CH]; }
        for (int tb = 0; tb < T; tb += 16) { float ub[16];
#pragma unroll
            for (int q = 0; q < 16; ++q) ub[q] = P[(size_t)(row0 + (tb + q < T ? tb + q : T - 1)) * LDP + ch];
#pragma unroll
            for (int q = 0; q < 16; ++q) { const int t = tb + q; if (t < T) { const float ut = ub[q]; XS[t * 64 + lane] = w3 * ut + w2 * x1 + w1 * x2 + w0 * x3 + bcv; x3 = x2; x2 = x1; x1 = ut;
                if (prompt) { if (n == NC - 1 && t >= 61) a.out[O_CONVP + (((size_t)r * NB + b) * 3 + (t - 61)) * CONV_CH + ch] = ut; }
                else if (t >= DT - 3) a.out[O_CONVS + (((size_t)r * DB + db) * 3 + (t - (DT - 3))) * CONV_CH + ch] = ut; } } }
        asm volatile("s_waitcnt lgkmcnt(0)" ::: "memory");
        float war[64], wxr[64];
        unsigned ln = (unsigned)lane; asm volatile("" : "+v"(ln)); ln &= 63u;
        const float* wah = wa + (size_t)hd * 4096; const float* wxh = wx + (size_t)hd * 4096;
#pragma unroll
        for (int k = 0; k < 64; ++k) { war[k] = wah[k * 64u + ln]; wxr[k] = wxh[k * 64u + ln]; }
        const float ba = a.in[I_BA][(size_t)r * D_RNN + ch], bx = a.in[I_BX][(size_t)r * D_RNN + ch], sp = softplusf_(-a.in[I_LAM][(size_t)r * D_RNN + ch]);
        float h = 0.f, ap = 1.f;
        for (int t = 0; t < T; ++t) { float pr = 0.f, pi = 0.f;
#pragma unroll
            for (int k = 0; k < 64; k += 4) { const f32x4_t x4 = *(const LAS f32x4_t*)(XS + t * 64 + k);
#pragma unroll
                for (int e = 0; e < 4; ++e) { pr += x4[e] * war[k + e]; pi += x4[e] * wxr[k + e]; } }
            const float rg = sigmoidf_(pr + ba), ig = sigmoidf_(pi + bx), log_a = -8.0f * rg * sp, av = __expf(log_a);
            const bool first = prompt && n == 0 && t == 0; const float mult = first ? 1.0f : FSQRT(fmaxf(1.0f - __expf(2.0f * log_a), 0.0f));
            float bv = XS[t * 64 + lane] * ig * mult; if (!prompt && t == 0) bv += av * a.in[I_SH][((size_t)r * DB + db) * D_RNN + ch];
            h = av * h + bv; ap *= av; const size_t o = (size_t)(row0 + t) * D_RNN + ch; HH[o] = h; AP[o] = ap; }
        if (!prompt) a.out[O_HS + ((size_t)r * DB + db) * D_RNN + ch] = h;
        asm volatile("s_waitcnt lgkmcnt(0)" ::: "memory");
    }
}
__device__ __forceinline__ void ph_dn_tok(const Args& a, int r) {
    const float* P = (const float*)(a.ws + WS_P); float* QKV = (float*)(a.ws + WS_QKV); float* QN = (float*)(a.ws + WS_QN); float* KN = (float*)(a.ws + WS_KN); float* GB = (float*)(a.ws + WS_GB); float* KNT = (float*)(a.ws + WS_KNT);
    const float* wc = a.in[I_WCONV] + (size_t)r * 4 * CONV_CH;
    int tx_ = TID(); asm volatile("" : "+v"(tx_));
    const int lane = tx_ & 63, wv = __builtin_amdgcn_readfirstlane(blockIdx.x * (NTHREADS >> 6) + (tx_ >> 6)), nwv = gridDim.x * (NTHREADS >> 6);
    constexpr int NUP = (MP / 16) * DNH, NU = NUP + DB * DNH;
    static_assert(DT == 4 && SEQ % 64 == 0, "ph_dn_tok run lengths");
    for (int u = wv; u < NU; u += nwv) { const bool prompt = u < NUP; const int hd = prompt ? (u & 3) : ((u - NUP) & 3), m0 = prompt ? (u >> 2) * 16 : MP + ((u - NUP) >> 2) * DT, T = prompt ? 16 : DT;
        const int seq = prompt ? m0 / SEQ : 0, t0 = prompt ? m0 % SEQ : 0, db = prompt ? 0 : (m0 - MP) / DT;
        f32x2_t wk[3][4], h3[3], h2[3], h1[3];
#pragma unroll
        for (int p = 0; p < 3; ++p) { const int c = D_RNN + p * 512 + hd * 128 + 2 * lane;
#pragma unroll
            for (int k = 0; k < 4; ++k) wk[p][k] = *(const f32x2_t*)(wc + (size_t)k * CONV_CH + c);
            h3[p] = h2[p] = h1[p] = (f32x2_t){0.f, 0.f};
            if (prompt) { if (t0 != 0) { h3[p] = *(const f32x2_t*)(P + (size_t)(m0 - 3) * LDP + c); h2[p] = *(const f32x2_t*)(P + (size_t)(m0 - 2) * LDP + c); h1[p] = *(const f32x2_t*)(P + (size_t)(m0 - 1) * LDP + c); } }
            else { const float* sc = a.in[I_SCONV] + ((size_t)r * DB + db) * 3 * CONV_CH + c; h3[p] = *(const f32x2_t*)sc; h2[p] = *(const f32x2_t*)(sc + CONV_CH); h1[p] = *(const f32x2_t*)(sc + 2 * CONV_CH); } }
        float gcum = 0.f;
        if (prompt) { const int tl0 = t0 & 63; float gt = lane < tl0 ? dn_g(a, r, (size_t)(m0 - tl0 + lane), hd) : 0.f;
#pragma unroll
            for (int o2 = 32; o2 >= 1; o2 >>= 1) gt += shfl_xor_l(gt, o2, lane);
            gcum = gt; }
        for (int tb = 0; tb < T; tb += 8) { f32x2_t xin[8][3];
#pragma unroll
            for (int q = 0; q < 8; ++q)
#pragma unroll
                for (int p = 0; p < 3; ++p) xin[q][p] = *(const f32x2_t*)(P + (size_t)(m0 + (tb + q < T ? tb + q : T - 1)) * LDP + D_RNN + p * 512 + hd * 128 + 2 * lane);
#pragma unroll
            for (int q = 0; q < 8; ++q) { const int t = tb + q; if (t < T) { const int m = m0 + t; f32x2_t x[3];
#pragma unroll
                for (int p = 0; p < 3; ++p) { const int c = D_RNN + p * 512 + hd * 128 + 2 * lane; const f32x2_t xv = xin[q][p];
                    const f32x2_t acc = wk[p][0] * h3[p] + wk[p][1] * h2[p] + wk[p][2] * h1[p] + wk[p][3] * xv; h3[p] = h2[p]; h2[p] = h1[p]; h1[p] = xv;
                    x[p][0] = siluf_(acc[0]); x[p][1] = siluf_(acc[1]);
                    if (prompt) { if (t0 + t >= SEQ - 3) *(f32x2_t*)(a.out + O_CONVP + (((size_t)r * NB + seq) * 3 + (t0 + t - (SEQ - 3))) * CONV_CH + c) = xv; }
                    else if (t >= DT - 3) *(f32x2_t*)(a.out + O_CONVS + (((size_t)r * DB + db) * 3 + (t - (DT - 3))) * CONV_CH + c) = xv; }
                float sq = x[0][0] * x[0][0] + x[0][1] * x[0][1], sk = x[1][0] * x[1][0] + x[1][1] * x[1][1];
#pragma unroll
                for (int o = 32; o >= 1; o >>= 1) { sq += shfl_xor_l(sq, o, lane); sk += shfl_xor_l(sk, o, lane); }
                const float rq = FRSQ(sq + EPS) * 0.08838834764831845f, rk = FRSQ(sk + EPS);
                const f32x2_t qn = x[0] * rq, kn = x[1] * rk; const size_t o = (size_t)m * 512 + hd * 128 + 2 * lane;
                *(f32x2_t*)(QN + o) = qn; *(f32x2_t*)(KN + o) = kn; *(f32x2_t*)(QKV + (size_t)m * 1536 + 1024 + hd * 128 + 2 * lane) = x[2];
                const float g = dn_g(a, r, (size_t)m, hd); float gc = g;
                if (prompt) { const int tt = t0 + t, tl = tt & 63; if (tl == 0) gcum = 0.f; gcum += g; gc = gcum;
                    float* kt = KNT + (((size_t)seq * DNH + hd) * NC + tt / 64) * 8192 + (size_t)(2 * lane) * 64 + tl; kt[0] = kn[0]; kt[64] = kn[1]; }
                if (lane == 0) { GB[(size_t)m * 16 + hd * 4] = g; GB[(size_t)m * 16 + hd * 4 + 1] = sigmoidf_(P[(size_t)m * LDP + OFF_B + hd]); GB[(size_t)m * 16 + hd * 4 + 2] = gc; } } } } }
}
__device__ __forceinline__ void ph_rec_out_w(const Args& a, int r) {
    static_assert(D_RNN == 512 && Y2W == 1024, "ph_rec_out_w is written for D_RNN 512");
    const float* P = (const float*)(a.ws + WS_P); const float* HH = (const float*)(a.ws + WS_HH); const float* AP = (const float*)(a.ws + WS_XR); const float* CARRY = (const float*)(a.ws + WS_CARRY);
    const float* ODN = (const float*)(a.ws + WS_ODN); bf16* Y2 = (bf16*)(a.ws + WS_Y2); const float* dnw = a.in[I_DNW] + r * 128;
    int tx_ = TID(); asm volatile("" : "+v"(tx_));
    const int lane = tx_ & 63, wv = __builtin_amdgcn_readfirstlane(blockIdx.x * (NTHREADS >> 6) + (tx_ >> 6)), nwv = gridDim.x * (NTHREADS >> 6);
    const f32x2_t dw = *(const f32x2_t*)(dnw + 2 * lane);
    for (int m = wv; m < MT; m += nwv) {
        { const size_t o = (size_t)m * D_RNN + 8 * lane; f32x4_t h0 = *(const f32x4_t*)(HH + o), h1 = *(const f32x4_t*)(HH + o + 4);
            if (m < MP) { const float* cr = CARRY + (size_t)(m / 64) * D_RNN + 8 * lane; h0 += *(const f32x4_t*)(AP + o) * *(const f32x4_t*)cr; h1 += *(const f32x4_t*)(AP + o + 4) * *(const f32x4_t*)(cr + 4); }
            const float* gp = P + (size_t)m * LDP + OFF_GATE + 8 * lane; const f32x4_t g0 = *(const f32x4_t*)gp, g1 = *(const f32x4_t*)(gp + 4);
            u32x4_t w; w[0] = pk_bf16(h0[0] * gelu_tanhf_(g0[0]), h0[1] * gelu_tanhf_(g0[1])); w[1] = pk_bf16(h0[2] * gelu_tanhf_(g0[2]), h0[3] * gelu_tanhf_(g0[3]));
            w[2] = pk_bf16(h1[0] * gelu_tanhf_(g1[0]), h1[1] * gelu_tanhf_(g1[1])); w[3] = pk_bf16(h1[2] * gelu_tanhf_(g1[2]), h1[3] * gelu_tanhf_(g1[3]));
            *(u32x4_t*)(Y2 + (size_t)m * Y2W + 8 * lane) = w; }
        f32x2_t ov[4]; float ss[4];
#pragma unroll
        for (int hd = 0; hd < 4; ++hd) { ov[hd] = *(const f32x2_t*)(ODN + (size_t)m * 512 + hd * 128 + 2 * lane); ss[hd] = ov[hd][0] * ov[hd][0] + ov[hd][1] * ov[hd][1]; }
#pragma unroll
        for (int o = 32; o >= 1; o >>= 1)
#pragma unroll
            for (int hd = 0; hd < 4; ++hd) ss[hd] += shfl_xor_l(ss[hd], o, lane);
#pragma unroll
        for (int hd = 0; hd < 4; ++hd) { const float rs = FRSQ(ss[hd] * (1.0f / 128.0f) + EPS); const f32x2_t z = *(const f32x2_t*)(P + (size_t)m * LDP + OFF_Z + hd * 128 + 2 * lane);
            *(unsigned*)(Y2 + (size_t)m * Y2W + D_RNN + hd * 128 + 2 * lane) = pk_bf16(ov[hd][0] * rs * dw[0] * siluf_(z[0]), ov[hd][1] * rs * dw[1] * siluf_(z[1])); } }
}


__device__ __forceinline__ void ph_dn_chunk(const Args& a, LAS unsigned char* lds) {
    const float* QKV = (const float*)(a.ws + WS_QKV); const float* QN = (const float*)(a.ws + WS_QN); const float* KN = (const float*)(a.ws + WS_KN); const float* GB = (const float*)(a.ws + WS_GB); const float* KNT = (const float*)(a.ws + WS_KNT);
    bf16* AT = (bf16*)(a.ws + WS_AT); float* UT = (float*)(a.ws + WS_UT); bf16* WN = (bf16*)(a.ws + WS_WN); bf16* QG = (bf16*)(a.ws + WS_QG); bf16* KDT = (bf16*)(a.ws + WS_KDT); float* GL = (float*)(a.ws + WS_GL);
    int tx_ = TID(); asm volatile("" : "+v"(tx_));
    const int tid = tx_, lane = tid & 63, fr = lane & 15, fq = lane >> 4, wid = __builtin_amdgcn_readfirstlane(tid >> 6);
    constexpr int RS = 136;
    LAS bf16* Kb = (LAS bf16*)lds; LAS bf16* Qb = (LAS bf16*)(lds + 17408); LAS float* Lf = (LAS float*)(lds + 34816); LAS float* gcs = (LAS float*)(lds + 51200); LAS float* bts = (LAS float*)(lds + 51456);
    for (int cu = blockIdx.x; cu < NCU; cu += gridDim.x) { const int n = cu % NC, hd = (cu / NC) % DNH, b = cu / (NC * DNH); const size_t m0 = (size_t)b * SEQ + n * 64;
        { const int i = tid >> 3, sg = tid & 7; const float* qp = QN + (m0 + i) * 512 + hd * 128 + sg * 16; const float* kp = KN + (m0 + i) * 512 + hd * 128 + sg * 16;
            f32x4_t qv[4], kv[4];
#pragma unroll
            for (int e = 0; e < 4; ++e) { qv[e] = *(const f32x4_t*)(qp + 4 * e); kv[e] = *(const f32x4_t*)(kp + 4 * e); }
            u32x4_t w0, w1;
#pragma unroll
            for (int e = 0; e < 2; ++e) { w0[2 * e] = pk_bf16(qv[e][0], qv[e][1]); w0[2 * e + 1] = pk_bf16(qv[e][2], qv[e][3]); w1[2 * e] = pk_bf16(qv[e + 2][0], qv[e + 2][1]); w1[2 * e + 1] = pk_bf16(qv[e + 2][2], qv[e + 2][3]); }
            *(LAS u32x4_t*)(Qb + i * RS + sg * 16) = w0; *(LAS u32x4_t*)(Qb + i * RS + sg * 16 + 8) = w1;
#pragma unroll
            for (int e = 0; e < 2; ++e) { w0[2 * e] = pk_bf16(kv[e][0], kv[e][1]); w0[2 * e + 1] = pk_bf16(kv[e][2], kv[e][3]); w1[2 * e] = pk_bf16(kv[e + 2][0], kv[e + 2][1]); w1[2 * e + 1] = pk_bf16(kv[e + 2][2], kv[e + 2][3]); }
            *(LAS u32x4_t*)(Kb + i * RS + sg * 16) = w0; *(LAS u32x4_t*)(Kb + i * RS + sg * 16 + 8) = w1;
            if (tid < 64) { gcs[tid] = GB[(m0 + tid) * 16 + hd * 4 + 2]; bts[tid] = GB[(m0 + tid) * 16 + hd * 4 + 1]; } }
        __syncthreads();
        { const int ti = wid >> 1;
#pragma unroll
            for (int tq = 0; tq < 2; ++tq) { const int tj = 2 * (wid & 1) + tq; f32x4_t ck = {0.f, 0.f, 0.f, 0.f}, cq = {0.f, 0.f, 0.f, 0.f};
                if (tj <= ti) {
#pragma unroll
                    for (int ks = 0; ks < 4; ++ks) { const bf16x8_t bK = *(const LAS bf16x8_t*)(Kb + (tj * 16 + fr) * RS + ks * 32 + fq * 8);
                        ck = __builtin_amdgcn_mfma_f32_16x16x32_bf16(*(const LAS bf16x8_t*)(Kb + (ti * 16 + fr) * RS + ks * 32 + fq * 8), bK, ck, 0, 0, 0);
                        cq = __builtin_amdgcn_mfma_f32_16x16x32_bf16(*(const LAS bf16x8_t*)(Qb + (ti * 16 + fr) * RS + ks * 32 + fq * 8), bK, cq, 0, 0, 0); } }
                const int j = tj * 16 + fr; const float gj = gcs[j];
#pragma unroll
                for (int q = 0; q < 4; ++q) { const int i = ti * 16 + 4 * fq + q; float lv = 0.f, av = 0.f;
                    if (i >= j) { const float dec = __expf(gcs[i] - gj); av = cq[q] * dec; if (i > j) lv = bts[i] * ck[q] * dec; }
                    Lf[i * 64 + j] = lv; AT[(size_t)cu * 4096 + FRAG_OFF(i, j, 2)] = f2bf(av); } } }
        __syncthreads();
        if (wid < 4) { const int col = tid; float X[64];
            if (col < 128) {
#pragma unroll
                for (int j = 0; j < 64; ++j) X[j] = QKV[(m0 + j) * 1536 + 1024 + hd * 128 + col] * bts[j]; }
            else {
#pragma unroll
                for (int j = 0; j < 64; ++j) X[j] = KN[(m0 + j) * 512 + hd * 128 + (col - 128)] * bts[j] * __expf(gcs[j]); }
#pragma unroll
            for (int i = 1; i < 64; ++i) { float acc = X[i];
#pragma unroll
                for (int jb = 0; jb < i; jb += 4) { const f32x4_t l4 = *(const LAS f32x4_t*)(Lf + i * 64 + jb);
                    acc -= l4[0] * X[jb]; acc -= l4[1] * X[jb + 1]; acc -= l4[2] * X[jb + 2]; acc -= l4[3] * X[jb + 3]; }
                X[i] = acc; }
            if (col < 128) { float* up = UT + (size_t)cu * 8192 + (size_t)((col >> 4) * 4) * 256 + (col & 15) * 4;
#pragma unroll
                for (int j = 0; j < 64; j += 4) *(f32x4_t*)(up + (j >> 4) * 256 + ((j >> 2) & 3) * 64) = (f32x4_t){X[j], X[j + 1], X[j + 2], X[j + 3]}; }
            else { bf16* wp = WN + (size_t)cu * 8192;
#pragma unroll
                for (int j = 0; j < 64; ++j) wp[FRAG_OFF(j, col - 128, 4)] = f2bf(-X[j]); } }
        else { const int t2 = tid - 256; const float gl63 = gcs[63];
            { const int i = t2 >> 2, sg = t2 & 3; const float eg = __expf(gcs[i]); const float* qp = QN + (m0 + i) * 512 + hd * 128 + sg * 32; bf16* op = QG + (size_t)cu * 8192;
#pragma unroll
                for (int e = 0; e < 8; ++e) { const f32x4_t v = *(const f32x4_t*)(qp + 4 * e); u32x2_t w; w[0] = pk_bf16(v[0] * eg, v[1] * eg); w[1] = pk_bf16(v[2] * eg, v[3] * eg); *(u32x2_t*)(op + FRAG_OFF(i, sg * 32 + 4 * e, 4)) = w; } }
            { const int dd = t2 >> 1, hf = t2 & 1; const float* kp = KNT + (size_t)cu * 8192 + dd * 64 + hf * 32; bf16* op = KDT + (size_t)cu * 8192;
#pragma unroll
                for (int e = 0; e < 8; ++e) { const f32x4_t v = *(const f32x4_t*)(kp + 4 * e); const int i0 = hf * 32 + 4 * e; u32x2_t w;
                    w[0] = pk_bf16(v[0] * __expf(gl63 - gcs[i0]), v[1] * __expf(gl63 - gcs[i0 + 1])); w[1] = pk_bf16(v[2] * __expf(gl63 - gcs[i0 + 2]), v[3] * __expf(gl63 - gcs[i0 + 3])); *(u32x2_t*)(op + FRAG_OFF(dd, i0, 2)) = w; } }
            if (t2 == 0) GL[cu] = __expf(gl63); }
        __syncthreads();
    }
}


template <int MODE, int UNR> __device__ __forceinline__ void small_gemm(const bf16* __restrict__ A, const bf16* __restrict__ Bt, int N, int K, void* C, int ldc) {
    static_assert(MS == 128, "small_gemm covers 128 sample rows");
    int tx_ = TID(); asm volatile("" : "+v"(tx_));
    const int lane = tx_ & 63, fr = lane & 15, fq = lane >> 4, wv = __builtin_amdgcn_readfirstlane(blockIdx.x * (NTHREADS >> 6) + (tx_ >> 6)), nwv = gridDim.x * (NTHREADS >> 6);
    const int ntile = (N / 16) * 4;
    for (int tile = wv; tile < ntile; tile += nwv) { const int n0 = (tile >> 2) * 16, tg = tile & 3;
        f32x4_t acc0 = {0.f, 0.f, 0.f, 0.f}, acc1 = {0.f, 0.f, 0.f, 0.f};
        const bf16* bp = Bt + (size_t)(n0 + fr) * K + fq * 8; const bf16* ap0 = A + (size_t)(MP + tg * 32 + fr) * K + fq * 8; const bf16* ap1 = ap0 + (size_t)16 * K;
        for (int k = 0; k < K; k += 32 * UNR) { bf16x8_t bb[UNR], a0[UNR], a1[UNR];
#pragma unroll
            for (int u = 0; u < UNR; ++u) { bb[u] = *(const bf16x8_t*)(bp + k + 32 * u); a0[u] = *(const bf16x8_t*)(ap0 + k + 32 * u); a1[u] = *(const bf16x8_t*)(ap1 + k + 32 * u); }
#pragma unroll
            for (int u = 0; u < UNR; ++u) { acc0 = __builtin_amdgcn_mfma_f32_16x16x32_bf16(bb[u], a0[u], acc0, 0, 0, 0); acc1 = __builtin_amdgcn_mfma_f32_16x16x32_bf16(bb[u], a1[u], acc1, 0, 0, 0); } }
#pragma unroll
        for (int tt = 0; tt < 2; ++tt) { const f32x4_t v = tt ? acc1 : acc0; const size_t o = (size_t)(MP + tg * 32 + tt * 16 + fr) * ldc + n0 + 4 * fq;
            if (MODE == 0) *(f32x4_t*)((float*)C + o) = v;
            else if (MODE == 1) { const float r0 = fmaxf(v[0], 0.f), r1 = fmaxf(v[1], 0.f), r2 = fmaxf(v[2], 0.f), r3 = fmaxf(v[3], 0.f); u32x2_t w; w[0] = pk_bf16(r0 * r0, r1 * r1); w[1] = pk_bf16(r2 * r2, r3 * r3); *(u32x2_t*)((bf16*)C + o) = w; }
            else { f32x4_t* p = (f32x4_t*)((float*)C + o); *p = *p + v; } } }
}


template <int MODE> __device__ __forceinline__ void small_gemm2(const bf16* __restrict__ A, const bf16* __restrict__ Bt, int N, int K, void* C, int ldc, bf16* XB, unsigned long long* ss, LAS unsigned char* lds) {
    static_assert(MS == 128, "small_gemm2 covers 128 sample rows");
    int tx_ = TID(); asm volatile("" : "+v"(tx_));
    const int tid = tx_, lane = tid & 63, fr = lane & 15, fq = lane >> 4, wid = __builtin_amdgcn_readfirstlane(tid >> 6);
    LAS float* RED = (LAS float*)lds;
    const int kw = K / 8;
    for (int tile = blockIdx.x; tile < (N / 16) * 4; tile += gridDim.x) { const int n0 = (tile >> 2) * 16, tg = tile & 3;
        f32x4_t acc0 = {0.f, 0.f, 0.f, 0.f}, acc1 = {0.f, 0.f, 0.f, 0.f};
        const bf16* bp = Bt + (size_t)(n0 + fr) * K + wid * kw + fq * 8; const bf16* ap0 = A + (size_t)(MP + tg * 32 + fr) * K + wid * kw + fq * 8; const bf16* ap1 = ap0 + (size_t)16 * K;
        for (int k = 0; k < kw; k += 128) { bf16x8_t bb[4], a0[4], a1[4];
#pragma unroll
            for (int u = 0; u < 4; ++u) { bb[u] = *(const bf16x8_t*)(bp + k + 32 * u); a0[u] = *(const bf16x8_t*)(ap0 + k + 32 * u); a1[u] = *(const bf16x8_t*)(ap1 + k + 32 * u); }
#pragma unroll
            for (int u = 0; u < 4; ++u) { acc0 = __builtin_amdgcn_mfma_f32_16x16x32_bf16(bb[u], a0[u], acc0, 0, 0, 0); acc1 = __builtin_amdgcn_mfma_f32_16x16x32_bf16(bb[u], a1[u], acc1, 0, 0, 0); } }
        *(LAS f32x4_t*)(RED + ((size_t)(wid * 32 + fr)) * 16 + 4 * fq) = acc0; *(LAS f32x4_t*)(RED + ((size_t)(wid * 32 + 16 + fr)) * 16 + 4 * fq) = acc1;
        __syncthreads();
        { const int tok = tid >> 4, c = tid & 15; float v = RED[(size_t)tok * 16 + c];
#pragma unroll
            for (int w = 1; w < 8; ++w) v += RED[(size_t)(w * 32 + tok) * 16 + c];
            const int m = MP + tg * 32 + tok; const size_t o = (size_t)m * ldc + n0 + c;
            if (MODE == 1) { const float rs = FRSQ((float)ss[m] * (5.9604644775390625e-08f / D) + EPS); const float r0 = fmaxf(v * rs, 0.f); ((bf16*)C)[o] = f2bf(r0 * r0); }
            else { const float x = ((float*)C)[o] + v; ((float*)C)[o] = x; XB[o] = f2bf(x);
                float q = x * x; q += shfl_xor_l(q, 1, lane); q += shfl_xor_l(q, 2, lane); q += shfl_xor_l(q, 4, lane); q += shfl_xor_l(q, 8, lane);
                if (c == 0) __hip_atomic_fetch_add(ss + m, (unsigned long long)(q * 16777216.0f), __ATOMIC_RELAXED, __HIP_MEMORY_SCOPE_AGENT); } }
        __syncthreads();
    }
}

constexpr int PH_PER_LAYER = 12, PH_LAYER0 = 2, PH_FINAL = PH_LAYER0 + DEPTH * PH_PER_LAYER, N_PHASES = PH_FINAL + 1;
#ifndef DIAG_SEQ_LO
#define DIAG_SEQ_LO NB
#endif
#ifndef PROBE_N
#define PROBE_N 1
#define PROBE_KIND -1
#define PROBE_LO 0
#define PROBE_HI 0
#endif
#define NREP(kind, k) ((PROBE_KIND == (kind) && (k) >= PROBE_LO && (k) <= PROBE_HI) ? PROBE_N : 1)
#define REP(kind, k) for (int rep_ = 0; rep_ < NREP(kind, k); ++rep_)
#ifndef MK_SINGLE
#define MK_SINGLE 1
#endif
__global__ void __launch_bounds__(NTHREADS, 2) mega(KArgs ka) {
    extern __shared__ __attribute__((aligned(16))) unsigned char lds[];
    LAS unsigned char* L = (LAS unsigned char*)lds;
    const size_t gsz = (size_t)gridDim.x * NTHREADS;
#define GT() ([&]() -> size_t { unsigned tx_ = TID(); asm volatile("" : "+v"(tx_)); return (size_t)blockIdx.x * NTHREADS + tx_; }())
    const int lo = ka.ph_lo, hi = ka.ph_hi; (void)lo; (void)hi;
    { const unsigned hw_ = (unsigned)__builtin_amdgcn_s_getreg((5 << 11) | 4) & 63u; if ((threadIdx.x & 63) == 0) ((LAS int*)(L + LDS_WTAB))[hw_] = (int)(threadIdx.x >> 6); __syncthreads(); }
    { const float** tab = (const float**)(ka.ws + WS_TAB); if (threadIdx.x < 28) tab[threadIdx.x] = ka.in[threadIdx.x]; asm volatile("s_waitcnt vmcnt(0)" ::: "memory"); __syncthreads(); }
    Args a; a.in = (const float* const*)(ka.ws + WS_TAB); a.out = ka.out; a.ws = ka.ws;
#define OPQ() do { size_t z_ = 0; asm volatile("" : "+s"(z_)); a.ws = ka.ws + z_; a.out = ka.out + z_; a.in = (const float* const*)(ka.ws + WS_TAB + z_); } while (0)
#if MK_SINGLE
    if (TID() < 4) ((LAS unsigned*)(L + LDS_MISC))[TID()] = 0u;
    __syncthreads();
    XcdBarrier bar = xcd_barrier_post((unsigned*)(a.ws + WS_CTL) + 4096, (volatile LAS unsigned*)(L + LDS_MISC));
#define SEAM(k) do { XcdBarrier bb_ = bar; asm volatile("" : "+s"(bb_.x)); xcd_barrier(bb_); } while (0)
#else
#define SEAM(k) do { } while (0)
#endif
#if MK_SINGLE
#define IN(k) (true)
#else
#define IN(k) (lo <= (k) && (k) < hi)
#endif
#define XN ((bf16*)(a.ws + WS_XN))
#define X ((float*)(a.ws + WS_X))
#define P ((float*)(a.ws + WS_P))
#define H ((bf16*)(a.ws + WS_H))
#define Y2 ((bf16*)(a.ws + WS_Y2))
    if (IN(0)) { OPQ(); REP(2, 0) { ph_prep_x(a); ph_wprep(a, true, 0, GT(), gsz); } SEAM(0); }
    for (int l = 0; l < DEPTH; ++l) {
        const int pb = PH_LAYER0 + l * PH_PER_LAYER, r = l >> 1; unsigned long long* SSb = (unsigned long long*)(a.ws + WS_SS);
        if ((l & 1) == 0) {
            if (IN(pb + 1)) { OPQ(); REP(3, 1) { pg8::Gemm g{XN, (const bf16*)(a.ws + WS_WINR) + (size_t)r * REC_PAD * D, MPAD, REC_PAD, D}; pg8::StaticOrder S; S.init(MPAD, REC_PAD, gridDim.x, blockIdx.x);
                pg8::EpiF32S E{P, LDP, SSb + (size_t)(2 * l) * MPAD}; pg8::gemm_phase<pg8::EpiF32S, pg8::StaticOrder, false>(L, g, S, E, nullptr); } SEAM(pb + 1); }
            if (IN(pb + 2)) { OPQ(); REP(0, 2) { ph_rg_chunk(a, r, L); ph_dn_tok(a, r); } SEAM(pb + 2); }
            if (IN(pb + 3)) { OPQ(); REP(0, 3) ph_dn_chunk(a, L); SEAM(pb + 3); }
            if (IN(pb + 6)) { OPQ();
                constexpr int NDNB = NB * DNH * 8;
                REP(0, 6) {
                if ((int)gridDim.x > NDNB) { if ((int)blockIdx.x < NDNB) {
#ifdef DIAG_NAIVE_B
                    ph_dn_b_naive(a, r, GT(), (size_t)NDNB * NTHREADS);
#else
                    ph_dn_b(a, r, L);
#endif
                } else { const size_t g2 = GT() - (size_t)NDNB * NTHREADS, s2 = gsz - (size_t)NDNB * NTHREADS; ph_rg_scan2(a, r, g2, s2); if (DIAG_SEQ_LO != 0) ph_dn_seq(a, r, DIAG_SEQ_LO, g2, s2);
                    if (l == 0) ph_wprep(a, true, 1, g2, s2); } }
                else { ph_dn_b(a, r, L); ph_rg_scan2(a, r, GT(), gsz); ph_dn_seq(a, r, DIAG_SEQ_LO, GT(), gsz); if (l == 0) ph_wprep(a, true, 1, GT(), gsz); }
                }
                SEAM(pb + 6); }
            if (IN(pb + 7)) { OPQ(); REP(0, 7) ph_rec_out_w(a, r); SEAM(pb + 7); }
            if (IN(pb + 8)) { OPQ(); REP(3, 8) { pg8::Gemm g{Y2, (const bf16*)(a.ws + WS_WOUTR) + (size_t)r * D * Y2W, MP, D, Y2W}; pg8::StaticOrder S; S.init(MP, D, gridDim.x, blockIdx.x);
                pg8::EpiAddN E{X, D, XN, SSb + (size_t)(2 * l + 1) * MPAD}; pg8::gemm_phase<pg8::EpiAddN, pg8::StaticOrder, false>(L, g, S, E, nullptr); small_gemm2<2>(Y2, (const bf16*)(a.ws + WS_WOUTR) + (size_t)r * D * Y2W, D, Y2W, X, D, XN, SSb + (size_t)(2 * l + 1) * MPAD, L); } SEAM(pb + 8); }
        } else {
            if (IN(pb + 1)) { OPQ(); REP(3, 1) { pg8::Gemm g{XN, (const bf16*)(a.ws + WS_WINA) + (size_t)r * ATT_PAD * D, MPAD, ATT_PAD, D}; pg8::StaticOrder S; S.init(MPAD, ATT_PAD, gridDim.x, blockIdx.x);
                pg8::EpiAttS E{a.ws, a.out, SSb + (size_t)(2 * l) * MPAD, r}; pg8::gemm_phase<pg8::EpiAttS, pg8::StaticOrder, false>(L, g, S, E, nullptr); } SEAM(pb + 1); }
            if (IN(pb + 3)) { OPQ(); REP(1, 3) { ph_idx_sample_mfma(a, r); ph_idx_mfma(a, L); } SEAM(pb + 3); }
            if (IN(pb + 4)) { OPQ(); REP(1, 4) ph_select_w(a, L); SEAM(pb + 4); }
            if (IN(pb + 5)) { OPQ(); REP(1, 5) { ph_sparse_sample(a, r, L); ph_sparse_attn(a, L); } SEAM(pb + 5); }
            if (IN(pb + 8)) { OPQ(); REP(3, 8) { pg8::Gemm g{Y2, (const bf16*)(a.ws + WS_WOUTA) + (size_t)r * D * D, MP, D, D}; pg8::StaticOrder S; S.init(MP, D, gridDim.x, blockIdx.x);
                pg8::EpiAddN E{X, D, XN, SSb + (size_t)(2 * l + 1) * MPAD}; pg8::gemm_phase<pg8::EpiAddN, pg8::StaticOrder, false>(L, g, S, E, nullptr); small_gemm2<2>(Y2, (const bf16*)(a.ws + WS_WOUTA) + (size_t)r * D * D, D, D, X, D, XN, SSb + (size_t)(2 * l + 1) * MPAD, L); } SEAM(pb + 8); }
        }
        if (IN(pb + 10)) { OPQ(); REP(3, 10) { pg8::Gemm g{XN, (const bf16*)(a.ws + WS_WUP) + (size_t)l * D_FF * D, MP, D_FF, D}; pg8::StaticOrder S; S.init(MP, D_FF, gridDim.x, blockIdx.x);
            pg8::EpiRelu2S E{H, D_FF, SSb + (size_t)(2 * l + 1) * MPAD}; pg8::gemm_phase<pg8::EpiRelu2S, pg8::StaticOrder, false>(L, g, S, E, nullptr); small_gemm2<1>(XN, (const bf16*)(a.ws + WS_WUP) + (size_t)l * D_FF * D, D_FF, D, H, D_FF, nullptr, SSb + (size_t)(2 * l + 1) * MPAD, L); } SEAM(pb + 10); }
        if (IN(pb + 11)) { OPQ(); REP(3, 11) { pg8::Gemm g{H, (const bf16*)(a.ws + WS_WDN) + (size_t)l * D * D_FF, MP, D, D_FF}; pg8::StaticOrder S; S.init(MP, D, gridDim.x, blockIdx.x);
            pg8::EpiAddN E{X, D, XN, SSb + (size_t)(2 * l + 2) * MPAD}; pg8::gemm_phase<pg8::EpiAddN, pg8::StaticOrder, false>(L, g, S, E, nullptr); small_gemm2<2>(H, (const bf16*)(a.ws + WS_WDN) + (size_t)l * D * D_FF, D, D_FF, X, D, XN, SSb + (size_t)(2 * l + 2) * MPAD, L); } SEAM(pb + 11); }
    }
    if (IN(PH_FINAL)) { OPQ(); ph_final(a); }
}
#undef XN
#undef X
#undef P
#undef H
#undef Y2

extern "C" void kernel_launch(void* const* d_in, const int* in_sizes, int n_in, void* d_out, int out_size, void* d_ws, size_t ws_size, hipStream_t stream) {
    static int grid = 0;
    if (grid == 0) {
        if (n_in != 28 || (size_t)out_size != (size_t)O_END || ws_size < WS_END2) { fprintf(stderr, "kernel_launch: unexpected shapes n_in %d out %d (want %zu) ws %zu (want %zu)\n", n_in, out_size, (size_t)O_END, ws_size, (size_t)WS_END2); grid = -1; return; }
        int dev = 0, cus = 0;
        if (hipGetDevice(&dev) != hipSuccess || hipDeviceGetAttribute(&cus, hipDeviceAttributeMultiprocessorCount, dev) != hipSuccess) { grid = -1; return; }
        if (hipFuncSetAttribute((const void*)mega, hipFuncAttributeMaxDynamicSharedMemorySize, LDS_BYTES) != hipSuccess) { fprintf(stderr, "kernel_launch: hipFuncSetAttribute failed\n"); grid = -1; return; }
        int per_cu = 0; (void)hipOccupancyMaxActiveBlocksPerMultiprocessor(&per_cu, (const void*)mega, NTHREADS, LDS_BYTES); (void)hipGetLastError();
        if (per_cu < 1) fprintf(stderr, "kernel_launch: occupancy query says %d blocks per CU\n", per_cu);
        grid = cus;
    }
    if (grid < 0) return;
    (void)hipMemsetAsync((char*)d_ws + WS_CTL, 0, CTL_BYTES, stream);
    KArgs a{};
    for (int i = 0; i < 28; ++i) a.in[i] = (const float*)d_in[i];
    a.out = (float*)d_out; a.ws = (unsigned char*)d_ws;
#if MK_SINGLE
    a.ph_lo = 0; a.ph_hi = N_PHASES;
    hipLaunchKernelGGL(mega, dim3(grid), dim3(NTHREADS), LDS_BYTES, stream, a);
#else
    for (int ph = 0; ph < N_PHASES; ++ph) { const int k = ph - PH_LAYER0; if (k >= 0 && ph < PH_FINAL && ((k / PH_PER_LAYER) & 1) == 1 && (k % PH_PER_LAYER) == 7) continue;
        a.ph_lo = ph; a.ph_hi = ph + 1; hipLaunchKernelGGL(mega, dim3(grid), dim3(NTHREADS), LDS_BYTES, stream, a); }
#endif
}
#endif
```

```cpp
#ifndef HOST_TEST
#include <hip/hip_runtime.h>
#define HD __device__ __forceinline__
#define UNI(x) __builtin_amdgcn_readfirstlane(x)
#else
#include <cmath>
#include <cstddef>
#include <cstring>
#define HD static inline
#define UNI(x) (x)
#endif

#ifndef CFG_D_MODEL
#define CFG_D_MODEL 1024
#define CFG_BATCH 2
#define CFG_SEQ 8192
#define CFG_DEC_BATCH 32
#define CFG_PAST 8192
#endif
constexpr int D = CFG_D_MODEL, NB = CFG_BATCH, SEQ = CFG_SEQ, DEPTH = 4, DB = CFG_DEC_BATCH, DT = 4, PAST = CFG_PAST, PAGE = 128;
constexpr int N_REC = 2, N_ATT = 2, NPAGES = PAST / PAGE, NUSED = DB * NPAGES, NPOOL = NUSED + (NUSED + 3) / 4;
constexpr int D_RNN = D / 2, RG_HEADS = 8, RG_BW = D_RNN / RG_HEADS;
constexpr int DNH = 4, DNK = 128, DN_QK = 512, DN_VD = 512;
constexpr int CONV_CH = D_RNN + 2 * DN_QK + DN_VD, REC_IN = CONV_CH + D_RNN + DN_VD + 2 * DNH;
constexpr int OFF_GATE = CONV_CH, OFF_Z = CONV_CH + D_RNN, OFF_B = OFF_Z + DN_VD, OFF_A = OFF_B + DNH;
constexpr int AH = D / 128, KVH = 2, HDIM = 128, GROUP = AH / KVH, IH = 8, IDIM = 64;
constexpr int AO_K = AH * HDIM, AO_V = AO_K + KVH * HDIM, AO_QI = AO_V + KVH * HDIM, AO_KI = AO_QI + IH * IDIM, AO_WI = AO_KI + IDIM, ATT_IN = AO_WI + IH;
constexpr int D_FF = 4 * D;
constexpr int TOPK_P = (SEQ / 4 < 256) ? SEQ / 4 : 256, TOPK_S = ((PAST + DT) / 4 < 256) ? (PAST + DT) / 4 : 256, KMAX = 256, KROW = 320;
constexpr int MP = NB * SEQ, MS = DB * DT, MT = MP + MS, MPAD = (MT + 255) / 256 * 256;
constexpr int REC_PAD = (REC_IN + 255) / 256 * 256, ATT_PAD = (ATT_IN + 255) / 256 * 256, LDP = REC_PAD > ATT_PAD ? REC_PAD : ATT_PAD;
constexpr int Y2W = D_RNN + DN_VD;
constexpr int SMAX = (PAST + DT > SEQ) ? PAST + DT : SEQ, SLD = (SMAX + 63) / 64 * 64;
constexpr int NC = SEQ / 64, NCU = NB * DNH * NC;
constexpr float EPS = 1e-6f;
typedef unsigned short bf16;

constexpr size_t O_YP = 0, O_YS = O_YP + (size_t)MP * D, O_CONVP = O_YS + (size_t)MS * D, O_HP = O_CONVP + (size_t)N_REC * NB * 3 * CONV_CH,
    O_SP = O_HP + (size_t)N_REC * NB * D_RNN, O_KP = O_SP + (size_t)N_REC * NB * DNH * 128 * 128, O_VP = O_KP + (size_t)N_ATT * MP * KVH * HDIM,
    O_KIP = O_VP + (size_t)N_ATT * MP * KVH * HDIM, O_CONVS = O_KIP + (size_t)N_ATT * MP * IDIM, O_HS = O_CONVS + (size_t)N_REC * DB * 3 * CONV_CH,
    O_SS = O_HS + (size_t)N_REC * DB * D_RNN, O_KS = O_SS + (size_t)N_REC * DB * DNH * 128 * 128, O_VS = O_KS + (size_t)N_ATT * MS * KVH * HDIM,
    O_KIS = O_VS + (size_t)N_ATT * MS * KVH * HDIM, O_END = O_KIS + (size_t)N_ATT * MS * IDIM;

constexpr size_t al256(size_t x) { return (x + 255) / 256 * 256; }
constexpr size_t WS_CTL = 0, CTL_BYTES = 4u << 20;
constexpr size_t WS_WINR = CTL_BYTES, WS_WOUTR = WS_WINR + al256((size_t)N_REC * REC_PAD * D * 2), WS_WINA = WS_WOUTR + al256((size_t)N_REC * D * Y2W * 2),
    WS_WOUTA = WS_WINA + al256((size_t)N_ATT * ATT_PAD * D * 2), WS_WUP = WS_WOUTA + al256((size_t)N_ATT * D * D * 2), WS_WDN = WS_WUP + al256((size_t)DEPTH * D_FF * D * 2),
    WS_X = WS_WDN + al256((size_t)DEPTH * D * D_FF * 2), WS_XN = WS_X + al256((size_t)MPAD * D * 4), WS_P = WS_XN + al256((size_t)MPAD * D * 2),
    WS_H = WS_P + al256((size_t)MPAD * LDP * 4), WS_Y2 = WS_H + al256((size_t)MPAD * D_FF * 2), WS_XR = WS_Y2 + al256((size_t)MPAD * D * 2),
    WS_QKV = WS_XR + al256((size_t)MT * D_RNN * 4), WS_RA = WS_QKV + al256((size_t)MT * 1536 * 4), WS_RB = WS_RA + al256((size_t)MT * D_RNN * 4),
    WS_HH = WS_RB + al256((size_t)MT * D_RNN * 4), WS_QN = WS_HH + al256((size_t)MT * D_RNN * 4), WS_KN = WS_QN + al256((size_t)MT * 512 * 4),
    WS_GB = WS_KN + al256((size_t)MT * 512 * 4), WS_ODN = WS_GB + al256((size_t)MT * 16 * 4), WS_SCT = WS_ODN + al256((size_t)MT * 512 * 4),
    WS_IDX = WS_SCT + al256((size_t)MT * SLD * 4), WS_NSEL = WS_IDX + al256((size_t)MT * KROW * 4), WS_SCR = WS_NSEL + al256((size_t)MT * 4),
    WS_CARRY = WS_SCR + al256((size_t)MT * AH * KMAX * 4), WS_L = WS_CARRY + al256((size_t)NB * NC * D_RNN * 4), WS_AT = WS_L + al256((size_t)NCU * 4096 * 4),
    WS_UT = WS_AT + al256((size_t)NCU * 4096 * 2), WS_WN = WS_UT + al256((size_t)NCU * 8192 * 4), WS_QG = WS_WN + al256((size_t)NCU * 8192 * 2),
    WS_KDT = WS_QG + al256((size_t)NCU * 8192 * 2), WS_GL = WS_KDT + al256((size_t)NCU * 8192 * 2), WS_KNT = WS_GL + al256((size_t)NCU * 4), WS_END = WS_KNT + al256((size_t)NCU * 8192 * 4);

constexpr size_t WS_KB = WS_H, WS_VB = WS_KB + al256((size_t)MT * 256 * 2), WS_QIB = WS_VB + al256((size_t)MT * 256 * 2), WS_KIB = WS_QIB + al256((size_t)MT * 512 * 2);
constexpr size_t WS_QB = WS_KIB + al256((size_t)MT * 64 * 2);
static_assert(WS_QB + (size_t)MT * D * 2 <= WS_Y2, "bf16 attention copies must fit inside the H buffer");
#ifdef HOST_TEST
struct Args { const float* in[28]; float* out; unsigned char* ws; int ph_lo, ph_hi; };
#else
struct KArgs { const float* in[28]; float* out; unsigned char* ws; int ph_lo, ph_hi; };
struct Args { const float* const* in; float* out; unsigned char* ws; };
constexpr size_t WS_TAB = 65536;
constexpr size_t WS_SS = 1u << 20;
static_assert(WS_SS + (size_t)9 * MPAD * 8 <= CTL_BYTES, "norm statistics inside the memset region");
constexpr size_t WS_END2 = WS_END;
#endif
enum { I_XP = 0, I_XS, I_SCONV, I_SH, I_SS, I_CK, I_CV, I_CKI, I_PT, I_NMIX, I_NMLP, I_NFIN, I_WINR, I_WCONV, I_BCONV, I_WA, I_BA, I_WX, I_BX, I_LAM, I_ALOG, I_DTB, I_DNW,
       I_WOUTR, I_WINA, I_WOUTA, I_WUP, I_WDN };

HD bf16 f2bf(float f) { unsigned u; memcpy(&u, &f, 4); u += 0x7FFFu + ((u >> 16) & 1u); return (bf16)(u >> 16); }
HD float bf2f(bf16 b) { unsigned u = ((unsigned)b) << 16; float f; memcpy(&f, &u, 4); return f; }
#ifndef HOST_TEST
#define FEXP(x) __expf(x)
#define FLOG(x) __logf(x)
#define FRCP(x) __builtin_amdgcn_rcpf(x)
#define FSQRT(x) __builtin_amdgcn_sqrtf(x)
#define FRSQ(x) __builtin_amdgcn_rsqf(x)
#else
#define FEXP(x) expf(x)
#define FLOG(x) logf(x)
#define FRCP(x) (1.0f / (x))
#define FSQRT(x) sqrtf(x)
#define FRSQ(x) (1.0f / sqrtf(x))
#endif
HD float sigmoidf_(float x) { return FRCP(1.0f + FEXP(-x)); }
HD float softplusf_(float x) { return x > 20.f ? x : FLOG(1.0f + FEXP(x)); }
HD float siluf_(float x) { return x * sigmoidf_(x); }
HD float gelu_tanhf_(float x) { const float u = 0.7978845608028654f * (x + 0.044715f * x * x * x); const float th = 1.0f - 2.0f * FRCP(1.0f + FEXP(2.0f * u)); return 0.5f * x * (1.0f + th); }
HD unsigned fkey(float f) { f = f + 0.0f; unsigned u; memcpy(&u, &f, 4); return (u & 0x80000000u) ? ~u : (u | 0x80000000u); }
struct RowInfo { int seq, t, T, row0; bool sample; };
HD RowInfo row_info(int m) { RowInfo r; if (m < MP) { r.seq = m / SEQ; r.t = m % SEQ; r.T = SEQ; r.row0 = r.seq * SEQ; r.sample = false; }
    else { const int q = m - MP; r.seq = NB + q / DT; r.t = q % DT; r.T = DT; r.row0 = MP + (q / DT) * DT; r.sample = true; } return r; }

HD void ph_copy_x(const Args& a, size_t gtid, size_t gsz) {
    float* X = (float*)(a.ws + WS_X);
    for (size_t i = gtid; i < (size_t)MPAD * D; i += gsz) { const size_t m = i / D; X[i] = m < (size_t)MP ? a.in[I_XP][i] : (m < (size_t)MT ? a.in[I_XS][i - (size_t)MP * D] : 0.f); }
}
HD void wprep_one(const float* w, bf16* wt, int K, int N, int NP, const float* gamma, size_t gtid, size_t gsz) {
    const size_t k32n = (size_t)K / 32;
    for (size_t i = gtid; i < (size_t)NP * k32n; i += gsz) { const int n = (int)(i % NP); const size_t k0 = (i / NP) * 32; bf16 tmp[32];
#ifndef HOST_TEST
#pragma unroll
#endif
        for (int j = 0; j < 32; ++j) tmp[j] = n < N ? f2bf(w[(k0 + j) * (size_t)N + n] * (gamma ? gamma[k0 + j] : 1.0f)) : (bf16)0;
#ifndef HOST_TEST
#pragma unroll
#endif
        for (int j = 0; j < 32; ++j) wt[(size_t)n * K + k0 + j] = tmp[j]; }
}
HD void ph_wprep(const Args& a, bool fold, int part, size_t gtid, size_t gsz) {
    for (int r = 0; r < N_REC; ++r) { if (part == 2 || (part == 0) == (r == 0)) wprep_one(a.in[I_WINR] + (size_t)r * D * REC_IN, (bf16*)(a.ws + WS_WINR) + (size_t)r * REC_PAD * D, D, REC_IN, REC_PAD, fold ? a.in[I_NMIX] + (size_t)(2 * r) * D : nullptr, gtid, gsz);
        if (part != 0) wprep_one(a.in[I_WOUTR] + (size_t)r * Y2W * D, (bf16*)(a.ws + WS_WOUTR) + (size_t)r * D * Y2W, Y2W, D, D, nullptr, gtid, gsz); }
    if (part == 0) return;
    for (int r = 0; r < N_ATT; ++r) { wprep_one(a.in[I_WINA] + (size_t)r * D * ATT_IN, (bf16*)(a.ws + WS_WINA) + (size_t)r * ATT_PAD * D, D, ATT_IN, ATT_PAD, fold ? a.in[I_NMIX] + (size_t)(2 * r + 1) * D : nullptr, gtid, gsz);
        wprep_one(a.in[I_WOUTA] + (size_t)r * D * D, (bf16*)(a.ws + WS_WOUTA) + (size_t)r * D * D, D, D, D, nullptr, gtid, gsz); }
    for (int l = 0; l < DEPTH; ++l) { wprep_one(a.in[I_WUP] + (size_t)l * D * D_FF, (bf16*)(a.ws + WS_WUP) + (size_t)l * D_FF * D, D, D_FF, D_FF, fold ? a.in[I_NMLP] + (size_t)l * D : nullptr, gtid, gsz);
        wprep_one(a.in[I_WDN] + (size_t)l * D_FF * D, (bf16*)(a.ws + WS_WDN) + (size_t)l * D * D_FF, D_FF, D, D, nullptr, gtid, gsz); }
}
HD void ph_conv(const Args& a, int r, size_t gtid, size_t gsz) {
    const float* P = (const float*)(a.ws + WS_P); float* XR = (float*)(a.ws + WS_XR); float* QKV = (float*)(a.ws + WS_QKV);
    const float* wc = a.in[I_WCONV] + (size_t)r * 4 * CONV_CH; const float* bc = a.in[I_BCONV] + (size_t)r * D_RNN;
    for (size_t i = gtid; i < (size_t)MT * CONV_CH; i += gsz) { const int m = (int)(i / CONV_CH), c = (int)(i % CONV_CH); const RowInfo ri = row_info(m);
        float acc = 0.f;
        for (int k = 0; k < 4; ++k) { const int tau = ri.t - 3 + k; float xv;
            if (tau >= 0) xv = P[(size_t)(ri.row0 + tau) * LDP + c];
            else xv = ri.sample ? a.in[I_SCONV][(((size_t)r * DB + (ri.seq - NB)) * 3 + (3 + tau)) * CONV_CH + c] : 0.f;
            acc += xv * wc[(size_t)k * CONV_CH + c]; }
        if (c < D_RNN) XR[(size_t)m * D_RNN + c] = acc + bc[c]; else QKV[(size_t)m * 1536 + (c - D_RNN)] = siluf_(acc);
        const float uraw = P[(size_t)m * LDP + c];
        if (!ri.sample) { if (ri.t >= SEQ - 3) a.out[O_CONVP + (((size_t)r * NB + ri.seq) * 3 + (ri.t - (SEQ - 3))) * CONV_CH + c] = uraw; }
        else { if (ri.t >= DT - 3) a.out[O_CONVS + (((size_t)r * DB + (ri.seq - NB)) * 3 + (ri.t - (DT - 3))) * CONV_CH + c] = uraw; }
    }
}
HD void ph_rg_gates(const Args& a, int r, size_t gtid, size_t gsz) {
    const float* XR = (const float*)(a.ws + WS_XR); float* RA = (float*)(a.ws + WS_RA); float* RB = (float*)(a.ws + WS_RB);
    const float* wa = a.in[I_WA] + (size_t)r * RG_HEADS * RG_BW * RG_BW; const float* wx = a.in[I_WX] + (size_t)r * RG_HEADS * RG_BW * RG_BW;
    for (size_t i = gtid; i < (size_t)MT * D_RNN; i += gsz) { const int m = (int)(i / D_RNN), j = (int)(i % D_RNN), hd = j / RG_BW, jj = j % RG_BW; const RowInfo ri = row_info(m);
        float pr = 0.f, pi = 0.f; const float* xrow = XR + (size_t)m * D_RNN + hd * RG_BW;
        for (int k = 0; k < RG_BW; ++k) { const float xv = xrow[k]; pr += xv * wa[((size_t)hd * RG_BW + k) * RG_BW + jj]; pi += xv * wx[((size_t)hd * RG_BW + k) * RG_BW + jj]; }
        const float rg = sigmoidf_(pr + a.in[I_BA][(size_t)r * D_RNN + j]), ig = sigmoidf_(pi + a.in[I_BX][(size_t)r * D_RNN + j]);
        const float log_a = -8.0f * rg * softplusf_(-a.in[I_LAM][(size_t)r * D_RNN + j]); const float av = FEXP(log_a);
        const bool first = (!ri.sample) && ri.t == 0;
        const float mult = first ? 1.0f : sqrtf(fmaxf(1.0f - FEXP(2.0f * log_a), 0.0f));
        float bv = XR[(size_t)m * D_RNN + j] * ig * mult;
        if (ri.t == 0 && ri.sample) bv += av * a.in[I_SH][((size_t)r * DB + (ri.seq - NB)) * D_RNN + j];
        RA[i] = av; RB[i] = bv; }
}
HD void ph_rg_scan1(const Args& a, int r, size_t gtid, size_t gsz) {
    const float* RA = (const float*)(a.ws + WS_RA); float* AP = (float*)(a.ws + WS_XR); const float* RB = (const float*)(a.ws + WS_RB); float* HH = (float*)(a.ws + WS_HH);
    const size_t n_p = (size_t)NB * NC * D_RNN, n_s = (size_t)DB * D_RNN;
    for (size_t i = gtid; i < n_p + n_s; i += gsz) {
        if (i < n_p) { const int j = (int)(i % D_RNN); const size_t row0 = (i / D_RNN) * 64; float h = 0.f, ap = 1.f;
            for (int t = 0; t < 64; ++t) { const size_t o = (row0 + t) * D_RNN + j; const float av = RA[o]; h = av * h + RB[o]; ap *= av; HH[o] = h; AP[o] = ap; } }
        else { const size_t q = i - n_p; const int db = (int)(q / D_RNN), j = (int)(q % D_RNN); float h = 0.f;
            for (int t = 0; t < DT; ++t) { const size_t o = (size_t)(MP + db * DT + t) * D_RNN + j; h = RA[o] * h + RB[o]; HH[o] = h; }
            a.out[O_HS + ((size_t)r * DB + db) * D_RNN + j] = h; } }
}
HD void ph_rg_scan2(const Args& a, int r, size_t gtid, size_t gsz) {
    const float* RA = (const float*)(a.ws + WS_XR); const float* HH = (const float*)(a.ws + WS_HH); float* CARRY = (float*)(a.ws + WS_CARRY);
    for (size_t i = gtid; i < (size_t)NB * D_RNN; i += gsz) { const int b = (int)(i / D_RNN), j = (int)(i % D_RNN); float carry = 0.f;
        for (int n0 = 0; n0 < NC; n0 += 16) { float av[16], hv[16];
#pragma unroll
            for (int q = 0; q < 16; ++q) { const int n = n0 + q < NC ? n0 + q : NC - 1; const size_t last = ((size_t)b * SEQ + n * 64 + 63) * D_RNN + j; av[q] = RA[last]; hv[q] = HH[last]; }
#pragma unroll
            for (int q = 0; q < 16; ++q) if (n0 + q < NC) { CARRY[((size_t)b * NC + n0 + q) * D_RNN + j] = carry; carry = av[q] * carry + hv[q]; } }
        a.out[O_HP + ((size_t)r * NB + b) * D_RNN + j] = carry; }
}
HD float dn_g(const Args& a, int r, size_t m, int hd) { const float* P = (const float*)(a.ws + WS_P);
    return -FEXP(a.in[I_ALOG][r * DNH + hd]) * softplusf_(P[m * LDP + OFF_A + hd] + a.in[I_DTB][r * DNH + hd]); }
HD void ph_dn_prep(const Args& a, int r, size_t gtid, size_t gsz) {
    const float* P = (const float*)(a.ws + WS_P); const float* QKV = (const float*)(a.ws + WS_QKV); float* QN = (float*)(a.ws + WS_QN); float* KN = (float*)(a.ws + WS_KN); float* GB = (float*)(a.ws + WS_GB);
    for (size_t i = gtid; i < (size_t)MT * DNH; i += gsz) { const int m = (int)(i / DNH), hd = (int)(i % DNH);
        const float* q = QKV + (size_t)m * 1536 + hd * 128; const float* k = q + 512; float sq = 0.f, sk = 0.f;
        for (int d = 0; d < 128; ++d) { sq += q[d] * q[d]; sk += k[d] * k[d]; }
        const float rq = FRSQ(sq + EPS) * 0.08838834764831845f, rk = 1.0f / sqrtf(sk + EPS);
        for (int d = 0; d < 128; ++d) { QN[(size_t)m * 512 + hd * 128 + d] = q[d] * rq; KN[(size_t)m * 512 + hd * 128 + d] = k[d] * rk; }
        if (m < MP) { float* KNT = (float*)(a.ws + WS_KNT) + (((size_t)(m / SEQ) * DNH + hd) * NC + (m % SEQ) / 64) * 8192 + (m % 64); for (int d = 0; d < 128; ++d) KNT[(size_t)d * 64] = k[d] * rk; }
        const float beta = sigmoidf_(P[(size_t)m * LDP + OFF_B + hd]);
        const float g = dn_g(a, r, (size_t)m, hd); float gc = g;
        if (m < MP) { const int t = m % SEQ; for (int tau = (t / 64) * 64; tau < t; ++tau) gc += dn_g(a, r, (size_t)(m - t + tau), hd); }
        GB[(size_t)m * 16 + hd * 4] = g; GB[(size_t)m * 16 + hd * 4 + 1] = beta; GB[(size_t)m * 16 + hd * 4 + 2] = gc; }
}
#ifndef HOST_TEST
#define DN_FENCE() asm volatile("" ::: "memory")
#else
#define DN_FENCE() do { } while (0)
#endif
HD void ph_dn_seq(const Args& a, int r, int seq_lo, size_t gtid, size_t gsz) {
    const float* QKV = (const float*)(a.ws + WS_QKV); const float* QN = (const float*)(a.ws + WS_QN); const float* KN = (const float*)(a.ws + WS_KN); const float* GB = (const float*)(a.ws + WS_GB);
    float* ODN = (float*)(a.ws + WS_ODN);
    for (size_t i = gtid; i < (size_t)(NB + DB - seq_lo) * DNH * 128; i += gsz) { const int v = (int)(i % 128), sh = UNI((int)(i / 128)), hd = sh % DNH, seq = seq_lo + sh / DNH;
        const int row0 = seq < NB ? seq * SEQ : MP + (seq - NB) * DT, T = seq < NB ? SEQ : DT;
        float S[128];
        if (seq < NB) {
#pragma unroll
            for (int d = 0; d < 128; ++d) S[d] = 0.f; }
        else { const float* s0 = a.in[I_SS] + ((((size_t)r * DB + (seq - NB)) * DNH + hd) * 128) * 128 + v;
#pragma unroll
            for (int d = 0; d < 128; ++d) S[d] = s0[(size_t)d * 128]; }
        for (int t = 0; t < T; ++t) { const size_t m = (size_t)(row0 + t);
            const float* kk = KN + m * 512 + hd * 128; const float* qq = QN + m * 512 + hd * 128;
            const float eg = FEXP(GB[m * 16 + hd * 4]), beta = GB[m * 16 + hd * 4 + 1], vv = QKV[m * 1536 + 1024 + hd * 128 + v];
            float ks = 0.f;
#pragma unroll
            for (int c = 0; c < 4; ++c) {
#pragma unroll
                for (int d = c * 32; d < c * 32 + 32; ++d) ks += kk[d] * S[d];
                DN_FENCE(); }
            const float cc = beta * (vv - eg * ks); float o = 0.f;
#pragma unroll
            for (int c = 0; c < 4; ++c) {
#pragma unroll
                for (int d = c * 32; d < c * 32 + 32; ++d) { S[d] = eg * S[d] + kk[d] * cc; o += qq[d] * S[d]; }
                DN_FENCE(); }
            ODN[m * 512 + hd * 128 + v] = o; }
        float* so = seq < NB ? a.out + O_SP + ((((size_t)r * NB + seq) * DNH + hd) * 128) * 128 + v : a.out + O_SS + ((((size_t)r * DB + (seq - NB)) * DNH + hd) * 128) * 128 + v;
#pragma unroll
        for (int d = 0; d < 128; ++d) so[(size_t)d * 128] = S[d]; }
}
HD void ph_dn_lat(const Args& a, size_t gtid, size_t gsz) {
    const float* QN = (const float*)(a.ws + WS_QN); const float* KN = (const float*)(a.ws + WS_KN); const float* GB = (const float*)(a.ws + WS_GB); const float* KNT = (const float*)(a.ws + WS_KNT);
    float* Lm = (float*)(a.ws + WS_L); bf16* AT = (bf16*)(a.ws + WS_AT); bf16* QG = (bf16*)(a.ws + WS_QG); bf16* KDT = (bf16*)(a.ws + WS_KDT); float* GL = (float*)(a.ws + WS_GL);
    for (size_t it = gtid; it < (size_t)NCU * 4096; it += gsz) { const int j = (int)(it % 64), ci = UNI((int)(it / 64)), i = ci % 64, cu = ci / 64;
        const int n = cu % NC, hd = (cu / NC) % DNH, b = cu / (NC * DNH); const size_t mi = (size_t)b * SEQ + n * 64 + i, mj = (size_t)b * SEQ + n * 64 + j;
        const float* ki = KN + mi * 512 + hd * 128; const float* qi = QN + mi * 512 + hd * 128; const float* kt = KNT + (size_t)cu * 8192 + j; float kk = 0.f, qk = 0.f;
        for (int d = 0; d < 128; ++d) { const float kj = kt[(size_t)d * 64]; kk += ki[d] * kj; qk += qi[d] * kj; }
        float lv = 0.f, av = 0.f;
        if (i >= j) { const float dec = FEXP(GB[mi * 16 + hd * 4 + 2] - GB[mj * 16 + hd * 4 + 2]); av = qk * dec; if (i > j) lv = GB[mi * 16 + hd * 4 + 1] * kk * dec; }
        Lm[it] = lv; AT[it] = f2bf(av); }
    for (size_t it = gtid; it < (size_t)NCU * 8192; it += gsz) { const int d = (int)(it % 128), i = (int)((it / 128) % 64), cu = (int)(it / 8192);
        const int n = cu % NC, hd = (cu / NC) % DNH, b = cu / (NC * DNH); const size_t mi = (size_t)b * SEQ + n * 64 + i;
        QG[it] = f2bf(QN[mi * 512 + hd * 128 + d] * FEXP(GB[mi * 16 + hd * 4 + 2])); }
    for (size_t it = gtid; it < (size_t)NCU * 8192; it += gsz) { const int i = (int)(it % 64), cu = (int)(it / 8192);
        const int n = cu % NC, hd = (cu / NC) % DNH, b = cu / (NC * DNH); const size_t mi = (size_t)b * SEQ + n * 64 + i, ml = (size_t)b * SEQ + n * 64 + 63;
        const float gci = GB[mi * 16 + hd * 4 + 2], gcl = GB[ml * 16 + hd * 4 + 2];
        KDT[it] = f2bf(KNT[it] * FEXP(gcl - gci)); if ((it % 8192) == 0) GL[cu] = FEXP(gcl); }
}
HD void ph_dn_solve(const Args& a, size_t gtid, size_t gsz) {
    const float* QKV = (const float*)(a.ws + WS_QKV); const float* KN = (const float*)(a.ws + WS_KN); const float* GB = (const float*)(a.ws + WS_GB); const float* Lm = (const float*)(a.ws + WS_L);
    float* UT = (float*)(a.ws + WS_UT); bf16* WN = (bf16*)(a.ws + WS_WN);
    for (size_t it = gtid; it < (size_t)NCU * 256; it += gsz) { const int col = (int)(it % 256), cu = UNI((int)(it / 256));
        const int n = cu % NC, hd = (cu / NC) % DNH, b = cu / (NC * DNH); const size_t m0 = (size_t)b * SEQ + n * 64; const float* Lc = Lm + (size_t)cu * 4096;
        float X[64];
#pragma unroll
        for (int j = 0; j < 64; ++j) { const float beta = GB[(m0 + j) * 16 + hd * 4 + 1];
            X[j] = col < 128 ? QKV[(m0 + j) * 1536 + 1024 + hd * 128 + col] * beta : KN[(m0 + j) * 512 + hd * 128 + (col - 128)] * beta * FEXP(GB[(m0 + j) * 16 + hd * 4 + 2]); }
#pragma unroll
        for (int i = 1; i < 64; ++i) { float acc = X[i];
#pragma unroll
            for (int j = 0; j < i; ++j) acc -= Lc[i * 64 + j] * X[j];
            X[i] = acc; DN_FENCE(); }
        if (col < 128) {
#pragma unroll
            for (int j = 0; j < 64; ++j) UT[(size_t)cu * 8192 + (size_t)col * 64 + j] = X[j]; }
        else {
#pragma unroll
            for (int j = 0; j < 64; ++j) WN[(size_t)cu * 8192 + (size_t)j * 128 + (col - 128)] = f2bf(-X[j]); } }
}
HD float bfr(float x) { return bf2f(f2bf(x)); }
HD void ph_dn_b_naive(const Args& a, int r, size_t gtid, size_t gsz) {
    const float* UT = (const float*)(a.ws + WS_UT); const bf16* WN = (const bf16*)(a.ws + WS_WN); const bf16* QG = (const bf16*)(a.ws + WS_QG); const bf16* AT = (const bf16*)(a.ws + WS_AT);
    const bf16* KDT = (const bf16*)(a.ws + WS_KDT); const float* GL = (const float*)(a.ws + WS_GL); float* ODN = (float*)(a.ws + WS_ODN); float* VN = (float*)(a.ws + WS_SCR);
    for (size_t it = gtid; it < (size_t)NB * DNH * 128; it += gsz) { const int v = (int)(it % 128), bh = UNI((int)(it / 128)), b = bh / DNH, hd = bh % DNH;
        float S[128];
#pragma unroll
        for (int d = 0; d < 128; ++d) S[d] = 0.f;
        for (int n = 0; n < NC; ++n) { const size_t cu = (size_t)bh * NC + n;
            for (int i = 0; i < 64; ++i) { float acc = UT[cu * 8192 + (size_t)v * 64 + i]; const bf16* wr = WN + cu * 8192 + i * 128;
#pragma unroll
                for (int d = 0; d < 128; ++d) acc += bf2f(wr[d]) * S[d];
                VN[((size_t)bh * 64 + i) * 128 + v] = acc; DN_FENCE(); }
            for (int i = 0; i < 64; ++i) { float acc = 0.f; const bf16* qr = QG + cu * 8192 + i * 128;
#pragma unroll
                for (int d = 0; d < 128; ++d) acc += bf2f(qr[d]) * S[d];
                for (int j = 0; j < 64; ++j) acc += bf2f(AT[cu * 4096 + i * 64 + j]) * bfr(VN[((size_t)bh * 64 + j) * 128 + v]);
                ODN[((size_t)b * SEQ + n * 64 + i) * 512 + hd * 128 + v] = acc; DN_FENCE(); }
            const float gl = GL[cu];
#pragma unroll
            for (int d = 0; d < 128; ++d) S[d] *= gl;
            for (int j = 0; j < 64; ++j) { const float vj = bfr(VN[((size_t)bh * 64 + j) * 128 + v]); const bf16* kr = KDT + cu * 8192 + j;
#pragma unroll
                for (int d = 0; d < 128; ++d) S[d] += bf2f(kr[d * 64]) * vj;
                DN_FENCE(); }
            DN_FENCE(); }
        float* so = a.out + O_SP + ((((size_t)r * NB + b) * DNH + hd) * 128) * 128 + v;
#pragma unroll
        for (int d = 0; d < 128; ++d) so[(size_t)d * 128] = S[d]; }
}
HD void ph_rec_out(const Args& a, int r, size_t gtid, size_t gsz) {
    const float* P = (const float*)(a.ws + WS_P); const float* HH = (const float*)(a.ws + WS_HH); const float* ODN = (const float*)(a.ws + WS_ODN); bf16* Y2 = (bf16*)(a.ws + WS_Y2);
    for (size_t i = gtid; i < (size_t)MT * Y2W; i += gsz) { const int m = (int)(i / Y2W), c = (int)(i % Y2W); float y;
        if (c < D_RNN) { float h = HH[(size_t)m * D_RNN + c]; if (m < MP) h += ((const float*)(a.ws + WS_XR))[(size_t)m * D_RNN + c] * ((const float*)(a.ws + WS_CARRY))[(size_t)(m / 64) * D_RNN + c];
            y = h * gelu_tanhf_(P[(size_t)m * LDP + OFF_GATE + c]); }
        else { const int cc = c - D_RNN, hd = cc / 128, vv = cc % 128; const float* o = ODN + (size_t)m * 512 + hd * 128; float ss = 0.f;
            for (int d = 0; d < 128; ++d) ss += o[d] * o[d];
            y = o[vv] / sqrtf(ss * (1.0f / 128.0f) + EPS) * a.in[I_DNW][r * 128 + vv] * siluf_(P[(size_t)m * LDP + OFF_Z + cc]); }
        Y2[i] = f2bf(y); }
}
HD void ph_att_split(const Args& a, int ai, size_t gtid, size_t gsz) {
    const float* P = (const float*)(a.ws + WS_P); constexpr int W = 2 * KVH * HDIM + IDIM;
    for (size_t i = gtid; i < (size_t)MT * W; i += gsz) { const int m = (int)(i / W), c = (int)(i % W);
        if (m < MP) { if (c < 256) a.out[O_KP + ((size_t)ai * MP + m) * 256 + c] = P[(size_t)m * LDP + AO_K + c];
            else if (c < 512) a.out[O_VP + ((size_t)ai * MP + m) * 256 + (c - 256)] = P[(size_t)m * LDP + AO_V + (c - 256)];
            else a.out[O_KIP + ((size_t)ai * MP + m) * 64 + (c - 512)] = P[(size_t)m * LDP + AO_KI + (c - 512)]; }
        else { const int ms = m - MP; if (c < 256) a.out[O_KS + ((size_t)ai * MS + ms) * 256 + c] = P[(size_t)m * LDP + AO_K + c];
            else if (c < 512) a.out[O_VS + ((size_t)ai * MS + ms) * 256 + (c - 256)] = P[(size_t)m * LDP + AO_V + (c - 256)];
            else a.out[O_KIS + ((size_t)ai * MS + ms) * 64 + (c - 512)] = P[(size_t)m * LDP + AO_KI + (c - 512)]; } }
}
HD const float* ki_row_sample(const Args& a, int ai, int db, int s) {
    if (s < PAST) { const int pg = ((const int*)a.in[I_PT])[db * NPAGES + s / PAGE]; return a.in[I_CKI] + (((size_t)ai * NPOOL + pg) * PAGE + s % PAGE) * IDIM; }
    return (const float*)(a.ws + WS_P) + (size_t)(MP + db * DT + (s - PAST)) * LDP + AO_KI;
}
HD void ph_idx_scores(const Args& a, int ai, bool prompt_too, size_t gtid, size_t gsz) {
    const float* P = (const float*)(a.ws + WS_P); float* SCT = (float*)(a.ws + WS_SCT);
    const int lane = (int)(gtid & 63); const size_t w = gtid >> 6, nw = gsz >> 6;
    constexpr int TM = 8, NKB = (SEQ + 63) / 64, NMT = SEQ / TM, NKBS = (PAST + DT + 63) / 64;
    const size_t n_p = (size_t)NB * NMT * NKB, n_s = (size_t)DB * NKBS;
    for (size_t it0 = w + (prompt_too ? 0 : n_p); it0 < n_p + n_s; it0 += nw) { const size_t it = (size_t)UNI((int)it0);
        int mrow0, nrows, s, smax_valid; const float* kr;
        if (it < n_p) { const int b = (int)(it / ((size_t)NMT * NKB)), rr = (int)(it % ((size_t)NMT * NKB)), mt = rr / NKB, kb = rr % NKB;
            if (kb * 64 > mt * TM + TM - 1) continue;
            mrow0 = b * SEQ + mt * TM; nrows = TM; s = kb * 64 + lane; smax_valid = SEQ; kr = P + (size_t)(b * SEQ + (s < SEQ ? s : 0)) * LDP + AO_KI; }
        else { const int q = (int)(it - n_p), db = q / NKBS, kb = q % NKBS; mrow0 = MP + db * DT; nrows = DT; s = kb * 64 + lane; smax_valid = PAST + DT; kr = ki_row_sample(a, ai, db, s < PAST + DT ? s : 0); }
        float kv[IDIM];
#pragma unroll
        for (int d = 0; d < IDIM; ++d) kv[d] = kr[d];
        for (int i = 0; i < nrows; ++i) { const int m = mrow0 + i; const float* qi = P + (size_t)m * LDP + AO_QI; const float* wi = P + (size_t)m * LDP + AO_WI; float sc = 0.f;
            for (int h = 0; h < IH; ++h) { float dot = 0.f;
#pragma unroll
                for (int d = 0; d < IDIM; ++d) dot += qi[h * IDIM + d] * kv[d];
                sc += wi[h] * fmaxf(dot, 0.f); }
            if (s < smax_valid) SCT[(size_t)m * SLD + s] = sc; } }
}
HD void ph_select(const Args& a, size_t gtid, size_t gsz) {
    const float* SCT = (const float*)(a.ws + WS_SCT); int* IDX = (int*)(a.ws + WS_IDX); int* NSEL = (int*)(a.ws + WS_NSEL);
    for (size_t m = gtid; m < (size_t)MT; m += gsz) { const RowInfo ri = row_info((int)m);
        const int n = ri.sample ? PAST + ri.t + 1 : ri.t + 1, K = ri.sample ? TOPK_S : TOPK_P; const float* col = SCT + m * SLD; int* out = IDX + m * KROW;
        if (n <= K) { for (int j = 0; j < n; ++j) out[j] = j; NSEL[m] = n; continue; }
        unsigned lo = 0u;
        for (int bit = 31; bit >= 0; --bit) { const unsigned cand = lo | (1u << bit); int c = 0;
            for (int s = 0; s < n; ++s) c += (fkey(col[s]) >= cand) ? 1 : 0;
            if (c >= K) lo = cand; }
        int cnt = 0;
        for (int s = 0; s < n; ++s) if (fkey(col[s]) > lo) out[cnt++] = s;
        for (int s = 0; s < n && cnt < K; ++s) if (fkey(col[s]) == lo) out[cnt++] = s;
        NSEL[m] = K; }
}
HD const float* kv_row(const Args& a, int ai, const RowInfo& ri, int idx, int kvh, bool isv) {
    const float* P = (const float*)(a.ws + WS_P); const int off = (isv ? AO_V : AO_K) + kvh * HDIM;
    if (!ri.sample) return P + (size_t)(ri.row0 + idx) * LDP + off;
    const int db = ri.seq - NB;
    if (idx >= PAST) return P + (size_t)(MP + db * DT + (idx - PAST)) * LDP + off;
    const int pg = ((const int*)a.in[I_PT])[db * NPAGES + idx / PAGE];
    return a.in[isv ? I_CV : I_CK] + ((((size_t)ai * NPOOL + pg) * PAGE + idx % PAGE) * KVH + kvh) * HDIM;
}
HD void ph_sp_scores(const Args& a, int ai, int m_lo, int m_hi, size_t gtid, size_t gsz) {
    const float* P = (const float*)(a.ws + WS_P); const int* IDX = (const int*)(a.ws + WS_IDX); const int* NSEL = (const int*)(a.ws + WS_NSEL); float* SCR = (float*)(a.ws + WS_SCR);
    for (size_t i = gtid + (size_t)m_lo * AH * KMAX; i < (size_t)m_hi * AH * KMAX; i += gsz) { const int j = (int)(i % KMAX), h = (int)((i / KMAX) % AH), m = (int)(i / ((size_t)KMAX * AH));
        if (j >= NSEL[m]) { SCR[i] = -1e30f; continue; }
        const RowInfo ri = row_info(m); const float* kr = kv_row(a, ai, ri, IDX[(size_t)m * KROW + j], h / GROUP, false); const float* q = P + (size_t)m * LDP + h * HDIM; float dot = 0.f;
        for (int d = 0; d < HDIM; ++d) dot += q[d] * kr[d];
        SCR[i] = dot * 0.08838834764831845f; }
}
HD void ph_sp_out(const Args& a, int ai, int m_lo, int m_hi, size_t gtid, size_t gsz) {
    const int* IDX = (const int*)(a.ws + WS_IDX); const int* NSEL = (const int*)(a.ws + WS_NSEL); const float* SCR = (const float*)(a.ws + WS_SCR); bf16* O = (bf16*)(a.ws + WS_Y2);
    for (size_t i = gtid + (size_t)m_lo * AH * HDIM; i < (size_t)m_hi * AH * HDIM; i += gsz) { const int d = (int)(i % HDIM), h = (int)((i / HDIM) % AH), m = (int)(i / ((size_t)HDIM * AH));
        const int ns = NSEL[m]; const float* sc = SCR + ((size_t)m * AH + h) * KMAX; const RowInfo ri = row_info(m);
        float mx = -3e38f; for (int j = 0; j < ns; ++j) mx = fmaxf(mx, sc[j]);
        float sum = 0.f, acc = 0.f;
        for (int j = 0; j < ns; ++j) { const float p = FEXP(sc[j] - mx); sum += p; acc += p * kv_row(a, ai, ri, IDX[(size_t)m * KROW + j], h / GROUP, true)[d]; }
        O[(size_t)m * D + h * HDIM + d] = f2bf(acc / sum); }
}
#ifndef HOST_TEST
#define LAS __attribute__((address_space(3)))

constexpr int LDS_WTAB = 131072 + 64;
__device__ __forceinline__ int TID() { extern __shared__ __attribute__((aligned(16))) unsigned char lds_dyn_[]; const unsigned hw = (unsigned)__builtin_amdgcn_s_getreg((5 << 11) | 4) & 63u;
    const int wvi = ((const LAS int*)((LAS unsigned char*)lds_dyn_ + LDS_WTAB))[hw]; int ln_; asm volatile("v_mbcnt_lo_u32_b32 %0, -1, 0\n\tv_mbcnt_hi_u32_b32 %0, -1, %0" : "=v"(ln_));
    return (wvi << 6) | ln_; }
#define XB_TMO      128
#define XB_XCNT(j)  (256  + 64 * (j))
#define XB_XSUB(j)  (1280 + 64 * (j))
#define XB_XGEN(j)  (2304 + 64 * (j))
#define XB_TOP      3328
#define XB_TOPGEN   3392
#define XCD_BAR_WORDS 3456
#define XB_SPIN_CAP (1u << 22)

__device__ __forceinline__ unsigned xb_ld(unsigned* p)              { return __hip_atomic_load(p, __ATOMIC_RELAXED, __HIP_MEMORY_SCOPE_AGENT); }
__device__ __forceinline__ unsigned xb_add(unsigned* p, unsigned v) { return __hip_atomic_fetch_add(p, v, __ATOMIC_RELAXED, __HIP_MEMORY_SCOPE_AGENT); }
__device__ __forceinline__ unsigned xb_xcc_id() { return (unsigned)__builtin_amdgcn_s_getreg((3 << 11) | 20) & 0xFu; }
#define XB_SPIN(cond, bar) do { unsigned _sp = 0; while (cond) { __builtin_amdgcn_s_sleep(1); \
    if ((++_sp & 255u) == 0u) { if (xb_ld(&(bar)[XB_TMO])) break; if (_sp > XB_SPIN_CAP) { atomicAdd(&(bar)[XB_TMO], 1u); break; } } } } while (0)

struct XcdBarrier {
    unsigned* bar; unsigned x;
    volatile LAS unsigned* st;
};

__device__ __forceinline__ XcdBarrier xcd_barrier_post(unsigned* bar, volatile LAS unsigned* st) {
    XcdBarrier b; b.bar = bar; b.x = xb_xcc_id(); b.st = st;
    if (TID() == 0) (void)xb_add(&bar[XB_XCNT(b.x)], 1u);
    return b;
}
__device__ __forceinline__ void xcd_barrier_complete(unsigned* bar, unsigned x, unsigned& nloc, unsigned& nx) {
    const unsigned G = gridDim.x * gridDim.y * gridDim.z;
    unsigned sum, cnt, mine, sp = 0u;
    for (;;) {
        sum = 0u; cnt = 0u; mine = 0u;
#pragma unroll
        for (unsigned j = 0; j < 16; ++j) { const unsigned c = xb_ld(&bar[XB_XCNT(j)]); sum += c; cnt += (c > 0u) ? 1u : 0u; mine = (j == x) ? c : mine; }
        if (sum == G) break;
        __builtin_amdgcn_s_sleep(1);
        if ((++sp & 255u) == 0u) { if (xb_ld(&bar[XB_TMO])) break; if (sp > XB_SPIN_CAP) { atomicAdd(&bar[XB_TMO], 1u); break; } }
    }
    nloc = mine > 0u ? mine : 1u; nx = cnt > 0u ? cnt : 1u;
}

__device__ __forceinline__ void xcd_barrier(const XcdBarrier& b) {
    asm volatile("s_waitcnt vmcnt(0)" ::: "memory");
    __syncthreads();
    if (TID() == 0) {
        unsigned* bar = b.bar;
        __builtin_amdgcn_s_waitcnt(0);
        unsigned nloc = b.st[0], nx = b.st[1];
        if (nloc == 0u) { xcd_barrier_complete(bar, b.x, nloc, nx); b.st[0] = nloc; b.st[1] = nx; }
        const unsigned old = xb_add(&bar[XB_XSUB(b.x)], 1u);
        const unsigned gen = old / nloc;
        if (old + 1u == (gen + 1u) * nloc) {
            __builtin_amdgcn_fence(__ATOMIC_RELEASE, "agent");
            asm volatile("s_waitcnt vmcnt(0)" ::: "memory");
            const unsigned og = xb_add(&bar[XB_TOP], 1u);
            const unsigned tg = og / nx;
            if (og + 1u == (tg + 1u) * nx) xb_add(&bar[XB_TOPGEN], 1u);
            else XB_SPIN(xb_ld(&bar[XB_TOPGEN]) == tg, bar);
            __builtin_amdgcn_fence(__ATOMIC_ACQUIRE, "agent");
            xb_add(&bar[XB_XGEN(b.x)], 1u);
            asm volatile("s_waitcnt vmcnt(0)" ::: "memory");
        } else {
            XB_SPIN(xb_ld(&bar[XB_XGEN(b.x)]) == gen, bar);
            __builtin_amdgcn_fence(__ATOMIC_ACQUIRE, "agent");
            asm volatile("s_waitcnt vmcnt(0)" ::: "memory");
        }
    }
    __syncthreads();
}

namespace pg8 {
#define PG8_LAS __attribute__((address_space(3)))
typedef unsigned short bf16_t;
typedef short bf16x8 __attribute__((ext_vector_type(8)));
typedef float f32x4 __attribute__((ext_vector_type(4)));
typedef unsigned u32x4 __attribute__((ext_vector_type(4)));
constexpr int BM = 256, BK = 64, HALF = 128, HTB = HALF * BK * 2  , STAGE_BYTES = 8 * HTB, NXCD = 8, WGM = 8;

__host__ __device__ __forceinline__ int lds_byte(int r, int c) { const int st = (r >> 4) * 2 + (c >> 5), rr = r & 15, cc = c & 31, ob = rr * 64 + cc * 2; return st * 1024 + (ob ^ (((ob >> 9) & 1) << 5)); }
__host__ __device__ __forceinline__ void stage_rc(int b, int& R, int& C) { const int st = b / 1024, sb = b % 1024, swz = sb ^ (((sb >> 9) & 1) << 5); R = (st >> 1) * 16 + swz / 64; C = (st & 1) * 32 + (swz % 64) / 2; }
__host__ __device__ __forceinline__ int perm32(int rho) { const int n = rho >> 4, i = rho & 15; return 8 * (i >> 2) + 4 * n + (i & 3); }

struct Unit { int pm, pn; };
struct Gemm { const bf16_t* A; const bf16_t* Bt; int M, N, K; };

struct StaticOrder {
    int nM, nN, nwg, G, c;
    __host__ __device__ void init(int M, int N, int G_, int c_) { nM = M / BM; nN = N / BM; nwg = nM * nN; G = G_; c = c_; }
    __host__ __device__ bool next(int i, Unit& u) const {
        const long L = (long)i * G + c; if (L >= nwg) return false;
        int wgid = (int)L; { const int q = nwg / NXCD, r = nwg % NXCD, xcd = wgid % NXCD, off = wgid / NXCD; wgid = (xcd < r ? xcd * (q + 1) : r * (q + 1) + (xcd - r) * q) + off; }
        const int nig = WGM * nN, gid = wgid / nig, fm = gid * WGM, gsz = (nM - fm) < WGM ? (nM - fm) : WGM;
        u.pm = fm + ((wgid % nig) % gsz); u.pn = (wgid % nig) / gsz; return true;
    }
    __device__ __forceinline__ void a_ready(const Unit&) const {}
    __device__ __forceinline__ void done(const Unit&) const {}
};

__device__ __forceinline__ unsigned cvt_pk_bf16(float lo, float hi) { unsigned r; asm volatile("v_cvt_pk_bf16_f32 %0, %1, %2" : "=v"(r) : "v"(lo), "v"(hi)); return r; }
struct EpiF32 {
    static constexpr bool PERM = false, AFTER_DRAIN = false;
    float* C; int ldc; const float* bias;
    __device__ __forceinline__ void operator()(const f32x4 (&acc)[2][2][4][2], const Unit& u, int wr, int wc, int fr, int fq) const {
        const int row0 = u.pm * BM + wr * 64 + fr, col0 = u.pn * BM + wc * 32 + 4 * fq;
        f32x4 bv[2][2];
#pragma unroll
        for (int bj = 0; bj < 2; ++bj)
#pragma unroll
            for (int n = 0; n < 2; ++n) bv[bj][n] = bias ? *(const f32x4*)(bias + col0 + bj * HALF + n * 16) : (f32x4){0.f, 0.f, 0.f, 0.f};
#pragma unroll
        for (int ai = 0; ai < 2; ++ai)
#pragma unroll
            for (int m = 0; m < 4; ++m) { float* rowp = C + (size_t)(row0 + ai * HALF + m * 16) * ldc + col0;
#pragma unroll
                for (int bj = 0; bj < 2; ++bj)
#pragma unroll
                    for (int n = 0; n < 2; ++n) *(f32x4*)(rowp + bj * HALF + n * 16) = acc[ai][bj][m][n] + bv[bj][n]; }
    }
};
template <class Epi, class Sched, bool STAMP = false>
__device__ __forceinline__ void gemm_phase(PG8_LAS unsigned char* lds, const Gemm g, const Sched& S, const Epi& E, unsigned long long* stamps) {
    int tid_ = TID(); asm volatile("" : "+v"(tid_));
    const int tid = tid_, wid = __builtin_amdgcn_readfirstlane(tid >> 6), lane = tid & 63, wr = wid >> 2, wc = wid & 3, fr = lane & 15, fq = lane >> 4;
    const int K = g.K, nt = K / BK;
    int ts_lo = 0, ts_hi = 0, nts = 0; const unsigned long long rt_entry = STAMP ? (unsigned long long)wall_clock64() : 0ull;
#define PG8_STAMP() do { if (STAMP && wid == 0 && nts < 64) { const unsigned long long _c = (unsigned long long)clock64(); \
        ts_lo = (lane == nts) ? (int)(unsigned)_c : ts_lo; ts_hi = (lane == nts) ? (int)(unsigned)(_c >> 32) : ts_hi; ++nts; } } while (0)
    PG8_STAMP();
    unsigned voffA[2], voffB[2];
#pragma unroll
    for (int i = 0; i < 2; ++i) { int R, C; stage_rc(tid * 16 + i * 8192, R, C); const int Rb = Epi::PERM ? ((R & ~31) + perm32(R & 31)) : R;
        voffA[i] = (unsigned)(R * K + C) * 2u; voffB[i] = (unsigned)(Rb * K + C) * 2u; }
    const size_t kstep = (size_t)(BK * 2);
    const size_t hstep = (size_t)HALF * K * 2;
    const size_t tstep = 2 * hstep;
    const unsigned ldsw = (unsigned)wid * 1024u;
    const int aoff = lds_byte(wr * 64 + fr, fq * 8), boff = lds_byte(wc * 32 + fr, fq * 8);
#define PG8_SA(b, h) (((b) * 2 + (h)) * HTB)
#define PG8_SB(b, h) ((4 + (b) * 2 + (h)) * HTB)
#define PG8_STAGE(bufoff, gbase, voff) do { _Pragma("unroll") for (int _i = 0; _i < 2; ++_i) \
        __builtin_amdgcn_global_load_lds((const unsigned*)((const char*)(gbase) + (voff)[_i]), (PG8_LAS unsigned*)(lds + (bufoff) + ldsw + _i * 8192), 16, 0, 0); } while (0)
#define PG8_LDA(dst, b, h) do { _Pragma("unroll") for (int m = 0; m < 4; ++m) _Pragma("unroll") for (int k = 0; k < 2; ++k) dst[m][k] = *(const PG8_LAS bf16x8*)(lds + PG8_SA(b, h) + aoff + m * 2048 + k * 1024); } while (0)
#define PG8_LDB(dst, b, h) do { _Pragma("unroll") for (int n = 0; n < 2; ++n) _Pragma("unroll") for (int k = 0; k < 2; ++k) dst[n][k] = *(const PG8_LAS bf16x8*)(lds + PG8_SB(b, h) + boff + n * 2048 + k * 1024); } while (0)
#define PG8_MMA(ai, bj, At, Bt) do { __builtin_amdgcn_s_setprio(1); _Pragma("unroll") for (int m = 0; m < 4; ++m) _Pragma("unroll") for (int n = 0; n < 2; ++n) _Pragma("unroll") for (int k = 0; k < 2; ++k) \
        acc[ai][bj][m][n] = __builtin_amdgcn_mfma_f32_16x16x32_bf16(Bt[n][k], At[m][k], acc[ai][bj][m][n], 0, 0, 0); __builtin_amdgcn_s_setprio(0); } while (0)
#define PG8_WAIT_V(n) asm volatile("s_waitcnt vmcnt(" #n ")" ::: "memory")
#define PG8_WAIT_L(n) asm volatile("s_waitcnt lgkmcnt(" #n ")" ::: "memory")
#define PG8_BAR __builtin_amdgcn_s_barrier()
#define PG8_SCHED __builtin_amdgcn_sched_barrier(0)
    Unit cur, nxt; int ui = 0;
    if (!S.next(0, cur)) return;
    f32x4 acc[2][2][4][2];
#pragma unroll
    for (int a = 0; a < 2; ++a)
#pragma unroll
        for (int b = 0; b < 2; ++b)
#pragma unroll
            for (int m = 0; m < 4; ++m)
#pragma unroll
                for (int n = 0; n < 2; ++n) acc[a][b][m][n] = (f32x4){0.f, 0.f, 0.f, 0.f};
    bf16x8 At[4][2], B0[2][2], B1[2][2];
    const char* cA = (const char*)g.A + (size_t)cur.pm * tstep; const char* cB = (const char*)g.Bt + (size_t)cur.pn * tstep;
    S.a_ready(cur);
    PG8_STAGE(PG8_SB(0, 0), cB, voffB); PG8_STAGE(PG8_SA(0, 0), cA, voffA); PG8_STAGE(PG8_SB(0, 1), cB + hstep, voffB); PG8_STAGE(PG8_SA(0, 1), cA + hstep, voffA);
    if (wr == 1) PG8_BAR;
    PG8_WAIT_V(4); PG8_BAR;
    PG8_STAGE(PG8_SB(1, 0), cB + kstep, voffB); PG8_STAGE(PG8_SA(1, 0), cA + kstep, voffA); PG8_STAGE(PG8_SB(1, 1), cB + hstep + kstep, voffB);
    PG8_WAIT_V(6); PG8_BAR;
    PG8_STAMP();
    for (;;) {
        const bool has_next = S.next(ui + 1, nxt);
        const char* nA = has_next ? (const char*)g.A + (size_t)nxt.pm * tstep : cA; const char* nB = has_next ? (const char*)g.Bt + (size_t)nxt.pn * tstep : cB;
        for (int t = 0; t < nt; t += 2) {
            const bool last = (t == nt - 2);
            const char* a1 = cA + (size_t)(t + 1) * kstep;
            const char* a2 = last ? nA : cA + (size_t)(t + 2) * kstep; const char* b2 = last ? nB : cB + (size_t)(t + 2) * kstep;
            const char* a3 = a2 + kstep; const char* b3 = b2 + kstep;
            if (last && has_next) S.a_ready(nxt);
            PG8_LDB(B0, 0, 0); PG8_SCHED; PG8_LDA(At, 0, 0); PG8_STAGE(PG8_SA(1, 1), a1 + hstep, voffA);
            PG8_WAIT_L(8); PG8_BAR; PG8_WAIT_L(0); PG8_MMA(0, 0, At, B0); PG8_BAR; PG8_SCHED;
            PG8_LDB(B1, 0, 1); PG8_STAGE(PG8_SB(0, 0), b2, voffB);
            PG8_BAR; PG8_WAIT_L(0); PG8_MMA(0, 1, At, B1); PG8_BAR;
            PG8_LDA(At, 0, 1); PG8_STAGE(PG8_SA(0, 0), a2, voffA);
            PG8_BAR; PG8_WAIT_L(0); PG8_MMA(1, 0, At, B0); PG8_BAR; PG8_SCHED;
            PG8_STAGE(PG8_SB(0, 1), b2 + hstep, voffB);
            PG8_WAIT_V(6); PG8_BAR; PG8_MMA(1, 1, At, B1); PG8_BAR;
            PG8_LDB(B0, 1, 0); PG8_SCHED; PG8_LDA(At, 1, 0); PG8_STAGE(PG8_SA(0, 1), a2 + hstep, voffA);
            PG8_WAIT_L(8); PG8_BAR; PG8_WAIT_L(0); PG8_MMA(0, 0, At, B0); PG8_BAR; PG8_SCHED;
            PG8_LDB(B1, 1, 1); PG8_STAGE(PG8_SB(1, 0), b3, voffB);
            PG8_BAR; PG8_WAIT_L(0); PG8_MMA(0, 1, At, B1); PG8_BAR;
            PG8_LDA(At, 1, 1); PG8_STAGE(PG8_SA(1, 0), a3, voffA);
            PG8_BAR; PG8_WAIT_L(0); PG8_MMA(1, 0, At, B0); PG8_BAR; PG8_SCHED;
            PG8_STAGE(PG8_SB(1, 1), b3 + hstep, voffB);
            PG8_WAIT_V(6); PG8_BAR; PG8_MMA(1, 1, At, B1); PG8_BAR;
        }
        PG8_STAMP();
        if constexpr (!Epi::AFTER_DRAIN) { E(acc, cur, wr, wc, fr, fq); S.done(cur); }
        PG8_STAMP();
        if (!has_next) break;
#pragma unroll
        for (int a = 0; a < 2; ++a)
#pragma unroll
            for (int b = 0; b < 2; ++b)
#pragma unroll
                for (int m = 0; m < 4; ++m)
#pragma unroll
                    for (int n = 0; n < 2; ++n) acc[a][b][m][n] = (f32x4){0.f, 0.f, 0.f, 0.f};
        cur = nxt; cA = nA; cB = nB; ++ui;
    }
    PG8_WAIT_V(0);
    if (wr == 0) PG8_BAR;
    PG8_BAR;
    if constexpr (Epi::AFTER_DRAIN) { E.fused(acc, cur, wr, wc, fr, fq, lds, wid, lane); S.done(cur); }
    PG8_STAMP();
    if (STAMP && wid == 0) { stamps[lane] = lane < nts ? (((unsigned long long)(unsigned)ts_hi << 32) | (unsigned)ts_lo) : 0ull;
        if (lane == 62) stamps[62] = rt_entry; if (lane == 63) stamps[63] = (unsigned long long)wall_clock64(); }
#undef PG8_STAMP
#undef PG8_SA
#undef PG8_SB
#undef PG8_STAGE
#undef PG8_LDA
#undef PG8_LDB
#undef PG8_MMA
#undef PG8_WAIT_V
#undef PG8_WAIT_L
#undef PG8_BAR
#undef PG8_SCHED
}
}
#endif

#ifndef HOST_TEST
#include <cstdio>
#define FRAG_OFF(row_, k_, KS_) ((((((row_) >> 4) * (KS_) + ((k_) >> 5)) * 64 + (((k_) >> 3) & 3) * 16 + ((row_) & 15)) * 8) + ((k_) & 7))
namespace pg8 {
struct EpiAddF32 {
    static constexpr bool PERM = false, AFTER_DRAIN = false;
    float* C; int ldc;
    __device__ __forceinline__ void operator()(const f32x4 (&acc)[2][2][4][2], const Unit& u, int wr, int wc, int fr, int fq) const {
        const int row0 = u.pm * BM + wr * 64 + fr, col0 = u.pn * BM + wc * 32 + 4 * fq;
#pragma unroll
        for (int ai = 0; ai < 2; ++ai)
#pragma unroll
            for (int m = 0; m < 4; ++m) { float* rowp = C + (size_t)(row0 + ai * HALF + m * 16) * ldc + col0;
#pragma unroll
                for (int bj = 0; bj < 2; ++bj)
#pragma unroll
                    for (int n = 0; n < 2; ++n) { f32x4* p = (f32x4*)(rowp + bj * HALF + n * 16); *p = *p + acc[ai][bj][m][n]; } }
    }
};
struct EpiRelu2Bf16 {
    static constexpr bool PERM = true, AFTER_DRAIN = false;
    bf16_t* O; int ldc;
    __device__ __forceinline__ void operator()(const f32x4 (&acc)[2][2][4][2], const Unit& u, int wr, int wc, int fr, int fq) const {
        const int row0 = u.pm * BM + wr * 64 + fr, col0 = u.pn * BM + wc * 32 + 8 * fq;
#pragma unroll
        for (int ai = 0; ai < 2; ++ai)
#pragma unroll
            for (int m = 0; m < 4; ++m) { bf16_t* rowp = O + (size_t)(row0 + ai * HALF + m * 16) * ldc + col0;
#pragma unroll
                for (int bj = 0; bj < 2; ++bj) { f32x4 v0 = acc[ai][bj][m][0], v1 = acc[ai][bj][m][1];
#pragma unroll
                    for (int j = 0; j < 4; ++j) { const float r0 = fmaxf(v0[j], 0.f), r1 = fmaxf(v1[j], 0.f); v0[j] = r0 * r0; v1[j] = r1 * r1; }
                    u32x4 w; w.x = cvt_pk_bf16(v0[0], v0[1]); w.y = cvt_pk_bf16(v0[2], v0[3]); w.z = cvt_pk_bf16(v1[0], v1[1]); w.w = cvt_pk_bf16(v1[2], v1[3]);
                    *(u32x4*)(rowp + bj * HALF) = w; } }
    }
};

__device__ __forceinline__ float epi_shfl_xor(float v, int o, int lane) { return __builtin_bit_cast(float, __builtin_amdgcn_ds_bpermute((lane ^ o) << 2, __builtin_bit_cast(int, v))); }
__device__ __forceinline__ float row_rs(const unsigned long long* ss, int row) { return FRSQ((float)ss[row] * (5.9604644775390625e-08f / D) + EPS); }
struct EpiF32S {
    static constexpr bool PERM = false, AFTER_DRAIN = false;
    float* C; int ldc; const unsigned long long* ss;
    __device__ __forceinline__ void operator()(const f32x4 (&acc)[2][2][4][2], const Unit& u, int wr, int wc, int fr_in, int fq_in) const {
        int fr = fr_in, fq = fq_in; asm volatile("" : "+v"(fr), "+v"(fq));
        const int row0 = u.pm * BM + wr * 64 + fr, col0 = u.pn * BM + wc * 32 + 4 * fq;
#pragma unroll
        for (int ai = 0; ai < 2; ++ai)
#pragma unroll
            for (int m = 0; m < 4; ++m) { const int row = row0 + ai * HALF + m * 16; const float rs = row_rs(ss, row); float* rowp = C + (size_t)row * ldc + col0;
#pragma unroll
                for (int bj = 0; bj < 2; ++bj)
#pragma unroll
                    for (int n = 0; n < 2; ++n) *(f32x4*)(rowp + bj * HALF + n * 16) = acc[ai][bj][m][n] * rs; }
    }
};
struct EpiRelu2S {
    static constexpr bool PERM = true, AFTER_DRAIN = false;
    bf16_t* O; int ldc; const unsigned long long* ss;
    __device__ __forceinline__ void operator()(const f32x4 (&acc)[2][2][4][2], const Unit& u, int wr, int wc, int fr_in, int fq_in) const {
        int fr = fr_in, fq = fq_in; asm volatile("" : "+v"(fr), "+v"(fq));
        const int row0 = u.pm * BM + wr * 64 + fr, col0 = u.pn * BM + wc * 32 + 8 * fq;
#pragma unroll
        for (int ai = 0; ai < 2; ++ai)
#pragma unroll
            for (int m = 0; m < 4; ++m) { const int row = row0 + ai * HALF + m * 16; const float rs = row_rs(ss, row); bf16_t* rowp = O + (size_t)row * ldc + col0;
#pragma unroll
                for (int bj = 0; bj < 2; ++bj) { f32x4 v0 = acc[ai][bj][m][0] * rs, v1 = acc[ai][bj][m][1] * rs;
#pragma unroll
                    for (int j = 0; j < 4; ++j) { const float r0 = fmaxf(v0[j], 0.f), r1 = fmaxf(v1[j], 0.f); v0[j] = r0 * r0; v1[j] = r1 * r1; }
                    u32x4 w; w.x = cvt_pk_bf16(v0[0], v0[1]); w.y = cvt_pk_bf16(v0[2], v0[3]); w.z = cvt_pk_bf16(v1[0], v1[1]); w.w = cvt_pk_bf16(v1[2], v1[3]);
                    *(u32x4*)(rowp + bj * HALF) = w; } }
    }
};
struct EpiAddN {
    static constexpr bool PERM = false, AFTER_DRAIN = false;
    float* C; int ldc; bf16_t* XB; unsigned long long* ss;
    __device__ __forceinline__ void operator()(const f32x4 (&acc)[2][2][4][2], const Unit& u, int wr, int wc, int fr_in, int fq_in) const {
        int fr = fr_in, fq = fq_in; asm volatile("" : "+v"(fr), "+v"(fq));
        const int row0 = u.pm * BM + wr * 64 + fr, col0 = u.pn * BM + wc * 32 + 4 * fq, lane = fq * 16 + fr;
#pragma unroll
        for (int ai = 0; ai < 2; ++ai)
#pragma unroll
            for (int m = 0; m < 4; ++m) { const int row = row0 + ai * HALF + m * 16; float* rowp = C + (size_t)row * ldc + col0; bf16_t* xbp = XB + (size_t)row * ldc + col0; float q = 0.f;
#pragma unroll
                for (int bj = 0; bj < 2; ++bj)
#pragma unroll
                    for (int n = 0; n < 2; ++n) { f32x4* p = (f32x4*)(rowp + bj * HALF + n * 16); const f32x4 v = *p + acc[ai][bj][m][n]; *p = v; q += (v[0] * v[0] + v[1] * v[1]) + (v[2] * v[2] + v[3] * v[3]);
                        unsigned w0 = cvt_pk_bf16(v[0], v[1]), w1 = cvt_pk_bf16(v[2], v[3]); *(uint2*)(xbp + bj * HALF + n * 16) = make_uint2(w0, w1); }
                q += epi_shfl_xor(q, 16, lane); q += epi_shfl_xor(q, 32, lane);
                if (fq == 0) __hip_atomic_fetch_add(ss + row, (unsigned long long)(q * 16777216.0f), __ATOMIC_RELAXED, __HIP_MEMORY_SCOPE_AGENT); }
    }
};
struct EpiAttS {
    static constexpr bool PERM = false, AFTER_DRAIN = false;
    unsigned char* ws; float* out; const unsigned long long* ss; int ai_;
    __device__ __forceinline__ void operator()(const f32x4 (&acc)[2][2][4][2], const Unit& u, int wr, int wc, int fr_in, int fq_in) const {
        int fr = fr_in, fq = fq_in; asm volatile("" : "+v"(fr), "+v"(fq));
        float* P = (float*)(ws + WS_P); constexpr int ldc = LDP; bf16_t* QB = (bf16_t*)(ws + WS_QB); bf16_t* KB = (bf16_t*)(ws + WS_KB); bf16_t* VB = (bf16_t*)(ws + WS_VB); bf16_t* QIB = (bf16_t*)(ws + WS_QIB); bf16_t* KIB = (bf16_t*)(ws + WS_KIB);
        const int row0 = u.pm * BM + wr * 64 + fr; float rsv[2][4];
#pragma unroll
        for (int ai = 0; ai < 2; ++ai)
#pragma unroll
            for (int m = 0; m < 4; ++m) rsv[ai][m] = row_rs(ss, row0 + ai * HALF + m * 16);
#pragma unroll
        for (int bj = 0; bj < 2; ++bj)
#pragma unroll
            for (int n = 0; n < 2; ++n) { const int cb = u.pn * BM + bj * HALF + wc * 32 + n * 16;
                bf16_t* bdst; int bld, bc; float* odst0 = nullptr; float* odst1 = nullptr; int old_ = 0;
                if (cb < AO_K) { bdst = QB; bld = D; bc = cb; }
                else if (cb < AO_V) { bdst = KB; bld = 256; bc = cb - AO_K; odst0 = out + O_KP + (size_t)ai_ * MP * 256 + bc; odst1 = out + O_KS + (size_t)ai_ * MS * 256 + bc; old_ = 256; }
                else if (cb < AO_QI) { bdst = VB; bld = 256; bc = cb - AO_V; odst0 = out + O_VP + (size_t)ai_ * MP * 256 + bc; odst1 = out + O_VS + (size_t)ai_ * MS * 256 + bc; old_ = 256; }
                else if (cb < AO_KI) { bdst = QIB; bld = 512; bc = cb - AO_QI; }
                else if (cb < AO_WI) { bdst = KIB; bld = -1; bc = cb - AO_KI;     odst0 = out + O_KIP + (size_t)ai_ * MP * 64 + bc; odst1 = out + O_KIS + (size_t)ai_ * MS * 64 + bc; old_ = 64; }
                else { bdst = nullptr; bld = 0; bc = 0; }
                const bool keepP = (u.pm * BM >= MP) || (cb >= AO_WI);
#pragma unroll
                for (int ai = 0; ai < 2; ++ai)
#pragma unroll
                    for (int m = 0; m < 4; ++m) { const int row = row0 + ai * HALF + m * 16; const f32x4 v = acc[ai][bj][m][n] * rsv[ai][m]; if (keepP) *(f32x4*)(P + (size_t)row * ldc + cb + 4 * fq) = v;
                        if (bdst != nullptr && row < MT) { bf16_t* bp_ = bld >= 0 ? bdst + (size_t)row * bld + bc + 4 * fq : bdst + (size_t)(row >> 4) * 1024 + FRAG_OFF(row & 15, bc + 4 * fq, 2); *(uint2*)bp_ = make_uint2(cvt_pk_bf16(v[0], v[1]), cvt_pk_bf16(v[2], v[3]));
                            if (odst0 != nullptr) { float* op = row < MP ? odst0 + (size_t)row * old_ : odst1 + (size_t)(row - MP) * old_; *(f32x4*)(op + 4 * fq) = v; } } } }
    }
};
}

constexpr int NTHREADS = 512, LDS_BYTES = 147456, LDS_MISC = 131072;
typedef float f32x4_t __attribute__((ext_vector_type(4)));
__device__ __forceinline__ float shfl_xor_l(float v, int o, int lane) { return __builtin_bit_cast(float, __builtin_amdgcn_ds_bpermute((lane ^ o) << 2, __builtin_bit_cast(int, v))); }
__device__ __forceinline__ void ph_rmsnorm(const Args& a, const float* g) {
    static_assert(D == 1024, "device rmsnorm is written for D = 1024");
    const float* X = (const float*)(a.ws + WS_X); bf16* XN = (bf16*)(a.ws + WS_XN);
    int tx_ = TID(); asm volatile("" : "+v"(tx_));
    const int lane = tx_ & 63, wv = blockIdx.x * (NTHREADS >> 6) + (tx_ >> 6), nwv = gridDim.x * (NTHREADS >> 6);
    f32x4_t gv[4];
#pragma unroll
    for (int i = 0; i < 4; ++i) gv[i] = *(const f32x4_t*)(g + (i * 64 + lane) * 4);
    for (int m = wv; m < MPAD; m += nwv) { f32x4_t xv[4]; float ss = 0.f;
#pragma unroll
        for (int i = 0; i < 4; ++i) { xv[i] = *(const f32x4_t*)(X + (size_t)m * D + (i * 64 + lane) * 4); ss += xv[i][0] * xv[i][0] + xv[i][1] * xv[i][1] + xv[i][2] * xv[i][2] + xv[i][3] * xv[i][3]; }
#pragma unroll
        for (int o = 32; o >= 1; o >>= 1) ss += shfl_xor_l(ss, o, lane);
        const float r = FRSQ(ss * (1.0f / D) + EPS);
#pragma unroll
        for (int i = 0; i < 4; ++i) { const f32x4_t y = xv[i] * r * gv[i]; uint2 w; w.x = pg8::cvt_pk_bf16(y[0], y[1]); w.y = pg8::cvt_pk_bf16(y[2], y[3]); *(uint2*)(XN + (size_t)m * D + (i * 64 + lane) * 4) = w; } }
}

__device__ __forceinline__ void ph_prep_x(const Args& a) {
    float* X = (float*)(a.ws + WS_X); bf16* XB = (bf16*)(a.ws + WS_XN); unsigned long long* SS = (unsigned long long*)(a.ws + WS_SS);
    int tx_ = TID(); asm volatile("" : "+v"(tx_));
    const int lane = tx_ & 63, wv = blockIdx.x * (NTHREADS >> 6) + (tx_ >> 6), nwv = gridDim.x * (NTHREADS >> 6);
    for (int m = wv; m < MPAD; m += nwv) { const float* src = m < MP ? a.in[I_XP] + (size_t)m * D : a.in[I_XS] + (size_t)(m - MP) * D; float ss = 0.f;
#pragma unroll
        for (int i = 0; i < 4; ++i) { f32x4_t v = {0.f, 0.f, 0.f, 0.f}; if (m < MT) v = *(const f32x4_t*)(src + (i * 64 + lane) * 4);
            *(f32x4_t*)(X + (size_t)m * D + (i * 64 + lane) * 4) = v; ss += v[0] * v[0] + v[1] * v[1] + v[2] * v[2] + v[3] * v[3];
            uint2 w; w.x = pg8::cvt_pk_bf16(v[0], v[1]); w.y = pg8::cvt_pk_bf16(v[2], v[3]); *(uint2*)(XB + (size_t)m * D + (i * 64 + lane) * 4) = w; }
#pragma unroll
        for (int o = 32; o >= 1; o >>= 1) ss += shfl_xor_l(ss, o, lane);
        if (lane == 0) SS[m] = (unsigned long long)(ss * 16777216.0f); }
}
__device__ __forceinline__ void ph_final(const Args& a) {
    const float* X = (const float*)(a.ws + WS_X); const float* g = a.in[I_NFIN];
    int tx_ = TID(); asm volatile("" : "+v"(tx_));
    const int lane = tx_ & 63, wv = blockIdx.x * (NTHREADS >> 6) + (tx_ >> 6), nwv = gridDim.x * (NTHREADS >> 6);
    f32x4_t gv[4];
#pragma unroll
    for (int i = 0; i < 4; ++i) gv[i] = *(const f32x4_t*)(g + (i * 64 + lane) * 4);
    for (int m = wv; m < MT; m += nwv) { f32x4_t xv[4]; float ss = 0.f;
#pragma unroll
        for (int i = 0; i < 4; ++i) { xv[i] = *(const f32x4_t*)(X + (size_t)m * D + (i * 64 + lane) * 4); ss += xv[i][0] * xv[i][0] + xv[i][1] * xv[i][1] + xv[i][2] * xv[i][2] + xv[i][3] * xv[i][3]; }
#pragma unroll
        for (int o = 32; o >= 1; o >>= 1) ss += shfl_xor_l(ss, o, lane);
        const float r = FRSQ(ss * (1.0f / D) + EPS);
        float* orow = a.out + (m < MP ? O_YP + (size_t)m * D : O_YS + (size_t)(m - MP) * D);
#pragma unroll
        for (int i = 0; i < 4; ++i) *(f32x4_t*)(orow + (i * 64 + lane) * 4) = xv[i] * r * gv[i]; }
}


#ifndef DIAG_WRITE_O
#define DIAG_WRITE_O 1
#define DIAG_WRITE_S 1
#endif
typedef short bf16x8_t __attribute__((ext_vector_type(8)));
typedef unsigned u32x2_t __attribute__((ext_vector_type(2)));
typedef unsigned u32x4_t __attribute__((ext_vector_type(4)));
typedef float f32x2_t __attribute__((ext_vector_type(2)));
typedef __bf16 bf16x2n_t __attribute__((ext_vector_type(2)));
__device__ __forceinline__ unsigned pk_bf16(float lo, float hi) { const f32x2_t v = {lo, hi}; const bf16x2n_t r = __builtin_convertvector(v, bf16x2n_t); return __builtin_bit_cast(unsigned, r); }
__device__ __forceinline__ void ph_dn_b(const Args& a, int r, LAS unsigned char* lds) {
    const float* UT = (const float*)(a.ws + WS_UT); const bf16* WN = (const bf16*)(a.ws + WS_WN); const bf16* QG = (const bf16*)(a.ws + WS_QG); const bf16* AT = (const bf16*)(a.ws + WS_AT);
    const bf16* KDT = (const bf16*)(a.ws + WS_KDT); const float* GL = (const float*)(a.ws + WS_GL); float* ODN = (float*)(a.ws + WS_ODN); float* DUMP = (float*)(a.ws + WS_SCR);
    int tid_ = TID(); asm volatile("" : "+v"(tid_));
    const int tid = tid_, wid = __builtin_amdgcn_readfirstlane(tid >> 6), lane = tid & 63, fr = lane & 15, fq = lane >> 4;
    constexpr int STS = 136, VTS = 72;
    LAS bf16* ST = (LAS bf16*)lds; LAS bf16* VT = (LAS bf16*)(lds + 16 * STS * 2);
    const bool vw = wid < 4; const float uf = vw ? 1.0f : 0.0f;
    for (int unit = blockIdx.x; unit < NB * DNH * 8; unit += gridDim.x) {
        const int slice = unit & 7, bh = unit >> 3, b = bh / DNH, hd = bh % DNH, c0 = slice * 16;
        f32x4_t accS = {0.f, 0.f, 0.f, 0.f};
        for (int i = tid; i < 16 * STS; i += NTHREADS) ST[i] = (bf16)0;
        __syncthreads();
        const int i0 = (wid & 3) * 16;
        const bf16* p1 = (vw ? WN : QG) + (size_t)bh * NC * 8192 + (size_t)((wid & 3) * 4) * 512 + lane * 8;
        const bf16* p2 = AT + (size_t)bh * NC * 4096 + (size_t)((wid & 3) * 2) * 512 + lane * 8;
        const bf16* p3 = KDT + (size_t)bh * NC * 8192 + (size_t)(wid * 2) * 512 + lane * 8;
        const float* pu = UT + (size_t)bh * NC * 8192 + (size_t)(slice * 4 + (wid & 3)) * 256 + lane * 4; const float* pg = GL + (size_t)bh * NC;
        LAS bf16* vtw = VT + (vw ? 0 : 16 * VTS) + fr * VTS + i0 + 4 * fq;
        float* op = (vw ? DUMP + ((size_t)blockIdx.x * NTHREADS + tid) * 4 - (size_t)0 : ODN + ((size_t)b * SEQ + i0 + 4 * fq) * 512 + hd * 128 + c0 + fr);
        const size_t ostep = vw ? 0 : (size_t)64 * 512, oq = vw ? 1 : 512;
        bf16x8_t s0a1[4], s0a2[2], s0a3[2], s1a1[4], s1a2[2], s1a3[2], s2a1[4], s2a2[2], s2a3[2]; f32x4_t s0u, s1u, s2u; float s0g, s1g, s2g;
#define DNB_LOAD(P_, n_) do { const size_t c_ = (size_t)((n_) < NC ? (n_) : NC - 1); \
            _Pragma("unroll") for (int ks = 0; ks < 4; ++ks) P_##a1[ks] = *(const bf16x8_t*)(p1 + c_ * 8192 + ks * 512); \
            _Pragma("unroll") for (int ks = 0; ks < 2; ++ks) { P_##a2[ks] = *(const bf16x8_t*)(p2 + c_ * 4096 + ks * 512); P_##a3[ks] = *(const bf16x8_t*)(p3 + c_ * 8192 + ks * 512); } \
            P_##u = *(const f32x4_t*)(pu + c_ * 8192); P_##g = pg[c_]; } while (0)
#define DNB_BAR() do { asm volatile("s_waitcnt lgkmcnt(0)" ::: "memory"); __builtin_amdgcn_s_barrier(); asm volatile("" ::: "memory"); } while (0)
#define DNB_STEP(C_, L_, n_) do { f32x4_t acc = C_##u * uf; const float gl = C_##g; bf16x8_t x1[4], x2[2], x3[2]; \
            _Pragma("unroll") for (int ks = 0; ks < 4; ++ks) x1[ks] = C_##a1[ks]; \
            _Pragma("unroll") for (int ks = 0; ks < 2; ++ks) { x2[ks] = C_##a2[ks]; x3[ks] = C_##a3[ks]; } \
            DNB_LOAD(L_, (n_) + 2); \
            bf16x8_t bS[4]; \
            _Pragma("unroll") for (int ks = 0; ks < 4; ++ks) bS[ks] = *(const LAS bf16x8_t*)(ST + fr * STS + ks * 32 + fq * 8); \
            _Pragma("unroll") for (int ks = 0; ks < 4; ++ks) acc = __builtin_amdgcn_mfma_f32_16x16x32_bf16(x1[ks], bS[ks], acc, 0, 0, 0); \
            { u32x2_t w; w.x = pk_bf16(acc[0], acc[1]); w.y = pk_bf16(acc[2], acc[3]); *(LAS u32x2_t*)vtw = w; } \
            DNB_BAR(); \
            bf16x8_t bV[2]; \
            _Pragma("unroll") for (int ks = 0; ks < 2; ++ks) bV[ks] = *(const LAS bf16x8_t*)(VT + fr * VTS + ks * 32 + fq * 8); \
            _Pragma("unroll") for (int ks = 0; ks < 2; ++ks) acc = __builtin_amdgcn_mfma_f32_16x16x32_bf16(x2[ks], bV[ks], acc, 0, 0, 0); \
            { float* o_ = op + (size_t)(n_) * ostep; _Pragma("unroll") for (int q = 0; q < 4; ++q) o_[(size_t)q * oq] = acc[q]; } \
            accS = accS * gl; \
            _Pragma("unroll") for (int ks = 0; ks < 2; ++ks) accS = __builtin_amdgcn_mfma_f32_16x16x32_bf16(x3[ks], bV[ks], accS, 0, 0, 0); \
            { u32x2_t w; w.x = pk_bf16(accS[0], accS[1]); w.y = pk_bf16(accS[2], accS[3]); *(LAS u32x2_t*)(ST + fr * STS + wid * 16 + 4 * fq) = w; } \
            DNB_BAR(); } while (0)
        static_assert(NC % 3 == 2, "the chunk loop is peeled for NC = 3 k + 2");
        DNB_LOAD(s0, 0); DNB_LOAD(s1, 1);
        int n = 0;
        for (; n + 2 < NC; n += 3) { DNB_STEP(s0, s2, n); DNB_STEP(s1, s0, n + 1); DNB_STEP(s2, s1, n + 2); }
        DNB_STEP(s0, s2, n); DNB_STEP(s1, s0, n + 1);
#undef DNB_STEP
#undef DNB_LOAD
        float* sp = a.out + O_SP + ((((size_t)r * NB + b) * DNH + hd) * 128 + wid * 16 + 4 * fq) * 128 + c0 + fr;
#pragma unroll
        for (int q = 0; q < 4; ++q) sp[(size_t)q * 128] = accS[q];
        __syncthreads();
    }
}


template <int NREG> __device__ __forceinline__ void select_row(const float* __restrict__ row, int n, int K, int* __restrict__ out, unsigned lane, LAS unsigned* cand_lds) {
    static_assert(NREG * 64 <= SLD, "row buffer too short");
    lane &= 63u;
    unsigned key[NREG];
#pragma unroll
    for (int i = 0; i < NREG; ++i) { const float f = __builtin_nontemporal_load(row + i * 64u + lane); key[i] = fkey(f) & (0u - ((unsigned)((int)(i * 64u + lane) - n) >> 31)); }
    if (NREG >= 32 && n >= 1024) { unsigned ls = 0u;
        for (int bit = 31; bit >= 0; --bit) { const unsigned cand = ls | (1u << bit); int c = 0;
#pragma unroll
            for (int i = 0; i < NREG; i += 8) c += __builtin_popcountll(__ballot(key[i] >= cand));
            if (c >= 48) ls = cand;
            if (c == 48) break; }
        int c0 = 0;
#pragma unroll
        for (int i = 0; i < NREG; ++i) c0 += __builtin_popcountll(__ballot(key[i] >= ls));
        if (c0 >= K && c0 <= 512) {
            asm volatile("" : "+v"(lane)); lane &= 63u; const unsigned long long bl = (1ull << lane) - 1ull; int base = 0;
            unsigned ls2 = ls; asm volatile("" : "+v"(ls2));
#pragma unroll
            for (int i = 0; i < NREG; ++i) { const bool g = key[i] >= ls2; const unsigned long long mg = __ballot(g);
                const int p = base + __builtin_popcountll(mg & bl); cand_lds[g ? (unsigned)p : 1024u + lane] = key[i]; cand_lds[g ? 512u + p : 1088u + lane] = i * 64u + lane;
                base += __builtin_popcountll(mg); }
            asm volatile("s_waitcnt lgkmcnt(0)" ::: "memory");
            unsigned ck[8], ci[8];
#pragma unroll
            for (int q = 0; q < 8; ++q) { const int p = q * 64 + (int)lane; const bool v = p < c0; ck[q] = v ? cand_lds[p] : 0u; ci[q] = v ? cand_lds[512 + p] : 0u; }
            unsigned lo2 = 0u;
            for (int bit = 31; bit >= 0; --bit) { const unsigned cand = lo2 | (1u << bit); int c = 0;
#pragma unroll
                for (int q = 0; q < 8; ++q) c += __builtin_popcountll(__ballot(ck[q] >= cand));
                if (c >= K) lo2 = cand;
                if (c == K) break; }
            int bg2 = 0;
#pragma unroll
            for (int q = 0; q < 8; ++q) { const bool g = ck[q] > lo2; const unsigned long long mg = __ballot(g);
                out[g ? (unsigned)(bg2 + __builtin_popcountll(mg & bl)) : KMAX + lane] = (int)ci[q]; bg2 += __builtin_popcountll(mg); }
            int be2 = 0;
#pragma unroll
            for (int q = 0; q < 8; ++q) { const bool e = ck[q] == lo2; const unsigned long long me = __ballot(e); const int slot = bg2 + be2 + __builtin_popcountll(me & bl);
                out[(e && slot < K) ? (unsigned)slot : KMAX + lane] = (int)ci[q]; be2 += __builtin_popcountll(me); }
            asm volatile("s_waitcnt lgkmcnt(0)" ::: "memory");
            return; } }
    unsigned lo = 0u;
    for (int bit = 31; bit >= 0; --bit) { const unsigned cand = lo | (1u << bit); int c = 0;
#pragma unroll
        for (int i = 0; i < NREG; ++i) c += __builtin_popcountll(__ballot(key[i] >= cand));
        if (c >= K) lo = cand;
        if (c == K) break; }
    asm volatile("" : "+v"(lane)); lane &= 63u;
    const unsigned long long below = (1ull << lane) - 1ull; int bg = 0;
#pragma unroll
    for (int i = 0; i < NREG; ++i) { const bool g = key[i] > lo; const unsigned long long mg = __ballot(g);
        out[g ? (unsigned)(bg + __builtin_popcountll(mg & below)) : KMAX + lane] = (int)(i * 64u + lane); bg += __builtin_popcountll(mg); }
    const int cg = bg; int be = 0; asm volatile("" : "+v"(lane)); lane &= 63u; const unsigned long long below2 = (1ull << lane) - 1ull;
#pragma unroll
    for (int i = 0; i < NREG; ++i) { const bool e = key[i] == lo; const unsigned long long me = __ballot(e); const int slot = cg + be + __builtin_popcountll(me & below2);
        out[(e && slot < K) ? (unsigned)slot : KMAX + lane] = (int)(i * 64u + lane); be += __builtin_popcountll(me); }
}
__device__ __forceinline__ void ph_select_w(const Args& a, LAS unsigned char* lds) {
    const float* SC = (const float*)(a.ws + WS_SCT); int* IDX = (int*)(a.ws + WS_IDX); int* NSEL = (int*)(a.ws + WS_NSEL);
    int tx_ = TID(); asm volatile("" : "+v"(tx_));
    const int lane0 = tx_ & 63, wv = __builtin_amdgcn_readfirstlane(blockIdx.x * (NTHREADS >> 6) + (tx_ >> 6)), nwv = gridDim.x * (NTHREADS >> 6);
    LAS unsigned* cand = (LAS unsigned*)(lds + (tx_ >> 6) * 4608);
    for (int m = MP + wv; m < MT; m += nwv) { const RowInfo ri = row_info(m); int lane = lane0; asm volatile("" : "+v"(lane));
        const int n = PAST + ri.t + 1, K = TOPK_S; const float* row = SC + (size_t)m * SLD; int* out = IDX + (size_t)m * KROW;
        if (n <= K) { for (int j = lane; j < n; j += 64) out[j] = j; if (lane == 0) NSEL[m] = n; continue; }
        select_row<(SLD / 64)>(row, n, K, out, lane, cand);
        if (lane == 0) NSEL[m] = K; }
}


__device__ __forceinline__ void ph_att_split_dev(const Args& a, int ai, size_t gtid, size_t gsz) {
    const float* P = (const float*)(a.ws + WS_P); bf16* QB = (bf16*)(a.ws + WS_XN); bf16* KB = (bf16*)(a.ws + WS_KB); bf16* VB = (bf16*)(a.ws + WS_VB); bf16* QIB = (bf16*)(a.ws + WS_QIB); bf16* KIB = (bf16*)(a.ws + WS_KIB);
    constexpr int W = AO_WI;
    for (size_t i = gtid; i < (size_t)MT * W; i += gsz) { const int m = (int)(i / W), c = (int)(i % W); const float v = P[(size_t)m * LDP + c];
        if (c < AO_K) QB[(size_t)m * D + c] = f2bf(v);
        else if (c < AO_V) { const int cc = c - AO_K; KB[(size_t)m * 256 + cc] = f2bf(v); if (m < MP) a.out[O_KP + ((size_t)ai * MP + m) * 256 + cc] = v; else a.out[O_KS + ((size_t)ai * MS + (m - MP)) * 256 + cc] = v; }
        else if (c < AO_QI) { const int cc = c - AO_V; VB[(size_t)m * 256 + cc] = f2bf(v); if (m < MP) a.out[O_VP + ((size_t)ai * MP + m) * 256 + cc] = v; else a.out[O_VS + ((size_t)ai * MS + (m - MP)) * 256 + cc] = v; }
        else if (c < AO_KI) QIB[(size_t)m * 512 + (c - AO_QI)] = f2bf(v);
        else { const int cc = c - AO_KI; KIB[(size_t)m * 64 + cc] = f2bf(v); if (m < MP) a.out[O_KIP + ((size_t)ai * MP + m) * 64 + cc] = v; else a.out[O_KIS + ((size_t)ai * MS + (m - MP)) * 64 + cc] = v; } }
}
__device__ __forceinline__ void ph_idx_mfma(const Args& a, LAS unsigned char* lds) {
    const float* P = (const float*)(a.ws + WS_P); const bf16* QIB = (const bf16*)(a.ws + WS_QIB); const bf16* KIB = (const bf16*)(a.ws + WS_KIB); float* SC = (float*)(a.ws + WS_SCT); int* IDX = (int*)(a.ws + WS_IDX); int* NSEL = (int*)(a.ws + WS_NSEL);
    int tx_ = TID(); asm volatile("" : "+v"(tx_));
    const int lane = tx_ & 63, fr = lane & 15, fq = lane >> 4, wv = __builtin_amdgcn_readfirstlane(blockIdx.x * (NTHREADS >> 6) + (tx_ >> 6)), nwv = gridDim.x * (NTHREADS >> 6);
    constexpr int NU = MP / 4;
    for (int pr2 = wv * 2; pr2 < NU; pr2 += nwv * 2) for (int u0 = pr2; u0 < pr2 + 2; ++u0) { const int hh = u0 >> 1, u = (u0 & 1) ? (NU - 1 - hh) : hh;
        const int m0 = u * 4, b = m0 / SEQ, t0 = m0 % SEQ;
        int lnu = lane; asm volatile("" : "+v"(lnu)); const int fr = lnu & 15, fq = (lnu >> 4) & 3;
        bf16x8_t aQ[2][2];
#pragma unroll
        for (int p = 0; p < 2; ++p)
#pragma unroll
            for (int ks = 0; ks < 2; ++ks) aQ[p][ks] = *(const bf16x8_t*)(QIB + (size_t)(m0 + (fr >> 2)) * 512 + (4 * p + (fr & 3)) * 64 + ks * 32 + fq * 8);
        const f32x4_t w0 = *(const f32x4_t*)(P + (size_t)(m0 + fq) * LDP + AO_WI), w1 = *(const f32x4_t*)(P + (size_t)(m0 + fq) * LDP + AO_WI + 4);
        float* scrow = SC + (size_t)(m0 + fq) * SLD + fr;
        const int nkt = (t0 + 3) / 16 + 1;
        bf16x8_t bKa[4][2], bKb[4][2];
#define IDX_LOAD(B_, kt0_) do { _Pragma("unroll") for (int q = 0; q < 4; ++q) { const int kt = (kt0_) + q < nkt ? (kt0_) + q : nkt - 1; const bf16* kr = KIB + ((size_t)b * (SEQ / 16) + kt) * 1024 + lnu * 8; \
            B_[q][0] = *(const bf16x8_t*)kr; B_[q][1] = *(const bf16x8_t*)(kr + 512); } } while (0)
#define IDX_COMP(B_, kt0_) do { _Pragma("unroll") for (int q = 0; q < 4; ++q) { if ((kt0_) + q < nkt) { f32x4_t c0 = {0.f, 0.f, 0.f, 0.f}, c1 = {0.f, 0.f, 0.f, 0.f}; \
                    c0 = __builtin_amdgcn_mfma_f32_16x16x32_bf16(aQ[0][0], B_[q][0], c0, 0, 0, 0); c0 = __builtin_amdgcn_mfma_f32_16x16x32_bf16(aQ[0][1], B_[q][1], c0, 0, 0, 0); \
                    c1 = __builtin_amdgcn_mfma_f32_16x16x32_bf16(aQ[1][0], B_[q][0], c1, 0, 0, 0); c1 = __builtin_amdgcn_mfma_f32_16x16x32_bf16(aQ[1][1], B_[q][1], c1, 0, 0, 0); \
                    __builtin_nontemporal_store((w0[0] * fmaxf(c0[0], 0.f) + w0[1] * fmaxf(c0[1], 0.f)) + (w0[2] * fmaxf(c0[2], 0.f) + w0[3] * fmaxf(c0[3], 0.f)) \
                                             + (w1[0] * fmaxf(c1[0], 0.f) + w1[1] * fmaxf(c1[1], 0.f)) + (w1[2] * fmaxf(c1[2], 0.f) + w1[3] * fmaxf(c1[3], 0.f)), scrow + ((kt0_) + q) * 16); } } } while (0)
        IDX_LOAD(bKa, 0);
        for (int kt0 = 0; kt0 < nkt; kt0 += 8) { IDX_LOAD(bKb, kt0 + 4); IDX_COMP(bKa, kt0); IDX_LOAD(bKa, kt0 + 8); IDX_COMP(bKb, kt0 + 4); }
#undef IDX_LOAD
#undef IDX_COMP
        LAS unsigned* cand = (LAS unsigned*)(lds + (tx_ >> 6) * 4608);
        for (int q = 0; q < 4; ++q) { const int m = m0 + q, n = t0 + q + 1, K = TOPK_P; int ln = lane; asm volatile("" : "+v"(ln));
            const float* row = SC + (size_t)m * SLD; int* out = IDX + (size_t)m * KROW;
            if (n <= K) { for (int j = ln; j < n; j += 64) out[j] = j; if (ln == 0) NSEL[m] = n; continue; }
            if (n <= 2048) select_row<32>(row, n, K, out, ln, cand);
            else if (n <= 4096) select_row<64>(row, n, K, out, ln, cand);
            else if (n <= 6144) select_row<96>(row, n, K, out, ln, cand);
            else select_row<128>(row, n, K, out, ln, cand);
            if (ln == 0) NSEL[m] = K; }
    }
}
__device__ __forceinline__ void ph_idx_sample_mfma(const Args& a, int ai) {
    const float* P = (const float*)(a.ws + WS_P); const bf16* QIB = (const bf16*)(a.ws + WS_QIB); float* SC = (float*)(a.ws + WS_SCT); const int* PT = (const int*)a.in[I_PT]; const float* CKI = a.in[I_CKI];
    int tx_ = TID(); asm volatile("" : "+v"(tx_));
    const int lane = tx_ & 63, fr = lane & 15, fq = lane >> 4, wv = __builtin_amdgcn_readfirstlane(blockIdx.x * (NTHREADS >> 6) + (tx_ >> 6)), nwv = gridDim.x * (NTHREADS >> 6);
    constexpr int NKT = (PAST + DT + 15) / 16, SPL = 64, TPU = (NKT + SPL - 1) / SPL;
    static_assert(PAGE % 16 == 0 && PAST % 16 == 0 && DT <= 16, "sample index tiles");
    for (int u = wv; u < DB * SPL; u += nwv) { const int db = u / SPL, k0 = (u % SPL) * TPU, k1 = (k0 + TPU < NKT) ? k0 + TPU : NKT; const int m0 = MP + db * DT;
        if (k0 >= k1) continue;
        bf16x8_t aQ[2][2];
#pragma unroll
        for (int p = 0; p < 2; ++p)
#pragma unroll
            for (int ks = 0; ks < 2; ++ks) aQ[p][ks] = *(const bf16x8_t*)(QIB + (size_t)(m0 + (fr >> 2)) * 512 + (4 * p + (fr & 3)) * 64 + ks * 32 + fq * 8);
        const f32x4_t w0 = *(const f32x4_t*)(P + (size_t)(m0 + fq) * LDP + AO_WI), w1 = *(const f32x4_t*)(P + (size_t)(m0 + fq) * LDP + AO_WI + 4);
        float* scrow = SC + (size_t)(m0 + fq) * SLD + fr;
        for (int kb = k0; kb < k1; kb += 3) { f32x4_t kf[3][4];
#pragma unroll
            for (int q = 0; q < 3; ++q) { const int kt = kb + q < k1 ? kb + q : k1 - 1, s0 = kt * 16; const float* kr;
                if (s0 < PAST) { const int pg = PT[db * NPAGES + s0 / PAGE]; kr = CKI + (((size_t)ai * NPOOL + pg) * PAGE + (s0 % PAGE) + fr) * IDIM + fq * 8; }
                else kr = P + (size_t)(m0 + (fr < DT ? fr : DT - 1)) * LDP + AO_KI + fq * 8;
                kf[q][0] = *(const f32x4_t*)kr; kf[q][1] = *(const f32x4_t*)(kr + 4); kf[q][2] = *(const f32x4_t*)(kr + 32); kf[q][3] = *(const f32x4_t*)(kr + 36); }
#pragma unroll
            for (int q = 0; q < 3; ++q) { if (kb + q < k1) { const int s0 = (kb + q) * 16; u32x4_t b0, b1;
                b0[0] = pk_bf16(kf[q][0][0], kf[q][0][1]); b0[1] = pk_bf16(kf[q][0][2], kf[q][0][3]); b0[2] = pk_bf16(kf[q][1][0], kf[q][1][1]); b0[3] = pk_bf16(kf[q][1][2], kf[q][1][3]);
                b1[0] = pk_bf16(kf[q][2][0], kf[q][2][1]); b1[1] = pk_bf16(kf[q][2][2], kf[q][2][3]); b1[2] = pk_bf16(kf[q][3][0], kf[q][3][1]); b1[3] = pk_bf16(kf[q][3][2], kf[q][3][3]);
                const bf16x8_t bK0 = __builtin_bit_cast(bf16x8_t, b0), bK1 = __builtin_bit_cast(bf16x8_t, b1);
                f32x4_t c0 = {0.f, 0.f, 0.f, 0.f}, c1 = {0.f, 0.f, 0.f, 0.f};
                c0 = __builtin_amdgcn_mfma_f32_16x16x32_bf16(aQ[0][0], bK0, c0, 0, 0, 0); c0 = __builtin_amdgcn_mfma_f32_16x16x32_bf16(aQ[0][1], bK1, c0, 0, 0, 0);
                c1 = __builtin_amdgcn_mfma_f32_16x16x32_bf16(aQ[1][0], bK0, c1, 0, 0, 0); c1 = __builtin_amdgcn_mfma_f32_16x16x32_bf16(aQ[1][1], bK1, c1, 0, 0, 0);
                scrow[s0] = (w0[0] * fmaxf(c0[0], 0.f) + w0[1] * fmaxf(c0[1], 0.f)) + (w0[2] * fmaxf(c0[2], 0.f) + w0[3] * fmaxf(c0[3], 0.f))
                          + (w1[0] * fmaxf(c1[0], 0.f) + w1[1] * fmaxf(c1[1], 0.f)) + (w1[2] * fmaxf(c1[2], 0.f) + w1[3] * fmaxf(c1[3], 0.f)); } } } }
}

__device__ __forceinline__ void ph_sparse_attn(const Args& a, LAS unsigned char* lds) {
    const bf16* QB = (const bf16*)(a.ws + WS_QB); const bf16* KB = (const bf16*)(a.ws + WS_KB); const bf16* VB = (const bf16*)(a.ws + WS_VB); const int* IDX = (const int*)(a.ws + WS_IDX); const int* NSEL = (const int*)(a.ws + WS_NSEL);
    bf16* O = (bf16*)(a.ws + WS_Y2);
    int tx_ = TID(); asm volatile("" : "+v"(tx_));
    const int lane = tx_ & 63, fr = lane & 15, fq = lane >> 4, wid = __builtin_amdgcn_readfirstlane(tx_ >> 6), wv = blockIdx.x * (NTHREADS >> 6) + wid, nwv = gridDim.x * (NTHREADS >> 6);
    LAS int* IDXS = (LAS int*)(lds + wid * 9216); LAS float* PS = (LAS float*)(lds + wid * 9216 + 1024);
    for (int m = wv; m < MP; m += nwv) { const int b = m / SEQ; const int ns = __builtin_amdgcn_readfirstlane(NSEL[m]);
#pragma unroll
        for (int c = 0; c < 4; ++c) { const int j = lane + 64 * c; IDXS[j] = j < ns ? IDX[(size_t)m * KROW + j] : 0; }
        bf16x8_t bQ[2][4];
#pragma unroll
        for (int kv = 0; kv < 2; ++kv)
#pragma unroll
            for (int ks = 0; ks < 4; ++ks) { bQ[kv][ks] = (bf16x8_t){0, 0, 0, 0, 0, 0, 0, 0}; if (fr < 4) bQ[kv][ks] = *(const bf16x8_t*)(QB + (size_t)m * D + (kv * 4 + fr) * 128 + ks * 32 + fq * 8); }
        asm volatile("s_waitcnt lgkmcnt(0)" ::: "memory");
#pragma unroll
        for (int tb = 0; tb < 16; tb += 2) { bf16x8_t ak[2][2][4];
#pragma unroll
            for (int t = 0; t < 2; ++t) { const int ri = IDXS[(tb + t) * 16 + fr]; const bf16* kb = KB + (size_t)(b * SEQ + ri) * 256 + fq * 8;
#pragma unroll
                for (int kv = 0; kv < 2; ++kv)
#pragma unroll
                    for (int ks = 0; ks < 4; ++ks) ak[t][kv][ks] = *(const bf16x8_t*)(kb + kv * 128 + ks * 32); }
#pragma unroll
            for (int t = 0; t < 2; ++t)
#pragma unroll
                for (int kv = 0; kv < 2; ++kv) { f32x4_t acc = {0.f, 0.f, 0.f, 0.f};
#pragma unroll
                    for (int ks = 0; ks < 4; ++ks) acc = __builtin_amdgcn_mfma_f32_16x16x32_bf16(ak[t][kv][ks], bQ[kv][ks], acc, 0, 0, 0);
                    if (fr < 4) {
#pragma unroll
                        for (int q = 0; q < 4; ++q) { const int j = (tb + t) * 16 + 4 * fq + q; PS[j * 8 + kv * 4 + fr] = j < ns ? acc[q] * 0.08838834764831845f : -1e30f; } } } }
        asm volatile("s_waitcnt lgkmcnt(0)" ::: "memory");
        { f32x4_t sv[4][2]; float mx[8];
#pragma unroll
            for (int h = 0; h < 8; ++h) mx[h] = -3e38f;
#pragma unroll
            for (int c = 0; c < 4; ++c) { sv[c][0] = *(const LAS f32x4_t*)(PS + (lane + 64 * c) * 8); sv[c][1] = *(const LAS f32x4_t*)(PS + (lane + 64 * c) * 8 + 4);
#pragma unroll
                for (int h = 0; h < 8; ++h) mx[h] = fmaxf(mx[h], sv[c][h >> 2][h & 3]); }
#pragma unroll
            for (int o = 32; o >= 1; o >>= 1)
#pragma unroll
                for (int h = 0; h < 8; ++h) mx[h] = fmaxf(mx[h], shfl_xor_l(mx[h], o, lane));
            float sum[8];
#pragma unroll
            for (int h = 0; h < 8; ++h) sum[h] = 0.f;
#pragma unroll
            for (int c = 0; c < 4; ++c)
#pragma unroll
                for (int h = 0; h < 8; ++h) { const float e = FEXP(sv[c][h >> 2][h & 3] - mx[h]); sv[c][h >> 2][h & 3] = e; sum[h] += e; }
#pragma unroll
            for (int o = 32; o >= 1; o >>= 1)
#pragma unroll
                for (int h = 0; h < 8; ++h) sum[h] += shfl_xor_l(sum[h], o, lane);
#pragma unroll
            for (int h = 0; h < 8; ++h) sum[h] = FRCP(sum[h]);
#pragma unroll
            for (int c = 0; c < 4; ++c) { f32x4_t p0, p1;
#pragma unroll
                for (int h = 0; h < 4; ++h) { p0[h] = sv[c][0][h] * sum[h]; p1[h] = sv[c][1][h] * sum[4 + h]; }
                *(LAS f32x4_t*)(PS + (lane + 64 * c) * 8) = p0; *(LAS f32x4_t*)(PS + (lane + 64 * c) * 8 + 4) = p1; } }
        asm volatile("s_waitcnt lgkmcnt(0)" ::: "memory");
        f32x4_t o4[4] = {{0.f, 0.f, 0.f, 0.f}, {0.f, 0.f, 0.f, 0.f}, {0.f, 0.f, 0.f, 0.f}, {0.f, 0.f, 0.f, 0.f}};
        const int kvl = lane >> 5; const char* vb8 = (const char*)(VB + (size_t)b * SEQ * 256);
        const unsigned loff = (unsigned)(kvl * 128 + (lane & 31) * 4) * 2u;
        for (int j0 = 0; j0 < ns; j0 += 32) { u32x2_t vv[32];
#pragma unroll
            for (int jj = 0; jj < 32; ++jj) { const unsigned off = (unsigned)IDXS[j0 + jj] * 512u + loff; vv[jj] = *(const u32x2_t*)(vb8 + off); }
#pragma unroll
            for (int jj = 0; jj < 32; ++jj) { const f32x4_t p4 = *(const LAS f32x4_t*)(PS + (j0 + jj) * 8 + kvl * 4);
                const f32x4_t vf = {__builtin_bit_cast(float, vv[jj][0] << 16), __builtin_bit_cast(float, vv[jj][0] & 0xffff0000u), __builtin_bit_cast(float, vv[jj][1] << 16), __builtin_bit_cast(float, vv[jj][1] & 0xffff0000u)};
#pragma unroll
                for (int h = 0; h < 4; ++h) o4[h] += vf * p4[h]; } }
#pragma unroll
        for (int h = 0; h < 4; ++h) { u32x2_t w; w[0] = pk_bf16(o4[h][0], o4[h][1]); w[1] = pk_bf16(o4[h][2], o4[h][3]); *(u32x2_t*)(O + (size_t)m * D + (kvl * 4 + h) * 128 + (lane & 31) * 4) = w; }
        asm volatile("s_waitcnt lgkmcnt(0)" ::: "memory");
    }
}

__device__ __forceinline__ void ph_sparse_sample(const Args& a, int ai, LAS unsigned char* lds) {
    const float* P = (const float*)(a.ws + WS_P); const int* IDX = (const int*)(a.ws + WS_IDX); const int* NSEL = (const int*)(a.ws + WS_NSEL); bf16* O = (bf16*)(a.ws + WS_Y2);
    int tx_ = TID(); asm volatile("" : "+v"(tx_));
    const int lane = tx_ & 63, wid = __builtin_amdgcn_readfirstlane(tx_ >> 6), wv = blockIdx.x * (NTHREADS >> 6) + wid, nwv = gridDim.x * (NTHREADS >> 6);
    LAS float* QS = (LAS float*)(lds + wid * 9216); LAS float* PSs = (LAS float*)(lds + wid * 9216 + 512); LAS unsigned long long* VP = (LAS unsigned long long*)(lds + wid * 9216 + 1536);
    for (int u = wv; u < MS * AH; u += nwv) { const int m = MP + u / AH, h = u % AH, kvh = h / GROUP; const RowInfo ri = row_info(m); const int ns = __builtin_amdgcn_readfirstlane(NSEL[m]);
        { const f32x2_t q2 = *(const f32x2_t*)(P + (size_t)m * LDP + h * HDIM + 2 * lane); QS[2 * lane] = q2[0]; QS[2 * lane + 1] = q2[1]; }
        const float* kp[4];
#pragma unroll
        for (int c = 0; c < 4; ++c) { const int j = lane + 64 * c; const int idx = j < ns ? IDX[(size_t)m * KROW + j] : 0; kp[c] = kv_row(a, ai, ri, idx, kvh, false); VP[j] = (unsigned long long)(size_t)kv_row(a, ai, ri, idx, kvh, true); }
        asm volatile("s_waitcnt lgkmcnt(0)" ::: "memory");
        float sc[4] = {0.f, 0.f, 0.f, 0.f};
        for (int d0 = 0; d0 < HDIM; d0 += 16) { f32x4_t kq[4][4];
#pragma unroll
            for (int e = 0; e < 4; ++e)
#pragma unroll
                for (int c = 0; c < 4; ++c) kq[e][c] = *(const f32x4_t*)(kp[c] + d0 + 4 * e);
#pragma unroll
            for (int e = 0; e < 4; ++e) { const f32x4_t q4 = *(const LAS f32x4_t*)(QS + d0 + 4 * e);
#pragma unroll
                for (int c = 0; c < 4; ++c) sc[c] += (kq[e][c][0] * q4[0] + kq[e][c][1] * q4[1]) + (kq[e][c][2] * q4[2] + kq[e][c][3] * q4[3]); } }
        float mx = -3e38f;
#pragma unroll
        for (int c = 0; c < 4; ++c) { sc[c] = (lane + 64 * c) < ns ? sc[c] * 0.08838834764831845f : -1e30f; mx = fmaxf(mx, sc[c]); }
#pragma unroll
        for (int o = 32; o >= 1; o >>= 1) mx = fmaxf(mx, shfl_xor_l(mx, o, lane));
        float sum = 0.f;
#pragma unroll
        for (int c = 0; c < 4; ++c) { sc[c] = FEXP(sc[c] - mx); sum += sc[c]; }
#pragma unroll
        for (int o = 32; o >= 1; o >>= 1) sum += shfl_xor_l(sum, o, lane);
        const float inv = FRCP(sum);
#pragma unroll
        for (int c = 0; c < 4; ++c) PSs[lane + 64 * c] = sc[c] * inv;
        asm volatile("s_waitcnt lgkmcnt(0)" ::: "memory");
        f32x2_t o2 = {0.f, 0.f};
        for (int j0 = 0; j0 < ns; j0 += 16) { f32x2_t vv[16];
#pragma unroll
            for (int jj = 0; jj < 16; ++jj) { const float* vp = (const float*)(size_t)VP[j0 + jj]; vv[jj] = *(const f32x2_t*)(vp + 2 * lane); }
#pragma unroll
            for (int jj = 0; jj < 16; ++jj) o2 += vv[jj] * PSs[j0 + jj]; }
        *(unsigned*)(O + (size_t)m * D + h * HDIM + 2 * lane) = pk_bf16(o2[0], o2[1]);
        asm volatile("s_waitcnt lgkmcnt(0)" ::: "memory");
    }
}

__device__ __forceinline__ void ph_rg_chunk(const Args& a, int r, LAS unsigned char* lds) {
    const float* P = (const float*)(a.ws + WS_P); float* HH = (float*)(a.ws + WS_HH); float* AP = (float*)(a.ws + WS_XR);
    const float* wc = a.in[I_WCONV] + (size_t)r * 4 * CONV_CH; const float* wa = a.in[I_WA] + (size_t)r * RG_HEADS * RG_BW * RG_BW; const float* wx = a.in[I_WX] + (size_t)r * RG_HEADS * RG_BW * RG_BW;
    static_assert(RG_BW == 64 && RG_HEADS == 8, "ph_rg_chunk is written for 8 gate heads of 64 channels");
    int tx_ = TID(); asm volatile("" : "+v"(tx_));
    const int lane = tx_ & 63, wid = __builtin_amdgcn_readfirstlane(tx_ >> 6), wv = blockIdx.x * (NTHREADS >> 6) + wid, nwv = gridDim.x * (NTHREADS >> 6);
    LAS float* XS = (LAS float*)(lds + wid * 16384);
    constexpr int NUP = NB * NC * 8, NU = NUP + DB * 8;
    for (int u = wv; u < NU; u += nwv) { const bool prompt = u < NUP; int hd, row0, T, n = 0, b = 0, db = 0;
        if (prompt) { const int c = u >> 3; hd = u & 7; row0 = c * 64; T = 64; n = c % NC; b = c / NC; } else { const int q = u - NUP; db = q >> 3; hd = q & 7; row0 = MP + db * DT; T = DT; }
        const int ch = hd * 64 + lane;
        const float w0 = wc[ch], w1 = wc[CONV_CH + ch], w2 = wc[2 * CONV_CH + ch], w3 = wc[3 * CONV_CH + ch], bcv = a.in[I_BCONV][(size_t)r * D_RNN + ch];
        float x3 = 0.f, x2 = 0.f, x1 = 0.f;
        if (prompt) { if (n != 0) { x3 = P[(size_t)(row0 - 3) * LDP + ch]; x2 = P[(size_t)(row0 - 2) * LDP + ch]; x1 = P[(size_t)(row0 - 1) * LDP + ch]; } }
        else { const float* sc = a.in[I_SCONV] + ((size_t)r * DB + db) * 3 * CONV_CH + ch; x3 = sc[0]; x2 = sc[CONV_CH]; x1 = sc[2 * CONV_CH]; }
        for (int tb = 0; tb < T; tb += 16) { float ub[16];
#pragma unroll
            for (int q = 0; q < 16; ++q) ub[q] = P[(size_t)(row0 + (tb + q < T ? tb + q : T - 1)) * LDP + ch];
#pragma unroll
            for (int q = 0; q < 16; ++q) { const int t = tb + q; if (t < T) { const float ut = ub[q]; XS[t * 64 + lane] = w3 * ut + w2 * x1 + w1 * x2 + w0 * x3 + bcv; x3 = x2; x2 = x1; x1 = ut;
                if (prompt) { if (n == NC - 1 && t >= 61) a.out[O_CONVP + (((size_t)r * NB + b) * 3 + (t - 61)) * CONV_CH + ch] = ut; }
                else if (t >= DT - 3) a.out[O_CONVS + (((size_t)r * DB + db) * 3 + (t - (DT - 3))) * CONV_CH + ch] = ut; } } }
        asm volatile("s_waitcnt lgkmcnt(0)" ::: "memory");
        float war[64], wxr[64];
        unsigned ln = (unsigned)lane; asm volatile("" : "+v"(ln)); ln &= 63u;
        const float* wah = wa + (size_t)hd * 4096; const float* wxh = wx + (size_t)hd * 4096;
#pragma unroll
        for (int k = 0; k < 64; ++k) { war[k] = wah[k * 64u + ln]; wxr[k] = wxh[k * 64u + ln]; }
        const float ba = a.in[I_BA][(size_t)r * D_RNN + ch], bx = a.in[I_BX][(size_t)r * D_RNN + ch], sp = softplusf_(-a.in[I_LAM][(size_t)r * D_RNN + ch]);
        float h = 0.f, ap = 1.f;
        for (int t = 0; t < T; ++t) { float pr = 0.f, pi = 0.f;
#pragma unroll
            for (int k = 0; k < 64; k += 4) { const f32x4_t x4 = *(const LAS f32x4_t*)(XS + t * 64 + k);
#pragma unroll
                for (int e = 0; e < 4; ++e) { pr += x4[e] * war[k + e]; pi += x4[e] * wxr[k + e]; } }
            const float rg = sigmoidf_(pr + ba), ig = sigmoidf_(pi + bx), log_a = -8.0f * rg * sp, av = __expf(log_a);
            const bool first = prompt && n == 0 && t == 0; const float mult = first ? 1.0f : FSQRT(fmaxf(1.0f - __expf(2.0f * log_a), 0.0f));
            float bv = XS[t * 64 + lane] * ig * mult; if (!prompt && t == 0) bv += av * a.in[I_SH][((size_t)r * DB + db) * D_RNN + ch];
            h = av * h + bv; ap *= av; const size_t o = (size_t)(row0 + t) * D_RNN + ch; HH[o] = h; AP[o] = ap; }
        if (!prompt) a.out[O_HS + ((size_t)r * DB + db) * D_RNN + ch] = h;
        asm volatile("s_waitcnt lgkmcnt(0)" ::: "memory");
    }
}
__device__ __forceinline__ void ph_dn_tok(const Args& a, int r) {
    const float* P = (const float*)(a.ws + WS_P); float* QKV = (float*)(a.ws + WS_QKV); float* QN = (float*)(a.ws + WS_QN); float* KN = (float*)(a.ws + WS_KN); float* GB = (float*)(a.ws + WS_GB); float* KNT = (float*)(a.ws + WS_KNT);
    const float* wc = a.in[I_WCONV] + (size_t)r * 4 * CONV_CH;
    int tx_ = TID(); asm volatile("" : "+v"(tx_));
    const int lane = tx_ & 63, wv = __builtin_amdgcn_readfirstlane(blockIdx.x * (NTHREADS >> 6) + (tx_ >> 6)), nwv = gridDim.x * (NTHREADS >> 6);
    constexpr int NUP = (MP / 16) * DNH, NU = NUP + DB * DNH;
    static_assert(DT == 4 && SEQ % 64 == 0, "ph_dn_tok run lengths");
    for (int u = wv; u < NU; u += nwv) { const bool prompt = u < NUP; const int hd = prompt ? (u & 3) : ((u - NUP) & 3), m0 = prompt ? (u >> 2) * 16 : MP + ((u - NUP) >> 2) * DT, T = prompt ? 16 : DT;
        const int seq = prompt ? m0 / SEQ : 0, t0 = prompt ? m0 % SEQ : 0, db = prompt ? 0 : (m0 - MP) / DT;
        f32x2_t wk[3][4], h3[3], h2[3], h1[3];
#pragma unroll
        for (int p = 0; p < 3; ++p) { const int c = D_RNN + p * 512 + hd * 128 + 2 * lane;
#pragma unroll
            for (int k = 0; k < 4; ++k) wk[p][k] = *(const f32x2_t*)(wc + (size_t)k * CONV_CH + c);
            h3[p] = h2[p] = h1[p] = (f32x2_t){0.f, 0.f};
            if (prompt) { if (t0 != 0) { h3[p] = *(const f32x2_t*)(P + (size_t)(m0 - 3) * LDP + c); h2[p] = *(const f32x2_t*)(P + (size_t)(m0 - 2) * LDP + c); h1[p] = *(const f32x2_t*)(P + (size_t)(m0 - 1) * LDP + c); } }
            else { const float* sc = a.in[I_SCONV] + ((size_t)r * DB + db) * 3 * CONV_CH + c; h3[p] = *(const f32x2_t*)sc; h2[p] = *(const f32x2_t*)(sc + CONV_CH); h1[p] = *(const f32x2_t*)(sc + 2 * CONV_CH); } }
        float gcum = 0.f;
        if (prompt) { const int tl0 = t0 & 63; float gt = lane < tl0 ? dn_g(a, r, (size_t)(m0 - tl0 + lane), hd) : 0.f;
#pragma unroll
            for (int o2 = 32; o2 >= 1; o2 >>= 1) gt += shfl_xor_l(gt, o2, lane);
            gcum = gt; }
        for (int tb = 0; tb < T; tb += 8) { f32x2_t xin[8][3];
#pragma unroll
            for (int q = 0; q < 8; ++q)
#pragma unroll
                for (int p = 0; p < 3; ++p) xin[q][p] = *(const f32x2_t*)(P + (size_t)(m0 + (tb + q < T ? tb + q : T - 1)) * LDP + D_RNN + p * 512 + hd * 128 + 2 * lane);
#pragma unroll
            for (int q = 0; q < 8; ++q) { const int t = tb + q; if (t < T) { const int m = m0 + t; f32x2_t x[3];
#pragma unroll
                for (int p = 0; p < 3; ++p) { const int c = D_RNN + p * 512 + hd * 128 + 2 * lane; const f32x2_t xv = xin[q][p];
                    const f32x2_t acc = wk[p][0] * h3[p] + wk[p][1] * h2[p] + wk[p][2] * h1[p] + wk[p][3] * xv; h3[p] = h2[p]; h2[p] = h1[p]; h1[p] = xv;
                    x[p][0] = siluf_(acc[0]); x[p][1] = siluf_(acc[1]);
                    if (prompt) { if (t0 + t >= SEQ - 3) *(f32x2_t*)(a.out + O_CONVP + (((size_t)r * NB + seq) * 3 + (t0 + t - (SEQ - 3))) * CONV_CH + c) = xv; }
                    else if (t >= DT - 3) *(f32x2_t*)(a.out + O_CONVS + (((size_t)r * DB + db) * 3 + (t - (DT - 3))) * CONV_CH + c) = xv; }
                float sq = x[0][0] * x[0][0] + x[0][1] * x[0][1], sk = x[1][0] * x[1][0] + x[1][1] * x[1][1];
#pragma unroll
                for (int o = 32; o >= 1; o >>= 1) { sq += shfl_xor_l(sq, o, lane); sk += shfl_xor_l(sk, o, lane); }
                const float rq = FRSQ(sq + EPS) * 0.08838834764831845f, rk = FRSQ(sk + EPS);
                const f32x2_t qn = x[0] * rq, kn = x[1] * rk; const size_t o = (size_t)m * 512 + hd * 128 + 2 * lane;
                *(f32x2_t*)(QN + o) = qn; *(f32x2_t*)(KN + o) = kn; *(f32x2_t*)(QKV + (size_t)m * 1536 + 1024 + hd * 128 + 2 * lane) = x[2];
                const float g = dn_g(a, r, (size_t)m, hd); float gc = g;
                if (prompt) { const int tt = t0 + t, tl = tt & 63; if (tl == 0) gcum = 0.f; gcum += g; gc = gcum;
                    float* kt = KNT + (((size_t)seq * DNH + hd) * NC + tt / 64) * 8192 + (size_t)(2 * lane) * 64 + tl; kt[0] = kn[0]; kt[64] = kn[1]; }
                if (lane == 0) { GB[(size_t)m * 16 + hd * 4] = g; GB[(size_t)m * 16 + hd * 4 + 1] = sigmoidf_(P[(size_t)m * LDP + OFF_B + hd]); GB[(size_t)m * 16 + hd * 4 + 2] = gc; } } } } }
}
__device__ __forceinline__ void ph_rec_out_w(const Args& a, int r) {
    static_assert(D_RNN == 512 && Y2W == 1024, "ph_rec_out_w is written for D_RNN 512");
    const float* P = (const float*)(a.ws + WS_P); const float* HH = (const float*)(a.ws + WS_HH); const float* AP = (const float*)(a.ws + WS_XR); const float* CARRY = (const float*)(a.ws + WS_CARRY);
    const float* ODN = (const float*)(a.ws + WS_ODN); bf16* Y2 = (bf16*)(a.ws + WS_Y2); const float* dnw = a.in[I_DNW] + r * 128;
    int tx_ = TID(); asm volatile("" : "+v"(tx_));
    const int lane = tx_ & 63, wv = __builtin_amdgcn_readfirstlane(blockIdx.x * (NTHREADS >> 6) + (tx_ >> 6)), nwv = gridDim.x * (NTHREADS >> 6);
    const f32x2_t dw = *(const f32x2_t*)(dnw + 2 * lane);
    for (int m = wv; m < MT; m += nwv) {
        { const size_t o = (size_t)m * D_RNN + 8 * lane; f32x4_t h0 = *(const f32x4_t*)(HH + o), h1 = *(const f32x4_t*)(HH + o + 4);
            if (m < MP) { const float* cr = CARRY + (size_t)(m / 64) * D_RNN + 8 * lane; h0 += *(const f32x4_t*)(AP + o) * *(const f32x4_t*)cr; h1 += *(const f32x4_t*)(AP + o + 4) * *(const f32x4_t*)(cr + 4); }
            const float* gp = P + (size_t)m * LDP + OFF_GATE + 8 * lane; const f32x4_t g0 = *(const f32x4_t*)gp, g1 = *(const f32x4_t*)(gp + 4);
            u32x4_t w; w[0] = pk_bf16(h0[0] * gelu_tanhf_(g0[0]), h0[1] * gelu_tanhf_(g0[1])); w[1] = pk_bf16(h0[2] * gelu_tanhf_(g0[2]), h0[3] * gelu_tanhf_(g0[3]));
            w[2] = pk_bf16(h1[0] * gelu_tanhf_(g1[0]), h1[1] * gelu_tanhf_(g1[1])); w[3] = pk_bf16(h1[2] * gelu_tanhf_(g1[2]), h1[3] * gelu_tanhf_(g1[3]));
            *(u32x4_t*)(Y2 + (size_t)m * Y2W + 8 * lane) = w; }
        f32x2_t ov[4]; float ss[4];
#pragma unroll
        for (int hd = 0; hd < 4; ++hd) { ov[hd] = *(const f32x2_t*)(ODN + (size_t)m * 512 + hd * 128 + 2 * lane); ss[hd] = ov[hd][0] * ov[hd][0] + ov[hd][1] * ov[hd][1]; }
#pragma unroll
        for (int o = 32; o >= 1; o >>= 1)
#pragma unroll
            for (int hd = 0; hd < 4; ++hd) ss[hd] += shfl_xor_l(ss[hd], o, lane);
#pragma unroll
        for (int hd = 0; hd < 4; ++hd) { const float rs = FRSQ(ss[hd] * (1.0f / 128.0f) + EPS); const f32x2_t z = *(const f32x2_t*)(P + (size_t)m * LDP + OFF_Z + hd * 128 + 2 * lane);
            *(unsigned*)(Y2 + (size_t)m * Y2W + D_RNN + hd * 128 + 2 * lane) = pk_bf16(ov[hd][0] * rs * dw[0] * siluf_(z[0]), ov[hd][1] * rs * dw[1] * siluf_(z[1])); } }
}


__device__ __forceinline__ void ph_dn_chunk(const Args& a, LAS unsigned char* lds) {
    const float* QKV = (const float*)(a.ws + WS_QKV); const float* QN = (const float*)(a.ws + WS_QN); const float* KN = (const float*)(a.ws + WS_KN); const float* GB = (const float*)(a.ws + WS_GB); const float* KNT = (const float*)(a.ws + WS_KNT);
    bf16* AT = (bf16*)(a.ws + WS_AT); float* UT = (float*)(a.ws + WS_UT); bf16* WN = (bf16*)(a.ws + WS_WN); bf16* QG = (bf16*)(a.ws + WS_QG); bf16* KDT = (bf16*)(a.ws + WS_KDT); float* GL = (float*)(a.ws + WS_GL);
    int tx_ = TID(); asm volatile("" : "+v"(tx_));
    const int tid = tx_, lane = tid & 63, fr = lane & 15, fq = lane >> 4, wid = __builtin_amdgcn_readfirstlane(tid >> 6);
    constexpr int RS = 136;
    LAS bf16* Kb = (LAS bf16*)lds; LAS bf16* Qb = (LAS bf16*)(lds + 17408); LAS float* Lf = (LAS float*)(lds + 34816); LAS float* gcs = (LAS float*)(lds + 51200); LAS float* bts = (LAS float*)(lds + 51456);
    for (int cu = blockIdx.x; cu < NCU; cu += gridDim.x) { const int n = cu % NC, hd = (cu / NC) % DNH, b = cu / (NC * DNH); const size_t m0 = (size_t)b * SEQ + n * 64;
        { const int i = tid >> 3, sg = tid & 7; const float* qp = QN + (m0 + i) * 512 + hd * 128 + sg * 16; const float* kp = KN + (m0 + i) * 512 + hd * 128 + sg * 16;
            f32x4_t qv[4], kv[4];
#pragma unroll
            for (int e = 0; e < 4; ++e) { qv[e] = *(const f32x4_t*)(qp + 4 * e); kv[e] = *(const f32x4_t*)(kp + 4 * e); }
            u32x4_t w0, w1;
#pragma unroll
            for (int e = 0; e < 2; ++e) { w0[2 * e] = pk_bf16(qv[e][0], qv[e][1]); w0[2 * e + 1] = pk_bf16(qv[e][2], qv[e][3]); w1[2 * e] = pk_bf16(qv[e + 2][0], qv[e + 2][1]); w1[2 * e + 1] = pk_bf16(qv[e + 2][2], qv[e + 2][3]); }
            *(LAS u32x4_t*)(Qb + i * RS + sg * 16) = w0; *(LAS u32x4_t*)(Qb + i * RS + sg * 16 + 8) = w1;
#pragma unroll
            for (int e = 0; e < 2; ++e) { w0[2 * e] = pk_bf16(kv[e][0], kv[e][1]); w0[2 * e + 1] = pk_bf16(kv[e][2], kv[e][3]); w1[2 * e] = pk_bf16(kv[e + 2][0], kv[e + 2][1]); w1[2 * e + 1] = pk_bf16(kv[e + 2][2], kv[e + 2][3]); }
            *(LAS u32x4_t*)(Kb + i * RS + sg * 16) = w0; *(LAS u32x4_t*)(Kb + i * RS + sg * 16 + 8) = w1;
            if (tid < 64) { gcs[tid] = GB[(m0 + tid) * 16 + hd * 4 + 2]; bts[tid] = GB[(m0 + tid) * 16 + hd * 4 + 1]; } }
        __syncthreads();
        { const int ti = wid >> 1;
#pragma unroll
            for (int tq = 0; tq < 2; ++tq) { const int tj = 2 * (wid & 1) + tq; f32x4_t ck = {0.f, 0.f, 0.f, 0.f}, cq = {0.f, 0.f, 0.f, 0.f};
                if (tj <= ti) {
#pragma unroll
                    for (int ks = 0; ks < 4; ++ks) { const bf16x8_t bK = *(const LAS bf16x8_t*)(Kb + (tj * 16 + fr) * RS + ks * 32 + fq * 8);
                        ck = __builtin_amdgcn_mfma_f32_16x16x32_bf16(*(const LAS bf16x8_t*)(Kb + (ti * 16 + fr) * RS + ks * 32 + fq * 8), bK, ck, 0, 0, 0);
                        cq = __builtin_amdgcn_mfma_f32_16x16x32_bf16(*(const LAS bf16x8_t*)(Qb + (ti * 16 + fr) * RS + ks * 32 + fq * 8), bK, cq, 0, 0, 0); } }
                const int j = tj * 16 + fr; const float gj = gcs[j];
#pragma unroll
                for (int q = 0; q < 4; ++q) { const int i = ti * 16 + 4 * fq + q; float lv = 0.f, av = 0.f;
                    if (i >= j) { const float dec = __expf(gcs[i] - gj); av = cq[q] * dec; if (i > j) lv = bts[i] * ck[q] * dec; }
                    Lf[i * 64 + j] = lv; AT[(size_t)cu * 4096 + FRAG_OFF(i, j, 2)] = f2bf(av); } } }
        __syncthreads();
        if (wid < 4) { const int col = tid; float X[64];
            if (col < 128) {
#pragma unroll
                for (int j = 0; j < 64; ++j) X[j] = QKV[(m0 + j) * 1536 + 1024 + hd * 128 + col] * bts[j]; }
            else {
#pragma unroll
                for (int j = 0; j < 64; ++j) X[j] = KN[(m0 + j) * 512 + hd * 128 + (col - 128)] * bts[j] * __expf(gcs[j]); }
#pragma unroll
            for (int i = 1; i < 64; ++i) { float acc = X[i];
#pragma unroll
                for (int jb = 0; jb < i; jb += 4) { const f32x4_t l4 = *(const LAS f32x4_t*)(Lf + i * 64 + jb);
                    acc -= l4[0] * X[jb]; acc -= l4[1] * X[jb + 1]; acc -= l4[2] * X[jb + 2]; acc -= l4[3] * X[jb + 3]; }
                X[i] = acc; }
            if (col < 128) { float* up = UT + (size_t)cu * 8192 + (size_t)((col >> 4) * 4) * 256 + (col & 15) * 4;
#pragma unroll
                for (int j = 0; j < 64; j += 4) *(f32x4_t*)(up + (j >> 4) * 256 + ((j >> 2) & 3) * 64) = (f32x4_t){X[j], X[j + 1], X[j + 2], X[j + 3]}; }
            else { bf16* wp = WN + (size_t)cu * 8192;
#pragma unroll
                for (int j = 0; j < 64; ++j) wp[FRAG_OFF(j, col - 128, 4)] = f2bf(-X[j]); } }
        else { const int t2 = tid - 256; const float gl63 = gcs[63];
            { const int i = t2 >> 2, sg = t2 & 3; const float eg = __expf(gcs[i]); const float* qp = QN + (m0 + i) * 512 + hd * 128 + sg * 32; bf16* op = QG + (size_t)cu * 8192;
#pragma unroll
                for (int e = 0; e < 8; ++e) { const f32x4_t v = *(const f32x4_t*)(qp + 4 * e); u32x2_t w; w[0] = pk_bf16(v[0] * eg, v[1] * eg); w[1] = pk_bf16(v[2] * eg, v[3] * eg); *(u32x2_t*)(op + FRAG_OFF(i, sg * 32 + 4 * e, 4)) = w; } }
            { const int dd = t2 >> 1, hf = t2 & 1; const float* kp = KNT + (size_t)cu * 8192 + dd * 64 + hf * 32; bf16* op = KDT + (size_t)cu * 8192;
#pragma unroll
                for (int e = 0; e < 8; ++e) { const f32x4_t v = *(const f32x4_t*)(kp + 4 * e); const int i0 = hf * 32 + 4 * e; u32x2_t w;
                    w[0] = pk_bf16(v[0] * __expf(gl63 - gcs[i0]), v[1] * __expf(gl63 - gcs[i0 + 1])); w[1] = pk_bf16(v[2] * __expf(gl63 - gcs[i0 + 2]), v[3] * __expf(gl63 - gcs[i0 + 3])); *(u32x2_t*)(op + FRAG_OFF(dd, i0, 2)) = w; } }
            if (t2 == 0) GL[cu] = __expf(gl63); }
        __syncthreads();
    }
}


template <int MODE, int UNR> __device__ __forceinline__ void small_gemm(const bf16* __restrict__ A, const bf16* __restrict__ Bt, int N, int K, void* C, int ldc) {
    static_assert(MS == 128, "small_gemm covers 128 sample rows");
    int tx_ = TID(); asm volatile("" : "+v"(tx_));
    const int lane = tx_ & 63, fr = lane & 15, fq = lane >> 4, wv = __builtin_amdgcn_readfirstlane(blockIdx.x * (NTHREADS >> 6) + (tx_ >> 6)), nwv = gridDim.x * (NTHREADS >> 6);
    const int ntile = (N / 16) * 4;
    for (int tile = wv; tile < ntile; tile += nwv) { const int n0 = (tile >> 2) * 16, tg = tile & 3;
        f32x4_t acc0 = {0.f, 0.f, 0.f, 0.f}, acc1 = {0.f, 0.f, 0.f, 0.f};
        const bf16* bp = Bt + (size_t)(n0 + fr) * K + fq * 8; const bf16* ap0 = A + (size_t)(MP + tg * 32 + fr) * K + fq * 8; const bf16* ap1 = ap0 + (size_t)16 * K;
        for (int k = 0; k < K; k += 32 * UNR) { bf16x8_t bb[UNR], a0[UNR], a1[UNR];
#pragma unroll
            for (int u = 0; u < UNR; ++u) { bb[u] = *(const bf16x8_t*)(bp + k + 32 * u); a0[u] = *(const bf16x8_t*)(ap0 + k + 32 * u); a1[u] = *(const bf16x8_t*)(ap1 + k + 32 * u); }
#pragma unroll
            for (int u = 0; u < UNR; ++u) { acc0 = __builtin_amdgcn_mfma_f32_16x16x32_bf16(bb[u], a0[u], acc0, 0, 0, 0); acc1 = __builtin_amdgcn_mfma_f32_16x16x32_bf16(bb[u], a1[u], acc1, 0, 0, 0); } }
#pragma unroll
        for (int tt = 0; tt < 2; ++tt) { const f32x4_t v = tt ? acc1 : acc0; const size_t o = (size_t)(MP + tg * 32 + tt * 16 + fr) * ldc + n0 + 4 * fq;
            if (MODE == 0) *(f32x4_t*)((float*)C + o) = v;
            else if (MODE == 1) { const float r0 = fmaxf(v[0], 0.f), r1 = fmaxf(v[1], 0.f), r2 = fmaxf(v[2], 0.f), r3 = fmaxf(v[3], 0.f); u32x2_t w; w[0] = pk_bf16(r0 * r0, r1 * r1); w[1] = pk_bf16(r2 * r2, r3 * r3); *(u32x2_t*)((bf16*)C + o) = w; }
            else { f32x4_t* p = (f32x4_t*)((float*)C + o); *p = *p + v; } } }
}


template <int MODE> __device__ __forceinline__ void small_gemm2(const bf16* __restrict__ A, const bf16* __restrict__ Bt, int N, int K, void* C, int ldc, bf16* XB, unsigned long long* ss, LAS unsigned char* lds) {
    static_assert(MS == 128, "small_gemm2 covers 128 sample rows");
    int tx_ = TID(); asm volatile("" : "+v"(tx_));
    const int tid = tx_, lane = tid & 63, fr = lane & 15, fq = lane >> 4, wid = __builtin_amdgcn_readfirstlane(tid >> 6);
    LAS float* RED = (LAS float*)lds;
    const int kw = K / 8;
    for (int tile = blockIdx.x; tile < (N / 16) * 4; tile += gridDim.x) { const int n0 = (tile >> 2) * 16, tg = tile & 3;
        f32x4_t acc0 = {0.f, 0.f, 0.f, 0.f}, acc1 = {0.f, 0.f, 0.f, 0.f};
        const bf16* bp = Bt + (size_t)(n0 + fr) * K + wid * kw + fq * 8; const bf16* ap0 = A + (size_t)(MP + tg * 32 + fr) * K + wid * kw + fq * 8; const bf16* ap1 = ap0 + (size_t)16 * K;
        for (int k = 0; k < kw; k += 128) { bf16x8_t bb[4], a0[4], a1[4];
#pragma unroll
            for (int u = 0; u < 4; ++u) { bb[u] = *(const bf16x8_t*)(bp + k + 32 * u); a0[u] = *(const bf16x8_t*)(ap0 + k + 32 * u); a1[u] = *(const bf16x8_t*)(ap1 + k + 32 * u); }
#pragma unroll
            for (int u = 0; u < 4; ++u) { acc0 = __builtin_amdgcn_mfma_f32_16x16x32_bf16(bb[u], a0[u], acc0, 0, 0, 0); acc1 = __builtin_amdgcn_mfma_f32_16x16x32_bf16(bb[u], a1[u], acc1, 0, 0, 0); } }
        *(LAS f32x4_t*)(RED + ((size_t)(wid * 32 + fr)) * 16 + 4 * fq) = acc0; *(LAS f32x4_t*)(RED + ((size_t)(wid * 32 + 16 + fr)) * 16 + 4 * fq) = acc1;
        __syncthreads();
        { const int tok = tid >> 4, c = tid & 15; float v = RED[(size_t)tok * 16 + c];
#pragma unroll
            for (int w = 1; w < 8; ++w) v += RED[(size_t)(w * 32 + tok) * 16 + c];
            const int m = MP + tg * 32 + tok; const size_t o = (size_t)m * ldc + n0 + c;
            if (MODE == 1) { const float rs = FRSQ((float)ss[m] * (5.9604644775390625e-08f / D) + EPS); const float r0 = fmaxf(v * rs, 0.f); ((bf16*)C)[o] = f2bf(r0 * r0); }
            else { const float x = ((float*)C)[o] + v; ((float*)C)[o] = x; XB[o] = f2bf(x);
                float q = x * x; q += shfl_xor_l(q, 1, lane); q += shfl_xor_l(q, 2, lane); q += shfl_xor_l(q, 4, lane); q += shfl_xor_l(q, 8, lane);
                if (c == 0) __hip_atomic_fetch_add(ss + m, (unsigned long long)(q * 16777216.0f), __ATOMIC_RELAXED, __HIP_MEMORY_SCOPE_AGENT); } }
        __syncthreads();
    }
}

constexpr int PH_PER_LAYER = 12, PH_LAYER0 = 2, PH_FINAL = PH_LAYER0 + DEPTH * PH_PER_LAYER, N_PHASES = PH_FINAL + 1;
#ifndef DIAG_SEQ_LO
#define DIAG_SEQ_LO NB
#endif
#ifndef PROBE_N
#define PROBE_N 1
#define PROBE_KIND -1
#define PROBE_LO 0
#define PROBE_HI 0
#endif
#define NREP(kind, k) ((PROBE_KIND == (kind) && (k) >= PROBE_LO && (k) <= PROBE_HI) ? PROBE_N : 1)
#define REP(kind, k) for (int rep_ = 0; rep_ < NREP(kind, k); ++rep_)
#ifndef MK_SINGLE
#define MK_SINGLE 1
#endif
__global__ void __launch_bounds__(NTHREADS, 2) mega(KArgs ka) {
    extern __shared__ __attribute__((aligned(16))) unsigned char lds[];
    LAS unsigned char* L = (LAS unsigned char*)lds;
    const size_t gsz = (size_t)gridDim.x * NTHREADS;
#define GT() ([&]() -> size_t { unsigned tx_ = TID(); asm volatile("" : "+v"(tx_)); return (size_t)blockIdx.x * NTHREADS + tx_; }())
    const int lo = ka.ph_lo, hi = ka.ph_hi; (void)lo; (void)hi;
    { const unsigned hw_ = (unsigned)__builtin_amdgcn_s_getreg((5 << 11) | 4) & 63u; if ((threadIdx.x & 63) == 0) ((LAS int*)(L + LDS_WTAB))[hw_] = (int)(threadIdx.x >> 6); __syncthreads(); }
    { const float** tab = (const float**)(ka.ws + WS_TAB); if (threadIdx.x < 28) tab[threadIdx.x] = ka.in[threadIdx.x]; asm volatile("s_waitcnt vmcnt(0)" ::: "memory"); __syncthreads(); }
    Args a; a.in = (const float* const*)(ka.ws + WS_TAB); a.out = ka.out; a.ws = ka.ws;
#define OPQ() do { size_t z_ = 0; asm volatile("" : "+s"(z_)); a.ws = ka.ws + z_; a.out = ka.out + z_; a.in = (const float* const*)(ka.ws + WS_TAB + z_); } while (0)
#if MK_SINGLE
    if (TID() < 4) ((LAS unsigned*)(L + LDS_MISC))[TID()] = 0u;
    __syncthreads();
    XcdBarrier bar = xcd_barrier_post((unsigned*)(a.ws + WS_CTL) + 4096, (volatile LAS unsigned*)(L + LDS_MISC));
#define SEAM(k) do { XcdBarrier bb_ = bar; asm volatile("" : "+s"(bb_.x)); xcd_barrier(bb_); } while (0)
#else
#define SEAM(k) do { } while (0)
#endif
#if MK_SINGLE
#define IN(k) (true)
#else
#define IN(k) (lo <= (k) && (k) < hi)
#endif
#define XN ((bf16*)(a.ws + WS_XN))
#define X ((float*)(a.ws + WS_X))
#define P ((float*)(a.ws + WS_P))
#define H ((bf16*)(a.ws + WS_H))
#define Y2 ((bf16*)(a.ws + WS_Y2))
    if (IN(0)) { OPQ(); REP(2, 0) { ph_prep_x(a); ph_wprep(a, true, 0, GT(), gsz); } SEAM(0); }
    for (int l = 0; l < DEPTH; ++l) {
        const int pb = PH_LAYER0 + l * PH_PER_LAYER, r = l >> 1; unsigned long long* SSb = (unsigned long long*)(a.ws + WS_SS);
        if ((l & 1) == 0) {
            if (IN(pb + 1)) { OPQ(); REP(3, 1) { pg8::Gemm g{XN, (const bf16*)(a.ws + WS_WINR) + (size_t)r * REC_PAD * D, MPAD, REC_PAD, D}; pg8::StaticOrder S; S.init(MPAD, REC_PAD, gridDim.x, blockIdx.x);
                pg8::EpiF32S E{P, LDP, SSb + (size_t)(2 * l) * MPAD}; pg8::gemm_phase<pg8::EpiF32S, pg8::StaticOrder, false>(L, g, S, E, nullptr); } SEAM(pb + 1); }
            if (IN(pb + 2)) { OPQ(); REP(0, 2) { ph_rg_chunk(a, r, L); ph_dn_tok(a, r); } SEAM(pb + 2); }
            if (IN(pb + 3)) { OPQ(); REP(0, 3) ph_dn_chunk(a, L); SEAM(pb + 3); }
            if (IN(pb + 6)) { OPQ();
                constexpr int NDNB = NB * DNH * 8;
                REP(0, 6) {
                if ((int)gridDim.x > NDNB) { if ((int)blockIdx.x < NDNB) {
#ifdef DIAG_NAIVE_B
                    ph_dn_b_naive(a, r, GT(), (size_t)NDNB * NTHREADS);
#else
                    ph_dn_b(a, r, L);
#endif
                } else { const size_t g2 = GT() - (size_t)NDNB * NTHREADS, s2 = gsz - (size_t)NDNB * NTHREADS; ph_rg_scan2(a, r, g2, s2); if (DIAG_SEQ_LO != 0) ph_dn_seq(a, r, DIAG_SEQ_LO, g2, s2);
                    if (l == 0) ph_wprep(a, true, 1, g2, s2); } }
                else { ph_dn_b(a, r, L); ph_rg_scan2(a, r, GT(), gsz); ph_dn_seq(a, r, DIAG_SEQ_LO, GT(), gsz); if (l == 0) ph_wprep(a, true, 1, GT(), gsz); }
                }
                SEAM(pb + 6); }
            if (IN(pb + 7)) { OPQ(); REP(0, 7) ph_rec_out_w(a, r); SEAM(pb + 7); }
            if (IN(pb + 8)) { OPQ(); REP(3, 8) { pg8::Gemm g{Y2, (const bf16*)(a.ws + WS_WOUTR) + (size_t)r * D * Y2W, MP, D, Y2W}; pg8::StaticOrder S; S.init(MP, D, gridDim.x, blockIdx.x);
                pg8::EpiAddN E{X, D, XN, SSb + (size_t)(2 * l + 1) * MPAD}; pg8::gemm_phase<pg8::EpiAddN, pg8::StaticOrder, false>(L, g, S, E, nullptr); small_gemm2<2>(Y2, (const bf16*)(a.ws + WS_WOUTR) + (size_t)r * D * Y2W, D, Y2W, X, D, XN, SSb + (size_t)(2 * l + 1) * MPAD, L); } SEAM(pb + 8); }
        } else {
            if (IN(pb + 1)) { OPQ(); REP(3, 1) { pg8::Gemm g{XN, (const bf16*)(a.ws + WS_WINA) + (size_t)r * ATT_PAD * D, MPAD, ATT_PAD, D}; pg8::StaticOrder S; S.init(MPAD, ATT_PAD, gridDim.x, blockIdx.x);
                pg8::EpiAttS E{a.ws, a.out, SSb + (size_t)(2 * l) * MPAD, r}; pg8::gemm_phase<pg8::EpiAttS, pg8::StaticOrder, false>(L, g, S, E, nullptr); } SEAM(pb + 1); }
            if (IN(pb + 3)) { OPQ(); REP(1, 3) { ph_idx_sample_mfma(a, r); ph_idx_mfma(a, L); } SEAM(pb + 3); }
            if (IN(pb + 4)) { OPQ(); REP(1, 4) ph_select_w(a, L); SEAM(pb + 4); }
            if (IN(pb + 5)) { OPQ(); REP(1, 5) { ph_sparse_sample(a, r, L); ph_sparse_attn(a, L); } SEAM(pb + 5); }
            if (IN(pb + 8)) { OPQ(); REP(3, 8) { pg8::Gemm g{Y2, (const bf16*)(a.ws + WS_WOUTA) + (size_t)r * D * D, MP, D, D}; pg8::StaticOrder S; S.init(MP, D, gridDim.x, blockIdx.x);
                pg8::EpiAddN E{X, D, XN, SSb + (size_t)(2 * l + 1) * MPAD}; pg8::gemm_phase<pg8::EpiAddN, pg8::StaticOrder, false>(L, g, S, E, nullptr); small_gemm2<2>(Y2, (const bf16*)(a.ws + WS_WOUTA) + (size_t)r * D * D, D, D, X, D, XN, SSb + (size_t)(2 * l + 1) * MPAD, L); } SEAM(pb + 8); }
        }
        if (IN(pb + 10)) { OPQ(); REP(3, 10) { pg8::Gemm g{XN, (const bf16*)(a.ws + WS_WUP) + (size_t)l * D_FF * D, MP, D_FF, D}; pg8::StaticOrder S; S.init(MP, D_FF, gridDim.x, blockIdx.x);
            pg8::EpiRelu2S E{H, D_FF, SSb + (size_t)(2 * l + 1) * MPAD}; pg8::gemm_phase<pg8::EpiRelu2S, pg8::StaticOrder, false>(L, g, S, E, nullptr); small_gemm2<1>(XN, (const bf16*)(a.ws + WS_WUP) + (size_t)l * D_FF * D, D_FF, D, H, D_FF, nullptr, SSb + (size_t)(2 * l + 1) * MPAD, L); } SEAM(pb + 10); }
        if (IN(pb + 11)) { OPQ(); REP(3, 11) { pg8::Gemm g{H, (const bf16*)(a.ws + WS_WDN) + (size_t)l * D * D_FF, MP, D, D_FF}; pg8::StaticOrder S; S.init(MP, D, gridDim.x, blockIdx.x);
            pg8::EpiAddN E{X, D, XN, SSb + (size_t)(2 * l + 2) * MPAD}; pg8::gemm_phase<pg8::EpiAddN, pg8::StaticOrder, false>(L, g, S, E, nullptr); small_gemm2<2>(H, (const bf16*)(a.ws + WS_WDN) + (size_t)l * D * D_FF, D, D_FF, X, D, XN, SSb + (size_t)(2 * l + 2) * MPAD, L); } SEAM(pb + 11); }
    }
    if (IN(PH_FINAL)) { OPQ(); ph_final(a); }
}
#undef XN
#undef X
#undef P
#undef H
#undef Y2

extern "C" void kernel_launch(void* const* d_in, const int* in_sizes, int n_in, void* d_out, int out_size, void* d_ws, size_t ws_size, hipStream_t stream) {
    static int grid = 0;
    if (grid == 0) {
        if (n_in != 28 || (size_t)out_size != (size_t)O_END || ws_size < WS_END2) { fprintf(stderr, "kernel_launch: unexpected shapes n_in %d out %d (want %zu) ws %zu (want %zu)\n", n_in, out_size, (size_t)O_END, ws_size, (size_t)WS_END2); grid = -1; return; }
        int dev = 0, cus = 0;
        if (hipGetDevice(&dev) != hipSuccess || hipDeviceGetAttribute(&cus, hipDeviceAttributeMultiprocessorCount, dev) != hipSuccess) { grid = -1; return; }
        if (hipFuncSetAttribute((const void*)mega, hipFuncAttributeMaxDynamicSharedMemorySize, LDS_BYTES) != hipSuccess) { fprintf(stderr, "kernel_launch: hipFuncSetAttribute failed\n"); grid = -1; return; }
        int per_cu = 0; (void)hipOccupancyMaxActiveBlocksPerMultiprocessor(&per_cu, (const void*)mega, NTHREADS, LDS_BYTES); (void)hipGetLastError();
        if (per_cu < 1) fprintf(stderr, "kernel_launch: occupancy query says %d blocks per CU\n", per_cu);
        grid = cus;
    }
    if (grid < 0) return;
    (void)hipMemsetAsync((char*)d_ws + WS_CTL, 0, CTL_BYTES, stream);
    KArgs a{};
    for (int i = 0; i < 28; ++i) a.in[i] = (const float*)d_in[i];
    a.out = (float*)d_out; a.ws = (unsigned char*)d_ws;
#if MK_SINGLE
    a.ph_lo = 0; a.ph_hi = N_PHASES;
    hipLaunchKernelGGL(mega, dim3(grid), dim3(NTHREADS), LDS_BYTES, stream, a);
#else
    for (int ph = 0; ph < N_PHASES; ++ph) { const int k = ph - PH_LAYER0; if (k >= 0 && ph < PH_FINAL && ((k / PH_PER_LAYER) & 1) == 1 && (k % PH_PER_LAYER) == 7) continue;
        a.ph_lo = ph; a.ph_hi = ph + 1; hipLaunchKernelGGL(mega, dim3(grid), dim3(NTHREADS), LDS_BYTES, stream, a); }
#endif
}
#endif
```

```cpp
#ifndef HOST_TEST
#include <hip/hip_runtime.h>
#define HD __device__ __forceinline__
#define UNI(x) __builtin_amdgcn_readfirstlane(x)
#else
#include <cmath>
#include <cstddef>
#include <cstring>
#define HD static inline
#define UNI(x) (x)
#endif

#ifndef CFG_D_MODEL
#define CFG_D_MODEL 1024
#define CFG_BATCH 2
#define CFG_SEQ 8192
#define CFG_DEC_BATCH 32
#define CFG_PAST 8192
#endif
constexpr int D = CFG_D_MODEL, NB = CFG_BATCH, SEQ = CFG_SEQ, DEPTH = 4, DB = CFG_DEC_BATCH, DT = 4, PAST = CFG_PAST, PAGE = 128;
constexpr int N_REC = 2, N_ATT = 2, NPAGES = PAST / PAGE, NUSED = DB * NPAGES, NPOOL = NUSED + (NUSED + 3) / 4;
constexpr int D_RNN = D / 2, RG_HEADS = 8, RG_BW = D_RNN / RG_HEADS;
constexpr int DNH = 4, DNK = 128, DN_QK = 512, DN_VD = 512;
constexpr int CONV_CH = D_RNN + 2 * DN_QK + DN_VD, REC_IN = CONV_CH + D_RNN + DN_VD + 2 * DNH;
constexpr int OFF_GATE = CONV_CH, OFF_Z = CONV_CH + D_RNN, OFF_B = OFF_Z + DN_VD, OFF_A = OFF_B + DNH;
constexpr int AH = D / 128, KVH = 2, HDIM = 128, GROUP = AH / KVH, IH = 8, IDIM = 64;
constexpr int AO_K = AH * HDIM, AO_V = AO_K + KVH * HDIM, AO_QI = AO_V + KVH * HDIM, AO_KI = AO_QI + IH * IDIM, AO_WI = AO_KI + IDIM, ATT_IN = AO_WI + IH;
constexpr int D_FF = 4 * D;
constexpr int TOPK_P = (SEQ / 4 < 256) ? SEQ / 4 : 256, TOPK_S = ((PAST + DT) / 4 < 256) ? (PAST + DT) / 4 : 256, KMAX = 256, KROW = 320;
constexpr int MP = NB * SEQ, MS = DB * DT, MT = MP + MS, MPAD = (MT + 255) / 256 * 256;
constexpr int REC_PAD = (REC_IN + 255) / 256 * 256, ATT_PAD = (ATT_IN + 255) / 256 * 256, LDP = REC_PAD > ATT_PAD ? REC_PAD : ATT_PAD;
constexpr int Y2W = D_RNN + DN_VD;
constexpr int SMAX = (PAST + DT > SEQ) ? PAST + DT : SEQ, SLD = (SMAX + 63) / 64 * 64;
constexpr int NC = SEQ / 64, NCU = NB * DNH * NC;
constexpr float EPS = 1e-6f;
typedef unsigned short bf16;

constexpr size_t O_YP = 0, O_YS = O_YP + (size_t)MP * D, O_CONVP = O_YS + (size_t)MS * D, O_HP = O_CONVP + (size_t)N_REC * NB * 3 * CONV_CH,
    O_SP = O_HP + (size_t)N_REC * NB * D_RNN, O_KP = O_SP + (size_t)N_REC * NB * DNH * 128 * 128, O_VP = O_KP + (size_t)N_ATT * MP * KVH * HDIM,
    O_KIP = O_VP + (size_t)N_ATT * MP * KVH * HDIM, O_CONVS = O_KIP + (size_t)N_ATT * MP * IDIM, O_HS = O_CONVS + (size_t)N_REC * DB * 3 * CONV_CH,
    O_SS = O_HS + (size_t)N_REC * DB * D_RNN, O_KS = O_SS + (size_t)N_REC * DB * DNH * 128 * 128, O_VS = O_KS + (size_t)N_ATT * MS * KVH * HDIM,
    O_KIS = O_VS + (size_t)N_ATT * MS * KVH * HDIM, O_END = O_KIS + (size_t)N_ATT * MS * IDIM;

constexpr size_t al256(size_t x) { return (x + 255) / 256 * 256; }
constexpr size_t WS_CTL = 0, CTL_BYTES = 4u << 20;
constexpr size_t WS_WINR = CTL_BYTES, WS_WOUTR = WS_WINR + al256((size_t)N_REC * REC_PAD * D * 2), WS_WINA = WS_WOUTR + al256((size_t)N_REC * D * Y2W * 2),
    WS_WOUTA = WS_WINA + al256((size_t)N_ATT * ATT_PAD * D * 2), WS_WUP = WS_WOUTA + al256((size_t)N_ATT * D * D * 2), WS_WDN = WS_WUP + al256((size_t)DEPTH * D_FF * D * 2),
    WS_X = WS_WDN + al256((size_t)DEPTH * D * D_FF * 2), WS_XN = WS_X + al256((size_t)MPAD * D * 4), WS_P = WS_XN + al256((size_t)MPAD * D * 2),
    WS_H = WS_P + al256((size_t)MPAD * LDP * 4), WS_Y2 = WS_H + al256((size_t)MPAD * D_FF * 2), WS_XR = WS_Y2 + al256((size_t)MPAD * D * 2),
    WS_QKV = WS_XR + al256((size_t)MT * D_RNN * 4), WS_RA = WS_QKV + al256((size_t)MT * 1536 * 4), WS_RB = WS_RA + al256((size_t)MT * D_RNN * 4),
    WS_HH = WS_RB + al256((size_t)MT * D_RNN * 4), WS_QN = WS_HH + al256((size_t)MT * D_RNN * 4), WS_KN = WS_QN + al256((size_t)MT * 512 * 4),
    WS_GB = WS_KN + al256((size_t)MT * 512 * 4), WS_ODN = WS_GB + al256((size_t)MT * 16 * 4), WS_SCT = WS_ODN + al256((size_t)MT * 512 * 4),
    WS_IDX = WS_SCT + al256((size_t)MT * SLD * 4), WS_NSEL = WS_IDX + al256((size_t)MT * KROW * 4), WS_SCR = WS_NSEL + al256((size_t)MT * 4),
    WS_CARRY = WS_SCR + al256((size_t)MT * AH * KMAX * 4), WS_L = WS_CARRY + al256((size_t)NB * NC * D_RNN * 4), WS_AT = WS_L + al256((size_t)NCU * 4096 * 4),
    WS_UT = WS_AT + al256((size_t)NCU * 4096 * 2), WS_WN = WS_UT + al256((size_t)NCU * 8192 * 4), WS_QG = WS_WN + al256((size_t)NCU * 8192 * 2),
    WS_KDT = WS_QG + al256((size_t)NCU * 8192 * 2), WS_GL = WS_KDT + al256((size_t)NCU * 8192 * 2), WS_KNT = WS_GL + al256((size_t)NCU * 4), WS_END = WS_KNT + al256((size_t)NCU * 8192 * 4);

constexpr size_t WS_KB = WS_H, WS_VB = WS_KB + al256((size_t)MT * 256 * 2), WS_QIB = WS_VB + al256((size_t)MT * 256 * 2), WS_KIB = WS_QIB + al256((size_t)MT * 512 * 2);
constexpr size_t WS_QB = WS_KIB + al256((size_t)MT * 64 * 2);
static_assert(WS_QB + (size_t)MT * D * 2 <= WS_Y2, "bf16 attention copies must fit inside the H buffer");
#ifdef HOST_TEST
struct Args { const float* in[28]; float* out; unsigned char* ws; int ph_lo, ph_hi; };
#else
struct KArgs { const float* in[28]; float* out; unsigned char* ws; int ph_lo, ph_hi; };
struct Args { const float* const* in; float* out; unsigned char* ws; };
constexpr size_t WS_TAB = 65536;
constexpr size_t WS_SS = 1u << 20;
static_assert(WS_SS + (size_t)9 * MPAD * 8 <= CTL_BYTES, "norm statistics inside the memset region");
constexpr size_t WS_END2 = WS_END;
#endif
enum { I_XP = 0, I_XS, I_SCONV, I_SH, I_SS, I_CK, I_CV, I_CKI, I_PT, I_NMIX, I_NMLP, I_NFIN, I_WINR, I_WCONV, I_BCONV, I_WA, I_BA, I_WX, I_BX, I_LAM, I_ALOG, I_DTB, I_DNW,
       I_WOUTR, I_WINA, I_WOUTA, I_WUP, I_WDN };

HD bf16 f2bf(float f) { unsigned u; memcpy(&u, &f, 4); u += 0x7FFFu + ((u >> 16) & 1u); return (bf16)(u >> 16); }
HD float bf2f(bf16 b) { unsigned u = ((unsigned)b) << 16; float f; memcpy(&f, &u, 4); return f; }
#ifndef HOST_TEST
#define FEXP(x) __expf(x)
#define FLOG(x) __logf(x)
#define FRCP(x) __builtin_amdgcn_rcpf(x)
#define FSQRT(x) __builtin_amdgcn_sqrtf(x)
#define FRSQ(x) __builtin_amdgcn_rsqf(x)
#else
#define FEXP(x) expf(x)
#define FLOG(x) logf(x)
#define FRCP(x) (1.0f / (x))
#define FSQRT(x) sqrtf(x)
#define FRSQ(x) (1.0f / sqrtf(x))
#endif
HD float sigmoidf_(float x) { return FRCP(1.0f + FEXP(-x)); }
HD float softplusf_(float x) { return x > 20.f ? x : FLOG(1.0f + FEXP(x)); }
HD float siluf_(float x) { return x * sigmoidf_(x); }
HD float gelu_tanhf_(float x) { const float u = 0.7978845608028654f * (x + 0.044715f * x * x * x); const float th = 1.0f - 2.0f * FRCP(1.0f + FEXP(2.0f * u)); return 0.5f * x * (1.0f + th); }
HD unsigned fkey(float f) { f = f + 0.0f; unsigned u; memcpy(&u, &f, 4); return (u & 0x80000000u) ? ~u : (u | 0x80000000u); }
struct RowInfo { int seq, t, T, row0; bool sample; };
HD RowInfo row_info(int m) { RowInfo r; if (m < MP) { r.seq = m / SEQ; r.t = m % SEQ; r.T = SEQ; r.row0 = r.seq * SEQ; r.sample = false; }
    else { const int q = m - MP; r.seq = NB + q / DT; r.t = q % DT; r.T = DT; r.row0 = MP + (q / DT) * DT; r.sample = true; } return r; }

HD void ph_copy_x(const Args& a, size_t gtid, size_t gsz) {
    float* X = (float*)(a.ws + WS_X);
    for (size_t i = gtid; i < (size_t)MPAD * D; i += gsz) { const size_t m = i / D; X[i] = m < (size_t)MP ? a.in[I_XP][i] : (m < (size_t)MT ? a.in[I_XS][i - (size_t)MP * D] : 0.f); }
}
HD void wprep_one(const float* w, bf16* wt, int K, int N, int NP, const float* gamma, size_t gtid, size_t gsz) {
    const size_t k32n = (size_t)K / 32;
    for (size_t i = gtid; i < (size_t)NP * k32n; i += gsz) { const int n = (int)(i % NP); const size_t k0 = (i / NP) * 32; bf16 tmp[32];
#ifndef HOST_TEST
#pragma unroll
#endif
        for (int j = 0; j < 32; ++j) tmp[j] = n < N ? f2bf(w[(k0 + j) * (size_t)N + n] * (gamma ? gamma[k0 + j] : 1.0f)) : (bf16)0;
#ifndef HOST_TEST
#pragma unroll
#endif
        for (int j = 0; j < 32; ++j) wt[(size_t)n * K + k0 + j] = tmp[j]; }
}
HD void ph_wprep(const Args& a, bool fold, int part, size_t gtid, size_t gsz) {
    for (int r = 0; r < N_REC; ++r) { if (part == 2 || (part == 0) == (r == 0)) wprep_one(a.in[I_WINR] + (size_t)r * D * REC_IN, (bf16*)(a.ws + WS_WINR) + (size_t)r * REC_PAD * D, D, REC_IN, REC_PAD, fold ? a.in[I_NMIX] + (size_t)(2 * r) * D : nullptr, gtid, gsz);
        if (part != 0) wprep_one(a.in[I_WOUTR] + (size_t)r * Y2W * D, (bf16*)(a.ws + WS_WOUTR) + (size_t)r * D * Y2W, Y2W, D, D, nullptr, gtid, gsz); }
    if (part == 0) return;
    for (int r = 0; r < N_ATT; ++r) { wprep_one(a.in[I_WINA] + (size_t)r * D * ATT_IN, (bf16*)(a.ws + WS_WINA) + (size_t)r * ATT_PAD * D, D, ATT_IN, ATT_PAD, fold ? a.in[I_NMIX] + (size_t)(2 * r + 1) * D : nullptr, gtid, gsz);
        wprep_one(a.in[I_WOUTA] + (size_t)r * D * D, (bf16*)(a.ws + WS_WOUTA) + (size_t)r * D * D, D, D, D, nullptr, gtid, gsz); }
    for (int l = 0; l < DEPTH; ++l) { wprep_one(a.in[I_WUP] + (size_t)l * D * D_FF, (bf16*)(a.ws + WS_WUP) + (size_t)l * D_FF * D, D, D_FF, D_FF, fold ? a.in[I_NMLP] + (size_t)l * D : nullptr, gtid, gsz);
        wprep_one(a.in[I_WDN] + (size_t)l * D_FF * D, (bf16*)(a.ws + WS_WDN) + (size_t)l * D * D_FF, D_FF, D, D, nullptr, gtid, gsz); }
}
HD void ph_conv(const Args& a, int r, size_t gtid, size_t gsz) {
    const float* P = (const float*)(a.ws + WS_P); float* XR = (float*)(a.ws + WS_XR); float* QKV = (float*)(a.ws + WS_QKV);
    const float* wc = a.in[I_WCONV] + (size_t)r * 4 * CONV_CH; const float* bc = a.in[I_BCONV] + (size_t)r * D_RNN;
    for (size_t i = gtid; i < (size_t)MT * CONV_CH; i += gsz) { const int m = (int)(i / CONV_CH), c = (int)(i % CONV_CH); const RowInfo ri = row_info(m);
        float acc = 0.f;
        for (int k = 0; k < 4; ++k) { const int tau = ri.t - 3 + k; float xv;
            if (tau >= 0) xv = P[(size_t)(ri.row0 + tau) * LDP + c];
            else xv = ri.sample ? a.in[I_SCONV][(((size_t)r * DB + (ri.seq - NB)) * 3 + (3 + tau)) * CONV_CH + c] : 0.f;
            acc += xv * wc[(size_t)k * CONV_CH + c]; }
        if (c < D_RNN) XR[(size_t)m * D_RNN + c] = acc + bc[c]; else QKV[(size_t)m * 1536 + (c - D_RNN)] = siluf_(acc);
        const float uraw = P[(size_t)m * LDP + c];
        if (!ri.sample) { if (ri.t >= SEQ - 3) a.out[O_CONVP + (((size_t)r * NB + ri.seq) * 3 + (ri.t - (SEQ - 3))) * CONV_CH + c] = uraw; }
        else { if (ri.t >= DT - 3) a.out[O_CONVS + (((size_t)r * DB + (ri.seq - NB)) * 3 + (ri.t - (DT - 3))) * CONV_CH + c] = uraw; }
    }
}
HD void ph_rg_gates(const Args& a, int r, size_t gtid, size_t gsz) {
    const float* XR = (const float*)(a.ws + WS_XR); float* RA = (float*)(a.ws + WS_RA); float* RB = (float*)(a.ws + WS_RB);
    const float* wa = a.in[I_WA] + (size_t)r * RG_HEADS * RG_BW * RG_BW; const float* wx = a.in[I_WX] + (size_t)r * RG_HEADS * RG_BW * RG_BW;
    for (size_t i = gtid; i < (size_t)MT * D_RNN; i += gsz) { const int m = (int)(i / D_RNN), j = (int)(i % D_RNN), hd = j / RG_BW, jj = j % RG_BW; const RowInfo ri = row_info(m);
        float pr = 0.f, pi = 0.f; const float* xrow = XR + (size_t)m * D_RNN + hd * RG_BW;
        for (int k = 0; k < RG_BW; ++k) { const float xv = xrow[k]; pr += xv * wa[((size_t)hd * RG_BW + k) * RG_BW + jj]; pi += xv * wx[((size_t)hd * RG_BW + k) * RG_BW + jj]; }
        const float rg = sigmoidf_(pr + a.in[I_BA][(size_t)r * D_RNN + j]), ig = sigmoidf_(pi + a.in[I_BX][(size_t)r * D_RNN + j]);
        const float log_a = -8.0f * rg * softplusf_(-a.in[I_LAM][(size_t)r * D_RNN + j]); const float av = FEXP(log_a);
        const bool first = (!ri.sample) && ri.t == 0;
        const float mult = first ? 1.0f : sqrtf(fmaxf(1.0f - FEXP(2.0f * log_a), 0.0f));
        float bv = XR[(size_t)m * D_RNN + j] * ig * mult;
        if (ri.t == 0 && ri.sample) bv += av * a.in[I_SH][((size_t)r * DB + (ri.seq - NB)) * D_RNN + j];
        RA[i] = av; RB[i] = bv; }
}
HD void ph_rg_scan1(const Args& a, int r, size_t gtid, size_t gsz) {
    const float* RA = (const float*)(a.ws + WS_RA); float* AP = (float*)(a.ws + WS_XR); const float* RB = (const float*)(a.ws + WS_RB); float* HH = (float*)(a.ws + WS_HH);
    const size_t n_p = (size_t)NB * NC * D_RNN, n_s = (size_t)DB * D_RNN;
    for (size_t i = gtid; i < n_p + n_s; i += gsz) {
        if (i < n_p) { const int j = (int)(i % D_RNN); const size_t row0 = (i / D_RNN) * 64; float h = 0.f, ap = 1.f;
            for (int t = 0; t < 64; ++t) { const size_t o = (row0 + t) * D_RNN + j; const float av = RA[o]; h = av * h + RB[o]; ap *= av; HH[o] = h; AP[o] = ap; } }
        else { const size_t q = i - n_p; const int db = (int)(q / D_RNN), j = (int)(q % D_RNN); float h = 0.f;
            for (int t = 0; t < DT; ++t) { const size_t o = (size_t)(MP + db * DT + t) * D_RNN + j; h = RA[o] * h + RB[o]; HH[o] = h; }
            a.out[O_HS + ((size_t)r * DB + db) * D_RNN + j] = h; } }
}
HD void ph_rg_scan2(const Args& a, int r, size_t gtid, size_t gsz) {
    const float* RA = (const float*)(a.ws + WS_XR); const float* HH = (const float*)(a.ws + WS_HH); float* CARRY = (float*)(a.ws + WS_CARRY);
    for (size_t i = gtid; i < (size_t)NB * D_RNN; i += gsz) { const int b = (int)(i / D_RNN), j = (int)(i % D_RNN); float carry = 0.f;
        for (int n0 = 0; n0 < NC; n0 += 16) { float av[16], hv[16];
#pragma unroll
            for (int q = 0; q < 16; ++q) { const int n = n0 + q < NC ? n0 + q : NC - 1; const size_t last = ((size_t)b * SEQ + n * 64 + 63) * D_RNN + j; av[q] = RA[last]; hv[q] = HH[last]; }
#pragma unroll
            for (int q = 0; q < 16; ++q) if (n0 + q < NC) { CARRY[((size_t)b * NC + n0 + q) * D_RNN + j] = carry; carry = av[q] * carry + hv[q]; } }
        a.out[O_HP + ((size_t)r * NB + b) * D_RNN + j] = carry; }
}
HD float dn_g(const Args& a, int r, size_t m, int hd) { const float* P = (const float*)(a.ws + WS_P);
    return -FEXP(a.in[I_ALOG][r * DNH + hd]) * softplusf_(P[m * LDP + OFF_A + hd] + a.in[I_DTB][r * DNH + hd]); }
HD void ph_dn_prep(const Args& a, int r, size_t gtid, size_t gsz) {
    const float* P = (const float*)(a.ws + WS_P); const float* QKV = (const float*)(a.ws + WS_QKV); float* QN = (float*)(a.ws + WS_QN); float* KN = (float*)(a.ws + WS_KN); float* GB = (float*)(a.ws + WS_GB);
    for (size_t i = gtid; i < (size_t)MT * DNH; i += gsz) { const int m = (int)(i / DNH), hd = (int)(i % DNH);
        const float* q = QKV + (size_t)m * 1536 + hd * 128; const float* k = q + 512; float sq = 0.f, sk = 0.f;
        for (int d = 0; d < 128; ++d) { sq += q[d] * q[d]; sk += k[d] * k[d]; }
        const float rq = FRSQ(sq + EPS) * 0.08838834764831845f, rk = 1.0f / sqrtf(sk + EPS);
        for (int d = 0; d < 128; ++d) { QN[(size_t)m * 512 + hd * 128 + d] = q[d] * rq; KN[(size_t)m * 512 + hd * 128 + d] = k[d] * rk; }
        if (m < MP) { float* KNT = (float*)(a.ws + WS_KNT) + (((size_t)(m / SEQ) * DNH + hd) * NC + (m % SEQ) / 64) * 8192 + (m % 64); for (int d = 0; d < 128; ++d) KNT[(size_t)d * 64] = k[d] * rk; }
        const float beta = sigmoidf_(P[(size_t)m * LDP + OFF_B + hd]);
        const float g = dn_g(a, r, (size_t)m, hd); float gc = g;
        if (m < MP) { const int t = m % SEQ; for (int tau = (t / 64) * 64; tau < t; ++tau) gc += dn_g(a, r, (size_t)(m - t + tau), hd); }
        GB[(size_t)m * 16 + hd * 4] = g; GB[(size_t)m * 16 + hd * 4 + 1] = beta; GB[(size_t)m * 16 + hd * 4 + 2] = gc; }
}
#ifndef HOST_TEST
#define DN_FENCE() asm volatile("" ::: "memory")
#else
#define DN_FENCE() do { } while (0)
#endif
HD void ph_dn_seq(const Args& a, int r, int seq_lo, size_t gtid, size_t gsz) {
    const float* QKV = (const float*)(a.ws + WS_QKV); const float* QN = (const float*)(a.ws + WS_QN); const float* KN = (const float*)(a.ws + WS_KN); const float* GB = (const float*)(a.ws + WS_GB);
    float* ODN = (float*)(a.ws + WS_ODN);
    for (size_t i = gtid; i < (size_t)(NB + DB - seq_lo) * DNH * 128; i += gsz) { const int v = (int)(i % 128), sh = UNI((int)(i / 128)), hd = sh % DNH, seq = seq_lo + sh / DNH;
        const int row0 = seq < NB ? seq * SEQ : MP + (seq - NB) * DT, T = seq < NB ? SEQ : DT;
        float S[128];
        if (seq < NB) {
#pragma unroll
            for (int d = 0; d < 128; ++d) S[d] = 0.f; }
        else { const float* s0 = a.in[I_SS] + ((((size_t)r * DB + (seq - NB)) * DNH + hd) * 128) * 128 + v;
#pragma unroll
            for (int d = 0; d < 128; ++d) S[d] = s0[(size_t)d * 128]; }
        for (int t = 0; t < T; ++t) { const size_t m = (size_t)(row0 + t);
            const float* kk = KN + m * 512 + hd * 128; const float* qq = QN + m * 512 + hd * 128;
            const float eg = FEXP(GB[m * 16 + hd * 4]), beta = GB[m * 16 + hd * 4 + 1], vv = QKV[m * 1536 + 1024 + hd * 128 + v];
            float ks = 0.f;
#pragma unroll
            for (int c = 0; c < 4; ++c) {
#pragma unroll
                for (int d = c * 32; d < c * 32 + 32; ++d) ks += kk[d] * S[d];
                DN_FENCE(); }
            const float cc = beta * (vv - eg * ks); float o = 0.f;
#pragma unroll
            for (int c = 0; c < 4; ++c) {
#pragma unroll
                for (int d = c * 32; d < c * 32 + 32; ++d) { S[d] = eg * S[d] + kk[d] * cc; o += qq[d] * S[d]; }
                DN_FENCE(); }
            ODN[m * 512 + hd * 128 + v] = o; }
        float* so = seq < NB ? a.out + O_SP + ((((size_t)r * NB + seq) * DNH + hd) * 128) * 128 + v : a.out + O_SS + ((((size_t)r * DB + (seq - NB)) * DNH + hd) * 128) * 128 + v;
#pragma unroll
        for (int d = 0; d < 128; ++d) so[(size_t)d * 128] = S[d]; }
}
HD void ph_dn_lat(const Args& a, size_t gtid, size_t gsz) {
    const float* QN = (const float*)(a.ws + WS_QN); const float* KN = (const float*)(a.ws + WS_KN); const float* GB = (const float*)(a.ws + WS_GB); const float* KNT = (const float*)(a.ws + WS_KNT);
    float* Lm = (float*)(a.ws + WS_L); bf16* AT = (bf16*)(a.ws + WS_AT); bf16* QG = (bf16*)(a.ws + WS_QG); bf16* KDT = (bf16*)(a.ws + WS_KDT); float* GL = (float*)(a.ws + WS_GL);
    for (size_t it = gtid; it < (size_t)NCU * 4096; it += gsz) { const int j = (int)(it % 64), ci = UNI((int)(it / 64)), i = ci % 64, cu = ci / 64;
        const int n = cu % NC, hd = (cu / NC) % DNH, b = cu / (NC * DNH); const size_t mi = (size_t)b * SEQ + n * 64 + i, mj = (size_t)b * SEQ + n * 64 + j;
        const float* ki = KN + mi * 512 + hd * 128; const float* qi = QN + mi * 512 + hd * 128; const float* kt = KNT + (size_t)cu * 8192 + j; float kk = 0.f, qk = 0.f;
        for (int d = 0; d < 128; ++d) { const float kj = kt[(size_t)d * 64]; kk += ki[d] * kj; qk += qi[d] * kj; }
        float lv = 0.f, av = 0.f;
        if (i >= j) { const float dec = FEXP(GB[mi * 16 + hd * 4 + 2] - GB[mj * 16 + hd * 4 + 2]); av = qk * dec; if (i > j) lv = GB[mi * 16 + hd * 4 + 1] * kk * dec; }
        Lm[it] = lv; AT[it] = f2bf(av); }
    for (size_t it = gtid; it < (size_t)NCU * 8192; it += gsz) { const int d = (int)(it % 128), i = (int)((it / 128) % 64), cu = (int)(it / 8192);
        const int n = cu % NC, hd = (cu / NC) % DNH, b = cu / (NC * DNH); const size_t mi = (size_t)b * SEQ + n * 64 + i;
        QG[it] = f2bf(QN[mi * 512 + hd * 128 + d] * FEXP(GB[mi * 16 + hd * 4 + 2])); }
    for (size_t it = gtid; it < (size_t)NCU * 8192; it += gsz) { const int i = (int)(it % 64), cu = (int)(it / 8192);
        const int n = cu % NC, hd = (cu / NC) % DNH, b = cu / (NC * DNH); const size_t mi = (size_t)b * SEQ + n * 64 + i, ml = (size_t)b * SEQ + n * 64 + 63;
        const float gci = GB[mi * 16 + hd * 4 + 2], gcl = GB[ml * 16 + hd * 4 + 2];
        KDT[it] = f2bf(KNT[it] * FEXP(gcl - gci)); if ((it % 8192) == 0) GL[cu] = FEXP(gcl); }
}
HD void ph_dn_solve(const Args& a, size_t gtid, size_t gsz) {
    const float* QKV = (const float*)(a.ws + WS_QKV); const float* KN = (const float*)(a.ws + WS_KN); const float* GB = (const float*)(a.ws + WS_GB); const float* Lm = (const float*)(a.ws + WS_L);
    float* UT = (float*)(a.ws + WS_UT); bf16* WN = (bf16*)(a.ws + WS_WN);
    for (size_t it = gtid; it < (size_t)NCU * 256; it += gsz) { const int col = (int)(it % 256), cu = UNI((int)(it / 256));
        const int n = cu % NC, hd = (cu / NC) % DNH, b = cu / (NC * DNH); const size_t m0 = (size_t)b * SEQ + n * 64; const float* Lc = Lm + (size_t)cu * 4096;
        float X[64];
#pragma unroll
        for (int j = 0; j < 64; ++j) { const float beta = GB[(m0 + j) * 16 + hd * 4 + 1];
            X[j] = col < 128 ? QKV[(m0 + j) * 1536 + 1024 + hd * 128 + col] * beta : KN[(m0 + j) * 512 + hd * 128 + (col - 128)] * beta * FEXP(GB[(m0 + j) * 16 + hd * 4 + 2]); }
#pragma unroll
        for (int i = 1; i < 64; ++i) { float acc = X[i];
#pragma unroll
            for (int j = 0; j < i; ++j) acc -= Lc[i * 64 + j] * X[j];
            X[i] = acc; DN_FENCE(); }
        if (col < 128) {
#pragma unroll
            for (int j = 0; j < 64; ++j) UT[(size_t)cu * 8192 + (size_t)col * 64 + j] = X[j]; }
        else {
#pragma unroll
            for (int j = 0; j < 64; ++j) WN[(size_t)cu * 8192 + (size_t)j * 128 + (col - 128)] = f2bf(-X[j]); } }
}
HD float bfr(float x) { return bf2f(f2bf(x)); }
HD void ph_dn_b_naive(const Args& a, int r, size_t gtid, size_t gsz) {
    const float* UT = (const float*)(a.ws + WS_UT); const bf16* WN = (const bf16*)(a.ws + WS_WN); const bf16* QG = (const bf16*)(a.ws + WS_QG); const bf16* AT = (const bf16*)(a.ws + WS_AT);
    const bf16* KDT = (const bf16*)(a.ws + WS_KDT); const float* GL = (const float*)(a.ws + WS_GL); float* ODN = (float*)(a.ws + WS_ODN); float* VN = (float*)(a.ws + WS_SCR);
    for (size_t it = gtid; it < (size_t)NB * DNH * 128; it += gsz) { const int v = (int)(it % 128), bh = UNI((int)(it / 128)), b = bh / DNH, hd = bh % DNH;
        float S[128];
#pragma unroll
        for (int d = 0; d < 128; ++d) S[d] = 0.f;
        for (int n = 0; n < NC; ++n) { const size_t cu = (size_t)bh * NC + n;
            for (int i = 0; i < 64; ++i) { float acc = UT[cu * 8192 + (size_t)v * 64 + i]; const bf16* wr = WN + cu * 8192 + i * 128;
#pragma unroll
                for (int d = 0; d < 128; ++d) acc += bf2f(wr[d]) * S[d];
                VN[((size_t)bh * 64 + i) * 128 + v] = acc; DN_FENCE(); }
            for (int i = 0; i < 64; ++i) { float acc = 0.f; const bf16* qr = QG + cu * 8192 + i * 128;
#pragma unroll
                for (int d = 0; d < 128; ++d) acc += bf2f(qr[d]) * S[d];
                for (int j = 0; j < 64; ++j) acc += bf2f(AT[cu * 4096 + i * 64 + j]) * bfr(VN[((size_t)bh * 64 + j) * 128 + v]);
                ODN[((size_t)b * SEQ + n * 64 + i) * 512 + hd * 128 + v] = acc; DN_FENCE(); }
            const float gl = GL[cu];
#pragma unroll
            for (int d = 0; d < 128; ++d) S[d] *= gl;
            for (int j = 0; j < 64; ++j) { const float vj = bfr(VN[((size_t)bh * 64 + j) * 128 + v]); const bf16* kr = KDT + cu * 8192 + j;
#pragma unroll
                for (int d = 0; d < 128; ++d) S[d] += bf2f(kr[d * 64]) * vj;
                DN_FENCE(); }
            DN_FENCE(); }
        float* so = a.out + O_SP + ((((size_t)r * NB + b) * DNH + hd) * 128) * 128 + v;
#pragma unroll
        for (int d = 0; d < 128; ++d) so[(size_t)d * 128] = S[d]; }
}
HD void ph_rec_out(const Args& a, int r, size_t gtid, size_t gsz) {
    const float* P = (const float*)(a.ws + WS_P); const float* HH = (const float*)(a.ws + WS_HH); const float* ODN = (const float*)(a.ws + WS_ODN); bf16* Y2 = (bf16*)(a.ws + WS_Y2);
    for (size_t i = gtid; i < (size_t)MT * Y2W; i += gsz) { const int m = (int)(i / Y2W), c = (int)(i % Y2W); float y;
        if (c < D_RNN) { float h = HH[(size_t)m * D_RNN + c]; if (m < MP) h += ((const float*)(a.ws + WS_XR))[(size_t)m * D_RNN + c] * ((const float*)(a.ws + WS_CARRY))[(size_t)(m / 64) * D_RNN + c];
            y = h * gelu_tanhf_(P[(size_t)m * LDP + OFF_GATE + c]); }
        else { const int cc = c - D_RNN, hd = cc / 128, vv = cc % 128; const float* o = ODN + (size_t)m * 512 + hd * 128; float ss = 0.f;
            for (int d = 0; d < 128; ++d) ss += o[d] * o[d];
            y = o[vv] / sqrtf(ss * (1.0f / 128.0f) + EPS) * a.in[I_DNW][r * 128 + vv] * siluf_(P[(size_t)m * LDP + OFF_Z + cc]); }
        Y2[i] = f2bf(y); }
}
HD void ph_att_split(const Args& a, int ai, size_t gtid, size_t gsz) {
    const float* P = (const float*)(a.ws + WS_P); constexpr int W = 2 * KVH * HDIM + IDIM;
    for (size_t i = gtid; i < (size_t)MT * W; i += gsz) { const int m = (int)(i / W), c = (int)(i % W);
        if (m < MP) { if (c < 256) a.out[O_KP + ((size_t)ai * MP + m) * 256 + c] = P[(size_t)m * LDP + AO_K + c];
            else if (c < 512) a.out[O_VP + ((size_t)ai * MP + m) * 256 + (c - 256)] = P[(size_t)m * LDP + AO_V + (c - 256)];
            else a.out[O_KIP + ((size_t)ai * MP + m) * 64 + (c - 512)] = P[(size_t)m * LDP + AO_KI + (c - 512)]; }
        else { const int ms = m - MP; if (c < 256) a.out[O_KS + ((size_t)ai * MS + ms) * 256 + c] = P[(size_t)m * LDP + AO_K + c];
            else if (c < 512) a.out[O_VS + ((size_t)ai * MS + ms) * 256 + (c - 256)] = P[(size_t)m * LDP + AO_V + (c - 256)];
            else a.out[O_KIS + ((size_t)ai * MS + ms) * 64 + (c - 512)] = P[(size_t)m * LDP + AO_KI + (c - 512)]; } }
}
HD const float* ki_row_sample(const Args& a, int ai, int db, int s) {
    if (s < PAST) { const int pg = ((const int*)a.in[I_PT])[db * NPAGES + s / PAGE]; return a.in[I_CKI] + (((size_t)ai * NPOOL + pg) * PAGE + s % PAGE) * IDIM; }
    return (const float*)(a.ws + WS_P) + (size_t)(MP + db * DT + (s - PAST)) * LDP + AO_KI;
}
HD void ph_idx_scores(const Args& a, int ai, bool prompt_too, size_t gtid, size_t gsz) {
    const float* P = (const float*)(a.ws + WS_P); float* SCT = (float*)(a.ws + WS_SCT);
    const int lane = (int)(gtid & 63); const size_t w = gtid >> 6, nw = gsz >> 6;
    constexpr int TM = 8, NKB = (SEQ + 63) / 64, NMT = SEQ / TM, NKBS = (PAST + DT + 63) / 64;
    const size_t n_p = (size_t)NB * NMT * NKB, n_s = (size_t)DB * NKBS;
    for (size_t it0 = w + (prompt_too ? 0 : n_p); it0 < n_p + n_s; it0 += nw) { const size_t it = (size_t)UNI((int)it0);
        int mrow0, nrows, s, smax_valid; const float* kr;
        if (it < n_p) { const int b = (int)(it / ((size_t)NMT * NKB)), rr = (int)(it % ((size_t)NMT * NKB)), mt = rr / NKB, kb = rr % NKB;
            if (kb * 64 > mt * TM + TM - 1) continue;
            mrow0 = b * SEQ + mt * TM; nrows = TM; s = kb * 64 + lane; smax_valid = SEQ; kr = P + (size_t)(b * SEQ + (s < SEQ ? s : 0)) * LDP + AO_KI; }
        else { const int q = (int)(it - n_p), db = q / NKBS, kb = q % NKBS; mrow0 = MP + db * DT; nrows = DT; s = kb * 64 + lane; smax_valid = PAST + DT; kr = ki_row_sample(a, ai, db, s < PAST + DT ? s : 0); }
        float kv[IDIM];
#pragma unroll
        for (int d = 0; d < IDIM; ++d) kv[d] = kr[d];
        for (int i = 0; i < nrows; ++i) { const int m = mrow0 + i; const float* qi = P + (size_t)m * LDP + AO_QI; const float* wi = P + (size_t)m * LDP + AO_WI; float sc = 0.f;
            for (int h = 0; h < IH; ++h) { float dot = 0.f;
#pragma unroll
                for (int d = 0; d < IDIM; ++d) dot += qi[h * IDIM + d] * kv[d];
                sc += wi[h] * fmaxf(dot, 0.f); }
            if (s < smax_valid) SCT[(size_t)m * SLD + s] = sc; } }
}
HD void ph_select(const Args& a, size_t gtid, size_t gsz) {
    const float* SCT = (const float*)(a.ws + WS_SCT); int* IDX = (int*)(a.ws + WS_IDX); int* NSEL = (int*)(a.ws + WS_NSEL);
    for (size_t m = gtid; m < (size_t)MT; m += gsz) { const RowInfo ri = row_info((int)m);
        const int n = ri.sample ? PAST + ri.t + 1 : ri.t + 1, K = ri.sample ? TOPK_S : TOPK_P; const float* col = SCT + m * SLD; int* out = IDX + m * KROW;
        if (n <= K) { for (int j = 0; j < n; ++j) out[j] = j; NSEL[m] = n; continue; }
        unsigned lo = 0u;
        for (int bit = 31; bit >= 0; --bit) { const unsigned cand = lo | (1u << bit); int c = 0;
            for (int s = 0; s < n; ++s) c += (fkey(col[s]) >= cand) ? 1 : 0;
            if (c >= K) lo = cand; }
        int cnt = 0;
        for (int s = 0; s < n; ++s) if (fkey(col[s]) > lo) out[cnt++] = s;
        for (int s = 0; s < n && cnt < K; ++s) if (fkey(col[s]) == lo) out[cnt++] = s;
        NSEL[m] = K; }
}
HD const float* kv_row(const Args& a, int ai, const RowInfo& ri, int idx, int kvh, bool isv) {
    const float* P = (const float*)(a.ws + WS_P); const int off = (isv ? AO_V : AO_K) + kvh * HDIM;
    if (!ri.sample) return P + (size_t)(ri.row0 + idx) * LDP + off;
    const int db = ri.seq - NB;
    if (idx >= PAST) return P + (size_t)(MP + db * DT + (idx - PAST)) * LDP + off;
    const int pg = ((const int*)a.in[I_PT])[db * NPAGES + idx / PAGE];
    return a.in[isv ? I_CV : I_CK] + ((((size_t)ai * NPOOL + pg) * PAGE + idx % PAGE) * KVH + kvh) * HDIM;
}
HD void ph_sp_scores(const Args& a, int ai, int m_lo, int m_hi, size_t gtid, size_t gsz) {
    const float* P = (const float*)(a.ws + WS_P); const int* IDX = (const int*)(a.ws + WS_IDX); const int* NSEL = (const int*)(a.ws + WS_NSEL); float* SCR = (float*)(a.ws + WS_SCR);
    for (size_t i = gtid + (size_t)m_lo * AH * KMAX; i < (size_t)m_hi * AH * KMAX; i += gsz) { const int j = (int)(i % KMAX), h = (int)((i / KMAX) % AH), m = (int)(i / ((size_t)KMAX * AH));
        if (j >= NSEL[m]) { SCR[i] = -1e30f; continue; }
        const RowInfo ri = row_info(m); const float* kr = kv_row(a, ai, ri, IDX[(size_t)m * KROW + j], h / GROUP, false); const float* q = P + (size_t)m * LDP + h * HDIM; float dot = 0.f;
        for (int d = 0; d < HDIM; ++d) dot += q[d] * kr[d];
        SCR[i] = dot * 0.08838834764831845f; }
}
HD void ph_sp_out(const Args& a, int ai, int m_lo, int m_hi, size_t gtid, size_t gsz) {
    const int* IDX = (const int*)(a.ws + WS_IDX); const int* NSEL = (const int*)(a.ws + WS_NSEL); const float* SCR = (const float*)(a.ws + WS_SCR); bf16* O = (bf16*)(a.ws + WS_Y2);
    for (size_t i = gtid + (size_t)m_lo * AH * HDIM; i < (size_t)m_hi * AH * HDIM; i += gsz) { const int d = (int)(i % HDIM), h = (int)((i / HDIM) % AH), m = (int)(i / ((size_t)HDIM * AH));
        const int ns = NSEL[m]; const float* sc = SCR + ((size_t)m * AH + h) * KMAX; const RowInfo ri = row_info(m);
        float mx = -3e38f; for (int j = 0; j < ns; ++j) mx = fmaxf(mx, sc[j]);
        float sum = 0.f, acc = 0.f;
        for (int j = 0; j < ns; ++j) { const float p = FEXP(sc[j] - mx); sum += p; acc += p * kv_row(a, ai, ri, IDX[(size_t)m * KROW + j], h / GROUP, true)[d]; }
        O[(size_t)m * D + h * HDIM + d] = f2bf(acc / sum); }
}
#ifndef HOST_TEST
#define LAS __attribute__((address_space(3)))

constexpr int LDS_WTAB = 131072 + 64;
__device__ __forceinline__ int TID() { extern __shared__ __attribute__((aligned(16))) unsigned char lds_dyn_[]; const unsigned hw = (unsigned)__builtin_amdgcn_s_getreg((5 << 11) | 4) & 63u;
    const int wvi = ((const LAS int*)((LAS unsigned char*)lds_dyn_ + LDS_WTAB))[hw]; int ln_; asm volatile("v_mbcnt_lo_u32_b32 %0, -1, 0\n\tv_mbcnt_hi_u32_b32 %0, -1, %0" : "=v"(ln_));
    return (wvi << 6) | ln_; }
#define XB_TMO      128
#define XB_XCNT(j)  (256  + 64 * (j))
#define XB_XSUB(j)  (1280 + 64 * (j))
#define XB_XGEN(j)  (2304 + 64 * (j))
#define XB_TOP      3328
#define XB_TOPGEN   3392
#define XCD_BAR_WORDS 3456
#define XB_SPIN_CAP (1u << 22)

__device__ __forceinline__ unsigned xb_ld(unsigned* p)              { return __hip_atomic_load(p, __ATOMIC_RELAXED, __HIP_MEMORY_SCOPE_AGENT); }
__device__ __forceinline__ unsigned xb_add(unsigned* p, unsigned v) { return __hip_atomic_fetch_add(p, v, __ATOMIC_RELAXED, __HIP_MEMORY_SCOPE_AGENT); }
__device__ __forceinline__ unsigned xb_xcc_id() { return (unsigned)__builtin_amdgcn_s_getreg((3 << 11) | 20) & 0xFu; }
#define XB_SPIN(cond, bar) do { unsigned _sp = 0; while (cond) { __builtin_amdgcn_s_sleep(1); \
    if ((++_sp & 255u) == 0u) { if (xb_ld(&(bar)[XB_TMO])) break; if (_sp > XB_SPIN_CAP) { atomicAdd(&(bar)[XB_TMO], 1u); break; } } } } while (0)

struct XcdBarrier {
    unsigned* bar; unsigned x;
    volatile LAS unsigned* st;
};

__device__ __forceinline__ XcdBarrier xcd_barrier_post(unsigned* bar, volatile LAS unsigned* st) {
    XcdBarrier b; b.bar = bar; b.x = xb_xcc_id(); b.st = st;
    if (TID() == 0) (void)xb_add(&bar[XB_XCNT(b.x)], 1u);
    return b;
}
__device__ __forceinline__ void xcd_barrier_complete(unsigned* bar, unsigned x, unsigned& nloc, unsigned& nx) {
    const unsigned G = gridDim.x * gridDim.y * gridDim.z;
    unsigned sum, cnt, mine, sp = 0u;
    for (;;) {
        sum = 0u; cnt = 0u; mine = 0u;
#pragma unroll
        for (unsigned j = 0; j < 16; ++j) { const unsigned c = xb_ld(&bar[XB_XCNT(j)]); sum += c; cnt += (c > 0u) ? 1u : 0u; mine = (j == x) ? c : mine; }
        if (sum == G) break;
        __builtin_amdgcn_s_sleep(1);
        if ((++sp & 255u) == 0u) { if (xb_ld(&bar[XB_TMO])) break; if (sp > XB_SPIN_CAP) { atomicAdd(&bar[XB_TMO], 1u); break; } }
    }
    nloc = mine > 0u ? mine : 1u; nx = cnt > 0u ? cnt : 1u;
}

__device__ __forceinline__ void xcd_barrier(const XcdBarrier& b) {
    asm volatile("s_waitcnt vmcnt(0)" ::: "memory");
    __syncthreads();
    if (TID() == 0) {
        unsigned* bar = b.bar;
        __builtin_amdgcn_s_waitcnt(0);
        unsigned nloc = b.st[0], nx = b.st[1];
        if (nloc == 0u) { xcd_barrier_complete(bar, b.x, nloc, nx); b.st[0] = nloc; b.st[1] = nx; }
        const unsigned old = xb_add(&bar[XB_XSUB(b.x)], 1u);
        const unsigned gen = old / nloc;
        if (old + 1u == (gen + 1u) * nloc) {
            __builtin_amdgcn_fence(__ATOMIC_RELEASE, "agent");
            asm volatile("s_waitcnt vmcnt(0)" ::: "memory");
            const unsigned og = xb_add(&bar[XB_TOP], 1u);
            const unsigned tg = og / nx;
            if (og + 1u == (tg + 1u) * nx) xb_add(&bar[XB_TOPGEN], 1u);
            else XB_SPIN(xb_ld(&bar[XB_TOPGEN]) == tg, bar);
            __builtin_amdgcn_fence(__ATOMIC_ACQUIRE, "agent");
            xb_add(&bar[XB_XGEN(b.x)], 1u);
            asm volatile("s_waitcnt vmcnt(0)" ::: "memory");
        } else {
            XB_SPIN(xb_ld(&bar[XB_XGEN(b.x)]) == gen, bar);
            __builtin_amdgcn_fence(__ATOMIC_ACQUIRE, "agent");
            asm volatile("s_waitcnt vmcnt(0)" ::: "memory");
        }
    }
    __syncthreads();
}

namespace pg8 {
#define PG8_LAS __attribute__((address_space(3)))
typedef unsigned short bf16_t;
typedef short bf16x8 __attribute__((ext_vector_type(8)));
typedef float f32x4 __attribute__((ext_vector_type(4)));
typedef unsigned u32x4 __attribute__((ext_vector_type(4)));
constexpr int BM = 256, BK = 64, HALF = 128, HTB = HALF * BK * 2  , STAGE_BYTES = 8 * HTB, NXCD = 8, WGM = 8;

__host__ __device__ __forceinline__ int lds_byte(int r, int c) { const int st = (r >> 4) * 2 + (c >> 5), rr = r & 15, cc = c & 31, ob = rr * 64 + cc * 2; return st * 1024 + (ob ^ (((ob >> 9) & 1) << 5)); }
__host__ __device__ __forceinline__ void stage_rc(int b, int& R, int& C) { const int st = b / 1024, sb = b % 1024, swz = sb ^ (((sb >> 9) & 1) << 5); R = (st >> 1) * 16 + swz / 64; C = (st & 1) * 32 + (swz % 64) / 2; }
__host__ __device__ __forceinline__ int perm32(int rho) { const int n = rho >> 4, i = rho & 15; return 8 * (i >> 2) + 4 * n + (i & 3); }

struct Unit { int pm, pn; };
struct Gemm { const bf16_t* A; const bf16_t* Bt; int M, N, K; };

struct StaticOrder {
    int nM, nN, nwg, G, c;
    __host__ __device__ void init(int M, int N, int G_, int c_) { nM = M / BM; nN = N / BM; nwg = nM * nN; G = G_; c = c_; }
    __host__ __device__ bool next(int i, Unit& u) const {
        const long L = (long)i * G + c; if (L >= nwg) return false;
        int wgid = (int)L; { const int q = nwg / NXCD, r = nwg % NXCD, xcd = wgid % NXCD, off = wgid / NXCD; wgid = (xcd < r ? xcd * (q + 1) : r * (q + 1) + (xcd - r) * q) + off; }
        const int nig = WGM * nN, gid = wgid / nig, fm = gid * WGM, gsz = (nM - fm) < WGM ? (nM - fm) : WGM;
        u.pm = fm + ((wgid % nig) % gsz); u.pn = (wgid % nig) / gsz; return true;
    }
    __device__ __forceinline__ void a_ready(const Unit&) const {}
    __device__ __forceinline__ void done(const Unit&) const {}
};

__device__ __forceinline__ unsigned cvt_pk_bf16(float lo, float hi) { unsigned r; asm volatile("v_cvt_pk_bf16_f32 %0, %1, %2" : "=v"(r) : "v"(lo), "v"(hi)); return r; }
struct EpiF32 {
    static constexpr bool PERM = false, AFTER_DRAIN = false;
    float* C; int ldc; const float* bias;
    __device__ __forceinline__ void operator()(const f32x4 (&acc)[2][2][4][2], const Unit& u, int wr, int wc, int fr, int fq) const {
        const int row0 = u.pm * BM + wr * 64 + fr, col0 = u.pn * BM + wc * 32 + 4 * fq;
        f32x4 bv[2][2];
#pragma unroll
        for (int bj = 0; bj < 2; ++bj)
#pragma unroll
            for (int n = 0; n < 2; ++n) bv[bj][n] = bias ? *(const f32x4*)(bias + col0 + bj * HALF + n * 16) : (f32x4){0.f, 0.f, 0.f, 0.f};
#pragma unroll
        for (int ai = 0; ai < 2; ++ai)
#pragma unroll
            for (int m = 0; m < 4; ++m) { float* rowp = C + (size_t)(row0 + ai * HALF + m * 16) * ldc + col0;
#pragma unroll
                for (int bj = 0; bj < 2; ++bj)
#pragma unroll
                    for (int n = 0; n < 2; ++n) *(f32x4*)(rowp + bj * HALF + n * 16) = acc[ai][bj][m][n] + bv[bj][n]; }
    }
};
template <class Epi, class Sched, bool STAMP = false>
__device__ __forceinline__ void gemm_phase(PG8_LAS unsigned char* lds, const Gemm g, const Sched& S, const Epi& E, unsigned long long* stamps) {
    int tid_ = TID(); asm volatile("" : "+v"(tid_));
    const int tid = tid_, wid = __builtin_amdgcn_readfirstlane(tid >> 6), lane = tid & 63, wr = wid >> 2, wc = wid & 3, fr = lane & 15, fq = lane >> 4;
    const int K = g.K, nt = K / BK;
    int ts_lo = 0, ts_hi = 0, nts = 0; const unsigned long long rt_entry = STAMP ? (unsigned long long)wall_clock64() : 0ull;
#define PG8_STAMP() do { if (STAMP && wid == 0 && nts < 64) { const unsigned long long _c = (unsigned long long)clock64(); \
        ts_lo = (lane == nts) ? (int)(unsigned)_c : ts_lo; ts_hi = (lane == nts) ? (int)(unsigned)(_c >> 32) : ts_hi; ++nts; } } while (0)
    PG8_STAMP();
    unsigned voffA[2], voffB[2];
#pragma unroll
    for (int i = 0; i < 2; ++i) { int R, C; stage_rc(tid * 16 + i * 8192, R, C); const int Rb = Epi::PERM ? ((R & ~31) + perm32(R & 31)) : R;
        voffA[i] = (unsigned)(R * K + C) * 2u; voffB[i] = (unsigned)(Rb * K + C) * 2u; }
    const size_t kstep = (size_t)(BK * 2);
    const size_t hstep = (size_t)HALF * K * 2;
    const size_t tstep = 2 * hstep;
    const unsigned ldsw = (unsigned)wid * 1024u;
    const int aoff = lds_byte(wr * 64 + fr, fq * 8), boff = lds_byte(wc * 32 + fr, fq * 8);
#define PG8_SA(b, h) (((b) * 2 + (h)) * HTB)
#define PG8_SB(b, h) ((4 + (b) * 2 + (h)) * HTB)
#define PG8_STAGE(bufoff, gbase, voff) do { _Pragma("unroll") for (int _i = 0; _i < 2; ++_i) \
        __builtin_amdgcn_global_load_lds((const unsigned*)((const char*)(gbase) + (voff)[_i]), (PG8_LAS unsigned*)(lds + (bufoff) + ldsw + _i * 8192), 16, 0, 0); } while (0)
#define PG8_LDA(dst, b, h) do { _Pragma("unroll") for (int m = 0; m < 4; ++m) _Pragma("unroll") for (int k = 0; k < 2; ++k) dst[m][k] = *(const PG8_LAS bf16x8*)(lds + PG8_SA(b, h) + aoff + m * 2048 + k * 1024); } while (0)
#define PG8_LDB(dst, b, h) do { _Pragma("unroll") for (int n = 0; n < 2; ++n) _Pragma("unroll") for (int k = 0; k < 2; ++k) dst[n][k] = *(const PG8_LAS bf16x8*)(lds + PG8_SB(b, h) + boff + n * 2048 + k * 1024); } while (0)
#define PG8_MMA(ai, bj, At, Bt) do { __builtin_amdgcn_s_setprio(1); _Pragma("unroll") for (int m = 0; m < 4; ++m) _Pragma("unroll") for (int n = 0; n < 2; ++n) _Pragma("unroll") for (int k = 0; k < 2; ++k) \
        acc[ai][bj][m][n] = __builtin_amdgcn_mfma_f32_16x16x32_bf16(Bt[n][k], At[m][k], acc[ai][bj][m][n], 0, 0, 0); __builtin_amdgcn_s_setprio(0); } while (0)
#define PG8_WAIT_V(n) asm volatile("s_waitcnt vmcnt(" #n ")" ::: "memory")
#define PG8_WAIT_L(n) asm volatile("s_waitcnt lgkmcnt(" #n ")" ::: "memory")
#define PG8_BAR __builtin_amdgcn_s_barrier()
#define PG8_SCHED __builtin_amdgcn_sched_barrier(0)
    Unit cur, nxt; int ui = 0;
    if (!S.next(0, cur)) return;
    f32x4 acc[2][2][4][2];
#pragma unroll
    for (int a = 0; a < 2; ++a)
#pragma unroll
        for (int b = 0; b < 2; ++b)
#pragma unroll
            for (int m = 0; m < 4; ++m)
#pragma unroll
                for (int n = 0; n < 2; ++n) acc[a][b][m][n] = (f32x4){0.f, 0.f, 0.f, 0.f};
    bf16x8 At[4][2], B0[2][2], B1[2][2];
    const char* cA = (const char*)g.A + (size_t)cur.pm * tstep; const char* cB = (const char*)g.Bt + (size_t)cur.pn * tstep;
    S.a_ready(cur);
    PG8_STAGE(PG8_SB(0, 0), cB, voffB); PG8_STAGE(PG8_SA(0, 0), cA, voffA); PG8_STAGE(PG8_SB(0, 1), cB + hstep, voffB); PG8_STAGE(PG8_SA(0, 1), cA + hstep, voffA);
    if (wr == 1) PG8_BAR;
    PG8_WAIT_V(4); PG8_BAR;
    PG8_STAGE(PG8_SB(1, 0), cB + kstep, voffB); PG8_STAGE(PG8_SA(1, 0), cA + kstep, voffA); PG8_STAGE(PG8_SB(1, 1), cB + hstep + kstep, voffB);
    PG8_WAIT_V(6); PG8_BAR;
    PG8_STAMP();
    for (;;) {
        const bool has_next = S.next(ui + 1, nxt);
        const char* nA = has_next ? (const char*)g.A + (size_t)nxt.pm * tstep : cA; const char* nB = has_next ? (const char*)g.Bt + (size_t)nxt.pn * tstep : cB;
        for (int t = 0; t < nt; t += 2) {
            const bool last = (t == nt - 2);
            const char* a1 = cA + (size_t)(t + 1) * kstep;
            const char* a2 = last ? nA : cA + (size_t)(t + 2) * kstep; const char* b2 = last ? nB : cB + (size_t)(t + 2) * kstep;
            const char* a3 = a2 + kstep; const char* b3 = b2 + kstep;
            if (last && has_next) S.a_ready(nxt);
            PG8_LDB(B0, 0, 0); PG8_SCHED; PG8_LDA(At, 0, 0); PG8_STAGE(PG8_SA(1, 1), a1 + hstep, voffA);
            PG8_WAIT_L(8); PG8_BAR; PG8_WAIT_L(0); PG8_MMA(0, 0, At, B0); PG8_BAR; PG8_SCHED;
            PG8_LDB(B1, 0, 1); PG8_STAGE(PG8_SB(0, 0), b2, voffB);
            PG8_BAR; PG8_WAIT_L(0); PG8_MMA(0, 1, At, B1); PG8_BAR;
            PG8_LDA(At, 0, 1); PG8_STAGE(PG8_SA(0, 0), a2, voffA);
            PG8_BAR; PG8_WAIT_L(0); PG8_MMA(1, 0, At, B0); PG8_BAR; PG8_SCHED;
            PG8_STAGE(PG8_SB(0, 1), b2 + hstep, voffB);
            PG8_WAIT_V(6); PG8_BAR; PG8_MMA(1, 1, At, B1); PG8_BAR;
            PG8_LDB(B0, 1, 0); PG8_SCHED; PG8_LDA(At, 1, 0); PG8_STAGE(PG8_SA(0, 1), a2 + hstep, voffA);
            PG8_WAIT_L(8); PG8_BAR; PG8_WAIT_L(0); PG8_MMA(0, 0, At, B0); PG8_BAR; PG8_SCHED;
            PG8_LDB(B1, 1, 1); PG8_STAGE(PG8_SB(1, 0), b3, voffB);
            PG8_BAR; PG8_WAIT_L(0); PG8_MMA(0, 1, At, B1); PG8_BAR;
            PG8_LDA(At, 1, 1); PG8_STAGE(PG8_SA(1, 0), a3, voffA);
            PG8_BAR; PG8_WAIT_L(0); PG8_MMA(1, 0, At, B0); PG8_BAR; PG8_SCHED;
            PG8_STAGE(PG8_SB(1, 1), b3 + hstep, voffB);
            PG8_WAIT_V(6); PG8_BAR; PG8_MMA(1, 1, At, B1); PG8_BAR;
        }
        PG8_STAMP();
        if constexpr (!Epi::AFTER_DRAIN) { E(acc, cur, wr, wc, fr, fq); S.done(cur); }
        PG8_STAMP();
        if (!has_next) break;
#pragma unroll
        for (int a = 0; a < 2; ++a)
#pragma unroll
            for (int b = 0; b < 2; ++b)
#pragma unroll
                for (int m = 0; m < 4; ++m)
#pragma unroll
                    for (int n = 0; n < 2; ++n) acc[a][b][m][n] = (f32x4){0.f, 0.f, 0.f, 0.f};
        cur = nxt; cA = nA; cB = nB; ++ui;
    }
    PG8_WAIT_V(0);
    if (wr == 0) PG8_BAR;
    PG8_BAR;
    if constexpr (Epi::AFTER_DRAIN) { E.fused(acc, cur, wr, wc, fr, fq, lds, wid, lane); S.done(cur); }
    PG8_STAMP();
    if (STAMP && wid == 0) { stamps[lane] = lane < nts ? (((unsigned long long)(unsigned)ts_hi << 32) | (unsigned)ts_lo) : 0ull;
        if (lane == 62) stamps[62] = rt_entry; if (lane == 63) stamps[63] = (unsigned long long)wall_clock64(); }
#undef PG8_STAMP
#undef PG8_SA
#undef PG8_SB
#undef PG8_STAGE
#undef PG8_LDA
#undef PG8_LDB
#undef PG8_MMA
#undef PG8_WAIT_V
#undef PG8_WAIT_L
#undef PG8_BAR
#undef PG8_SCHED
}
}
#endif

#ifndef HOST_TEST
#include <cstdio>
#define FRAG_OFF(row_, k_, KS_) ((((((row_) >> 4) * (KS_) + ((k_) >> 5)) * 64 + (((k_) >> 3) & 3) * 16 + ((row_) & 15)) * 8) + ((k_) & 7))
namespace pg8 {
struct EpiAddF32 {
    static constexpr bool PERM = false, AFTER_DRAIN = false;
    float* C; int ldc;
    __device__ __forceinline__ void operator()(const f32x4 (&acc)[2][2][4][2], const Unit& u, int wr, int wc, int fr, int fq) const {
        const int row0 = u.pm * BM + wr * 64 + fr, col0 = u.pn * BM + wc * 32 + 4 * fq;
#pragma unroll
        for (int ai = 0; ai < 2; ++ai)
#pragma unroll
            for (int m = 0; m < 4; ++m) { float* rowp = C + (size_t)(row0 + ai * HALF + m * 16) * ldc + col0;
#pragma unroll
                for (int bj = 0; bj < 2; ++bj)
#pragma unroll
                    for (int n = 0; n < 2; ++n) { f32x4* p = (f32x4*)(rowp + bj * HALF + n * 16); *p = *p + acc[ai][bj][m][n]; } }
    }
};
struct EpiRelu2Bf16 {
    static constexpr bool PERM = true, AFTER_DRAIN = false;
    bf16_t* O; int ldc;
    __device__ __forceinline__ void operator()(const f32x4 (&acc)[2][2][4][2], const Unit& u, int wr, int wc, int fr, int fq) const {
        const int row0 = u.pm * BM + wr * 64 + fr, col0 = u.pn * BM + wc * 32 + 8 * fq;
#pragma unroll
        for (int ai = 0; ai < 2; ++ai)
#pragma unroll
            for (int m = 0; m < 4; ++m) { bf16_t* rowp = O + (size_t)(row0 + ai * HALF + m * 16) * ldc + col0;
#pragma unroll
                for (int bj = 0; bj < 2; ++bj) { f32x4 v0 = acc[ai][bj][m][0], v1 = acc[ai][bj][m][1];
#pragma unroll
                    for (int j = 0; j < 4; ++j) { const float r0 = fmaxf(v0[j], 0.f), r1 = fmaxf(v1[j], 0.f); v0[j] = r0 * r0; v1[j] = r1 * r1; }
                    u32x4 w; w.x = cvt_pk_bf16(v0[0], v0[1]); w.y = cvt_pk_bf16(v0[2], v0[3]); w.z = cvt_pk_bf16(v1[0], v1[1]); w.w = cvt_pk_bf16(v1[2], v1[3]);
                    *(u32x4*)(rowp + bj * HALF) = w; } }
    }
};

__device__ __forceinline__ float epi_shfl_xor(float v, int o, int lane) { return __builtin_bit_cast(float, __builtin_amdgcn_ds_bpermute((lane ^ o) << 2, __builtin_bit_cast(int, v))); }
__device__ __forceinline__ float row_rs(const unsigned long long* ss, int row) { return FRSQ((float)ss[row] * (5.9604644775390625e-08f / D) + EPS); }
struct EpiF32S {
    static constexpr bool PERM = false, AFTER_DRAIN = false;
    float* C; int ldc; const unsigned long long* ss;
    __device__ __forceinline__ void operator()(const f32x4 (&acc)[2][2][4][2], const Unit& u, int wr, int wc, int fr_in, int fq_in) const {
        int fr = fr_in, fq = fq_in; asm volatile("" : "+v"(fr), "+v"(fq));
        const int row0 = u.pm * BM + wr * 64 + fr, col0 = u.pn * BM + wc * 32 + 4 * fq;
#pragma unroll
        for (int ai = 0; ai < 2; ++ai)
#pragma unroll
            for (int m = 0; m < 4; ++m) { const int row = row0 + ai * HALF + m * 16; const float rs = row_rs(ss, row); float* rowp = C + (size_t)row * ldc + col0;
#pragma unroll
                for (int bj = 0; bj < 2; ++bj)
#pragma unroll
                    for (int n = 0; n < 2; ++n) *(f32x4*)(rowp + bj * HALF + n * 16) = acc[ai][bj][m][n] * rs; }
    }
};
struct EpiRelu2S {
    static constexpr bool PERM = true, AFTER_DRAIN = false;
    bf16_t* O; int ldc; const unsigned long long* ss;
    __device__ __forceinline__ void operator()(const f32x4 (&acc)[2][2][4][2], const Unit& u, int wr, int wc, int fr_in, int fq_in) const {
        int fr = fr_in, fq = fq_in; asm volatile("" : "+v"(fr), "+v"(fq));
        const int row0 = u.pm * BM + wr * 64 + fr, col0 = u.pn * BM + wc * 32 + 8 * fq;
#pragma unroll
        for (int ai = 0; ai < 2; ++ai)
#pragma unroll
            for (int m = 0; m < 4; ++m) { const int row = row0 + ai * HALF + m * 16; const float rs = row_rs(ss, row); bf16_t* rowp = O + (size_t)row * ldc + col0;
#pragma unroll
                for (int bj = 0; bj < 2; ++bj) { f32x4 v0 = acc[ai][bj][m][0] * rs, v1 = acc[ai][bj][m][1] * rs;
#pragma unroll
                    for (int j = 0; j < 4; ++j) { const float r0 = fmaxf(v0[j], 0.f), r1 = fmaxf(v1[j], 0.f); v0[j] = r0 * r0; v1[j] = r1 * r1; }
                    u32x4 w; w.x = cvt_pk_bf16(v0[0], v0[1]); w.y = cvt_pk_bf16(v0[2], v0[3]); w.z = cvt_pk_bf16(v1[0], v1[1]); w.w = cvt_pk_bf16(v1[2], v1[3]);
                    *(u32x4*)(rowp + bj * HALF) = w; } }
    }
};
struct EpiAddN {
    static constexpr bool PERM = false, AFTER_DRAIN = false;
    float* C; int ldc; bf16_t* XB; unsigned long long* ss;
    __device__ __forceinline__ void operator()(const f32x4 (&acc)[2][2][4][2], const Unit& u, int wr, int wc, int fr_in, int fq_in) const {
        int fr = fr_in, fq = fq_in; asm volatile("" : "+v"(fr), "+v"(fq));
        const int row0 = u.pm * BM + wr * 64 + fr, col0 = u.pn * BM + wc * 32 + 4 * fq, lane = fq * 16 + fr;
#pragma unroll
        for (int ai = 0; ai < 2; ++ai)
#pragma unroll
            for (int m = 0; m < 4; ++m) { const int row = row0 + ai * HALF + m * 16; float* rowp = C + (size_t)row * ldc + col0; bf16_t* xbp = XB + (size_t)row * ldc + col0; float q = 0.f;
#pragma unroll
                for (int bj = 0; bj < 2; ++bj)
#pragma unroll
                    for (int n = 0; n < 2; ++n) { f32x4* p = (f32x4*)(rowp + bj * HALF + n * 16); const f32x4 v = *p + acc[ai][bj][m][n]; *p = v; q += (v[0] * v[0] + v[1] * v[1]) + (v[2] * v[2] + v[3] * v[3]);
                        unsigned w0 = cvt_pk_bf16(v[0], v[1]), w1 = cvt_pk_bf16(v[2], v[3]); *(uint2*)(xbp + bj * HALF + n * 16) = make_uint2(w0, w1); }
                q += epi_shfl_xor(q, 16, lane); q += epi_shfl_xor(q, 32, lane);
                if (fq == 0) __hip_atomic_fetch_add(ss + row, (unsigned long long)(q * 16777216.0f), __ATOMIC_RELAXED, __HIP_MEMORY_SCOPE_AGENT); }
    }
};
struct EpiAttS {
    static constexpr bool PERM = false, AFTER_DRAIN = false;
    unsigned char* ws; float* out; const unsigned long long* ss; int ai_;
    __device__ __forceinline__ void operator()(const f32x4 (&acc)[2][2][4][2], const Unit& u, int wr, int wc, int fr_in, int fq_in) const {
        int fr = fr_in, fq = fq_in; asm volatile("" : "+v"(fr), "+v"(fq));
        float* P = (float*)(ws + WS_P); constexpr int ldc = LDP; bf16_t* QB = (bf16_t*)(ws + WS_QB); bf16_t* KB = (bf16_t*)(ws + WS_KB); bf16_t* VB = (bf16_t*)(ws + WS_VB); bf16_t* QIB = (bf16_t*)(ws + WS_QIB); bf16_t* KIB = (bf16_t*)(ws + WS_KIB);
        const int row0 = u.pm * BM + wr * 64 + fr; float rsv[2][4];
#pragma unroll
        for (int ai = 0; ai < 2; ++ai)
#pragma unroll
            for (int m = 0; m < 4; ++m) rsv[ai][m] = row_rs(ss, row0 + ai * HALF + m * 16);
#pragma unroll
        for (int bj = 0; bj < 2; ++bj)
#pragma unroll
            for (int n = 0; n < 2; ++n) { const int cb = u.pn * BM + bj * HALF + wc * 32 + n * 16;
                bf16_t* bdst; int bld, bc; float* odst0 = nullptr; float* odst1 = nullptr; int old_ = 0;
                if (cb < AO_K) { bdst = QB; bld = D; bc = cb; }
                else if (cb < AO_V) { bdst = KB; bld = 256; bc = cb - AO_K; odst0 = out + O_KP + (size_t)ai_ * MP * 256 + bc; odst1 = out + O_KS + (size_t)ai_ * MS * 256 + bc; old_ = 256; }
                else if (cb < AO_QI) { bdst = VB; bld = 256; bc = cb - AO_V; odst0 = out + O_VP + (size_t)ai_ * MP * 256 + bc; odst1 = out + O_VS + (size_t)ai_ * MS * 256 + bc; old_ = 256; }
                else if (cb < AO_KI) { bdst = QIB; bld = 512; bc = cb - AO_QI; }
                else if (cb < AO_WI) { bdst = KIB; bld = -1; bc = cb - AO_KI;     odst0 = out + O_KIP + (size_t)ai_ * MP * 64 + bc; odst1 = out + O_KIS + (size_t)ai_ * MS * 64 + bc; old_ = 64; }
                else { bdst = nullptr; bld = 0; bc = 0; }
                const bool keepP = (u.pm * BM >= MP) || (cb >= AO_WI);
#pragma unroll
                for (int ai = 0; ai < 2; ++ai)
#pragma unroll
                    for (int m = 0; m < 4; ++m) { const int row = row0 + ai * HALF + m * 16; const f32x4 v = acc[ai][bj][m][n] * rsv[ai][m]; if (keepP) *(f32x4*)(P + (size_t)row * ldc + cb + 4 * fq) = v;
                        if (bdst != nullptr && row < MT) { bf16_t* bp_ = bld >= 0 ? bdst + (size_t)row * bld + bc + 4 * fq : bdst + (size_t)(row >> 4) * 1024 + FRAG_OFF(row & 15, bc + 4 * fq, 2); *(uint2*)bp_ = make_uint2(cvt_pk_bf16(v[0], v[1]), cvt_pk_bf16(v[2], v[3]));
                            if (odst0 != nullptr) { float* op = row < MP ? odst0 + (size_t)row * old_ : odst1 + (size_t)(row - MP) * old_; *(f32x4*)(op + 4 * fq) = v; } } } }
    }
};
}

constexpr int NTHREADS = 512, LDS_BYTES = 147456, LDS_MISC = 131072;
typedef float f32x4_t __attribute__((ext_vector_type(4)));
__device__ __forceinline__ float shfl_xor_l(float v, int o, int lane) { return __builtin_bit_cast(float, __builtin_amdgcn_ds_bpermute((lane ^ o) << 2, __builtin_bit_cast(int, v))); }
__device__ __forceinline__ void ph_rmsnorm(const Args& a, const float* g) {
    static_assert(D == 1024, "device rmsnorm is written for D = 1024");
    const float* X = (const float*)(a.ws + WS_X); bf16* XN = (bf16*)(a.ws + WS_XN);
    int tx_ = TID(); asm volatile("" : "+v"(tx_));
    const int lane = tx_ & 63, wv = blockIdx.x * (NTHREADS >> 6) + (tx_ >> 6), nwv = gridDim.x * (NTHREADS >> 6);
    f32x4_t gv[4];
#pragma unroll
    for (int i = 0; i < 4; ++i) gv[i] = *(const f32x4_t*)(g + (i * 64 + lane) * 4);
    for (int m = wv; m < MPAD; m += nwv) { f32x4_t xv[4]; float ss = 0.f;
#pragma unroll
        for (int i = 0; i < 4; ++i) { xv[i] = *(const f32x4_t*)(X + (size_t)m * D + (i * 64 + lane) * 4); ss += xv[i][0] * xv[i][0] + xv[i][1] * xv[i][1] + xv[i][2] * xv[i][2] + xv[i][3] * xv[i][3]; }
#pragma unroll
        for (int o = 32; o >= 1; o >>= 1) ss += shfl_xor_l(ss, o, lane);
        const float r = FRSQ(ss * (1.0f / D) + EPS);
#pragma unroll
        for (int i = 0; i < 4; ++i) { const f32x4_t y = xv[i] * r * gv[i]; uint2 w; w.x = pg8::cvt_pk_bf16(y[0], y[1]); w.y = pg8::cvt_pk_bf16(y[2], y[3]); *(uint2*)(XN + (size_t)m * D + (i * 64 + lane) * 4) = w; } }
}

__device__ __forceinline__ void ph_prep_x(const Args& a) {
    float* X = (float*)(a.ws + WS_X); bf16* XB = (bf16*)(a.ws + WS_XN); unsigned long long* SS = (unsigned long long*)(a.ws + WS_SS);
    int tx_ = TID(); asm volatile("" : "+v"(tx_));
    const int lane = tx_ & 63, wv = blockIdx.x * (NTHREADS >> 6) + (tx_ >> 6), nwv = gridDim.x * (NTHREADS >> 6);
    for (int m = wv; m < MPAD; m += nwv) { const float* src = m < MP ? a.in[I_XP] + (size_t)m * D : a.in[I_XS] + (size_t)(m - MP) * D; float ss = 0.f;
#pragma unroll
        for (int i = 0; i < 4; ++i) { f32x4_t v = {0.f, 0.f, 0.f, 0.f}; if (m < MT) v = *(const f32x4_t*)(src + (i * 64 + lane) * 4);
            *(f32x4_t*)(X + (size_t)m * D + (i * 64 + lane) * 4) = v; ss += v[0] * v[0] + v[1] * v[1] + v[2] * v[2] + v[3] * v[3];
            uint2 w; w.x = pg8::cvt_pk_bf16(v[0], v[1]); w.y = pg8::cvt_pk_bf16(v[2], v[3]); *(uint2*)(XB + (size_t)m * D + (i * 64 + lane) * 4) = w; }
#pragma unroll
        for (int o = 32; o >= 1; o >>= 1) ss += shfl_xor_l(ss, o, lane);
        if (lane == 0) SS[m] = (unsigned long long)(ss * 16777216.0f); }
}
__device__ __forceinline__ void ph_final(const Args& a) {
    const float* X = (const float*)(a.ws + WS_X); const float* g = a.in[I_NFIN];
    int tx_ = TID(); asm volatile("" : "+v"(tx_));
    const int lane = tx_ & 63, wv = blockIdx.x * (NTHREADS >> 6) + (tx_ >> 6), nwv = gridDim.x * (NTHREADS >> 6);
    f32x4_t gv[4];
#pragma unroll
    for (int i = 0; i < 4; ++i) gv[i] = *(const f32x4_t*)(g + (i * 64 + lane) * 4);
    for (int m = wv; m < MT; m += nwv) { f32x4_t xv[4]; float ss = 0.f;
#pragma unroll
        for (int i = 0; i < 4; ++i) { xv[i] = *(const f32x4_t*)(X + (size_t)m * D + (i * 64 + lane) * 4); ss += xv[i][0] * xv[i][0] + xv[i][1] * xv[i][1] + xv[i][2] * xv[i][2] + xv[i][3] * xv[i][3]; }
#pragma unroll
        for (int o = 32; o >= 1; o >>= 1) ss += shfl_xor_l(ss, o, lane);
        const float r = FRSQ(ss * (1.0f / D) + EPS);
        float* orow = a.out + (m < MP ? O_YP + (size_t)m * D : O_YS + (size_t)(m - MP) * D);
#pragma unroll
        for (int i = 0; i < 4; ++i) *(f32x4_t*)(orow + (i * 64 + lane) * 4) = xv[i] * r * gv[i]; }
}


#ifndef DIAG_WRITE_O
#define DIAG_WRITE_O 1
#define DIAG_WRITE_S 1
#endif
typedef short bf16x8_t __attribute__((ext_vector_type(8)));
typedef unsigned u32x2_t __attribute__((ext_vector_type(2)));
typedef unsigned u32x4_t __attribute__((ext_vector_type(4)));
typedef float f32x2_t __attribute__((ext_vector_type(2)));
typedef __bf16 bf16x2n_t __attribute__((ext_vector_type(2)));
__device__ __forceinline__ unsigned pk_bf16(float lo, float hi) { const f32x2_t v = {lo, hi}; const bf16x2n_t r = __builtin_convertvector(v, bf16x2n_t); return __builtin_bit_cast(unsigned, r); }
__device__ __forceinline__ void ph_dn_b(const Args& a, int r, LAS unsigned char* lds) {
    const float* UT = (const float*)(a.ws + WS_UT); const bf16* WN = (const bf16*)(a.ws + WS_WN); const bf16* QG = (const bf16*)(a.ws + WS_QG); const bf16* AT = (const bf16*)(a.ws + WS_AT);
    const bf16* KDT = (const bf16*)(a.ws + WS_KDT); const float* GL = (const float*)(a.ws + WS_GL); float* ODN = (float*)(a.ws + WS_ODN); float* DUMP = (float*)(a.ws + WS_SCR);
    int tid_ = TID(); asm volatile("" : "+v"(tid_));
    const int tid = tid_, wid = __builtin_amdgcn_readfirstlane(tid >> 6), lane = tid & 63, fr = lane & 15, fq = lane >> 4;
    constexpr int STS = 136, VTS = 72;
    LAS bf16* ST = (LAS bf16*)lds; LAS bf16* VT = (LAS bf16*)(lds + 16 * STS * 2);
    const bool vw = wid < 4; const float uf = vw ? 1.0f : 0.0f;
    for (int unit = blockIdx.x; unit < NB * DNH * 8; unit += gridDim.x) {
        const int slice = unit & 7, bh = unit >> 3, b = bh / DNH, hd = bh % DNH, c0 = slice * 16;
        f32x4_t accS = {0.f, 0.f, 0.f, 0.f};
        for (int i = tid; i < 16 * STS; i += NTHREADS) ST[i] = (bf16)0;
        __syncthreads();
        const int i0 = (wid & 3) * 16;
        const bf16* p1 = (vw ? WN : QG) + (size_t)bh * NC * 8192 + (size_t)((wid & 3) * 4) * 512 + lane * 8;
        const bf16* p2 = AT + (size_t)bh * NC * 4096 + (size_t)((wid & 3) * 2) * 512 + lane * 8;
        const bf16* p3 = KDT + (size_t)bh * NC * 8192 + (size_t)(wid * 2) * 512 + lane * 8;
        const float* pu = UT + (size_t)bh * NC * 8192 + (size_t)(slice * 4 + (wid & 3)) * 256 + lane * 4; const float* pg = GL + (size_t)bh * NC;
        LAS bf16* vtw = VT + (vw ? 0 : 16 * VTS) + fr * VTS + i0 + 4 * fq;
        float* op = (vw ? DUMP + ((size_t)blockIdx.x * NTHREADS + tid) * 4 - (size_t)0 : ODN + ((size_t)b * SEQ + i0 + 4 * fq) * 512 + hd * 128 + c0 + fr);
        const size_t ostep = vw ? 0 : (size_t)64 * 512, oq = vw ? 1 : 512;
        bf16x8_t s0a1[4], s0a2[2], s0a3[2], s1a1[4], s1a2[2], s1a3[2], s2a1[4], s2a2[2], s2a3[2]; f32x4_t s0u, s1u, s2u; float s0g, s1g, s2g;
#define DNB_LOAD(P_, n_) do { const size_t c_ = (size_t)((n_) < NC ? (n_) : NC - 1); \
            _Pragma("unroll") for (int ks = 0; ks < 4; ++ks) P_##a1[ks] = *(const bf16x8_t*)(p1 + c_ * 8192 + ks * 512); \
            _Pragma("unroll") for (int ks = 0; ks < 2; ++ks) { P_##a2[ks] = *(const bf16x8_t*)(p2 + c_ * 4096 + ks * 512); P_##a3[ks] = *(const bf16x8_t*)(p3 + c_ * 8192 + ks * 512); } \
            P_##u = *(const f32x4_t*)(pu + c_ * 8192); P_##g = pg[c_]; } while (0)
#define DNB_BAR() do { asm volatile("s_waitcnt lgkmcnt(0)" ::: "memory"); __builtin_amdgcn_s_barrier(); asm volatile("" ::: "memory"); } while (0)
#define DNB_STEP(C_, L_, n_) do { f32x4_t acc = C_##u * uf; const float gl = C_##g; bf16x8_t x1[4], x2[2], x3[2]; \
            _Pragma("unroll") for (int ks = 0; ks < 4; ++ks) x1[ks] = C_##a1[ks]; \
            _Pragma("unroll") for (int ks = 0; ks < 2; ++ks) { x2[ks] = C_##a2[ks]; x3[ks] = C_##a3[ks]; } \
            DNB_LOAD(L_, (n_) + 2); \
            bf16x8_t bS[4]; \
            _Pragma("unroll") for (int ks = 0; ks < 4; ++ks) bS[ks] = *(const LAS bf16x8_t*)(ST + fr * STS + ks * 32 + fq * 8); \
            _Pragma("unroll") for (int ks = 0; ks < 4; ++ks) acc = __builtin_amdgcn_mfma_f32_16x16x32_bf16(x1[ks], bS[ks], acc, 0, 0, 0); \
            { u32x2_t w; w.x = pk_bf16(acc[0], acc[1]); w.y = pk_bf16(acc[2], acc[3]); *(LAS u32x2_t*)vtw = w; } \
            DNB_BAR(); \
            bf16x8_t bV[2]; \
            _Pragma("unroll") for (int ks = 0; ks < 2; ++ks) bV[ks] = *(const LAS bf16x8_t*)(VT + fr * VTS + ks * 32 + fq * 8); \
            _Pragma("unroll") for (int ks = 0; ks < 2; ++ks) acc = __builtin_amdgcn_mfma_f32_16x16x32_bf16(x2[ks], bV[ks], acc, 0, 0, 0); \
            { float* o_ = op + (size_t)(n_) * ostep; _Pragma("unroll") for (int q = 0; q < 4; ++q) o_[(size_t)q * oq] = acc[q]; } \
            accS = accS * gl; \
            _Pragma("unroll") for (int ks = 0; ks < 2; ++ks) accS = __builtin_amdgcn_mfma_f32_16x16x32_bf16(x3[ks], bV[ks], accS, 0, 0, 0); \
            { u32x2_t w; w.x = pk_bf16(accS[0], accS[1]); w.y = pk_bf16(accS[2], accS[3]); *(LAS u32x2_t*)(ST + fr * STS + wid * 16 + 4 * fq) = w; } \
            DNB_BAR(); } while (0)
        static_assert(NC % 3 == 2, "the chunk loop is peeled for NC = 3 k + 2");
        DNB_LOAD(s0, 0); DNB_LOAD(s1, 1);
        int n = 0;
        for (; n + 2 < NC; n += 3) { DNB_STEP(s0, s2, n); DNB_STEP(s1, s0, n + 1); DNB_STEP(s2, s1, n + 2); }
        DNB_STEP(s0, s2, n); DNB_STEP(s1, s0, n + 1);
#undef DNB_STEP
#undef DNB_LOAD
        float* sp = a.out + O_SP + ((((size_t)r * NB + b) * DNH + hd) * 128 + wid * 16 + 4 * fq) * 128 + c0 + fr;
#pragma unroll
        for (int q = 0; q < 4; ++q) sp[(size_t)q * 128] = accS[q];
        __syncthreads();
    }
}


template <int NREG> __device__ __forceinline__ void select_row(const float* __restrict__ row, int n, int K, int* __restrict__ out, unsigned lane, LAS unsigned* cand_lds) {
    static_assert(NREG * 64 <= SLD, "row buffer too short");
    lane &= 63u;
    unsigned key[NREG];
#pragma unroll
    for (int i = 0; i < NREG; ++i) { const float f = __builtin_nontemporal_load(row + i * 64u + lane); key[i] = fkey(f) & (0u - ((unsigned)((int)(i * 64u + lane) - n) >> 31)); }
    if (NREG >= 32 && n >= 1024) { unsigned ls = 0u;
        for (int bit = 31; bit >= 0; --bit) { const unsigned cand = ls | (1u << bit); int c = 0;
#pragma unroll
            for (int i = 0; i < NREG; i += 8) c += __builtin_popcountll(__ballot(key[i] >= cand));
            if (c >= 48) ls = cand;
            if (c == 48) break; }
        int c0 = 0;
#pragma unroll
        for (int i = 0; i < NREG; ++i) c0 += __builtin_popcountll(__ballot(key[i] >= ls));
        if (c0 >= K && c0 <= 512) {
            asm volatile("" : "+v"(lane)); lane &= 63u; const unsigned long long bl = (1ull << lane) - 1ull; int base = 0;
            unsigned ls2 = ls; asm volatile("" : "+v"(ls2));
#pragma unroll
            for (int i = 0; i < NREG; ++i) { const bool g = key[i] >= ls2; const unsigned long long mg = __ballot(g);
                const int p = base + __builtin_popcountll(mg & bl); cand_lds[g ? (unsigned)p : 1024u + lane] = key[i]; cand_lds[g ? 512u + p : 1088u + lane] = i * 64u + lane;
                base += __builtin_popcountll(mg); }
            asm volatile("s_waitcnt lgkmcnt(0)" ::: "memory");
            unsigned ck[8], ci[8];
#pragma unroll
            for (int q = 0; q < 8; ++q) { const int p = q * 64 + (int)lane; const bool v = p < c0; ck[q] = v ? cand_lds[p] : 0u; ci[q] = v ? cand_lds[512 + p] : 0u; }
            unsigned lo2 = 0u;
            for (int bit = 31; bit >= 0; --bit) { const unsigned cand = lo2 | (1u << bit); int c = 0;
#pragma unroll
                for (int q = 0; q < 8; ++q) c += __builtin_popcountll(__ballot(ck[q] >= cand));
                if (c >= K) lo2 = cand;
                if (c == K) break; }
            int bg2 = 0;
#pragma unroll
            for (int q = 0; q < 8; ++q) { const bool g = ck[q] > lo2; const unsigned long long mg = __ballot(g);
                out[g ? (unsigned)(bg2 + __builtin_popcountll(mg & bl)) : KMAX + lane] = (int)ci[q]; bg2 += __builtin_popcountll(mg); }
            int be2 = 0;
#pragma unroll
            for (int q = 0; q < 8; ++q) { const bool e = ck[q] == lo2; const unsigned long long me = __ballot(e); const int slot = bg2 + be2 + __builtin_popcountll(me & bl);
                out[(e && slot < K) ? (unsigned)slot : KMAX + lane] = (int)ci[q]; be2 += __builtin_popcountll(me); }
            asm volatile("s_waitcnt lgkmcnt(0)" ::: "memory");
            return; } }
    unsigned lo = 0u;
    for (int bit = 31; bit >= 0; --bit) { const unsigned cand = lo | (1u << bit); int c = 0;
#pragma unroll
        for (int i = 0; i < NREG; ++i) c += __builtin_popcountll(__ballot(key[i] >= cand));
        if (c >= K) lo = cand;
        if (c == K) break; }
    asm volatile("" : "+v"(lane)); lane &= 63u;
    const unsigned long long below = (1ull << lane) - 1ull; int bg = 0;
#pragma unroll
    for (int i = 0; i < NREG; ++i) { const bool g = key[i] > lo; const unsigned long long mg = __ballot(g);
        out[g ? (unsigned)(bg + __builtin_popcountll(mg & below)) : KMAX + lane] = (int)(i * 64u + lane); bg += __builtin_popcountll(mg); }
    const int cg = bg; int be = 0; asm volatile("" : "+v"(lane)); lane &= 63u; const unsigned long long below2 = (1ull << lane) - 1ull;
#pragma unroll
    for (int i = 0; i < NREG; ++i) { const bool e = key[i] == lo; const unsigned long long me = __ballot(e); const int slot = cg + be + __builtin_popcountll(me & below2);
        out[(e && slot < K) ? (unsigned)slot : KMAX + lane] = (int)(i * 64u + lane); be += __builtin_popcountll(me); }
}
__device__ __forceinline__ void ph_select_w(const Args& a, LAS unsigned char* lds) {
    const float* SC = (const float*)(a.ws + WS_SCT); int* IDX = (int*)(a.ws + WS_IDX); int* NSEL = (int*)(a.ws + WS_NSEL);
    int tx_ = TID(); asm volatile("" : "+v"(tx_));
    const int lane0 = tx_ & 63, wv = __builtin_amdgcn_readfirstlane(blockIdx.x * (NTHREADS >> 6) + (tx_ >> 6)), nwv = gridDim.x * (NTHREADS >> 6);
    LAS unsigned* cand = (LAS unsigned*)(lds + (tx_ >> 6) * 4608);
    for (int m = MP + wv; m < MT; m += nwv) { const RowInfo ri = row_info(m); int lane = lane0; asm volatile("" : "+v"(lane));
        const int n = PAST + ri.t + 1, K = TOPK_S; const float* row = SC + (size_t)m * SLD; int* out = IDX + (size_t)m * KROW;
        if (n <= K) { for (int j = lane; j < n; j += 64) out[j] = j; if (lane == 0) NSEL[m] = n; continue; }
        select_row<(SLD / 64)>(row, n, K, out, lane, cand);
        if (lane == 0) NSEL[m] = K; }
}


__device__ __forceinline__ void ph_att_split_dev(const Args& a, int ai, size_t gtid, size_t gsz) {
    const float* P = (const float*)(a.ws + WS_P); bf16* QB = (bf16*)(a.ws + WS_XN); bf16* KB = (bf16*)(a.ws + WS_KB); bf16* VB = (bf16*)(a.ws + WS_VB); bf16* QIB = (bf16*)(a.ws + WS_QIB); bf16* KIB = (bf16*)(a.ws + WS_KIB);
    constexpr int W = AO_WI;
    for (size_t i = gtid; i < (size_t)MT * W; i += gsz) { const int m = (int)(i / W), c = (int)(i % W); const float v = P[(size_t)m * LDP + c];
        if (c < AO_K) QB[(size_t)m * D + c] = f2bf(v);
        else if (c < AO_V) { const int cc = c - AO_K; KB[(size_t)m * 256 + cc] = f2bf(v); if (m < MP) a.out[O_KP + ((size_t)ai * MP + m) * 256 + cc] = v; else a.out[O_KS + ((size_t)ai * MS + (m - MP)) * 256 + cc] = v; }
        else if (c < AO_QI) { const int cc = c - AO_V; VB[(size_t)m * 256 + cc] = f2bf(v); if (m < MP) a.out[O_VP + ((size_t)ai * MP + m) * 256 + cc] = v; else a.out[O_VS + ((size_t)ai * MS + (m - MP)) * 256 + cc] = v; }
        else if (c < AO_KI) QIB[(size_t)m * 512 + (c - AO_QI)] = f2bf(v);
        else { const int cc = c - AO_KI; KIB[(size_t)m * 64 + cc] = f2bf(v); if (m < MP) a.out[O_KIP + ((size_t)ai * MP + m) * 64 + cc] = v; else a.out[O_KIS + ((size_t)ai * MS + (m - MP)) * 64 + cc] = v; } }
}
__device__ __forceinline__ void ph_idx_mfma(const Args& a, LAS unsigned char* lds) {
    const float* P = (const float*)(a.ws + WS_P); const bf16* QIB = (const bf16*)(a.ws + WS_QIB); const bf16* KIB = (const bf16*)(a.ws + WS_KIB); float* SC = (float*)(a.ws + WS_SCT); int* IDX = (int*)(a.ws + WS_IDX); int* NSEL = (int*)(a.ws + WS_NSEL);
    int tx_ = TID(); asm volatile("" : "+v"(tx_));
    const int lane = tx_ & 63, fr = lane & 15, fq = lane >> 4, wv = __builtin_amdgcn_readfirstlane(blockIdx.x * (NTHREADS >> 6) + (tx_ >> 6)), nwv = gridDim.x * (NTHREADS >> 6);
    constexpr int NU = MP / 4;
    for (int pr2 = wv * 2; pr2 < NU; pr2 += nwv * 2) for (int u0 = pr2; u0 < pr2 + 2; ++u0) { const int hh = u0 >> 1, u = (u0 & 1) ? (NU - 1 - hh) : hh;
        const int m0 = u * 4, b = m0 / SEQ, t0 = m0 % SEQ;
        int lnu = lane; asm volatile("" : "+v"(lnu)); const int fr = lnu & 15, fq = (lnu >> 4) & 3;
        bf16x8_t aQ[2][2];
#pragma unroll
        for (int p = 0; p < 2; ++p)
#pragma unroll
            for (int ks = 0; ks < 2; ++ks) aQ[p][ks] = *(const bf16x8_t*)(QIB + (size_t)(m0 + (fr >> 2)) * 512 + (4 * p + (fr & 3)) * 64 + ks * 32 + fq * 8);
        const f32x4_t w0 = *(const f32x4_t*)(P + (size_t)(m0 + fq) * LDP + AO_WI), w1 = *(const f32x4_t*)(P + (size_t)(m0 + fq) * LDP + AO_WI + 4);
        float* scrow = SC + (size_t)(m0 + fq) * SLD + fr;
        const int nkt = (t0 + 3) / 16 + 1;
        bf16x8_t bKa[4][2], bKb[4][2];
#define IDX_LOAD(B_, kt0_) do { _Pragma("unroll") for (int q = 0; q < 4; ++q) { const int kt = (kt0_) + q < nkt ? (kt0_) + q : nkt - 1; const bf16* kr = KIB + ((size_t)b * (SEQ / 16) + kt) * 1024 + lnu * 8; \
            B_[q][0] = *(const bf16x8_t*)kr; B_[q][1] = *(const bf16x8_t*)(kr + 512); } } while (0)
#define IDX_COMP(B_, kt0_) do { _Pragma("unroll") for (int q = 0; q < 4; ++q) { if ((kt0_) + q < nkt) { f32x4_t c0 = {0.f, 0.f, 0.f, 0.f}, c1 = {0.f, 0.f, 0.f, 0.f}; \
                    c0 = __builtin_amdgcn_mfma_f32_16x16x32_bf16(aQ[0][0], B_[q][0], c0, 0, 0, 0); c0 = __builtin_amdgcn_mfma_f32_16x16x32_bf16(aQ[0][1], B_[q][1], c0, 0, 0, 0); \
                    c1 = __builtin_amdgcn_mfma_f32_16x16x32_bf16(aQ[1][0], B_[q][0], c1, 0, 0, 0); c1 = __builtin_amdgcn_mfma_f32_16x16x32_bf16(aQ[1][1], B_[q][1], c1, 0, 0, 0); \
                    __builtin_nontemporal_store((w0[0] * fmaxf(c0[0], 0.f) + w0[1] * fmaxf(c0[1], 0.f)) + (w0[2] * fmaxf(c0[2], 0.f) + w0[3] * fmaxf(c0[3], 0.f)) \
                                             + (w1[0] * fmaxf(c1[0], 0.f) + w1[1] * fmaxf(c1[1], 0.f)) + (w1[2] * fmaxf(c1[2], 0.f) + w1[3] * fmaxf(c1[3], 0.f)), scrow + ((kt0_) + q) * 16); } } } while (0)
        IDX_LOAD(bKa, 0);
        for (int kt0 = 0; kt0 < nkt; kt0 += 8) { IDX_LOAD(bKb, kt0 + 4); IDX_COMP(bKa, kt0); IDX_LOAD(bKa, kt0 + 8); IDX_COMP(bKb, kt0 + 4); }
#undef IDX_LOAD
#undef IDX_COMP
        LAS unsigned* cand = (LAS unsigned*)(lds + (tx_ >> 6) * 4608);
        for (int q = 0; q < 4; ++q) { const int m = m0 + q, n = t0 + q + 1, K = TOPK_P; int ln = lane; asm volatile("" : "+v"(ln));
            const float* row = SC + (size_t)m * SLD; int* out = IDX + (size_t)m * KROW;
            if (n <= K) { for (int j = ln; j < n; j += 64) out[j] = j; if (ln == 0) NSEL[m] = n; continue; }
            if (n <= 2048) select_row<32>(row, n, K, out, ln, cand);
            else if (n <= 4096) select_row<64>(row, n, K, out, ln, cand);
            else if (n <= 6144) select_row<96>(row, n, K, out, ln, cand);
            else select_row<128>(row, n, K, out, ln, cand);
            if (ln == 0) NSEL[m] = K; }
    }
}
__device__ __forceinline__ void ph_idx_sample_mfma(const Args& a, int ai) {
    const float* P = (const float*)(a.ws + WS_P); const bf16* QIB = (const bf16*)(a.ws + WS_QIB); float* SC = (float*)(a.ws + WS_SCT); const int* PT = (const int*)a.in[I_PT]; const float* CKI = a.in[I_CKI];
    int tx_ = TID(); asm volatile("" : "+v"(tx_));
    const int lane = tx_ & 63, fr = lane & 15, fq = lane >> 4, wv = __builtin_amdgcn_readfirstlane(blockIdx.x * (NTHREADS >> 6) + (tx_ >> 6)), nwv = gridDim.x * (NTHREADS >> 6);
    constexpr int NKT = (PAST + DT + 15) / 16, SPL = 64, TPU = (NKT + SPL - 1) / SPL;
    static_assert(PAGE % 16 == 0 && PAST % 16 == 0 && DT <= 16, "sample index tiles");
    for (int u = wv; u < DB * SPL; u += nwv) { const int db = u / SPL, k0 = (u % SPL) * TPU, k1 = (k0 + TPU < NKT) ? k0 + TPU : NKT; const int m0 = MP + db * DT;
        if (k0 >= k1) continue;
        bf16x8_t aQ[2][2];
#pragma unroll
        for (int p = 0; p < 2; ++p)
#pragma unroll
            for (int ks = 0; ks < 2; ++ks) aQ[p][ks] = *(const bf16x8_t*)(QIB + (size_t)(m0 + (fr >> 2)) * 512 + (4 * p + (fr & 3)) * 64 + ks * 32 + fq * 8);
        const f32x4_t w0 = *(const f32x4_t*)(P + (size_t)(m0 + fq) * LDP + AO_WI), w1 = *(const f32x4_t*)(P + (size_t)(m0 + fq) * LDP + AO_WI + 4);
        float* scrow = SC + (size_t)(m0 + fq) * SLD + fr;
        for (int kb = k0; kb < k1; kb += 3) { f32x4_t kf[3][4];
#pragma unroll
            for (int q = 0; q < 3; ++q) { const int kt = kb + q < k1 ? kb + q : k1 - 1, s0 = kt * 16; const float* kr;
                if (s0 < PAST) { const int pg = PT[db * NPAGES + s0 / PAGE]; kr = CKI + (((size_t)ai * NPOOL + pg) * PAGE + (s0 % PAGE) + fr) * IDIM + fq * 8; }
                else kr = P + (size_t)(m0 + (fr < DT ? fr : DT - 1)) * LDP + AO_KI + fq * 8;
                kf[q][0] = *(const f32x4_t*)kr; kf[q][1] = *(const f32x4_t*)(kr + 4); kf[q][2] = *(const f32x4_t*)(kr + 32); kf[q][3] = *(const f32x4_t*)(kr + 36); }
#pragma unroll
            for (int q = 0; q < 3; ++q) { if (kb + q < k1) { const int s0 = (kb + q) * 16; u32x4_t b0, b1;
                b0[0] = pk_bf16(kf[q][0][0], kf[q][0][1]); b0[1] = pk_bf16(kf[q][0][2], kf[q][0][3]); b0[2] = pk_bf16(kf[q][1][0], kf[q][1][1]); b0[3] = pk_bf16(kf[q][1][2], kf[q][1][3]);
                b1[0] = pk_bf16(kf[q][2][0], kf[q][2][1]); b1[1] = pk_bf16(kf[q][2][2], kf[q][2][3]); b1[2] = pk_bf16(kf[q][3][0], kf[q][3][1]); b1[3] = pk_bf16(kf[q][3][2], kf[q][3][3]);
                const bf16x8_t bK0 = __builtin_bit_cast(bf16x8_t, b0), bK1 = __builtin_bit_cast(bf16x8_t, b1);
                f32x4_t c0 = {0.f, 0.f, 0.f, 0.f}, c1 = {0.f, 0.f, 0.f, 0.f};
                c0 = __builtin_amdgcn_mfma_f32_16x16x32_bf16(aQ[0][0], bK0, c0, 0, 0, 0); c0 = __builtin_amdgcn_mfma_f32_16x16x32_bf16(aQ[0][1], bK1, c0, 0, 0, 0);
                c1 = __builtin_amdgcn_mfma_f32_16x16x32_bf16(aQ[1][0], bK0, c1, 0, 0, 0); c1 = __builtin_amdgcn_mfma_f32_16x16x32_bf16(aQ[1][1], bK1, c1, 0, 0, 0);
                scrow[s0] = (w0[0] * fmaxf(c0[0], 0.f) + w0[1] * fmaxf(c0[1], 0.f)) + (w0[2] * fmaxf(c0[2], 0.f) + w0[3] * fmaxf(c0[3], 0.f))
                          + (w1[0] * fmaxf(c1[0], 0.f) + w1[1] * fmaxf(c1[1], 0.f)) + (w1[2] * fmaxf(c1[2], 0.f) + w1[3] * fmaxf(c1[3], 0.f)); } } } }
}

__device__ __forceinline__ void ph_sparse_attn(const Args& a, LAS unsigned char* lds) {
    const bf16* QB = (const bf16*)(a.ws + WS_QB); const bf16* KB = (const bf16*)(a.ws + WS_KB); const bf16* VB = (const bf16*)(a.ws + WS_VB); const int* IDX = (const int*)(a.ws + WS_IDX); const int* NSEL = (const int*)(a.ws + WS_NSEL);
    bf16* O = (bf16*)(a.ws + WS_Y2);
    int tx_ = TID(); asm volatile("" : "+v"(tx_));
    const int lane = tx_ & 63, fr = lane & 15, fq = lane >> 4, wid = __builtin_amdgcn_readfirstlane(tx_ >> 6), wv = blockIdx.x * (NTHREADS >> 6) + wid, nwv = gridDim.x * (NTHREADS >> 6);
    LAS int* IDXS = (LAS int*)(lds + wid * 9216); LAS float* PS = (LAS float*)(lds + wid * 9216 + 1024);
    for (int m = wv; m < MP; m += nwv) { const int b = m / SEQ; const int ns = __builtin_amdgcn_readfirstlane(NSEL[m]);
#pragma unroll
        for (int c = 0; c < 4; ++c) { const int j = lane + 64 * c; IDXS[j] = j < ns ? IDX[(size_t)m * KROW + j] : 0; }
        bf16x8_t bQ[2][4];
#pragma unroll
        for (int kv = 0; kv < 2; ++kv)
#pragma unroll
            for (int ks = 0; ks < 4; ++ks) { bQ[kv][ks] = (bf16x8_t){0, 0, 0, 0, 0, 0, 0, 0}; if (fr < 4) bQ[kv][ks] = *(const bf16x8_t*)(QB + (size_t)m * D + (kv * 4 + fr) * 128 + ks * 32 + fq * 8); }
        asm volatile("s_waitcnt lgkmcnt(0)" ::: "memory");
#pragma unroll
        for (int tb = 0; tb < 16; tb += 2) { bf16x8_t ak[2][2][4];
#pragma unroll
            for (int t = 0; t < 2; ++t) { const int ri = IDXS[(tb + t) * 16 + fr]; const bf16* kb = KB + (size_t)(b * SEQ + ri) * 256 + fq * 8;
#pragma unroll
                for (int kv = 0; kv < 2; ++kv)
#pragma unroll
                    for (int ks = 0; ks < 4; ++ks) ak[t][kv][ks] = *(const bf16x8_t*)(kb + kv * 128 + ks * 32); }
#pragma unroll
            for (int t = 0; t < 2; ++t)
#pragma unroll
                for (int kv = 0; kv < 2; ++kv) { f32x4_t acc = {0.f, 0.f, 0.f, 0.f};
#pragma unroll
                    for (int ks = 0; ks < 4; ++ks) acc = __builtin_amdgcn_mfma_f32_16x16x32_bf16(ak[t][kv][ks], bQ[kv][ks], acc, 0, 0, 0);
                    if (fr < 4) {
#pragma unroll
                        for (int q = 0; q < 4; ++q) { const int j = (tb + t) * 16 + 4 * fq + q; PS[j * 8 + kv * 4 + fr] = j < ns ? acc[q] * 0.08838834764831845f : -1e30f; } } } }
        asm volatile("s_waitcnt lgkmcnt(0)" ::: "memory");
        { f32x4_t sv[4][2]; float mx[8];
#pragma unroll
            for (int h = 0; h < 8; ++h) mx[h] = -3e38f;
#pragma unroll
            for (int c = 0; c < 4; ++c) { sv[c][0] = *(const LAS f32x4_t*)(PS + (lane + 64 * c) * 8); sv[c][1] = *(const LAS f32x4_t*)(PS + (lane + 64 * c) * 8 + 4);
#pragma unroll
                for (int h = 0; h < 8; ++h) mx[h] = fmaxf(mx[h], sv[c][h >> 2][h & 3]); }
#pragma unroll
            for (int o = 32; o >= 1; o >>= 1)
#pragma unroll
                for (int h = 0; h < 8; ++h) mx[h] = fmaxf(mx[h], shfl_xor_l(mx[h], o, lane));
            float sum[8];
#pragma unroll
            for (int h = 0; h < 8; ++h) sum[h] = 0.f;
#pragma unroll
            for (int c = 0; c < 4; ++c)
#pragma unroll
                for (int h = 0; h < 8; ++h) { const float e = FEXP(sv[c][h >> 2][h & 3] - mx[h]); sv[c][h >> 2][h & 3] = e; sum[h] += e; }
#pragma unroll
            for (int o = 32; o >= 1; o >>= 1)
#pragma unroll
                for (int h = 0; h < 8; ++h) sum[h] += shfl_xor_l(sum[h], o, lane);
#pragma unroll
            for (int h = 0; h < 8; ++h) sum[h] = FRCP(sum[h]);
#pragma unroll
            for (int c = 0; c < 4; ++c) { f32x4_t p0, p1;
#pragma unroll
                for (int h = 0; h < 4; ++h) { p0[h] = sv[c][0][h] * sum[h]; p1[h] = sv[c][1][h] * sum[4 + h]; }
                *(LAS f32x4_t*)(PS + (lane + 64 * c) * 8) = p0; *(LAS f32x4_t*)(PS + (lane + 64 * c) * 8 + 4) = p1; } }
        asm volatile("s_waitcnt lgkmcnt(0)" ::: "memory");
        f32x4_t o4[4] = {{0.f, 0.f, 0.f, 0.f}, {0.f, 0.f, 0.f, 0.f}, {0.f, 0.f, 0.f, 0.f}, {0.f, 0.f, 0.f, 0.f}};
        const int kvl = lane >> 5; const char* vb8 = (const char*)(VB + (size_t)b * SEQ * 256);
        const unsigned loff = (unsigned)(kvl * 128 + (lane & 31) * 4) * 2u;
        for (int j0 = 0; j0 < ns; j0 += 32) { u32x2_t vv[32];
#pragma unroll
            for (int jj = 0; jj < 32; ++jj) { const unsigned off = (unsigned)IDXS[j0 + jj] * 512u + loff; vv[jj] = *(const u32x2_t*)(vb8 + off); }
#pragma unroll
            for (int jj = 0; jj < 32; ++jj) { const f32x4_t p4 = *(const LAS f32x4_t*)(PS + (j0 + jj) * 8 + kvl * 4);
                const f32x4_t vf = {__builtin_bit_cast(float, vv[jj][0] << 16), __builtin_bit_cast(float, vv[jj][0] & 0xffff0000u), __builtin_bit_cast(float, vv[jj][1] << 16), __builtin_bit_cast(float, vv[jj][1] & 0xffff0000u)};
#pragma unroll
                for (int h = 0; h < 4; ++h) o4[h] += vf * p4[h]; } }
#pragma unroll
        for (int h = 0; h < 4; ++h) { u32x2_t w; w[0] = pk_bf16(o4[h][0], o4[h][1]); w[1] = pk_bf16(o4[h][2], o4[h][3]); *(u32x2_t*)(O + (size_t)m * D + (kvl * 4 + h) * 128 + (lane & 31) * 4) = w; }
        asm volatile("s_waitcnt lgkmcnt(0)" ::: "memory");
    }
}

__device__ __forceinline__ void ph_sparse_sample(const Args& a, int ai, LAS unsigned char* lds) {
    const float* P = (const float*)(a.ws + WS_P); const int* IDX = (const int*)(a.ws + WS_IDX); const int* NSEL = (const int*)(a.ws + WS_NSEL); bf16* O = (bf16*)(a.ws + WS_Y2);
    int tx_ = TID(); asm volatile("" : "+v"(tx_));
    const int lane = tx_ & 63, wid = __builtin_amdgcn_readfirstlane(tx_ >> 6), wv = blockIdx.x * (NTHREADS >> 6) + wid, nwv = gridDim.x * (NTHREADS >> 6);
    LAS float* QS = (LAS float*)(lds + wid * 9216); LAS float* PSs = (LAS float*)(lds + wid * 9216 + 512); LAS unsigned long long* VP = (LAS unsigned long long*)(lds + wid * 9216 + 1536);
    for (int u = wv; u < MS * AH; u += nwv) { const int m = MP + u / AH, h = u % AH, kvh = h / GROUP; const RowInfo ri = row_info(m); const int ns = __builtin_amdgcn_readfirstlane(NSEL[m]);
        { const f32x2_t q2 = *(const f32x2_t*)(P + (size_t)m * LDP + h * HDIM + 2 * lane); QS[2 * lane] = q2[0]; QS[2 * lane + 1] = q2[1]; }
        const float* kp[4];
#pragma unroll
        for (int c = 0; c < 4; ++c) { const int j = lane + 64 * c; const int idx = j < ns ? IDX[(size_t)m * KROW + j] : 0; kp[c] = kv_row(a, ai, ri, idx, kvh, false); VP[j] = (unsigned long long)(size_t)kv_row(a, ai, ri, idx, kvh, true); }
        asm volatile("s_waitcnt lgkmcnt(0)" ::: "memory");
        float sc[4] = {0.f, 0.f, 0.f, 0.f};
        for (int d0 = 0; d0 < HDIM; d0 += 16) { f32x4_t kq[4][4];
#pragma unroll
            for (int e = 0; e < 4; ++e)
#pragma unroll
                for (int c = 0; c < 4; ++c) kq[e][c] = *(const f32x4_t*)(kp[c] + d0 + 4 * e);
#pragma unroll
            for (int e = 0; e < 4; ++e) { const f32x4_t q4 = *(const LAS f32x4_t*)(QS + d0 + 4 * e);
#pragma unroll
                for (int c = 0; c < 4; ++c) sc[c] += (kq[e][c][0] * q4[0] + kq[e][c][1] * q4[1]) + (kq[e][c][2] * q4[2] + kq[e][c][3] * q4[3]); } }
        float mx = -3e38f;
#pragma unroll
        for (int c = 0; c < 4; ++c) { sc[c] = (lane + 64 * c) < ns ? sc[c] * 0.08838834764831845f : -1e30f; mx = fmaxf(mx, sc[c]); }
#pragma unroll
        for (int o = 32; o >= 1; o >>= 1) mx = fmaxf(mx, shfl_xor_l(mx, o, lane));
        float sum = 0.f;
#pragma unroll
        for (int c = 0; c < 4; ++c) { sc[c] = FEXP(sc[c] - mx); sum += sc[c]; }
#pragma unroll
        for (int o = 32; o >= 1; o >>= 1) sum += shfl_xor_l(sum, o, lane);
        const float inv = FRCP(sum);
#pragma unroll
        for (int c = 0; c < 4; ++c) PSs[lane + 64 * c] = sc[c] * inv;
        asm volatile("s_waitcnt lgkmcnt(0)" ::: "memory");
        f32x2_t o2 = {0.f, 0.f};
        for (int j0 = 0; j0 < ns; j0 += 16) { f32x2_t vv[16];
#pragma unroll
            for (int jj = 0; jj < 16; ++jj) { const float* vp = (const float*)(size_t)VP[j0 + jj]; vv[jj] = *(const f32x2_t*)(vp + 2 * lane); }
#pragma unroll
            for (int jj = 0; jj < 16; ++jj) o2 += vv[jj] * PSs[j0 + jj]; }
        *(unsigned*)(O + (size_t)m * D + h * HDIM + 2 * lane) = pk_bf16(o2[0], o2[1]);
        asm volatile("s_waitcnt lgkmcnt(0)" ::: "memory");
    }
}

__device__ __forceinline__ void ph_rg_chunk(const Args& a, int r, LAS unsigned char* lds) {
    const float* P = (const float*)(a.ws + WS_P); float* HH = (float*)(a.ws + WS_HH); float* AP = (float*)(a.ws + WS_XR);
    const float* wc = a.in[I_WCONV] + (size_t)r * 4 * CONV_CH; const float* wa = a.in[I_WA] + (size_t)r * RG_HEADS * RG_BW * RG_BW; const float* wx = a.in[I_WX] + (size_t)r * RG_HEADS * RG_BW * RG_BW;
    static_assert(RG_BW == 64 && RG_HEADS == 8, "ph_rg_chunk is written for 8 gate heads of 64 channels");
    int tx_ = TID(); asm volatile("" : "+v"(tx_));
    const int lane = tx_ & 63, wid = __builtin_amdgcn_readfirstlane(tx_ >> 6), wv = blockIdx.x * (NTHREADS >> 6) + wid, nwv = gridDim.x * (NTHREADS >> 6);
    LAS float* XS = (LAS float*)(lds + wid * 16384);
    constexpr int NUP = NB * NC * 8, NU = NUP + DB * 8;
    for (int u = wv; u < NU; u += nwv) { const bool prompt = u < NUP; int hd, row0, T, n = 0, b = 0, db = 0;
        if (prompt) { const int c = u >> 3; hd = u & 7; row0 = c * 64; T = 64; n = c % NC; b = c / NC; } else { const int q = u - NUP; db = q >> 3; hd = q & 7; row0 = MP + db * DT; T = DT; }
        const int ch = hd * 64 + lane;
        const float w0 = wc[ch], w1 = wc[CONV_CH + ch], w2 = wc[2 * CONV_CH + ch], w3 = wc[3 * CONV_CH + ch], bcv = a.in[I_BCONV][(size_t)r * D_RNN + ch];
        float x3 = 0.f, x2 = 0.f, x1 = 0.f;
        if (prompt) { if (n != 0) { x3 = P[(size_t)(row0 - 3) * LDP + ch]; x2 = P[(size_t)(row0 - 2) * LDP + ch]; x1 = P[(size_t)(row0 - 1) * LDP + ch]; } }
        else { const float* sc = a.in[I_SCONV] + ((size_t)r * DB + db) * 3 * CONV_CH + ch; x3 = sc[0]; x2 = sc[CONV_CH]; x1 = sc[2 * CONV_CH]; }
        for (int tb = 0; tb < T; tb += 16) { float ub[16];
#pragma unroll
            for (int q = 0; q < 16; ++q) ub[q] = P[(size_t)(row0 + (tb + q < T ? tb + q : T - 1)) * LDP + ch];
#pragma unroll
            for (int q = 0; q < 16; ++q) { const int t = tb + q; if (t < T) { const float ut = ub[q]; XS[t * 64 + lane] = w3 * ut + w2 * x1 + w1 * x2 + w0 * x3 + bcv; x3 = x2; x2 = x1; x1 = ut;
                if (prompt) { if (n == NC - 1 && t >= 61) a.out[O_CONVP + (((size_t)r * NB + b) * 3 + (t - 61)) * CONV_CH + ch] = ut; }
                else if (t >= DT - 3) a.out[O_CONVS + (((size_t)r * DB + db) * 3 + (t - (DT - 3))) * CONV_CH + ch] = ut; } } }
        asm volatile("s_waitcnt lgkmcnt(0)" ::: "memory");
        float war[64], wxr[64];
        unsigned ln = (unsigned)lane; asm volatile("" : "+v"(ln)); ln &= 63u;
        const float* wah = wa + (size_t)hd * 4096; const float* wxh = wx + (size_t)hd * 4096;
#pragma unroll
        for (int k = 0; k < 64; ++k) { war[k] = wah[k * 64u + ln]; wxr[k] = wxh[k * 64u + ln]; }
        const float ba = a.in[I_BA][(size_t)r * D_RNN + ch], bx = a.in[I_BX][(size_t)r * D_RNN + ch], sp = softplusf_(-a.in[I_LAM][(size_t)r * D_RNN + ch]);
        float h = 0.f, ap = 1.f;
        for (int t = 0; t < T; ++t) { float pr = 0.f, pi = 0.f;
#pragma unroll
            for (int k = 0; k < 64; k += 4) { const f32x4_t x4 = *(const LAS f32x4_t*)(XS + t * 64 + k);
#pragma unroll
                for (int e = 0; e < 4; ++e) { pr += x4[e] * war[k + e]; pi += x4[e] * wxr[k + e]; } }
            const float rg = sigmoidf_(pr + ba), ig = sigmoidf_(pi + bx), log_a = -8.0f * rg * sp, av = __expf(log_a);
            const bool first = prompt && n == 0 && t == 0; const float mult = first ? 1.0f : FSQRT(fmaxf(1.0f - __expf(2.0f * log_a), 0.0f));
            float bv = XS[t * 64 + lane] * ig * mult; if (!prompt && t == 0) bv += av * a.in[I_SH][((size_t)r * DB + db) * D_RNN + ch];
            h = av * h + bv; ap *= av; const size_t o = (size_t)(row0 + t) * D_RNN + ch; HH[o] = h; AP[o] = ap; }
        if (!prompt) a.out[O_HS + ((size_t)r * DB + db) * D_RNN + ch] = h;
        asm volatile("s_waitcnt lgkmcnt(0)" ::: "memory");
    }
}
__device__ __forceinline__ void ph_dn_tok(const Args& a, int r) {
    const float* P = (const float*)(a.ws + WS_P); float* QKV = (float*)(a.ws + WS_QKV); float* QN = (float*)(a.ws + WS_QN); float* KN = (float*)(a.ws + WS_KN); float* GB = (float*)(a.ws + WS_GB); float* KNT = (float*)(a.ws + WS_KNT);
    const float* wc = a.in[I_WCONV] + (size_t)r * 4 * CONV_CH;
    int tx_ = TID(); asm volatile("" : "+v"(tx_));
    const int lane = tx_ & 63, wv = __builtin_amdgcn_readfirstlane(blockIdx.x * (NTHREADS >> 6) + (tx_ >> 6)), nwv = gridDim.x * (NTHREADS >> 6);
    constexpr int NUP = (MP / 16) * DNH, NU = NUP + DB * DNH;
    static_assert(DT == 4 && SEQ % 64 == 0, "ph_dn_tok run lengths");
    for (int u = wv; u < NU; u += nwv) { const bool prompt = u < NUP; const int hd = prompt ? (u & 3) : ((u - NUP) & 3), m0 = prompt ? (u >> 2) * 16 : MP + ((u - NUP) >> 2) * DT, T = prompt ? 16 : DT;
        const int seq = prompt ? m0 / SEQ : 0, t0 = prompt ? m0 % SEQ : 0, db = prompt ? 0 : (m0 - MP) / DT;
        f32x2_t wk[3][4], h3[3], h2[3], h1[3];
#pragma unroll
        for (int p = 0; p < 3; ++p) { const int c = D_RNN + p * 512 + hd * 128 + 2 * lane;
#pragma unroll
            for (int k = 0; k < 4; ++k) wk[p][k] = *(const f32x2_t*)(wc + (size_t)k * CONV_CH + c);
            h3[p] = h2[p] = h1[p] = (f32x2_t){0.f, 0.f};
            if (prompt) { if (t0 != 0) { h3[p] = *(const f32x2_t*)(P + (size_t)(m0 - 3) * LDP + c); h2[p] = *(const f32x2_t*)(P + (size_t)(m0 - 2) * LDP + c); h1[p] = *(const f32x2_t*)(P + (size_t)(m0 - 1) * LDP + c); } }
            else { const float* sc = a.in[I_SCONV] + ((size_t)r * DB + db) * 3 * CONV_CH + c; h3[p] = *(const f32x2_t*)sc; h2[p] = *(const f32x2_t*)(sc + CONV_CH); h1[p] = *(const f32x2_t*)(sc + 2 * CONV_CH); } }
        float gcum = 0.f;
        if (prompt) { const int tl0 = t0 & 63; float gt = lane < tl0 ? dn_g(a, r, (size_t)(m0 - tl0 + lane), hd) : 0.f;
#pragma unroll
            for (int o2 = 32; o2 >= 1; o2 >>= 1) gt += shfl_xor_l(gt, o2, lane);
            gcum = gt; }
        for (int tb = 0; tb < T; tb += 8) { f32x2_t xin[8][3];
#pragma unroll
            for (int q = 0; q < 8; ++q)
#pragma unroll
                for (int p = 0; p < 3; ++p) xin[q][p] = *(const f32x2_t*)(P + (size_t)(m0 + (tb + q < T ? tb + q : T - 1)) * LDP + D_RNN + p * 512 + hd * 128 + 2 * lane);
#pragma unroll
            for (int q = 0; q < 8; ++q) { const int t = tb + q; if (t < T) { const int m = m0 + t; f32x2_t x[3];
#pragma unroll
                for (int p = 0; p < 3; ++p) { const int c = D_RNN + p * 512 + hd * 128 + 2 * lane; const f32x2_t xv = xin[q][p];
                    const f32x2_t acc = wk[p][0] * h3[p] + wk[p][1] * h2[p] + wk[p][2] * h1[p] + wk[p][3] * xv; h3[p] = h2[p]; h2[p] = h1[p]; h1[p] = xv;
                    x[p][0] = siluf_(acc[0]); x[p][1] = siluf_(acc[1]);
                    if (prompt) { if (t0 + t >= SEQ - 3) *(f32x2_t*)(a.out + O_CONVP + (((size_t)r * NB + seq) * 3 + (t0 + t - (SEQ - 3))) * CONV_CH + c) = xv; }
                    else if (t >= DT - 3) *(f32x2_t*)(a.out + O_CONVS + (((size_t)r * DB + db) * 3 + (t - (DT - 3))) * CONV_CH + c) = xv; }
                float sq = x[0][0] * x[0][0] + x[0][1] * x[0][1], sk = x[1][0] * x[1][0] + x[1][1] * x[1][1];
#pragma unroll
                for (int o = 32; o >= 1; o >>= 1) { sq += shfl_xor_l(sq, o, lane); sk += shfl_xor_l(sk, o, lane); }
                const float rq = FRSQ(sq + EPS) * 0.08838834764831845f, rk = FRSQ(sk + EPS);
                const f32x2_t qn = x[0] * rq, kn = x[1] * rk; const size_t o = (size_t)m * 512 + hd * 128 + 2 * lane;
                *(f32x2_t*)(QN + o) = qn; *(f32x2_t*)(KN + o) = kn; *(f32x2_t*)(QKV + (size_t)m * 1536 + 1024 + hd * 128 + 2 * lane) = x[2];
                const float g = dn_g(a, r, (size_t)m, hd); float gc = g;
                if (prompt) { const int tt = t0 + t, tl = tt & 63; if (tl == 0) gcum = 0.f; gcum += g; gc = gcum;
                    (void)tl; }
                if (lane == 0) { GB[(size_t)m * 16 + hd * 4] = g; GB[(size_t)m * 16 + hd * 4 + 1] = sigmoidf_(P[(size_t)m * LDP + OFF_B + hd]); GB[(size_t)m * 16 + hd * 4 + 2] = gc; } } } } }
}
__device__ __forceinline__ void ph_rec_out_w(const Args& a, int r) {
    static_assert(D_RNN == 512 && Y2W == 1024, "ph_rec_out_w is written for D_RNN 512");
    const float* P = (const float*)(a.ws + WS_P); const float* HH = (const float*)(a.ws + WS_HH); const float* AP = (const float*)(a.ws + WS_XR); const float* CARRY = (const float*)(a.ws + WS_CARRY);
    const float* ODN = (const float*)(a.ws + WS_ODN); bf16* Y2 = (bf16*)(a.ws + WS_Y2); const float* dnw = a.in[I_DNW] + r * 128;
    int tx_ = TID(); asm volatile("" : "+v"(tx_));
    const int lane = tx_ & 63, wv = __builtin_amdgcn_readfirstlane(blockIdx.x * (NTHREADS >> 6) + (tx_ >> 6)), nwv = gridDim.x * (NTHREADS >> 6);
    const f32x2_t dw = *(const f32x2_t*)(dnw + 2 * lane);
    for (int m = wv; m < MT; m += nwv) {
        { const size_t o = (size_t)m * D_RNN + 8 * lane; f32x4_t h0 = *(const f32x4_t*)(HH + o), h1 = *(const f32x4_t*)(HH + o + 4);
            if (m < MP) { const float* cr = CARRY + (size_t)(m / 64) * D_RNN + 8 * lane; h0 += *(const f32x4_t*)(AP + o) * *(const f32x4_t*)cr; h1 += *(const f32x4_t*)(AP + o + 4) * *(const f32x4_t*)(cr + 4); }
            const float* gp = P + (size_t)m * LDP + OFF_GATE + 8 * lane; const f32x4_t g0 = *(const f32x4_t*)gp, g1 = *(const f32x4_t*)(gp + 4);
            u32x4_t w; w[0] = pk_bf16(h0[0] * gelu_tanhf_(g0[0]), h0[1] * gelu_tanhf_(g0[1])); w[1] = pk_bf16(h0[2] * gelu_tanhf_(g0[2]), h0[3] * gelu_tanhf_(g0[3]));
            w[2] = pk_bf16(h1[0] * gelu_tanhf_(g1[0]), h1[1] * gelu_tanhf_(g1[1])); w[3] = pk_bf16(h1[2] * gelu_tanhf_(g1[2]), h1[3] * gelu_tanhf_(g1[3]));
            *(u32x4_t*)(Y2 + (size_t)m * Y2W + 8 * lane) = w; }
        f32x2_t ov[4]; float ss[4];
#pragma unroll
        for (int hd = 0; hd < 4; ++hd) { ov[hd] = *(const f32x2_t*)(ODN + (size_t)m * 512 + hd * 128 + 2 * lane); ss[hd] = ov[hd][0] * ov[hd][0] + ov[hd][1] * ov[hd][1]; }
#pragma unroll
        for (int o = 32; o >= 1; o >>= 1)
#pragma unroll
            for (int hd = 0; hd < 4; ++hd) ss[hd] += shfl_xor_l(ss[hd], o, lane);
#pragma unroll
        for (int hd = 0; hd < 4; ++hd) { const float rs = FRSQ(ss[hd] * (1.0f / 128.0f) + EPS); const f32x2_t z = *(const f32x2_t*)(P + (size_t)m * LDP + OFF_Z + hd * 128 + 2 * lane);
            *(unsigned*)(Y2 + (size_t)m * Y2W + D_RNN + hd * 128 + 2 * lane) = pk_bf16(ov[hd][0] * rs * dw[0] * siluf_(z[0]), ov[hd][1] * rs * dw[1] * siluf_(z[1])); } }
}


__device__ __forceinline__ void ph_dn_chunk(const Args& a, LAS unsigned char* lds) {
    const float* QKV = (const float*)(a.ws + WS_QKV); const float* QN = (const float*)(a.ws + WS_QN); const float* KN = (const float*)(a.ws + WS_KN); const float* GB = (const float*)(a.ws + WS_GB); const float* KNT = (const float*)(a.ws + WS_KNT);
    bf16* AT = (bf16*)(a.ws + WS_AT); float* UT = (float*)(a.ws + WS_UT); bf16* WN = (bf16*)(a.ws + WS_WN); bf16* QG = (bf16*)(a.ws + WS_QG); bf16* KDT = (bf16*)(a.ws + WS_KDT); float* GL = (float*)(a.ws + WS_GL);
    int tx_ = TID(); asm volatile("" : "+v"(tx_));
    const int tid = tx_, lane = tid & 63, fr = lane & 15, fq = lane >> 4, wid = __builtin_amdgcn_readfirstlane(tid >> 6);
    constexpr int RS = 136;
    LAS bf16* Kb = (LAS bf16*)lds; LAS bf16* Qb = (LAS bf16*)(lds + 17408); LAS float* Lf = (LAS float*)(lds + 34816); LAS float* gcs = (LAS float*)(lds + 51200); LAS float* bts = (LAS float*)(lds + 51456);
    for (int cu = blockIdx.x; cu < NCU; cu += gridDim.x) { const int n = cu % NC, hd = (cu / NC) % DNH, b = cu / (NC * DNH); const size_t m0 = (size_t)b * SEQ + n * 64;
        { const int i = tid >> 3, sg = tid & 7; const float* qp = QN + (m0 + i) * 512 + hd * 128 + sg * 16; const float* kp = KN + (m0 + i) * 512 + hd * 128 + sg * 16;
            f32x4_t qv[4], kv[4];
#pragma unroll
            for (int e = 0; e < 4; ++e) { qv[e] = *(const f32x4_t*)(qp + 4 * e); kv[e] = *(const f32x4_t*)(kp + 4 * e); }
            u32x4_t w0, w1;
#pragma unroll
            for (int e = 0; e < 2; ++e) { w0[2 * e] = pk_bf16(qv[e][0], qv[e][1]); w0[2 * e + 1] = pk_bf16(qv[e][2], qv[e][3]); w1[2 * e] = pk_bf16(qv[e + 2][0], qv[e + 2][1]); w1[2 * e + 1] = pk_bf16(qv[e + 2][2], qv[e + 2][3]); }
            *(LAS u32x4_t*)(Qb + i * RS + sg * 16) = w0; *(LAS u32x4_t*)(Qb + i * RS + sg * 16 + 8) = w1;
#pragma unroll
            for (int e = 0; e < 2; ++e) { w0[2 * e] = pk_bf16(kv[e][0], kv[e][1]); w0[2 * e + 1] = pk_bf16(kv[e][2], kv[e][3]); w1[2 * e] = pk_bf16(kv[e + 2][0], kv[e + 2][1]); w1[2 * e + 1] = pk_bf16(kv[e + 2][2], kv[e + 2][3]); }
            *(LAS u32x4_t*)(Kb + i * RS + sg * 16) = w0; *(LAS u32x4_t*)(Kb + i * RS + sg * 16 + 8) = w1;
            if (tid < 64) { gcs[tid] = GB[(m0 + tid) * 16 + hd * 4 + 2]; bts[tid] = GB[(m0 + tid) * 16 + hd * 4 + 1]; } }
        __syncthreads();
        { const int ti = wid >> 1;
#pragma unroll
            for (int tq = 0; tq < 2; ++tq) { const int tj = 2 * (wid & 1) + tq; f32x4_t ck = {0.f, 0.f, 0.f, 0.f}, cq = {0.f, 0.f, 0.f, 0.f};
                if (tj <= ti) {
#pragma unroll
                    for (int ks = 0; ks < 4; ++ks) { const bf16x8_t bK = *(const LAS bf16x8_t*)(Kb + (tj * 16 + fr) * RS + ks * 32 + fq * 8);
                        ck = __builtin_amdgcn_mfma_f32_16x16x32_bf16(*(const LAS bf16x8_t*)(Kb + (ti * 16 + fr) * RS + ks * 32 + fq * 8), bK, ck, 0, 0, 0);
                        cq = __builtin_amdgcn_mfma_f32_16x16x32_bf16(*(const LAS bf16x8_t*)(Qb + (ti * 16 + fr) * RS + ks * 32 + fq * 8), bK, cq, 0, 0, 0); } }
                const int j = tj * 16 + fr; const float gj = gcs[j];
#pragma unroll
                for (int q = 0; q < 4; ++q) { const int i = ti * 16 + 4 * fq + q; float lv = 0.f, av = 0.f;
                    if (i >= j) { const float dec = __expf(gcs[i] - gj); av = cq[q] * dec; if (i > j) lv = bts[i] * ck[q] * dec; }
                    Lf[i * 64 + j] = lv; AT[(size_t)cu * 4096 + FRAG_OFF(i, j, 2)] = f2bf(av); } } }
        __syncthreads();
        if (wid < 4) { const int col = tid; float X[64];
            if (col < 128) {
#pragma unroll
                for (int j = 0; j < 64; ++j) X[j] = QKV[(m0 + j) * 1536 + 1024 + hd * 128 + col] * bts[j]; }
            else {
#pragma unroll
                for (int j = 0; j < 64; ++j) X[j] = KN[(m0 + j) * 512 + hd * 128 + (col - 128)] * bts[j] * __expf(gcs[j]); }
#pragma unroll
            for (int i = 1; i < 64; ++i) { float acc = X[i];
#pragma unroll
                for (int jb = 0; jb < i; jb += 4) { const f32x4_t l4 = *(const LAS f32x4_t*)(Lf + i * 64 + jb);
                    acc -= l4[0] * X[jb]; acc -= l4[1] * X[jb + 1]; acc -= l4[2] * X[jb + 2]; acc -= l4[3] * X[jb + 3]; }
                X[i] = acc; }
            if (col < 128) { float* up = UT + (size_t)cu * 8192 + (size_t)((col >> 4) * 4) * 256 + (col & 15) * 4;
#pragma unroll
                for (int j = 0; j < 64; j += 4) *(f32x4_t*)(up + (j >> 4) * 256 + ((j >> 2) & 3) * 64) = (f32x4_t){X[j], X[j + 1], X[j + 2], X[j + 3]}; }
            else { bf16* wp = WN + (size_t)cu * 8192;
#pragma unroll
                for (int j = 0; j < 64; ++j) wp[FRAG_OFF(j, col - 128, 4)] = f2bf(-X[j]); } }
        else { const int t2 = tid - 256; const float gl63 = gcs[63];
            { const int i = t2 >> 2, sg = t2 & 3; const float eg = __expf(gcs[i]); const float* qp = QN + (m0 + i) * 512 + hd * 128 + sg * 32; bf16* op = QG + (size_t)cu * 8192;
#pragma unroll
                for (int e = 0; e < 8; ++e) { const f32x4_t v = *(const f32x4_t*)(qp + 4 * e); u32x2_t w; w[0] = pk_bf16(v[0] * eg, v[1] * eg); w[1] = pk_bf16(v[2] * eg, v[3] * eg); *(u32x2_t*)(op + FRAG_OFF(i, sg * 32 + 4 * e, 4)) = w; } }
            { const int dd = t2 >> 1, hf = t2 & 1; bf16* op = KDT + (size_t)cu * 8192;
#pragma unroll
                for (int e = 0; e < 8; ++e) { const int i0 = hf * 32 + 4 * e; u32x2_t w;
                    const float k0 = bf2f(Kb[(i0) * RS + dd]), k1 = bf2f(Kb[(i0 + 1) * RS + dd]), k2 = bf2f(Kb[(i0 + 2) * RS + dd]), k3 = bf2f(Kb[(i0 + 3) * RS + dd]);
                    w[0] = pk_bf16(k0 * __expf(gl63 - gcs[i0]), k1 * __expf(gl63 - gcs[i0 + 1])); w[1] = pk_bf16(k2 * __expf(gl63 - gcs[i0 + 2]), k3 * __expf(gl63 - gcs[i0 + 3])); *(u32x2_t*)(op + FRAG_OFF(dd, i0, 2)) = w; } }
            if (t2 == 0) GL[cu] = __expf(gl63); }
        __syncthreads();
    }
}


template <int MODE, int UNR> __device__ __forceinline__ void small_gemm(const bf16* __restrict__ A, const bf16* __restrict__ Bt, int N, int K, void* C, int ldc) {
    static_assert(MS == 128, "small_gemm covers 128 sample rows");
    int tx_ = TID(); asm volatile("" : "+v"(tx_));
    const int lane = tx_ & 63, fr = lane & 15, fq = lane >> 4, wv = __builtin_amdgcn_readfirstlane(blockIdx.x * (NTHREADS >> 6) + (tx_ >> 6)), nwv = gridDim.x * (NTHREADS >> 6);
    const int ntile = (N / 16) * 4;
    for (int tile = wv; tile < ntile; tile += nwv) { const int n0 = (tile >> 2) * 16, tg = tile & 3;
        f32x4_t acc0 = {0.f, 0.f, 0.f, 0.f}, acc1 = {0.f, 0.f, 0.f, 0.f};
        const bf16* bp = Bt + (size_t)(n0 + fr) * K + fq * 8; const bf16* ap0 = A + (size_t)(MP + tg * 32 + fr) * K + fq * 8; const bf16* ap1 = ap0 + (size_t)16 * K;
        for (int k = 0; k < K; k += 32 * UNR) { bf16x8_t bb[UNR], a0[UNR], a1[UNR];
#pragma unroll
            for (int u = 0; u < UNR; ++u) { bb[u] = *(const bf16x8_t*)(bp + k + 32 * u); a0[u] = *(const bf16x8_t*)(ap0 + k + 32 * u); a1[u] = *(const bf16x8_t*)(ap1 + k + 32 * u); }
#pragma unroll
            for (int u = 0; u < UNR; ++u) { acc0 = __builtin_amdgcn_mfma_f32_16x16x32_bf16(bb[u], a0[u], acc0, 0, 0, 0); acc1 = __builtin_amdgcn_mfma_f32_16x16x32_bf16(bb[u], a1[u], acc1, 0, 0, 0); } }
#pragma unroll
        for (int tt = 0; tt < 2; ++tt) { const f32x4_t v = tt ? acc1 : acc0; const size_t o = (size_t)(MP + tg * 32 + tt * 16 + fr) * ldc + n0 + 4 * fq;
            if (MODE == 0) *(f32x4_t*)((float*)C + o) = v;
            else if (MODE == 1) { const float r0 = fmaxf(v[0], 0.f), r1 = fmaxf(v[1], 0.f), r2 = fmaxf(v[2], 0.f), r3 = fmaxf(v[3], 0.f); u32x2_t w; w[0] = pk_bf16(r0 * r0, r1 * r1); w[1] = pk_bf16(r2 * r2, r3 * r3); *(u32x2_t*)((bf16*)C + o) = w; }
            else { f32x4_t* p = (f32x4_t*)((float*)C + o); *p = *p + v; } } }
}


template <int MODE> __device__ __forceinline__ void small_gemm2(const bf16* __restrict__ A, const bf16* __restrict__ Bt, int N, int K, void* C, int ldc, bf16* XB, unsigned long long* ss, LAS unsigned char* lds) {
    static_assert(MS == 128, "small_gemm2 covers 128 sample rows");
    int tx_ = TID(); asm volatile("" : "+v"(tx_));
    const int tid = tx_, lane = tid & 63, fr = lane & 15, fq = lane >> 4, wid = __builtin_amdgcn_readfirstlane(tid >> 6);
    LAS float* RED = (LAS float*)lds;
    const int kw = K / 8;
    for (int tile = blockIdx.x; tile < (N / 16) * 4; tile += gridDim.x) { const int n0 = (tile >> 2) * 16, tg = tile & 3;
        f32x4_t acc0 = {0.f, 0.f, 0.f, 0.f}, acc1 = {0.f, 0.f, 0.f, 0.f};
        const bf16* bp = Bt + (size_t)(n0 + fr) * K + wid * kw + fq * 8; const bf16* ap0 = A + (size_t)(MP + tg * 32 + fr) * K + wid * kw + fq * 8; const bf16* ap1 = ap0 + (size_t)16 * K;
        for (int k = 0; k < kw; k += 128) { bf16x8_t bb[4], a0[4], a1[4];
#pragma unroll
            for (int u = 0; u < 4; ++u) { bb[u] = *(const bf16x8_t*)(bp + k + 32 * u); a0[u] = *(const bf16x8_t*)(ap0 + k + 32 * u); a1[u] = *(const bf16x8_t*)(ap1 + k + 32 * u); }
#pragma unroll
            for (int u = 0; u < 4; ++u) { acc0 = __builtin_amdgcn_mfma_f32_16x16x32_bf16(bb[u], a0[u], acc0, 0, 0, 0); acc1 = __builtin_amdgcn_mfma_f32_16x16x32_bf16(bb[u], a1[u], acc1, 0, 0, 0); } }
        *(LAS f32x4_t*)(RED + ((size_t)(wid * 32 + fr)) * 16 + 4 * fq) = acc0; *(LAS f32x4_t*)(RED + ((size_t)(wid * 32 + 16 + fr)) * 16 + 4 * fq) = acc1;
        __syncthreads();
        { const int tok = tid >> 4, c = tid & 15; float v = RED[(size_t)tok * 16 + c];
#pragma unroll
            for (int w = 1; w < 8; ++w) v += RED[(size_t)(w * 32 + tok) * 16 + c];
            const int m = MP + tg * 32 + tok; const size_t o = (size_t)m * ldc + n0 + c;
            if (MODE == 1) { const float rs = FRSQ((float)ss[m] * (5.9604644775390625e-08f / D) + EPS); const float r0 = fmaxf(v * rs, 0.f); ((bf16*)C)[o] = f2bf(r0 * r0); }
            else { const float x = ((float*)C)[o] + v; ((float*)C)[o] = x; XB[o] = f2bf(x);
                float q = x * x; q += shfl_xor_l(q, 1, lane); q += shfl_xor_l(q, 2, lane); q += shfl_xor_l(q, 4, lane); q += shfl_xor_l(q, 8, lane);
                if (c == 0) __hip_atomic_fetch_add(ss + m, (unsigned long long)(q * 16777216.0f), __ATOMIC_RELAXED, __HIP_MEMORY_SCOPE_AGENT); } }
        __syncthreads();
    }
}

constexpr int PH_PER_LAYER = 12, PH_LAYER0 = 2, PH_FINAL = PH_LAYER0 + DEPTH * PH_PER_LAYER, N_PHASES = PH_FINAL + 1;
#ifndef DIAG_SEQ_LO
#define DIAG_SEQ_LO NB
#endif
#ifndef PROBE_N
#define PROBE_N 1
#define PROBE_KIND -1
#define PROBE_LO 0
#define PROBE_HI 0
#endif
#define NREP(kind, k) ((PROBE_KIND == (kind) && (k) >= PROBE_LO && (k) <= PROBE_HI) ? PROBE_N : 1)
#define REP(kind, k) for (int rep_ = 0; rep_ < NREP(kind, k); ++rep_)
#ifndef MK_SINGLE
#define MK_SINGLE 1
#endif
__global__ void __launch_bounds__(NTHREADS, 2) mega(KArgs ka) {
    extern __shared__ __attribute__((aligned(16))) unsigned char lds[];
    LAS unsigned char* L = (LAS unsigned char*)lds;
    const size_t gsz = (size_t)gridDim.x * NTHREADS;
#define GT() ([&]() -> size_t { unsigned tx_ = TID(); asm volatile("" : "+v"(tx_)); return (size_t)blockIdx.x * NTHREADS + tx_; }())
    const int lo = ka.ph_lo, hi = ka.ph_hi; (void)lo; (void)hi;
    { const unsigned hw_ = (unsigned)__builtin_amdgcn_s_getreg((5 << 11) | 4) & 63u; if ((threadIdx.x & 63) == 0) ((LAS int*)(L + LDS_WTAB))[hw_] = (int)(threadIdx.x >> 6); __syncthreads(); }
    { const float** tab = (const float**)(ka.ws + WS_TAB); if (threadIdx.x < 28) tab[threadIdx.x] = ka.in[threadIdx.x]; asm volatile("s_waitcnt vmcnt(0)" ::: "memory"); __syncthreads(); }
    Args a; a.in = (const float* const*)(ka.ws + WS_TAB); a.out = ka.out; a.ws = ka.ws;
#define OPQ() do { size_t z_ = 0; asm volatile("" : "+s"(z_)); a.ws = ka.ws + z_; a.out = ka.out + z_; a.in = (const float* const*)(ka.ws + WS_TAB + z_); } while (0)
#if MK_SINGLE
    if (TID() < 4) ((LAS unsigned*)(L + LDS_MISC))[TID()] = 0u;
    __syncthreads();
    XcdBarrier bar = xcd_barrier_post((unsigned*)(a.ws + WS_CTL) + 4096, (volatile LAS unsigned*)(L + LDS_MISC));
#define SEAM(k) do { XcdBarrier bb_ = bar; asm volatile("" : "+s"(bb_.x)); xcd_barrier(bb_); } while (0)
#else
#define SEAM(k) do { } while (0)
#endif
#if MK_SINGLE
#define IN(k) (true)
#else
#define IN(k) (lo <= (k) && (k) < hi)
#endif
#define XN ((bf16*)(a.ws + WS_XN))
#define X ((float*)(a.ws + WS_X))
#define P ((float*)(a.ws + WS_P))
#define H ((bf16*)(a.ws + WS_H))
#define Y2 ((bf16*)(a.ws + WS_Y2))
    if (IN(0)) { OPQ(); REP(2, 0) { ph_prep_x(a); ph_wprep(a, true, 0, GT(), gsz); } SEAM(0); }
    for (int l = 0; l < DEPTH; ++l) {
        const int pb = PH_LAYER0 + l * PH_PER_LAYER, r = l >> 1; unsigned long long* SSb = (unsigned long long*)(a.ws + WS_SS);
        if ((l & 1) == 0) {
            if (IN(pb + 1)) { OPQ(); REP(3, 1) { pg8::Gemm g{XN, (const bf16*)(a.ws + WS_WINR) + (size_t)r * REC_PAD * D, MPAD, REC_PAD, D}; pg8::StaticOrder S; S.init(MPAD, REC_PAD, gridDim.x, blockIdx.x);
                pg8::EpiF32S E{P, LDP, SSb + (size_t)(2 * l) * MPAD}; pg8::gemm_phase<pg8::EpiF32S, pg8::StaticOrder, false>(L, g, S, E, nullptr); } SEAM(pb + 1); }
            if (IN(pb + 2)) { OPQ(); REP(0, 2) { ph_rg_chunk(a, r, L); ph_dn_tok(a, r); } SEAM(pb + 2); }
            if (IN(pb + 3)) { OPQ(); REP(0, 3) ph_dn_chunk(a, L); SEAM(pb + 3); }
            if (IN(pb + 6)) { OPQ();
                constexpr int NDNB = NB * DNH * 8;
                REP(0, 6) {
                if ((int)gridDim.x > NDNB) { if ((int)blockIdx.x < NDNB) {
#ifdef DIAG_NAIVE_B
                    ph_dn_b_naive(a, r, GT(), (size_t)NDNB * NTHREADS);
#else
                    ph_dn_b(a, r, L);
#endif
                } else { const size_t g2 = GT() - (size_t)NDNB * NTHREADS, s2 = gsz - (size_t)NDNB * NTHREADS; ph_rg_scan2(a, r, g2, s2); if (DIAG_SEQ_LO != 0) ph_dn_seq(a, r, DIAG_SEQ_LO, g2, s2);
                    if (l == 0) ph_wprep(a, true, 1, g2, s2); } }
                else { ph_dn_b(a, r, L); ph_rg_scan2(a, r, GT(), gsz); ph_dn_seq(a, r, DIAG_SEQ_LO, GT(), gsz); if (l == 0) ph_wprep(a, true, 1, GT(), gsz); }
                }
                SEAM(pb + 6); }
            if (IN(pb + 7)) { OPQ(); REP(0, 7) ph_rec_out_w(a, r); SEAM(pb + 7); }
            if (IN(pb + 8)) { OPQ(); REP(3, 8) { pg8::Gemm g{Y2, (const bf16*)(a.ws + WS_WOUTR) + (size_t)r * D * Y2W, MP, D, Y2W}; pg8::StaticOrder S; S.init(MP, D, gridDim.x, blockIdx.x);
                pg8::EpiAddN E{X, D, XN, SSb + (size_t)(2 * l + 1) * MPAD}; pg8::gemm_phase<pg8::EpiAddN, pg8::StaticOrder, false>(L, g, S, E, nullptr); small_gemm2<2>(Y2, (const bf16*)(a.ws + WS_WOUTR) + (size_t)r * D * Y2W, D, Y2W, X, D, XN, SSb + (size_t)(2 * l + 1) * MPAD, L); } SEAM(pb + 8); }
        } else {
            if (IN(pb + 1)) { OPQ(); REP(3, 1) { pg8::Gemm g{XN, (const bf16*)(a.ws + WS_WINA) + (size_t)r * ATT_PAD * D, MPAD, ATT_PAD, D}; pg8::StaticOrder S; S.init(MPAD, ATT_PAD, gridDim.x, blockIdx.x);
                pg8::EpiAttS E{a.ws, a.out, SSb + (size_t)(2 * l) * MPAD, r}; pg8::gemm_phase<pg8::EpiAttS, pg8::StaticOrder, false>(L, g, S, E, nullptr); } SEAM(pb + 1); }
            if (IN(pb + 3)) { OPQ(); REP(1, 3) { ph_idx_sample_mfma(a, r); ph_idx_mfma(a, L); } SEAM(pb + 3); }
            if (IN(pb + 4)) { OPQ(); REP(1, 4) ph_select_w(a, L); SEAM(pb + 4); }
            if (IN(pb + 5)) { OPQ(); REP(1, 5) { ph_sparse_sample(a, r, L); ph_sparse_attn(a, L); } SEAM(pb + 5); }
            if (IN(pb + 8)) { OPQ(); REP(3, 8) { pg8::Gemm g{Y2, (const bf16*)(a.ws + WS_WOUTA) + (size_t)r * D * D, MP, D, D}; pg8::StaticOrder S; S.init(MP, D, gridDim.x, blockIdx.x);
                pg8::EpiAddN E{X, D, XN, SSb + (size_t)(2 * l + 1) * MPAD}; pg8::gemm_phase<pg8::EpiAddN, pg8::StaticOrder, false>(L, g, S, E, nullptr); small_gemm2<2>(Y2, (const bf16*)(a.ws + WS_WOUTA) + (size_t)r * D * D, D, D, X, D, XN, SSb + (size_t)(2 * l + 1) * MPAD, L); } SEAM(pb + 8); }
        }
        if (IN(pb + 10)) { OPQ(); REP(3, 10) { pg8::Gemm g{XN, (const bf16*)(a.ws + WS_WUP) + (size_t)l * D_FF * D, MP, D_FF, D}; pg8::StaticOrder S; S.init(MP, D_FF, gridDim.x, blockIdx.x);
            pg8::EpiRelu2S E{H, D_FF, SSb + (size_t)(2 * l + 1) * MPAD}; pg8::gemm_phase<pg8::EpiRelu2S, pg8::StaticOrder, false>(L, g, S, E, nullptr); small_gemm2<1>(XN, (const bf16*)(a.ws + WS_WUP) + (size_t)l * D_FF * D, D_FF, D, H, D_FF, nullptr, SSb + (size_t)(2 * l + 1) * MPAD, L); } SEAM(pb + 10); }
        if (IN(pb + 11)) { OPQ(); REP(3, 11) { pg8::Gemm g{H, (const bf16*)(a.ws + WS_WDN) + (size_t)l * D * D_FF, MP, D, D_FF}; pg8::StaticOrder S; S.init(MP, D, gridDim.x, blockIdx.x);
            pg8::EpiAddN E{X, D, XN, SSb + (size_t)(2 * l + 2) * MPAD}; pg8::gemm_phase<pg8::EpiAddN, pg8::StaticOrder, false>(L, g, S, E, nullptr); small_gemm2<2>(H, (const bf16*)(a.ws + WS_WDN) + (size_t)l * D * D_FF, D, D_FF, X, D, XN, SSb + (size_t)(2 * l + 2) * MPAD, L); } SEAM(pb + 11); }
    }
    if (IN(PH_FINAL)) { OPQ(); ph_final(a); }
}
#undef XN
#undef X
#undef P
#undef H
#undef Y2

extern "C" void kernel_launch(void* const* d_in, const int* in_sizes, int n_in, void* d_out, int out_size, void* d_ws, size_t ws_size, hipStream_t stream) {
    static int grid = 0;
    if (grid == 0) {
        if (n_in != 28 || (size_t)out_size != (size_t)O_END || ws_size < WS_END2) { fprintf(stderr, "kernel_launch: unexpected shapes n_in %d out %d (want %zu) ws %zu (want %zu)\n", n_in, out_size, (size_t)O_END, ws_size, (size_t)WS_END2); grid = -1; return; }
        int dev = 0, cus = 0;
        if (hipGetDevice(&dev) != hipSuccess || hipDeviceGetAttribute(&cus, hipDeviceAttributeMultiprocessorCount, dev) != hipSuccess) { grid = -1; return; }
        if (hipFuncSetAttribute((const void*)mega, hipFuncAttributeMaxDynamicSharedMemorySize, LDS_BYTES) != hipSuccess) { fprintf(stderr, "kernel_launch: hipFuncSetAttribute failed\n"); grid = -1; return; }
        int per_cu = 0; (void)hipOccupancyMaxActiveBlocksPerMultiprocessor(&per_cu, (const void*)mega, NTHREADS, LDS_BYTES); (void)hipGetLastError();
        if (per_cu < 1) fprintf(stderr, "kernel_launch: occupancy query says %d blocks per CU\n", per_cu);
        grid = cus;
    }
    if (grid < 0) return;
    (void)hipMemsetAsync((char*)d_ws + WS_CTL, 0, CTL_BYTES, stream);
    KArgs a{};
    for (int i = 0; i < 28; ++i) a.in[i] = (const float*)d_in[i];
    a.out = (float*)d_out; a.ws = (unsigned char*)d_ws;
#if MK_SINGLE
    a.ph_lo = 0; a.ph_hi = N_PHASES;
    hipLaunchKernelGGL(mega, dim3(grid), dim3(NTHREADS), LDS_BYTES, stream, a);
#else
    for (int ph = 0; ph < N_PHASES; ++ph) { const int k = ph - PH_LAYER0; if (k >= 0 && ph < PH_FINAL && ((k / PH_PER_LAYER) & 1) == 1 && (k % PH_PER_LAYER) == 7) continue;
        a.ph_lo = ph; a.ph_hi = ph + 1; hipLaunchKernelGGL(mega, dim3(grid), dim3(NTHREADS), LDS_BYTES, stream, a); }
#endif
}
#endif
```

```cpp
#ifndef HOST_TEST
#include <hip/hip_runtime.h>
#define HD __device__ __forceinline__
#define UNI(x) __builtin_amdgcn_readfirstlane(x)
#else
#include <cmath>
#include <cstddef>
#include <cstring>
#define HD static inline
#define UNI(x) (x)
#endif

#ifndef CFG_D_MODEL
#define CFG_D_MODEL 1024
#define CFG_BATCH 2
#define CFG_SEQ 8192
#define CFG_DEC_BATCH 32
#define CFG_PAST 8192
#endif
constexpr int D = CFG_D_MODEL, NB = CFG_BATCH, SEQ = CFG_SEQ, DEPTH = 4, DB = CFG_DEC_BATCH, DT = 4, PAST = CFG_PAST, PAGE = 128;
constexpr int N_REC = 2, N_ATT = 2, NPAGES = PAST / PAGE, NUSED = DB * NPAGES, NPOOL = NUSED + (NUSED + 3) / 4;
constexpr int D_RNN = D / 2, RG_HEADS = 8, RG_BW = D_RNN / RG_HEADS;
constexpr int DNH = 4, DNK = 128, DN_QK = 512, DN_VD = 512;
constexpr int CONV_CH = D_RNN + 2 * DN_QK + DN_VD, REC_IN = CONV_CH + D_RNN + DN_VD + 2 * DNH;
constexpr int OFF_GATE = CONV_CH, OFF_Z = CONV_CH + D_RNN, OFF_B = OFF_Z + DN_VD, OFF_A = OFF_B + DNH;
constexpr int AH = D / 128, KVH = 2, HDIM = 128, GROUP = AH / KVH, IH = 8, IDIM = 64;
constexpr int AO_K = AH * HDIM, AO_V = AO_K + KVH * HDIM, AO_QI = AO_V + KVH * HDIM, AO_KI = AO_QI + IH * IDIM, AO_WI = AO_KI + IDIM, ATT_IN = AO_WI + IH;
constexpr int D_FF = 4 * D;
constexpr int TOPK_P = (SEQ / 4 < 256) ? SEQ / 4 : 256, TOPK_S = ((PAST + DT) / 4 < 256) ? (PAST + DT) / 4 : 256, KMAX = 256, KROW = 320;
constexpr int MP = NB * SEQ, MS = DB * DT, MT = MP + MS, MPAD = (MT + 255) / 256 * 256;
constexpr int REC_PAD = (REC_IN + 255) / 256 * 256, ATT_PAD = (ATT_IN + 255) / 256 * 256, LDP = REC_PAD > ATT_PAD ? REC_PAD : ATT_PAD;
constexpr int Y2W = D_RNN + DN_VD;
constexpr int SMAX = (PAST + DT > SEQ) ? PAST + DT : SEQ, SLD = (SMAX + 63) / 64 * 64;
constexpr int NC = SEQ / 64, NCU = NB * DNH * NC;
constexpr float EPS = 1e-6f;
typedef unsigned short bf16;

constexpr size_t O_YP = 0, O_YS = O_YP + (size_t)MP * D, O_CONVP = O_YS + (size_t)MS * D, O_HP = O_CONVP + (size_t)N_REC * NB * 3 * CONV_CH,
    O_SP = O_HP + (size_t)N_REC * NB * D_RNN, O_KP = O_SP + (size_t)N_REC * NB * DNH * 128 * 128, O_VP = O_KP + (size_t)N_ATT * MP * KVH * HDIM,
    O_KIP = O_VP + (size_t)N_ATT * MP * KVH * HDIM, O_CONVS = O_KIP + (size_t)N_ATT * MP * IDIM, O_HS = O_CONVS + (size_t)N_REC * DB * 3 * CONV_CH,
    O_SS = O_HS + (size_t)N_REC * DB * D_RNN, O_KS = O_SS + (size_t)N_REC * DB * DNH * 128 * 128, O_VS = O_KS + (size_t)N_ATT * MS * KVH * HDIM,
    O_KIS = O_VS + (size_t)N_ATT * MS * KVH * HDIM, O_END = O_KIS + (size_t)N_ATT * MS * IDIM;

constexpr size_t al256(size_t x) { return (x + 255) / 256 * 256; }
constexpr size_t WS_CTL = 0, CTL_BYTES = 4u << 20;
constexpr size_t WS_WINR = CTL_BYTES, WS_WOUTR = WS_WINR + al256((size_t)N_REC * REC_PAD * D * 2), WS_WINA = WS_WOUTR + al256((size_t)N_REC * D * Y2W * 2),
    WS_WOUTA = WS_WINA + al256((size_t)N_ATT * ATT_PAD * D * 2), WS_WUP = WS_WOUTA + al256((size_t)N_ATT * D * D * 2), WS_WDN = WS_WUP + al256((size_t)DEPTH * D_FF * D * 2),
    WS_X = WS_WDN + al256((size_t)DEPTH * D * D_FF * 2), WS_XN = WS_X + al256((size_t)MPAD * D * 4), WS_P = WS_XN + al256((size_t)MPAD * D * 2),
    WS_H = WS_P + al256((size_t)MPAD * LDP * 4), WS_Y2 = WS_H + al256((size_t)MPAD * D_FF * 2), WS_XR = WS_Y2 + al256((size_t)MPAD * D * 2),
    WS_QKV = WS_XR + al256((size_t)MT * D_RNN * 4), WS_RA = WS_QKV + al256((size_t)MT * 1536 * 4), WS_RB = WS_RA + al256((size_t)MT * D_RNN * 4),
    WS_HH = WS_RB + al256((size_t)MT * D_RNN * 4), WS_QN = WS_HH + al256((size_t)MT * D_RNN * 4), WS_KN = WS_QN + al256((size_t)MT * 512 * 4),
    WS_GB = WS_KN + al256((size_t)MT * 512 * 4), WS_ODN = WS_GB + al256((size_t)MT * 16 * 4), WS_SCT = WS_ODN + al256((size_t)MT * 512 * 4),
    WS_IDX = WS_SCT + al256((size_t)MT * SLD * 4), WS_NSEL = WS_IDX + al256((size_t)MT * KROW * 4), WS_SCR = WS_NSEL + al256((size_t)MT * 4),
    WS_CARRY = WS_SCR + al256((size_t)MT * AH * KMAX * 4), WS_L = WS_CARRY + al256((size_t)NB * NC * D_RNN * 4), WS_AT = WS_L + al256((size_t)NCU * 4096 * 4),
    WS_UT = WS_AT + al256((size_t)NCU * 4096 * 2), WS_WN = WS_UT + al256((size_t)NCU * 8192 * 4), WS_QG = WS_WN + al256((size_t)NCU * 8192 * 2),
    WS_KDT = WS_QG + al256((size_t)NCU * 8192 * 2), WS_GL = WS_KDT + al256((size_t)NCU * 8192 * 2), WS_KNT = WS_GL + al256((size_t)NCU * 4), WS_END = WS_KNT + al256((size_t)NCU * 8192 * 4);

constexpr size_t WS_KB = WS_H, WS_VB = WS_KB + al256((size_t)MT * 256 * 2), WS_QIB = WS_VB + al256((size_t)MT * 256 * 2), WS_KIB = WS_QIB + al256((size_t)MT * 512 * 2);
constexpr size_t WS_QB = WS_KIB + al256((size_t)MT * 64 * 2);
static_assert(WS_QB + (size_t)MT * D * 2 <= WS_Y2, "bf16 attention copies must fit inside the H buffer");
#ifdef HOST_TEST
struct Args { const float* in[28]; float* out; unsigned char* ws; int ph_lo, ph_hi; };
#else
struct KArgs { const float* in[28]; float* out; unsigned char* ws; int ph_lo, ph_hi; };
struct Args { const float* const* in; float* out; unsigned char* ws; };
constexpr size_t WS_TAB = 65536;
constexpr size_t WS_SS = 1u << 20;
static_assert(WS_SS + (size_t)9 * MPAD * 8 <= CTL_BYTES, "norm statistics inside the memset region");
constexpr size_t WS_END2 = WS_END;
#endif
enum { I_XP = 0, I_XS, I_SCONV, I_SH, I_SS, I_CK, I_CV, I_CKI, I_PT, I_NMIX, I_NMLP, I_NFIN, I_WINR, I_WCONV, I_BCONV, I_WA, I_BA, I_WX, I_BX, I_LAM, I_ALOG, I_DTB, I_DNW,
       I_WOUTR, I_WINA, I_WOUTA, I_WUP, I_WDN };

HD bf16 f2bf(float f) { unsigned u; memcpy(&u, &f, 4); u += 0x7FFFu + ((u >> 16) & 1u); return (bf16)(u >> 16); }
HD float bf2f(bf16 b) { unsigned u = ((unsigned)b) << 16; float f; memcpy(&f, &u, 4); return f; }
#ifndef HOST_TEST
#define FEXP(x) __expf(x)
#define FLOG(x) __logf(x)
#define FRCP(x) __builtin_amdgcn_rcpf(x)
#define FSQRT(x) __builtin_amdgcn_sqrtf(x)
#define FRSQ(x) __builtin_amdgcn_rsqf(x)
#else
#define FEXP(x) expf(x)
#define FLOG(x) logf(x)
#define FRCP(x) (1.0f / (x))
#define FSQRT(x) sqrtf(x)
#define FRSQ(x) (1.0f / sqrtf(x))
#endif
HD float sigmoidf_(float x) { return FRCP(1.0f + FEXP(-x)); }
HD float softplusf_(float x) { return x > 20.f ? x : FLOG(1.0f + FEXP(x)); }
HD float siluf_(float x) { return x * sigmoidf_(x); }
HD float gelu_tanhf_(float x) { const float u = 0.7978845608028654f * (x + 0.044715f * x * x * x); const float th = 1.0f - 2.0f * FRCP(1.0f + FEXP(2.0f * u)); return 0.5f * x * (1.0f + th); }
HD unsigned fkey(float f) { f = f + 0.0f; unsigned u; memcpy(&u, &f, 4); return (u & 0x80000000u) ? ~u : (u | 0x80000000u); }
struct RowInfo { int seq, t, T, row0; bool sample; };
HD RowInfo row_info(int m) { RowInfo r; if (m < MP) { r.seq = m / SEQ; r.t = m % SEQ; r.T = SEQ; r.row0 = r.seq * SEQ; r.sample = false; }
    else { const int q = m - MP; r.seq = NB + q / DT; r.t = q % DT; r.T = DT; r.row0 = MP + (q / DT) * DT; r.sample = true; } return r; }

HD void ph_copy_x(const Args& a, size_t gtid, size_t gsz) {
    float* X = (float*)(a.ws + WS_X);
    for (size_t i = gtid; i < (size_t)MPAD * D; i += gsz) { const size_t m = i / D; X[i] = m < (size_t)MP ? a.in[I_XP][i] : (m < (size_t)MT ? a.in[I_XS][i - (size_t)MP * D] : 0.f); }
}
HD void wprep_one(const float* w, bf16* wt, int K, int N, int NP, const float* gamma, size_t gtid, size_t gsz) {
    const size_t k32n = (size_t)K / 32;
    for (size_t i = gtid; i < (size_t)NP * k32n; i += gsz) { const int n = (int)(i % NP); const size_t k0 = (i / NP) * 32; bf16 tmp[32];
#ifndef HOST_TEST
#pragma unroll
#endif
        for (int j = 0; j < 32; ++j) tmp[j] = n < N ? f2bf(w[(k0 + j) * (size_t)N + n] * (gamma ? gamma[k0 + j] : 1.0f)) : (bf16)0;
#ifndef HOST_TEST
#pragma unroll
#endif
        for (int j = 0; j < 32; ++j) wt[(size_t)n * K + k0 + j] = tmp[j]; }
}
HD void ph_wprep(const Args& a, bool fold, int part, size_t gtid, size_t gsz) {
    for (int r = 0; r < N_REC; ++r) { if (part == 2 || (part == 0) == (r == 0)) wprep_one(a.in[I_WINR] + (size_t)r * D * REC_IN, (bf16*)(a.ws + WS_WINR) + (size_t)r * REC_PAD * D, D, REC_IN, REC_PAD, fold ? a.in[I_NMIX] + (size_t)(2 * r) * D : nullptr, gtid, gsz);
        if (part != 0) wprep_one(a.in[I_WOUTR] + (size_t)r * Y2W * D, (bf16*)(a.ws + WS_WOUTR) + (size_t)r * D * Y2W, Y2W, D, D, nullptr, gtid, gsz); }
    if (part == 0) return;
    for (int r = 0; r < N_ATT; ++r) { wprep_one(a.in[I_WINA] + (size_t)r * D * ATT_IN, (bf16*)(a.ws + WS_WINA) + (size_t)r * ATT_PAD * D, D, ATT_IN, ATT_PAD, fold ? a.in[I_NMIX] + (size_t)(2 * r + 1) * D : nullptr, gtid, gsz);
        wprep_one(a.in[I_WOUTA] + (size_t)r * D * D, (bf16*)(a.ws + WS_WOUTA) + (size_t)r * D * D, D, D, D, nullptr, gtid, gsz); }
    for (int l = 0; l < DEPTH; ++l) { wprep_one(a.in[I_WUP] + (size_t)l * D * D_FF, (bf16*)(a.ws + WS_WUP) + (size_t)l * D_FF * D, D, D_FF, D_FF, fold ? a.in[I_NMLP] + (size_t)l * D : nullptr, gtid, gsz);
        wprep_one(a.in[I_WDN] + (size_t)l * D_FF * D, (bf16*)(a.ws + WS_WDN) + (size_t)l * D * D_FF, D_FF, D, D, nullptr, gtid, gsz); }
}
HD void ph_conv(const Args& a, int r, size_t gtid, size_t gsz) {
    const float* P = (const float*)(a.ws + WS_P); float* XR = (float*)(a.ws + WS_XR); float* QKV = (float*)(a.ws + WS_QKV);
    const float* wc = a.in[I_WCONV] + (size_t)r * 4 * CONV_CH; const float* bc = a.in[I_BCONV] + (size_t)r * D_RNN;
    for (size_t i = gtid; i < (size_t)MT * CONV_CH; i += gsz) { const int m = (int)(i / CONV_CH), c = (int)(i % CONV_CH); const RowInfo ri = row_info(m);
        float acc = 0.f;
        for (int k = 0; k < 4; ++k) { const int tau = ri.t - 3 + k; float xv;
            if (tau >= 0) xv = P[(size_t)(ri.row0 + tau) * LDP + c];
            else xv = ri.sample ? a.in[I_SCONV][(((size_t)r * DB + (ri.seq - NB)) * 3 + (3 + tau)) * CONV_CH + c] : 0.f;
            acc += xv * wc[(size_t)k * CONV_CH + c]; }
        if (c < D_RNN) XR[(size_t)m * D_RNN + c] = acc + bc[c]; else QKV[(size_t)m * 1536 + (c - D_RNN)] = siluf_(acc);
        const float uraw = P[(size_t)m * LDP + c];
        if (!ri.sample) { if (ri.t >= SEQ - 3) a.out[O_CONVP + (((size_t)r * NB + ri.seq) * 3 + (ri.t - (SEQ - 3))) * CONV_CH + c] = uraw; }
        else { if (ri.t >= DT - 3) a.out[O_CONVS + (((size_t)r * DB + (ri.seq - NB)) * 3 + (ri.t - (DT - 3))) * CONV_CH + c] = uraw; }
    }
}
HD void ph_rg_gates(const Args& a, int r, size_t gtid, size_t gsz) {
    const float* XR = (const float*)(a.ws + WS_XR); float* RA = (float*)(a.ws + WS_RA); float* RB = (float*)(a.ws + WS_RB);
    const float* wa = a.in[I_WA] + (size_t)r * RG_HEADS * RG_BW * RG_BW; const float* wx = a.in[I_WX] + (size_t)r * RG_HEADS * RG_BW * RG_BW;
    for (size_t i = gtid; i < (size_t)MT * D_RNN; i += gsz) { const int m = (int)(i / D_RNN), j = (int)(i % D_RNN), hd = j / RG_BW, jj = j % RG_BW; const RowInfo ri = row_info(m);
        float pr = 0.f, pi = 0.f; const float* xrow = XR + (size_t)m * D_RNN + hd * RG_BW;
        for (int k = 0; k < RG_BW; ++k) { const float xv = xrow[k]; pr += xv * wa[((size_t)hd * RG_BW + k) * RG_BW + jj]; pi += xv * wx[((size_t)hd * RG_BW + k) * RG_BW + jj]; }
        const float rg = sigmoidf_(pr + a.in[I_BA][(size_t)r * D_RNN + j]), ig = sigmoidf_(pi + a.in[I_BX][(size_t)r * D_RNN + j]);
        const float log_a = -8.0f * rg * softplusf_(-a.in[I_LAM][(size_t)r * D_RNN + j]); const float av = FEXP(log_a);
        const bool first = (!ri.sample) && ri.t == 0;
        const float mult = first ? 1.0f : sqrtf(fmaxf(1.0f - FEXP(2.0f * log_a), 0.0f));
        float bv = XR[(size_t)m * D_RNN + j] * ig * mult;
        if (ri.t == 0 && ri.sample) bv += av * a.in[I_SH][((size_t)r * DB + (ri.seq - NB)) * D_RNN + j];
        RA[i] = av; RB[i] = bv; }
}
HD void ph_rg_scan1(const Args& a, int r, size_t gtid, size_t gsz) {
    const float* RA = (const float*)(a.ws + WS_RA); float* AP = (float*)(a.ws + WS_XR); const float* RB = (const float*)(a.ws + WS_RB); float* HH = (float*)(a.ws + WS_HH);
    const size_t n_p = (size_t)NB * NC * D_RNN, n_s = (size_t)DB * D_RNN;
    for (size_t i = gtid; i < n_p + n_s; i += gsz) {
        if (i < n_p) { const int j = (int)(i % D_RNN); const size_t row0 = (i / D_RNN) * 64; float h = 0.f, ap = 1.f;
            for (int t = 0; t < 64; ++t) { const size_t o = (row0 + t) * D_RNN + j; const float av = RA[o]; h = av * h + RB[o]; ap *= av; HH[o] = h; AP[o] = ap; } }
        else { const size_t q = i - n_p; const int db = (int)(q / D_RNN), j = (int)(q % D_RNN); float h = 0.f;
            for (int t = 0; t < DT; ++t) { const size_t o = (size_t)(MP + db * DT + t) * D_RNN + j; h = RA[o] * h + RB[o]; HH[o] = h; }
            a.out[O_HS + ((size_t)r * DB + db) * D_RNN + j] = h; } }
}
HD void ph_rg_scan2(const Args& a, int r, size_t gtid, size_t gsz) {
    const float* RA = (const float*)(a.ws + WS_XR); const float* HH = (const float*)(a.ws + WS_HH); float* CARRY = (float*)(a.ws + WS_CARRY);
    for (size_t i = gtid; i < (size_t)NB * D_RNN; i += gsz) { const int b = (int)(i / D_RNN), j = (int)(i % D_RNN); float carry = 0.f;
        for (int n0 = 0; n0 < NC; n0 += 16) { float av[16], hv[16];
#pragma unroll
            for (int q = 0; q < 16; ++q) { const int n = n0 + q < NC ? n0 + q : NC - 1; const size_t last = ((size_t)b * SEQ + n * 64 + 63) * D_RNN + j; av[q] = RA[last]; hv[q] = HH[last]; }
#pragma unroll
            for (int q = 0; q < 16; ++q) if (n0 + q < NC) { CARRY[((size_t)b * NC + n0 + q) * D_RNN + j] = carry; carry = av[q] * carry + hv[q]; } }
        a.out[O_HP + ((size_t)r * NB + b) * D_RNN + j] = carry; }
}
HD float dn_g(const Args& a, int r, size_t m, int hd) { const float* P = (const float*)(a.ws + WS_P);
    return -FEXP(a.in[I_ALOG][r * DNH + hd]) * softplusf_(P[m * LDP + OFF_A + hd] + a.in[I_DTB][r * DNH + hd]); }
HD void ph_dn_prep(const Args& a, int r, size_t gtid, size_t gsz) {
    const float* P = (const float*)(a.ws + WS_P); const float* QKV = (const float*)(a.ws + WS_QKV); float* QN = (float*)(a.ws + WS_QN); float* KN = (float*)(a.ws + WS_KN); float* GB = (float*)(a.ws + WS_GB);
    for (size_t i = gtid; i < (size_t)MT * DNH; i += gsz) { const int m = (int)(i / DNH), hd = (int)(i % DNH);
        const float* q = QKV + (size_t)m * 1536 + hd * 128; const float* k = q + 512; float sq = 0.f, sk = 0.f;
        for (int d = 0; d < 128; ++d) { sq += q[d] * q[d]; sk += k[d] * k[d]; }
        const float rq = FRSQ(sq + EPS) * 0.08838834764831845f, rk = 1.0f / sqrtf(sk + EPS);
        for (int d = 0; d < 128; ++d) { QN[(size_t)m * 512 + hd * 128 + d] = q[d] * rq; KN[(size_t)m * 512 + hd * 128 + d] = k[d] * rk; }
        if (m < MP) { float* KNT = (float*)(a.ws + WS_KNT) + (((size_t)(m / SEQ) * DNH + hd) * NC + (m % SEQ) / 64) * 8192 + (m % 64); for (int d = 0; d < 128; ++d) KNT[(size_t)d * 64] = k[d] * rk; }
        const float beta = sigmoidf_(P[(size_t)m * LDP + OFF_B + hd]);
        const float g = dn_g(a, r, (size_t)m, hd); float gc = g;
        if (m < MP) { const int t = m % SEQ; for (int tau = (t / 64) * 64; tau < t; ++tau) gc += dn_g(a, r, (size_t)(m - t + tau), hd); }
        GB[(size_t)m * 16 + hd * 4] = g; GB[(size_t)m * 16 + hd * 4 + 1] = beta; GB[(size_t)m * 16 + hd * 4 + 2] = gc; }
}
#ifndef HOST_TEST
#define DN_FENCE() asm volatile("" ::: "memory")
#else
#define DN_FENCE() do { } while (0)
#endif
HD void ph_dn_seq(const Args& a, int r, int seq_lo, size_t gtid, size_t gsz) {
    const float* QKV = (const float*)(a.ws + WS_QKV); const float* QN = (const float*)(a.ws + WS_QN); const float* KN = (const float*)(a.ws + WS_KN); const float* GB = (const float*)(a.ws + WS_GB);
    float* ODN = (float*)(a.ws + WS_ODN);
    for (size_t i = gtid; i < (size_t)(NB + DB - seq_lo) * DNH * 128; i += gsz) { const int v = (int)(i % 128), sh = UNI((int)(i / 128)), hd = sh % DNH, seq = seq_lo + sh / DNH;
        const int row0 = seq < NB ? seq * SEQ : MP + (seq - NB) * DT, T = seq < NB ? SEQ : DT;
        float S[128];
        if (seq < NB) {
#pragma unroll
            for (int d = 0; d < 128; ++d) S[d] = 0.f; }
        else { const float* s0 = a.in[I_SS] + ((((size_t)r * DB + (seq - NB)) * DNH + hd) * 128) * 128 + v;
#pragma unroll
            for (int d = 0; d < 128; ++d) S[d] = s0[(size_t)d * 128]; }
        for (int t = 0; t < T; ++t) { const size_t m = (size_t)(row0 + t);
            const float* kk = KN + m * 512 + hd * 128; const float* qq = QN + m * 512 + hd * 128;
            const float eg = FEXP(GB[m * 16 + hd * 4]), beta = GB[m * 16 + hd * 4 + 1], vv = QKV[m * 1536 + 1024 + hd * 128 + v];
            float ks = 0.f;
#pragma unroll
            for (int c = 0; c < 4; ++c) {
#pragma unroll
                for (int d = c * 32; d < c * 32 + 32; ++d) ks += kk[d] * S[d];
                DN_FENCE(); }
            const float cc = beta * (vv - eg * ks); float o = 0.f;
#pragma unroll
            for (int c = 0; c < 4; ++c) {
#pragma unroll
                for (int d = c * 32; d < c * 32 + 32; ++d) { S[d] = eg * S[d] + kk[d] * cc; o += qq[d] * S[d]; }
                DN_FENCE(); }
            ODN[m * 512 + hd * 128 + v] = o; }
        float* so = seq < NB ? a.out + O_SP + ((((size_t)r * NB + seq) * DNH + hd) * 128) * 128 + v : a.out + O_SS + ((((size_t)r * DB + (seq - NB)) * DNH + hd) * 128) * 128 + v;
#pragma unroll
        for (int d = 0; d < 128; ++d) so[(size_t)d * 128] = S[d]; }
}
HD void ph_dn_lat(const Args& a, size_t gtid, size_t gsz) {
    const float* QN = (const float*)(a.ws + WS_QN); const float* KN = (const float*)(a.ws + WS_KN); const float* GB = (const float*)(a.ws + WS_GB); const float* KNT = (const float*)(a.ws + WS_KNT);
    float* Lm = (float*)(a.ws + WS_L); bf16* AT = (bf16*)(a.ws + WS_AT); bf16* QG = (bf16*)(a.ws + WS_QG); bf16* KDT = (bf16*)(a.ws + WS_KDT); float* GL = (float*)(a.ws + WS_GL);
    for (size_t it = gtid; it < (size_t)NCU * 4096; it += gsz) { const int j = (int)(it % 64), ci = UNI((int)(it / 64)), i = ci % 64, cu = ci / 64;
        const int n = cu % NC, hd = (cu / NC) % DNH, b = cu / (NC * DNH); const size_t mi = (size_t)b * SEQ + n * 64 + i, mj = (size_t)b * SEQ + n * 64 + j;
        const float* ki = KN + mi * 512 + hd * 128; const float* qi = QN + mi * 512 + hd * 128; const float* kt = KNT + (size_t)cu * 8192 + j; float kk = 0.f, qk = 0.f;
        for (int d = 0; d < 128; ++d) { const float kj = kt[(size_t)d * 64]; kk += ki[d] * kj; qk += qi[d] * kj; }
        float lv = 0.f, av = 0.f;
        if (i >= j) { const float dec = FEXP(GB[mi * 16 + hd * 4 + 2] - GB[mj * 16 + hd * 4 + 2]); av = qk * dec; if (i > j) lv = GB[mi * 16 + hd * 4 + 1] * kk * dec; }
        Lm[it] = lv; AT[it] = f2bf(av); }
    for (size_t it = gtid; it < (size_t)NCU * 8192; it += gsz) { const int d = (int)(it % 128), i = (int)((it / 128) % 64), cu = (int)(it / 8192);
        const int n = cu % NC, hd = (cu / NC) % DNH, b = cu / (NC * DNH); const size_t mi = (size_t)b * SEQ + n * 64 + i;
        QG[it] = f2bf(QN[mi * 512 + hd * 128 + d] * FEXP(GB[mi * 16 + hd * 4 + 2])); }
    for (size_t it = gtid; it < (size_t)NCU * 8192; it += gsz) { const int i = (int)(it % 64), cu = (int)(it / 8192);
        const int n = cu % NC, hd = (cu / NC) % DNH, b = cu / (NC * DNH); const size_t mi = (size_t)b * SEQ + n * 64 + i, ml = (size_t)b * SEQ + n * 64 + 63;
        const float gci = GB[mi * 16 + hd * 4 + 2], gcl = GB[ml * 16 + hd * 4 + 2];
        KDT[it] = f2bf(KNT[it] * FEXP(gcl - gci)); if ((it % 8192) == 0) GL[cu] = FEXP(gcl); }
}
HD void ph_dn_solve(const Args& a, size_t gtid, size_t gsz) {
    const float* QKV = (const float*)(a.ws + WS_QKV); const float* KN = (const float*)(a.ws + WS_KN); const float* GB = (const float*)(a.ws + WS_GB); const float* Lm = (const float*)(a.ws + WS_L);
    float* UT = (float*)(a.ws + WS_UT); bf16* WN = (bf16*)(a.ws + WS_WN);
    for (size_t it = gtid; it < (size_t)NCU * 256; it += gsz) { const int col = (int)(it % 256), cu = UNI((int)(it / 256));
        const int n = cu % NC, hd = (cu / NC) % DNH, b = cu / (NC * DNH); const size_t m0 = (size_t)b * SEQ + n * 64; const float* Lc = Lm + (size_t)cu * 4096;
        float X[64];
#pragma unroll
        for (int j = 0; j < 64; ++j) { const float beta = GB[(m0 + j) * 16 + hd * 4 + 1];
            X[j] = col < 128 ? QKV[(m0 + j) * 1536 + 1024 + hd * 128 + col] * beta : KN[(m0 + j) * 512 + hd * 128 + (col - 128)] * beta * FEXP(GB[(m0 + j) * 16 + hd * 4 + 2]); }
#pragma unroll
        for (int i = 1; i < 64; ++i) { float acc = X[i];
#pragma unroll
            for (int j = 0; j < i; ++j) acc -= Lc[i * 64 + j] * X[j];
            X[i] = acc; DN_FENCE(); }
        if (col < 128) {
#pragma unroll
            for (int j = 0; j < 64; ++j) UT[(size_t)cu * 8192 + (size_t)col * 64 + j] = X[j]; }
        else {
#pragma unroll
            for (int j = 0; j < 64; ++j) WN[(size_t)cu * 8192 + (size_t)j * 128 + (col - 128)] = f2bf(-X[j]); } }
}
HD float bfr(float x) { return bf2f(f2bf(x)); }
HD void ph_dn_b_naive(const Args& a, int r, size_t gtid, size_t gsz) {
    const float* UT = (const float*)(a.ws + WS_UT); const bf16* WN = (const bf16*)(a.ws + WS_WN); const bf16* QG = (const bf16*)(a.ws + WS_QG); const bf16* AT = (const bf16*)(a.ws + WS_AT);
    const bf16* KDT = (const bf16*)(a.ws + WS_KDT); const float* GL = (const float*)(a.ws + WS_GL); float* ODN = (float*)(a.ws + WS_ODN); float* VN = (float*)(a.ws + WS_SCR);
    for (size_t it = gtid; it < (size_t)NB * DNH * 128; it += gsz) { const int v = (int)(it % 128), bh = UNI((int)(it / 128)), b = bh / DNH, hd = bh % DNH;
        float S[128];
#pragma unroll
        for (int d = 0; d < 128; ++d) S[d] = 0.f;
        for (int n = 0; n < NC; ++n) { const size_t cu = (size_t)bh * NC + n;
            for (int i = 0; i < 64; ++i) { float acc = UT[cu * 8192 + (size_t)v * 64 + i]; const bf16* wr = WN + cu * 8192 + i * 128;
#pragma unroll
                for (int d = 0; d < 128; ++d) acc += bf2f(wr[d]) * S[d];
                VN[((size_t)bh * 64 + i) * 128 + v] = acc; DN_FENCE(); }
            for (int i = 0; i < 64; ++i) { float acc = 0.f; const bf16* qr = QG + cu * 8192 + i * 128;
#pragma unroll
                for (int d = 0; d < 128; ++d) acc += bf2f(qr[d]) * S[d];
                for (int j = 0; j < 64; ++j) acc += bf2f(AT[cu * 4096 + i * 64 + j]) * bfr(VN[((size_t)bh * 64 + j) * 128 + v]);
                ODN[((size_t)b * SEQ + n * 64 + i) * 512 + hd * 128 + v] = acc; DN_FENCE(); }
            const float gl = GL[cu];
#pragma unroll
            for (int d = 0; d < 128; ++d) S[d] *= gl;
            for (int j = 0; j < 64; ++j) { const float vj = bfr(VN[((size_t)bh * 64 + j) * 128 + v]); const bf16* kr = KDT + cu * 8192 + j;
#pragma unroll
                for (int d = 0; d < 128; ++d) S[d] += bf2f(kr[d * 64]) * vj;
                DN_FENCE(); }
            DN_FENCE(); }
        float* so = a.out + O_SP + ((((size_t)r * NB + b) * DNH + hd) * 128) * 128 + v;
#pragma unroll
        for (int d = 0; d < 128; ++d) so[(size_t)d * 128] = S[d]; }
}
HD void ph_rec_out(const Args& a, int r, size_t gtid, size_t gsz) {
    const float* P = (const float*)(a.ws + WS_P); const float* HH = (const float*)(a.ws + WS_HH); const float* ODN = (const float*)(a.ws + WS_ODN); bf16* Y2 = (bf16*)(a.ws + WS_Y2);
    for (size_t i = gtid; i < (size_t)MT * Y2W; i += gsz) { const int m = (int)(i / Y2W), c = (int)(i % Y2W); float y;
        if (c < D_RNN) { float h = HH[(size_t)m * D_RNN + c]; if (m < MP) h += ((const float*)(a.ws + WS_XR))[(size_t)m * D_RNN + c] * ((const float*)(a.ws + WS_CARRY))[(size_t)(m / 64) * D_RNN + c];
            y = h * gelu_tanhf_(P[(size_t)m * LDP + OFF_GATE + c]); }
        else { const int cc = c - D_RNN, hd = cc / 128, vv = cc % 128; const float* o = ODN + (size_t)m * 512 + hd * 128; float ss = 0.f;
            for (int d = 0; d < 128; ++d) ss += o[d] * o[d];
            y = o[vv] / sqrtf(ss * (1.0f / 128.0f) + EPS) * a.in[I_DNW][r * 128 + vv] * siluf_(P[(size_t)m * LDP + OFF_Z + cc]); }
        Y2[i] = f2bf(y); }
}
HD void ph_att_split(const Args& a, int ai, size_t gtid, size_t gsz) {
    const float* P = (const float*)(a.ws + WS_P); constexpr int W = 2 * KVH * HDIM + IDIM;
    for (size_t i = gtid; i < (size_t)MT * W; i += gsz) { const int m = (int)(i / W), c = (int)(i % W);
        if (m < MP) { if (c < 256) a.out[O_KP + ((size_t)ai * MP + m) * 256 + c] = P[(size_t)m * LDP + AO_K + c];
            else if (c < 512) a.out[O_VP + ((size_t)ai * MP + m) * 256 + (c - 256)] = P[(size_t)m * LDP + AO_V + (c - 256)];
            else a.out[O_KIP + ((size_t)ai * MP + m) * 64 + (c - 512)] = P[(size_t)m * LDP + AO_KI + (c - 512)]; }
        else { const int ms = m - MP; if (c < 256) a.out[O_KS + ((size_t)ai * MS + ms) * 256 + c] = P[(size_t)m * LDP + AO_K + c];
            else if (c < 512) a.out[O_VS + ((size_t)ai * MS + ms) * 256 + (c - 256)] = P[(size_t)m * LDP + AO_V + (c - 256)];
            else a.out[O_KIS + ((size_t)ai * MS + ms) * 64 + (c - 512)] = P[(size_t)m * LDP + AO_KI + (c - 512)]; } }
}
HD const float* ki_row_sample(const Args& a, int ai, int db, int s) {
    if (s < PAST) { const int pg = ((const int*)a.in[I_PT])[db * NPAGES + s / PAGE]; return a.in[I_CKI] + (((size_t)ai * NPOOL + pg) * PAGE + s % PAGE) * IDIM; }
    return (const float*)(a.ws + WS_P) + (size_t)(MP + db * DT + (s - PAST)) * LDP + AO_KI;
}
HD void ph_idx_scores(const Args& a, int ai, bool prompt_too, size_t gtid, size_t gsz) {
    const float* P = (const float*)(a.ws + WS_P); float* SCT = (float*)(a.ws + WS_SCT);
    const int lane = (int)(gtid & 63); const size_t w = gtid >> 6, nw = gsz >> 6;
    constexpr int TM = 8, NKB = (SEQ + 63) / 64, NMT = SEQ / TM, NKBS = (PAST + DT + 63) / 64;
    const size_t n_p = (size_t)NB * NMT * NKB, n_s = (size_t)DB * NKBS;
    for (size_t it0 = w + (prompt_too ? 0 : n_p); it0 < n_p + n_s; it0 += nw) { const size_t it = (size_t)UNI((int)it0);
        int mrow0, nrows, s, smax_valid; const float* kr;
        if (it < n_p) { const int b = (int)(it / ((size_t)NMT * NKB)), rr = (int)(it % ((size_t)NMT * NKB)), mt = rr / NKB, kb = rr % NKB;
            if (kb * 64 > mt * TM + TM - 1) continue;
            mrow0 = b * SEQ + mt * TM; nrows = TM; s = kb * 64 + lane; smax_valid = SEQ; kr = P + (size_t)(b * SEQ + (s < SEQ ? s : 0)) * LDP + AO_KI; }
        else { const int q = (int)(it - n_p), db = q / NKBS, kb = q % NKBS; mrow0 = MP + db * DT; nrows = DT; s = kb * 64 + lane; smax_valid = PAST + DT; kr = ki_row_sample(a, ai, db, s < PAST + DT ? s : 0); }
        float kv[IDIM];
#pragma unroll
        for (int d = 0; d < IDIM; ++d) kv[d] = kr[d];
        for (int i = 0; i < nrows; ++i) { const int m = mrow0 + i; const float* qi = P + (size_t)m * LDP + AO_QI; const float* wi = P + (size_t)m * LDP + AO_WI; float sc = 0.f;
            for (int h = 0; h < IH; ++h) { float dot = 0.f;
#pragma unroll
                for (int d = 0; d < IDIM; ++d) dot += qi[h * IDIM + d] * kv[d];
                sc += wi[h] * fmaxf(dot, 0.f); }
            if (s < smax_valid) SCT[(size_t)m * SLD + s] = sc; } }
}
HD void ph_select(const Args& a, size_t gtid, size_t gsz) {
    const float* SCT = (const float*)(a.ws + WS_SCT); int* IDX = (int*)(a.ws + WS_IDX); int* NSEL = (int*)(a.ws + WS_NSEL);
    for (size_t m = gtid; m < (size_t)MT; m += gsz) { const RowInfo ri = row_info((int)m);
        const int n = ri.sample ? PAST + ri.t + 1 : ri.t + 1, K = ri.sample ? TOPK_S : TOPK_P; const float* col = SCT + m * SLD; int* out = IDX + m * KROW;
        if (n <= K) { for (int j = 0; j < n; ++j) out[j] = j; NSEL[m] = n; continue; }
        unsigned lo = 0u;
        for (int bit = 31; bit >= 0; --bit) { const unsigned cand = lo | (1u << bit); int c = 0;
            for (int s = 0; s < n; ++s) c += (fkey(col[s]) >= cand) ? 1 : 0;
            if (c >= K) lo = cand; }
        int cnt = 0;
        for (int s = 0; s < n; ++s) if (fkey(col[s]) > lo) out[cnt++] = s;
        for (int s = 0; s < n && cnt < K; ++s) if (fkey(col[s]) == lo) out[cnt++] = s;
        NSEL[m] = K; }
}
HD const float* kv_row(const Args& a, int ai, const RowInfo& ri, int idx, int kvh, bool isv) {
    const float* P = (const float*)(a.ws + WS_P); const int off = (isv ? AO_V : AO_K) + kvh * HDIM;
    if (!ri.sample) return P + (size_t)(ri.row0 + idx) * LDP + off;
    const int db = ri.seq - NB;
    if (idx >= PAST) return P + (size_t)(MP + db * DT + (idx - PAST)) * LDP + off;
    const int pg = ((const int*)a.in[I_PT])[db * NPAGES + idx / PAGE];
    return a.in[isv ? I_CV : I_CK] + ((((size_t)ai * NPOOL + pg) * PAGE + idx % PAGE) * KVH + kvh) * HDIM;
}
HD void ph_sp_scores(const Args& a, int ai, int m_lo, int m_hi, size_t gtid, size_t gsz) {
    const float* P = (const float*)(a.ws + WS_P); const int* IDX = (const int*)(a.ws + WS_IDX); const int* NSEL = (const int*)(a.ws + WS_NSEL); float* SCR = (float*)(a.ws + WS_SCR);
    for (size_t i = gtid + (size_t)m_lo * AH * KMAX; i < (size_t)m_hi * AH * KMAX; i += gsz) { const int j = (int)(i % KMAX), h = (int)((i / KMAX) % AH), m = (int)(i / ((size_t)KMAX * AH));
        if (j >= NSEL[m]) { SCR[i] = -1e30f; continue; }
        const RowInfo ri = row_info(m); const float* kr = kv_row(a, ai, ri, IDX[(size_t)m * KROW + j], h / GROUP, false); const float* q = P + (size_t)m * LDP + h * HDIM; float dot = 0.f;
        for (int d = 0; d < HDIM; ++d) dot += q[d] * kr[d];
        SCR[i] = dot * 0.08838834764831845f; }
}
HD void ph_sp_out(const Args& a, int ai, int m_lo, int m_hi, size_t gtid, size_t gsz) {
    const int* IDX = (const int*)(a.ws + WS_IDX); const int* NSEL = (const int*)(a.ws + WS_NSEL); const float* SCR = (const float*)(a.ws + WS_SCR); bf16* O = (bf16*)(a.ws + WS_Y2);
    for (size_t i = gtid + (size_t)m_lo * AH * HDIM; i < (size_t)m_hi * AH * HDIM; i += gsz) { const int d = (int)(i % HDIM), h = (int)((i / HDIM) % AH), m = (int)(i / ((size_t)HDIM * AH));
        const int ns = NSEL[m]; const float* sc = SCR + ((size_t)m * AH + h) * KMAX; const RowInfo ri = row_info(m);
        float mx = -3e38f; for (int j = 0; j < ns; ++j) mx = fmaxf(mx, sc[j]);
        float sum = 0.f, acc = 0.f;
        for (int j = 0; j < ns; ++j) { const float p = FEXP(sc[j] - mx); sum += p; acc += p * kv_row(a, ai, ri, IDX[(size_t)m * KROW + j], h / GROUP, true)[d]; }
        O[(size_t)m * D + h * HDIM + d] = f2bf(acc / sum); }
}
#ifndef HOST_TEST
#define LAS __attribute__((address_space(3)))

constexpr int LDS_WTAB = 131072 + 64;
__device__ __forceinline__ int TID() { extern __shared__ __attribute__((aligned(16))) unsigned char lds_dyn_[]; const unsigned hw = (unsigned)__builtin_amdgcn_s_getreg((5 << 11) | 4) & 63u;
    const int wvi = ((const LAS int*)((LAS unsigned char*)lds_dyn_ + LDS_WTAB))[hw]; int ln_; asm volatile("v_mbcnt_lo_u32_b32 %0, -1, 0\n\tv_mbcnt_hi_u32_b32 %0, -1, %0" : "=v"(ln_));
    return (wvi << 6) | ln_; }
#define XB_TMO      128
#define XB_XCNT(j)  (256  + 64 * (j))
#define XB_XSUB(j)  (1280 + 64 * (j))
#define XB_XGEN(j)  (2304 + 64 * (j))
#define XB_TOP      3328
#define XB_TOPGEN   3392
#define XCD_BAR_WORDS 3456
#define XB_SPIN_CAP (1u << 22)

__device__ __forceinline__ unsigned xb_ld(unsigned* p)              { return __hip_atomic_load(p, __ATOMIC_RELAXED, __HIP_MEMORY_SCOPE_AGENT); }
__device__ __forceinline__ unsigned xb_add(unsigned* p, unsigned v) { return __hip_atomic_fetch_add(p, v, __ATOMIC_RELAXED, __HIP_MEMORY_SCOPE_AGENT); }
__device__ __forceinline__ unsigned xb_xcc_id() { return (unsigned)__builtin_amdgcn_s_getreg((3 << 11) | 20) & 0xFu; }
#define XB_SPIN(cond, bar) do { unsigned _sp = 0; while (cond) { __builtin_amdgcn_s_sleep(1); \
    if ((++_sp & 255u) == 0u) { if (xb_ld(&(bar)[XB_TMO])) break; if (_sp > XB_SPIN_CAP) { atomicAdd(&(bar)[XB_TMO], 1u); break; } } } } while (0)

struct XcdBarrier {
    unsigned* bar; unsigned x;
    volatile LAS unsigned* st;
};

__device__ __forceinline__ XcdBarrier xcd_barrier_post(unsigned* bar, volatile LAS unsigned* st) {
    XcdBarrier b; b.bar = bar; b.x = xb_xcc_id(); b.st = st;
    if (TID() == 0) (void)xb_add(&bar[XB_XCNT(b.x)], 1u);
    return b;
}
__device__ __forceinline__ void xcd_barrier_complete(unsigned* bar, unsigned x, unsigned& nloc, unsigned& nx) {
    const unsigned G = gridDim.x * gridDim.y * gridDim.z;
    unsigned sum, cnt, mine, sp = 0u;
    for (;;) {
        sum = 0u; cnt = 0u; mine = 0u;
#pragma unroll
        for (unsigned j = 0; j < 16; ++j) { const unsigned c = xb_ld(&bar[XB_XCNT(j)]); sum += c; cnt += (c > 0u) ? 1u : 0u; mine = (j == x) ? c : mine; }
        if (sum == G) break;
        __builtin_amdgcn_s_sleep(1);
        if ((++sp & 255u) == 0u) { if (xb_ld(&bar[XB_TMO])) break; if (sp > XB_SPIN_CAP) { atomicAdd(&bar[XB_TMO], 1u); break; } }
    }
    nloc = mine > 0u ? mine : 1u; nx = cnt > 0u ? cnt : 1u;
}

__device__ __forceinline__ void xcd_barrier(const XcdBarrier& b) {
    asm volatile("s_waitcnt vmcnt(0)" ::: "memory");
    __syncthreads();
    if (TID() == 0) {
        unsigned* bar = b.bar;
        __builtin_amdgcn_s_waitcnt(0);
        unsigned nloc = b.st[0], nx = b.st[1];
        if (nloc == 0u) { xcd_barrier_complete(bar, b.x, nloc, nx); b.st[0] = nloc; b.st[1] = nx; }
        const unsigned old = xb_add(&bar[XB_XSUB(b.x)], 1u);
        const unsigned gen = old / nloc;
        if (old + 1u == (gen + 1u) * nloc) {
            __builtin_amdgcn_fence(__ATOMIC_RELEASE, "agent");
            asm volatile("s_waitcnt vmcnt(0)" ::: "memory");
            const unsigned og = xb_add(&bar[XB_TOP], 1u);
            const unsigned tg = og / nx;
            if (og + 1u == (tg + 1u) * nx) xb_add(&bar[XB_TOPGEN], 1u);
            else XB_SPIN(xb_ld(&bar[XB_TOPGEN]) == tg, bar);
            __builtin_amdgcn_fence(__ATOMIC_ACQUIRE, "agent");
            xb_add(&bar[XB_XGEN(b.x)], 1u);
            asm volatile("s_waitcnt vmcnt(0)" ::: "memory");
        } else {
            XB_SPIN(xb_ld(&bar[XB_XGEN(b.x)]) == gen, bar);
            __builtin_amdgcn_fence(__ATOMIC_ACQUIRE, "agent");
            asm volatile("s_waitcnt vmcnt(0)" ::: "memory");
        }
    }
    __syncthreads();
}

namespace pg8 {
#define PG8_LAS __attribute__((address_space(3)))
typedef unsigned short bf16_t;
typedef short bf16x8 __attribute__((ext_vector_type(8)));
typedef float f32x4 __attribute__((ext_vector_type(4)));
typedef unsigned u32x4 __attribute__((ext_vector_type(4)));
constexpr int BM = 256, BK = 64, HALF = 128, HTB = HALF * BK * 2  , STAGE_BYTES = 8 * HTB, NXCD = 8, WGM = 8;

__host__ __device__ __forceinline__ int lds_byte(int r, int c) { const int st = (r >> 4) * 2 + (c >> 5), rr = r & 15, cc = c & 31, ob = rr * 64 + cc * 2; return st * 1024 + (ob ^ (((ob >> 9) & 1) << 5)); }
__host__ __device__ __forceinline__ void stage_rc(int b, int& R, int& C) { const int st = b / 1024, sb = b % 1024, swz = sb ^ (((sb >> 9) & 1) << 5); R = (st >> 1) * 16 + swz / 64; C = (st & 1) * 32 + (swz % 64) / 2; }
__host__ __device__ __forceinline__ int perm32(int rho) { const int n = rho >> 4, i = rho & 15; return 8 * (i >> 2) + 4 * n + (i & 3); }

struct Unit { int pm, pn; };
struct Gemm { const bf16_t* A; const bf16_t* Bt; int M, N, K; };

struct StaticOrder {
    int nM, nN, nwg, G, c;
    __host__ __device__ void init(int M, int N, int G_, int c_) { nM = M / BM; nN = N / BM; nwg = nM * nN; G = G_; c = c_; }
    __host__ __device__ bool next(int i, Unit& u) const {
        const long L = (long)i * G + c; if (L >= nwg) return false;
        int wgid = (int)L; { const int q = nwg / NXCD, r = nwg % NXCD, xcd = wgid % NXCD, off = wgid / NXCD; wgid = (xcd < r ? xcd * (q + 1) : r * (q + 1) + (xcd - r) * q) + off; }
        const int nig = WGM * nN, gid = wgid / nig, fm = gid * WGM, gsz = (nM - fm) < WGM ? (nM - fm) : WGM;
        u.pm = fm + ((wgid % nig) % gsz); u.pn = (wgid % nig) / gsz; return true;
    }
    __device__ __forceinline__ void a_ready(const Unit&) const {}
    __device__ __forceinline__ void done(const Unit&) const {}
};

__device__ __forceinline__ unsigned cvt_pk_bf16(float lo, float hi) { unsigned r; asm volatile("v_cvt_pk_bf16_f32 %0, %1, %2" : "=v"(r) : "v"(lo), "v"(hi)); return r; }
struct EpiF32 {
    static constexpr bool PERM = false, AFTER_DRAIN = false;
    float* C; int ldc; const float* bias;
    __device__ __forceinline__ void operator()(const f32x4 (&acc)[2][2][4][2], const Unit& u, int wr, int wc, int fr, int fq) const {
        const int row0 = u.pm * BM + wr * 64 + fr, col0 = u.pn * BM + wc * 32 + 4 * fq;
        f32x4 bv[2][2];
#pragma unroll
        for (int bj = 0; bj < 2; ++bj)
#pragma unroll
            for (int n = 0; n < 2; ++n) bv[bj][n] = bias ? *(const f32x4*)(bias + col0 + bj * HALF + n * 16) : (f32x4){0.f, 0.f, 0.f, 0.f};
#pragma unroll
        for (int ai = 0; ai < 2; ++ai)
#pragma unroll
            for (int m = 0; m < 4; ++m) { float* rowp = C + (size_t)(row0 + ai * HALF + m * 16) * ldc + col0;
#pragma unroll
                for (int bj = 0; bj < 2; ++bj)
#pragma unroll
                    for (int n = 0; n < 2; ++n) *(f32x4*)(rowp + bj * HALF + n * 16) = acc[ai][bj][m][n] + bv[bj][n]; }
    }
};
template <class Epi, class Sched, bool STAMP = false>
__device__ __forceinline__ void gemm_phase(PG8_LAS unsigned char* lds, const Gemm g, const Sched& S, const Epi& E, unsigned long long* stamps) {
    int tid_ = TID(); asm volatile("" : "+v"(tid_));
    const int tid = tid_, wid = __builtin_amdgcn_readfirstlane(tid >> 6), lane = tid & 63, wr = wid >> 2, wc = wid & 3, fr = lane & 15, fq = lane >> 4;
    const int K = g.K, nt = K / BK;
    int ts_lo = 0, ts_hi = 0, nts = 0; const unsigned long long rt_entry = STAMP ? (unsigned long long)wall_clock64() : 0ull;
#define PG8_STAMP() do { if (STAMP && wid == 0 && nts < 64) { const unsigned long long _c = (unsigned long long)clock64(); \
        ts_lo = (lane == nts) ? (int)(unsigned)_c : ts_lo; ts_hi = (lane == nts) ? (int)(unsigned)(_c >> 32) : ts_hi; ++nts; } } while (0)
    PG8_STAMP();
    unsigned voffA[2], voffB[2];
#pragma unroll
    for (int i = 0; i < 2; ++i) { int R, C; stage_rc(tid * 16 + i * 8192, R, C); const int Rb = Epi::PERM ? ((R & ~31) + perm32(R & 31)) : R;
        voffA[i] = (unsigned)(R * K + C) * 2u; voffB[i] = (unsigned)(Rb * K + C) * 2u; }
    const size_t kstep = (size_t)(BK * 2);
    const size_t hstep = (size_t)HALF * K * 2;
    const size_t tstep = 2 * hstep;
    const unsigned ldsw = (unsigned)wid * 1024u;
    const int aoff = lds_byte(wr * 64 + fr, fq * 8), boff = lds_byte(wc * 32 + fr, fq * 8);
#define PG8_SA(b, h) (((b) * 2 + (h)) * HTB)
#define PG8_SB(b, h) ((4 + (b) * 2 + (h)) * HTB)
#define PG8_STAGE(bufoff, gbase, voff) do { _Pragma("unroll") for (int _i = 0; _i < 2; ++_i) \
        __builtin_amdgcn_global_load_lds((const unsigned*)((const char*)(gbase) + (voff)[_i]), (PG8_LAS unsigned*)(lds + (bufoff) + ldsw + _i * 8192), 16, 0, 0); } while (0)
#define PG8_LDA(dst, b, h) do { _Pragma("unroll") for (int m = 0; m < 4; ++m) _Pragma("unroll") for (int k = 0; k < 2; ++k) dst[m][k] = *(const PG8_LAS bf16x8*)(lds + PG8_SA(b, h) + aoff + m * 2048 + k * 1024); } while (0)
#define PG8_LDB(dst, b, h) do { _Pragma("unroll") for (int n = 0; n < 2; ++n) _Pragma("unroll") for (int k = 0; k < 2; ++k) dst[n][k] = *(const PG8_LAS bf16x8*)(lds + PG8_SB(b, h) + boff + n * 2048 + k * 1024); } while (0)
#define PG8_MMA(ai, bj, At, Bt) do { __builtin_amdgcn_s_setprio(1); _Pragma("unroll") for (int m = 0; m < 4; ++m) _Pragma("unroll") for (int n = 0; n < 2; ++n) _Pragma("unroll") for (int k = 0; k < 2; ++k) \
        acc[ai][bj][m][n] = __builtin_amdgcn_mfma_f32_16x16x32_bf16(Bt[n][k], At[m][k], acc[ai][bj][m][n], 0, 0, 0); __builtin_amdgcn_s_setprio(0); } while (0)
#define PG8_WAIT_V(n) asm volatile("s_waitcnt vmcnt(" #n ")" ::: "memory")
#define PG8_WAIT_L(n) asm volatile("s_waitcnt lgkmcnt(" #n ")" ::: "memory")
#define PG8_BAR __builtin_amdgcn_s_barrier()
#define PG8_SCHED __builtin_amdgcn_sched_barrier(0)
    Unit cur, nxt; int ui = 0;
    if (!S.next(0, cur)) return;
    f32x4 acc[2][2][4][2];
#pragma unroll
    for (int a = 0; a < 2; ++a)
#pragma unroll
        for (int b = 0; b < 2; ++b)
#pragma unroll
            for (int m = 0; m < 4; ++m)
#pragma unroll
                for (int n = 0; n < 2; ++n) acc[a][b][m][n] = (f32x4){0.f, 0.f, 0.f, 0.f};
    bf16x8 At[4][2], B0[2][2], B1[2][2];
    const char* cA = (const char*)g.A + (size_t)cur.pm * tstep; const char* cB = (const char*)g.Bt + (size_t)cur.pn * tstep;
    S.a_ready(cur);
    PG8_STAGE(PG8_SB(0, 0), cB, voffB); PG8_STAGE(PG8_SA(0, 0), cA, voffA); PG8_STAGE(PG8_SB(0, 1), cB + hstep, voffB); PG8_STAGE(PG8_SA(0, 1), cA + hstep, voffA);
    if (wr == 1) PG8_BAR;
    PG8_WAIT_V(4); PG8_BAR;
    PG8_STAGE(PG8_SB(1, 0), cB + kstep, voffB); PG8_STAGE(PG8_SA(1, 0), cA + kstep, voffA); PG8_STAGE(PG8_SB(1, 1), cB + hstep + kstep, voffB);
    PG8_WAIT_V(6); PG8_BAR;
    PG8_STAMP();
    for (;;) {
        const bool has_next = S.next(ui + 1, nxt);
        const char* nA = has_next ? (const char*)g.A + (size_t)nxt.pm * tstep : cA; const char* nB = has_next ? (const char*)g.Bt + (size_t)nxt.pn * tstep : cB;
        for (int t = 0; t < nt; t += 2) {
            const bool last = (t == nt - 2);
            const char* a1 = cA + (size_t)(t + 1) * kstep;
            const char* a2 = last ? nA : cA + (size_t)(t + 2) * kstep; const char* b2 = last ? nB : cB + (size_t)(t + 2) * kstep;
            const char* a3 = a2 + kstep; const char* b3 = b2 + kstep;
            if (last && has_next) S.a_ready(nxt);
            PG8_LDB(B0, 0, 0); PG8_SCHED; PG8_LDA(At, 0, 0); PG8_STAGE(PG8_SA(1, 1), a1 + hstep, voffA);
            PG8_WAIT_L(8); PG8_BAR; PG8_WAIT_L(0); PG8_MMA(0, 0, At, B0); PG8_BAR; PG8_SCHED;
            PG8_LDB(B1, 0, 1); PG8_STAGE(PG8_SB(0, 0), b2, voffB);
            PG8_BAR; PG8_WAIT_L(0); PG8_MMA(0, 1, At, B1); PG8_BAR;
            PG8_LDA(At, 0, 1); PG8_STAGE(PG8_SA(0, 0), a2, voffA);
            PG8_BAR; PG8_WAIT_L(0); PG8_MMA(1, 0, At, B0); PG8_BAR; PG8_SCHED;
            PG8_STAGE(PG8_SB(0, 1), b2 + hstep, voffB);
            PG8_WAIT_V(6); PG8_BAR; PG8_MMA(1, 1, At, B1); PG8_BAR;
            PG8_LDB(B0, 1, 0); PG8_SCHED; PG8_LDA(At, 1, 0); PG8_STAGE(PG8_SA(0, 1), a2 + hstep, voffA);
            PG8_WAIT_L(8); PG8_BAR; PG8_WAIT_L(0); PG8_MMA(0, 0, At, B0); PG8_BAR; PG8_SCHED;
            PG8_LDB(B1, 1, 1); PG8_STAGE(PG8_SB(1, 0), b3, voffB);
            PG8_BAR; PG8_WAIT_L(0); PG8_MMA(0, 1, At, B1); PG8_BAR;
            PG8_LDA(At, 1, 1); PG8_STAGE(PG8_SA(1, 0), a3, voffA);
            PG8_BAR; PG8_WAIT_L(0); PG8_MMA(1, 0, At, B0); PG8_BAR; PG8_SCHED;
            PG8_STAGE(PG8_SB(1, 1), b3 + hstep, voffB);
            PG8_WAIT_V(6); PG8_BAR; PG8_MMA(1, 1, At, B1); PG8_BAR;
        }
        PG8_STAMP();
        if constexpr (!Epi::AFTER_DRAIN) { E(acc, cur, wr, wc, fr, fq); S.done(cur); }
        PG8_STAMP();
        if (!has_next) break;
#pragma unroll
        for (int a = 0; a < 2; ++a)
#pragma unroll
            for (int b = 0; b < 2; ++b)
#pragma unroll
                for (int m = 0; m < 4; ++m)
#pragma unroll
                    for (int n = 0; n < 2; ++n) acc[a][b][m][n] = (f32x4){0.f, 0.f, 0.f, 0.f};
        cur = nxt; cA = nA; cB = nB; ++ui;
    }
    PG8_WAIT_V(0);
    if (wr == 0) PG8_BAR;
    PG8_BAR;
    if constexpr (Epi::AFTER_DRAIN) { E.fused(acc, cur, wr, wc, fr, fq, lds, wid, lane); S.done(cur); }
    PG8_STAMP();
    if (STAMP && wid == 0) { stamps[lane] = lane < nts ? (((unsigned long long)(unsigned)ts_hi << 32) | (unsigned)ts_lo) : 0ull;
        if (lane == 62) stamps[62] = rt_entry; if (lane == 63) stamps[63] = (unsigned long long)wall_clock64(); }
#undef PG8_STAMP
#undef PG8_SA
#undef PG8_SB
#undef PG8_STAGE
#undef PG8_LDA
#undef PG8_LDB
#undef PG8_MMA
#undef PG8_WAIT_V
#undef PG8_WAIT_L
#undef PG8_BAR
#undef PG8_SCHED
}
}
#endif

#ifndef HOST_TEST
#include <cstdio>
#define FRAG_OFF(row_, k_, KS_) ((((((row_) >> 4) * (KS_) + ((k_) >> 5)) * 64 + (((k_) >> 3) & 3) * 16 + ((row_) & 15)) * 8) + ((k_) & 7))
namespace pg8 {
struct EpiAddF32 {
    static constexpr bool PERM = false, AFTER_DRAIN = false;
    float* C; int ldc;
    __device__ __forceinline__ void operator()(const f32x4 (&acc)[2][2][4][2], const Unit& u, int wr, int wc, int fr, int fq) const {
        const int row0 = u.pm * BM + wr * 64 + fr, col0 = u.pn * BM + wc * 32 + 4 * fq;
#pragma unroll
        for (int ai = 0; ai < 2; ++ai)
#pragma unroll
            for (int m = 0; m < 4; ++m) { float* rowp = C + (size_t)(row0 + ai * HALF + m * 16) * ldc + col0;
#pragma unroll
                for (int bj = 0; bj < 2; ++bj)
#pragma unroll
                    for (int n = 0; n < 2; ++n) { f32x4* p = (f32x4*)(rowp + bj * HALF + n * 16); *p = *p + acc[ai][bj][m][n]; } }
    }
};
struct EpiRelu2Bf16 {
    static constexpr bool PERM = true, AFTER_DRAIN = false;
    bf16_t* O; int ldc;
    __device__ __forceinline__ void operator()(const f32x4 (&acc)[2][2][4][2], const Unit& u, int wr, int wc, int fr, int fq) const {
        const int row0 = u.pm * BM + wr * 64 + fr, col0 = u.pn * BM + wc * 32 + 8 * fq;
#pragma unroll
        for (int ai = 0; ai < 2; ++ai)
#pragma unroll
            for (int m = 0; m < 4; ++m) { bf16_t* rowp = O + (size_t)(row0 + ai * HALF + m * 16) * ldc + col0;
#pragma unroll
                for (int bj = 0; bj < 2; ++bj) { f32x4 v0 = acc[ai][bj][m][0], v1 = acc[ai][bj][m][1];
#pragma unroll
                    for (int j = 0; j < 4; ++j) { const float r0 = fmaxf(v0[j], 0.f), r1 = fmaxf(v1[j], 0.f); v0[j] = r0 * r0; v1[j] = r1 * r1; }
                    u32x4 w; w.x = cvt_pk_bf16(v0[0], v0[1]); w.y = cvt_pk_bf16(v0[2], v0[3]); w.z = cvt_pk_bf16(v1[0], v1[1]); w.w = cvt_pk_bf16(v1[2], v1[3]);
                    *(u32x4*)(rowp + bj * HALF) = w; } }
    }
};

__device__ __forceinline__ float epi_shfl_xor(float v, int o, int lane) { return __builtin_bit_cast(float, __builtin_amdgcn_ds_bpermute((lane ^ o) << 2, __builtin_bit_cast(int, v))); }
__device__ __forceinline__ float row_rs(const unsigned long long* ss, int row) { return FRSQ((float)ss[row] * (5.9604644775390625e-08f / D) + EPS); }
struct EpiF32S {
    static constexpr bool PERM = true, AFTER_DRAIN = false;
    float* C; int ldc; const unsigned long long* ss;
    __device__ __forceinline__ void operator()(const f32x4 (&acc)[2][2][4][2], const Unit& u, int wr, int wc, int fr_in, int fq_in) const {
        int fr = fr_in, fq = fq_in; asm volatile("" : "+v"(fr), "+v"(fq));
        const int row0 = u.pm * BM + wr * 64 + fr, col0 = u.pn * BM + wc * 32 + 8 * fq;
#pragma unroll
        for (int ai = 0; ai < 2; ++ai)
#pragma unroll
            for (int m = 0; m < 4; ++m) { const int row = row0 + ai * HALF + m * 16; const float rs = row_rs(ss, row); float* rowp = C + (size_t)row * ldc + col0;
#pragma unroll
                for (int bj = 0; bj < 2; ++bj) { *(f32x4*)(rowp + bj * HALF) = acc[ai][bj][m][0] * rs; *(f32x4*)(rowp + bj * HALF + 4) = acc[ai][bj][m][1] * rs; } }
    }
};
struct EpiRelu2S {
    static constexpr bool PERM = true, AFTER_DRAIN = false;
    bf16_t* O; int ldc; const unsigned long long* ss;
    __device__ __forceinline__ void operator()(const f32x4 (&acc)[2][2][4][2], const Unit& u, int wr, int wc, int fr_in, int fq_in) const {
        int fr = fr_in, fq = fq_in; asm volatile("" : "+v"(fr), "+v"(fq));
        const int row0 = u.pm * BM + wr * 64 + fr, col0 = u.pn * BM + wc * 32 + 8 * fq;
#pragma unroll
        for (int ai = 0; ai < 2; ++ai)
#pragma unroll
            for (int m = 0; m < 4; ++m) { const int row = row0 + ai * HALF + m * 16; const float rs = row_rs(ss, row); bf16_t* rowp = O + (size_t)row * ldc + col0;
#pragma unroll
                for (int bj = 0; bj < 2; ++bj) { f32x4 v0 = acc[ai][bj][m][0] * rs, v1 = acc[ai][bj][m][1] * rs;
#pragma unroll
                    for (int j = 0; j < 4; ++j) { const float r0 = fmaxf(v0[j], 0.f), r1 = fmaxf(v1[j], 0.f); v0[j] = r0 * r0; v1[j] = r1 * r1; }
                    u32x4 w; w.x = cvt_pk_bf16(v0[0], v0[1]); w.y = cvt_pk_bf16(v0[2], v0[3]); w.z = cvt_pk_bf16(v1[0], v1[1]); w.w = cvt_pk_bf16(v1[2], v1[3]);
                    *(u32x4*)(rowp + bj * HALF) = w; } }
    }
};
struct EpiAddN {
    static constexpr bool PERM = true, AFTER_DRAIN = false;
    float* C; int ldc; bf16_t* XB; unsigned long long* ss;
    __device__ __forceinline__ void operator()(const f32x4 (&acc)[2][2][4][2], const Unit& u, int wr, int wc, int fr_in, int fq_in) const {
        int fr = fr_in, fq = fq_in; asm volatile("" : "+v"(fr), "+v"(fq));
        const int row0 = u.pm * BM + wr * 64 + fr, col0 = u.pn * BM + wc * 32 + 8 * fq, lane = fq * 16 + fr;
#pragma unroll
        for (int ai = 0; ai < 2; ++ai)
#pragma unroll
            for (int m = 0; m < 4; ++m) { const int row = row0 + ai * HALF + m * 16; float* rowp = C + (size_t)row * ldc + col0; bf16_t* xbp = XB + (size_t)row * ldc + col0; float q = 0.f;
#pragma unroll
                for (int bj = 0; bj < 2; ++bj) { f32x4* p = (f32x4*)(rowp + bj * HALF); const f32x4 v0 = p[0] + acc[ai][bj][m][0], v1 = p[1] + acc[ai][bj][m][1]; p[0] = v0; p[1] = v1;
                    q += ((v0[0] * v0[0] + v0[1] * v0[1]) + (v0[2] * v0[2] + v0[3] * v0[3])) + ((v1[0] * v1[0] + v1[1] * v1[1]) + (v1[2] * v1[2] + v1[3] * v1[3]));
                    u32x4 w; w.x = cvt_pk_bf16(v0[0], v0[1]); w.y = cvt_pk_bf16(v0[2], v0[3]); w.z = cvt_pk_bf16(v1[0], v1[1]); w.w = cvt_pk_bf16(v1[2], v1[3]); *(u32x4*)(xbp + bj * HALF) = w; }
                q += epi_shfl_xor(q, 16, lane); q += epi_shfl_xor(q, 32, lane);
                if (fq == 0) __hip_atomic_fetch_add(ss + row, (unsigned long long)(q * 16777216.0f), __ATOMIC_RELAXED, __HIP_MEMORY_SCOPE_AGENT); }
    }
};
struct EpiAttS {
    static constexpr bool PERM = false, AFTER_DRAIN = false;
    unsigned char* ws; float* out; const unsigned long long* ss; int ai_;
    __device__ __forceinline__ void operator()(const f32x4 (&acc)[2][2][4][2], const Unit& u, int wr, int wc, int fr_in, int fq_in) const {
        int fr = fr_in, fq = fq_in; asm volatile("" : "+v"(fr), "+v"(fq));
        float* P = (float*)(ws + WS_P); constexpr int ldc = LDP; bf16_t* QB = (bf16_t*)(ws + WS_QB); bf16_t* KB = (bf16_t*)(ws + WS_KB); bf16_t* VB = (bf16_t*)(ws + WS_VB); bf16_t* QIB = (bf16_t*)(ws + WS_QIB); bf16_t* KIB = (bf16_t*)(ws + WS_KIB);
        const int row0 = u.pm * BM + wr * 64 + fr; float rsv[2][4];
#pragma unroll
        for (int ai = 0; ai < 2; ++ai)
#pragma unroll
            for (int m = 0; m < 4; ++m) rsv[ai][m] = row_rs(ss, row0 + ai * HALF + m * 16);
#pragma unroll
        for (int bj = 0; bj < 2; ++bj)
#pragma unroll
            for (int n = 0; n < 2; ++n) { const int cb = u.pn * BM + bj * HALF + wc * 32 + n * 16;
                bf16_t* bdst; int bld, bc; float* odst0 = nullptr; float* odst1 = nullptr; int old_ = 0;
                if (cb < AO_K) { bdst = QB; bld = D; bc = cb; }
                else if (cb < AO_V) { bdst = KB; bld = 256; bc = cb - AO_K; odst0 = out + O_KP + (size_t)ai_ * MP * 256 + bc; odst1 = out + O_KS + (size_t)ai_ * MS * 256 + bc; old_ = 256; }
                else if (cb < AO_QI) { bdst = VB; bld = 256; bc = cb - AO_V; odst0 = out + O_VP + (size_t)ai_ * MP * 256 + bc; odst1 = out + O_VS + (size_t)ai_ * MS * 256 + bc; old_ = 256; }
                else if (cb < AO_KI) { bdst = QIB; bld = 512; bc = cb - AO_QI; }
                else if (cb < AO_WI) { bdst = KIB; bld = -1; bc = cb - AO_KI;     odst0 = out + O_KIP + (size_t)ai_ * MP * 64 + bc; odst1 = out + O_KIS + (size_t)ai_ * MS * 64 + bc; old_ = 64; }
                else { bdst = nullptr; bld = 0; bc = 0; }
                const bool keepP = (u.pm * BM >= MP) || (cb >= AO_WI);
#pragma unroll
                for (int ai = 0; ai < 2; ++ai)
#pragma unroll
                    for (int m = 0; m < 4; ++m) { const int row = row0 + ai * HALF + m * 16; const f32x4 v = acc[ai][bj][m][n] * rsv[ai][m]; if (keepP) *(f32x4*)(P + (size_t)row * ldc + cb + 4 * fq) = v;
                        if (bdst != nullptr && row < MT) { bf16_t* bp_ = bld >= 0 ? bdst + (size_t)row * bld + bc + 4 * fq : bdst + (size_t)(row >> 4) * 1024 + FRAG_OFF(row & 15, bc + 4 * fq, 2); *(uint2*)bp_ = make_uint2(cvt_pk_bf16(v[0], v[1]), cvt_pk_bf16(v[2], v[3]));
                            if (odst0 != nullptr) { float* op = row < MP ? odst0 + (size_t)row * old_ : odst1 + (size_t)(row - MP) * old_; *(f32x4*)(op + 4 * fq) = v; } } } }
    }
};
}

constexpr int NTHREADS = 512, LDS_BYTES = 147456, LDS_MISC = 131072;
typedef float f32x4_t __attribute__((ext_vector_type(4)));
__device__ __forceinline__ float shfl_xor_l(float v, int o, int lane) { return __builtin_bit_cast(float, __builtin_amdgcn_ds_bpermute((lane ^ o) << 2, __builtin_bit_cast(int, v))); }
__device__ __forceinline__ void ph_rmsnorm(const Args& a, const float* g) {
    static_assert(D == 1024, "device rmsnorm is written for D = 1024");
    const float* X = (const float*)(a.ws + WS_X); bf16* XN = (bf16*)(a.ws + WS_XN);
    int tx_ = TID(); asm volatile("" : "+v"(tx_));
    const int lane = tx_ & 63, wv = blockIdx.x * (NTHREADS >> 6) + (tx_ >> 6), nwv = gridDim.x * (NTHREADS >> 6);
    f32x4_t gv[4];
#pragma unroll
    for (int i = 0; i < 4; ++i) gv[i] = *(const f32x4_t*)(g + (i * 64 + lane) * 4);
    for (int m = wv; m < MPAD; m += nwv) { f32x4_t xv[4]; float ss = 0.f;
#pragma unroll
        for (int i = 0; i < 4; ++i) { xv[i] = *(const f32x4_t*)(X + (size_t)m * D + (i * 64 + lane) * 4); ss += xv[i][0] * xv[i][0] + xv[i][1] * xv[i][1] + xv[i][2] * xv[i][2] + xv[i][3] * xv[i][3]; }
#pragma unroll
        for (int o = 32; o >= 1; o >>= 1) ss += shfl_xor_l(ss, o, lane);
        const float r = FRSQ(ss * (1.0f / D) + EPS);
#pragma unroll
        for (int i = 0; i < 4; ++i) { const f32x4_t y = xv[i] * r * gv[i]; uint2 w; w.x = pg8::cvt_pk_bf16(y[0], y[1]); w.y = pg8::cvt_pk_bf16(y[2], y[3]); *(uint2*)(XN + (size_t)m * D + (i * 64 + lane) * 4) = w; } }
}

__device__ __forceinline__ void ph_prep_x(const Args& a) {
    float* X = (float*)(a.ws + WS_X); bf16* XB = (bf16*)(a.ws + WS_XN); unsigned long long* SS = (unsigned long long*)(a.ws + WS_SS);
    int tx_ = TID(); asm volatile("" : "+v"(tx_));
    const int lane = tx_ & 63, wv = blockIdx.x * (NTHREADS >> 6) + (tx_ >> 6), nwv = gridDim.x * (NTHREADS >> 6);
    for (int m = wv; m < MPAD; m += nwv) { const float* src = m < MP ? a.in[I_XP] + (size_t)m * D : a.in[I_XS] + (size_t)(m - MP) * D; float ss = 0.f;
#pragma unroll
        for (int i = 0; i < 4; ++i) { f32x4_t v = {0.f, 0.f, 0.f, 0.f}; if (m < MT) v = *(const f32x4_t*)(src + (i * 64 + lane) * 4);
            *(f32x4_t*)(X + (size_t)m * D + (i * 64 + lane) * 4) = v; ss += v[0] * v[0] + v[1] * v[1] + v[2] * v[2] + v[3] * v[3];
            uint2 w; w.x = pg8::cvt_pk_bf16(v[0], v[1]); w.y = pg8::cvt_pk_bf16(v[2], v[3]); *(uint2*)(XB + (size_t)m * D + (i * 64 + lane) * 4) = w; }
#pragma unroll
        for (int o = 32; o >= 1; o >>= 1) ss += shfl_xor_l(ss, o, lane);
        if (lane == 0) SS[m] = (unsigned long long)(ss * 16777216.0f); }
}
__device__ __forceinline__ void ph_final(const Args& a) {
    const float* X = (const float*)(a.ws + WS_X); const float* g = a.in[I_NFIN];
    int tx_ = TID(); asm volatile("" : "+v"(tx_));
    const int lane = tx_ & 63, wv = blockIdx.x * (NTHREADS >> 6) + (tx_ >> 6), nwv = gridDim.x * (NTHREADS >> 6);
    f32x4_t gv[4];
#pragma unroll
    for (int i = 0; i < 4; ++i) gv[i] = *(const f32x4_t*)(g + (i * 64 + lane) * 4);
    for (int m = wv; m < MT; m += nwv) { f32x4_t xv[4]; float ss = 0.f;
#pragma unroll
        for (int i = 0; i < 4; ++i) { xv[i] = *(const f32x4_t*)(X + (size_t)m * D + (i * 64 + lane) * 4); ss += xv[i][0] * xv[i][0] + xv[i][1] * xv[i][1] + xv[i][2] * xv[i][2] + xv[i][3] * xv[i][3]; }
#pragma unroll
        for (int o = 32; o >= 1; o >>= 1) ss += shfl_xor_l(ss, o, lane);
        const float r = FRSQ(ss * (1.0f / D) + EPS);
        float* orow = a.out + (m < MP ? O_YP + (size_t)m * D : O_YS + (size_t)(m - MP) * D);
#pragma unroll
        for (int i = 0; i < 4; ++i) *(f32x4_t*)(orow + (i * 64 + lane) * 4) = xv[i] * r * gv[i]; }
}


#ifndef DIAG_WRITE_O
#define DIAG_WRITE_O 1
#define DIAG_WRITE_S 1
#endif
typedef short bf16x8_t __attribute__((ext_vector_type(8)));
typedef unsigned u32x2_t __attribute__((ext_vector_type(2)));
typedef unsigned u32x4_t __attribute__((ext_vector_type(4)));
typedef float f32x2_t __attribute__((ext_vector_type(2)));
typedef __bf16 bf16x2n_t __attribute__((ext_vector_type(2)));
__device__ __forceinline__ unsigned pk_bf16(float lo, float hi) { const f32x2_t v = {lo, hi}; const bf16x2n_t r = __builtin_convertvector(v, bf16x2n_t); return __builtin_bit_cast(unsigned, r); }
__device__ __forceinline__ void ph_dn_b(const Args& a, int r, LAS unsigned char* lds) {
    const float* UT = (const float*)(a.ws + WS_UT); const bf16* WN = (const bf16*)(a.ws + WS_WN); const bf16* QG = (const bf16*)(a.ws + WS_QG); const bf16* AT = (const bf16*)(a.ws + WS_AT);
    const bf16* KDT = (const bf16*)(a.ws + WS_KDT); const float* GL = (const float*)(a.ws + WS_GL); float* ODN = (float*)(a.ws + WS_ODN); float* DUMP = (float*)(a.ws + WS_SCR);
    int tid_ = TID(); asm volatile("" : "+v"(tid_));
    const int tid = tid_, wid = __builtin_amdgcn_readfirstlane(tid >> 6), lane = tid & 63, fr = lane & 15, fq = lane >> 4;
    constexpr int STS = 136, VTS = 72;
    LAS bf16* ST = (LAS bf16*)lds; LAS bf16* VT = (LAS bf16*)(lds + 16 * STS * 2);
    const bool vw = wid < 4; const float uf = vw ? 1.0f : 0.0f;
    for (int unit = blockIdx.x; unit < NB * DNH * 8; unit += gridDim.x) {
        const int slice = unit & 7, bh = unit >> 3, b = bh / DNH, hd = bh % DNH, c0 = slice * 16;
        f32x4_t accS = {0.f, 0.f, 0.f, 0.f};
        for (int i = tid; i < 16 * STS; i += NTHREADS) ST[i] = (bf16)0;
        __syncthreads();
        const int i0 = (wid & 3) * 16;
        const bf16* p1 = (vw ? WN : QG) + (size_t)bh * NC * 8192 + (size_t)((wid & 3) * 4) * 512 + lane * 8;
        const bf16* p2 = AT + (size_t)bh * NC * 4096 + (size_t)((wid & 3) * 2) * 512 + lane * 8;
        const bf16* p3 = KDT + (size_t)bh * NC * 8192 + (size_t)(wid * 2) * 512 + lane * 8;
        const float* pu = UT + (size_t)bh * NC * 8192 + (size_t)(slice * 4 + (wid & 3)) * 256 + lane * 4; const float* pg = GL + (size_t)bh * NC;
        LAS bf16* vtw = VT + (vw ? 0 : 16 * VTS) + fr * VTS + i0 + 4 * fq;
        float* op = (vw ? DUMP + ((size_t)blockIdx.x * NTHREADS + tid) * 4 - (size_t)0 : ODN + ((size_t)b * SEQ + i0 + 4 * fq) * 512 + hd * 128 + c0 + fr);
        const size_t ostep = vw ? 0 : (size_t)64 * 512, oq = vw ? 1 : 512;
        bf16x8_t s0a1[4], s0a2[2], s0a3[2], s1a1[4], s1a2[2], s1a3[2], s2a1[4], s2a2[2], s2a3[2]; f32x4_t s0u, s1u, s2u; float s0g, s1g, s2g;
#define DNB_LOAD(P_, n_) do { const size_t c_ = (size_t)((n_) < NC ? (n_) : NC - 1); \
            _Pragma("unroll") for (int ks = 0; ks < 4; ++ks) P_##a1[ks] = *(const bf16x8_t*)(p1 + c_ * 8192 + ks * 512); \
            _Pragma("unroll") for (int ks = 0; ks < 2; ++ks) { P_##a2[ks] = *(const bf16x8_t*)(p2 + c_ * 4096 + ks * 512); P_##a3[ks] = *(const bf16x8_t*)(p3 + c_ * 8192 + ks * 512); } \
            P_##u = *(const f32x4_t*)(pu + c_ * 8192); P_##g = pg[c_]; } while (0)
#define DNB_BAR() do { asm volatile("s_waitcnt lgkmcnt(0)" ::: "memory"); __builtin_amdgcn_s_barrier(); asm volatile("" ::: "memory"); } while (0)
#define DNB_STEP(C_, L_, n_) do { f32x4_t acc = C_##u * uf; const float gl = C_##g; bf16x8_t x1[4], x2[2], x3[2]; \
            _Pragma("unroll") for (int ks = 0; ks < 4; ++ks) x1[ks] = C_##a1[ks]; \
            _Pragma("unroll") for (int ks = 0; ks < 2; ++ks) { x2[ks] = C_##a2[ks]; x3[ks] = C_##a3[ks]; } \
            DNB_LOAD(L_, (n_) + 2); \
            bf16x8_t bS[4]; \
            _Pragma("unroll") for (int ks = 0; ks < 4; ++ks) bS[ks] = *(const LAS bf16x8_t*)(ST + fr * STS + ks * 32 + fq * 8); \
            _Pragma("unroll") for (int ks = 0; ks < 4; ++ks) acc = __builtin_amdgcn_mfma_f32_16x16x32_bf16(x1[ks], bS[ks], acc, 0, 0, 0); \
            { u32x2_t w; w.x = pk_bf16(acc[0], acc[1]); w.y = pk_bf16(acc[2], acc[3]); *(LAS u32x2_t*)vtw = w; } \
            DNB_BAR(); \
            bf16x8_t bV[2]; \
            _Pragma("unroll") for (int ks = 0; ks < 2; ++ks) bV[ks] = *(const LAS bf16x8_t*)(VT + fr * VTS + ks * 32 + fq * 8); \
            _Pragma("unroll") for (int ks = 0; ks < 2; ++ks) acc = __builtin_amdgcn_mfma_f32_16x16x32_bf16(x2[ks], bV[ks], acc, 0, 0, 0); \
            { float* o_ = op + (size_t)(n_) * ostep; _Pragma("unroll") for (int q = 0; q < 4; ++q) o_[(size_t)q * oq] = acc[q]; } \
            accS = accS * gl; \
            _Pragma("unroll") for (int ks = 0; ks < 2; ++ks) accS = __builtin_amdgcn_mfma_f32_16x16x32_bf16(x3[ks], bV[ks], accS, 0, 0, 0); \
            { u32x2_t w; w.x = pk_bf16(accS[0], accS[1]); w.y = pk_bf16(accS[2], accS[3]); *(LAS u32x2_t*)(ST + fr * STS + wid * 16 + 4 * fq) = w; } \
            DNB_BAR(); } while (0)
        static_assert(NC % 3 == 2, "the chunk loop is peeled for NC = 3 k + 2");
        DNB_LOAD(s0, 0); DNB_LOAD(s1, 1);
        int n = 0;
        for (; n + 2 < NC; n += 3) { DNB_STEP(s0, s2, n); DNB_STEP(s1, s0, n + 1); DNB_STEP(s2, s1, n + 2); }
        DNB_STEP(s0, s2, n); DNB_STEP(s1, s0, n + 1);
#undef DNB_STEP
#undef DNB_LOAD
        float* sp = a.out + O_SP + ((((size_t)r * NB + b) * DNH + hd) * 128 + wid * 16 + 4 * fq) * 128 + c0 + fr;
#pragma unroll
        for (int q = 0; q < 4; ++q) sp[(size_t)q * 128] = accS[q];
        __syncthreads();
    }
}


template <int NREG> __device__ __forceinline__ void select_row(const float* __restrict__ row, int n, int K, int* __restrict__ out, unsigned lane, LAS unsigned* cand_lds) {
    static_assert(NREG * 64 <= SLD, "row buffer too short");
    lane &= 63u;
    unsigned key[NREG];
#pragma unroll
    for (int i = 0; i < NREG; ++i) { const float f = __builtin_nontemporal_load(row + i * 64u + lane); key[i] = fkey(f) & (0u - ((unsigned)((int)(i * 64u + lane) - n) >> 31)); }
    if (NREG >= 32 && n >= 1024) { unsigned ls = 0u;
        for (int bit = 31; bit >= 0; --bit) { const unsigned cand = ls | (1u << bit); int c = 0;
#pragma unroll
            for (int i = 0; i < NREG; i += 8) c += __builtin_popcountll(__ballot(key[i] >= cand));
            if (c >= 48) ls = cand;
            if (c == 48) break; }
        int c0 = 0;
#pragma unroll
        for (int i = 0; i < NREG; ++i) c0 += __builtin_popcountll(__ballot(key[i] >= ls));
        if (c0 >= K && c0 <= 512) {
            asm volatile("" : "+v"(lane)); lane &= 63u; const unsigned long long bl = (1ull << lane) - 1ull; int base = 0;
            unsigned ls2 = ls; asm volatile("" : "+v"(ls2));
#pragma unroll
            for (int i = 0; i < NREG; ++i) { const bool g = key[i] >= ls2; const unsigned long long mg = __ballot(g);
                const int p = base + __builtin_popcountll(mg & bl); cand_lds[g ? (unsigned)p : 1024u + lane] = key[i]; cand_lds[g ? 512u + p : 1088u + lane] = i * 64u + lane;
                base += __builtin_popcountll(mg); }
            asm volatile("s_waitcnt lgkmcnt(0)" ::: "memory");
            unsigned ck[8], ci[8];
#pragma unroll
            for (int q = 0; q < 8; ++q) { const int p = q * 64 + (int)lane; const bool v = p < c0; ck[q] = v ? cand_lds[p] : 0u; ci[q] = v ? cand_lds[512 + p] : 0u; }
            unsigned lo2 = 0u;
            for (int bit = 31; bit >= 0; --bit) { const unsigned cand = lo2 | (1u << bit); int c = 0;
#pragma unroll
                for (int q = 0; q < 8; ++q) c += __builtin_popcountll(__ballot(ck[q] >= cand));
                if (c >= K) lo2 = cand;
                if (c == K) break; }
            int bg2 = 0;
#pragma unroll
            for (int q = 0; q < 8; ++q) { const bool g = ck[q] > lo2; const unsigned long long mg = __ballot(g);
                out[g ? (unsigned)(bg2 + __builtin_popcountll(mg & bl)) : KMAX + lane] = (int)ci[q]; bg2 += __builtin_popcountll(mg); }
            int be2 = 0;
#pragma unroll
            for (int q = 0; q < 8; ++q) { const bool e = ck[q] == lo2; const unsigned long long me = __ballot(e); const int slot = bg2 + be2 + __builtin_popcountll(me & bl);
                out[(e && slot < K) ? (unsigned)slot : KMAX + lane] = (int)ci[q]; be2 += __builtin_popcountll(me); }
            asm volatile("s_waitcnt lgkmcnt(0)" ::: "memory");
            return; } }
    unsigned lo = 0u;
    for (int bit = 31; bit >= 0; --bit) { const unsigned cand = lo | (1u << bit); int c = 0;
#pragma unroll
        for (int i = 0; i < NREG; ++i) c += __builtin_popcountll(__ballot(key[i] >= cand));
        if (c >= K) lo = cand;
        if (c == K) break; }
    asm volatile("" : "+v"(lane)); lane &= 63u;
    const unsigned long long below = (1ull << lane) - 1ull; int bg = 0;
#pragma unroll
    for (int i = 0; i < NREG; ++i) { const bool g = key[i] > lo; const unsigned long long mg = __ballot(g);
        out[g ? (unsigned)(bg + __builtin_popcountll(mg & below)) : KMAX + lane] = (int)(i * 64u + lane); bg += __builtin_popcountll(mg); }
    const int cg = bg; int be = 0; asm volatile("" : "+v"(lane)); lane &= 63u; const unsigned long long below2 = (1ull << lane) - 1ull;
#pragma unroll
    for (int i = 0; i < NREG; ++i) { const bool e = key[i] == lo; const unsigned long long me = __ballot(e); const int slot = cg + be + __builtin_popcountll(me & below2);
        out[(e && slot < K) ? (unsigned)slot : KMAX + lane] = (int)(i * 64u + lane); be += __builtin_popcountll(me); }
}
__device__ __forceinline__ void ph_select_w(const Args& a, LAS unsigned char* lds) {
    const float* SC = (const float*)(a.ws + WS_SCT); int* IDX = (int*)(a.ws + WS_IDX); int* NSEL = (int*)(a.ws + WS_NSEL);
    int tx_ = TID(); asm volatile("" : "+v"(tx_));
    const int lane0 = tx_ & 63, wv = __builtin_amdgcn_readfirstlane(blockIdx.x * (NTHREADS >> 6) + (tx_ >> 6)), nwv = gridDim.x * (NTHREADS >> 6);
    LAS unsigned* cand = (LAS unsigned*)(lds + (tx_ >> 6) * 4608);
    for (int m = MP + wv; m < MT; m += nwv) { const RowInfo ri = row_info(m); int lane = lane0; asm volatile("" : "+v"(lane));
        const int n = PAST + ri.t + 1, K = TOPK_S; const float* row = SC + (size_t)m * SLD; int* out = IDX + (size_t)m * KROW;
        if (n <= K) { for (int j = lane; j < n; j += 64) out[j] = j; if (lane == 0) NSEL[m] = n; continue; }
        select_row<(SLD / 64)>(row, n, K, out, lane, cand);
        if (lane == 0) NSEL[m] = K; }
}


__device__ __forceinline__ void ph_att_split_dev(const Args& a, int ai, size_t gtid, size_t gsz) {
    const float* P = (const float*)(a.ws + WS_P); bf16* QB = (bf16*)(a.ws + WS_XN); bf16* KB = (bf16*)(a.ws + WS_KB); bf16* VB = (bf16*)(a.ws + WS_VB); bf16* QIB = (bf16*)(a.ws + WS_QIB); bf16* KIB = (bf16*)(a.ws + WS_KIB);
    constexpr int W = AO_WI;
    for (size_t i = gtid; i < (size_t)MT * W; i += gsz) { const int m = (int)(i / W), c = (int)(i % W); const float v = P[(size_t)m * LDP + c];
        if (c < AO_K) QB[(size_t)m * D + c] = f2bf(v);
        else if (c < AO_V) { const int cc = c - AO_K; KB[(size_t)m * 256 + cc] = f2bf(v); if (m < MP) a.out[O_KP + ((size_t)ai * MP + m) * 256 + cc] = v; else a.out[O_KS + ((size_t)ai * MS + (m - MP)) * 256 + cc] = v; }
        else if (c < AO_QI) { const int cc = c - AO_V; VB[(size_t)m * 256 + cc] = f2bf(v); if (m < MP) a.out[O_VP + ((size_t)ai * MP + m) * 256 + cc] = v; else a.out[O_VS + ((size_t)ai * MS + (m - MP)) * 256 + cc] = v; }
        else if (c < AO_KI) QIB[(size_t)m * 512 + (c - AO_QI)] = f2bf(v);
        else { const int cc = c - AO_KI; KIB[(size_t)m * 64 + cc] = f2bf(v); if (m < MP) a.out[O_KIP + ((size_t)ai * MP + m) * 64 + cc] = v; else a.out[O_KIS + ((size_t)ai * MS + (m - MP)) * 64 + cc] = v; } }
}
__device__ __forceinline__ void ph_idx_mfma(const Args& a, LAS unsigned char* lds) {
    const float* P = (const float*)(a.ws + WS_P); const bf16* QIB = (const bf16*)(a.ws + WS_QIB); const bf16* KIB = (const bf16*)(a.ws + WS_KIB); float* SC = (float*)(a.ws + WS_SCT); int* IDX = (int*)(a.ws + WS_IDX); int* NSEL = (int*)(a.ws + WS_NSEL);
    int tx_ = TID(); asm volatile("" : "+v"(tx_));
    const int lane = tx_ & 63, fr = lane & 15, fq = lane >> 4, wv = __builtin_amdgcn_readfirstlane(blockIdx.x * (NTHREADS >> 6) + (tx_ >> 6)), nwv = gridDim.x * (NTHREADS >> 6);
    constexpr int NU = MP / 4;
    for (int pr2 = wv * 2; pr2 < NU; pr2 += nwv * 2) for (int u0 = pr2; u0 < pr2 + 2; ++u0) { const int hh = u0 >> 1, u = (u0 & 1) ? (NU - 1 - hh) : hh;
        const int m0 = u * 4, b = m0 / SEQ, t0 = m0 % SEQ;
        int lnu = lane; asm volatile("" : "+v"(lnu)); const int fr = lnu & 15, fq = (lnu >> 4) & 3;
        bf16x8_t aQ[2][2];
#pragma unroll
        for (int p = 0; p < 2; ++p)
#pragma unroll
            for (int ks = 0; ks < 2; ++ks) aQ[p][ks] = *(const bf16x8_t*)(QIB + (size_t)(m0 + (fr >> 2)) * 512 + (4 * p + (fr & 3)) * 64 + ks * 32 + fq * 8);
        const f32x4_t w0 = *(const f32x4_t*)(P + (size_t)(m0 + fq) * LDP + AO_WI), w1 = *(const f32x4_t*)(P + (size_t)(m0 + fq) * LDP + AO_WI + 4);
        float* scrow = SC + (size_t)(m0 + fq) * SLD + fr;
        const int nkt = (t0 + 3) / 16 + 1;
        bf16x8_t bKa[4][2], bKb[4][2];
#define IDX_LOAD(B_, kt0_) do { _Pragma("unroll") for (int q = 0; q < 4; ++q) { const int kt = (kt0_) + q < nkt ? (kt0_) + q : nkt - 1; const bf16* kr = KIB + ((size_t)b * (SEQ / 16) + kt) * 1024 + lnu * 8; \
            B_[q][0] = *(const bf16x8_t*)kr; B_[q][1] = *(const bf16x8_t*)(kr + 512); } } while (0)
#define IDX_COMP(B_, kt0_) do { _Pragma("unroll") for (int q = 0; q < 4; ++q) { if ((kt0_) + q < nkt) { f32x4_t c0 = {0.f, 0.f, 0.f, 0.f}, c1 = {0.f, 0.f, 0.f, 0.f}; \
                    c0 = __builtin_amdgcn_mfma_f32_16x16x32_bf16(aQ[0][0], B_[q][0], c0, 0, 0, 0); c0 = __builtin_amdgcn_mfma_f32_16x16x32_bf16(aQ[0][1], B_[q][1], c0, 0, 0, 0); \
                    c1 = __builtin_amdgcn_mfma_f32_16x16x32_bf16(aQ[1][0], B_[q][0], c1, 0, 0, 0); c1 = __builtin_amdgcn_mfma_f32_16x16x32_bf16(aQ[1][1], B_[q][1], c1, 0, 0, 0); \
                    __builtin_nontemporal_store((w0[0] * fmaxf(c0[0], 0.f) + w0[1] * fmaxf(c0[1], 0.f)) + (w0[2] * fmaxf(c0[2], 0.f) + w0[3] * fmaxf(c0[3], 0.f)) \
                                             + (w1[0] * fmaxf(c1[0], 0.f) + w1[1] * fmaxf(c1[1], 0.f)) + (w1[2] * fmaxf(c1[2], 0.f) + w1[3] * fmaxf(c1[3], 0.f)), scrow + ((kt0_) + q) * 16); } } } while (0)
        IDX_LOAD(bKa, 0);
        for (int kt0 = 0; kt0 < nkt; kt0 += 8) { IDX_LOAD(bKb, kt0 + 4); IDX_COMP(bKa, kt0); IDX_LOAD(bKa, kt0 + 8); IDX_COMP(bKb, kt0 + 4); }
#undef IDX_LOAD
#undef IDX_COMP
        LAS unsigned* cand = (LAS unsigned*)(lds + (tx_ >> 6) * 4608);
        for (int q = 0; q < 4; ++q) { const int m = m0 + q, n = t0 + q + 1, K = TOPK_P; int ln = lane; asm volatile("" : "+v"(ln));
            const float* row = SC + (size_t)m * SLD; int* out = IDX + (size_t)m * KROW;
            if (n <= K) { for (int j = ln; j < n; j += 64) out[j] = j; if (ln == 0) NSEL[m] = n; continue; }
            if (n <= 2048) select_row<32>(row, n, K, out, ln, cand);
            else if (n <= 4096) select_row<64>(row, n, K, out, ln, cand);
            else if (n <= 6144) select_row<96>(row, n, K, out, ln, cand);
            else select_row<128>(row, n, K, out, ln, cand);
            if (ln == 0) NSEL[m] = K; }
    }
}
__device__ __forceinline__ void ph_idx_sample_mfma(const Args& a, int ai) {
    const float* P = (const float*)(a.ws + WS_P); const bf16* QIB = (const bf16*)(a.ws + WS_QIB); float* SC = (float*)(a.ws + WS_SCT); const int* PT = (const int*)a.in[I_PT]; const float* CKI = a.in[I_CKI];
    int tx_ = TID(); asm volatile("" : "+v"(tx_));
    const int lane = tx_ & 63, fr = lane & 15, fq = lane >> 4, wv = __builtin_amdgcn_readfirstlane(blockIdx.x * (NTHREADS >> 6) + (tx_ >> 6)), nwv = gridDim.x * (NTHREADS >> 6);
    constexpr int NKT = (PAST + DT + 15) / 16, SPL = 64, TPU = (NKT + SPL - 1) / SPL;
    static_assert(PAGE % 16 == 0 && PAST % 16 == 0 && DT <= 16, "sample index tiles");
    for (int u = wv; u < DB * SPL; u += nwv) { const int db = u / SPL, k0 = (u % SPL) * TPU, k1 = (k0 + TPU < NKT) ? k0 + TPU : NKT; const int m0 = MP + db * DT;
        if (k0 >= k1) continue;
        bf16x8_t aQ[2][2];
#pragma unroll
        for (int p = 0; p < 2; ++p)
#pragma unroll
            for (int ks = 0; ks < 2; ++ks) aQ[p][ks] = *(const bf16x8_t*)(QIB + (size_t)(m0 + (fr >> 2)) * 512 + (4 * p + (fr & 3)) * 64 + ks * 32 + fq * 8);
        const f32x4_t w0 = *(const f32x4_t*)(P + (size_t)(m0 + fq) * LDP + AO_WI), w1 = *(const f32x4_t*)(P + (size_t)(m0 + fq) * LDP + AO_WI + 4);
        float* scrow = SC + (size_t)(m0 + fq) * SLD + fr;
        for (int kb = k0; kb < k1; kb += 3) { f32x4_t kf[3][4];
#pragma unroll
            for (int q = 0; q < 3; ++q) { const int kt = kb + q < k1 ? kb + q : k1 - 1, s0 = kt * 16; const float* kr;
                if (s0 < PAST) { const int pg = PT[db * NPAGES + s0 / PAGE]; kr = CKI + (((size_t)ai * NPOOL + pg) * PAGE + (s0 % PAGE) + fr) * IDIM + fq * 8; }
                else kr = P + (size_t)(m0 + (fr < DT ? fr : DT - 1)) * LDP + AO_KI + fq * 8;
                kf[q][0] = *(const f32x4_t*)kr; kf[q][1] = *(const f32x4_t*)(kr + 4); kf[q][2] = *(const f32x4_t*)(kr + 32); kf[q][3] = *(const f32x4_t*)(kr + 36); }
#pragma unroll
            for (int q = 0; q < 3; ++q) { if (kb + q < k1) { const int s0 = (kb + q) * 16; u32x4_t b0, b1;
                b0[0] = pk_bf16(kf[q][0][0], kf[q][0][1]); b0[1] = pk_bf16(kf[q][0][2], kf[q][0][3]); b0[2] = pk_bf16(kf[q][1][0], kf[q][1][1]); b0[3] = pk_bf16(kf[q][1][2], kf[q][1][3]);
                b1[0] = pk_bf16(kf[q][2][0], kf[q][2][1]); b1[1] = pk_bf16(kf[q][2][2], kf[q][2][3]); b1[2] = pk_bf16(kf[q][3][0], kf[q][3][1]); b1[3] = pk_bf16(kf[q][3][2], kf[q][3][3]);
                const bf16x8_t bK0 = __builtin_bit_cast(bf16x8_t, b0), bK1 = __builtin_bit_cast(bf16x8_t, b1);
                f32x4_t c0 = {0.f, 0.f, 0.f, 0.f}, c1 = {0.f, 0.f, 0.f, 0.f};
                c0 = __builtin_amdgcn_mfma_f32_16x16x32_bf16(aQ[0][0], bK0, c0, 0, 0, 0); c0 = __builtin_amdgcn_mfma_f32_16x16x32_bf16(aQ[0][1], bK1, c0, 0, 0, 0);
                c1 = __builtin_amdgcn_mfma_f32_16x16x32_bf16(aQ[1][0], bK0, c1, 0, 0, 0); c1 = __builtin_amdgcn_mfma_f32_16x16x32_bf16(aQ[1][1], bK1, c1, 0, 0, 0);
                scrow[s0] = (w0[0] * fmaxf(c0[0], 0.f) + w0[1] * fmaxf(c0[1], 0.f)) + (w0[2] * fmaxf(c0[2], 0.f) + w0[3] * fmaxf(c0[3], 0.f))
                          + (w1[0] * fmaxf(c1[0], 0.f) + w1[1] * fmaxf(c1[1], 0.f)) + (w1[2] * fmaxf(c1[2], 0.f) + w1[3] * fmaxf(c1[3], 0.f)); } } } }
}

__device__ __forceinline__ void ph_sparse_attn(const Args& a, LAS unsigned char* lds) {
    const bf16* QB = (const bf16*)(a.ws + WS_QB); const bf16* KB = (const bf16*)(a.ws + WS_KB); const bf16* VB = (const bf16*)(a.ws + WS_VB); const int* IDX = (const int*)(a.ws + WS_IDX); const int* NSEL = (const int*)(a.ws + WS_NSEL);
    bf16* O = (bf16*)(a.ws + WS_Y2);
    int tx_ = TID(); asm volatile("" : "+v"(tx_));
    const int lane = tx_ & 63, fr = lane & 15, fq = lane >> 4, wid = __builtin_amdgcn_readfirstlane(tx_ >> 6), wv = blockIdx.x * (NTHREADS >> 6) + wid, nwv = gridDim.x * (NTHREADS >> 6);
    LAS int* IDXS = (LAS int*)(lds + wid * 9216); LAS float* PS = (LAS float*)(lds + wid * 9216 + 1024);
    for (int m = wv; m < MP; m += nwv) { const int b = m / SEQ; const int ns = __builtin_amdgcn_readfirstlane(NSEL[m]);
#pragma unroll
        for (int c = 0; c < 4; ++c) { const int j = lane + 64 * c; IDXS[j] = j < ns ? IDX[(size_t)m * KROW + j] : 0; }
        bf16x8_t bQ[2][4];
#pragma unroll
        for (int kv = 0; kv < 2; ++kv)
#pragma unroll
            for (int ks = 0; ks < 4; ++ks) { bQ[kv][ks] = (bf16x8_t){0, 0, 0, 0, 0, 0, 0, 0}; if (fr < 4) bQ[kv][ks] = *(const bf16x8_t*)(QB + (size_t)m * D + (kv * 4 + fr) * 128 + ks * 32 + fq * 8); }
        asm volatile("s_waitcnt lgkmcnt(0)" ::: "memory");
#pragma unroll
        for (int tb = 0; tb < 16; tb += 2) { bf16x8_t ak[2][2][4];
#pragma unroll
            for (int t = 0; t < 2; ++t) { const int ri = IDXS[(tb + t) * 16 + fr]; const bf16* kb = KB + (size_t)(b * SEQ + ri) * 256 + fq * 8;
#pragma unroll
                for (int kv = 0; kv < 2; ++kv)
#pragma unroll
                    for (int ks = 0; ks < 4; ++ks) ak[t][kv][ks] = *(const bf16x8_t*)(kb + kv * 128 + ks * 32); }
#pragma unroll
            for (int t = 0; t < 2; ++t)
#pragma unroll
                for (int kv = 0; kv < 2; ++kv) { f32x4_t acc = {0.f, 0.f, 0.f, 0.f};
#pragma unroll
                    for (int ks = 0; ks < 4; ++ks) acc = __builtin_amdgcn_mfma_f32_16x16x32_bf16(ak[t][kv][ks], bQ[kv][ks], acc, 0, 0, 0);
                    if (fr < 4) {
#pragma unroll
                        for (int q = 0; q < 4; ++q) { const int j = (tb + t) * 16 + 4 * fq + q; PS[j * 8 + kv * 4 + fr] = j < ns ? acc[q] * 0.08838834764831845f : -1e30f; } } } }
        asm volatile("s_waitcnt lgkmcnt(0)" ::: "memory");
        { f32x4_t sv[4][2]; float mx[8];
#pragma unroll
            for (int h = 0; h < 8; ++h) mx[h] = -3e38f;
#pragma unroll
            for (int c = 0; c < 4; ++c) { sv[c][0] = *(const LAS f32x4_t*)(PS + (lane + 64 * c) * 8); sv[c][1] = *(const LAS f32x4_t*)(PS + (lane + 64 * c) * 8 + 4);
#pragma unroll
                for (int h = 0; h < 8; ++h) mx[h] = fmaxf(mx[h], sv[c][h >> 2][h & 3]); }
#pragma unroll
            for (int o = 32; o >= 1; o >>= 1)
#pragma unroll
                for (int h = 0; h < 8; ++h) mx[h] = fmaxf(mx[h], shfl_xor_l(mx[h], o, lane));
            float sum[8];
#pragma unroll
            for (int h = 0; h < 8; ++h) sum[h] = 0.f;
#pragma unroll
            for (int c = 0; c < 4; ++c)
#pragma unroll
                for (int h = 0; h < 8; ++h) { const float e = FEXP(sv[c][h >> 2][h & 3] - mx[h]); sv[c][h >> 2][h & 3] = e; sum[h] += e; }
#pragma unroll
            for (int o = 32; o >= 1; o >>= 1)
#pragma unroll
                for (int h = 0; h < 8; ++h) sum[h] += shfl_xor_l(sum[h], o, lane);
#pragma unroll
            for (int h = 0; h < 8; ++h) sum[h] = FRCP(sum[h]);
#pragma unroll
            for (int c = 0; c < 4; ++c) { f32x4_t p0, p1;
#pragma unroll
                for (int h = 0; h < 4; ++h) { p0[h] = sv[c][0][h] * sum[h]; p1[h] = sv[c][1][h] * sum[4 + h]; }
                *(LAS f32x4_t*)(PS + (lane + 64 * c) * 8) = p0; *(LAS f32x4_t*)(PS + (lane + 64 * c) * 8 + 4) = p1; } }
        asm volatile("s_waitcnt lgkmcnt(0)" ::: "memory");
        f32x4_t o4[4] = {{0.f, 0.f, 0.f, 0.f}, {0.f, 0.f, 0.f, 0.f}, {0.f, 0.f, 0.f, 0.f}, {0.f, 0.f, 0.f, 0.f}};
        const int kvl = lane >> 5; const char* vb8 = (const char*)(VB + (size_t)b * SEQ * 256);
        const unsigned loff = (unsigned)(kvl * 128 + (lane & 31) * 4) * 2u;
        for (int j0 = 0; j0 < ns; j0 += 32) { u32x2_t vv[32];
#pragma unroll
            for (int jj = 0; jj < 32; ++jj) { const unsigned off = (unsigned)IDXS[j0 + jj] * 512u + loff; vv[jj] = *(const u32x2_t*)(vb8 + off); }
#pragma unroll
            for (int jj = 0; jj < 32; ++jj) { const f32x4_t p4 = *(const LAS f32x4_t*)(PS + (j0 + jj) * 8 + kvl * 4);
                const f32x4_t vf = {__builtin_bit_cast(float, vv[jj][0] << 16), __builtin_bit_cast(float, vv[jj][0] & 0xffff0000u), __builtin_bit_cast(float, vv[jj][1] << 16), __builtin_bit_cast(float, vv[jj][1] & 0xffff0000u)};
#pragma unroll
                for (int h = 0; h < 4; ++h) o4[h] += vf * p4[h]; } }
#pragma unroll
        for (int h = 0; h < 4; ++h) { u32x2_t w; w[0] = pk_bf16(o4[h][0], o4[h][1]); w[1] = pk_bf16(o4[h][2], o4[h][3]); *(u32x2_t*)(O + (size_t)m * D + (kvl * 4 + h) * 128 + (lane & 31) * 4) = w; }
        asm volatile("s_waitcnt lgkmcnt(0)" ::: "memory");
    }
}

__device__ __forceinline__ void ph_sparse_sample(const Args& a, int ai, LAS unsigned char* lds) {
    const float* P = (const float*)(a.ws + WS_P); const int* IDX = (const int*)(a.ws + WS_IDX); const int* NSEL = (const int*)(a.ws + WS_NSEL); bf16* O = (bf16*)(a.ws + WS_Y2);
    int tx_ = TID(); asm volatile("" : "+v"(tx_));
    const int lane = tx_ & 63, wid = __builtin_amdgcn_readfirstlane(tx_ >> 6), wv = blockIdx.x * (NTHREADS >> 6) + wid, nwv = gridDim.x * (NTHREADS >> 6);
    LAS float* QS = (LAS float*)(lds + wid * 9216); LAS float* PSs = (LAS float*)(lds + wid * 9216 + 512); LAS unsigned long long* VP = (LAS unsigned long long*)(lds + wid * 9216 + 1536);
    for (int u = wv; u < MS * AH; u += nwv) { const int m = MP + u / AH, h = u % AH, kvh = h / GROUP; const RowInfo ri = row_info(m); const int ns = __builtin_amdgcn_readfirstlane(NSEL[m]);
        { const f32x2_t q2 = *(const f32x2_t*)(P + (size_t)m * LDP + h * HDIM + 2 * lane); QS[2 * lane] = q2[0]; QS[2 * lane + 1] = q2[1]; }
        const float* kp[4];
#pragma unroll
        for (int c = 0; c < 4; ++c) { const int j = lane + 64 * c; const int idx = j < ns ? IDX[(size_t)m * KROW + j] : 0; kp[c] = kv_row(a, ai, ri, idx, kvh, false); VP[j] = (unsigned long long)(size_t)kv_row(a, ai, ri, idx, kvh, true); }
        asm volatile("s_waitcnt lgkmcnt(0)" ::: "memory");
        float sc[4] = {0.f, 0.f, 0.f, 0.f};
        for (int d0 = 0; d0 < HDIM; d0 += 16) { f32x4_t kq[4][4];
#pragma unroll
            for (int e = 0; e < 4; ++e)
#pragma unroll
                for (int c = 0; c < 4; ++c) kq[e][c] = *(const f32x4_t*)(kp[c] + d0 + 4 * e);
#pragma unroll
            for (int e = 0; e < 4; ++e) { const f32x4_t q4 = *(const LAS f32x4_t*)(QS + d0 + 4 * e);
#pragma unroll
                for (int c = 0; c < 4; ++c) sc[c] += (kq[e][c][0] * q4[0] + kq[e][c][1] * q4[1]) + (kq[e][c][2] * q4[2] + kq[e][c][3] * q4[3]); } }
        float mx = -3e38f;
#pragma unroll
        for (int c = 0; c < 4; ++c) { sc[c] = (lane + 64 * c) < ns ? sc[c] * 0.08838834764831845f : -1e30f; mx = fmaxf(mx, sc[c]); }
#pragma unroll
        for (int o = 32; o >= 1; o >>= 1) mx = fmaxf(mx, shfl_xor_l(mx, o, lane));
        float sum = 0.f;
#pragma unroll
        for (int c = 0; c < 4; ++c) { sc[c] = FEXP(sc[c] - mx); sum += sc[c]; }
#pragma unroll
        for (int o = 32; o >= 1; o >>= 1) sum += shfl_xor_l(sum, o, lane);
        const float inv = FRCP(sum);
#pragma unroll
        for (int c = 0; c < 4; ++c) PSs[lane + 64 * c] = sc[c] * inv;
        asm volatile("s_waitcnt lgkmcnt(0)" ::: "memory");
        f32x2_t o2 = {0.f, 0.f};
        for (int j0 = 0; j0 < ns; j0 += 16) { f32x2_t vv[16];
#pragma unroll
            for (int jj = 0; jj < 16; ++jj) { const float* vp = (const float*)(size_t)VP[j0 + jj]; vv[jj] = *(const f32x2_t*)(vp + 2 * lane); }
#pragma unroll
            for (int jj = 0; jj < 16; ++jj) o2 += vv[jj] * PSs[j0 + jj]; }
        *(unsigned*)(O + (size_t)m * D + h * HDIM + 2 * lane) = pk_bf16(o2[0], o2[1]);
        asm volatile("s_waitcnt lgkmcnt(0)" ::: "memory");
    }
}

__device__ __forceinline__ void ph_rg_chunk(const Args& a, int r, LAS unsigned char* lds) {
    const float* P = (const float*)(a.ws + WS_P); float* HH = (float*)(a.ws + WS_HH); float* AP = (float*)(a.ws + WS_XR);
    const float* wc = a.in[I_WCONV] + (size_t)r * 4 * CONV_CH; const float* wa = a.in[I_WA] + (size_t)r * RG_HEADS * RG_BW * RG_BW; const float* wx = a.in[I_WX] + (size_t)r * RG_HEADS * RG_BW * RG_BW;
    static_assert(RG_BW == 64 && RG_HEADS == 8, "ph_rg_chunk is written for 8 gate heads of 64 channels");
    int tx_ = TID(); asm volatile("" : "+v"(tx_));
    const int lane = tx_ & 63, wid = __builtin_amdgcn_readfirstlane(tx_ >> 6), wv = blockIdx.x * (NTHREADS >> 6) + wid, nwv = gridDim.x * (NTHREADS >> 6);
    LAS float* XS = (LAS float*)(lds + wid * 16384);
    constexpr int NUP = NB * NC * 8, NU = NUP + DB * 8;
    for (int u = wv; u < NU; u += nwv) { const bool prompt = u < NUP; int hd, row0, T, n = 0, b = 0, db = 0;
        if (prompt) { const int c = u >> 3; hd = u & 7; row0 = c * 64; T = 64; n = c % NC; b = c / NC; } else { const int q = u - NUP; db = q >> 3; hd = q & 7; row0 = MP + db * DT; T = DT; }
        const int ch = hd * 64 + lane;
        const float w0 = wc[ch], w1 = wc[CONV_CH + ch], w2 = wc[2 * CONV_CH + ch], w3 = wc[3 * CONV_CH + ch], bcv = a.in[I_BCONV][(size_t)r * D_RNN + ch];
        float x3 = 0.f, x2 = 0.f, x1 = 0.f;
        if (prompt) { if (n != 0) { x3 = P[(size_t)(row0 - 3) * LDP + ch]; x2 = P[(size_t)(row0 - 2) * LDP + ch]; x1 = P[(size_t)(row0 - 1) * LDP + ch]; } }
        else { const float* sc = a.in[I_SCONV] + ((size_t)r * DB + db) * 3 * CONV_CH + ch; x3 = sc[0]; x2 = sc[CONV_CH]; x1 = sc[2 * CONV_CH]; }
        for (int tb = 0; tb < T; tb += 16) { float ub[16];
#pragma unroll
            for (int q = 0; q < 16; ++q) ub[q] = P[(size_t)(row0 + (tb + q < T ? tb + q : T - 1)) * LDP + ch];
#pragma unroll
            for (int q = 0; q < 16; ++q) { const int t = tb + q; if (t < T) { const float ut = ub[q]; XS[t * 64 + lane] = w3 * ut + w2 * x1 + w1 * x2 + w0 * x3 + bcv; x3 = x2; x2 = x1; x1 = ut;
                if (prompt) { if (n == NC - 1 && t >= 61) a.out[O_CONVP + (((size_t)r * NB + b) * 3 + (t - 61)) * CONV_CH + ch] = ut; }
                else if (t >= DT - 3) a.out[O_CONVS + (((size_t)r * DB + db) * 3 + (t - (DT - 3))) * CONV_CH + ch] = ut; } } }
        asm volatile("s_waitcnt lgkmcnt(0)" ::: "memory");
        float war[64], wxr[64];
        unsigned ln = (unsigned)lane; asm volatile("" : "+v"(ln)); ln &= 63u;
        const float* wah = wa + (size_t)hd * 4096; const float* wxh = wx + (size_t)hd * 4096;
#pragma unroll
        for (int k = 0; k < 64; ++k) { war[k] = wah[k * 64u + ln]; wxr[k] = wxh[k * 64u + ln]; }
        const float ba = a.in[I_BA][(size_t)r * D_RNN + ch], bx = a.in[I_BX][(size_t)r * D_RNN + ch], sp = softplusf_(-a.in[I_LAM][(size_t)r * D_RNN + ch]);
        float h = 0.f, ap = 1.f;
        for (int t = 0; t < T; ++t) { float pr = 0.f, pi = 0.f;
#pragma unroll
            for (int k = 0; k < 64; k += 4) { const f32x4_t x4 = *(const LAS f32x4_t*)(XS + t * 64 + k);
#pragma unroll
                for (int e = 0; e < 4; ++e) { pr += x4[e] * war[k + e]; pi += x4[e] * wxr[k + e]; } }
            const float rg = sigmoidf_(pr + ba), ig = sigmoidf_(pi + bx), log_a = -8.0f * rg * sp, av = __expf(log_a);
            const bool first = prompt && n == 0 && t == 0; const float mult = first ? 1.0f : FSQRT(fmaxf(1.0f - __expf(2.0f * log_a), 0.0f));
            float bv = XS[t * 64 + lane] * ig * mult; if (!prompt && t == 0) bv += av * a.in[I_SH][((size_t)r * DB + db) * D_RNN + ch];
            h = av * h + bv; ap *= av; const size_t o = (size_t)(row0 + t) * D_RNN + ch; HH[o] = h; AP[o] = ap; }
        if (!prompt) a.out[O_HS + ((size_t)r * DB + db) * D_RNN + ch] = h;
        asm volatile("s_waitcnt lgkmcnt(0)" ::: "memory");
    }
}
__device__ __forceinline__ void ph_dn_tok(const Args& a, int r) {
    const float* P = (const float*)(a.ws + WS_P); float* QKV = (float*)(a.ws + WS_QKV); float* QN = (float*)(a.ws + WS_QN); float* KN = (float*)(a.ws + WS_KN); float* GB = (float*)(a.ws + WS_GB); float* KNT = (float*)(a.ws + WS_KNT);
    const float* wc = a.in[I_WCONV] + (size_t)r * 4 * CONV_CH;
    int tx_ = TID(); asm volatile("" : "+v"(tx_));
    const int lane = tx_ & 63, wv = __builtin_amdgcn_readfirstlane(blockIdx.x * (NTHREADS >> 6) + (tx_ >> 6)), nwv = gridDim.x * (NTHREADS >> 6);
    constexpr int NUP = (MP / 16) * DNH, NU = NUP + DB * DNH;
    static_assert(DT == 4 && SEQ % 64 == 0, "ph_dn_tok run lengths");
    for (int u = wv; u < NU; u += nwv) { const bool prompt = u < NUP; const int hd = prompt ? (u & 3) : ((u - NUP) & 3), m0 = prompt ? (u >> 2) * 16 : MP + ((u - NUP) >> 2) * DT, T = prompt ? 16 : DT;
        const int seq = prompt ? m0 / SEQ : 0, t0 = prompt ? m0 % SEQ : 0, db = prompt ? 0 : (m0 - MP) / DT;
        f32x2_t wk[3][4], h3[3], h2[3], h1[3];
#pragma unroll
        for (int p = 0; p < 3; ++p) { const int c = D_RNN + p * 512 + hd * 128 + 2 * lane;
#pragma unroll
            for (int k = 0; k < 4; ++k) wk[p][k] = *(const f32x2_t*)(wc + (size_t)k * CONV_CH + c);
            h3[p] = h2[p] = h1[p] = (f32x2_t){0.f, 0.f};
            if (prompt) { if (t0 != 0) { h3[p] = *(const f32x2_t*)(P + (size_t)(m0 - 3) * LDP + c); h2[p] = *(const f32x2_t*)(P + (size_t)(m0 - 2) * LDP + c); h1[p] = *(const f32x2_t*)(P + (size_t)(m0 - 1) * LDP + c); } }
            else { const float* sc = a.in[I_SCONV] + ((size_t)r * DB + db) * 3 * CONV_CH + c; h3[p] = *(const f32x2_t*)sc; h2[p] = *(const f32x2_t*)(sc + CONV_CH); h1[p] = *(const f32x2_t*)(sc + 2 * CONV_CH); } }
        float gcum = 0.f;
        if (prompt) { const int tl0 = t0 & 63; float gt = lane < tl0 ? dn_g(a, r, (size_t)(m0 - tl0 + lane), hd) : 0.f;
#pragma unroll
            for (int o2 = 32; o2 >= 1; o2 >>= 1) gt += shfl_xor_l(gt, o2, lane);
            gcum = gt; }
        for (int tb = 0; tb < T; tb += 8) { f32x2_t xin[8][3];
#pragma unroll
            for (int q = 0; q < 8; ++q)
#pragma unroll
                for (int p = 0; p < 3; ++p) xin[q][p] = *(const f32x2_t*)(P + (size_t)(m0 + (tb + q < T ? tb + q : T - 1)) * LDP + D_RNN + p * 512 + hd * 128 + 2 * lane);
#pragma unroll
            for (int q = 0; q < 8; ++q) { const int t = tb + q; if (t < T) { const int m = m0 + t; f32x2_t x[3];
#pragma unroll
                for (int p = 0; p < 3; ++p) { const int c = D_RNN + p * 512 + hd * 128 + 2 * lane; const f32x2_t xv = xin[q][p];
                    const f32x2_t acc = wk[p][0] * h3[p] + wk[p][1] * h2[p] + wk[p][2] * h1[p] + wk[p][3] * xv; h3[p] = h2[p]; h2[p] = h1[p]; h1[p] = xv;
                    x[p][0] = siluf_(acc[0]); x[p][1] = siluf_(acc[1]);
                    if (prompt) { if (t0 + t >= SEQ - 3) *(f32x2_t*)(a.out + O_CONVP + (((size_t)r * NB + seq) * 3 + (t0 + t - (SEQ - 3))) * CONV_CH + c) = xv; }
                    else if (t >= DT - 3) *(f32x2_t*)(a.out + O_CONVS + (((size_t)r * DB + db) * 3 + (t - (DT - 3))) * CONV_CH + c) = xv; }
                float sq = x[0][0] * x[0][0] + x[0][1] * x[0][1], sk = x[1][0] * x[1][0] + x[1][1] * x[1][1];
#pragma unroll
                for (int o = 32; o >= 1; o >>= 1) { sq += shfl_xor_l(sq, o, lane); sk += shfl_xor_l(sk, o, lane); }
                const float rq = FRSQ(sq + EPS) * 0.08838834764831845f, rk = FRSQ(sk + EPS);
                const f32x2_t qn = x[0] * rq, kn = x[1] * rk; const size_t o = (size_t)m * 512 + hd * 128 + 2 * lane;
                *(f32x2_t*)(QN + o) = qn; *(f32x2_t*)(KN + o) = kn; *(f32x2_t*)(QKV + (size_t)m * 1536 + 1024 + hd * 128 + 2 * lane) = x[2];
                const float g = dn_g(a, r, (size_t)m, hd); float gc = g;
                if (prompt) { const int tt = t0 + t, tl = tt & 63; if (tl == 0) gcum = 0.f; gcum += g; gc = gcum;
                    (void)tl; }
                if (lane == 0) { GB[(size_t)m * 16 + hd * 4] = g; GB[(size_t)m * 16 + hd * 4 + 1] = sigmoidf_(P[(size_t)m * LDP + OFF_B + hd]); GB[(size_t)m * 16 + hd * 4 + 2] = gc; } } } } }
}
__device__ __forceinline__ void ph_rec_out_w(const Args& a, int r) {
    static_assert(D_RNN == 512 && Y2W == 1024, "ph_rec_out_w is written for D_RNN 512");
    const float* P = (const float*)(a.ws + WS_P); const float* HH = (const float*)(a.ws + WS_HH); const float* AP = (const float*)(a.ws + WS_XR); const float* CARRY = (const float*)(a.ws + WS_CARRY);
    const float* ODN = (const float*)(a.ws + WS_ODN); bf16* Y2 = (bf16*)(a.ws + WS_Y2); const float* dnw = a.in[I_DNW] + r * 128;
    int tx_ = TID(); asm volatile("" : "+v"(tx_));
    const int lane = tx_ & 63, wv = __builtin_amdgcn_readfirstlane(blockIdx.x * (NTHREADS >> 6) + (tx_ >> 6)), nwv = gridDim.x * (NTHREADS >> 6);
    const f32x2_t dw = *(const f32x2_t*)(dnw + 2 * lane);
    for (int m = wv; m < MT; m += nwv) {
        { const size_t o = (size_t)m * D_RNN + 8 * lane; f32x4_t h0 = *(const f32x4_t*)(HH + o), h1 = *(const f32x4_t*)(HH + o + 4);
            if (m < MP) { const float* cr = CARRY + (size_t)(m / 64) * D_RNN + 8 * lane; h0 += *(const f32x4_t*)(AP + o) * *(const f32x4_t*)cr; h1 += *(const f32x4_t*)(AP + o + 4) * *(const f32x4_t*)(cr + 4); }
            const float* gp = P + (size_t)m * LDP + OFF_GATE + 8 * lane; const f32x4_t g0 = *(const f32x4_t*)gp, g1 = *(const f32x4_t*)(gp + 4);
            u32x4_t w; w[0] = pk_bf16(h0[0] * gelu_tanhf_(g0[0]), h0[1] * gelu_tanhf_(g0[1])); w[1] = pk_bf16(h0[2] * gelu_tanhf_(g0[2]), h0[3] * gelu_tanhf_(g0[3]));
            w[2] = pk_bf16(h1[0] * gelu_tanhf_(g1[0]), h1[1] * gelu_tanhf_(g1[1])); w[3] = pk_bf16(h1[2] * gelu_tanhf_(g1[2]), h1[3] * gelu_tanhf_(g1[3]));
            *(u32x4_t*)(Y2 + (size_t)m * Y2W + 8 * lane) = w; }
        f32x2_t ov[4]; float ss[4];
#pragma unroll
        for (int hd = 0; hd < 4; ++hd) { ov[hd] = *(const f32x2_t*)(ODN + (size_t)m * 512 + hd * 128 + 2 * lane); ss[hd] = ov[hd][0] * ov[hd][0] + ov[hd][1] * ov[hd][1]; }
#pragma unroll
        for (int o = 32; o >= 1; o >>= 1)
#pragma unroll
            for (int hd = 0; hd < 4; ++hd) ss[hd] += shfl_xor_l(ss[hd], o, lane);
#pragma unroll
        for (int hd = 0; hd < 4; ++hd) { const float rs = FRSQ(ss[hd] * (1.0f / 128.0f) + EPS); const f32x2_t z = *(const f32x2_t*)(P + (size_t)m * LDP + OFF_Z + hd * 128 + 2 * lane);
            *(unsigned*)(Y2 + (size_t)m * Y2W + D_RNN + hd * 128 + 2 * lane) = pk_bf16(ov[hd][0] * rs * dw[0] * siluf_(z[0]), ov[hd][1] * rs * dw[1] * siluf_(z[1])); } }
}


__device__ __forceinline__ void ph_dn_chunk(const Args& a, LAS unsigned char* lds) {
    const float* QKV = (const float*)(a.ws + WS_QKV); const float* QN = (const float*)(a.ws + WS_QN); const float* KN = (const float*)(a.ws + WS_KN); const float* GB = (const float*)(a.ws + WS_GB); const float* KNT = (const float*)(a.ws + WS_KNT);
    bf16* AT = (bf16*)(a.ws + WS_AT); float* UT = (float*)(a.ws + WS_UT); bf16* WN = (bf16*)(a.ws + WS_WN); bf16* QG = (bf16*)(a.ws + WS_QG); bf16* KDT = (bf16*)(a.ws + WS_KDT); float* GL = (float*)(a.ws + WS_GL);
    int tx_ = TID(); asm volatile("" : "+v"(tx_));
    const int tid = tx_, lane = tid & 63, fr = lane & 15, fq = lane >> 4, wid = __builtin_amdgcn_readfirstlane(tid >> 6);
    constexpr int RS = 136;
    LAS bf16* Kb = (LAS bf16*)lds; LAS bf16* Qb = (LAS bf16*)(lds + 17408); LAS float* Lf = (LAS float*)(lds + 34816); LAS float* gcs = (LAS float*)(lds + 51200); LAS float* bts = (LAS float*)(lds + 51456);
    for (int cu = blockIdx.x; cu < NCU; cu += gridDim.x) { const int n = cu % NC, hd = (cu / NC) % DNH, b = cu / (NC * DNH); const size_t m0 = (size_t)b * SEQ + n * 64;
        { const int i = tid >> 3, sg = tid & 7; const float* qp = QN + (m0 + i) * 512 + hd * 128 + sg * 16; const float* kp = KN + (m0 + i) * 512 + hd * 128 + sg * 16;
            f32x4_t qv[4], kv[4];
#pragma unroll
            for (int e = 0; e < 4; ++e) { qv[e] = *(const f32x4_t*)(qp + 4 * e); kv[e] = *(const f32x4_t*)(kp + 4 * e); }
            u32x4_t w0, w1;
#pragma unroll
            for (int e = 0; e < 2; ++e) { w0[2 * e] = pk_bf16(qv[e][0], qv[e][1]); w0[2 * e + 1] = pk_bf16(qv[e][2], qv[e][3]); w1[2 * e] = pk_bf16(qv[e + 2][0], qv[e + 2][1]); w1[2 * e + 1] = pk_bf16(qv[e + 2][2], qv[e + 2][3]); }
            *(LAS u32x4_t*)(Qb + i * RS + sg * 16) = w0; *(LAS u32x4_t*)(Qb + i * RS + sg * 16 + 8) = w1;
#pragma unroll
            for (int e = 0; e < 2; ++e) { w0[2 * e] = pk_bf16(kv[e][0], kv[e][1]); w0[2 * e + 1] = pk_bf16(kv[e][2], kv[e][3]); w1[2 * e] = pk_bf16(kv[e + 2][0], kv[e + 2][1]); w1[2 * e + 1] = pk_bf16(kv[e + 2][2], kv[e + 2][3]); }
            *(LAS u32x4_t*)(Kb + i * RS + sg * 16) = w0; *(LAS u32x4_t*)(Kb + i * RS + sg * 16 + 8) = w1;
            if (tid < 64) { gcs[tid] = GB[(m0 + tid) * 16 + hd * 4 + 2]; bts[tid] = GB[(m0 + tid) * 16 + hd * 4 + 1]; } }
        __syncthreads();
        { const int ti = wid >> 1;
#pragma unroll
            for (int tq = 0; tq < 2; ++tq) { const int tj = 2 * (wid & 1) + tq; f32x4_t ck = {0.f, 0.f, 0.f, 0.f}, cq = {0.f, 0.f, 0.f, 0.f};
                if (tj <= ti) {
#pragma unroll
                    for (int ks = 0; ks < 4; ++ks) { const bf16x8_t bK = *(const LAS bf16x8_t*)(Kb + (tj * 16 + fr) * RS + ks * 32 + fq * 8);
                        ck = __builtin_amdgcn_mfma_f32_16x16x32_bf16(*(const LAS bf16x8_t*)(Kb + (ti * 16 + fr) * RS + ks * 32 + fq * 8), bK, ck, 0, 0, 0);
                        cq = __builtin_amdgcn_mfma_f32_16x16x32_bf16(*(const LAS bf16x8_t*)(Qb + (ti * 16 + fr) * RS + ks * 32 + fq * 8), bK, cq, 0, 0, 0); } }
                const int j = tj * 16 + fr; const float gj = gcs[j];
#pragma unroll
                for (int q = 0; q < 4; ++q) { const int i = ti * 16 + 4 * fq + q; float lv = 0.f, av = 0.f;
                    if (i >= j) { const float dec = __expf(gcs[i] - gj); av = cq[q] * dec; if (i > j) lv = bts[i] * ck[q] * dec; }
                    Lf[i * 64 + j] = lv; AT[(size_t)cu * 4096 + FRAG_OFF(i, j, 2)] = f2bf(av); } } }
        __syncthreads();
        if (wid < 4) { const int col = tid; float X[64];
            if (col < 128) {
#pragma unroll
                for (int j = 0; j < 64; ++j) X[j] = QKV[(m0 + j) * 1536 + 1024 + hd * 128 + col] * bts[j]; }
            else {
#pragma unroll
                for (int j = 0; j < 64; ++j) X[j] = KN[(m0 + j) * 512 + hd * 128 + (col - 128)] * bts[j] * __expf(gcs[j]); }
#pragma unroll
            for (int i = 1; i < 64; ++i) { float acc = X[i];
#pragma unroll
                for (int jb = 0; jb < i; jb += 4) { const f32x4_t l4 = *(const LAS f32x4_t*)(Lf + i * 64 + jb);
                    acc -= l4[0] * X[jb]; acc -= l4[1] * X[jb + 1]; acc -= l4[2] * X[jb + 2]; acc -= l4[3] * X[jb + 3]; }
                X[i] = acc; }
            if (col < 128) { float* up = UT + (size_t)cu * 8192 + (size_t)((col >> 4) * 4) * 256 + (col & 15) * 4;
#pragma unroll
                for (int j = 0; j < 64; j += 4) *(f32x4_t*)(up + (j >> 4) * 256 + ((j >> 2) & 3) * 64) = (f32x4_t){X[j], X[j + 1], X[j + 2], X[j + 3]}; }
            else { bf16* wp = WN + (size_t)cu * 8192;
#pragma unroll
                for (int j = 0; j < 64; ++j) wp[FRAG_OFF(j, col - 128, 4)] = f2bf(-X[j]); } }
        else { const int t2 = tid - 256; const float gl63 = gcs[63];
            { const int i = t2 >> 2, sg = t2 & 3; const float eg = __expf(gcs[i]); const float* qp = QN + (m0 + i) * 512 + hd * 128 + sg * 32; bf16* op = QG + (size_t)cu * 8192;
#pragma unroll
                for (int e = 0; e < 8; ++e) { const f32x4_t v = *(const f32x4_t*)(qp + 4 * e); u32x2_t w; w[0] = pk_bf16(v[0] * eg, v[1] * eg); w[1] = pk_bf16(v[2] * eg, v[3] * eg); *(u32x2_t*)(op + FRAG_OFF(i, sg * 32 + 4 * e, 4)) = w; } }
            { const int dd = t2 >> 1, hf = t2 & 1; bf16* op = KDT + (size_t)cu * 8192;
#pragma unroll
                for (int e = 0; e < 8; ++e) { const int i0 = hf * 32 + 4 * e; u32x2_t w;
                    const float k0 = bf2f(Kb[(i0) * RS + dd]), k1 = bf2f(Kb[(i0 + 1) * RS + dd]), k2 = bf2f(Kb[(i0 + 2) * RS + dd]), k3 = bf2f(Kb[(i0 + 3) * RS + dd]);
                    w[0] = pk_bf16(k0 * __expf(gl63 - gcs[i0]), k1 * __expf(gl63 - gcs[i0 + 1])); w[1] = pk_bf16(k2 * __expf(gl63 - gcs[i0 + 2]), k3 * __expf(gl63 - gcs[i0 + 3])); *(u32x2_t*)(op + FRAG_OFF(dd, i0, 2)) = w; } }
            if (t2 == 0) GL[cu] = __expf(gl63); }
        __syncthreads();
    }
}


template <int MODE, int UNR> __device__ __forceinline__ void small_gemm(const bf16* __restrict__ A, const bf16* __restrict__ Bt, int N, int K, void* C, int ldc) {
    static_assert(MS == 128, "small_gemm covers 128 sample rows");
    int tx_ = TID(); asm volatile("" : "+v"(tx_));
    const int lane = tx_ & 63, fr = lane & 15, fq = lane >> 4, wv = __builtin_amdgcn_readfirstlane(blockIdx.x * (NTHREADS >> 6) + (tx_ >> 6)), nwv = gridDim.x * (NTHREADS >> 6);
    const int ntile = (N / 16) * 4;
    for (int tile = wv; tile < ntile; tile += nwv) { const int n0 = (tile >> 2) * 16, tg = tile & 3;
        f32x4_t acc0 = {0.f, 0.f, 0.f, 0.f}, acc1 = {0.f, 0.f, 0.f, 0.f};
        const bf16* bp = Bt + (size_t)(n0 + fr) * K + fq * 8; const bf16* ap0 = A + (size_t)(MP + tg * 32 + fr) * K + fq * 8; const bf16* ap1 = ap0 + (size_t)16 * K;
        for (int k = 0; k < K; k += 32 * UNR) { bf16x8_t bb[UNR], a0[UNR], a1[UNR];
#pragma unroll
            for (int u = 0; u < UNR; ++u) { bb[u] = *(const bf16x8_t*)(bp + k + 32 * u); a0[u] = *(const bf16x8_t*)(ap0 + k + 32 * u); a1[u] = *(const bf16x8_t*)(ap1 + k + 32 * u); }
#pragma unroll
            for (int u = 0; u < UNR; ++u) { acc0 = __builtin_amdgcn_mfma_f32_16x16x32_bf16(bb[u], a0[u], acc0, 0, 0, 0); acc1 = __builtin_amdgcn_mfma_f32_16x16x32_bf16(bb[u], a1[u], acc1, 0, 0, 0); } }
#pragma unroll
        for (int tt = 0; tt < 2; ++tt) { const f32x4_t v = tt ? acc1 : acc0; const size_t o = (size_t)(MP + tg * 32 + tt * 16 + fr) * ldc + n0 + 4 * fq;
            if (MODE == 0) *(f32x4_t*)((float*)C + o) = v;
            else if (MODE == 1) { const float r0 = fmaxf(v[0], 0.f), r1 = fmaxf(v[1], 0.f), r2 = fmaxf(v[2], 0.f), r3 = fmaxf(v[3], 0.f); u32x2_t w; w[0] = pk_bf16(r0 * r0, r1 * r1); w[1] = pk_bf16(r2 * r2, r3 * r3); *(u32x2_t*)((bf16*)C + o) = w; }
            else { f32x4_t* p = (f32x4_t*)((float*)C + o); *p = *p + v; } } }
}


template <int MODE> __device__ __forceinline__ void small_gemm2(const bf16* __restrict__ A, const bf16* __restrict__ Bt, int N, int K, void* C, int ldc, bf16* XB, unsigned long long* ss, LAS unsigned char* lds) {
    static_assert(MS == 128, "small_gemm2 covers 128 sample rows");
    int tx_ = TID(); asm volatile("" : "+v"(tx_));
    const int tid = tx_, lane = tid & 63, fr = lane & 15, fq = lane >> 4, wid = __builtin_amdgcn_readfirstlane(tid >> 6);
    LAS float* RED = (LAS float*)lds;
    const int kw = K / 8;
    for (int tile = blockIdx.x; tile < (N / 16) * 4; tile += gridDim.x) { const int n0 = (tile >> 2) * 16, tg = tile & 3;
        f32x4_t acc0 = {0.f, 0.f, 0.f, 0.f}, acc1 = {0.f, 0.f, 0.f, 0.f};
        const bf16* bp = Bt + (size_t)(n0 + fr) * K + wid * kw + fq * 8; const bf16* ap0 = A + (size_t)(MP + tg * 32 + fr) * K + wid * kw + fq * 8; const bf16* ap1 = ap0 + (size_t)16 * K;
        for (int k = 0; k < kw; k += 128) { bf16x8_t bb[4], a0[4], a1[4];
#pragma unroll
            for (int u = 0; u < 4; ++u) { bb[u] = *(const bf16x8_t*)(bp + k + 32 * u); a0[u] = *(const bf16x8_t*)(ap0 + k + 32 * u); a1[u] = *(const bf16x8_t*)(ap1 + k + 32 * u); }
#pragma unroll
            for (int u = 0; u < 4; ++u) { acc0 = __builtin_amdgcn_mfma_f32_16x16x32_bf16(bb[u], a0[u], acc0, 0, 0, 0); acc1 = __builtin_amdgcn_mfma_f32_16x16x32_bf16(bb[u], a1[u], acc1, 0, 0, 0); } }
        *(LAS f32x4_t*)(RED + ((size_t)(wid * 32 + fr)) * 16 + 4 * fq) = acc0; *(LAS f32x4_t*)(RED + ((size_t)(wid * 32 + 16 + fr)) * 16 + 4 * fq) = acc1;
        __syncthreads();
        { const int tok = tid >> 4, c = tid & 15; float v = RED[(size_t)tok * 16 + c];
#pragma unroll
            for (int w = 1; w < 8; ++w) v += RED[(size_t)(w * 32 + tok) * 16 + c];
            const int m = MP + tg * 32 + tok; const size_t o = (size_t)m * ldc + n0 + c;
            if (MODE == 1) { const float rs = FRSQ((float)ss[m] * (5.9604644775390625e-08f / D) + EPS); const float r0 = fmaxf(v * rs, 0.f); ((bf16*)C)[o] = f2bf(r0 * r0); }
            else { const float x = ((float*)C)[o] + v; ((float*)C)[o] = x; XB[o] = f2bf(x);
                float q = x * x; q += shfl_xor_l(q, 1, lane); q += shfl_xor_l(q, 2, lane); q += shfl_xor_l(q, 4, lane); q += shfl_xor_l(q, 8, lane);
                if (c == 0) __hip_atomic_fetch_add(ss + m, (unsigned long long)(q * 16777216.0f), __ATOMIC_RELAXED, __HIP_MEMORY_SCOPE_AGENT); } }
        __syncthreads();
    }
}

constexpr int PH_PER_LAYER = 12, PH_LAYER0 = 2, PH_FINAL = PH_LAYER0 + DEPTH * PH_PER_LAYER, N_PHASES = PH_FINAL + 1;
#ifndef DIAG_SEQ_LO
#define DIAG_SEQ_LO NB
#endif
#ifndef PROBE_N
#define PROBE_N 1
#define PROBE_KIND -1
#define PROBE_LO 0
#define PROBE_HI 0
#endif
#define NREP(kind, k) ((PROBE_KIND == (kind) && (k) >= PROBE_LO && (k) <= PROBE_HI) ? PROBE_N : 1)
#define REP(kind, k) for (int rep_ = 0; rep_ < NREP(kind, k); ++rep_)
#ifndef MK_SINGLE
#define MK_SINGLE 1
#endif
__global__ void __launch_bounds__(NTHREADS, 2) mega(KArgs ka) {
    extern __shared__ __attribute__((aligned(16))) unsigned char lds[];
    LAS unsigned char* L = (LAS unsigned char*)lds;
    const size_t gsz = (size_t)gridDim.x * NTHREADS;
#define GT() ([&]() -> size_t { unsigned tx_ = TID(); asm volatile("" : "+v"(tx_)); return (size_t)blockIdx.x * NTHREADS + tx_; }())
    const int lo = ka.ph_lo, hi = ka.ph_hi; (void)lo; (void)hi;
    { const unsigned hw_ = (unsigned)__builtin_amdgcn_s_getreg((5 << 11) | 4) & 63u; if ((threadIdx.x & 63) == 0) ((LAS int*)(L + LDS_WTAB))[hw_] = (int)(threadIdx.x >> 6); __syncthreads(); }
    { const float** tab = (const float**)(ka.ws + WS_TAB); if (threadIdx.x < 28) tab[threadIdx.x] = ka.in[threadIdx.x]; asm volatile("s_waitcnt vmcnt(0)" ::: "memory"); __syncthreads(); }
    Args a; a.in = (const float* const*)(ka.ws + WS_TAB); a.out = ka.out; a.ws = ka.ws;
#define OPQ() do { size_t z_ = 0; asm volatile("" : "+s"(z_)); a.ws = ka.ws + z_; a.out = ka.out + z_; a.in = (const float* const*)(ka.ws + WS_TAB + z_); } while (0)
#if MK_SINGLE
    if (TID() < 4) ((LAS unsigned*)(L + LDS_MISC))[TID()] = 0u;
    __syncthreads();
    XcdBarrier bar = xcd_barrier_post((unsigned*)(a.ws + WS_CTL) + 4096, (volatile LAS unsigned*)(L + LDS_MISC));
#define SEAM(k) do { XcdBarrier bb_ = bar; asm volatile("" : "+s"(bb_.x)); xcd_barrier(bb_); } while (0)
#else
#define SEAM(k) do { } while (0)
#endif
#if MK_SINGLE
#define IN(k) (true)
#else
#define IN(k) (lo <= (k) && (k) < hi)
#endif
#define XN ((bf16*)(a.ws + WS_XN))
#define X ((float*)(a.ws + WS_X))
#define P ((float*)(a.ws + WS_P))
#define H ((bf16*)(a.ws + WS_H))
#define Y2 ((bf16*)(a.ws + WS_Y2))
    if (IN(0)) { OPQ(); REP(2, 0) { ph_prep_x(a); ph_wprep(a, true, 0, GT(), gsz); } SEAM(0); }
    for (int l = 0; l < DEPTH; ++l) {
        const int pb = PH_LAYER0 + l * PH_PER_LAYER, r = l >> 1; unsigned long long* SSb = (unsigned long long*)(a.ws + WS_SS);
        if ((l & 1) == 0) {
            if (IN(pb + 1)) { OPQ(); REP(3, 1) { pg8::Gemm g{XN, (const bf16*)(a.ws + WS_WINR) + (size_t)r * REC_PAD * D, MPAD, REC_PAD, D}; pg8::StaticOrder S; S.init(MPAD, REC_PAD, gridDim.x, blockIdx.x);
                pg8::EpiF32S E{P, LDP, SSb + (size_t)(2 * l) * MPAD}; pg8::gemm_phase<pg8::EpiF32S, pg8::StaticOrder, false>(L, g, S, E, nullptr); } SEAM(pb + 1); }
            if (IN(pb + 2)) { OPQ(); REP(0, 2) { ph_rg_chunk(a, r, L); ph_dn_tok(a, r); } SEAM(pb + 2); }
            if (IN(pb + 3)) { OPQ(); REP(0, 3) ph_dn_chunk(a, L); SEAM(pb + 3); }
            if (IN(pb + 6)) { OPQ();
                constexpr int NDNB = NB * DNH * 8;
                REP(0, 6) {
                if ((int)gridDim.x > NDNB) { if ((int)blockIdx.x < NDNB) {
#ifdef DIAG_NAIVE_B
                    ph_dn_b_naive(a, r, GT(), (size_t)NDNB * NTHREADS);
#else
                    ph_dn_b(a, r, L);
#endif
                } else { const size_t g2 = GT() - (size_t)NDNB * NTHREADS, s2 = gsz - (size_t)NDNB * NTHREADS; ph_rg_scan2(a, r, g2, s2); if (DIAG_SEQ_LO != 0) ph_dn_seq(a, r, DIAG_SEQ_LO, g2, s2);
                    if (l == 0) ph_wprep(a, true, 1, g2, s2); } }
                else { ph_dn_b(a, r, L); ph_rg_scan2(a, r, GT(), gsz); ph_dn_seq(a, r, DIAG_SEQ_LO, GT(), gsz); if (l == 0) ph_wprep(a, true, 1, GT(), gsz); }
                }
                SEAM(pb + 6); }
            if (IN(pb + 7)) { OPQ(); REP(0, 7) ph_rec_out_w(a, r); SEAM(pb + 7); }
            if (IN(pb + 8)) { OPQ(); REP(3, 8) { pg8::Gemm g{Y2, (const bf16*)(a.ws + WS_WOUTR) + (size_t)r * D * Y2W, MP, D, Y2W}; pg8::StaticOrder S; S.init(MP, D, gridDim.x, blockIdx.x);
                pg8::EpiAddN E{X, D, XN, SSb + (size_t)(2 * l + 1) * MPAD}; pg8::gemm_phase<pg8::EpiAddN, pg8::StaticOrder, false>(L, g, S, E, nullptr); small_gemm2<2>(Y2, (const bf16*)(a.ws + WS_WOUTR) + (size_t)r * D * Y2W, D, Y2W, X, D, XN, SSb + (size_t)(2 * l + 1) * MPAD, L); } SEAM(pb + 8); }
        } else {
            if (IN(pb + 1)) { OPQ(); REP(3, 1) { pg8::Gemm g{XN, (const bf16*)(a.ws + WS_WINA) + (size_t)r * ATT_PAD * D, MPAD, ATT_PAD, D}; pg8::StaticOrder S; S.init(MPAD, ATT_PAD, gridDim.x, blockIdx.x);
                pg8::EpiAttS E{a.ws, a.out, SSb + (size_t)(2 * l) * MPAD, r}; pg8::gemm_phase<pg8::EpiAttS, pg8::StaticOrder, false>(L, g, S, E, nullptr); } SEAM(pb + 1); }
            if (IN(pb + 3)) { OPQ(); REP(1, 3) { ph_idx_sample_mfma(a, r); ph_idx_mfma(a, L); } SEAM(pb + 3); }
            if (IN(pb + 4)) { OPQ(); REP(1, 4) ph_select_w(a, L); SEAM(pb + 4); }
            if (IN(pb + 5)) { OPQ(); REP(1, 5) { ph_sparse_sample(a, r, L); ph_sparse_attn(a, L); } SEAM(pb + 5); }
            if (IN(pb + 8)) { OPQ(); REP(3, 8) { pg8::Gemm g{Y2, (const bf16*)(a.ws + WS_WOUTA) + (size_t)r * D * D, MP, D, D}; pg8::StaticOrder S; S.init(MP, D, gridDim.x, blockIdx.x);
                pg8::EpiAddN E{X, D, XN, SSb + (size_t)(2 * l + 1) * MPAD}; pg8::gemm_phase<pg8::EpiAddN, pg8::StaticOrder, false>(L, g, S, E, nullptr); small_gemm2<2>(Y2, (const bf16*)(a.ws + WS_WOUTA) + (size_t)r * D * D, D, D, X, D, XN, SSb + (size_t)(2 * l + 1) * MPAD, L); } SEAM(pb + 8); }
        }
        if (IN(pb + 10)) { OPQ(); REP(3, 10) { pg8::Gemm g{XN, (const bf16*)(a.ws + WS_WUP) + (size_t)l * D_FF * D, MP, D_FF, D}; pg8::StaticOrder S; S.init(MP, D_FF, gridDim.x, blockIdx.x);
            pg8::EpiRelu2S E{H, D_FF, SSb + (size_t)(2 * l + 1) * MPAD}; pg8::gemm_phase<pg8::EpiRelu2S, pg8::StaticOrder, false>(L, g, S, E, nullptr); small_gemm2<1>(XN, (const bf16*)(a.ws + WS_WUP) + (size_t)l * D_FF * D, D_FF, D, H, D_FF, nullptr, SSb + (size_t)(2 * l + 1) * MPAD, L); } SEAM(pb + 10); }
        if (IN(pb + 11)) { OPQ(); REP(3, 11) { pg8::Gemm g{H, (const bf16*)(a.ws + WS_WDN) + (size_t)l * D * D_FF, MP, D, D_FF}; pg8::StaticOrder S; S.init(MP, D, gridDim.x, blockIdx.x);
            pg8::EpiAddN E{X, D, XN, SSb + (size_t)(2 * l + 2) * MPAD}; pg8::gemm_phase<pg8::EpiAddN, pg8::StaticOrder, false>(L, g, S, E, nullptr); small_gemm2<2>(H, (const bf16*)(a.ws + WS_WDN) + (size_t)l * D * D_FF, D, D_FF, X, D, XN, SSb + (size_t)(2 * l + 2) * MPAD, L); } SEAM(pb + 11); }
    }
    if (IN(PH_FINAL)) { OPQ(); ph_final(a); }
}
#undef XN
#undef X
#undef P
#undef H
#undef Y2

extern "C" void kernel_launch(void* const* d_in, const int* in_sizes, int n_in, void* d_out, int out_size, void* d_ws, size_t ws_size, hipStream_t stream) {
    static int grid = 0;
    if (grid == 0) {
        if (n_in != 28 || (size_t)out_size != (size_t)O_END || ws_size < WS_END2) { fprintf(stderr, "kernel_launch: unexpected shapes n_in %d out %d (want %zu) ws %zu (want %zu)\n", n_in, out_size, (size_t)O_END, ws_size, (size_t)WS_END2); grid = -1; return; }
        int dev = 0, cus = 0;
        if (hipGetDevice(&dev) != hipSuccess || hipDeviceGetAttribute(&cus, hipDeviceAttributeMultiprocessorCount, dev) != hipSuccess) { grid = -1; return; }
        if (hipFuncSetAttribute((const void*)mega, hipFuncAttributeMaxDynamicSharedMemorySize, LDS_BYTES) != hipSuccess) { fprintf(stderr, "kernel_launch: hipFuncSetAttribute failed\n"); grid = -1; return; }
        int per_cu = 0; (void)hipOccupancyMaxActiveBlocksPerMultiprocessor(&per_cu, (const void*)mega, NTHREADS, LDS_BYTES); (void)hipGetLastError();
        if (per_cu < 1) fprintf(stderr, "kernel_launch: occupancy query says %d blocks per CU\n", per_cu);
        grid = cus;
    }
    if (grid < 0) return;
    (void)hipMemsetAsync((char*)d_ws + WS_CTL, 0, CTL_BYTES, stream);
    KArgs a{};
    for (int i = 0; i < 28; ++i) a.in[i] = (const float*)d_in[i];
    a.out = (float*)d_out; a.ws = (unsigned char*)d_ws;
#if MK_SINGLE
    a.ph_lo = 0; a.ph_hi = N_PHASES;
    hipLaunchKernelGGL(mega, dim3(grid), dim3(NTHREADS), LDS_BYTES, stream, a);
#else
    for (int ph = 0; ph < N_PHASES; ++ph) { const int k = ph - PH_LAYER0; if (k >= 0 && ph < PH_FINAL && ((k / PH_PER_LAYER) & 1) == 1 && (k % PH_PER_LAYER) == 7) continue;
        a.ph_lo = ph; a.ph_hi = ph + 1; hipLaunchKernelGGL(mega, dim3(grid), dim3(NTHREADS), LDS_BYTES, stream, a); }
#endif
}
#endif
```

```cpp
#ifndef HOST_TEST
#include <hip/hip_runtime.h>
#define HD __device__ __forceinline__
#define UNI(x) __builtin_amdgcn_readfirstlane(x)
#else
#include <cmath>
#include <cstddef>
#include <cstring>
#define HD static inline
#define UNI(x) (x)
#endif

#ifndef CFG_D_MODEL
#define CFG_D_MODEL 1024
#define CFG_BATCH 2
#define CFG_SEQ 8192
#define CFG_DEC_BATCH 32
#define CFG_PAST 8192
#endif
constexpr int D = CFG_D_MODEL, NB = CFG_BATCH, SEQ = CFG_SEQ, DEPTH = 4, DB = CFG_DEC_BATCH, DT = 4, PAST = CFG_PAST, PAGE = 128;
constexpr int N_REC = 2, N_ATT = 2, NPAGES = PAST / PAGE, NUSED = DB * NPAGES, NPOOL = NUSED + (NUSED + 3) / 4;
constexpr int D_RNN = D / 2, RG_HEADS = 8, RG_BW = D_RNN / RG_HEADS;
constexpr int DNH = 4, DNK = 128, DN_QK = 512, DN_VD = 512;
constexpr int CONV_CH = D_RNN + 2 * DN_QK + DN_VD, REC_IN = CONV_CH + D_RNN + DN_VD + 2 * DNH;
constexpr int OFF_GATE = CONV_CH, OFF_Z = CONV_CH + D_RNN, OFF_B = OFF_Z + DN_VD, OFF_A = OFF_B + DNH;
constexpr int AH = D / 128, KVH = 2, HDIM = 128, GROUP = AH / KVH, IH = 8, IDIM = 64;
constexpr int AO_K = AH * HDIM, AO_V = AO_K + KVH * HDIM, AO_QI = AO_V + KVH * HDIM, AO_KI = AO_QI + IH * IDIM, AO_WI = AO_KI + IDIM, ATT_IN = AO_WI + IH;
constexpr int D_FF = 4 * D;
constexpr int TOPK_P = (SEQ / 4 < 256) ? SEQ / 4 : 256, TOPK_S = ((PAST + DT) / 4 < 256) ? (PAST + DT) / 4 : 256, KMAX = 256, KROW = 320;
constexpr int MP = NB * SEQ, MS = DB * DT, MT = MP + MS, MPAD = (MT + 255) / 256 * 256;
constexpr int REC_PAD = (REC_IN + 255) / 256 * 256, ATT_PAD = (ATT_IN + 255) / 256 * 256, LDP = REC_PAD > ATT_PAD ? REC_PAD : ATT_PAD;
constexpr int Y2W = D_RNN + DN_VD;
constexpr int SMAX = (PAST + DT > SEQ) ? PAST + DT : SEQ, SLD = (SMAX + 63) / 64 * 64;
constexpr int NC = SEQ / 64, NCU = NB * DNH * NC;
constexpr float EPS = 1e-6f;
typedef unsigned short bf16;

constexpr size_t O_YP = 0, O_YS = O_YP + (size_t)MP * D, O_CONVP = O_YS + (size_t)MS * D, O_HP = O_CONVP + (size_t)N_REC * NB * 3 * CONV_CH,
    O_SP = O_HP + (size_t)N_REC * NB * D_RNN, O_KP = O_SP + (size_t)N_REC * NB * DNH * 128 * 128, O_VP = O_KP + (size_t)N_ATT * MP * KVH * HDIM,
    O_KIP = O_VP + (size_t)N_ATT * MP * KVH * HDIM, O_CONVS = O_KIP + (size_t)N_ATT * MP * IDIM, O_HS = O_CONVS + (size_t)N_REC * DB * 3 * CONV_CH,
    O_SS = O_HS + (size_t)N_REC * DB * D_RNN, O_KS = O_SS + (size_t)N_REC * DB * DNH * 128 * 128, O_VS = O_KS + (size_t)N_ATT * MS * KVH * HDIM,
    O_KIS = O_VS + (size_t)N_ATT * MS * KVH * HDIM, O_END = O_KIS + (size_t)N_ATT * MS * IDIM;

constexpr size_t al256(size_t x) { return (x + 255) / 256 * 256; }
constexpr size_t WS_CTL = 0, CTL_BYTES = 4u << 20;
constexpr size_t WS_WINR = CTL_BYTES, WS_WOUTR = WS_WINR + al256((size_t)N_REC * REC_PAD * D * 2), WS_WINA = WS_WOUTR + al256((size_t)N_REC * D * Y2W * 2),
    WS_WOUTA = WS_WINA + al256((size_t)N_ATT * ATT_PAD * D * 2), WS_WUP = WS_WOUTA + al256((size_t)N_ATT * D * D * 2), WS_WDN = WS_WUP + al256((size_t)DEPTH * D_FF * D * 2),
    WS_X = WS_WDN + al256((size_t)DEPTH * D * D_FF * 2), WS_XN = WS_X + al256((size_t)MPAD * D * 4), WS_P = WS_XN + al256((size_t)MPAD * D * 2),
    WS_H = WS_P + al256((size_t)MPAD * LDP * 4), WS_Y2 = WS_H + al256((size_t)MPAD * D_FF * 2), WS_XR = WS_Y2 + al256((size_t)MPAD * D * 2),
    WS_QKV = WS_XR + al256((size_t)MT * D_RNN * 4), WS_RA = WS_QKV + al256((size_t)MT * 1536 * 4), WS_RB = WS_RA + al256((size_t)MT * D_RNN * 4),
    WS_HH = WS_RB + al256((size_t)MT * D_RNN * 4), WS_QN = WS_HH + al256((size_t)MT * D_RNN * 4), WS_KN = WS_QN + al256((size_t)MT * 512 * 4),
    WS_GB = WS_KN + al256((size_t)MT * 512 * 4), WS_ODN = WS_GB + al256((size_t)MT * 16 * 4), WS_SCT = WS_ODN + al256((size_t)MT * 512 * 4),
    WS_IDX = WS_SCT + al256((size_t)MT * SLD * 4), WS_NSEL = WS_IDX + al256((size_t)MT * KROW * 4), WS_SCR = WS_NSEL + al256((size_t)MT * 4),
    WS_CARRY = WS_SCR + al256((size_t)MT * AH * KMAX * 4), WS_L = WS_CARRY + al256((size_t)NB * NC * D_RNN * 4), WS_AT = WS_L + al256((size_t)NCU * 4096 * 4),
    WS_UT = WS_AT + al256((size_t)NCU * 4096 * 2), WS_WN = WS_UT + al256((size_t)NCU * 8192 * 4), WS_QG = WS_WN + al256((size_t)NCU * 8192 * 2),
    WS_KDT = WS_QG + al256((size_t)NCU * 8192 * 2), WS_GL = WS_KDT + al256((size_t)NCU * 8192 * 2), WS_KNT = WS_GL + al256((size_t)NCU * 4), WS_END = WS_KNT + al256((size_t)NCU * 8192 * 4);

constexpr size_t WS_KB = WS_H, WS_VB = WS_KB + al256((size_t)MT * 256 * 2), WS_QIB = WS_VB + al256((size_t)MT * 256 * 2), WS_KIB = WS_QIB + al256((size_t)MT * 512 * 2);
constexpr size_t WS_QB = WS_KIB + al256((size_t)MT * 64 * 2);
static_assert(WS_QB + (size_t)MT * D * 2 <= WS_Y2, "bf16 attention copies must fit inside the H buffer");
#ifdef HOST_TEST
struct Args { const float* in[28]; float* out; unsigned char* ws; int ph_lo, ph_hi; };
#else
struct KArgs { const float* in[28]; float* out; unsigned char* ws; int ph_lo, ph_hi; };
struct Args { const float* const* in; float* out; unsigned char* ws; };
constexpr size_t WS_TAB = 65536;
constexpr size_t WS_SS = 1u << 20;
static_assert(WS_SS + (size_t)9 * MPAD * 8 <= CTL_BYTES, "norm statistics inside the memset region");
constexpr size_t WS_END2 = WS_END;
#endif
enum { I_XP = 0, I_XS, I_SCONV, I_SH, I_SS, I_CK, I_CV, I_CKI, I_PT, I_NMIX, I_NMLP, I_NFIN, I_WINR, I_WCONV, I_BCONV, I_WA, I_BA, I_WX, I_BX, I_LAM, I_ALOG, I_DTB, I_DNW,
       I_WOUTR, I_WINA, I_WOUTA, I_WUP, I_WDN };

HD bf16 f2bf(float f) { unsigned u; memcpy(&u, &f, 4); u += 0x7FFFu + ((u >> 16) & 1u); return (bf16)(u >> 16); }
HD float bf2f(bf16 b) { unsigned u = ((unsigned)b) << 16; float f; memcpy(&f, &u, 4); return f; }
#ifndef HOST_TEST
#define FEXP(x) __expf(x)
#define FLOG(x) __logf(x)
#define FRCP(x) __builtin_amdgcn_rcpf(x)
#define FSQRT(x) __builtin_amdgcn_sqrtf(x)
#define FRSQ(x) __builtin_amdgcn_rsqf(x)
#else
#define FEXP(x) expf(x)
#define FLOG(x) logf(x)
#define FRCP(x) (1.0f / (x))
#define FSQRT(x) sqrtf(x)
#define FRSQ(x) (1.0f / sqrtf(x))
#endif
HD float sigmoidf_(float x) { return FRCP(1.0f + FEXP(-x)); }
HD float softplusf_(float x) { return x > 20.f ? x : FLOG(1.0f + FEXP(x)); }
HD float siluf_(float x) { return x * sigmoidf_(x); }
HD float gelu_tanhf_(float x) { const float u = 0.7978845608028654f * (x + 0.044715f * x * x * x); const float th = 1.0f - 2.0f * FRCP(1.0f + FEXP(2.0f * u)); return 0.5f * x * (1.0f + th); }
HD unsigned fkey(float f) { f = f + 0.0f; unsigned u; memcpy(&u, &f, 4); return (u & 0x80000000u) ? ~u : (u | 0x80000000u); }
struct RowInfo { int seq, t, T, row0; bool sample; };
HD RowInfo row_info(int m) { RowInfo r; if (m < MP) { r.seq = m / SEQ; r.t = m % SEQ; r.T = SEQ; r.row0 = r.seq * SEQ; r.sample = false; }
    else { const int q = m - MP; r.seq = NB + q / DT; r.t = q % DT; r.T = DT; r.row0 = MP + (q / DT) * DT; r.sample = true; } return r; }

HD void ph_copy_x(const Args& a, size_t gtid, size_t gsz) {
    float* X = (float*)(a.ws + WS_X);
    for (size_t i = gtid; i < (size_t)MPAD * D; i += gsz) { const size_t m = i / D; X[i] = m < (size_t)MP ? a.in[I_XP][i] : (m < (size_t)MT ? a.in[I_XS][i - (size_t)MP * D] : 0.f); }
}
HD void wprep_one(const float* w, bf16* wt, int K, int N, int NP, const float* gamma, size_t gtid, size_t gsz) {
    const size_t k32n = (size_t)K / 32;
    for (size_t i = gtid; i < (size_t)NP * k32n; i += gsz) { const int n = (int)(i % NP); const size_t k0 = (i / NP) * 32; bf16 tmp[32];
#ifndef HOST_TEST
#pragma unroll
#endif
        for (int j = 0; j < 32; ++j) tmp[j] = n < N ? f2bf(w[(k0 + j) * (size_t)N + n] * (gamma ? gamma[k0 + j] : 1.0f)) : (bf16)0;
#ifndef HOST_TEST
#pragma unroll
#endif
        for (int j = 0; j < 32; ++j) wt[(size_t)n * K + k0 + j] = tmp[j]; }
}
HD void ph_wprep(const Args& a, bool fold, int part, size_t gtid, size_t gsz) {
    for (int r = 0; r < N_REC; ++r) { if (part == 2 || (part == 0) == (r == 0)) wprep_one(a.in[I_WINR] + (size_t)r * D * REC_IN, (bf16*)(a.ws + WS_WINR) + (size_t)r * REC_PAD * D, D, REC_IN, REC_PAD, fold ? a.in[I_NMIX] + (size_t)(2 * r) * D : nullptr, gtid, gsz);
        if (part != 0) wprep_one(a.in[I_WOUTR] + (size_t)r * Y2W * D, (bf16*)(a.ws + WS_WOUTR) + (size_t)r * D * Y2W, Y2W, D, D, nullptr, gtid, gsz); }
    if (part == 0) return;
    for (int r = 0; r < N_ATT; ++r) { wprep_one(a.in[I_WINA] + (size_t)r * D * ATT_IN, (bf16*)(a.ws + WS_WINA) + (size_t)r * ATT_PAD * D, D, ATT_IN, ATT_PAD, fold ? a.in[I_NMIX] + (size_t)(2 * r + 1) * D : nullptr, gtid, gsz);
        wprep_one(a.in[I_WOUTA] + (size_t)r * D * D, (bf16*)(a.ws + WS_WOUTA) + (size_t)r * D * D, D, D, D, nullptr, gtid, gsz); }
    for (int l = 0; l < DEPTH; ++l) { wprep_one(a.in[I_WUP] + (size_t)l * D * D_FF, (bf16*)(a.ws + WS_WUP) + (size_t)l * D_FF * D, D, D_FF, D_FF, fold ? a.in[I_NMLP] + (size_t)l * D : nullptr, gtid, gsz);
        wprep_one(a.in[I_WDN] + (size_t)l * D_FF * D, (bf16*)(a.ws + WS_WDN) + (size_t)l * D * D_FF, D_FF, D, D, nullptr, gtid, gsz); }
}
HD void ph_conv(const Args& a, int r, size_t gtid, size_t gsz) {
    const float* P = (const float*)(a.ws + WS_P); float* XR = (float*)(a.ws + WS_XR); float* QKV = (float*)(a.ws + WS_QKV);
    const float* wc = a.in[I_WCONV] + (size_t)r * 4 * CONV_CH; const float* bc = a.in[I_BCONV] + (size_t)r * D_RNN;
    for (size_t i = gtid; i < (size_t)MT * CONV_CH; i += gsz) { const int m = (int)(i / CONV_CH), c = (int)(i % CONV_CH); const RowInfo ri = row_info(m);
        float acc = 0.f;
        for (int k = 0; k < 4; ++k) { const int tau = ri.t - 3 + k; float xv;
            if (tau >= 0) xv = P[(size_t)(ri.row0 + tau) * LDP + c];
            else xv = ri.sample ? a.in[I_SCONV][(((size_t)r * DB + (ri.seq - NB)) * 3 + (3 + tau)) * CONV_CH + c] : 0.f;
            acc += xv * wc[(size_t)k * CONV_CH + c]; }
        if (c < D_RNN) XR[(size_t)m * D_RNN + c] = acc + bc[c]; else QKV[(size_t)m * 1536 + (c - D_RNN)] = siluf_(acc);
        const float uraw = P[(size_t)m * LDP + c];
        if (!ri.sample) { if (ri.t >= SEQ - 3) a.out[O_CONVP + (((size_t)r * NB + ri.seq) * 3 + (ri.t - (SEQ - 3))) * CONV_CH + c] = uraw; }
        else { if (ri.t >= DT - 3) a.out[O_CONVS + (((size_t)r * DB + (ri.seq - NB)) * 3 + (ri.t - (DT - 3))) * CONV_CH + c] = uraw; }
    }
}
HD void ph_rg_gates(const Args& a, int r, size_t gtid, size_t gsz) {
    const float* XR = (const float*)(a.ws + WS_XR); float* RA = (float*)(a.ws + WS_RA); float* RB = (float*)(a.ws + WS_RB);
    const float* wa = a.in[I_WA] + (size_t)r * RG_HEADS * RG_BW * RG_BW; const float* wx = a.in[I_WX] + (size_t)r * RG_HEADS * RG_BW * RG_BW;
    for (size_t i = gtid; i < (size_t)MT * D_RNN; i += gsz) { const int m = (int)(i / D_RNN), j = (int)(i % D_RNN), hd = j / RG_BW, jj = j % RG_BW; const RowInfo ri = row_info(m);
        float pr = 0.f, pi = 0.f; const float* xrow = XR + (size_t)m * D_RNN + hd * RG_BW;
        for (int k = 0; k < RG_BW; ++k) { const float xv = xrow[k]; pr += xv * wa[((size_t)hd * RG_BW + k) * RG_BW + jj]; pi += xv * wx[((size_t)hd * RG_BW + k) * RG_BW + jj]; }
        const float rg = sigmoidf_(pr + a.in[I_BA][(size_t)r * D_RNN + j]), ig = sigmoidf_(pi + a.in[I_BX][(size_t)r * D_RNN + j]);
        const float log_a = -8.0f * rg * softplusf_(-a.in[I_LAM][(size_t)r * D_RNN + j]); const float av = FEXP(log_a);
        const bool first = (!ri.sample) && ri.t == 0;
        const float mult = first ? 1.0f : sqrtf(fmaxf(1.0f - FEXP(2.0f * log_a), 0.0f));
        float bv = XR[(size_t)m * D_RNN + j] * ig * mult;
        if (ri.t == 0 && ri.sample) bv += av * a.in[I_SH][((size_t)r * DB + (ri.seq - NB)) * D_RNN + j];
        RA[i] = av; RB[i] = bv; }
}
HD void ph_rg_scan1(const Args& a, int r, size_t gtid, size_t gsz) {
    const float* RA = (const float*)(a.ws + WS_RA); float* AP = (float*)(a.ws + WS_XR); const float* RB = (const float*)(a.ws + WS_RB); float* HH = (float*)(a.ws + WS_HH);
    const size_t n_p = (size_t)NB * NC * D_RNN, n_s = (size_t)DB * D_RNN;
    for (size_t i = gtid; i < n_p + n_s; i += gsz) {
        if (i < n_p) { const int j = (int)(i % D_RNN); const size_t row0 = (i / D_RNN) * 64; float h = 0.f, ap = 1.f;
            for (int t = 0; t < 64; ++t) { const size_t o = (row0 + t) * D_RNN + j; const float av = RA[o]; h = av * h + RB[o]; ap *= av; HH[o] = h; AP[o] = ap; } }
        else { const size_t q = i - n_p; const int db = (int)(q / D_RNN), j = (int)(q % D_RNN); float h = 0.f;
            for (int t = 0; t < DT; ++t) { const size_t o = (size_t)(MP + db * DT + t) * D_RNN + j; h = RA[o] * h + RB[o]; HH[o] = h; }
            a.out[O_HS + ((size_t)r * DB + db) * D_RNN + j] = h; } }
}
HD void ph_rg_scan2(const Args& a, int r, size_t gtid, size_t gsz) {
    const float* RA = (const float*)(a.ws + WS_XR); const float* HH = (const float*)(a.ws + WS_HH); float* CARRY = (float*)(a.ws + WS_CARRY);
    for (size_t i = gtid; i < (size_t)NB * D_RNN; i += gsz) { const int b = (int)(i / D_RNN), j = (int)(i % D_RNN); float carry = 0.f;
        for (int n0 = 0; n0 < NC; n0 += 16) { float av[16], hv[16];
#pragma unroll
            for (int q = 0; q < 16; ++q) { const int n = n0 + q < NC ? n0 + q : NC - 1; const size_t last = ((size_t)b * SEQ + n * 64 + 63) * D_RNN + j; av[q] = RA[last]; hv[q] = HH[last]; }
#pragma unroll
            for (int q = 0; q < 16; ++q) if (n0 + q < NC) { CARRY[((size_t)b * NC + n0 + q) * D_RNN + j] = carry; carry = av[q] * carry + hv[q]; } }
        a.out[O_HP + ((size_t)r * NB + b) * D_RNN + j] = carry; }
}
HD float dn_g(const Args& a, int r, size_t m, int hd) { const float* P = (const float*)(a.ws + WS_P);
    return -FEXP(a.in[I_ALOG][r * DNH + hd]) * softplusf_(P[m * LDP + OFF_A + hd] + a.in[I_DTB][r * DNH + hd]); }
HD void ph_dn_prep(const Args& a, int r, size_t gtid, size_t gsz) {
    const float* P = (const float*)(a.ws + WS_P); const float* QKV = (const float*)(a.ws + WS_QKV); float* QN = (float*)(a.ws + WS_QN); float* KN = (float*)(a.ws + WS_KN); float* GB = (float*)(a.ws + WS_GB);
    for (size_t i = gtid; i < (size_t)MT * DNH; i += gsz) { const int m = (int)(i / DNH), hd = (int)(i % DNH);
        const float* q = QKV + (size_t)m * 1536 + hd * 128; const float* k = q + 512; float sq = 0.f, sk = 0.f;
        for (int d = 0; d < 128; ++d) { sq += q[d] * q[d]; sk += k[d] * k[d]; }
        const float rq = FRSQ(sq + EPS) * 0.08838834764831845f, rk = 1.0f / sqrtf(sk + EPS);
        for (int d = 0; d < 128; ++d) { QN[(size_t)m * 512 + hd * 128 + d] = q[d] * rq; KN[(size_t)m * 512 + hd * 128 + d] = k[d] * rk; }
        if (m < MP) { float* KNT = (float*)(a.ws + WS_KNT) + (((size_t)(m / SEQ) * DNH + hd) * NC + (m % SEQ) / 64) * 8192 + (m % 64); for (int d = 0; d < 128; ++d) KNT[(size_t)d * 64] = k[d] * rk; }
        const float beta = sigmoidf_(P[(size_t)m * LDP + OFF_B + hd]);
        const float g = dn_g(a, r, (size_t)m, hd); float gc = g;
        if (m < MP) { const int t = m % SEQ; for (int tau = (t / 64) * 64; tau < t; ++tau) gc += dn_g(a, r, (size_t)(m - t + tau), hd); }
        GB[(size_t)m * 16 + hd * 4] = g; GB[(size_t)m * 16 + hd * 4 + 1] = beta; GB[(size_t)m * 16 + hd * 4 + 2] = gc; }
}
#ifndef HOST_TEST
#define DN_FENCE() asm volatile("" ::: "memory")
#else
#define DN_FENCE() do { } while (0)
#endif
HD void ph_dn_seq(const Args& a, int r, int seq_lo, size_t gtid, size_t gsz) {
    const float* QKV = (const float*)(a.ws + WS_QKV); const float* QN = (const float*)(a.ws + WS_QN); const float* KN = (const float*)(a.ws + WS_KN); const float* GB = (const float*)(a.ws + WS_GB);
    float* ODN = (float*)(a.ws + WS_ODN);
    for (size_t i = gtid; i < (size_t)(NB + DB - seq_lo) * DNH * 128; i += gsz) { const int v = (int)(i % 128), sh = UNI((int)(i / 128)), hd = sh % DNH, seq = seq_lo + sh / DNH;
        const int row0 = seq < NB ? seq * SEQ : MP + (seq - NB) * DT, T = seq < NB ? SEQ : DT;
        float S[128];
        if (seq < NB) {
#pragma unroll
            for (int d = 0; d < 128; ++d) S[d] = 0.f; }
        else { const float* s0 = a.in[I_SS] + ((((size_t)r * DB + (seq - NB)) * DNH + hd) * 128) * 128 + v;
#pragma unroll
            for (int d = 0; d < 128; ++d) S[d] = s0[(size_t)d * 128]; }
        for (int t = 0; t < T; ++t) { const size_t m = (size_t)(row0 + t);
            const float* kk = KN + m * 512 + hd * 128; const float* qq = QN + m * 512 + hd * 128;
            const float eg = FEXP(GB[m * 16 + hd * 4]), beta = GB[m * 16 + hd * 4 + 1], vv = QKV[m * 1536 + 1024 + hd * 128 + v];
            float ks = 0.f;
#pragma unroll
            for (int c = 0; c < 4; ++c) {
#pragma unroll
                for (int d = c * 32; d < c * 32 + 32; ++d) ks += kk[d] * S[d];
                DN_FENCE(); }
            const float cc = beta * (vv - eg * ks); float o = 0.f;
#pragma unroll
            for (int c = 0; c < 4; ++c) {
#pragma unroll
                for (int d = c * 32; d < c * 32 + 32; ++d) { S[d] = eg * S[d] + kk[d] * cc; o += qq[d] * S[d]; }
                DN_FENCE(); }
            ODN[m * 512 + hd * 128 + v] = o; }
        float* so = seq < NB ? a.out + O_SP + ((((size_t)r * NB + seq) * DNH + hd) * 128) * 128 + v : a.out + O_SS + ((((size_t)r * DB + (seq - NB)) * DNH + hd) * 128) * 128 + v;
#pragma unroll
        for (int d = 0; d < 128; ++d) so[(size_t)d * 128] = S[d]; }
}
HD void ph_dn_lat(const Args& a, size_t gtid, size_t gsz) {
    const float* QN = (const float*)(a.ws + WS_QN); const float* KN = (const float*)(a.ws + WS_KN); const float* GB = (const float*)(a.ws + WS_GB); const float* KNT = (const float*)(a.ws + WS_KNT);
    float* Lm = (float*)(a.ws + WS_L); bf16* AT = (bf16*)(a.ws + WS_AT); bf16* QG = (bf16*)(a.ws + WS_QG); bf16* KDT = (bf16*)(a.ws + WS_KDT); float* GL = (float*)(a.ws + WS_GL);
    for (size_t it = gtid; it < (size_t)NCU * 4096; it += gsz) { const int j = (int)(it % 64), ci = UNI((int)(it / 64)), i = ci % 64, cu = ci / 64;
        const int n = cu % NC, hd = (cu / NC) % DNH, b = cu / (NC * DNH); const size_t mi = (size_t)b * SEQ + n * 64 + i, mj = (size_t)b * SEQ + n * 64 + j;
        const float* ki = KN + mi * 512 + hd * 128; const float* qi = QN + mi * 512 + hd * 128; const float* kt = KNT + (size_t)cu * 8192 + j; float kk = 0.f, qk = 0.f;
        for (int d = 0; d < 128; ++d) { const float kj = kt[(size_t)d * 64]; kk += ki[d] * kj; qk += qi[d] * kj; }
        float lv = 0.f, av = 0.f;
        if (i >= j) { const float dec = FEXP(GB[mi * 16 + hd * 4 + 2] - GB[mj * 16 + hd * 4 + 2]); av = qk * dec; if (i > j) lv = GB[mi * 16 + hd * 4 + 1] * kk * dec; }
        Lm[it] = lv; AT[it] = f2bf(av); }
    for (size_t it = gtid; it < (size_t)NCU * 8192; it += gsz) { const int d = (int)(it % 128), i = (int)((it / 128) % 64), cu = (int)(it / 8192);
        const int n = cu % NC, hd = (cu / NC) % DNH, b = cu / (NC * DNH); const size_t mi = (size_t)b * SEQ + n * 64 + i;
        QG[it] = f2bf(QN[mi * 512 + hd * 128 + d] * FEXP(GB[mi * 16 + hd * 4 + 2])); }
    for (size_t it = gtid; it < (size_t)NCU * 8192; it += gsz) { const int i = (int)(it % 64), cu = (int)(it / 8192);
        const int n = cu % NC, hd = (cu / NC) % DNH, b = cu / (NC * DNH); const size_t mi = (size_t)b * SEQ + n * 64 + i, ml = (size_t)b * SEQ + n * 64 + 63;
        const float gci = GB[mi * 16 + hd * 4 + 2], gcl = GB[ml * 16 + hd * 4 + 2];
        KDT[it] = f2bf(KNT[it] * FEXP(gcl - gci)); if ((it % 8192) == 0) GL[cu] = FEXP(gcl); }
}
HD void ph_dn_solve(const Args& a, size_t gtid, size_t gsz) {
    const float* QKV = (const float*)(a.ws + WS_QKV); const float* KN = (const float*)(a.ws + WS_KN); const float* GB = (const float*)(a.ws + WS_GB); const float* Lm = (const float*)(a.ws + WS_L);
    float* UT = (float*)(a.ws + WS_UT); bf16* WN = (bf16*)(a.ws + WS_WN);
    for (size_t it = gtid; it < (size_t)NCU * 256; it += gsz) { const int col = (int)(it % 256), cu = UNI((int)(it / 256));
        const int n = cu % NC, hd = (cu / NC) % DNH, b = cu / (NC * DNH); const size_t m0 = (size_t)b * SEQ + n * 64; const float* Lc = Lm + (size_t)cu * 4096;
        float X[64];
#pragma unroll
        for (int j = 0; j < 64; ++j) { const float beta = GB[(m0 + j) * 16 + hd * 4 + 1];
            X[j] = col < 128 ? QKV[(m0 + j) * 1536 + 1024 + hd * 128 + col] * beta : KN[(m0 + j) * 512 + hd * 128 + (col - 128)] * beta * FEXP(GB[(m0 + j) * 16 + hd * 4 + 2]); }
#pragma unroll
        for (int i = 1; i < 64; ++i) { float acc = X[i];
#pragma unroll
            for (int j = 0; j < i; ++j) acc -= Lc[i * 64 + j] * X[j];
            X[i] = acc; DN_FENCE(); }
        if (col < 128) {
#pragma unroll
            for (int j = 0; j < 64; ++j) UT[(size_t)cu * 8192 + (size_t)col * 64 + j] = X[j]; }
        else {
#pragma unroll
            for (int j = 0; j < 64; ++j) WN[(size_t)cu * 8192 + (size_t)j * 128 + (col - 128)] = f2bf(-X[j]); } }
}
HD float bfr(float x) { return bf2f(f2bf(x)); }
HD void ph_dn_b_naive(const Args& a, int r, size_t gtid, size_t gsz) {
    const float* UT = (const float*)(a.ws + WS_UT); const bf16* WN = (const bf16*)(a.ws + WS_WN); const bf16* QG = (const bf16*)(a.ws + WS_QG); const bf16* AT = (const bf16*)(a.ws + WS_AT);
    const bf16* KDT = (const bf16*)(a.ws + WS_KDT); const float* GL = (const float*)(a.ws + WS_GL); float* ODN = (float*)(a.ws + WS_ODN); float* VN = (float*)(a.ws + WS_SCR);
    for (size_t it = gtid; it < (size_t)NB * DNH * 128; it += gsz) { const int v = (int)(it % 128), bh = UNI((int)(it / 128)), b = bh / DNH, hd = bh % DNH;
        float S[128];
#pragma unroll
        for (int d = 0; d < 128; ++d) S[d] = 0.f;
        for (int n = 0; n < NC; ++n) { const size_t cu = (size_t)bh * NC + n;
            for (int i = 0; i < 64; ++i) { float acc = UT[cu * 8192 + (size_t)v * 64 + i]; const bf16* wr = WN + cu * 8192 + i * 128;
#pragma unroll
                for (int d = 0; d < 128; ++d) acc += bf2f(wr[d]) * S[d];
                VN[((size_t)bh * 64 + i) * 128 + v] = acc; DN_FENCE(); }
            for (int i = 0; i < 64; ++i) { float acc = 0.f; const bf16* qr = QG + cu * 8192 + i * 128;
#pragma unroll
                for (int d = 0; d < 128; ++d) acc += bf2f(qr[d]) * S[d];
                for (int j = 0; j < 64; ++j) acc += bf2f(AT[cu * 4096 + i * 64 + j]) * bfr(VN[((size_t)bh * 64 + j) * 128 + v]);
                ODN[((size_t)b * SEQ + n * 64 + i) * 512 + hd * 128 + v] = acc; DN_FENCE(); }
            const float gl = GL[cu];
#pragma unroll
            for (int d = 0; d < 128; ++d) S[d] *= gl;
            for (int j = 0; j < 64; ++j) { const float vj = bfr(VN[((size_t)bh * 64 + j) * 128 + v]); const bf16* kr = KDT + cu * 8192 + j;
#pragma unroll
                for (int d = 0; d < 128; ++d) S[d] += bf2f(kr[d * 64]) * vj;
                DN_FENCE(); }
            DN_FENCE(); }
        float* so = a.out + O_SP + ((((size_t)r * NB + b) * DNH + hd) * 128) * 128 + v;
#pragma unroll
        for (int d = 0; d < 128; ++d) so[(size_t)d * 128] = S[d]; }
}
HD void ph_rec_out(const Args& a, int r, size_t gtid, size_t gsz) {
    const float* P = (const float*)(a.ws + WS_P); const float* HH = (const float*)(a.ws + WS_HH); const float* ODN = (const float*)(a.ws + WS_ODN); bf16* Y2 = (bf16*)(a.ws + WS_Y2);
    for (size_t i = gtid; i < (size_t)MT * Y2W; i += gsz) { const int m = (int)(i / Y2W), c = (int)(i % Y2W); float y;
        if (c < D_RNN) { float h = HH[(size_t)m * D_RNN + c]; if (m < MP) h += ((const float*)(a.ws + WS_XR))[(size_t)m * D_RNN + c] * ((const float*)(a.ws + WS_CARRY))[(size_t)(m / 64) * D_RNN + c];
            y = h * gelu_tanhf_(P[(size_t)m * LDP + OFF_GATE + c]); }
        else { const int cc = c - D_RNN, hd = cc / 128, vv = cc % 128; const float* o = ODN + (size_t)m * 512 + hd * 128; float ss = 0.f;
            for (int d = 0; d < 128; ++d) ss += o[d] * o[d];
            y = o[vv] / sqrtf(ss * (1.0f / 128.0f) + EPS) * a.in[I_DNW][r * 128 + vv] * siluf_(P[(size_t)m * LDP + OFF_Z + cc]); }
        Y2[i] = f2bf(y); }
}
HD void ph_att_split(const Args& a, int ai, size_t gtid, size_t gsz) {
    const float* P = (const float*)(a.ws + WS_P); constexpr int W = 2 * KVH * HDIM + IDIM;
    for (size_t i = gtid; i < (size_t)MT * W; i += gsz) { const int m = (int)(i / W), c = (int)(i % W);
        if (m < MP) { if (c < 256) a.out[O_KP + ((size_t)ai * MP + m) * 256 + c] = P[(size_t)m * LDP + AO_K + c];
            else if (c < 512) a.out[O_VP + ((size_t)ai * MP + m) * 256 + (c - 256)] = P[(size_t)m * LDP + AO_V + (c - 256)];
            else a.out[O_KIP + ((size_t)ai * MP + m) * 64 + (c - 512)] = P[(size_t)m * LDP + AO_KI + (c - 512)]; }
        else { const int ms = m - MP; if (c < 256) a.out[O_KS + ((size_t)ai * MS + ms) * 256 + c] = P[(size_t)m * LDP + AO_K + c];
            else if (c < 512) a.out[O_VS + ((size_t)ai * MS + ms) * 256 + (c - 256)] = P[(size_t)m * LDP + AO_V + (c - 256)];
            else a.out[O_KIS + ((size_t)ai * MS + ms) * 64 + (c - 512)] = P[(size_t)m * LDP + AO_KI + (c - 512)]; } }
}
HD const float* ki_row_sample(const Args& a, int ai, int db, int s) {
    if (s < PAST) { const int pg = ((const int*)a.in[I_PT])[db * NPAGES + s / PAGE]; return a.in[I_CKI] + (((size_t)ai * NPOOL + pg) * PAGE + s % PAGE) * IDIM; }
    return (const float*)(a.ws + WS_P) + (size_t)(MP + db * DT + (s - PAST)) * LDP + AO_KI;
}
HD void ph_idx_scores(const Args& a, int ai, bool prompt_too, size_t gtid, size_t gsz) {
    const float* P = (const float*)(a.ws + WS_P); float* SCT = (float*)(a.ws + WS_SCT);
    const int lane = (int)(gtid & 63); const size_t w = gtid >> 6, nw = gsz >> 6;
    constexpr int TM = 8, NKB = (SEQ + 63) / 64, NMT = SEQ / TM, NKBS = (PAST + DT + 63) / 64;
    const size_t n_p = (size_t)NB * NMT * NKB, n_s = (size_t)DB * NKBS;
    for (size_t it0 = w + (prompt_too ? 0 : n_p); it0 < n_p + n_s; it0 += nw) { const size_t it = (size_t)UNI((int)it0);
        int mrow0, nrows, s, smax_valid; const float* kr;
        if (it < n_p) { const int b = (int)(it / ((size_t)NMT * NKB)), rr = (int)(it % ((size_t)NMT * NKB)), mt = rr / NKB, kb = rr % NKB;
            if (kb * 64 > mt * TM + TM - 1) continue;
            mrow0 = b * SEQ + mt * TM; nrows = TM; s = kb * 64 + lane; smax_valid = SEQ; kr = P + (size_t)(b * SEQ + (s < SEQ ? s : 0)) * LDP + AO_KI; }
        else { const int q = (int)(it - n_p), db = q / NKBS, kb = q % NKBS; mrow0 = MP + db * DT; nrows = DT; s = kb * 64 + lane; smax_valid = PAST + DT; kr = ki_row_sample(a, ai, db, s < PAST + DT ? s : 0); }
        float kv[IDIM];
#pragma unroll
        for (int d = 0; d < IDIM; ++d) kv[d] = kr[d];
        for (int i = 0; i < nrows; ++i) { const int m = mrow0 + i; const float* qi = P + (size_t)m * LDP + AO_QI; const float* wi = P + (size_t)m * LDP + AO_WI; float sc = 0.f;
            for (int h = 0; h < IH; ++h) { float dot = 0.f;
#pragma unroll
                for (int d = 0; d < IDIM; ++d) dot += qi[h * IDIM + d] * kv[d];
                sc += wi[h] * fmaxf(dot, 0.f); }
            if (s < smax_valid) SCT[(size_t)m * SLD + s] = sc; } }
}
HD void ph_select(const Args& a, size_t gtid, size_t gsz) {
    const float* SCT = (const float*)(a.ws + WS_SCT); int* IDX = (int*)(a.ws + WS_IDX); int* NSEL = (int*)(a.ws + WS_NSEL);
    for (size_t m = gtid; m < (size_t)MT; m += gsz) { const RowInfo ri = row_info((int)m);
        const int n = ri.sample ? PAST + ri.t + 1 : ri.t + 1, K = ri.sample ? TOPK_S : TOPK_P; const float* col = SCT + m * SLD; int* out = IDX + m * KROW;
        if (n <= K) { for (int j = 0; j < n; ++j) out[j] = j; NSEL[m] = n; continue; }
        unsigned lo = 0u;
        for (int bit = 31; bit >= 0; --bit) { const unsigned cand = lo | (1u << bit); int c = 0;
            for (int s = 0; s < n; ++s) c += (fkey(col[s]) >= cand) ? 1 : 0;
            if (c >= K) lo = cand; }
        int cnt = 0;
        for (int s = 0; s < n; ++s) if (fkey(col[s]) > lo) out[cnt++] = s;
        for (int s = 0; s < n && cnt < K; ++s) if (fkey(col[s]) == lo) out[cnt++] = s;
        NSEL[m] = K; }
}
HD const float* kv_row(const Args& a, int ai, const RowInfo& ri, int idx, int kvh, bool isv) {
    const float* P = (const float*)(a.ws + WS_P); const int off = (isv ? AO_V : AO_K) + kvh * HDIM;
    if (!ri.sample) return P + (size_t)(ri.row0 + idx) * LDP + off;
    const int db = ri.seq - NB;
    if (idx >= PAST) return P + (size_t)(MP + db * DT + (idx - PAST)) * LDP + off;
    const int pg = ((const int*)a.in[I_PT])[db * NPAGES + idx / PAGE];
    return a.in[isv ? I_CV : I_CK] + ((((size_t)ai * NPOOL + pg) * PAGE + idx % PAGE) * KVH + kvh) * HDIM;
}
HD void ph_sp_scores(const Args& a, int ai, int m_lo, int m_hi, size_t gtid, size_t gsz) {
    const float* P = (const float*)(a.ws + WS_P); const int* IDX = (const int*)(a.ws + WS_IDX); const int* NSEL = (const int*)(a.ws + WS_NSEL); float* SCR = (float*)(a.ws + WS_SCR);
    for (size_t i = gtid + (size_t)m_lo * AH * KMAX; i < (size_t)m_hi * AH * KMAX; i += gsz) { const int j = (int)(i % KMAX), h = (int)((i / KMAX) % AH), m = (int)(i / ((size_t)KMAX * AH));
        if (j >= NSEL[m]) { SCR[i] = -1e30f; continue; }
        const RowInfo ri = row_info(m); const float* kr = kv_row(a, ai, ri, IDX[(size_t)m * KROW + j], h / GROUP, false); const float* q = P + (size_t)m * LDP + h * HDIM; float dot = 0.f;
        for (int d = 0; d < HDIM; ++d) dot += q[d] * kr[d];
        SCR[i] = dot * 0.08838834764831845f; }
}
HD void ph_sp_out(const Args& a, int ai, int m_lo, int m_hi, size_t gtid, size_t gsz) {
    const int* IDX = (const int*)(a.ws + WS_IDX); const int* NSEL = (const int*)(a.ws + WS_NSEL); const float* SCR = (const float*)(a.ws + WS_SCR); bf16* O = (bf16*)(a.ws + WS_Y2);
    for (size_t i = gtid + (size_t)m_lo * AH * HDIM; i < (size_t)m_hi * AH * HDIM; i += gsz) { const int d = (int)(i % HDIM), h = (int)((i / HDIM) % AH), m = (int)(i / ((size_t)HDIM * AH));
        const int ns = NSEL[m]; const float* sc = SCR + ((size_t)m * AH + h) * KMAX; const RowInfo ri = row_info(m);
        float mx = -3e38f; for (int j = 0; j < ns; ++j) mx = fmaxf(mx, sc[j]);
        float sum = 0.f, acc = 0.f;
        for (int j = 0; j < ns; ++j) { const float p = FEXP(sc[j] - mx); sum += p; acc += p * kv_row(a, ai, ri, IDX[(size_t)m * KROW + j], h / GROUP, true)[d]; }
        O[(size_t)m * D + h * HDIM + d] = f2bf(acc / sum); }
}
#ifndef HOST_TEST
#define LAS __attribute__((address_space(3)))

constexpr int LDS_WTAB = 131072 + 64;
__device__ __forceinline__ int TID() { extern __shared__ __attribute__((aligned(16))) unsigned char lds_dyn_[]; const unsigned hw = (unsigned)__builtin_amdgcn_s_getreg((5 << 11) | 4) & 63u;
    const int wvi = ((const LAS int*)((LAS unsigned char*)lds_dyn_ + LDS_WTAB))[hw]; int ln_; asm volatile("v_mbcnt_lo_u32_b32 %0, -1, 0\n\tv_mbcnt_hi_u32_b32 %0, -1, %0" : "=v"(ln_));
    return (wvi << 6) | ln_; }
#define XB_TMO      128
#define XB_XCNT(j)  (256  + 64 * (j))
#define XB_XSUB(j)  (1280 + 64 * (j))
#define XB_XGEN(j)  (2304 + 64 * (j))
#define XB_TOP      3328
#define XB_TOPGEN   3392
#define XCD_BAR_WORDS 3456
#define XB_SPIN_CAP (1u << 22)

__device__ __forceinline__ unsigned xb_ld(unsigned* p)              { return __hip_atomic_load(p, __ATOMIC_RELAXED, __HIP_MEMORY_SCOPE_AGENT); }
__device__ __forceinline__ unsigned xb_add(unsigned* p, unsigned v) { return __hip_atomic_fetch_add(p, v, __ATOMIC_RELAXED, __HIP_MEMORY_SCOPE_AGENT); }
__device__ __forceinline__ unsigned xb_xcc_id() { return (unsigned)__builtin_amdgcn_s_getreg((3 << 11) | 20) & 0xFu; }
#define XB_SPIN(cond, bar) do { unsigned _sp = 0; while (cond) { __builtin_amdgcn_s_sleep(1); \
    if ((++_sp & 255u) == 0u) { if (xb_ld(&(bar)[XB_TMO])) break; if (_sp > XB_SPIN_CAP) { atomicAdd(&(bar)[XB_TMO], 1u); break; } } } } while (0)

struct XcdBarrier {
    unsigned* bar; unsigned x;
    volatile LAS unsigned* st;
};

__device__ __forceinline__ XcdBarrier xcd_barrier_post(unsigned* bar, volatile LAS unsigned* st) {
    XcdBarrier b; b.bar = bar; b.x = xb_xcc_id(); b.st = st;
    if (TID() == 0) (void)xb_add(&bar[XB_XCNT(b.x)], 1u);
    return b;
}
__device__ __forceinline__ void xcd_barrier_complete(unsigned* bar, unsigned x, unsigned& nloc, unsigned& nx) {
    const unsigned G = gridDim.x * gridDim.y * gridDim.z;
    unsigned sum, cnt, mine, sp = 0u;
    for (;;) {
        sum = 0u; cnt = 0u; mine = 0u;
#pragma unroll
        for (unsigned j = 0; j < 16; ++j) { const unsigned c = xb_ld(&bar[XB_XCNT(j)]); sum += c; cnt += (c > 0u) ? 1u : 0u; mine = (j == x) ? c : mine; }
        if (sum == G) break;
        __builtin_amdgcn_s_sleep(1);
        if ((++sp & 255u) == 0u) { if (xb_ld(&bar[XB_TMO])) break; if (sp > XB_SPIN_CAP) { atomicAdd(&bar[XB_TMO], 1u); break; } }
    }
    nloc = mine > 0u ? mine : 1u; nx = cnt > 0u ? cnt : 1u;
}

__device__ __forceinline__ void xcd_barrier(const XcdBarrier& b) {
    asm volatile("s_waitcnt vmcnt(0)" ::: "memory");
    __syncthreads();
    if (TID() == 0) {
        unsigned* bar = b.bar;
        __builtin_amdgcn_s_waitcnt(0);
        unsigned nloc = b.st[0], nx = b.st[1];
        if (nloc == 0u) { xcd_barrier_complete(bar, b.x, nloc, nx); b.st[0] = nloc; b.st[1] = nx; }
        const unsigned old = xb_add(&bar[XB_XSUB(b.x)], 1u);
        const unsigned gen = old / nloc;
        if (old + 1u == (gen + 1u) * nloc) {
            __builtin_amdgcn_fence(__ATOMIC_RELEASE, "agent");
            asm volatile("s_waitcnt vmcnt(0)" ::: "memory");
            const unsigned og = xb_add(&bar[XB_TOP], 1u);
            const unsigned tg = og / nx;
            if (og + 1u == (tg + 1u) * nx) xb_add(&bar[XB_TOPGEN], 1u);
            else XB_SPIN(xb_ld(&bar[XB_TOPGEN]) == tg, bar);
            __builtin_amdgcn_fence(__ATOMIC_ACQUIRE, "agent");
            xb_add(&bar[XB_XGEN(b.x)], 1u);
            asm volatile("s_waitcnt vmcnt(0)" ::: "memory");
        } else {
            XB_SPIN(xb_ld(&bar[XB_XGEN(b.x)]) == gen, bar);
            __builtin_amdgcn_fence(__ATOMIC_ACQUIRE, "agent");
            asm volatile("s_waitcnt vmcnt(0)" ::: "memory");
        }
    }
    __syncthreads();
}

namespace pg8 {
#define PG8_LAS __attribute__((address_space(3)))
typedef unsigned short bf16_t;
typedef short bf16x8 __attribute__((ext_vector_type(8)));
typedef float f32x4 __attribute__((ext_vector_type(4)));
typedef unsigned u32x4 __attribute__((ext_vector_type(4)));
constexpr int BM = 256, BK = 64, HALF = 128, HTB = HALF * BK * 2  , STAGE_BYTES = 8 * HTB, NXCD = 8, WGM = 8;

__host__ __device__ __forceinline__ int lds_byte(int r, int c) { const int st = (r >> 4) * 2 + (c >> 5), rr = r & 15, cc = c & 31, ob = rr * 64 + cc * 2; return st * 1024 + (ob ^ (((ob >> 9) & 1) << 5)); }
__host__ __device__ __forceinline__ void stage_rc(int b, int& R, int& C) { const int st = b / 1024, sb = b % 1024, swz = sb ^ (((sb >> 9) & 1) << 5); R = (st >> 1) * 16 + swz / 64; C = (st & 1) * 32 + (swz % 64) / 2; }
__host__ __device__ __forceinline__ int perm32(int rho) { const int n = rho >> 4, i = rho & 15; return 8 * (i >> 2) + 4 * n + (i & 3); }

struct Unit { int pm, pn; };
struct Gemm { const bf16_t* A; const bf16_t* Bt; int M, N, K; };

struct StaticOrder {
    int nM, nN, nwg, G, c;
    __host__ __device__ void init(int M, int N, int G_, int c_) { nM = M / BM; nN = N / BM; nwg = nM * nN; G = G_; c = c_; }
    __host__ __device__ bool next(int i, Unit& u) const {
        const long L = (long)i * G + c; if (L >= nwg) return false;
        int wgid = (int)L; { const int q = nwg / NXCD, r = nwg % NXCD, xcd = wgid % NXCD, off = wgid / NXCD; wgid = (xcd < r ? xcd * (q + 1) : r * (q + 1) + (xcd - r) * q) + off; }
        const int nig = WGM * nN, gid = wgid / nig, fm = gid * WGM, gsz = (nM - fm) < WGM ? (nM - fm) : WGM;
        u.pm = fm + ((wgid % nig) % gsz); u.pn = (wgid % nig) / gsz; return true;
    }
    __device__ __forceinline__ void a_ready(const Unit&) const {}
    __device__ __forceinline__ void done(const Unit&) const {}
};

__device__ __forceinline__ unsigned cvt_pk_bf16(float lo, float hi) { unsigned r; asm volatile("v_cvt_pk_bf16_f32 %0, %1, %2" : "=v"(r) : "v"(lo), "v"(hi)); return r; }
struct EpiF32 {
    static constexpr bool PERM = false, AFTER_DRAIN = false;
    float* C; int ldc; const float* bias;
    __device__ __forceinline__ void operator()(const f32x4 (&acc)[2][2][4][2], const Unit& u, int wr, int wc, int fr, int fq) const {
        const int row0 = u.pm * BM + wr * 64 + fr, col0 = u.pn * BM + wc * 32 + 4 * fq;
        f32x4 bv[2][2];
#pragma unroll
        for (int bj = 0; bj < 2; ++bj)
#pragma unroll
            for (int n = 0; n < 2; ++n) bv[bj][n] = bias ? *(const f32x4*)(bias + col0 + bj * HALF + n * 16) : (f32x4){0.f, 0.f, 0.f, 0.f};
#pragma unroll
        for (int ai = 0; ai < 2; ++ai)
#pragma unroll
            for (int m = 0; m < 4; ++m) { float* rowp = C + (size_t)(row0 + ai * HALF + m * 16) * ldc + col0;
#pragma unroll
                for (int bj = 0; bj < 2; ++bj)
#pragma unroll
                    for (int n = 0; n < 2; ++n) *(f32x4*)(rowp + bj * HALF + n * 16) = acc[ai][bj][m][n] + bv[bj][n]; }
    }
};
template <class Epi, class Sched, bool STAMP = false>
__device__ __forceinline__ void gemm_phase(PG8_LAS unsigned char* lds, const Gemm g, const Sched& S, const Epi& E, unsigned long long* stamps) {
    int tid_ = TID(); asm volatile("" : "+v"(tid_));
    const int tid = tid_, wid = __builtin_amdgcn_readfirstlane(tid >> 6), lane = tid & 63, wr = wid >> 2, wc = wid & 3, fr = lane & 15, fq = lane >> 4;
    const int K = g.K, nt = K / BK;
    int ts_lo = 0, ts_hi = 0, nts = 0; const unsigned long long rt_entry = STAMP ? (unsigned long long)wall_clock64() : 0ull;
#define PG8_STAMP() do { if (STAMP && wid == 0 && nts < 64) { const unsigned long long _c = (unsigned long long)clock64(); \
        ts_lo = (lane == nts) ? (int)(unsigned)_c : ts_lo; ts_hi = (lane == nts) ? (int)(unsigned)(_c >> 32) : ts_hi; ++nts; } } while (0)
    PG8_STAMP();
    unsigned voffA[2], voffB[2];
#pragma unroll
    for (int i = 0; i < 2; ++i) { int R, C; stage_rc(tid * 16 + i * 8192, R, C); const int Rb = Epi::PERM ? ((R & ~31) + perm32(R & 31)) : R;
        voffA[i] = (unsigned)(R * K + C) * 2u; voffB[i] = (unsigned)(Rb * K + C) * 2u; }
    const size_t kstep = (size_t)(BK * 2);
    const size_t hstep = (size_t)HALF * K * 2;
    const size_t tstep = 2 * hstep;
    const unsigned ldsw = (unsigned)wid * 1024u;
    const int aoff = lds_byte(wr * 64 + fr, fq * 8), boff = lds_byte(wc * 32 + fr, fq * 8);
#define PG8_SA(b, h) (((b) * 2 + (h)) * HTB)
#define PG8_SB(b, h) ((4 + (b) * 2 + (h)) * HTB)
#define PG8_STAGE(bufoff, gbase, voff) do { _Pragma("unroll") for (int _i = 0; _i < 2; ++_i) \
        __builtin_amdgcn_global_load_lds((const unsigned*)((const char*)(gbase) + (voff)[_i]), (PG8_LAS unsigned*)(lds + (bufoff) + ldsw + _i * 8192), 16, 0, 0); } while (0)
#define PG8_LDA(dst, b, h) do { _Pragma("unroll") for (int m = 0; m < 4; ++m) _Pragma("unroll") for (int k = 0; k < 2; ++k) dst[m][k] = *(const PG8_LAS bf16x8*)(lds + PG8_SA(b, h) + aoff + m * 2048 + k * 1024); } while (0)
#define PG8_LDB(dst, b, h) do { _Pragma("unroll") for (int n = 0; n < 2; ++n) _Pragma("unroll") for (int k = 0; k < 2; ++k) dst[n][k] = *(const PG8_LAS bf16x8*)(lds + PG8_SB(b, h) + boff + n * 2048 + k * 1024); } while (0)
#define PG8_MMA(ai, bj, At, Bt) do { __builtin_amdgcn_s_setprio(1); _Pragma("unroll") for (int m = 0; m < 4; ++m) _Pragma("unroll") for (int n = 0; n < 2; ++n) _Pragma("unroll") for (int k = 0; k < 2; ++k) \
        acc[ai][bj][m][n] = __builtin_amdgcn_mfma_f32_16x16x32_bf16(Bt[n][k], At[m][k], acc[ai][bj][m][n], 0, 0, 0); __builtin_amdgcn_s_setprio(0); } while (0)
#define PG8_WAIT_V(n) asm volatile("s_waitcnt vmcnt(" #n ")" ::: "memory")
#define PG8_WAIT_L(n) asm volatile("s_waitcnt lgkmcnt(" #n ")" ::: "memory")
#define PG8_BAR __builtin_amdgcn_s_barrier()
#define PG8_SCHED __builtin_amdgcn_sched_barrier(0)
    Unit cur, nxt; int ui = 0;
    if (!S.next(0, cur)) return;
    f32x4 acc[2][2][4][2];
#pragma unroll
    for (int a = 0; a < 2; ++a)
#pragma unroll
        for (int b = 0; b < 2; ++b)
#pragma unroll
            for (int m = 0; m < 4; ++m)
#pragma unroll
                for (int n = 0; n < 2; ++n) acc[a][b][m][n] = (f32x4){0.f, 0.f, 0.f, 0.f};
    bf16x8 At[4][2], B0[2][2], B1[2][2];
    const char* cA = (const char*)g.A + (size_t)cur.pm * tstep; const char* cB = (const char*)g.Bt + (size_t)cur.pn * tstep;
    S.a_ready(cur);
    PG8_STAGE(PG8_SB(0, 0), cB, voffB); PG8_STAGE(PG8_SA(0, 0), cA, voffA); PG8_STAGE(PG8_SB(0, 1), cB + hstep, voffB); PG8_STAGE(PG8_SA(0, 1), cA + hstep, voffA);
    if (wr == 1) PG8_BAR;
    PG8_WAIT_V(4); PG8_BAR;
    PG8_STAGE(PG8_SB(1, 0), cB + kstep, voffB); PG8_STAGE(PG8_SA(1, 0), cA + kstep, voffA); PG8_STAGE(PG8_SB(1, 1), cB + hstep + kstep, voffB);
    PG8_WAIT_V(6); PG8_BAR;
    PG8_STAMP();
    for (;;) {
        const bool has_next = S.next(ui + 1, nxt);
        const char* nA = has_next ? (const char*)g.A + (size_t)nxt.pm * tstep : cA; const char* nB = has_next ? (const char*)g.Bt + (size_t)nxt.pn * tstep : cB;
        for (int t = 0; t < nt; t += 2) {
            const bool last = (t == nt - 2);
            const char* a1 = cA + (size_t)(t + 1) * kstep;
            const char* a2 = last ? nA : cA + (size_t)(t + 2) * kstep; const char* b2 = last ? nB : cB + (size_t)(t + 2) * kstep;
            const char* a3 = a2 + kstep; const char* b3 = b2 + kstep;
            if (last && has_next) S.a_ready(nxt);
            PG8_LDB(B0, 0, 0); PG8_SCHED; PG8_LDA(At, 0, 0); PG8_STAGE(PG8_SA(1, 1), a1 + hstep, voffA);
            PG8_WAIT_L(8); PG8_BAR; PG8_WAIT_L(0); PG8_MMA(0, 0, At, B0); PG8_BAR; PG8_SCHED;
            PG8_LDB(B1, 0, 1); PG8_STAGE(PG8_SB(0, 0), b2, voffB);
            PG8_BAR; PG8_WAIT_L(0); PG8_MMA(0, 1, At, B1); PG8_BAR;
            PG8_LDA(At, 0, 1); PG8_STAGE(PG8_SA(0, 0), a2, voffA);
            PG8_BAR; PG8_WAIT_L(0); PG8_MMA(1, 0, At, B0); PG8_BAR; PG8_SCHED;
            PG8_STAGE(PG8_SB(0, 1), b2 + hstep, voffB);
            PG8_WAIT_V(6); PG8_BAR; PG8_MMA(1, 1, At, B1); PG8_BAR;
            PG8_LDB(B0, 1, 0); PG8_SCHED; PG8_LDA(At, 1, 0); PG8_STAGE(PG8_SA(0, 1), a2 + hstep, voffA);
            PG8_WAIT_L(8); PG8_BAR; PG8_WAIT_L(0); PG8_MMA(0, 0, At, B0); PG8_BAR; PG8_SCHED;
            PG8_LDB(B1, 1, 1); PG8_STAGE(PG8_SB(1, 0), b3, voffB);
            PG8_BAR; PG8_WAIT_L(0); PG8_MMA(0, 1, At, B1); PG8_BAR;
            PG8_LDA(At, 1, 1); PG8_STAGE(PG8_SA(1, 0), a3, voffA);
            PG8_BAR; PG8_WAIT_L(0); PG8_MMA(1, 0, At, B0); PG8_BAR; PG8_SCHED;
            PG8_STAGE(PG8_SB(1, 1), b3 + hstep, voffB);
            PG8_WAIT_V(6); PG8_BAR; PG8_MMA(1, 1, At, B1); PG8_BAR;
        }
        PG8_STAMP();
        if constexpr (!Epi::AFTER_DRAIN) { E(acc, cur, wr, wc, fr, fq); S.done(cur); }
        PG8_STAMP();
        if (!has_next) break;
#pragma unroll
        for (int a = 0; a < 2; ++a)
#pragma unroll
            for (int b = 0; b < 2; ++b)
#pragma unroll
                for (int m = 0; m < 4; ++m)
#pragma unroll
                    for (int n = 0; n < 2; ++n) acc[a][b][m][n] = (f32x4){0.f, 0.f, 0.f, 0.f};
        cur = nxt; cA = nA; cB = nB; ++ui;
    }
    PG8_WAIT_V(0);
    if (wr == 0) PG8_BAR;
    PG8_BAR;
    if constexpr (Epi::AFTER_DRAIN) { E.fused(acc, cur, wr, wc, fr, fq, lds, wid, lane); S.done(cur); }
    PG8_STAMP();
    if (STAMP && wid == 0) { stamps[lane] = lane < nts ? (((unsigned long long)(unsigned)ts_hi << 32) | (unsigned)ts_lo) : 0ull;
        if (lane == 62) stamps[62] = rt_entry; if (lane == 63) stamps[63] = (unsigned long long)wall_clock64(); }
#undef PG8_STAMP
#undef PG8_SA
#undef PG8_SB
#undef PG8_STAGE
#undef PG8_LDA
#undef PG8_LDB
#undef PG8_MMA
#undef PG8_WAIT_V
#undef PG8_WAIT_L
#undef PG8_BAR
#undef PG8_SCHED
}
}
#endif

#ifndef HOST_TEST
#include <cstdio>
#define FRAG_OFF(row_, k_, KS_) ((((((row_) >> 4) * (KS_) + ((k_) >> 5)) * 64 + (((k_) >> 3) & 3) * 16 + ((row_) & 15)) * 8) + ((k_) & 7))
namespace pg8 {
struct EpiAddF32 {
    static constexpr bool PERM = false, AFTER_DRAIN = false;
    float* C; int ldc;
    __device__ __forceinline__ void operator()(const f32x4 (&acc)[2][2][4][2], const Unit& u, int wr, int wc, int fr, int fq) const {
        const int row0 = u.pm * BM + wr * 64 + fr, col0 = u.pn * BM + wc * 32 + 4 * fq;
#pragma unroll
        for (int ai = 0; ai < 2; ++ai)
#pragma unroll
            for (int m = 0; m < 4; ++m) { float* rowp = C + (size_t)(row0 + ai * HALF + m * 16) * ldc + col0;
#pragma unroll
                for (int bj = 0; bj < 2; ++bj)
#pragma unroll
                    for (int n = 0; n < 2; ++n) { f32x4* p = (f32x4*)(rowp + bj * HALF + n * 16); *p = *p + acc[ai][bj][m][n]; } }
    }
};
struct EpiRelu2Bf16 {
    static constexpr bool PERM = true, AFTER_DRAIN = false;
    bf16_t* O; int ldc;
    __device__ __forceinline__ void operator()(const f32x4 (&acc)[2][2][4][2], const Unit& u, int wr, int wc, int fr, int fq) const {
        const int row0 = u.pm * BM + wr * 64 + fr, col0 = u.pn * BM + wc * 32 + 8 * fq;
#pragma unroll
        for (int ai = 0; ai < 2; ++ai)
#pragma unroll
            for (int m = 0; m < 4; ++m) { bf16_t* rowp = O + (size_t)(row0 + ai * HALF + m * 16) * ldc + col0;
#pragma unroll
                for (int bj = 0; bj < 2; ++bj) { f32x4 v0 = acc[ai][bj][m][0], v1 = acc[ai][bj][m][1];
#pragma unroll
                    for (int j = 0; j < 4; ++j) { const float r0 = fmaxf(v0[j], 0.f), r1 = fmaxf(v1[j], 0.f); v0[j] = r0 * r0; v1[j] = r1 * r1; }
                    u32x4 w; w.x = cvt_pk_bf16(v0[0], v0[1]); w.y = cvt_pk_bf16(v0[2], v0[3]); w.z = cvt_pk_bf16(v1[0], v1[1]); w.w = cvt_pk_bf16(v1[2], v1[3]);
                    *(u32x4*)(rowp + bj * HALF) = w; } }
    }
};

__device__ __forceinline__ float epi_shfl_xor(float v, int o, int lane) { return __builtin_bit_cast(float, __builtin_amdgcn_ds_bpermute((lane ^ o) << 2, __builtin_bit_cast(int, v))); }
__device__ __forceinline__ float row_rs(const unsigned long long* ss, int row) { return FRSQ((float)ss[row] * (5.9604644775390625e-08f / D) + EPS); }
struct EpiF32S {
    static constexpr bool PERM = true, AFTER_DRAIN = false;
    float* C; int ldc; const unsigned long long* ss;
    __device__ __forceinline__ void operator()(const f32x4 (&acc)[2][2][4][2], const Unit& u, int wr, int wc, int fr_in, int fq_in) const {
        int fr = fr_in, fq = fq_in; asm volatile("" : "+v"(fr), "+v"(fq));
        const int row0 = u.pm * BM + wr * 64 + fr, col0 = u.pn * BM + wc * 32 + 8 * fq;
#pragma unroll
        for (int ai = 0; ai < 2; ++ai)
#pragma unroll
            for (int m = 0; m < 4; ++m) { const int row = row0 + ai * HALF + m * 16; const float rs = row_rs(ss, row); float* rowp = C + (size_t)row * ldc + col0;
#pragma unroll
                for (int bj = 0; bj < 2; ++bj) { *(f32x4*)(rowp + bj * HALF) = acc[ai][bj][m][0] * rs; *(f32x4*)(rowp + bj * HALF + 4) = acc[ai][bj][m][1] * rs; } }
    }
};
struct EpiRelu2S {
    static constexpr bool PERM = true, AFTER_DRAIN = false;
    bf16_t* O; int ldc; const unsigned long long* ss;
    __device__ __forceinline__ void operator()(const f32x4 (&acc)[2][2][4][2], const Unit& u, int wr, int wc, int fr_in, int fq_in) const {
        int fr = fr_in, fq = fq_in; asm volatile("" : "+v"(fr), "+v"(fq));
        const int row0 = u.pm * BM + wr * 64 + fr, col0 = u.pn * BM + wc * 32 + 8 * fq;
#pragma unroll
        for (int ai = 0; ai < 2; ++ai)
#pragma unroll
            for (int m = 0; m < 4; ++m) { const int row = row0 + ai * HALF + m * 16; const float rs = row_rs(ss, row); bf16_t* rowp = O + (size_t)row * ldc + col0;
#pragma unroll
                for (int bj = 0; bj < 2; ++bj) { f32x4 v0 = acc[ai][bj][m][0] * rs, v1 = acc[ai][bj][m][1] * rs;
#pragma unroll
                    for (int j = 0; j < 4; ++j) { const float r0 = fmaxf(v0[j], 0.f), r1 = fmaxf(v1[j], 0.f); v0[j] = r0 * r0; v1[j] = r1 * r1; }
                    u32x4 w; w.x = cvt_pk_bf16(v0[0], v0[1]); w.y = cvt_pk_bf16(v0[2], v0[3]); w.z = cvt_pk_bf16(v1[0], v1[1]); w.w = cvt_pk_bf16(v1[2], v1[3]);
                    *(u32x4*)(rowp + bj * HALF) = w; } }
    }
};
struct EpiAddN {
    static constexpr bool PERM = true, AFTER_DRAIN = false;
    float* C; int ldc; bf16_t* XB; unsigned long long* ss;
    __device__ __forceinline__ void operator()(const f32x4 (&acc)[2][2][4][2], const Unit& u, int wr, int wc, int fr_in, int fq_in) const {
        int fr = fr_in, fq = fq_in; asm volatile("" : "+v"(fr), "+v"(fq));
        const int row0 = u.pm * BM + wr * 64 + fr, col0 = u.pn * BM + wc * 32 + 8 * fq, lane = fq * 16 + fr;
#pragma unroll
        for (int ai = 0; ai < 2; ++ai)
#pragma unroll
            for (int m = 0; m < 4; ++m) { const int row = row0 + ai * HALF + m * 16; float* rowp = C + (size_t)row * ldc + col0; bf16_t* xbp = XB + (size_t)row * ldc + col0; float q = 0.f;
#pragma unroll
                for (int bj = 0; bj < 2; ++bj) { f32x4* p = (f32x4*)(rowp + bj * HALF); const f32x4 v0 = p[0] + acc[ai][bj][m][0], v1 = p[1] + acc[ai][bj][m][1]; p[0] = v0; p[1] = v1;
                    q += ((v0[0] * v0[0] + v0[1] * v0[1]) + (v0[2] * v0[2] + v0[3] * v0[3])) + ((v1[0] * v1[0] + v1[1] * v1[1]) + (v1[2] * v1[2] + v1[3] * v1[3]));
                    u32x4 w; w.x = cvt_pk_bf16(v0[0], v0[1]); w.y = cvt_pk_bf16(v0[2], v0[3]); w.z = cvt_pk_bf16(v1[0], v1[1]); w.w = cvt_pk_bf16(v1[2], v1[3]); *(u32x4*)(xbp + bj * HALF) = w; }
                q += epi_shfl_xor(q, 16, lane); q += epi_shfl_xor(q, 32, lane);
                if (fq == 0) __hip_atomic_fetch_add(ss + row, (unsigned long long)(q * 16777216.0f), __ATOMIC_RELAXED, __HIP_MEMORY_SCOPE_AGENT); }
    }
};
struct EpiAttS {
    static constexpr bool PERM = true, AFTER_DRAIN = false;
    unsigned char* ws; float* out; const unsigned long long* ss; int ai_;
    __device__ __forceinline__ void operator()(const f32x4 (&acc)[2][2][4][2], const Unit& u, int wr, int wc, int fr_in, int fq_in) const {
        int fr = fr_in, fq = fq_in; asm volatile("" : "+v"(fr), "+v"(fq));
        float* P = (float*)(ws + WS_P); constexpr int ldc = LDP; bf16_t* QB = (bf16_t*)(ws + WS_QB); bf16_t* KB = (bf16_t*)(ws + WS_KB); bf16_t* VB = (bf16_t*)(ws + WS_VB); bf16_t* QIB = (bf16_t*)(ws + WS_QIB); bf16_t* KIB = (bf16_t*)(ws + WS_KIB);
        const int row0 = u.pm * BM + wr * 64 + fr; float rsv[2][4];
#pragma unroll
        for (int ai = 0; ai < 2; ++ai)
#pragma unroll
            for (int m = 0; m < 4; ++m) rsv[ai][m] = row_rs(ss, row0 + ai * HALF + m * 16);
#pragma unroll
        for (int bj = 0; bj < 2; ++bj) { const int cb = u.pn * BM + bj * HALF + wc * 32;
                bf16_t* bdst; int bld, bc; float* odst0 = nullptr; float* odst1 = nullptr; int old_ = 0;
                if (cb < AO_K) { bdst = QB; bld = D; bc = cb; }
                else if (cb < AO_V) { bdst = KB; bld = 256; bc = cb - AO_K; odst0 = out + O_KP + (size_t)ai_ * MP * 256 + bc; odst1 = out + O_KS + (size_t)ai_ * MS * 256 + bc; old_ = 256; }
                else if (cb < AO_QI) { bdst = VB; bld = 256; bc = cb - AO_V; odst0 = out + O_VP + (size_t)ai_ * MP * 256 + bc; odst1 = out + O_VS + (size_t)ai_ * MS * 256 + bc; old_ = 256; }
                else if (cb < AO_KI) { bdst = QIB; bld = 512; bc = cb - AO_QI; }
                else if (cb < AO_WI) { bdst = KIB; bld = -1; bc = cb - AO_KI;     odst0 = out + O_KIP + (size_t)ai_ * MP * 64 + bc; odst1 = out + O_KIS + (size_t)ai_ * MS * 64 + bc; old_ = 64; }
                else { bdst = nullptr; bld = 0; bc = 0; }
                const bool keepP = (u.pm * BM >= MP) || (cb >= AO_WI);
#pragma unroll
                for (int ai = 0; ai < 2; ++ai)
#pragma unroll
                    for (int m = 0; m < 4; ++m) { const int row = row0 + ai * HALF + m * 16; const f32x4 v0 = acc[ai][bj][m][0] * rsv[ai][m], v1 = acc[ai][bj][m][1] * rsv[ai][m];
                        if (keepP) { float* pp = P + (size_t)row * ldc + cb + 8 * fq; *(f32x4*)pp = v0; *(f32x4*)(pp + 4) = v1; }
                        if (bdst != nullptr && row < MT) { bf16_t* bp_ = bld >= 0 ? bdst + (size_t)row * bld + bc + 8 * fq : bdst + (size_t)(row >> 4) * 1024 + FRAG_OFF(row & 15, bc + 8 * fq, 2);
                            u32x4 w; w.x = cvt_pk_bf16(v0[0], v0[1]); w.y = cvt_pk_bf16(v0[2], v0[3]); w.z = cvt_pk_bf16(v1[0], v1[1]); w.w = cvt_pk_bf16(v1[2], v1[3]); *(u32x4*)bp_ = w;
                            if (odst0 != nullptr) { float* op = (row < MP ? odst0 + (size_t)row * old_ : odst1 + (size_t)(row - MP) * old_) + 8 * fq; *(f32x4*)op = v0; *(f32x4*)(op + 4) = v1; } } } }
    }
};
}

constexpr int NTHREADS = 512, LDS_BYTES = 147456, LDS_MISC = 131072;
typedef float f32x4_t __attribute__((ext_vector_type(4)));
__device__ __forceinline__ float shfl_xor_l(float v, int o, int lane) { return __builtin_bit_cast(float, __builtin_amdgcn_ds_bpermute((lane ^ o) << 2, __builtin_bit_cast(int, v))); }
__device__ __forceinline__ void ph_rmsnorm(const Args& a, const float* g) {
    static_assert(D == 1024, "device rmsnorm is written for D = 1024");
    const float* X = (const float*)(a.ws + WS_X); bf16* XN = (bf16*)(a.ws + WS_XN);
    int tx_ = TID(); asm volatile("" : "+v"(tx_));
    const int lane = tx_ & 63, wv = blockIdx.x * (NTHREADS >> 6) + (tx_ >> 6), nwv = gridDim.x * (NTHREADS >> 6);
    f32x4_t gv[4];
#pragma unroll
    for (int i = 0; i < 4; ++i) gv[i] = *(const f32x4_t*)(g + (i * 64 + lane) * 4);
    for (int m = wv; m < MPAD; m += nwv) { f32x4_t xv[4]; float ss = 0.f;
#pragma unroll
        for (int i = 0; i < 4; ++i) { xv[i] = *(const f32x4_t*)(X + (size_t)m * D + (i * 64 + lane) * 4); ss += xv[i][0] * xv[i][0] + xv[i][1] * xv[i][1] + xv[i][2] * xv[i][2] + xv[i][3] * xv[i][3]; }
#pragma unroll
        for (int o = 32; o >= 1; o >>= 1) ss += shfl_xor_l(ss, o, lane);
        const float r = FRSQ(ss * (1.0f / D) + EPS);
#pragma unroll
        for (int i = 0; i < 4; ++i) { const f32x4_t y = xv[i] * r * gv[i]; uint2 w; w.x = pg8::cvt_pk_bf16(y[0], y[1]); w.y = pg8::cvt_pk_bf16(y[2], y[3]); *(uint2*)(XN + (size_t)m * D + (i * 64 + lane) * 4) = w; } }
}

__device__ __forceinline__ void ph_prep_x(const Args& a) {
    float* X = (float*)(a.ws + WS_X); bf16* XB = (bf16*)(a.ws + WS_XN); unsigned long long* SS = (unsigned long long*)(a.ws + WS_SS);
    int tx_ = TID(); asm volatile("" : "+v"(tx_));
    const int lane = tx_ & 63, wv = blockIdx.x * (NTHREADS >> 6) + (tx_ >> 6), nwv = gridDim.x * (NTHREADS >> 6);
    for (int m = wv; m < MPAD; m += nwv) { const float* src = m < MP ? a.in[I_XP] + (size_t)m * D : a.in[I_XS] + (size_t)(m - MP) * D; float ss = 0.f;
#pragma unroll
        for (int i = 0; i < 4; ++i) { f32x4_t v = {0.f, 0.f, 0.f, 0.f}; if (m < MT) v = *(const f32x4_t*)(src + (i * 64 + lane) * 4);
            *(f32x4_t*)(X + (size_t)m * D + (i * 64 + lane) * 4) = v; ss += v[0] * v[0] + v[1] * v[1] + v[2] * v[2] + v[3] * v[3];
            uint2 w; w.x = pg8::cvt_pk_bf16(v[0], v[1]); w.y = pg8::cvt_pk_bf16(v[2], v[3]); *(uint2*)(XB + (size_t)m * D + (i * 64 + lane) * 4) = w; }
#pragma unroll
        for (int o = 32; o >= 1; o >>= 1) ss += shfl_xor_l(ss, o, lane);
        if (lane == 0) SS[m] = (unsigned long long)(ss * 16777216.0f); }
}
__device__ __forceinline__ void ph_final(const Args& a) {
    const float* X = (const float*)(a.ws + WS_X); const float* g = a.in[I_NFIN];
    int tx_ = TID(); asm volatile("" : "+v"(tx_));
    const int lane = tx_ & 63, wv = blockIdx.x * (NTHREADS >> 6) + (tx_ >> 6), nwv = gridDim.x * (NTHREADS >> 6);
    f32x4_t gv[4];
#pragma unroll
    for (int i = 0; i < 4; ++i) gv[i] = *(const f32x4_t*)(g + (i * 64 + lane) * 4);
    for (int m = wv; m < MT; m += nwv) { f32x4_t xv[4]; float ss = 0.f;
#pragma unroll
        for (int i = 0; i < 4; ++i) { xv[i] = *(const f32x4_t*)(X + (size_t)m * D + (i * 64 + lane) * 4); ss += xv[i][0] * xv[i][0] + xv[i][1] * xv[i][1] + xv[i][2] * xv[i][2] + xv[i][3] * xv[i][3]; }
#pragma unroll
        for (int o = 32; o >= 1; o >>= 1) ss += shfl_xor_l(ss, o, lane);
        const float r = FRSQ(ss * (1.0f / D) + EPS);
        float* orow = a.out + (m < MP ? O_YP + (size_t)m * D : O_YS + (size_t)(m - MP) * D);
#pragma unroll
        for (int i = 0; i < 4; ++i) *(f32x4_t*)(orow + (i * 64 + lane) * 4) = xv[i] * r * gv[i]; }
}


#ifndef DIAG_WRITE_O
#define DIAG_WRITE_O 1
#define DIAG_WRITE_S 1
#endif
typedef short bf16x8_t __attribute__((ext_vector_type(8)));
typedef unsigned u32x2_t __attribute__((ext_vector_type(2)));
typedef unsigned u32x4_t __attribute__((ext_vector_type(4)));
typedef float f32x2_t __attribute__((ext_vector_type(2)));
typedef __bf16 bf16x2n_t __attribute__((ext_vector_type(2)));
__device__ __forceinline__ unsigned pk_bf16(float lo, float hi) { const f32x2_t v = {lo, hi}; const bf16x2n_t r = __builtin_convertvector(v, bf16x2n_t); return __builtin_bit_cast(unsigned, r); }
__device__ __forceinline__ void ph_dn_b(const Args& a, int r, LAS unsigned char* lds) {
    const float* UT = (const float*)(a.ws + WS_UT); const bf16* WN = (const bf16*)(a.ws + WS_WN); const bf16* QG = (const bf16*)(a.ws + WS_QG); const bf16* AT = (const bf16*)(a.ws + WS_AT);
    const bf16* KDT = (const bf16*)(a.ws + WS_KDT); const float* GL = (const float*)(a.ws + WS_GL); float* ODN = (float*)(a.ws + WS_ODN); float* DUMP = (float*)(a.ws + WS_SCR);
    int tid_ = TID(); asm volatile("" : "+v"(tid_));
    const int tid = tid_, wid = __builtin_amdgcn_readfirstlane(tid >> 6), lane = tid & 63, fr = lane & 15, fq = lane >> 4;
    constexpr int STS = 136, VTS = 72;
    LAS bf16* ST = (LAS bf16*)lds; LAS bf16* VT = (LAS bf16*)(lds + 16 * STS * 2);
    const bool vw = wid < 4; const float uf = vw ? 1.0f : 0.0f;
    for (int unit = blockIdx.x; unit < NB * DNH * 8; unit += gridDim.x) {
        const int slice = unit & 7, bh = unit >> 3, b = bh / DNH, hd = bh % DNH, c0 = slice * 16;
        f32x4_t accS = {0.f, 0.f, 0.f, 0.f};
        for (int i = tid; i < 16 * STS; i += NTHREADS) ST[i] = (bf16)0;
        __syncthreads();
        const int i0 = (wid & 3) * 16;
        const bf16* p1 = (vw ? WN : QG) + (size_t)bh * NC * 8192 + (size_t)((wid & 3) * 4) * 512 + lane * 8;
        const bf16* p2 = AT + (size_t)bh * NC * 4096 + (size_t)((wid & 3) * 2) * 512 + lane * 8;
        const bf16* p3 = KDT + (size_t)bh * NC * 8192 + (size_t)(wid * 2) * 512 + lane * 8;
        const float* pu = UT + (size_t)bh * NC * 8192 + (size_t)(slice * 4 + (wid & 3)) * 256 + lane * 4; const float* pg = GL + (size_t)bh * NC;
        LAS bf16* vtw = VT + (vw ? 0 : 16 * VTS) + fr * VTS + i0 + 4 * fq;
        float* op = (vw ? DUMP + ((size_t)blockIdx.x * NTHREADS + tid) * 4 - (size_t)0 : ODN + ((size_t)b * SEQ + i0 + 4 * fq) * 512 + hd * 128 + c0 + fr);
        const size_t ostep = vw ? 0 : (size_t)64 * 512, oq = vw ? 1 : 512;
        bf16x8_t s0a1[4], s0a2[2], s0a3[2], s1a1[4], s1a2[2], s1a3[2], s2a1[4], s2a2[2], s2a3[2]; f32x4_t s0u, s1u, s2u; float s0g, s1g, s2g;
#define DNB_LOAD(P_, n_) do { const size_t c_ = (size_t)((n_) < NC ? (n_) : NC - 1); \
            _Pragma("unroll") for (int ks = 0; ks < 4; ++ks) P_##a1[ks] = *(const bf16x8_t*)(p1 + c_ * 8192 + ks * 512); \
            _Pragma("unroll") for (int ks = 0; ks < 2; ++ks) { P_##a2[ks] = *(const bf16x8_t*)(p2 + c_ * 4096 + ks * 512); P_##a3[ks] = *(const bf16x8_t*)(p3 + c_ * 8192 + ks * 512); } \
            P_##u = *(const f32x4_t*)(pu + c_ * 8192); P_##g = pg[c_]; } while (0)
#define DNB_BAR() do { asm volatile("s_waitcnt lgkmcnt(0)" ::: "memory"); __builtin_amdgcn_s_barrier(); asm volatile("" ::: "memory"); } while (0)
#define DNB_STEP(C_, L_, n_) do { f32x4_t acc = C_##u * uf; const float gl = C_##g; bf16x8_t x1[4], x2[2], x3[2]; \
            _Pragma("unroll") for (int ks = 0; ks < 4; ++ks) x1[ks] = C_##a1[ks]; \
            _Pragma("unroll") for (int ks = 0; ks < 2; ++ks) { x2[ks] = C_##a2[ks]; x3[ks] = C_##a3[ks]; } \
            DNB_LOAD(L_, (n_) + 2); \
            bf16x8_t bS[4]; \
            _Pragma("unroll") for (int ks = 0; ks < 4; ++ks) bS[ks] = *(const LAS bf16x8_t*)(ST + fr * STS + ks * 32 + fq * 8); \
            _Pragma("unroll") for (int ks = 0; ks < 4; ++ks) acc = __builtin_amdgcn_mfma_f32_16x16x32_bf16(x1[ks], bS[ks], acc, 0, 0, 0); \
            { u32x2_t w; w.x = pk_bf16(acc[0], acc[1]); w.y = pk_bf16(acc[2], acc[3]); *(LAS u32x2_t*)vtw = w; } \
            DNB_BAR(); \
            bf16x8_t bV[2]; \
            _Pragma("unroll") for (int ks = 0; ks < 2; ++ks) bV[ks] = *(const LAS bf16x8_t*)(VT + fr * VTS + ks * 32 + fq * 8); \
            _Pragma("unroll") for (int ks = 0; ks < 2; ++ks) acc = __builtin_amdgcn_mfma_f32_16x16x32_bf16(x2[ks], bV[ks], acc, 0, 0, 0); \
            { float* o_ = op + (size_t)(n_) * ostep; _Pragma("unroll") for (int q = 0; q < 4; ++q) o_[(size_t)q * oq] = acc[q]; } \
            accS = accS * gl; \
            _Pragma("unroll") for (int ks = 0; ks < 2; ++ks) accS = __builtin_amdgcn_mfma_f32_16x16x32_bf16(x3[ks], bV[ks], accS, 0, 0, 0); \
            { u32x2_t w; w.x = pk_bf16(accS[0], accS[1]); w.y = pk_bf16(accS[2], accS[3]); *(LAS u32x2_t*)(ST + fr * STS + wid * 16 + 4 * fq) = w; } \
            DNB_BAR(); } while (0)
        static_assert(NC % 3 == 2, "the chunk loop is peeled for NC = 3 k + 2");
        DNB_LOAD(s0, 0); DNB_LOAD(s1, 1);
        int n = 0;
        for (; n + 2 < NC; n += 3) { DNB_STEP(s0, s2, n); DNB_STEP(s1, s0, n + 1); DNB_STEP(s2, s1, n + 2); }
        DNB_STEP(s0, s2, n); DNB_STEP(s1, s0, n + 1);
#undef DNB_STEP
#undef DNB_LOAD
        float* sp = a.out + O_SP + ((((size_t)r * NB + b) * DNH + hd) * 128 + wid * 16 + 4 * fq) * 128 + c0 + fr;
#pragma unroll
        for (int q = 0; q < 4; ++q) sp[(size_t)q * 128] = accS[q];
        __syncthreads();
    }
}


template <int NREG> __device__ __forceinline__ void select_row(const float* __restrict__ row, int n, int K, int* __restrict__ out, unsigned lane, LAS unsigned* cand_lds) {
    static_assert(NREG * 64 <= SLD, "row buffer too short");
    lane &= 63u;
    unsigned key[NREG];
#pragma unroll
    for (int i = 0; i < NREG; ++i) { const float f = __builtin_nontemporal_load(row + i * 64u + lane); key[i] = fkey(f) & (0u - ((unsigned)((int)(i * 64u + lane) - n) >> 31)); }
    if (NREG >= 32 && n >= 1024) { unsigned ls = 0u;
        for (int bit = 31; bit >= 0; --bit) { const unsigned cand = ls | (1u << bit); int c = 0;
#pragma unroll
            for (int i = 0; i < NREG; i += 8) c += __builtin_popcountll(__ballot(key[i] >= cand));
            if (c >= 48) ls = cand;
            if (c == 48) break; }
        int c0 = 0;
#pragma unroll
        for (int i = 0; i < NREG; ++i) c0 += __builtin_popcountll(__ballot(key[i] >= ls));
        if (c0 >= K && c0 <= 512) {
            asm volatile("" : "+v"(lane)); lane &= 63u; const unsigned long long bl = (1ull << lane) - 1ull; int base = 0;
            unsigned ls2 = ls; asm volatile("" : "+v"(ls2));
#pragma unroll
            for (int i = 0; i < NREG; ++i) { const bool g = key[i] >= ls2; const unsigned long long mg = __ballot(g);
                const int p = base + __builtin_popcountll(mg & bl); cand_lds[g ? (unsigned)p : 1024u + lane] = key[i]; cand_lds[g ? 512u + p : 1088u + lane] = i * 64u + lane;
                base += __builtin_popcountll(mg); }
            asm volatile("s_waitcnt lgkmcnt(0)" ::: "memory");
            unsigned ck[8], ci[8];
#pragma unroll
            for (int q = 0; q < 8; ++q) { const int p = q * 64 + (int)lane; const bool v = p < c0; ck[q] = v ? cand_lds[p] : 0u; ci[q] = v ? cand_lds[512 + p] : 0u; }
            unsigned lo2 = 0u;
            for (int bit = 31; bit >= 0; --bit) { const unsigned cand = lo2 | (1u << bit); int c = 0;
#pragma unroll
                for (int q = 0; q < 8; ++q) c += __builtin_popcountll(__ballot(ck[q] >= cand));
                if (c >= K) lo2 = cand;
                if (c == K) break; }
            int bg2 = 0;
#pragma unroll
            for (int q = 0; q < 8; ++q) { const bool g = ck[q] > lo2; const unsigned long long mg = __ballot(g);
                out[g ? (unsigned)(bg2 + __builtin_popcountll(mg & bl)) : KMAX + lane] = (int)ci[q]; bg2 += __builtin_popcountll(mg); }
            int be2 = 0;
#pragma unroll
            for (int q = 0; q < 8; ++q) { const bool e = ck[q] == lo2; const unsigned long long me = __ballot(e); const int slot = bg2 + be2 + __builtin_popcountll(me & bl);
                out[(e && slot < K) ? (unsigned)slot : KMAX + lane] = (int)ci[q]; be2 += __builtin_popcountll(me); }
            asm volatile("s_waitcnt lgkmcnt(0)" ::: "memory");
            return; } }
    unsigned lo = 0u;
    for (int bit = 31; bit >= 0; --bit) { const unsigned cand = lo | (1u << bit); int c = 0;
#pragma unroll
        for (int i = 0; i < NREG; ++i) c += __builtin_popcountll(__ballot(key[i] >= cand));
        if (c >= K) lo = cand;
        if (c == K) break; }
    asm volatile("" : "+v"(lane)); lane &= 63u;
    const unsigned long long below = (1ull << lane) - 1ull; int bg = 0;
#pragma unroll
    for (int i = 0; i < NREG; ++i) { const bool g = key[i] > lo; const unsigned long long mg = __ballot(g);
        out[g ? (unsigned)(bg + __builtin_popcountll(mg & below)) : KMAX + lane] = (int)(i * 64u + lane); bg += __builtin_popcountll(mg); }
    const int cg = bg; int be = 0; asm volatile("" : "+v"(lane)); lane &= 63u; const unsigned long long below2 = (1ull << lane) - 1ull;
#pragma unroll
    for (int i = 0; i < NREG; ++i) { const bool e = key[i] == lo; const unsigned long long me = __ballot(e); const int slot = cg + be + __builtin_popcountll(me & below2);
        out[(e && slot < K) ? (unsigned)slot : KMAX + lane] = (int)(i * 64u + lane); be += __builtin_popcountll(me); }
}
__device__ __forceinline__ void ph_select_w(const Args& a, LAS unsigned char* lds) {
    const float* SC = (const float*)(a.ws + WS_SCT); int* IDX = (int*)(a.ws + WS_IDX); int* NSEL = (int*)(a.ws + WS_NSEL);
    int tx_ = TID(); asm volatile("" : "+v"(tx_));
    const int lane0 = tx_ & 63, wv = __builtin_amdgcn_readfirstlane(blockIdx.x * (NTHREADS >> 6) + (tx_ >> 6)), nwv = gridDim.x * (NTHREADS >> 6);
    LAS unsigned* cand = (LAS unsigned*)(lds + (tx_ >> 6) * 4608);
    for (int m = MP + wv; m < MT; m += nwv) { const RowInfo ri = row_info(m); int lane = lane0; asm volatile("" : "+v"(lane));
        const int n = PAST + ri.t + 1, K = TOPK_S; const float* row = SC + (size_t)m * SLD; int* out = IDX + (size_t)m * KROW;
        if (n <= K) { for (int j = lane; j < n; j += 64) out[j] = j; if (lane == 0) NSEL[m] = n; continue; }
        select_row<(SLD / 64)>(row, n, K, out, lane, cand);
        if (lane == 0) NSEL[m] = K; }
}


__device__ __forceinline__ void ph_att_split_dev(const Args& a, int ai, size_t gtid, size_t gsz) {
    const float* P = (const float*)(a.ws + WS_P); bf16* QB = (bf16*)(a.ws + WS_XN); bf16* KB = (bf16*)(a.ws + WS_KB); bf16* VB = (bf16*)(a.ws + WS_VB); bf16* QIB = (bf16*)(a.ws + WS_QIB); bf16* KIB = (bf16*)(a.ws + WS_KIB);
    constexpr int W = AO_WI;
    for (size_t i = gtid; i < (size_t)MT * W; i += gsz) { const int m = (int)(i / W), c = (int)(i % W); const float v = P[(size_t)m * LDP + c];
        if (c < AO_K) QB[(size_t)m * D + c] = f2bf(v);
        else if (c < AO_V) { const int cc = c - AO_K; KB[(size_t)m * 256 + cc] = f2bf(v); if (m < MP) a.out[O_KP + ((size_t)ai * MP + m) * 256 + cc] = v; else a.out[O_KS + ((size_t)ai * MS + (m - MP)) * 256 + cc] = v; }
        else if (c < AO_QI) { const int cc = c - AO_V; VB[(size_t)m * 256 + cc] = f2bf(v); if (m < MP) a.out[O_VP + ((size_t)ai * MP + m) * 256 + cc] = v; else a.out[O_VS + ((size_t)ai * MS + (m - MP)) * 256 + cc] = v; }
        else if (c < AO_KI) QIB[(size_t)m * 512 + (c - AO_QI)] = f2bf(v);
        else { const int cc = c - AO_KI; KIB[(size_t)m * 64 + cc] = f2bf(v); if (m < MP) a.out[O_KIP + ((size_t)ai * MP + m) * 64 + cc] = v; else a.out[O_KIS + ((size_t)ai * MS + (m - MP)) * 64 + cc] = v; } }
}
__device__ __forceinline__ void ph_idx_mfma(const Args& a, LAS unsigned char* lds) {
    const float* P = (const float*)(a.ws + WS_P); const bf16* QIB = (const bf16*)(a.ws + WS_QIB); const bf16* KIB = (const bf16*)(a.ws + WS_KIB); float* SC = (float*)(a.ws + WS_SCT); int* IDX = (int*)(a.ws + WS_IDX); int* NSEL = (int*)(a.ws + WS_NSEL);
    int tx_ = TID(); asm volatile("" : "+v"(tx_));
    const int lane = tx_ & 63, fr = lane & 15, fq = lane >> 4, wv = __builtin_amdgcn_readfirstlane(blockIdx.x * (NTHREADS >> 6) + (tx_ >> 6)), nwv = gridDim.x * (NTHREADS >> 6);
    constexpr int NU = MP / 4;
    for (int pr2 = wv * 2; pr2 < NU; pr2 += nwv * 2) for (int u0 = pr2; u0 < pr2 + 2; ++u0) { const int hh = u0 >> 1, u = (u0 & 1) ? (NU - 1 - hh) : hh;
        const int m0 = u * 4, b = m0 / SEQ, t0 = m0 % SEQ;
        int lnu = lane; asm volatile("" : "+v"(lnu)); const int fr = lnu & 15, fq = (lnu >> 4) & 3;
        bf16x8_t aQ[2][2];
#pragma unroll
        for (int p = 0; p < 2; ++p)
#pragma unroll
            for (int ks = 0; ks < 2; ++ks) aQ[p][ks] = *(const bf16x8_t*)(QIB + (size_t)(m0 + (fr >> 2)) * 512 + (4 * p + (fr & 3)) * 64 + ks * 32 + fq * 8);
        const f32x4_t w0 = *(const f32x4_t*)(P + (size_t)(m0 + fq) * LDP + AO_WI), w1 = *(const f32x4_t*)(P + (size_t)(m0 + fq) * LDP + AO_WI + 4);
        float* scrow = SC + (size_t)(m0 + fq) * SLD + fr;
        const int nkt = (t0 + 3) / 16 + 1;
        bf16x8_t bKa[4][2], bKb[4][2];
#define IDX_LOAD(B_, kt0_) do { _Pragma("unroll") for (int q = 0; q < 4; ++q) { const int kt = (kt0_) + q < nkt ? (kt0_) + q : nkt - 1; const bf16* kr = KIB + ((size_t)b * (SEQ / 16) + kt) * 1024 + lnu * 8; \
            B_[q][0] = *(const bf16x8_t*)kr; B_[q][1] = *(const bf16x8_t*)(kr + 512); } } while (0)
#define IDX_COMP(B_, kt0_) do { _Pragma("unroll") for (int q = 0; q < 4; ++q) { if ((kt0_) + q < nkt) { f32x4_t c0 = {0.f, 0.f, 0.f, 0.f}, c1 = {0.f, 0.f, 0.f, 0.f}; \
                    c0 = __builtin_amdgcn_mfma_f32_16x16x32_bf16(aQ[0][0], B_[q][0], c0, 0, 0, 0); c0 = __builtin_amdgcn_mfma_f32_16x16x32_bf16(aQ[0][1], B_[q][1], c0, 0, 0, 0); \
                    c1 = __builtin_amdgcn_mfma_f32_16x16x32_bf16(aQ[1][0], B_[q][0], c1, 0, 0, 0); c1 = __builtin_amdgcn_mfma_f32_16x16x32_bf16(aQ[1][1], B_[q][1], c1, 0, 0, 0); \
                    __builtin_nontemporal_store((w0[0] * fmaxf(c0[0], 0.f) + w0[1] * fmaxf(c0[1], 0.f)) + (w0[2] * fmaxf(c0[2], 0.f) + w0[3] * fmaxf(c0[3], 0.f)) \
                                             + (w1[0] * fmaxf(c1[0], 0.f) + w1[1] * fmaxf(c1[1], 0.f)) + (w1[2] * fmaxf(c1[2], 0.f) + w1[3] * fmaxf(c1[3], 0.f)), scrow + ((kt0_) + q) * 16); } } } while (0)
        IDX_LOAD(bKa, 0);
        for (int kt0 = 0; kt0 < nkt; kt0 += 8) { IDX_LOAD(bKb, kt0 + 4); IDX_COMP(bKa, kt0); IDX_LOAD(bKa, kt0 + 8); IDX_COMP(bKb, kt0 + 4); }
#undef IDX_LOAD
#undef IDX_COMP
        LAS unsigned* cand = (LAS unsigned*)(lds + (tx_ >> 6) * 4608);
        for (int q = 0; q < 4; ++q) { const int m = m0 + q, n = t0 + q + 1, K = TOPK_P; int ln = lane; asm volatile("" : "+v"(ln));
            const float* row = SC + (size_t)m * SLD; int* out = IDX + (size_t)m * KROW;
            if (n <= K) { for (int j = ln; j < n; j += 64) out[j] = j; if (ln == 0) NSEL[m] = n; continue; }
            if (n <= 2048) select_row<32>(row, n, K, out, ln, cand);
            else if (n <= 4096) select_row<64>(row, n, K, out, ln, cand);
            else if (n <= 6144) select_row<96>(row, n, K, out, ln, cand);
            else select_row<128>(row, n, K, out, ln, cand);
            if (ln == 0) NSEL[m] = K; }
    }
}
__device__ __forceinline__ void ph_idx_sample_mfma(const Args& a, int ai) {
    const float* P = (const float*)(a.ws + WS_P); const bf16* QIB = (const bf16*)(a.ws + WS_QIB); float* SC = (float*)(a.ws + WS_SCT); const int* PT = (const int*)a.in[I_PT]; const float* CKI = a.in[I_CKI];
    int tx_ = TID(); asm volatile("" : "+v"(tx_));
    const int lane = tx_ & 63, fr = lane & 15, fq = lane >> 4, wv = __builtin_amdgcn_readfirstlane(blockIdx.x * (NTHREADS >> 6) + (tx_ >> 6)), nwv = gridDim.x * (NTHREADS >> 6);
    constexpr int NKT = (PAST + DT + 15) / 16, SPL = 64, TPU = (NKT + SPL - 1) / SPL;
    static_assert(PAGE % 16 == 0 && PAST % 16 == 0 && DT <= 16, "sample index tiles");
    for (int u = wv; u < DB * SPL; u += nwv) { const int db = u / SPL, k0 = (u % SPL) * TPU, k1 = (k0 + TPU < NKT) ? k0 + TPU : NKT; const int m0 = MP + db * DT;
        if (k0 >= k1) continue;
        bf16x8_t aQ[2][2];
#pragma unroll
        for (int p = 0; p < 2; ++p)
#pragma unroll
            for (int ks = 0; ks < 2; ++ks) aQ[p][ks] = *(const bf16x8_t*)(QIB + (size_t)(m0 + (fr >> 2)) * 512 + (4 * p + (fr & 3)) * 64 + ks * 32 + fq * 8);
        const f32x4_t w0 = *(const f32x4_t*)(P + (size_t)(m0 + fq) * LDP + AO_WI), w1 = *(const f32x4_t*)(P + (size_t)(m0 + fq) * LDP + AO_WI + 4);
        float* scrow = SC + (size_t)(m0 + fq) * SLD + fr;
        for (int kb = k0; kb < k1; kb += 3) { f32x4_t kf[3][4];
#pragma unroll
            for (int q = 0; q < 3; ++q) { const int kt = kb + q < k1 ? kb + q : k1 - 1, s0 = kt * 16; const float* kr;
                if (s0 < PAST) { const int pg = PT[db * NPAGES + s0 / PAGE]; kr = CKI + (((size_t)ai * NPOOL + pg) * PAGE + (s0 % PAGE) + fr) * IDIM + fq * 8; }
                else kr = P + (size_t)(m0 + (fr < DT ? fr : DT - 1)) * LDP + AO_KI + fq * 8;
                kf[q][0] = *(const f32x4_t*)kr; kf[q][1] = *(const f32x4_t*)(kr + 4); kf[q][2] = *(const f32x4_t*)(kr + 32); kf[q][3] = *(const f32x4_t*)(kr + 36); }
#pragma unroll
            for (int q = 0; q < 3; ++q) { if (kb + q < k1) { const int s0 = (kb + q) * 16; u32x4_t b0, b1;
                b0[0] = pk_bf16(kf[q][0][0], kf[q][0][1]); b0[1] = pk_bf16(kf[q][0][2], kf[q][0][3]); b0[2] = pk_bf16(kf[q][1][0], kf[q][1][1]); b0[3] = pk_bf16(kf[q][1][2], kf[q][1][3]);
                b1[0] = pk_bf16(kf[q][2][0], kf[q][2][1]); b1[1] = pk_bf16(kf[q][2][2], kf[q][2][3]); b1[2] = pk_bf16(kf[q][3][0], kf[q][3][1]); b1[3] = pk_bf16(kf[q][3][2], kf[q][3][3]);
                const bf16x8_t bK0 = __builtin_bit_cast(bf16x8_t, b0), bK1 = __builtin_bit_cast(bf16x8_t, b1);
                f32x4_t c0 = {0.f, 0.f, 0.f, 0.f}, c1 = {0.f, 0.f, 0.f, 0.f};
                c0 = __builtin_amdgcn_mfma_f32_16x16x32_bf16(aQ[0][0], bK0, c0, 0, 0, 0); c0 = __builtin_amdgcn_mfma_f32_16x16x32_bf16(aQ[0][1], bK1, c0, 0, 0, 0);
                c1 = __builtin_amdgcn_mfma_f32_16x16x32_bf16(aQ[1][0], bK0, c1, 0, 0, 0); c1 = __builtin_amdgcn_mfma_f32_16x16x32_bf16(aQ[1][1], bK1, c1, 0, 0, 0);
                scrow[s0] = (w0[0] * fmaxf(c0[0], 0.f) + w0[1] * fmaxf(c0[1], 0.f)) + (w0[2] * fmaxf(c0[2], 0.f) + w0[3] * fmaxf(c0[3], 0.f))
                          + (w1[0] * fmaxf(c1[0], 0.f) + w1[1] * fmaxf(c1[1], 0.f)) + (w1[2] * fmaxf(c1[2], 0.f) + w1[3] * fmaxf(c1[3], 0.f)); } } } }
}

__device__ __forceinline__ void ph_sparse_attn(const Args& a, LAS unsigned char* lds) {
    const bf16* QB = (const bf16*)(a.ws + WS_QB); const bf16* KB = (const bf16*)(a.ws + WS_KB); const bf16* VB = (const bf16*)(a.ws + WS_VB); const int* IDX = (const int*)(a.ws + WS_IDX); const int* NSEL = (const int*)(a.ws + WS_NSEL);
    bf16* O = (bf16*)(a.ws + WS_Y2);
    int tx_ = TID(); asm volatile("" : "+v"(tx_));
    const int lane = tx_ & 63, fr = lane & 15, fq = lane >> 4, wid = __builtin_amdgcn_readfirstlane(tx_ >> 6), wv = blockIdx.x * (NTHREADS >> 6) + wid, nwv = gridDim.x * (NTHREADS >> 6);
    LAS int* IDXS = (LAS int*)(lds + wid * 9216); LAS float* PS = (LAS float*)(lds + wid * 9216 + 1024);
    for (int m = wv; m < MP; m += nwv) { const int b = m / SEQ; const int ns = __builtin_amdgcn_readfirstlane(NSEL[m]);
#pragma unroll
        for (int c = 0; c < 4; ++c) { const int j = lane + 64 * c; IDXS[j] = j < ns ? IDX[(size_t)m * KROW + j] : 0; }
        bf16x8_t bQ[2][4];
#pragma unroll
        for (int kv = 0; kv < 2; ++kv)
#pragma unroll
            for (int ks = 0; ks < 4; ++ks) { bQ[kv][ks] = (bf16x8_t){0, 0, 0, 0, 0, 0, 0, 0}; if (fr < 4) bQ[kv][ks] = *(const bf16x8_t*)(QB + (size_t)m * D + (kv * 4 + fr) * 128 + ks * 32 + fq * 8); }
        asm volatile("s_waitcnt lgkmcnt(0)" ::: "memory");
#pragma unroll
        for (int tb = 0; tb < 16; tb += 2) { bf16x8_t ak[2][2][4];
#pragma unroll
            for (int t = 0; t < 2; ++t) { const int ri = IDXS[(tb + t) * 16 + fr]; const bf16* kb = KB + (size_t)(b * SEQ + ri) * 256 + fq * 8;
#pragma unroll
                for (int kv = 0; kv < 2; ++kv)
#pragma unroll
                    for (int ks = 0; ks < 4; ++ks) ak[t][kv][ks] = *(const bf16x8_t*)(kb + kv * 128 + ks * 32); }
#pragma unroll
            for (int t = 0; t < 2; ++t)
#pragma unroll
                for (int kv = 0; kv < 2; ++kv) { f32x4_t acc = {0.f, 0.f, 0.f, 0.f};
#pragma unroll
                    for (int ks = 0; ks < 4; ++ks) acc = __builtin_amdgcn_mfma_f32_16x16x32_bf16(ak[t][kv][ks], bQ[kv][ks], acc, 0, 0, 0);
                    if (fr < 4) {
#pragma unroll
                        for (int q = 0; q < 4; ++q) { const int j = (tb + t) * 16 + 4 * fq + q; PS[j * 8 + kv * 4 + fr] = j < ns ? acc[q] * 0.08838834764831845f : -1e30f; } } } }
        asm volatile("s_waitcnt lgkmcnt(0)" ::: "memory");
        { f32x4_t sv[4][2]; float mx[8];
#pragma unroll
            for (int h = 0; h < 8; ++h) mx[h] = -3e38f;
#pragma unroll
            for (int c = 0; c < 4; ++c) { sv[c][0] = *(const LAS f32x4_t*)(PS + (lane + 64 * c) * 8); sv[c][1] = *(const LAS f32x4_t*)(PS + (lane + 64 * c) * 8 + 4);
#pragma unroll
                for (int h = 0; h < 8; ++h) mx[h] = fmaxf(mx[h], sv[c][h >> 2][h & 3]); }
#pragma unroll
            for (int o = 32; o >= 1; o >>= 1)
#pragma unroll
                for (int h = 0; h < 8; ++h) mx[h] = fmaxf(mx[h], shfl_xor_l(mx[h], o, lane));
            float sum[8];
#pragma unroll
            for (int h = 0; h < 8; ++h) sum[h] = 0.f;
#pragma unroll
            for (int c = 0; c < 4; ++c)
#pragma unroll
                for (int h = 0; h < 8; ++h) { const float e = FEXP(sv[c][h >> 2][h & 3] - mx[h]); sv[c][h >> 2][h & 3] = e; sum[h] += e; }
#pragma unroll
            for (int o = 32; o >= 1; o >>= 1)
#pragma unroll
                for (int h = 0; h < 8; ++h) sum[h] += shfl_xor_l(sum[h], o, lane);
#pragma unroll
            for (int h = 0; h < 8; ++h) sum[h] = FRCP(sum[h]);
#pragma unroll
            for (int c = 0; c < 4; ++c) { f32x4_t p0, p1;
#pragma unroll
                for (int h = 0; h < 4; ++h) { p0[h] = sv[c][0][h] * sum[h]; p1[h] = sv[c][1][h] * sum[4 + h]; }
                *(LAS f32x4_t*)(PS + (lane + 64 * c) * 8) = p0; *(LAS f32x4_t*)(PS + (lane + 64 * c) * 8 + 4) = p1; } }
        asm volatile("s_waitcnt lgkmcnt(0)" ::: "memory");
        f32x4_t o4[4] = {{0.f, 0.f, 0.f, 0.f}, {0.f, 0.f, 0.f, 0.f}, {0.f, 0.f, 0.f, 0.f}, {0.f, 0.f, 0.f, 0.f}};
        const int kvl = lane >> 5; const char* vb8 = (const char*)(VB + (size_t)b * SEQ * 256);
        const unsigned loff = (unsigned)(kvl * 128 + (lane & 31) * 4) * 2u;
        for (int j0 = 0; j0 < ns; j0 += 32) { u32x2_t vv[32];
#pragma unroll
            for (int jj = 0; jj < 32; ++jj) { const unsigned off = (unsigned)IDXS[j0 + jj] * 512u + loff; vv[jj] = *(const u32x2_t*)(vb8 + off); }
#pragma unroll
            for (int jj = 0; jj < 32; ++jj) { const f32x4_t p4 = *(const LAS f32x4_t*)(PS + (j0 + jj) * 8 + kvl * 4);
                const f32x4_t vf = {__builtin_bit_cast(float, vv[jj][0] << 16), __builtin_bit_cast(float, vv[jj][0] & 0xffff0000u), __builtin_bit_cast(float, vv[jj][1] << 16), __builtin_bit_cast(float, vv[jj][1] & 0xffff0000u)};
#pragma unroll
                for (int h = 0; h < 4; ++h) o4[h] += vf * p4[h]; } }
#pragma unroll
        for (int h = 0; h < 4; ++h) { u32x2_t w; w[0] = pk_bf16(o4[h][0], o4[h][1]); w[1] = pk_bf16(o4[h][2], o4[h][3]); *(u32x2_t*)(O + (size_t)m * D + (kvl * 4 + h) * 128 + (lane & 31) * 4) = w; }
        asm volatile("s_waitcnt lgkmcnt(0)" ::: "memory");
    }
}

__device__ __forceinline__ void ph_sparse_sample(const Args& a, int ai, LAS unsigned char* lds) {
    const float* P = (const float*)(a.ws + WS_P); const int* IDX = (const int*)(a.ws + WS_IDX); const int* NSEL = (const int*)(a.ws + WS_NSEL); bf16* O = (bf16*)(a.ws + WS_Y2);
    int tx_ = TID(); asm volatile("" : "+v"(tx_));
    const int lane = tx_ & 63, wid = __builtin_amdgcn_readfirstlane(tx_ >> 6), wv = blockIdx.x * (NTHREADS >> 6) + wid, nwv = gridDim.x * (NTHREADS >> 6);
    LAS float* QS = (LAS float*)(lds + wid * 9216); LAS float* PSs = (LAS float*)(lds + wid * 9216 + 512); LAS unsigned long long* VP = (LAS unsigned long long*)(lds + wid * 9216 + 1536);
    for (int u = wv; u < MS * AH; u += nwv) { const int m = MP + u / AH, h = u % AH, kvh = h / GROUP; const RowInfo ri = row_info(m); const int ns = __builtin_amdgcn_readfirstlane(NSEL[m]);
        { const f32x2_t q2 = *(const f32x2_t*)(P + (size_t)m * LDP + h * HDIM + 2 * lane); QS[2 * lane] = q2[0]; QS[2 * lane + 1] = q2[1]; }
        const float* kp[4];
#pragma unroll
        for (int c = 0; c < 4; ++c) { const int j = lane + 64 * c; const int idx = j < ns ? IDX[(size_t)m * KROW + j] : 0; kp[c] = kv_row(a, ai, ri, idx, kvh, false); VP[j] = (unsigned long long)(size_t)kv_row(a, ai, ri, idx, kvh, true); }
        asm volatile("s_waitcnt lgkmcnt(0)" ::: "memory");
        float sc[4] = {0.f, 0.f, 0.f, 0.f};
        for (int d0 = 0; d0 < HDIM; d0 += 16) { f32x4_t kq[4][4];
#pragma unroll
            for (int e = 0; e < 4; ++e)
#pragma unroll
                for (int c = 0; c < 4; ++c) kq[e][c] = *(const f32x4_t*)(kp[c] + d0 + 4 * e);
#pragma unroll
            for (int e = 0; e < 4; ++e) { const f32x4_t q4 = *(const LAS f32x4_t*)(QS + d0 + 4 * e);
#pragma unroll
                for (int c = 0; c < 4; ++c) sc[c] += (kq[e][c][0] * q4[0] + kq[e][c][1] * q4[1]) + (kq[e][c][2] * q4[2] + kq[e][c][3] * q4[3]); } }
        float mx = -3e38f;
#pragma unroll
        for (int c = 0; c < 4; ++c) { sc[c] = (lane + 64 * c) < ns ? sc[c] * 0.08838834764831845f : -1e30f; mx = fmaxf(mx, sc[c]); }
#pragma unroll
        for (int o = 32; o >= 1; o >>= 1) mx = fmaxf(mx, shfl_xor_l(mx, o, lane));
        float sum = 0.f;
#pragma unroll
        for (int c = 0; c < 4; ++c) { sc[c] = FEXP(sc[c] - mx); sum += sc[c]; }
#pragma unroll
        for (int o = 32; o >= 1; o >>= 1) sum += shfl_xor_l(sum, o, lane);
        const float inv = FRCP(sum);
#pragma unroll
        for (int c = 0; c < 4; ++c) PSs[lane + 64 * c] = sc[c] * inv;
        asm volatile("s_waitcnt lgkmcnt(0)" ::: "memory");
        f32x2_t o2 = {0.f, 0.f};
        for (int j0 = 0; j0 < ns; j0 += 16) { f32x2_t vv[16];
#pragma unroll
            for (int jj = 0; jj < 16; ++jj) { const float* vp = (const float*)(size_t)VP[j0 + jj]; vv[jj] = *(const f32x2_t*)(vp + 2 * lane); }
#pragma unroll
            for (int jj = 0; jj < 16; ++jj) o2 += vv[jj] * PSs[j0 + jj]; }
        *(unsigned*)(O + (size_t)m * D + h * HDIM + 2 * lane) = pk_bf16(o2[0], o2[1]);
        asm volatile("s_waitcnt lgkmcnt(0)" ::: "memory");
    }
}

__device__ __forceinline__ void ph_rg_chunk(const Args& a, int r, LAS unsigned char* lds) {
    const float* P = (const float*)(a.ws + WS_P); float* HH = (float*)(a.ws + WS_HH); float* AP = (float*)(a.ws + WS_XR);
    const float* wc = a.in[I_WCONV] + (size_t)r * 4 * CONV_CH; const float* wa = a.in[I_WA] + (size_t)r * RG_HEADS * RG_BW * RG_BW; const float* wx = a.in[I_WX] + (size_t)r * RG_HEADS * RG_BW * RG_BW;
    static_assert(RG_BW == 64 && RG_HEADS == 8, "ph_rg_chunk is written for 8 gate heads of 64 channels");
    int tx_ = TID(); asm volatile("" : "+v"(tx_));
    const int lane = tx_ & 63, wid = __builtin_amdgcn_readfirstlane(tx_ >> 6), wv = blockIdx.x * (NTHREADS >> 6) + wid, nwv = gridDim.x * (NTHREADS >> 6);
    LAS float* XS = (LAS float*)(lds + wid * 16384);
    constexpr int NUP = NB * NC * 8, NU = NUP + DB * 8;
    for (int u = wv; u < NU; u += nwv) { const bool prompt = u < NUP; int hd, row0, T, n = 0, b = 0, db = 0;
        if (prompt) { const int c = u >> 3; hd = u & 7; row0 = c * 64; T = 64; n = c % NC; b = c / NC; } else { const int q = u - NUP; db = q >> 3; hd = q & 7; row0 = MP + db * DT; T = DT; }
        const int ch = hd * 64 + lane;
        const float w0 = wc[ch], w1 = wc[CONV_CH + ch], w2 = wc[2 * CONV_CH + ch], w3 = wc[3 * CONV_CH + ch], bcv = a.in[I_BCONV][(size_t)r * D_RNN + ch];
        float x3 = 0.f, x2 = 0.f, x1 = 0.f;
        if (prompt) { if (n != 0) { x3 = P[(size_t)(row0 - 3) * LDP + ch]; x2 = P[(size_t)(row0 - 2) * LDP + ch]; x1 = P[(size_t)(row0 - 1) * LDP + ch]; } }
        else { const float* sc = a.in[I_SCONV] + ((size_t)r * DB + db) * 3 * CONV_CH + ch; x3 = sc[0]; x2 = sc[CONV_CH]; x1 = sc[2 * CONV_CH]; }
        for (int tb = 0; tb < T; tb += 16) { float ub[16];
#pragma unroll
            for (int q = 0; q < 16; ++q) ub[q] = P[(size_t)(row0 + (tb + q < T ? tb + q : T - 1)) * LDP + ch];
#pragma unroll
            for (int q = 0; q < 16; ++q) { const int t = tb + q; if (t < T) { const float ut = ub[q]; XS[t * 64 + lane] = w3 * ut + w2 * x1 + w1 * x2 + w0 * x3 + bcv; x3 = x2; x2 = x1; x1 = ut;
                if (prompt) { if (n == NC - 1 && t >= 61) a.out[O_CONVP + (((size_t)r * NB + b) * 3 + (t - 61)) * CONV_CH + ch] = ut; }
                else if (t >= DT - 3) a.out[O_CONVS + (((size_t)r * DB + db) * 3 + (t - (DT - 3))) * CONV_CH + ch] = ut; } } }
        asm volatile("s_waitcnt lgkmcnt(0)" ::: "memory");
        float war[64], wxr[64];
        unsigned ln = (unsigned)lane; asm volatile("" : "+v"(ln)); ln &= 63u;
        const float* wah = wa + (size_t)hd * 4096; const float* wxh = wx + (size_t)hd * 4096;
#pragma unroll
        for (int k = 0; k < 64; ++k) { war[k] = wah[k * 64u + ln]; wxr[k] = wxh[k * 64u + ln]; }
        const float ba = a.in[I_BA][(size_t)r * D_RNN + ch], bx = a.in[I_BX][(size_t)r * D_RNN + ch], sp = softplusf_(-a.in[I_LAM][(size_t)r * D_RNN + ch]);
        float h = 0.f, ap = 1.f;
        for (int t = 0; t < T; ++t) { float pr = 0.f, pi = 0.f;
#pragma unroll
            for (int k = 0; k < 64; k += 4) { const f32x4_t x4 = *(const LAS f32x4_t*)(XS + t * 64 + k);
#pragma unroll
                for (int e = 0; e < 4; ++e) { pr += x4[e] * war[k + e]; pi += x4[e] * wxr[k + e]; } }
            const float rg = sigmoidf_(pr + ba), ig = sigmoidf_(pi + bx), log_a = -8.0f * rg * sp, av = __expf(log_a);
            const bool first = prompt && n == 0 && t == 0; const float mult = first ? 1.0f : FSQRT(fmaxf(1.0f - __expf(2.0f * log_a), 0.0f));
            float bv = XS[t * 64 + lane] * ig * mult; if (!prompt && t == 0) bv += av * a.in[I_SH][((size_t)r * DB + db) * D_RNN + ch];
            h = av * h + bv; ap *= av; const size_t o = (size_t)(row0 + t) * D_RNN + ch; HH[o] = h; AP[o] = ap; }
        if (!prompt) a.out[O_HS + ((size_t)r * DB + db) * D_RNN + ch] = h;
        asm volatile("s_waitcnt lgkmcnt(0)" ::: "memory");
    }
}
__device__ __forceinline__ void ph_dn_tok(const Args& a, int r) {
    const float* P = (const float*)(a.ws + WS_P); float* QKV = (float*)(a.ws + WS_QKV); float* QN = (float*)(a.ws + WS_QN); float* KN = (float*)(a.ws + WS_KN); float* GB = (float*)(a.ws + WS_GB); float* KNT = (float*)(a.ws + WS_KNT);
    const float* wc = a.in[I_WCONV] + (size_t)r * 4 * CONV_CH;
    int tx_ = TID(); asm volatile("" : "+v"(tx_));
    const int lane = tx_ & 63, wv = __builtin_amdgcn_readfirstlane(blockIdx.x * (NTHREADS >> 6) + (tx_ >> 6)), nwv = gridDim.x * (NTHREADS >> 6);
    constexpr int NUP = (MP / 16) * DNH, NU = NUP + DB * DNH;
    static_assert(DT == 4 && SEQ % 64 == 0, "ph_dn_tok run lengths");
    for (int u = wv; u < NU; u += nwv) { const bool prompt = u < NUP; const int hd = prompt ? (u & 3) : ((u - NUP) & 3), m0 = prompt ? (u >> 2) * 16 : MP + ((u - NUP) >> 2) * DT, T = prompt ? 16 : DT;
        const int seq = prompt ? m0 / SEQ : 0, t0 = prompt ? m0 % SEQ : 0, db = prompt ? 0 : (m0 - MP) / DT;
        f32x2_t wk[3][4], h3[3], h2[3], h1[3];
#pragma unroll
        for (int p = 0; p < 3; ++p) { const int c = D_RNN + p * 512 + hd * 128 + 2 * lane;
#pragma unroll
            for (int k = 0; k < 4; ++k) wk[p][k] = *(const f32x2_t*)(wc + (size_t)k * CONV_CH + c);
            h3[p] = h2[p] = h1[p] = (f32x2_t){0.f, 0.f};
            if (prompt) { if (t0 != 0) { h3[p] = *(const f32x2_t*)(P + (size_t)(m0 - 3) * LDP + c); h2[p] = *(const f32x2_t*)(P + (size_t)(m0 - 2) * LDP + c); h1[p] = *(const f32x2_t*)(P + (size_t)(m0 - 1) * LDP + c); } }
            else { const float* sc = a.in[I_SCONV] + ((size_t)r * DB + db) * 3 * CONV_CH + c; h3[p] = *(const f32x2_t*)sc; h2[p] = *(const f32x2_t*)(sc + CONV_CH); h1[p] = *(const f32x2_t*)(sc + 2 * CONV_CH); } }
        float gcum = 0.f;
        if (prompt) { const int tl0 = t0 & 63; float gt = lane < tl0 ? dn_g(a, r, (size_t)(m0 - tl0 + lane), hd) : 0.f;
#pragma unroll
            for (int o2 = 32; o2 >= 1; o2 >>= 1) gt += shfl_xor_l(gt, o2, lane);
            gcum = gt; }
        for (int tb = 0; tb < T; tb += 8) { f32x2_t xin[8][3];
#pragma unroll
            for (int q = 0; q < 8; ++q)
#pragma unroll
                for (int p = 0; p < 3; ++p) xin[q][p] = *(const f32x2_t*)(P + (size_t)(m0 + (tb + q < T ? tb + q : T - 1)) * LDP + D_RNN + p * 512 + hd * 128 + 2 * lane);
#pragma unroll
            for (int q = 0; q < 8; ++q) { const int t = tb + q; if (t < T) { const int m = m0 + t; f32x2_t x[3];
#pragma unroll
                for (int p = 0; p < 3; ++p) { const int c = D_RNN + p * 512 + hd * 128 + 2 * lane; const f32x2_t xv = xin[q][p];
                    const f32x2_t acc = wk[p][0] * h3[p] + wk[p][1] * h2[p] + wk[p][2] * h1[p] + wk[p][3] * xv; h3[p] = h2[p]; h2[p] = h1[p]; h1[p] = xv;
                    x[p][0] = siluf_(acc[0]); x[p][1] = siluf_(acc[1]);
                    if (prompt) { if (t0 + t >= SEQ - 3) *(f32x2_t*)(a.out + O_CONVP + (((size_t)r * NB + seq) * 3 + (t0 + t - (SEQ - 3))) * CONV_CH + c) = xv; }
                    else if (t >= DT - 3) *(f32x2_t*)(a.out + O_CONVS + (((size_t)r * DB + db) * 3 + (t - (DT - 3))) * CONV_CH + c) = xv; }
                float sq = x[0][0] * x[0][0] + x[0][1] * x[0][1], sk = x[1][0] * x[1][0] + x[1][1] * x[1][1];
#pragma unroll
                for (int o = 32; o >= 1; o >>= 1) { sq += shfl_xor_l(sq, o, lane); sk += shfl_xor_l(sk, o, lane); }
                const float rq = FRSQ(sq + EPS) * 0.08838834764831845f, rk = FRSQ(sk + EPS);
                const f32x2_t qn = x[0] * rq, kn = x[1] * rk; const size_t o = (size_t)m * 512 + hd * 128 + 2 * lane;
                *(f32x2_t*)(QN + o) = qn; *(f32x2_t*)(KN + o) = kn; *(f32x2_t*)(QKV + (size_t)m * 1536 + 1024 + hd * 128 + 2 * lane) = x[2];
                const float g = dn_g(a, r, (size_t)m, hd); float gc = g;
                if (prompt) { const int tt = t0 + t, tl = tt & 63; if (tl == 0) gcum = 0.f; gcum += g; gc = gcum;
                    (void)tl; }
                if (lane == 0) { GB[(size_t)m * 16 + hd * 4] = g; GB[(size_t)m * 16 + hd * 4 + 1] = sigmoidf_(P[(size_t)m * LDP + OFF_B + hd]); GB[(size_t)m * 16 + hd * 4 + 2] = gc; } } } } }
}
__device__ __forceinline__ void ph_rec_out_w(const Args& a, int r) {
    static_assert(D_RNN == 512 && Y2W == 1024, "ph_rec_out_w is written for D_RNN 512");
    const float* P = (const float*)(a.ws + WS_P); const float* HH = (const float*)(a.ws + WS_HH); const float* AP = (const float*)(a.ws + WS_XR); const float* CARRY = (const float*)(a.ws + WS_CARRY);
    const float* ODN = (const float*)(a.ws + WS_ODN); bf16* Y2 = (bf16*)(a.ws + WS_Y2); const float* dnw = a.in[I_DNW] + r * 128;
    int tx_ = TID(); asm volatile("" : "+v"(tx_));
    const int lane = tx_ & 63, wv = __builtin_amdgcn_readfirstlane(blockIdx.x * (NTHREADS >> 6) + (tx_ >> 6)), nwv = gridDim.x * (NTHREADS >> 6);
    const f32x2_t dw = *(const f32x2_t*)(dnw + 2 * lane);
    for (int m = wv; m < MT; m += nwv) {
        { const size_t o = (size_t)m * D_RNN + 8 * lane; f32x4_t h0 = *(const f32x4_t*)(HH + o), h1 = *(const f32x4_t*)(HH + o + 4);
            if (m < MP) { const float* cr = CARRY + (size_t)(m / 64) * D_RNN + 8 * lane; h0 += *(const f32x4_t*)(AP + o) * *(const f32x4_t*)cr; h1 += *(const f32x4_t*)(AP + o + 4) * *(const f32x4_t*)(cr + 4); }
            const float* gp = P + (size_t)m * LDP + OFF_GATE + 8 * lane; const f32x4_t g0 = *(const f32x4_t*)gp, g1 = *(const f32x4_t*)(gp + 4);
            u32x4_t w; w[0] = pk_bf16(h0[0] * gelu_tanhf_(g0[0]), h0[1] * gelu_tanhf_(g0[1])); w[1] = pk_bf16(h0[2] * gelu_tanhf_(g0[2]), h0[3] * gelu_tanhf_(g0[3]));
            w[2] = pk_bf16(h1[0] * gelu_tanhf_(g1[0]), h1[1] * gelu_tanhf_(g1[1])); w[3] = pk_bf16(h1[2] * gelu_tanhf_(g1[2]), h1[3] * gelu_tanhf_(g1[3]));
            *(u32x4_t*)(Y2 + (size_t)m * Y2W + 8 * lane) = w; }
        f32x2_t ov[4]; float ss[4];
#pragma unroll
        for (int hd = 0; hd < 4; ++hd) { ov[hd] = *(const f32x2_t*)(ODN + (size_t)m * 512 + hd * 128 + 2 * lane); ss[hd] = ov[hd][0] * ov[hd][0] + ov[hd][1] * ov[hd][1]; }
#pragma unroll
        for (int o = 32; o >= 1; o >>= 1)
#pragma unroll
            for (int hd = 0; hd < 4; ++hd) ss[hd] += shfl_xor_l(ss[hd], o, lane);
#pragma unroll
        for (int hd = 0; hd < 4; ++hd) { const float rs = FRSQ(ss[hd] * (1.0f / 128.0f) + EPS); const f32x2_t z = *(const f32x2_t*)(P + (size_t)m * LDP + OFF_Z + hd * 128 + 2 * lane);
            *(unsigned*)(Y2 + (size_t)m * Y2W + D_RNN + hd * 128 + 2 * lane) = pk_bf16(ov[hd][0] * rs * dw[0] * siluf_(z[0]), ov[hd][1] * rs * dw[1] * siluf_(z[1])); } }
}


__device__ __forceinline__ void ph_dn_chunk(const Args& a, LAS unsigned char* lds) {
    const float* QKV = (const float*)(a.ws + WS_QKV); const float* QN = (const float*)(a.ws + WS_QN); const float* KN = (const float*)(a.ws + WS_KN); const float* GB = (const float*)(a.ws + WS_GB); const float* KNT = (const float*)(a.ws + WS_KNT);
    bf16* AT = (bf16*)(a.ws + WS_AT); float* UT = (float*)(a.ws + WS_UT); bf16* WN = (bf16*)(a.ws + WS_WN); bf16* QG = (bf16*)(a.ws + WS_QG); bf16* KDT = (bf16*)(a.ws + WS_KDT); float* GL = (float*)(a.ws + WS_GL);
    int tx_ = TID(); asm volatile("" : "+v"(tx_));
    const int tid = tx_, lane = tid & 63, fr = lane & 15, fq = lane >> 4, wid = __builtin_amdgcn_readfirstlane(tid >> 6);
    constexpr int RS = 136;
    LAS bf16* Kb = (LAS bf16*)lds; LAS bf16* Qb = (LAS bf16*)(lds + 17408); LAS float* Lf = (LAS float*)(lds + 34816); LAS float* gcs = (LAS float*)(lds + 51200); LAS float* bts = (LAS float*)(lds + 51456);
    for (int cu = blockIdx.x; cu < NCU; cu += gridDim.x) { const int n = cu % NC, hd = (cu / NC) % DNH, b = cu / (NC * DNH); const size_t m0 = (size_t)b * SEQ + n * 64;
        { const int i = tid >> 3, sg = tid & 7; const float* qp = QN + (m0 + i) * 512 + hd * 128 + sg * 16; const float* kp = KN + (m0 + i) * 512 + hd * 128 + sg * 16;
            f32x4_t qv[4], kv[4];
#pragma unroll
            for (int e = 0; e < 4; ++e) { qv[e] = *(const f32x4_t*)(qp + 4 * e); kv[e] = *(const f32x4_t*)(kp + 4 * e); }
            u32x4_t w0, w1;
#pragma unroll
            for (int e = 0; e < 2; ++e) { w0[2 * e] = pk_bf16(qv[e][0], qv[e][1]); w0[2 * e + 1] = pk_bf16(qv[e][2], qv[e][3]); w1[2 * e] = pk_bf16(qv[e + 2][0], qv[e + 2][1]); w1[2 * e + 1] = pk_bf16(qv[e + 2][2], qv[e + 2][3]); }
            *(LAS u32x4_t*)(Qb + i * RS + sg * 16) = w0; *(LAS u32x4_t*)(Qb + i * RS + sg * 16 + 8) = w1;
#pragma unroll
            for (int e = 0; e < 2; ++e) { w0[2 * e] = pk_bf16(kv[e][0], kv[e][1]); w0[2 * e + 1] = pk_bf16(kv[e][2], kv[e][3]); w1[2 * e] = pk_bf16(kv[e + 2][0], kv[e + 2][1]); w1[2 * e + 1] = pk_bf16(kv[e + 2][2], kv[e + 2][3]); }
            *(LAS u32x4_t*)(Kb + i * RS + sg * 16) = w0; *(LAS u32x4_t*)(Kb + i * RS + sg * 16 + 8) = w1;
            if (tid < 64) { gcs[tid] = GB[(m0 + tid) * 16 + hd * 4 + 2]; bts[tid] = GB[(m0 + tid) * 16 + hd * 4 + 1]; } }
        __syncthreads();
        { const int ti = wid >> 1;
#pragma unroll
            for (int tq = 0; tq < 2; ++tq) { const int tj = 2 * (wid & 1) + tq; f32x4_t ck = {0.f, 0.f, 0.f, 0.f}, cq = {0.f, 0.f, 0.f, 0.f};
                if (tj <= ti) {
#pragma unroll
                    for (int ks = 0; ks < 4; ++ks) { const bf16x8_t bK = *(const LAS bf16x8_t*)(Kb + (tj * 16 + fr) * RS + ks * 32 + fq * 8);
                        ck = __builtin_amdgcn_mfma_f32_16x16x32_bf16(*(const LAS bf16x8_t*)(Kb + (ti * 16 + fr) * RS + ks * 32 + fq * 8), bK, ck, 0, 0, 0);
                        cq = __builtin_amdgcn_mfma_f32_16x16x32_bf16(*(const LAS bf16x8_t*)(Qb + (ti * 16 + fr) * RS + ks * 32 + fq * 8), bK, cq, 0, 0, 0); } }
                const int j = tj * 16 + fr; const float gj = gcs[j];
#pragma unroll
                for (int q = 0; q < 4; ++q) { const int i = ti * 16 + 4 * fq + q; float lv = 0.f, av = 0.f;
                    if (i >= j) { const float dec = __expf(gcs[i] - gj); av = cq[q] * dec; if (i > j) lv = bts[i] * ck[q] * dec; }
                    Lf[i * 64 + j] = lv; AT[(size_t)cu * 4096 + FRAG_OFF(i, j, 2)] = f2bf(av); } } }
        __syncthreads();
        if (wid < 4) { const int col = tid; float X[64];
            if (col < 128) {
#pragma unroll
                for (int j = 0; j < 64; ++j) X[j] = QKV[(m0 + j) * 1536 + 1024 + hd * 128 + col] * bts[j]; }
            else {
#pragma unroll
                for (int j = 0; j < 64; ++j) X[j] = KN[(m0 + j) * 512 + hd * 128 + (col - 128)] * bts[j] * __expf(gcs[j]); }
#pragma unroll
            for (int i = 1; i < 64; ++i) { float acc = X[i];
#pragma unroll
                for (int jb = 0; jb < i; jb += 4) { const f32x4_t l4 = *(const LAS f32x4_t*)(Lf + i * 64 + jb);
                    acc -= l4[0] * X[jb]; acc -= l4[1] * X[jb + 1]; acc -= l4[2] * X[jb + 2]; acc -= l4[3] * X[jb + 3]; }
                X[i] = acc; }
            if (col < 128) { float* up = UT + (size_t)cu * 8192 + (size_t)((col >> 4) * 4) * 256 + (col & 15) * 4;
#pragma unroll
                for (int j = 0; j < 64; j += 4) *(f32x4_t*)(up + (j >> 4) * 256 + ((j >> 2) & 3) * 64) = (f32x4_t){X[j], X[j + 1], X[j + 2], X[j + 3]}; }
            else { bf16* wp = WN + (size_t)cu * 8192;
#pragma unroll
                for (int j = 0; j < 64; ++j) wp[FRAG_OFF(j, col - 128, 4)] = f2bf(-X[j]); } }
        else { const int t2 = tid - 256; const float gl63 = gcs[63];
            { const int i = t2 >> 2, sg = t2 & 3; const float eg = __expf(gcs[i]); const float* qp = QN + (m0 + i) * 512 + hd * 128 + sg * 32; bf16* op = QG + (size_t)cu * 8192;
#pragma unroll
                for (int e = 0; e < 8; ++e) { const f32x4_t v = *(const f32x4_t*)(qp + 4 * e); u32x2_t w; w[0] = pk_bf16(v[0] * eg, v[1] * eg); w[1] = pk_bf16(v[2] * eg, v[3] * eg); *(u32x2_t*)(op + FRAG_OFF(i, sg * 32 + 4 * e, 4)) = w; } }
            { const int dd = t2 >> 1, hf = t2 & 1; bf16* op = KDT + (size_t)cu * 8192;
#pragma unroll
                for (int e = 0; e < 8; ++e) { const int i0 = hf * 32 + 4 * e; u32x2_t w;
                    const float k0 = bf2f(Kb[(i0) * RS + dd]), k1 = bf2f(Kb[(i0 + 1) * RS + dd]), k2 = bf2f(Kb[(i0 + 2) * RS + dd]), k3 = bf2f(Kb[(i0 + 3) * RS + dd]);
                    w[0] = pk_bf16(k0 * __expf(gl63 - gcs[i0]), k1 * __expf(gl63 - gcs[i0 + 1])); w[1] = pk_bf16(k2 * __expf(gl63 - gcs[i0 + 2]), k3 * __expf(gl63 - gcs[i0 + 3])); *(u32x2_t*)(op + FRAG_OFF(dd, i0, 2)) = w; } }
            if (t2 == 0) GL[cu] = __expf(gl63); }
        __syncthreads();
    }
}


template <int MODE, int UNR> __device__ __forceinline__ void small_gemm(const bf16* __restrict__ A, const bf16* __restrict__ Bt, int N, int K, void* C, int ldc) {
    static_assert(MS == 128, "small_gemm covers 128 sample rows");
    int tx_ = TID(); asm volatile("" : "+v"(tx_));
    const int lane = tx_ & 63, fr = lane & 15, fq = lane >> 4, wv = __builtin_amdgcn_readfirstlane(blockIdx.x * (NTHREADS >> 6) + (tx_ >> 6)), nwv = gridDim.x * (NTHREADS >> 6);
    const int ntile = (N / 16) * 4;
    for (int tile = wv; tile < ntile; tile += nwv) { const int n0 = (tile >> 2) * 16, tg = tile & 3;
        f32x4_t acc0 = {0.f, 0.f, 0.f, 0.f}, acc1 = {0.f, 0.f, 0.f, 0.f};
        const bf16* bp = Bt + (size_t)(n0 + fr) * K + fq * 8; const bf16* ap0 = A + (size_t)(MP + tg * 32 + fr) * K + fq * 8; const bf16* ap1 = ap0 + (size_t)16 * K;
        for (int k = 0; k < K; k += 32 * UNR) { bf16x8_t bb[UNR], a0[UNR], a1[UNR];
#pragma unroll
            for (int u = 0; u < UNR; ++u) { bb[u] = *(const bf16x8_t*)(bp + k + 32 * u); a0[u] = *(const bf16x8_t*)(ap0 + k + 32 * u); a1[u] = *(const bf16x8_t*)(ap1 + k + 32 * u); }
#pragma unroll
            for (int u = 0; u < UNR; ++u) { acc0 = __builtin_amdgcn_mfma_f32_16x16x32_bf16(bb[u], a0[u], acc0, 0, 0, 0); acc1 = __builtin_amdgcn_mfma_f32_16x16x32_bf16(bb[u], a1[u], acc1, 0, 0, 0); } }
#pragma unroll
        for (int tt = 0; tt < 2; ++tt) { const f32x4_t v = tt ? acc1 : acc0; const size_t o = (size_t)(MP + tg * 32 + tt * 16 + fr) * ldc + n0 + 4 * fq;
            if (MODE == 0) *(f32x4_t*)((float*)C + o) = v;
            else if (MODE == 1) { const float r0 = fmaxf(v[0], 0.f), r1 = fmaxf(v[1], 0.f), r2 = fmaxf(v[2], 0.f), r3 = fmaxf(v[3], 0.f); u32x2_t w; w[0] = pk_bf16(r0 * r0, r1 * r1); w[1] = pk_bf16(r2 * r2, r3 * r3); *(u32x2_t*)((bf16*)C + o) = w; }
            else { f32x4_t* p = (f32x4_t*)((float*)C + o); *p = *p + v; } } }
}


template <int MODE> __device__ __forceinline__ void small_gemm2(const bf16* __restrict__ A, const bf16* __restrict__ Bt, int N, int K, void* C, int ldc, bf16* XB, unsigned long long* ss, LAS unsigned char* lds) {
    static_assert(MS == 128, "small_gemm2 covers 128 sample rows");
    int tx_ = TID(); asm volatile("" : "+v"(tx_));
    const int tid = tx_, lane = tid & 63, fr = lane & 15, fq = lane >> 4, wid = __builtin_amdgcn_readfirstlane(tid >> 6);
    LAS float* RED = (LAS float*)lds;
    const int kw = K / 8;
    for (int tile = blockIdx.x; tile < (N / 16) * 4; tile += gridDim.x) { const int n0 = (tile >> 2) * 16, tg = tile & 3;
        f32x4_t acc0 = {0.f, 0.f, 0.f, 0.f}, acc1 = {0.f, 0.f, 0.f, 0.f};
        const bf16* bp = Bt + (size_t)(n0 + fr) * K + wid * kw + fq * 8; const bf16* ap0 = A + (size_t)(MP + tg * 32 + fr) * K + wid * kw + fq * 8; const bf16* ap1 = ap0 + (size_t)16 * K;
        for (int k = 0; k < kw; k += 128) { bf16x8_t bb[4], a0[4], a1[4];
#pragma unroll
            for (int u = 0; u < 4; ++u) { bb[u] = *(const bf16x8_t*)(bp + k + 32 * u); a0[u] = *(const bf16x8_t*)(ap0 + k + 32 * u); a1[u] = *(const bf16x8_t*)(ap1 + k + 32 * u); }
#pragma unroll
            for (int u = 0; u < 4; ++u) { acc0 = __builtin_amdgcn_mfma_f32_16x16x32_bf16(bb[u], a0[u], acc0, 0, 0, 0); acc1 = __builtin_amdgcn_mfma_f32_16x16x32_bf16(bb[u], a1[u], acc1, 0, 0, 0); } }
        *(LAS f32x4_t*)(RED + ((size_t)(wid * 32 + fr)) * 16 + 4 * fq) = acc0; *(LAS f32x4_t*)(RED + ((size_t)(wid * 32 + 16 + fr)) * 16 + 4 * fq) = acc1;
        __syncthreads();
        { const int tok = tid >> 4, c = tid & 15; float v = RED[(size_t)tok * 16 + c];
#pragma unroll
            for (int w = 1; w < 8; ++w) v += RED[(size_t)(w * 32 + tok) * 16 + c];
            const int m = MP + tg * 32 + tok; const size_t o = (size_t)m * ldc + n0 + c;
            if (MODE == 1) { const float rs = FRSQ((float)ss[m] * (5.9604644775390625e-08f / D) + EPS); const float r0 = fmaxf(v * rs, 0.f); ((bf16*)C)[o] = f2bf(r0 * r0); }
            else { const float x = ((float*)C)[o] + v; ((float*)C)[o] = x; XB[o] = f2bf(x);
                float q = x * x; q += shfl_xor_l(q, 1, lane); q += shfl_xor_l(q, 2, lane); q += shfl_xor_l(q, 4, lane); q += shfl_xor_l(q, 8, lane);
                if (c == 0) __hip_atomic_fetch_add(ss + m, (unsigned long long)(q * 16777216.0f), __ATOMIC_RELAXED, __HIP_MEMORY_SCOPE_AGENT); } }
        __syncthreads();
    }
}

constexpr int PH_PER_LAYER = 12, PH_LAYER0 = 2, PH_FINAL = PH_LAYER0 + DEPTH * PH_PER_LAYER, N_PHASES = PH_FINAL + 1;
#ifndef DIAG_SEQ_LO
#define DIAG_SEQ_LO NB
#endif
#ifndef PROBE_N
#define PROBE_N 1
#define PROBE_KIND -1
#define PROBE_LO 0
#define PROBE_HI 0
#endif
#define NREP(kind, k) ((PROBE_KIND == (kind) && (k) >= PROBE_LO && (k) <= PROBE_HI) ? PROBE_N : 1)
#define REP(kind, k) for (int rep_ = 0; rep_ < NREP(kind, k); ++rep_)
#ifndef MK_SINGLE
#define MK_SINGLE 1
#endif
__global__ void __launch_bounds__(NTHREADS, 2) mega(KArgs ka) {
    extern __shared__ __attribute__((aligned(16))) unsigned char lds[];
    LAS unsigned char* L = (LAS unsigned char*)lds;
    const size_t gsz = (size_t)gridDim.x * NTHREADS;
#define GT() ([&]() -> size_t { unsigned tx_ = TID(); asm volatile("" : "+v"(tx_)); return (size_t)blockIdx.x * NTHREADS + tx_; }())
    const int lo = ka.ph_lo, hi = ka.ph_hi; (void)lo; (void)hi;
    { const unsigned hw_ = (unsigned)__builtin_amdgcn_s_getreg((5 << 11) | 4) & 63u; if ((threadIdx.x & 63) == 0) ((LAS int*)(L + LDS_WTAB))[hw_] = (int)(threadIdx.x >> 6); __syncthreads(); }
    { const float** tab = (const float**)(ka.ws + WS_TAB); if (threadIdx.x < 28) tab[threadIdx.x] = ka.in[threadIdx.x]; asm volatile("s_waitcnt vmcnt(0)" ::: "memory"); __syncthreads(); }
    Args a; a.in = (const float* const*)(ka.ws + WS_TAB); a.out = ka.out; a.ws = ka.ws;
#define OPQ() do { size_t z_ = 0; asm volatile("" : "+s"(z_)); a.ws = ka.ws + z_; a.out = ka.out + z_; a.in = (const float* const*)(ka.ws + WS_TAB + z_); } while (0)
#if MK_SINGLE
    if (TID() < 4) ((LAS unsigned*)(L + LDS_MISC))[TID()] = 0u;
    __syncthreads();
    XcdBarrier bar = xcd_barrier_post((unsigned*)(a.ws + WS_CTL) + 4096, (volatile LAS unsigned*)(L + LDS_MISC));
#define SEAM(k) do { XcdBarrier bb_ = bar; asm volatile("" : "+s"(bb_.x)); xcd_barrier(bb_); } while (0)
#else
#define SEAM(k) do { } while (0)
#endif
#if MK_SINGLE
#define IN(k) (true)
#else
#define IN(k) (lo <= (k) && (k) < hi)
#endif
#define XN ((bf16*)(a.ws + WS_XN))
#define X ((float*)(a.ws + WS_X))
#define P ((float*)(a.ws + WS_P))
#define H ((bf16*)(a.ws + WS_H))
#define Y2 ((bf16*)(a.ws + WS_Y2))
    if (IN(0)) { OPQ(); REP(2, 0) { ph_prep_x(a); ph_wprep(a, true, 0, GT(), gsz); } SEAM(0); }
    for (int l = 0; l < DEPTH; ++l) {
        const int pb = PH_LAYER0 + l * PH_PER_LAYER, r = l >> 1; unsigned long long* SSb = (unsigned long long*)(a.ws + WS_SS);
        if ((l & 1) == 0) {
            if (IN(pb + 1)) { OPQ(); REP(3, 1) { pg8::Gemm g{XN, (const bf16*)(a.ws + WS_WINR) + (size_t)r * REC_PAD * D, MPAD, REC_PAD, D}; pg8::StaticOrder S; S.init(MPAD, REC_PAD, gridDim.x, blockIdx.x);
                pg8::EpiF32S E{P, LDP, SSb + (size_t)(2 * l) * MPAD}; pg8::gemm_phase<pg8::EpiF32S, pg8::StaticOrder, false>(L, g, S, E, nullptr); } SEAM(pb + 1); }
            if (IN(pb + 2)) { OPQ(); REP(0, 2) { ph_rg_chunk(a, r, L); ph_dn_tok(a, r); } SEAM(pb + 2); }
            if (IN(pb + 3)) { OPQ(); REP(0, 3) ph_dn_chunk(a, L); SEAM(pb + 3); }
            if (IN(pb + 6)) { OPQ();
                constexpr int NDNB = NB * DNH * 8;
                REP(0, 6) {
                if ((int)gridDim.x > NDNB) { if ((int)blockIdx.x < NDNB) {
#ifdef DIAG_NAIVE_B
                    ph_dn_b_naive(a, r, GT(), (size_t)NDNB * NTHREADS);
#else
                    ph_dn_b(a, r, L);
#endif
                } else { const size_t g2 = GT() - (size_t)NDNB * NTHREADS, s2 = gsz - (size_t)NDNB * NTHREADS; ph_rg_scan2(a, r, g2, s2); if (DIAG_SEQ_LO != 0) ph_dn_seq(a, r, DIAG_SEQ_LO, g2, s2);
                    if (l == 0) ph_wprep(a, true, 1, g2, s2); } }
                else { ph_dn_b(a, r, L); ph_rg_scan2(a, r, GT(), gsz); ph_dn_seq(a, r, DIAG_SEQ_LO, GT(), gsz); if (l == 0) ph_wprep(a, true, 1, GT(), gsz); }
                }
                SEAM(pb + 6); }
            if (IN(pb + 7)) { OPQ(); REP(0, 7) ph_rec_out_w(a, r); SEAM(pb + 7); }
            if (IN(pb + 8)) { OPQ(); REP(3, 8) { pg8::Gemm g{Y2, (const bf16*)(a.ws + WS_WOUTR) + (size_t)r * D * Y2W, MP, D, Y2W}; pg8::StaticOrder S; S.init(MP, D, gridDim.x, blockIdx.x);
                pg8::EpiAddN E{X, D, XN, SSb + (size_t)(2 * l + 1) * MPAD}; pg8::gemm_phase<pg8::EpiAddN, pg8::StaticOrder, false>(L, g, S, E, nullptr); small_gemm2<2>(Y2, (const bf16*)(a.ws + WS_WOUTR) + (size_t)r * D * Y2W, D, Y2W, X, D, XN, SSb + (size_t)(2 * l + 1) * MPAD, L); } SEAM(pb + 8); }
        } else {
            if (IN(pb + 1)) { OPQ(); REP(3, 1) { pg8::Gemm g{XN, (const bf16*)(a.ws + WS_WINA) + (size_t)r * ATT_PAD * D, MPAD, ATT_PAD, D}; pg8::StaticOrder S; S.init(MPAD, ATT_PAD, gridDim.x, blockIdx.x);
                pg8::EpiAttS E{a.ws, a.out, SSb + (size_t)(2 * l) * MPAD, r}; pg8::gemm_phase<pg8::EpiAttS, pg8::StaticOrder, false>(L, g, S, E, nullptr); } SEAM(pb + 1); }
            if (IN(pb + 3)) { OPQ(); REP(1, 3) { ph_idx_sample_mfma(a, r); ph_idx_mfma(a, L); } SEAM(pb + 3); }
            if (IN(pb + 4)) { OPQ(); REP(1, 4) ph_select_w(a, L); SEAM(pb + 4); }
            if (IN(pb + 5)) { OPQ(); REP(1, 5) { ph_sparse_sample(a, r, L); ph_sparse_attn(a, L); } SEAM(pb + 5); }
            if (IN(pb + 8)) { OPQ(); REP(3, 8) { pg8::Gemm g{Y2, (const bf16*)(a.ws + WS_WOUTA) + (size_t)r * D * D, MP, D, D}; pg8::StaticOrder S; S.init(MP, D, gridDim.x, blockIdx.x);
                pg8::EpiAddN E{X, D, XN, SSb + (size_t)(2 * l + 1) * MPAD}; pg8::gemm_phase<pg8::EpiAddN, pg8::StaticOrder, false>(L, g, S, E, nullptr); small_gemm2<2>(Y2, (const bf16*)(a.ws + WS_WOUTA) + (size_t)r * D * D, D, D, X, D, XN, SSb + (size_t)(2 * l + 1) * MPAD, L); } SEAM(pb + 8); }
        }
        if (IN(pb + 10)) { OPQ(); REP(3, 10) { pg8::Gemm g{XN, (const bf16*)(a.ws + WS_WUP) + (size_t)l * D_FF * D, MP, D_FF, D}; pg8::StaticOrder S; S.init(MP, D_FF, gridDim.x, blockIdx.x);
            pg8::EpiRelu2S E{H, D_FF, SSb + (size_t)(2 * l + 1) * MPAD}; pg8::gemm_phase<pg8::EpiRelu2S, pg8::StaticOrder, false>(L, g, S, E, nullptr); small_gemm2<1>(XN, (const bf16*)(a.ws + WS_WUP) + (size_t)l * D_FF * D, D_FF, D, H, D_FF, nullptr, SSb + (size_t)(2 * l + 1) * MPAD, L); } SEAM(pb + 10); }
        if (IN(pb + 11)) { OPQ(); REP(3, 11) { pg8::Gemm g{H, (const bf16*)(a.ws + WS_WDN) + (size_t)l * D * D_FF, MP, D, D_FF}; pg8::StaticOrder S; S.init(MP, D, gridDim.x, blockIdx.x);
            pg8::EpiAddN E{X, D, XN, SSb + (size_t)(2 * l + 2) * MPAD}; pg8::gemm_phase<pg8::EpiAddN, pg8::StaticOrder, false>(L, g, S, E, nullptr); small_gemm2<2>(H, (const bf16*)(a.ws + WS_WDN) + (size_t)l * D * D_FF, D, D_FF, X, D, XN, SSb + (size_t)(2 * l + 2) * MPAD, L); } SEAM(pb + 11); }
    }
    if (IN(PH_FINAL)) { OPQ(); ph_final(a); }
}
#undef XN
#undef X
#undef P
#undef H
#undef Y2

extern "C" void kernel_launch(void* const* d_in, const int* in_sizes, int n_in, void* d_out, int out_size, void* d_ws, size_t ws_size, hipStream_t stream) {
    static int grid = 0;
    if (grid == 0) {
        if (n_in != 28 || (size_t)out_size != (size_t)O_END || ws_size < WS_END2) { fprintf(stderr, "kernel_launch: unexpected shapes n_in %d out %d (want %zu) ws %zu (want %zu)\n", n_in, out_size, (size_t)O_END, ws_size, (size_t)WS_END2); grid = -1; return; }
        int dev = 0, cus = 0;
        if (hipGetDevice(&dev) != hipSuccess || hipDeviceGetAttribute(&cus, hipDeviceAttributeMultiprocessorCount, dev) != hipSuccess) { grid = -1; return; }
        if (hipFuncSetAttribute((const void*)mega, hipFuncAttributeMaxDynamicSharedMemorySize, LDS_BYTES) != hipSuccess) { fprintf(stderr, "kernel_launch: hipFuncSetAttribute failed\n"); grid = -1; return; }
        int per_cu = 0; (void)hipOccupancyMaxActiveBlocksPerMultiprocessor(&per_cu, (const void*)mega, NTHREADS, LDS_BYTES); (void)hipGetLastError();
        if (per_cu < 1) fprintf(stderr, "kernel_launch: occupancy query says %d blocks per CU\n", per_cu);
        grid = cus;
    }
    if (grid < 0) return;
    (void)hipMemsetAsync((char*)d_ws + WS_CTL, 0, CTL_BYTES, stream);
    KArgs a{};
    for (int i = 0; i < 28; ++i) a.in[i] = (const float*)d_in[i];
    a.out = (float*)d_out; a.ws = (unsigned char*)d_ws;
#if MK_SINGLE
    a.ph_lo = 0; a.ph_hi = N_PHASES;
    hipLaunchKernelGGL(mega, dim3(grid), dim3(NTHREADS), LDS_BYTES, stream, a);
#else
    for (int ph = 0; ph < N_PHASES; ++ph) { const int k = ph - PH_LAYER0; if (k >= 0 && ph < PH_FINAL && ((k / PH_PER_LAYER) & 1) == 1 && (k % PH_PER_LAYER) == 7) continue;
        a.ph_lo = ph; a.ph_hi = ph + 1; hipLaunchKernelGGL(mega, dim3(grid), dim3(NTHREADS), LDS_BYTES, stream, a); }
#endif
}
#endif
```
